# Optimizing an MI355X kernel written in HIP

```python
import math
import jax, jax.numpy as jnp
from jax import lax
import numpy as np

D_MODEL = 1024
BATCH = 16
SEQ = 256
DEPTH = 4
DEC_BATCH = 4
DEC_SEQ = 1024
PAST_LEN = 512

GRID_W = 64
N_MIXERS = 3
N_ATTN_LAYERS = (DEPTH + 2) // N_MIXERS
N_HGRN_LAYERS = (DEPTH + 1) // N_MIXERS
N_SSM_LAYERS = DEPTH // N_MIXERS

ATTN_HEADS = 16
ATTN_KV_HEADS = 4
ATTN_GROUP = ATTN_HEADS // ATTN_KV_HEADS
HEAD_DIM = D_MODEL // ATTN_HEADS
WINDOW = 128
ATTN_BLOCK = 128
ROPE_BASE = 10000.0

HGRN_EXPAND = 128
HGRN_HEADS = D_MODEL // HGRN_EXPAND
HGRN_DK = HGRN_EXPAND
HGRN_DV = D_MODEL // HGRN_HEADS
HGRN_FDIM = HGRN_HEADS * HGRN_DK
HGRN_VDIM = HGRN_HEADS * HGRN_DV
HGRN_CHUNK = 32

SSM_GROUP = 16
SSM_GROUPS = D_MODEL // SSM_GROUP
SSM_STATE = 64

D_FF = 2816
CONV_WIDTH = 3
NORM_EPS = 1e-6

F32 = jnp.float32

kernel_name = 'hybrid_diffusion_swa_hgrn2_s5_step'


def rmsnorm(x, g):
    xf = x.astype(F32)
    y = xf * lax.rsqrt(jnp.mean(xf * xf, axis=-1, keepdims=True) + NORM_EPS)
    return (y * g.astype(F32)).astype(x.dtype)


def ada_modulation(cond, w, b):
    m = jax.nn.silu(cond) @ w + b
    m = m.reshape(m.shape[:-1] + (1, m.shape[-1]))
    return jnp.split(m, 6, axis=-1)


def modulate(x, shift, scale):
    return x * (1 + scale) + shift


def conv_ffn(xn, w_up, conv_w, conv_b, w_down):
    s = xn.shape[1]
    h = xn @ w_up
    half = CONV_WIDTH // 2
    hp = jnp.pad(h, ((0, 0), (half, half), (0, 0)))
    h = sum(hp[:, j:j + s] * conv_w[j] for j in range(CONV_WIDTH)) + conv_b
    gate, val = jnp.split(h, 2, axis=-1)
    return (jax.nn.silu(gate) * val) @ w_down


def axial_rope(s):
    n_rows = s // GRID_W
    row = jnp.repeat(jnp.arange(n_rows, dtype=F32), GRID_W)
    col = jnp.tile(jnp.arange(GRID_W, dtype=F32), n_rows)
    half = HEAD_DIM // 2
    inv_freq = 1.0 / (ROPE_BASE ** (jnp.arange(0, half, 2, dtype=F32) / half))
    ar = row[:, None] * inv_freq
    ac = col[:, None] * inv_freq
    ang = jnp.concatenate([ar, ar, ac, ac], axis=-1)
    return jnp.cos(ang), jnp.sin(ang)


def _rotate_half(x):
    a, b = jnp.split(x, 2, axis=-1)
    return jnp.concatenate([-b, a], axis=-1)


def apply_rope(x, cos, sin):
    shape = (x.shape[1],) + (1,) * (x.ndim - 3) + (HEAD_DIM,)
    cos = cos.reshape(shape)
    sin = sin.reshape(shape)
    xf = x.astype(F32)
    xr, xc = jnp.split(xf, 2, axis=-1)
    rot = jnp.concatenate([_rotate_half(xr), _rotate_half(xc)], axis=-1)
    return (xf * cos + rot * sin).astype(x.dtype)


def attn_qkv(xn, w):
    b, s, _ = xn.shape
    nq = ATTN_HEADS * HEAD_DIM
    nk = ATTN_KV_HEADS * HEAD_DIM
    qkv = xn @ w
    q = qkv[..., :nq].reshape(b, s, ATTN_KV_HEADS, ATTN_GROUP, HEAD_DIM)
    k = qkv[..., nq:nq + nk].reshape(b, s, ATTN_KV_HEADS, HEAD_DIM)
    v = qkv[..., nq + nk:].reshape(b, s, ATTN_KV_HEADS, HEAD_DIM)
    return q, k, v


def context_attention(q, k, v, sink):
    b, l = q.shape[:2]
    s = jnp.einsum('blhgd,bmhd->bhglm', q, k).astype(F32) * HEAD_DIM ** -0.5
    s_sink = jnp.broadcast_to(sink.astype(F32).reshape(1, ATTN_KV_HEADS, ATTN_GROUP, 1, 1), s.shape[:-1] + (1,))
    p = jax.nn.softmax(jnp.concatenate([s, s_sink], axis=-1), axis=-1)[..., :l]
    o = jnp.einsum('bhglm,bmhd->blhgd', p.astype(v.dtype), v)
    return o.reshape(b, l, ATTN_HEADS * HEAD_DIM)


def latent_attention(q, k, v, ck, cv, sink):
    b, s = q.shape[:2]
    blk = ATTN_BLOCK
    nb = s // blk
    scale = HEAD_DIM ** -0.5
    qb = q.reshape(b, nb, blk, ATTN_KV_HEADS, ATTN_GROUP, HEAD_DIM)
    pad = ((0, 0), (blk, blk), (0, 0), (0, 0))
    kp = jnp.pad(k, pad).reshape(b, nb + 2, blk, ATTN_KV_HEADS, HEAD_DIM)
    vp = jnp.pad(v, pad).reshape(b, nb + 2, blk, ATTN_KV_HEADS, HEAD_DIM)
    kb = jnp.concatenate([kp[:, 0:nb], kp[:, 1:nb + 1], kp[:, 2:nb + 2]], axis=2)
    vb = jnp.concatenate([vp[:, 0:nb], vp[:, 1:nb + 1], vp[:, 2:nb + 2]], axis=2)
    rel = jnp.arange(3 * blk)[None, :] - blk - jnp.arange(blk)[:, None]
    band = jnp.abs(rel) <= WINDOW
    kpos = jnp.arange(nb)[:, None] * blk - blk + jnp.arange(3 * blk)[None, :]
    valid = (kpos >= 0) & (kpos < s)
    mask = band[None, :, :] & valid[:, None, :]
    s_lat = jnp.einsum('bnqhgd,bnkhd->bnhgqk', qb, kb).astype(F32) * scale
    s_lat = jnp.where(mask[None, :, None, None], s_lat, -jnp.inf)
    s_ctx = jnp.einsum('bnqhgd,blhd->bnhgql', qb, ck).astype(F32) * scale
    s_sink = jnp.broadcast_to(sink.astype(F32).reshape(1, 1, ATTN_KV_HEADS, ATTN_GROUP, 1, 1), s_lat.shape[:-1] + (1,))
    p = jax.nn.softmax(jnp.concatenate([s_lat, s_ctx, s_sink], axis=-1), axis=-1)
    n_lat = 3 * blk
    n_ctx = ck.shape[1]
    p_lat = p[..., :n_lat].astype(v.dtype)
    p_ctx = p[..., n_lat:n_lat + n_ctx].astype(cv.dtype)
    o = jnp.einsum('bnhgqk,bnkhd->bnqhgd', p_lat, vb) + jnp.einsum('bnhgql,blhd->bnqhgd', p_ctx, cv)
    return o.reshape(b, s, ATTN_HEADS * HEAD_DIM)


def hgrn_chunk_scan(q, k, v, log_f, s0):
    b, s, h, dk = q.shape
    dv = v.shape[-1]
    c = HGRN_CHUNK
    nc = s // c

    def chunks(t):
        return t.reshape(b, nc, c, h, t.shape[-1]).transpose(1, 0, 3, 2, 4)

    causal = jnp.tril(jnp.ones((c, c), dtype=bool))[:, :, None]

    def step(state, xs):
        qc, kc, vc, gc = xs
        cum = jnp.cumsum(gc, axis=2)
        inter = jnp.einsum('bhtd,bhdv->bhtv', qc * jnp.exp(cum), state)
        diff = cum[:, :, :, None, :] - cum[:, :, None, :, :]
        decay = jnp.exp(jnp.where(causal, diff, -jnp.inf))
        att = jnp.einsum('bhtsd,bhsd->bhts', qc[:, :, :, None, :] * decay, kc)
        out = inter + jnp.einsum('bhts,bhsv->bhtv', att, vc)
        last = cum[:, :, -1, :]
        k_dec = kc * jnp.exp(last[:, :, None, :] - cum)
        new_state = jnp.exp(last)[..., None] * state + jnp.einsum('bhsd,bhsv->bhdv', k_dec, vc)
        return new_state, out

    s_fin, o = lax.scan(step, s0, (chunks(q), chunks(k), chunks(v), chunks(log_f)))
    o = o.transpose(1, 0, 3, 2, 4).reshape(b, s, h, dv)
    return o, s_fin


def hgrn_mix(xn, w_in, lb, g_norm, w_o, s0_f, s0_b):
    b, s, _ = xn.shape
    proj = (xn @ w_in).astype(F32)
    cuts = (HGRN_FDIM, HGRN_FDIM + HGRN_VDIM, 2 * HGRN_FDIM + HGRN_VDIM, 3 * HGRN_FDIM + HGRN_VDIM)
    q, i, zf, zb, g = jnp.split(proj, cuts, axis=-1)

    def heads(t):
        return t.reshape(b, s, HGRN_HEADS, t.shape[-1] // HGRN_HEADS)

    q, i, zf, zb, g = heads(q), heads(i), heads(zf), heads(zb), heads(g)

    def log_forget(z, lbd):
        lbd = lbd.astype(F32).reshape(HGRN_HEADS, HGRN_DK)
        return jnp.logaddexp(jnp.log(lbd), jnp.log1p(-lbd) + jax.nn.log_sigmoid(z))

    lf_f = log_forget(zf, lb[0])
    lf_b = log_forget(zb, lb[1])
    o_f, s_f = hgrn_chunk_scan(q, -jnp.expm1(lf_f), i, lf_f, s0_f)
    o_b, s_b = hgrn_chunk_scan(jnp.flip(q, 1), jnp.flip(-jnp.expm1(lf_b), 1), jnp.flip(i, 1), jnp.flip(lf_b, 1), s0_b)
    o = o_f + jnp.flip(o_b, 1)
    o = o * lax.rsqrt(jnp.mean(o * o, axis=-1, keepdims=True) + NORM_EPS) * g_norm.astype(F32) * jax.nn.silu(g)
    return o.reshape(b, s, HGRN_VDIM).astype(xn.dtype) @ w_o, s_f, s_b


def ssm_discretize(a_re, a_im, log_dt, b_re, b_im):
    lam = lax.complex(jnp.minimum(a_re.astype(F32), -1e-4), a_im.astype(F32))
    dt = jnp.exp(log_dt.astype(F32))[:, None]
    lam_bar = jnp.exp(lam * dt)
    b_bar = ((lam_bar - 1.0) / lam)[..., None] * lax.complex(b_re.astype(F32), b_im.astype(F32))
    return lam_bar, b_bar


def ssm_scan(u, lam_bar, b_bar, h0):
    bu = jnp.einsum('bsgi,gpi->bsgp', u.astype(jnp.complex64), b_bar)
    bu = bu.at[:, 0].add(lam_bar * h0)
    a = jnp.broadcast_to(lam_bar, bu.shape)

    def combine(e1, e2):
        a1, b1 = e1
        a2, b2 = e2
        return a1 * a2, a2 * b1 + b2

    _, h = lax.associative_scan(combine, (a, bu), axis=1)
    return h


def ssm_mix(xn, a_re, a_im, log_dt, b_re, b_im, c_re, c_im, d, w_glu, h0_f, h0_b):
    b, s, dm = xn.shape
    u = xn.astype(F32).reshape(b, s, SSM_GROUPS, SSM_GROUP)
    y = d.astype(F32) * xn.astype(F32)
    finals = []
    for direction, h0 in enumerate((h0_f, h0_b)):
        lam_bar, b_bar = ssm_discretize(a_re[direction], a_im[direction], log_dt[direction], b_re[direction], b_im[direction])
        ud = u if direction == 0 else jnp.flip(u, axis=1)
        h = ssm_scan(ud, lam_bar, b_bar, h0)
        c_mat = lax.complex(c_re[direction].astype(F32), c_im[direction].astype(F32))
        yd = jnp.einsum('gip,bsgp->bsgi', c_mat, h).real.reshape(b, s, dm)
        y = y + (yd if direction == 0 else jnp.flip(yd, axis=1))
        finals.append(h[:, -1])
    g = jax.nn.gelu(y).astype(xn.dtype)
    val, gate = jnp.split(g @ w_glu, 2, axis=-1)
    return val * jax.nn.sigmoid(gate), finals[0], finals[1]


def to_complex(st):
    st = st.astype(F32)
    return lax.complex(st[..., 0], st[..., 1])


def from_complex(h):
    return jnp.stack([h.real, h.imag], axis=-1)


def setup_inputs(seed: int = 0) -> dict:
    key = jax.random.key(seed)
    ks = iter(jax.random.split(key, 40))

    def nrm(shape, scale):
        return scale * jax.random.normal(next(ks), shape, F32)

    D = D_MODEL
    qkv_w = (ATTN_HEADS + 2 * ATTN_KV_HEADS) * HEAD_DIM
    hg_in = 3 * HGRN_FDIM + 2 * HGRN_VDIM
    ssm_gp = (N_SSM_LAYERS, 2, SSM_GROUPS, SSM_STATE)
    n_idx = jnp.arange(SSM_STATE, dtype=F32)
    return {
        'x_prompt': nrm((BATCH, SEQ, D), 1.0),
        'x_sample': nrm((DEC_BATCH, DEC_SEQ, D), 1.0),
        'cache_k': nrm((DEC_BATCH, N_ATTN_LAYERS, PAST_LEN, ATTN_KV_HEADS, HEAD_DIM), 1.0),
        'cache_v': nrm((DEC_BATCH, N_ATTN_LAYERS, PAST_LEN, ATTN_KV_HEADS, HEAD_DIM), 1.0),
        'state_hgrn': nrm((DEC_BATCH, N_HGRN_LAYERS, 2, HGRN_HEADS, HGRN_DK, HGRN_DV), 0.5),
        'state_ssm': nrm((DEC_BATCH, N_SSM_LAYERS, 2, SSM_GROUPS, SSM_STATE, 2), 0.1),
        'c': nrm((DEC_BATCH, D), 1.0),
        'c_ctx': nrm((D,), 1.0),
        'ada_w': nrm((DEPTH, D, 6 * D), 0.5 * D ** -0.5),
        'ada_b': nrm((DEPTH, 6 * D), 0.01),
        'norm1_g': 1.0 + nrm((DEPTH, D), 0.02),
        'norm2_g': 1.0 + nrm((DEPTH, D), 0.02),
        'attn_wqkv': nrm((N_ATTN_LAYERS, D, qkv_w), D ** -0.5),
        'attn_wo': nrm((N_ATTN_LAYERS, ATTN_HEADS * HEAD_DIM, D), (ATTN_HEADS * HEAD_DIM) ** -0.5),
        'attn_sink': nrm((N_ATTN_LAYERS, ATTN_HEADS), 0.5),
        'hgrn_w_in': nrm((N_HGRN_LAYERS, D, hg_in), D ** -0.5),
        'hgrn_lb': nrm((DEPTH, 2, HGRN_FDIM), 0.5),
        'hgrn_g_norm': 1.0 + nrm((N_HGRN_LAYERS, HGRN_DV), 0.02),
        'hgrn_wo': nrm((N_HGRN_LAYERS, HGRN_VDIM, D), HGRN_VDIM ** -0.5),
        'ssm_a_re': -0.5 + nrm(ssm_gp, 0.01),
        'ssm_a_im': math.pi * n_idx + nrm(ssm_gp, 0.01),
        'ssm_log_dt': jax.random.uniform(next(ks), (N_SSM_LAYERS, 2, SSM_GROUPS), F32, math.log(1e-3), math.log(1e-1)),
        'ssm_b_re': nrm(ssm_gp + (SSM_GROUP,), (2 * SSM_GROUP) ** -0.5),
        'ssm_b_im': nrm(ssm_gp + (SSM_GROUP,), (2 * SSM_GROUP) ** -0.5),
        'ssm_c_re': nrm((N_SSM_LAYERS, 2, SSM_GROUPS, SSM_GROUP, SSM_STATE), SSM_STATE ** -0.5),
        'ssm_c_im': nrm((N_SSM_LAYERS, 2, SSM_GROUPS, SSM_GROUP, SSM_STATE), SSM_STATE ** -0.5),
        'ssm_d': nrm((N_SSM_LAYERS, D), 0.5),
        'ssm_w_glu': nrm((N_SSM_LAYERS, D, 2 * D), D ** -0.5),
        'ffn_w_up': nrm((DEPTH, D, 2 * D_FF), D ** -0.5),
        'ffn_conv_w': nrm((DEPTH, CONV_WIDTH, 2 * D_FF), 0.6),
        'ffn_conv_b': nrm((DEPTH, 2 * D_FF), 0.01),
        'ffn_w_down': nrm((DEPTH, D_FF, D), D_FF ** -0.5),
        'final_g': 1.0 + nrm((D,), 0.02),
    }


def reference(x_prompt, x_sample, cache_k, cache_v, state_hgrn, state_ssm, c, c_ctx,
              ada_w, ada_b, norm1_g, norm2_g, attn_wqkv, attn_wo, attn_sink,
              hgrn_w_in, hgrn_lb, hgrn_g_norm, hgrn_wo,
              ssm_a_re, ssm_a_im, ssm_log_dt, ssm_b_re, ssm_b_im, ssm_c_re, ssm_c_im, ssm_d, ssm_w_glu,
              ffn_w_up, ffn_conv_w, ffn_conv_b, ffn_w_down, final_g):
    bp = x_prompt.shape[0]
    s_lat = x_sample.shape[1]
    rope_cos, rope_sin = axial_rope(s_lat)
    lb_p = jax.nn.softmax(hgrn_lb.astype(F32), axis=0)
    lb_all = jnp.cumsum(lb_p, axis=0) - lb_p[:1]

    xp, xs = x_prompt, x_sample
    new_k, new_v, new_hgrn, new_ssm = [], [], [], []
    for l in range(DEPTH):
        kind, j = l % N_MIXERS, l // N_MIXERS
        mod_p = ada_modulation(c_ctx, ada_w[l], ada_b[l])
        mod_s = ada_modulation(c, ada_w[l], ada_b[l])
        hp = modulate(rmsnorm(xp, norm1_g[l]), mod_p[0], mod_p[1])
        hs = modulate(rmsnorm(xs, norm1_g[l]), mod_s[0], mod_s[1])
        if kind == 0:
            q, k, v = attn_qkv(hp, attn_wqkv[j])
            op = context_attention(q, k, v, attn_sink[j]) @ attn_wo[j]
            new_k.append(k)
            new_v.append(v)
            q, k, v = attn_qkv(hs, attn_wqkv[j])
            q = apply_rope(q, rope_cos, rope_sin)
            k = apply_rope(k, rope_cos, rope_sin)
            os_ = latent_attention(q, k, v, cache_k[:, j], cache_v[:, j], attn_sink[j]) @ attn_wo[j]
        elif kind == 1:
            z = jnp.zeros((bp, HGRN_HEADS, HGRN_DK, HGRN_DV), F32)
            op, sf, sb = hgrn_mix(hp, hgrn_w_in[j], lb_all[l], hgrn_g_norm[j], hgrn_wo[j], z, z)
            new_hgrn.append(jnp.stack([sf, sb], axis=1))
            os_, _, _ = hgrn_mix(hs, hgrn_w_in[j], lb_all[l], hgrn_g_norm[j], hgrn_wo[j],
                                 state_hgrn[:, j, 0].astype(F32), state_hgrn[:, j, 1].astype(F32))
        else:
            ssm_args = (ssm_a_re[j], ssm_a_im[j], ssm_log_dt[j], ssm_b_re[j], ssm_b_im[j],
                        ssm_c_re[j], ssm_c_im[j], ssm_d[j], ssm_w_glu[j])
            z = jnp.zeros((bp, SSM_GROUPS, SSM_STATE), jnp.complex64)
            op, hf, hb = ssm_mix(hp, *ssm_args, z, z)
            new_ssm.append(jnp.stack([from_complex(hf), from_complex(hb)], axis=1))
            os_, _, _ = ssm_mix(hs, *ssm_args, to_complex(state_ssm[:, j, 0]), to_complex(state_ssm[:, j, 1]))
        xp = xp + mod_p[2] * op
        xs = xs + mod_s[2] * os_
        hp = modulate(rmsnorm(xp, norm2_g[l]), mod_p[3], mod_p[4])
        hs = modulate(rmsnorm(xs, norm2_g[l]), mod_s[3], mod_s[4])
        xp = xp + mod_p[5] * conv_ffn(hp, ffn_w_up[l], ffn_conv_w[l], ffn_conv_b[l], ffn_w_down[l])
        xs = xs + mod_s[5] * conv_ffn(hs, ffn_w_up[l], ffn_conv_w[l], ffn_conv_b[l], ffn_w_down[l])

    y_prompt = rmsnorm(xp, final_g)
    y_sample = rmsnorm(xs, final_g)
    new_cache_k = jnp.stack(new_k, axis=1)
    new_cache_v = jnp.stack(new_v, axis=1)
    new_state_hgrn = jnp.stack(new_hgrn, axis=1)
    new_state_ssm = jnp.stack(new_ssm, axis=1)
    return (y_prompt, y_sample, new_cache_k, new_cache_v, new_state_hgrn, new_state_ssm)
```

```cpp
#include <hip/hip_runtime.h>
#include <cstdio>
#include <cstdint>
#include <cmath>
namespace refp {
constexpr int D = 1024, MP = 4096, M = 8192, DFF = 2816;
constexpr float EPS = 1e-6f;
__device__ __forceinline__ int cond_of_row(int r) { return r < MP ? 0 : 1 + ((r - MP) >> 10); }
__device__ __forceinline__ float silu_f(float x) { return x / (1.f + expf(-x)); }
__device__ __forceinline__ float sigm_f(float x) { return 1.f / (1.f + expf(-x)); }

__global__ void k_ada(const float* __restrict__ c_s, const float* __restrict__ c_ctx, const float* __restrict__ w, const float* __restrict__ b, float* __restrict__ mod) {
    const int l = blockIdx.y, n = blockIdx.x * 256 + threadIdx.x;
    __shared__ float sc[5][1024];
    for (int i = threadIdx.x; i < 5 * 1024; i += 256) { const int c = i >> 10, k = i & 1023; const float v = c == 0 ? c_ctx[k] : c_s[(c - 1) * 1024 + k]; sc[c][k] = silu_f(v); }
    __syncthreads();
    float acc[5] = {0.f, 0.f, 0.f, 0.f, 0.f};
    const float* wp = w + (size_t)l * 1024 * 6144 + n;
    for (int k = 0; k < 1024; ++k) { const float wv = wp[(size_t)k * 6144];
#pragma unroll
        for (int c = 0; c < 5; ++c) acc[c] += sc[c][k] * wv; }
#pragma unroll
    for (int c = 0; c < 5; ++c) mod[((size_t)l * 5 + c) * 6144 + n] = acc[c] + b[l * 6144 + n];
}
__global__ void k_normmod(const float* __restrict__ x, const float* __restrict__ g, const float* __restrict__ modl  , int shift_idx, float* __restrict__ xn) {
    const int r = blockIdx.x, c = cond_of_row(r);
    __shared__ float red[256];
    const float* xr = x + (size_t)r * D;
    float s = 0.f;
    for (int n = threadIdx.x; n < D; n += 256) { const float v = xr[n]; s += v * v; }
    red[threadIdx.x] = s; __syncthreads();
    for (int o = 128; o > 0; o >>= 1) { if (threadIdx.x < o) red[threadIdx.x] += red[threadIdx.x + o]; __syncthreads(); }
    const float rstd = 1.f / sqrtf(red[0] / D + EPS);
    const float* sh = modl + (size_t)c * 6144 + shift_idx * 1024; const float* scl = sh + 1024;
    for (int n = threadIdx.x; n < D; n += 256) xn[(size_t)r * D + n] = xr[n] * rstd * g[n] * (1.f + scl[n]) + sh[n];
}
__global__ void __launch_bounds__(256) k_gemm(const float* __restrict__ A, const float* __restrict__ B, float* __restrict__ C, int Mm, int Nn, int Kk) {
    __shared__ float As[8][132], Bs[8][132];
    const int tid = threadIdx.x, tx = tid & 15, ty = tid >> 4;
    const int m0 = blockIdx.y * 128, n0 = blockIdx.x * 128;
    float acc[8][8];
#pragma unroll
    for (int i = 0; i < 8; ++i)
#pragma unroll
        for (int j = 0; j < 8; ++j) acc[i][j] = 0.f;
    for (int k0 = 0; k0 < Kk; k0 += 8) {
        { const int r = tid >> 1, kc = (tid & 1) * 4; const float4 v = *(const float4*)(A + (size_t)(m0 + r) * Kk + k0 + kc);
          As[kc + 0][r] = v.x; As[kc + 1][r] = v.y; As[kc + 2][r] = v.z; As[kc + 3][r] = v.w; }
        { const int kr = tid >> 5, nc = (tid & 31) * 4; const float4 v = *(const float4*)(B + (size_t)(k0 + kr) * Nn + n0 + nc);
          *(float4*)&Bs[kr][nc] = v; }
        __syncthreads();
#pragma unroll
        for (int k = 0; k < 8; ++k) {
            float a[8], b[8];
#pragma unroll
            for (int i = 0; i < 8; ++i) a[i] = As[k][ty * 8 + i];
#pragma unroll
            for (int j = 0; j < 8; ++j) b[j] = Bs[k][tx * 8 + j];
#pragma unroll
            for (int i = 0; i < 8; ++i)
#pragma unroll
                for (int j = 0; j < 8; ++j) acc[i][j] += a[i] * b[j];
        }
        __syncthreads();
    }
#pragma unroll
    for (int i = 0; i < 8; ++i)
#pragma unroll
        for (int j = 0; j < 8; j += 4) *(float4*)(C + (size_t)(m0 + ty * 8 + i) * Nn + n0 + tx * 8 + j) = make_float4(acc[i][j], acc[i][j + 1], acc[i][j + 2], acc[i][j + 3]);
}
__global__ void k_res(float* __restrict__ x, const float* __restrict__ raw, const float* __restrict__ modl, int gidx) {
    const size_t i = (size_t)blockIdx.x * 256 + threadIdx.x; const int r = (int)(i >> 10), n = (int)(i & 1023);
    x[i] += modl[(size_t)cond_of_row(r) * 6144 + gidx * 1024 + n] * raw[i];
}
__global__ void k_qkv_post(const float* __restrict__ qkv, float* __restrict__ Q, float* __restrict__ K, float* __restrict__ V, float* __restrict__ outK, float* __restrict__ outV, int j) {
    const size_t i = (size_t)blockIdx.x * 256 + threadIdx.x; const int r = (int)(i / 1536), n = (int)(i % 1536);
    float v = qkv[i];
    const bool samp = r >= MP;
    if (samp && n < 1280) {
        const int t = (r - MP) & 1023, d = n & 63, half = d >> 5, dd = d & 31, fi = dd & 15;
        const float pos = half == 0 ? (float)(t >> 6) : (float)(t & 63);
        const float inv = 1.0f / powf(10000.0f, (float)(2 * fi) / 32.0f);
        const float ang = pos * inv, cs = cosf(ang), sn = sinf(ang);
        const float other = dd < 16 ? qkv[i + 16] : qkv[i - 16];
        v = dd < 16 ? v * cs - other * sn : v * cs + other * sn;
    }
    if (n < 1024) Q[(size_t)r * 1024 + n] = v;
    else if (n < 1280) { K[(size_t)r * 256 + n - 1024] = v; if (!samp) { const int b = r >> 8, t = r & 255; outK[(((size_t)b * 2 + j) * 256 + t) * 256 + n - 1024] = v; } }
    else { V[(size_t)r * 256 + n - 1280] = v; if (!samp) { const int b = r >> 8, t = r & 255; outV[(((size_t)b * 2 + j) * 256 + t) * 256 + n - 1280] = v; } }
}
__global__ void __launch_bounds__(64) k_attn(const float* __restrict__ Q, const float* __restrict__ K, const float* __restrict__ V, const float* __restrict__ ck, const float* __restrict__ cv,
                                             const float* __restrict__ sink, float* __restrict__ O, int j) {
    const int r = blockIdx.x * 64 + threadIdx.x, hq = blockIdx.y, kvh = hq >> 2;
    float q[64], o[64];
#pragma unroll
    for (int d = 0; d < 64; ++d) { q[d] = Q[(size_t)r * 1024 + hq * 64 + d] * 0.125f; o[d] = 0.f; }
    float m = sink[j * 16 + hq], l = 1.f;
    const bool samp = r >= MP;
    int kbeg, kend, rowbase, t;
    if (!samp) { rowbase = (r >> 8) << 8; t = r & 255; kbeg = 0; kend = 256; }
    else { rowbase = MP + (((r - MP) >> 10) << 10); t = (r - MP) & 1023; const int t0 = t & ~63; kbeg = t0 - 128 < 0 ? 0 : t0 - 128; kend = t0 + 63 + 128 + 1 > 1024 ? 1024 : t0 + 63 + 128 + 1; }
    for (int kk = kbeg; kk < kend; ++kk) {
        const float* kp = K + (size_t)(rowbase + kk) * 256 + kvh * 64;
        float s = 0.f;
#pragma unroll
        for (int d = 0; d < 64; ++d) s += q[d] * kp[d];
        const bool ok = !samp || (kk - t <= 128 && t - kk <= 128);
        if (ok) {
            const float mn = fmaxf(m, s), a = expf(m - mn), p = expf(s - mn);
            l = l * a + p; m = mn;
            const float* vp = V + (size_t)(rowbase + kk) * 256 + kvh * 64;
#pragma unroll
            for (int d = 0; d < 64; ++d) o[d] = o[d] * a + p * vp[d];
        }
    }
    if (samp) {
        const int b = (r - MP) >> 10;
        for (int kk = 0; kk < 512; ++kk) {
            const size_t off = ((((size_t)b * 2 + j) * 512 + kk) * 4 + kvh) * 64;
            const float* kp = ck + off; float s = 0.f;
#pragma unroll
            for (int d = 0; d < 64; ++d) s += q[d] * kp[d];
            const float mn = fmaxf(m, s), a = expf(m - mn), p = expf(s - mn);
            l = l * a + p; m = mn;
            const float* vp = cv + off;
#pragma unroll
            for (int d = 0; d < 64; ++d) o[d] = o[d] * a + p * vp[d];
        }
    }
    const float il = 1.f / l;
#pragma unroll
    for (int d = 0; d < 64; ++d) O[(size_t)r * 1024 + hq * 64 + d] = o[d] * il;
}
__global__ void k_lb(const float* __restrict__ lb, float* __restrict__ lb1) {
    const int i = blockIdx.x * 256 + threadIdx.x; if (i >= 2048) return;
    float v[4], mx = -1e30f; for (int l = 0; l < 4; ++l) { v[l] = lb[l * 2048 + i]; mx = fmaxf(mx, v[l]); }
    float s = 0.f; for (int l = 0; l < 4; ++l) { v[l] = expf(v[l] - mx); s += v[l]; }
    lb1[i] = v[1] / s;
}
__global__ void __launch_bounds__(128) k_hgrn(const float* __restrict__ proj, const float* __restrict__ lb1, const float* __restrict__ st_in, float* __restrict__ odir, float* __restrict__ st_out) {
    const int dir = blockIdx.x & 1, h = (blockIdx.x >> 1) & 7, sq = blockIdx.x >> 4;
    const bool samp = sq >= 16; const int S = samp ? 1024 : 256, rowbase = samp ? MP + (sq - 16) * 1024 : sq * 256;
    const int v = threadIdx.x;
    __shared__ float sf[128], sk[128], sq_[128];
    float St[128];
#pragma unroll
    for (int d = 0; d < 128; ++d) St[d] = samp ? st_in[((((size_t)(sq - 16) * 1 + 0) * 2 + dir) * 8 + h) * 16384 + d * 128 + v] : 0.f;
    const float lbv = lb1[dir * 1024 + h * 128 + v];
    for (int s = 0; s < S; ++s) {
        const int t = dir == 0 ? s : S - 1 - s; const float* pr = proj + (size_t)(rowbase + t) * 5120;
        { const float z = pr[(2 + dir) * 1024 + h * 128 + v]; const float f = lbv + (1.f - lbv) * sigm_f(z); sf[v] = f; sk[v] = 1.f - f; sq_[v] = pr[h * 128 + v]; }
        __syncthreads();
        const float vt = pr[1024 + h * 128 + v]; float o = 0.f;
#pragma unroll
        for (int d = 0; d < 128; ++d) { St[d] = sf[d] * St[d] + sk[d] * vt; o += St[d] * sq_[d]; }
        odir[((size_t)dir * M + rowbase + t) * 1024 + h * 128 + v] = o;
        __syncthreads();
    }
    if (!samp) {
#pragma unroll
        for (int d = 0; d < 128; ++d) st_out[((((size_t)sq * 1 + 0) * 2 + dir) * 8 + h) * 16384 + d * 128 + v] = St[d];
    }
}
__global__ void __launch_bounds__(128) k_hgrn_post(const float* __restrict__ odir, const float* __restrict__ proj, const float* __restrict__ gn, float* __restrict__ A) {
    const int r = blockIdx.x >> 3, h = blockIdx.x & 7, v = threadIdx.x;
    __shared__ float red[128];
    const float o = odir[(size_t)r * 1024 + h * 128 + v] + odir[((size_t)M + r) * 1024 + h * 128 + v];
    red[v] = o * o; __syncthreads();
    for (int s = 64; s > 0; s >>= 1) { if (v < s) red[v] += red[v + s]; __syncthreads(); }
    const float rstd = 1.f / sqrtf(red[0] / 128.f + EPS);
    const float g = proj[(size_t)r * 5120 + 4096 + h * 128 + v];
    A[(size_t)r * 1024 + h * 128 + v] = o * rstd * gn[v] * silu_f(g);
}
__global__ void __launch_bounds__(64) k_ssm(const float* __restrict__ xn, const float* __restrict__ a_re, const float* __restrict__ a_im, const float* __restrict__ log_dt,
                                            const float* __restrict__ b_re, const float* __restrict__ b_im, const float* __restrict__ c_re, const float* __restrict__ c_im,
                                            const float* __restrict__ st_in, float* __restrict__ ydir, float* __restrict__ st_out) {
    const int g = blockIdx.x & 63, dir = (blockIdx.x >> 6) & 1, sq = blockIdx.x >> 7;
    const bool samp = sq >= 16; const int S = samp ? 1024 : 256, rowbase = samp ? MP + (sq - 16) * 1024 : sq * 256;
    const int p = threadIdx.x; const int dg = dir * 64 + g;
    const float ar = fminf(a_re[dg * 64 + p], -1e-4f), ai = a_im[dg * 64 + p], dt = expf(log_dt[dg]);
    const float e = expf(ar * dt), lr = e * cosf(ai * dt), li = e * sinf(ai * dt);
    const float den = ar * ar + ai * ai, fr = ((lr - 1.f) * ar + li * ai) / den, fi = (li * ar - (lr - 1.f) * ai) / den;
    float br[16], bi[16];
#pragma unroll
    for (int i = 0; i < 16; ++i) { const float xr = b_re[((size_t)dg * 64 + p) * 16 + i], xi = b_im[((size_t)dg * 64 + p) * 16 + i]; br[i] = fr * xr - fi * xi; bi[i] = fr * xi + fi * xr; }
    float cr[64], ci[64];
#pragma unroll
    for (int q = 0; q < 64; ++q) { const int i = p & 15; cr[q] = c_re[((size_t)dg * 16 + i) * 64 + q]; ci[q] = c_im[((size_t)dg * 16 + i) * 64 + q]; }
    float hr = 0.f, hi = 0.f;
    if (samp) { const size_t o = (((((size_t)(sq - 16) * 1 + 0) * 2 + dir) * 64 + g) * 64 + p) * 2; hr = st_in[o]; hi = st_in[o + 1]; }
    __shared__ float shr[64], shi[64];
    for (int s = 0; s < S; ++s) {
        const int t = dir == 0 ? s : S - 1 - s; const float* u = xn + (size_t)(rowbase + t) * 1024 + g * 16;
        float bur = 0.f, bui = 0.f;
#pragma unroll
        for (int i = 0; i < 16; ++i) { const float uv = u[i]; bur += br[i] * uv; bui += bi[i] * uv; }
        const float nr = lr * hr - li * hi + bur, ni = lr * hi + li * hr + bui; hr = nr; hi = ni;
        shr[p] = hr; shi[p] = hi; __syncthreads();
        if (p < 16) { float y = 0.f;
#pragma unroll
            for (int q = 0; q < 64; ++q) y += cr[q] * shr[q] - ci[q] * shi[q];
            ydir[((size_t)dir * M + rowbase + t) * 1024 + g * 16 + p] = y; }
        __syncthreads();
    }
    if (!samp) { const size_t o = (((((size_t)sq * 1 + 0) * 2 + dir) * 64 + g) * 64 + p) * 2; st_out[o] = hr; st_out[o + 1] = hi; }
}
__device__ __forceinline__ float gelu_tanh(float y) { const float u = 0.7978845608028654f * (y + 0.044715f * y * y * y); return 0.5f * y * (1.f + tanhf(u)); }
__global__ void k_ssm_post(const float* __restrict__ xn, const float* __restrict__ ydir, const float* __restrict__ dvec, float* __restrict__ A) {
    const size_t i = (size_t)blockIdx.x * 256 + threadIdx.x; const int n = (int)(i & 1023);
    const float y = dvec[n] * xn[i] + ydir[i] + ydir[(size_t)M * 1024 + i];
    A[i] = gelu_tanh(y);
}
__global__ void k_glu_res(float* __restrict__ x, const float* __restrict__ raw, const float* __restrict__ modl, int gidx) {
    const size_t i = (size_t)blockIdx.x * 256 + threadIdx.x; const int r = (int)(i >> 10), n = (int)(i & 1023);
    const float val = raw[(size_t)r * 2048 + n], gt = raw[(size_t)r * 2048 + 1024 + n];
    x[i] += modl[(size_t)cond_of_row(r) * 6144 + gidx * 1024 + n] * (val * sigm_f(gt));
}
__global__ void k_conv_act(const float* __restrict__ h, const float* __restrict__ cw, const float* __restrict__ cb, float* __restrict__ act) {
    const size_t i = (size_t)blockIdx.x * 256 + threadIdx.x; const int r = (int)(i / DFF), n = (int)(i % DFF);
    int t, S; if (r < MP) { t = r & 255; S = 256; } else { t = (r - MP) & 1023; S = 1024; }
    float g = cb[n], v = cb[DFF + n];
#pragma unroll
    for (int jj = 0; jj < 3; ++jj) { const int tt = t + jj - 1; if (tt >= 0 && tt < S) { const float* hr = h + (size_t)(r + jj - 1) * 5632; g += cw[jj * 5632 + n] * hr[n]; v += cw[jj * 5632 + DFF + n] * hr[DFF + n]; } }
    act[i] = silu_f(g) * v;
}
__global__ void k_final(const float* __restrict__ x, const float* __restrict__ g, float* __restrict__ y) {
    const int r = blockIdx.x; __shared__ float red[256];
    const float* xr = x + (size_t)r * D; float s = 0.f;
    for (int n = threadIdx.x; n < D; n += 256) { const float v = xr[n]; s += v * v; }
    red[threadIdx.x] = s; __syncthreads();
    for (int o = 128; o > 0; o >>= 1) { if (threadIdx.x < o) red[threadIdx.x] += red[threadIdx.x + o]; __syncthreads(); }
    const float rstd = 1.f / sqrtf(red[0] / D + EPS);
    for (int n = threadIdx.x; n < D; n += 256) y[(size_t)r * D + n] = xr[n] * rstd * g[n];
}

struct Bufs { float *mod, *x, *xn, *raw, *act, *q, *k, *v, *o, *odir, *a, *lb1; };
inline Bufs carve(void* d_ws) { char* w = (char*)d_ws; const size_t Mi = 1u << 20; Bufs b;
    b.mod = (float*)(w + 0); b.lb1 = (float*)(w + 512 * 1024); b.x = (float*)(w + 1 * Mi); b.xn = (float*)(w + 33 * Mi); b.raw = (float*)(w + 65 * Mi); b.act = (float*)(w + 241 * Mi);
    b.q = (float*)(w + 241 * Mi); b.k = (float*)(w + 273 * Mi); b.v = (float*)(w + 281 * Mi); b.o = (float*)(w + 289 * Mi);
    b.odir = (float*)(w + 241 * Mi); b.a = (float*)(w + 305 * Mi); return b; }

inline void run(void* const* d_in, float* out, void* d_ws, hipStream_t st) {
    const float* x_prompt = (const float*)d_in[0]; const float* x_sample = (const float*)d_in[1];
    const float* cache_k = (const float*)d_in[2]; const float* cache_v = (const float*)d_in[3];
    const float* state_hgrn = (const float*)d_in[4]; const float* state_ssm = (const float*)d_in[5];
    const float* c_s = (const float*)d_in[6]; const float* c_ctx = (const float*)d_in[7];
    const float* ada_w = (const float*)d_in[8]; const float* ada_b = (const float*)d_in[9];
    const float* norm1_g = (const float*)d_in[10]; const float* norm2_g = (const float*)d_in[11];
    const float* wqkv = (const float*)d_in[12]; const float* wo = (const float*)d_in[13]; const float* sink = (const float*)d_in[14];
    const float* hwin = (const float*)d_in[15]; const float* hlb = (const float*)d_in[16]; const float* hgn = (const float*)d_in[17]; const float* hwo = (const float*)d_in[18];
    const float* sa_re = (const float*)d_in[19]; const float* sa_im = (const float*)d_in[20]; const float* sdt = (const float*)d_in[21];
    const float* sb_re = (const float*)d_in[22]; const float* sb_im = (const float*)d_in[23]; const float* sc_re = (const float*)d_in[24]; const float* sc_im = (const float*)d_in[25];
    const float* sd = (const float*)d_in[26]; const float* wglu = (const float*)d_in[27];
    const float* wup = (const float*)d_in[28]; const float* cw = (const float*)d_in[29]; const float* cb = (const float*)d_in[30]; const float* wdown = (const float*)d_in[31];
    const float* final_g = (const float*)d_in[32];
    float* y = out; float* outK = out + 8388608; float* outV = outK + 2097152; float* outH = outV + 2097152; float* outS = outH + 4194304;
    Bufs b = carve(d_ws);
    (void)hipMemcpyAsync(b.x, x_prompt, (size_t)MP * D * 4, hipMemcpyDeviceToDevice, st);
    (void)hipMemcpyAsync(b.x + (size_t)MP * D, x_sample, (size_t)MP * D * 4, hipMemcpyDeviceToDevice, st);
    k_ada<<<dim3(24, 4), 256, 0, st>>>(c_s, c_ctx, ada_w, ada_b, b.mod);
    k_lb<<<8, 256, 0, st>>>(hlb, b.lb1);
    for (int l = 0; l < 4; ++l) {
        const int kind = l % 3, j = l / 3; const float* modl = b.mod + (size_t)l * 5 * 6144;
        k_normmod<<<M, 256, 0, st>>>(b.x, norm1_g + l * D, modl, 0, b.xn);
        if (kind == 0) {
            k_gemm<<<dim3(1536 / 128, M / 128), 256, 0, st>>>(b.xn, wqkv + (size_t)j * 1024 * 1536, b.raw, M, 1536, 1024);
            k_qkv_post<<<(M * 1536) / 256, 256, 0, st>>>(b.raw, b.q, b.k, b.v, outK, outV, j);
            k_attn<<<dim3(M / 64, 16), 64, 0, st>>>(b.q, b.k, b.v, cache_k, cache_v, sink, b.o, j);
            k_gemm<<<dim3(1024 / 128, M / 128), 256, 0, st>>>(b.o, wo + (size_t)j * 1024 * 1024, b.raw, M, 1024, 1024);
            k_res<<<(M * D) / 256, 256, 0, st>>>(b.x, b.raw, modl, 2);
        } else if (kind == 1) {
            k_gemm<<<dim3(5120 / 128, M / 128), 256, 0, st>>>(b.xn, hwin, b.raw, M, 5120, 1024);
            k_hgrn<<<20 * 8 * 2, 128, 0, st>>>(b.raw, b.lb1, state_hgrn, b.odir, outH);
            k_hgrn_post<<<M * 8, 128, 0, st>>>(b.odir, b.raw, hgn, b.a);
            k_gemm<<<dim3(1024 / 128, M / 128), 256, 0, st>>>(b.a, hwo, b.raw, M, 1024, 1024);
            k_res<<<(M * D) / 256, 256, 0, st>>>(b.x, b.raw, modl, 2);
        } else {
            k_ssm<<<20 * 2 * 64, 64, 0, st>>>(b.xn, sa_re, sa_im, sdt, sb_re, sb_im, sc_re, sc_im, state_ssm, b.odir, outS);
            k_ssm_post<<<(M * D) / 256, 256, 0, st>>>(b.xn, b.odir, sd, b.a);
            k_gemm<<<dim3(2048 / 128, M / 128), 256, 0, st>>>(b.a, wglu, b.raw, M, 2048, 1024);
            k_glu_res<<<(M * D) / 256, 256, 0, st>>>(b.x, b.raw, modl, 2);
        }
        k_normmod<<<M, 256, 0, st>>>(b.x, norm2_g + l * D, modl, 3, b.xn);
        k_gemm<<<dim3(5632 / 128, M / 128), 256, 0, st>>>(b.xn, wup + (size_t)l * 1024 * 5632, b.raw, M, 5632, 1024);
        k_conv_act<<<(M * DFF) / 256, 256, 0, st>>>(b.raw, cw + (size_t)l * 3 * 5632, cb + (size_t)l * 5632, b.act);
        k_gemm<<<dim3(1024 / 128, M / 128), 256, 0, st>>>(b.act, wdown + (size_t)l * DFF * 1024, b.raw, M, 1024, DFF);
        k_res<<<(M * D) / 256, 256, 0, st>>>(b.x, b.raw, modl, 5);
    }
    k_final<<<M, 256, 0, st>>>(b.x, final_g, y);
}
}
extern "C" void kernel_launch(void* const* d_in, const int* in_sizes, int n_in, void* d_out, int out_size, void* d_ws, size_t ws_size, hipStream_t stream) {
    if (n_in != 33 || out_size != 17039360 || ws_size < (size_t)340 * 1024 * 1024) { fprintf(stderr, "kernel_launch: unexpected sizes n_in %d out %d ws %zu\n", n_in, out_size, ws_size); return; }
    refp::run(d_in, (float*)d_out, d_ws, stream);
}
```

```cpp
#include <hip/hip_runtime.h>
#include <hip/hip_cooperative_groups.h>
#include <cstdio>
#include <cstdint>
#include <cmath>
#define LAS __attribute__((address_space(3)))
#define GAS __attribute__((address_space(1)))
typedef unsigned short bf16_t;
typedef short bf16x8 __attribute__((ext_vector_type(8)));
typedef short s16x4 __attribute__((ext_vector_type(4)));
typedef float f32x2 __attribute__((ext_vector_type(2)));
typedef float f32x4 __attribute__((ext_vector_type(4)));
typedef float f32x16 __attribute__((ext_vector_type(16)));
typedef unsigned u32x2 __attribute__((ext_vector_type(2)));
typedef unsigned u32x4 __attribute__((ext_vector_type(4)));
typedef __bf16 bf16x2_t __attribute__((ext_vector_type(2)));

namespace om {
constexpr int D = 1024, MP = 4096, M = 8192, DFF = 2816, NUP = 5632, NQKV = 1536, NHIN = 5120;
constexpr float EPS = 1e-6f, LOG2E = 1.4426950408889634f, QSCALE = 0.125f * 1.4426950408889634f;
constexpr int NTHREADS = 512, NWAVES = 8, LDS_BYTES = 147456, RING_BYTES = 131072;
constexpr int SW_STRIDE = 5632;
constexpr size_t MiB = 1u << 20;
constexpr size_t WS_CTL = 0, CTL_ZERO_BYTES = 64 * 1024;
constexpr size_t WS_MODP = 1 * MiB, WS_MOD = 3 * MiB, WS_SW = 4 * MiB, WS_GMOD = 5 * MiB, WS_SS = 6 * MiB, WS_ROPE = 7 * MiB;
constexpr size_t WS_LB1 = 8 * MiB, WS_SLAM = 8 * MiB + 64 * 1024, WS_SBB = 8 * MiB + 512 * 1024, WS_SCB = 9 * MiB;
constexpr size_t WS_CTXK = 10 * MiB, WS_CTXV = 12 * MiB;
constexpr size_t WS_NAIVE_MOD = 14 * MiB;
constexpr size_t WS_WQKV = 16 * MiB, WS_WO = 22 * MiB, WS_HWIN = 26 * MiB, WS_HWO = 36 * MiB, WS_GLU = 38 * MiB, WS_UP = 42 * MiB, WS_DOWN = 86 * MiB;
constexpr size_t WS_X = 108 * MiB, WS_R = 140 * MiB;
constexpr size_t WS_AP = WS_R, WS_ACT = WS_R + 16 * MiB, WS_SCR = WS_R + 60 * MiB, WS_END = WS_SCR + 176 * MiB;

constexpr size_t SCR_Q = WS_SCR, SCR_KB = WS_SCR + 16 * MiB, SCR_VB = WS_SCR + 20 * MiB, SCR_O = WS_SCR + 24 * MiB;
constexpr size_t SCR_HQ = WS_SCR, SCR_HV = WS_SCR + 16 * MiB, SCR_HG = WS_SCR + 32 * MiB, SCR_LFF = WS_SCR + 48 * MiB, SCR_LFB = WS_SCR + 80 * MiB, SCR_OF = WS_SCR + 112 * MiB, SCR_OB = WS_SCR + 144 * MiB, SCR_AWO = WS_SCR;
constexpr size_t SCR_YF = WS_SCR, SCR_YB = WS_SCR + 32 * MiB, SCR_AGLU = WS_SCR + 64 * MiB;

__device__ __forceinline__ int cond_of_tile(int pm) { return pm < 16 ? 0 : 1 + ((pm - 16) >> 2); }
__device__ __forceinline__ int cond_of_row(int r) { return r < MP ? 0 : 1 + ((r - MP) >> 10); }
__device__ __forceinline__ unsigned cvtpk(float lo, float hi) { f32x2 v = {lo, hi}; bf16x2_t b = __builtin_convertvector(v, bf16x2_t); return __builtin_bit_cast(unsigned, b); }
__device__ __forceinline__ float bf2f(unsigned short h) { return __uint_as_float(((unsigned)h) << 16); }
__device__ __forceinline__ float bflo(unsigned w) { return __uint_as_float(w << 16); }
__device__ __forceinline__ float bfhi(unsigned w) { return __uint_as_float(w & 0xffff0000u); }
__device__ __forceinline__ float sigm(float x) { return 1.f / (1.f + __expf(-x)); }
__device__ __forceinline__ float wave_sum(float v) {
#pragma unroll
    for (int o = 1; o < 64; o <<= 1) v += __shfl_xor(v, o);
    return v;
}

struct Ctx {
    const float* in[33]; float* out; unsigned char* ws;
    LAS unsigned char* lds; int tid, lane, wave, G, bid;
    __device__ __forceinline__ float* f(size_t off) const { return (float*)(ws + off); }
    __device__ __forceinline__ bf16_t* h(size_t off) const { return (bf16_t*)(ws + off); }
};

namespace pg8 {
constexpr int BM = 256, BK = 64, HALF = 128, HTB = HALF * BK * 2, STAGE_BYTES = 8 * HTB, NXCD = 8, WGM = 8;
__host__ __device__ __forceinline__ int lds_byte(int r, int c) { const int st = (r >> 4) * 2 + (c >> 5), rr = r & 15, cc = c & 31, ob = rr * 64 + cc * 2; return st * 1024 + (ob ^ (((ob >> 9) & 1) << 5)); }
__host__ __device__ __forceinline__ void stage_rc(int b, int& R, int& C) { const int st = b / 1024, sb = b % 1024, swz = sb ^ (((sb >> 9) & 1) << 5); R = (st >> 1) * 16 + swz / 64; C = (st & 1) * 32 + (swz % 64) / 2; }
struct Unit { int pm, pn; };
struct Gemm { const bf16_t* A; const bf16_t* Bt; int K; int b_tile_rows, b_half_rows; };
struct StaticOrder {
    int nM, nN, nwg, G, c;
    __device__ void init(int nM_, int nN_, int G_, int c_) { nM = nM_; nN = nN_; nwg = nM * nN; G = G_; c = c_; }
    __device__ bool next(int i, Unit& u) const {
        const long L = (long)i * G + c; if (L >= nwg) return false;
        int wgid = (int)L; { const int q = nwg / NXCD, r = nwg % NXCD, xcd = wgid % NXCD, off = wgid / NXCD; wgid = (xcd < r ? xcd * (q + 1) : r * (q + 1) + (xcd - r) * q) + off; }
        const int nig = WGM * nN, gid = wgid / nig, fm = gid * WGM, gsz = (nM - fm) < WGM ? (nM - fm) : WGM;
        u.pm = fm + ((wgid % nig) % gsz); u.pn = (wgid % nig) / gsz; return true;
    }
};
template <class Epi>
__device__ __forceinline__ void gemm_phase(LAS unsigned char* lds, const Gemm g, const StaticOrder& S, const Epi& E) {
    int tid_ = threadIdx.x; asm volatile("" : "+v"(tid_));
    const int tid = tid_, wid = __builtin_amdgcn_readfirstlane(tid >> 6), lane = tid & 63, wr = wid >> 2, wc = wid & 3, fr = lane & 15, fq = lane >> 4;
    const int K = g.K, nt = K / BK;
    unsigned voffA[2];
#pragma unroll
    for (int i = 0; i < 2; ++i) { int R, C; stage_rc(tid * 16 + i * 8192, R, C); voffA[i] = (unsigned)(R * K + C) * 2u; }
    const size_t kstep = (size_t)(BK * 2);
    const size_t hstepA = (size_t)HALF * K * 2, tstepA = 2 * hstepA;
    const size_t hstepB = (size_t)g.b_half_rows * K * 2, tstepB = (size_t)g.b_tile_rows * K * 2;
    const unsigned ldsw = (unsigned)wid * 1024u;
    const int aoff = lds_byte(wr * 64 + fr, fq * 8), boff = lds_byte(wc * 32 + fr, fq * 8);
#define PG8_SA(b, h) (((b) * 2 + (h)) * HTB)
#define PG8_SB(b, h) ((4 + (b) * 2 + (h)) * HTB)
#define PG8_STAGE(bufoff, gbase) do { _Pragma("unroll") for (int _i = 0; _i < 2; ++_i) \
        __builtin_amdgcn_global_load_lds((const unsigned*)((const char*)(gbase) + voffA[_i]), (LAS unsigned*)(lds + (bufoff) + ldsw + _i * 8192), 16, 0, 0); } while (0)
#define PG8_LDA(dst, b, h) do { _Pragma("unroll") for (int m = 0; m < 4; ++m) _Pragma("unroll") for (int k = 0; k < 2; ++k) dst[m][k] = *(const LAS bf16x8*)(lds + PG8_SA(b, h) + aoff + m * 2048 + k * 1024); } while (0)
#define PG8_LDB(dst, b, h) do { _Pragma("unroll") for (int n = 0; n < 2; ++n) _Pragma("unroll") for (int k = 0; k < 2; ++k) dst[n][k] = *(const LAS bf16x8*)(lds + PG8_SB(b, h) + boff + n * 2048 + k * 1024); } while (0)
#define PG8_MMA(ai, bj, At, Bt) do { __builtin_amdgcn_s_setprio(1); _Pragma("unroll") for (int m = 0; m < 4; ++m) _Pragma("unroll") for (int n = 0; n < 2; ++n) _Pragma("unroll") for (int k = 0; k < 2; ++k) \
        acc[ai][bj][m][n] = __builtin_amdgcn_mfma_f32_16x16x32_bf16(Bt[n][k], At[m][k], acc[ai][bj][m][n], 0, 0, 0); __builtin_amdgcn_s_setprio(0); } while (0)
#define PG8_WAIT_V(n) asm volatile("s_waitcnt vmcnt(" #n ")" ::: "memory")
#define PG8_WAIT_L(n) asm volatile("s_waitcnt lgkmcnt(" #n ")" ::: "memory")
#define PG8_BAR __builtin_amdgcn_s_barrier()
#define PG8_SCHED __builtin_amdgcn_sched_barrier(0)
    Unit cur, nxt; int ui = 0;
    if (!S.next(0, cur)) return;
    f32x4 acc[2][2][4][2];
#pragma unroll
    for (int a = 0; a < 2; ++a)
#pragma unroll
        for (int b = 0; b < 2; ++b)
#pragma unroll
            for (int m = 0; m < 4; ++m)
#pragma unroll
                for (int n = 0; n < 2; ++n) acc[a][b][m][n] = (f32x4){0.f, 0.f, 0.f, 0.f};
    bf16x8 At[4][2], B0[2][2], B1[2][2];
    const char* cA = (const char*)g.A + (size_t)cur.pm * tstepA; const char* cB = (const char*)g.Bt + (size_t)cur.pn * tstepB;
    PG8_STAGE(PG8_SB(0, 0), cB); PG8_STAGE(PG8_SB(0, 1), cB + hstepB); PG8_STAGE(PG8_SA(0, 0), cA); PG8_STAGE(PG8_SA(0, 1), cA + hstepA);
    if (wr == 1) PG8_BAR;
    PG8_WAIT_V(2); PG8_BAR;
    PG8_STAGE(PG8_SB(1, 0), cB + kstep); PG8_STAGE(PG8_SA(1, 0), cA + kstep); PG8_STAGE(PG8_SB(1, 1), cB + hstepB + kstep);
    PG8_WAIT_V(6); PG8_BAR;
    for (;;) {
        const bool has_next = S.next(ui + 1, nxt);
        const char* nA = has_next ? (const char*)g.A + (size_t)nxt.pm * tstepA : cA; const char* nB = has_next ? (const char*)g.Bt + (size_t)nxt.pn * tstepB : cB;
        for (int t = 0; t < nt; t += 2) {
            const bool last = (t == nt - 2);
            const char* a1 = cA + (size_t)(t + 1) * kstep;
            const char* a2 = last ? nA : cA + (size_t)(t + 2) * kstep; const char* b2 = last ? nB : cB + (size_t)(t + 2) * kstep;
            const char* a3 = a2 + kstep; const char* b3 = b2 + kstep;
            PG8_LDB(B0, 0, 0); PG8_LDB(B1, 0, 1); PG8_SCHED; PG8_LDA(At, 0, 0); PG8_STAGE(PG8_SA(1, 1), a1 + hstepA);
            PG8_WAIT_V(8); PG8_WAIT_L(0); PG8_BAR; PG8_MMA(0, 0, At, B0); PG8_MMA(0, 1, At, B1); PG8_BAR; PG8_SCHED;
            PG8_LDA(At, 0, 1); PG8_STAGE(PG8_SB(0, 0), b2); PG8_STAGE(PG8_SB(0, 1), b2 + hstepB); PG8_STAGE(PG8_SA(0, 0), a2);
            PG8_WAIT_V(8); PG8_WAIT_L(0); PG8_BAR; PG8_MMA(1, 0, At, B0); PG8_MMA(1, 1, At, B1); PG8_BAR; PG8_SCHED;
            PG8_LDB(B0, 1, 0); PG8_LDB(B1, 1, 1); PG8_SCHED; PG8_LDA(At, 1, 0); PG8_STAGE(PG8_SA(0, 1), a2 + hstepA);
            PG8_WAIT_V(8); PG8_WAIT_L(0); PG8_BAR; PG8_MMA(0, 0, At, B0); PG8_MMA(0, 1, At, B1); PG8_BAR; PG8_SCHED;
            PG8_LDA(At, 1, 1); PG8_STAGE(PG8_SB(1, 0), b3); PG8_STAGE(PG8_SB(1, 1), b3 + hstepB); PG8_STAGE(PG8_SA(1, 0), a3);
            PG8_WAIT_V(8); PG8_WAIT_L(0); PG8_BAR; PG8_MMA(1, 0, At, B0); PG8_MMA(1, 1, At, B1); PG8_BAR; PG8_SCHED;
        }
        if (wr == 0) PG8_BAR;
        E(acc, cur, wr, wc, fr, fq);
        if (!has_next) break;
#pragma unroll
        for (int a = 0; a < 2; ++a)
#pragma unroll
            for (int b = 0; b < 2; ++b)
#pragma unroll
                for (int m = 0; m < 4; ++m)
#pragma unroll
                    for (int n = 0; n < 2; ++n) acc[a][b][m][n] = (f32x4){0.f, 0.f, 0.f, 0.f};
        cur = nxt; cA = nA; cB = nB; ++ui;
        if (wr == 1) PG8_BAR;
    }
    PG8_WAIT_V(0);
    PG8_BAR;
#undef PG8_SA
#undef PG8_SB
#undef PG8_STAGE
#undef PG8_LDA
#undef PG8_LDB
#undef PG8_MMA
#undef PG8_WAIT_V
#undef PG8_WAIT_L
#undef PG8_BAR
#undef PG8_SCHED
}
}
using pg8::Unit;
typedef f32x4 Acc[2][2][4][2];

__device__ __forceinline__ void st_bf16x4(bf16_t* p, f32x4 v) { u32x2 w; w.x = cvtpk(v[0], v[1]); w.y = cvtpk(v[2], v[3]); *(u32x2*)p = w; }

template <bool PAIRED> struct EpiRes {
    const float* xin; float* xout; bf16_t* ap; float* ssn; const float* gate;   const float* gmodn;
    __device__ __forceinline__ void operator()(const Acc& acc, const Unit& u, int wr, int wc, int fr, int fq) const {
        const int c = cond_of_tile(u.pm);
        const int colb = (PAIRED ? u.pn * 128 : u.pn * 256) + wc * 32 + 4 * fq;
        constexpr int NBJ = PAIRED ? 1 : 2;
        f32x4 gv[NBJ][2], gm[NBJ][2];
#pragma unroll
        for (int bj = 0; bj < NBJ; ++bj)
#pragma unroll
            for (int n = 0; n < 2; ++n) { gv[bj][n] = *(const f32x4*)(gate + (size_t)c * 6144 + colb + bj * 128 + n * 16);
                gm[bj][n] = gmodn ? *(const f32x4*)(gmodn + (size_t)c * 1024 + colb + bj * 128 + n * 16) : (f32x4){0.f, 0.f, 0.f, 0.f}; }
#pragma unroll
        for (int ai = 0; ai < 2; ++ai)
#pragma unroll
            for (int m = 0; m < 4; ++m) {
                const int r = u.pm * 256 + ai * 128 + wr * 64 + m * 16 + fr; float sq = 0.f;
#pragma unroll
                for (int bj = 0; bj < NBJ; ++bj)
#pragma unroll
                    for (int n = 0; n < 2; ++n) {
                        f32x4 o = acc[ai][bj][m][n];
                        if (PAIRED) { const f32x4 gt = acc[ai][1][m][n];
#pragma unroll
                            for (int e = 0; e < 4; ++e) o[e] = o[e] * sigm(gt[e]); }
                        const size_t off = (size_t)r * D + colb + bj * 128 + n * 16;
                        const f32x4 xo = *(const f32x4*)(xin + off) + gv[bj][n] * o;
                        *(f32x4*)(xout + off) = xo;
                        sq += (xo[0] * xo[0] + xo[1] * xo[1]) + (xo[2] * xo[2] + xo[3] * xo[3]);
                        if (gmodn) st_bf16x4(ap + off, xo * gm[bj][n]);
                    }
                sq += __shfl_xor(sq, 16); sq += __shfl_xor(sq, 32);
                if (fq == 0) atomicAdd(ssn + r, sq);
            }
    }
};
struct EpiUpRaw {
    const float* ss; const float* sw;   bf16_t* hraw;
    __device__ __forceinline__ void operator()(const Acc& acc, const Unit& u, int wr, int wc, int fr, int fq) const {
        const int c = cond_of_tile(u.pm); const int colb = u.pn * 256 + wc * 32 + 4 * fq;
        f32x4 sv[2][2];
#pragma unroll
        for (int bj = 0; bj < 2; ++bj)
#pragma unroll
            for (int n = 0; n < 2; ++n) sv[bj][n] = *(const f32x4*)(sw + (size_t)c * SW_STRIDE + colb + bj * 128 + n * 16);
#pragma unroll
        for (int ai = 0; ai < 2; ++ai)
#pragma unroll
            for (int m = 0; m < 4; ++m) {
                const int r = u.pm * 256 + ai * 128 + wr * 64 + m * 16 + fr; const float rs = rsqrtf(ss[r] * (1.f / D) + EPS);
#pragma unroll
                for (int bj = 0; bj < 2; ++bj)
#pragma unroll
                    for (int n = 0; n < 2; ++n) st_bf16x4(hraw + (size_t)r * NUP + colb + bj * 128 + n * 16, acc[ai][bj][m][n] * rs + sv[bj][n]);
            }
    }
};
struct EpiQKV {
    const float* ss; const float* sw; bf16_t *Q, *KB, *VB; float *outK, *outV; const float *ropec, *ropes; int j;
    __device__ __forceinline__ void operator()(const Acc& acc, const Unit& u, int wr, int wc, int fr, int fq) const {
        const int c = cond_of_tile(u.pm); const bool samp = u.pm >= 16; const int colt = u.pn * 256, cl0 = wc * 32 + 4 * fq;
        f32x4 sv[2][2];
#pragma unroll
        for (int bj = 0; bj < 2; ++bj)
#pragma unroll
            for (int n = 0; n < 2; ++n) sv[bj][n] = *(const f32x4*)(sw + (size_t)c * SW_STRIDE + colt + cl0 + bj * 128 + n * 16);
#pragma unroll
        for (int ai = 0; ai < 2; ++ai)
#pragma unroll
            for (int m = 0; m < 4; ++m) {
                const int r = u.pm * 256 + ai * 128 + wr * 64 + m * 16 + fr; const float rs = rsqrtf(ss[r] * (1.f / D) + EPS);
                f32x4 cs = {1.f, 1.f, 1.f, 1.f}, sn = {0.f, 0.f, 0.f, 0.f};
                if (samp && u.pn < 5) { const int t = (r - MP) & 1023, idx = t * 32 + (wc & 1) * 16 + 4 * fq; cs = *(const f32x4*)(ropec + idx); sn = *(const f32x4*)(ropes + idx); }
#pragma unroll
                for (int bj = 0; bj < 2; ++bj) {
                    f32x4 v0 = acc[ai][bj][m][0] * rs + sv[bj][0], v1 = acc[ai][bj][m][1] * rs + sv[bj][1];
                    if (u.pn < 5) { const f32x4 o0 = v0 * cs - v1 * sn, o1 = v1 * cs + v0 * sn; v0 = o0; v1 = o1; }
                    const int cl = bj * 128 + cl0;
                    if (u.pn < 4) { st_bf16x4(Q + (size_t)r * D + colt + cl, v0 * QSCALE); st_bf16x4(Q + (size_t)r * D + colt + cl + 16, v1 * QSCALE); }
                    else {
                        bf16_t* dst = (u.pn == 4 ? KB : VB) + (size_t)r * 256 + cl; st_bf16x4(dst, v0); st_bf16x4(dst + 16, v1);
                        if (!samp) { float* o = (u.pn == 4 ? outK : outV) + (((size_t)(r >> 8) * 2 + j) * 256 + (r & 255)) * 256 + cl; *(f32x4*)o = v0; *(f32x4*)(o + 16) = v1; }
                    }
                }
            }
    }
};
struct EpiHin {
    const float* ss; const float* sw; const float* lb1; bf16_t *HQ, *HV, *HG; float *LFF, *LFB;
    __device__ __forceinline__ void operator()(const Acc& acc, const Unit& u, int wr, int wc, int fr, int fq) const {
        const int c = cond_of_tile(u.pm); const int seg = u.pn >> 2, colt = u.pn * 256, cl0 = wc * 32 + 4 * fq, cs0 = (u.pn & 3) * 256 + cl0;
        f32x4 sv[2][2], lbv[2][2];
#pragma unroll
        for (int bj = 0; bj < 2; ++bj)
#pragma unroll
            for (int n = 0; n < 2; ++n) { sv[bj][n] = *(const f32x4*)(sw + (size_t)c * SW_STRIDE + colt + cl0 + bj * 128 + n * 16);
                lbv[bj][n] = (seg == 2 || seg == 3) ? *(const f32x4*)(lb1 + (seg - 2) * 1024 + cs0 + bj * 128 + n * 16) : (f32x4){0.f, 0.f, 0.f, 0.f}; }
#pragma unroll
        for (int ai = 0; ai < 2; ++ai)
#pragma unroll
            for (int m = 0; m < 4; ++m) {
                const int r = u.pm * 256 + ai * 128 + wr * 64 + m * 16 + fr; const float rs = rsqrtf(ss[r] * (1.f / D) + EPS);
#pragma unroll
                for (int bj = 0; bj < 2; ++bj)
#pragma unroll
                    for (int n = 0; n < 2; ++n) {
                        f32x4 v = acc[ai][bj][m][n] * rs + sv[bj][n]; const size_t off = (size_t)r * D + cs0 + bj * 128 + n * 16;
                        if (seg == 0) st_bf16x4(HQ + off, v);
                        else if (seg == 1) st_bf16x4(HV + off, v);
                        else if (seg == 4) {
#pragma unroll
                            for (int e = 0; e < 4; ++e) v[e] = v[e] * sigm(v[e]);
                            st_bf16x4(HG + off, v); }
                        else { const f32x4 lb = lbv[bj][n];
#pragma unroll
                            for (int e = 0; e < 4; ++e) v[e] = __logf(lb[e] + (1.f - lb[e]) * sigm(v[e]));
                            *(f32x4*)((seg == 2 ? LFF : LFB) + off) = v; }
                    }
            }
    }
};
enum { EK_RES = 0, EK_RES_GLU, EK_UPRAW, EK_QKV, EK_HIN };
struct EpiAny {
    int kind, j;
    const float *ss, *sw, *lb1, *xin, *gate, *gmodn, *ropec, *ropes; float *xout, *ssn, *f0, *f1; bf16_t *b0, *b1, *b2, *ap;
    __device__ __forceinline__ void operator()(const Acc& acc, const Unit& u, int wr, int wc, int fr, int fq) const {
#ifndef EK_MASK
#define EK_MASK 31
#endif
        if (!((EK_MASK >> kind) & 1)) return;
        switch (kind) {
        case EK_RES: { EpiRes<false> E{xin, xout, ap, ssn, gate, gmodn}; E(acc, u, wr, wc, fr, fq); } break;
        case EK_RES_GLU: { EpiRes<true> E{xin, xout, ap, ssn, gate, gmodn}; E(acc, u, wr, wc, fr, fq); } break;
        case EK_UPRAW: { EpiUpRaw E{ss, sw, b0}; E(acc, u, wr, wc, fr, fq); } break;
        case EK_QKV: { EpiQKV E{ss, sw, b0, b1, b2, f0, f1, ropec, ropes, j}; E(acc, u, wr, wc, fr, fq); } break;
        default: { EpiHin E{ss, sw, lb1, b0, b1, b2, f0, f1}; E(acc, u, wr, wc, fr, fq); } break;
        }
    }
};
}
namespace om {
#define LDS_WAIT() asm volatile("s_waitcnt lgkmcnt(0)" ::: "memory")
__device__ __forceinline__ void transpose_item(const float* W, int K, int N, bf16_t* WT, LAS float* scr, int item, int lane) {
    const int nblk = N / 32, kb = item / nblk, nb = item % nblk, k0 = 64 * kb, n0 = 32 * nb;
#pragma unroll 8
    for (int i = 0; i < 32; ++i) { const int kk = 2 * i + (lane >> 5); scr[kk * 33 + (lane & 31)] = W[(size_t)(k0 + kk) * N + n0 + (lane & 31)]; }
    LDS_WAIT(); asm volatile("" ::: "memory");
    const int c = lane & 7;
#pragma unroll
    for (int j = 0; j < 4; ++j) { const int n = (lane >> 3) + 8 * j; const LAS float* s = scr + (8 * c) * 33 + n;
        u32x4 o; o.x = cvtpk(s[0 * 33], s[1 * 33]); o.y = cvtpk(s[2 * 33], s[3 * 33]); o.z = cvtpk(s[4 * 33], s[5 * 33]); o.w = cvtpk(s[6 * 33], s[7 * 33]);
        *(u32x4*)(WT + (size_t)(n0 + n) * K + k0 + 8 * c) = o; }
    LDS_WAIT(); asm volatile("" ::: "memory");
}
__device__ __forceinline__ float modsum(const Ctx& C, int l, int c, int idx) {
    const float* mp = C.f(WS_MODP) + ((size_t)l * 5 + c) * 6144 + idx; float s = C.in[9][l * 6144 + idx];
#pragma unroll
    for (int kp = 0; kp < 4; ++kp) s += mp[(size_t)kp * 4 * 5 * 6144];
    return s;
}
__device__ __forceinline__ void phase_p0a(const Ctx& C) {
    const int gw = C.bid * NWAVES + C.wave, NGW = C.G * NWAVES, gt = C.bid * NTHREADS + C.tid, NGT = C.G * NTHREADS;
    LAS float* scr = (LAS float*)(C.lds + C.wave * 16384);
#define DO_MAT(src, dst, K, N) for (int it = gw; it < ((K) / 64) * ((N) / 32); it += NGW) transpose_item((src), (K), (N), (dst), scr, it, C.lane)
    for (int j = 0; j < 2; ++j) { DO_MAT(C.in[12] + (size_t)j * D * NQKV, C.h(WS_WQKV) + (size_t)j * NQKV * D, D, NQKV); DO_MAT(C.in[13] + (size_t)j * D * D, C.h(WS_WO) + (size_t)j * D * D, D, D); }
    DO_MAT(C.in[15], C.h(WS_HWIN), D, NHIN); DO_MAT(C.in[18], C.h(WS_HWO), D, D); DO_MAT(C.in[27], C.h(WS_GLU), D, 2048);
    for (int l = 0; l < 4; ++l) { DO_MAT(C.in[28] + (size_t)l * D * NUP, C.h(WS_UP) + (size_t)l * NUP * D, D, NUP); DO_MAT(C.in[31] + (size_t)l * DFF * D, C.h(WS_DOWN) + (size_t)l * D * DFF, DFF, D); }
#undef DO_MAT
    __syncthreads();
    LAS float* sS = (LAS float*)(C.lds + RING_BYTES);
    LAS float* red = (LAS float*)(C.lds);
    for (int it = C.bid; it < 384; it += C.G) {
        const int l = it / 96, cb = (it % 96) >> 2, kp = it & 3;
        for (int i = C.tid; i < 5 * 256; i += NTHREADS) { const int c = i >> 8, k = kp * 256 + (i & 255); const float v = c == 0 ? C.in[7][k] : C.in[6][(c - 1) * 1024 + k]; sS[i] = v / (1.f + __expf(-v)); }
        __syncthreads();
        f32x4 a[5];
#pragma unroll
        for (int c = 0; c < 5; ++c) a[c] = (f32x4){0.f, 0.f, 0.f, 0.f};
        const float* wp = C.in[8] + ((size_t)l * 1024 + kp * 256 + C.wave * 32) * 6144 + cb * 256 + 4 * C.lane;
#pragma unroll 4
        for (int k = 0; k < 32; ++k) { const f32x4 w = *(const f32x4*)(wp + (size_t)k * 6144);
#pragma unroll
            for (int c = 0; c < 5; ++c) a[c] += w * sS[c * 256 + C.wave * 32 + k]; }
#pragma unroll
        for (int c = 0; c < 5; ++c) *(LAS f32x4*)(red + (C.wave * 5 + c) * 256 + 4 * C.lane) = a[c];
        __syncthreads();
        for (int i = C.tid; i < 5 * 256; i += NTHREADS) { float s = 0.f;
#pragma unroll
            for (int w = 0; w < 8; ++w) s += red[w * 1280 + i];
            C.f(WS_MODP)[(((size_t)kp * 4 + l) * 5 + (i >> 8)) * 6144 + cb * 256 + (i & 255)] = s; }
        __syncthreads();
    }
    for (int i = gt; i < 9 * M; i += NGT) C.f(WS_SS)[i] = 0.f;
    for (int i = gt; i < 1024 * 32; i += NGT) { const int t = i >> 5, e = i & 31, fi = e & 15; const float pos = (e >> 4) == 0 ? (float)(t >> 6) : (float)(t & 63);
        const float ang = pos * (1.0f / powf(10000.0f, (float)(2 * fi) / 32.0f)); C.f(WS_ROPE)[i] = cosf(ang); C.f(WS_ROPE)[32768 + i] = sinf(ang); }
    for (int i = gt; i < 2 * 131072; i += NGT) { const int which = i >> 17, e = (i & 131071) * 8; const float* s = (which ? C.in[3] : C.in[2]) + e; const f32x4 a = *(const f32x4*)s, b = *(const f32x4*)(s + 4);
        u32x4 o; o.x = cvtpk(a[0], a[1]); o.y = cvtpk(a[2], a[3]); o.z = cvtpk(b[0], b[1]); o.w = cvtpk(b[2], b[3]); *(u32x4*)(C.h(which ? WS_CTXV : WS_CTXK) + e) = o; }
    for (int i = gt; i < 2048; i += NGT) { float v[4], mx = -1e30f;
#pragma unroll
        for (int l = 0; l < 4; ++l) { v[l] = C.in[16][l * 2048 + i]; mx = fmaxf(mx, v[l]); }
        float s = 0.f;
#pragma unroll
        for (int l = 0; l < 4; ++l) { v[l] = expf(v[l] - mx); s += v[l]; }
        C.f(WS_LB1)[i] = v[1] / s; }
    for (int i = gt; i < 8192; i += NGT) {
        const int dg = i >> 6, p = i & 63;
        const float ar = fminf(C.in[19][i], -1e-4f), ai = C.in[20][i], dt = expf(C.in[21][dg]);
        const float e = expf(ar * dt), lr = e * cosf(ai * dt), li = e * sinf(ai * dt);
        const float den = ar * ar + ai * ai, fr = ((lr - 1.f) * ar + li * ai) / den, fi = (li * ar - (lr - 1.f) * ai) / den;
        C.f(WS_SLAM)[2 * i] = lr; C.f(WS_SLAM)[2 * i + 1] = li;
        unsigned wr_[8], wi_[8];
#pragma unroll
        for (int q = 0; q < 8; ++q) { const float x0 = C.in[22][(size_t)i * 16 + 2 * q], y0 = C.in[23][(size_t)i * 16 + 2 * q], x1 = C.in[22][(size_t)i * 16 + 2 * q + 1], y1 = C.in[23][(size_t)i * 16 + 2 * q + 1];
            wr_[q] = cvtpk(fr * x0 - fi * y0, fr * x1 - fi * y1); wi_[q] = cvtpk(fr * y0 + fi * x0, fr * y1 + fi * x1); }
        bf16_t* bb = C.h(WS_SBB) + ((size_t)dg * 128 + p) * 16;
        *(u32x4*)bb = (u32x4){wr_[0], wr_[1], wr_[2], wr_[3]}; *(u32x4*)(bb + 8) = (u32x4){wr_[4], wr_[5], wr_[6], wr_[7]};
        *(u32x4*)(bb + 64 * 16) = (u32x4){wi_[0], wi_[1], wi_[2], wi_[3]}; *(u32x4*)(bb + 64 * 16 + 8) = (u32x4){wi_[4], wi_[5], wi_[6], wi_[7]};
    }
    for (int i = gt; i < 2 * 64 * 16 * 64; i += NGT) {
        const int p = i & 63, row = i >> 6; bf16_t* cb = C.h(WS_SCB) + (size_t)row * 128;
        cb[p] = (bf16_t)(cvtpk(C.in[24][i], 0.f) & 0xffffu); cb[64 + p] = (bf16_t)(cvtpk(-C.in[25][i], 0.f) & 0xffffu); }
}
__device__ __forceinline__ void rows_ap_ss(const Ctx& C, const float* xsrc_p, const float* xsrc_s, float* xcopy, int l, int s, bool from_table, float* ssdst) {
    for (int gw = C.bid * NWAVES + C.wave; gw < M / 4; gw += C.G * NWAVES) {
    const int r0 = gw * 4;
    const int c = cond_of_row(r0);
    f32x4 gm[4];
#pragma unroll
    for (int j = 0; j < 4; ++j) { const int n = 4 * C.lane + 256 * j;
        if (from_table) gm[j] = *(const f32x4*)(C.f(WS_GMOD) + (((size_t)l * 2 + s) * 5 + c) * 1024 + n);
        else { const float* g = (s == 0 ? C.in[10] : C.in[11]) + l * D + n;
#pragma unroll
            for (int e = 0; e < 4; ++e) gm[j][e] = g[e] * (1.f + modsum(C, l, c, (s == 0 ? 1 : 4) * 1024 + n + e)); } }
    for (int rr = 0; rr < 4; ++rr) {
        const int r = r0 + rr; const float* xr = (r < MP ? xsrc_p + (size_t)r * D : xsrc_s + (size_t)(r - MP) * D);
        f32x4 v[4]; float sq = 0.f;
#pragma unroll
        for (int j = 0; j < 4; ++j) { v[j] = *(const f32x4*)(xr + 4 * C.lane + 256 * j); sq += (v[j][0] * v[j][0] + v[j][1] * v[j][1]) + (v[j][2] * v[j][2] + v[j][3] * v[j][3]); }
        sq = wave_sum(sq);
#pragma unroll
        for (int j = 0; j < 4; ++j) { const size_t off = (size_t)r * D + 4 * C.lane + 256 * j; if (xcopy) *(f32x4*)(xcopy + off) = v[j]; st_bf16x4(C.h(WS_AP) + off, v[j] * gm[j]); }
        if (C.lane == 0) ssdst[r] = sq;
    }
    }
}
__device__ __forceinline__ void phase_p0c(const Ctx& C) {
    for (int vb = C.bid; vb < 256; vb += C.G) {
    if (vb < 240) {
        int ch = vb, l = 0, s = 0, N = 0; const bf16_t* Wt = nullptr;
        if (ch < 12) { l = 0; s = 0; N = NQKV; Wt = C.h(WS_WQKV); }
        else if ((ch -= 12) < 44) { l = 0; s = 1; N = NUP; Wt = C.h(WS_UP); }
        else if ((ch -= 44) < 40) { l = 1; s = 0; N = NHIN; Wt = C.h(WS_HWIN); }
        else if ((ch -= 40) < 44) { l = 1; s = 1; N = NUP; Wt = C.h(WS_UP) + (size_t)1 * NUP * D; }
        else if ((ch -= 44) < 44) { l = 2; s = 1; N = NUP; Wt = C.h(WS_UP) + (size_t)2 * NUP * D; }
        else if ((ch -= 44) < 12) { l = 3; s = 0; N = NQKV; Wt = C.h(WS_WQKV) + (size_t)1 * NQKV * D; }
        else { ch -= 12; l = 3; s = 1; N = NUP; Wt = C.h(WS_UP) + (size_t)3 * NUP * D; }
        LAS float* sh = (LAS float*)C.lds;
        for (int i = C.tid; i < 5 * 1024; i += NTHREADS) sh[i] = modsum(C, l, i >> 10, (s == 0 ? 0 : 3) * 1024 + (i & 1023));
        __syncthreads();
        for (int q = 0; q < 16; ++q) {
            const int n = ch * 128 + C.wave * 16 + q;
            const u32x4 w0 = *(const u32x4*)(Wt + (size_t)n * D + 16 * C.lane), w1 = *(const u32x4*)(Wt + (size_t)n * D + 16 * C.lane + 8);
            float wv[16];
#pragma unroll
            for (int e = 0; e < 4; ++e) { wv[2 * e] = bflo(w0[e]); wv[2 * e + 1] = bfhi(w0[e]); wv[8 + 2 * e] = bflo(w1[e]); wv[8 + 2 * e + 1] = bfhi(w1[e]); }
            float a[5];
#pragma unroll
            for (int c = 0; c < 5; ++c) { a[c] = 0.f;
#pragma unroll
                for (int e = 0; e < 16; ++e) a[c] += wv[e] * sh[c * 1024 + 16 * C.lane + e]; a[c] = wave_sum(a[c]); }
            if (C.lane == 0) {
#pragma unroll
                for (int c = 0; c < 5; ++c) C.f(WS_SW)[(((size_t)l * 2 + s) * 5 + c) * SW_STRIDE + n] = a[c]; }
        }
    } else {
        const int t = (vb - 240) * NTHREADS + C.tid, NT = 16 * NTHREADS;
        for (int i = t; i < 4 * 5 * 6144; i += NT) { const int l = i / 30720, c = (i / 6144) % 5, idx = i % 6144; C.f(WS_MOD)[i] = modsum(C, l, c, idx); }
        for (int i = t; i < 4 * 2 * 5 * 1024; i += NT) { const int n = i & 1023, c = (i >> 10) % 5, s = (i / 5120) & 1, l = i / 10240;
            C.f(WS_GMOD)[i] = (s == 0 ? C.in[10] : C.in[11])[l * D + n] * (1.f + modsum(C, l, c, (s == 0 ? 1 : 4) * 1024 + n)); }
    }
    __syncthreads();
    }
    rows_ap_ss(C, C.in[0], C.in[1], C.f(WS_X), 0, 0, false, C.f(WS_SS));
}
__device__ __forceinline__ void phase_glue(const Ctx& C, int l, int s) { rows_ap_ss(C, C.f(WS_X), C.f(WS_X) + (size_t)MP * D, nullptr, l, s, true, C.f(WS_SS) + (size_t)(l * 2 + s) * M); }

__device__ __forceinline__ void phase_conv(const Ctx& C, int l) {
    const bf16_t* h = C.h(WS_SCR); bf16_t* act = C.h(WS_ACT); const float* cw = C.in[29] + (size_t)l * 3 * NUP; const float* cb = C.in[30] + (size_t)l * NUP;
    const int gt = C.bid * NTHREADS + C.tid, NGT = C.G * NTHREADS;
    for (int i = gt; i < M * (DFF / 8); i += NGT) {
        const int r = i / (DFF / 8), n = (i % (DFF / 8)) * 8;
        int t, S; if (r < MP) { t = r & 255; S = 256; } else { t = (r - MP) & 1023; S = 1024; }
        float g[8], v[8];
#pragma unroll
        for (int e = 0; e < 8; ++e) { g[e] = cb[n + e]; v[e] = cb[DFF + n + e]; }
#pragma unroll
        for (int jj = 0; jj < 3; ++jj) { const int tt = t + jj - 1; if (tt >= 0 && tt < S) {
            const u32x4 hg = *(const u32x4*)(h + (size_t)(r + jj - 1) * NUP + n), hv = *(const u32x4*)(h + (size_t)(r + jj - 1) * NUP + DFF + n);
#pragma unroll
            for (int e = 0; e < 4; ++e) { g[2 * e] += cw[jj * NUP + n + 2 * e] * bflo(hg[e]); g[2 * e + 1] += cw[jj * NUP + n + 2 * e + 1] * bfhi(hg[e]);
                v[2 * e] += cw[jj * NUP + DFF + n + 2 * e] * bflo(hv[e]); v[2 * e + 1] += cw[jj * NUP + DFF + n + 2 * e + 1] * bfhi(hv[e]); } } }
        u32x4 o;
#pragma unroll
        for (int e = 0; e < 4; ++e) o[e] = cvtpk(g[2 * e] * sigm(g[2 * e]) * v[2 * e], g[2 * e + 1] * sigm(g[2 * e + 1]) * v[2 * e + 1]);
        *(u32x4*)(act + (size_t)r * DFF + n) = o;
    }
}
__device__ __forceinline__ void phase_final(const Ctx& C) {
    const int gw = C.bid * NWAVES + C.wave, NGW = C.G * NWAVES; const float* ss = C.f(WS_SS) + (size_t)8 * M;
    for (int r = gw; r < M; r += NGW) { const float rs = rsqrtf(ss[r] * (1.f / D) + EPS);
#pragma unroll
        for (int j = 0; j < 4; ++j) { const int n = 4 * C.lane + 256 * j; float* p = C.out + (size_t)r * D + n; *(f32x4*)p = *(const f32x4*)p * rs * *(const f32x4*)(C.in[32] + n); } }
}
}
namespace om {
__device__ __forceinline__ int rowidx(int r, int h) { return (r & 3) + 8 * (r >> 2) + 4 * h; }
__device__ __forceinline__ float xhalf(float v) {
    auto rr = __builtin_amdgcn_permlane32_swap(__float_as_uint(v), __float_as_uint(v), false, false);
    return __uint_as_float((threadIdx.x & 32) ? rr[0] : rr[1]);
}
__device__ __forceinline__ bf16x8 pack8(const f32x16& x, int base) {
    u32x4 w; w.x = cvtpk(x[base], x[base + 1]); w.y = cvtpk(x[base + 2], x[base + 3]); w.z = cvtpk(x[base + 4], x[base + 5]); w.w = cvtpk(x[base + 6], x[base + 7]);
    return __builtin_bit_cast(bf16x8, w);
}
__device__ __forceinline__ bf16x8 cat44(u32x2 a, u32x2 b) { u32x4 w = {a.x, a.y, b.x, b.y}; return __builtin_bit_cast(bf16x8, w); }

constexpr int AT_KSTR = 144;
constexpr int AT_BUF = 2 * 64 * AT_KSTR;
__device__ __forceinline__ void attn_unit(const Ctx& C, int j, bool samp, int b, int hq, int qb) {
    const int lane = C.lane, c = lane & 31, h = lane >> 5, w = C.wave, kvh = hq >> 2;
    const int rowbase = samp ? MP + b * 1024 : b * 256, q0 = qb * 256, qlo = q0 + 32 * w;
    const bf16_t* Q = C.h(SCR_Q); const bf16_t* KB = C.h(SCR_KB); const bf16_t* VB = C.h(SCR_VB);
    const bf16_t* CK = C.h(WS_CTXK) + ((size_t)(b * 2 + j) * 512) * 256; const bf16_t* CV = C.h(WS_CTXV) + ((size_t)(b * 2 + j) * 512) * 256;
    int klo = 0, nlat = 4, NT = 4;
    if (samp) { klo = q0 - 128 < 0 ? 0 : q0 - 128; const int khi = q0 + 384 > 1024 ? 1024 : q0 + 384; nlat = (khi - klo) >> 6; NT = nlat + 8; }
    bf16x8 qf[4];
#pragma unroll
    for (int s = 0; s < 4; ++s) qf[s] = *(const bf16x8*)(Q + (size_t)(rowbase + qlo + c) * D + hq * 64 + 16 * s + 8 * h);
    float m = C.in[14][j * 16 + hq] * LOG2E, lsum = h == 0 ? 1.f : 0.f;
    f32x16 o0 = {}, o1 = {};
    const int lkey = C.tid >> 3, lch = C.tid & 7;
    auto src_k = [&](int t) -> const bf16_t* { return (t < nlat ? KB + (size_t)(rowbase + klo + 64 * t + lkey) * 256 : CK + (size_t)(64 * (t - nlat) + lkey) * 256) + kvh * 64 + lch * 8; };
    auto src_v = [&](int t) -> const bf16_t* { return (t < nlat ? VB + (size_t)(rowbase + klo + 64 * t + lkey) * 256 : CV + (size_t)(64 * (t - nlat) + lkey) * 256) + kvh * 64 + lch * 8; };
    auto put = [&](int buf, u32x4 kr, u32x4 vr) {
        LAS unsigned char* kb = C.lds + buf * AT_BUF; LAS unsigned char* vb = kb + 64 * AT_KSTR;
        *(LAS u32x4*)(kb + lkey * AT_KSTR + lch * 16) = kr;
#pragma unroll
        for (int e = 0; e < 4; ++e) { *(LAS unsigned short*)(vb + (lch * 8 + 2 * e) * AT_KSTR + lkey * 2) = (unsigned short)(vr[e] & 0xffffu); *(LAS unsigned short*)(vb + (lch * 8 + 2 * e + 1) * AT_KSTR + lkey * 2) = (unsigned short)(vr[e] >> 16); }
    };
    { const u32x4 kr = *(const u32x4*)src_k(0), vr = *(const u32x4*)src_v(0); put(0, kr, vr); }
    __syncthreads();
    for (int t = 0; t < NT; ++t) {
        u32x4 kr = {}, vr = {};
        if (t + 1 < NT) { kr = *(const u32x4*)src_k(t + 1); vr = *(const u32x4*)src_v(t + 1); }
        const bool lat = samp && t < nlat; const int key0 = klo + 64 * t;
        const bool skip = lat && (key0 > qlo + 31 + 128 || key0 + 63 < qlo - 128);
        if (!skip) {
            LAS unsigned char* kb = C.lds + (t & 1) * AT_BUF; LAS unsigned char* vb = kb + 64 * AT_KSTR;
            f32x16 x0 = {}, x1 = {};
#pragma unroll
            for (int s = 0; s < 4; ++s) {
                const bf16x8 a0 = *(const LAS bf16x8*)(kb + c * AT_KSTR + (16 * s + 8 * h) * 2), a1 = *(const LAS bf16x8*)(kb + (32 + c) * AT_KSTR + (16 * s + 8 * h) * 2);
                x0 = __builtin_amdgcn_mfma_f32_32x32x16_bf16(a0, qf[s], x0, 0, 0, 0); x1 = __builtin_amdgcn_mfma_f32_32x32x16_bf16(a1, qf[s], x1, 0, 0, 0);
            }
            if (lat && !(key0 >= qlo + 31 - 128 && key0 + 63 <= qlo + 128)) {
                const int tq = qlo + c;
#pragma unroll
                for (int r = 0; r < 16; ++r) { const int k0 = key0 + rowidx(r, h) - tq; if (k0 > 128 || k0 < -128) x0[r] = -INFINITY; if (k0 + 32 > 128 || k0 + 32 < -128) x1[r] = -INFINITY; }
            }
            float mx = fmaxf(x0[0], x1[0]);
#pragma unroll
            for (int r = 1; r < 16; ++r) mx = fmaxf(mx, fmaxf(x0[r], x1[r]));
            mx = fmaxf(mx, xhalf(mx));
            const float mn = fmaxf(m, mx), al = __builtin_amdgcn_exp2f(m - mn); m = mn;
            float ps = 0.f;
#pragma unroll
            for (int r = 0; r < 16; ++r) { x0[r] = __builtin_amdgcn_exp2f(x0[r] - mn); x1[r] = __builtin_amdgcn_exp2f(x1[r] - mn); ps += x0[r] + x1[r]; }
            lsum = lsum * al + ps;
#pragma unroll
            for (int r = 0; r < 16; ++r) { o0[r] *= al; o1[r] *= al; }
#pragma unroll
            for (int ks = 0; ks < 2; ++ks) {
                const bf16x8 p0 = pack8(x0, 8 * ks), p1 = pack8(x1, 8 * ks);
#pragma unroll
                for (int dt = 0; dt < 2; ++dt) {
                    const LAS unsigned char* vrow = vb + (32 * dt + c) * AT_KSTR + (16 * ks + 4 * h) * 2;
                    const bf16x8 v0 = cat44(*(const LAS u32x2*)(vrow), *(const LAS u32x2*)(vrow + 16)), v1 = cat44(*(const LAS u32x2*)(vrow + 64), *(const LAS u32x2*)(vrow + 80));
                    if (dt == 0) { o0 = __builtin_amdgcn_mfma_f32_32x32x16_bf16(v0, p0, o0, 0, 0, 0); o0 = __builtin_amdgcn_mfma_f32_32x32x16_bf16(v1, p1, o0, 0, 0, 0); }
                    else { o1 = __builtin_amdgcn_mfma_f32_32x32x16_bf16(v0, p0, o1, 0, 0, 0); o1 = __builtin_amdgcn_mfma_f32_32x32x16_bf16(v1, p1, o1, 0, 0, 0); }
                }
            }
        }
        if (t + 1 < NT) put((t + 1) & 1, kr, vr);
        __syncthreads();
    }
    lsum += xhalf(lsum);
    const float il = 1.f / lsum;
    bf16_t* O = C.h(SCR_O) + (size_t)(rowbase + qlo + c) * D + hq * 64 + 4 * h;
#pragma unroll
    for (int g = 0; g < 4; ++g) { st_bf16x4(O + 8 * g, (f32x4){o0[4 * g], o0[4 * g + 1], o0[4 * g + 2], o0[4 * g + 3]} * il); st_bf16x4(O + 32 + 8 * g, (f32x4){o1[4 * g], o1[4 * g + 1], o1[4 * g + 2], o1[4 * g + 3]} * il); }
}
__device__ __forceinline__ void phase_attn(const Ctx& C, int l) {
    const int j = l / 3;
    for (int u = C.bid; u < 512; u += C.G) {
        if (u < 256) attn_unit(C, j, false, u >> 4, u & 15, 0);
        else { const int v = u - 256; attn_unit(C, j, true, v >> 6, (v >> 2) & 15, v & 3); }
    }
}

constexpr int HS_QSTR = 272, HS_TSTR = 80;
constexpr int HS_QT = 0, HS_KT = 32 * HS_QSTR, HS_KTT = 2 * 32 * HS_QSTR, HS_VT = HS_KTT + 128 * HS_TSTR, HS_E1 = HS_VT + 128 * HS_TSTR, HS_E2 = HS_E1 + 512, HS_T1 = HS_E2 + 512, HS_GRP = HS_T1 + 512;
__device__ __forceinline__ void hscan_item(const Ctx& C, int item, int gi) {
    const bool samp = item < 64; const int it = samp ? item : item - 64;
    const int dir = it & 1, hd = (it >> 1) & 7, sq = it >> 4;
    const int S = samp ? 1024 : 256, rowbase = samp ? MP + sq * 1024 : sq * 256, nchunk = S >> 5;
    const int tg = C.tid & 255, lane = C.lane, c = lane & 31, h = lane >> 5, w4 = C.wave & 3;
    LAS unsigned char* L = C.lds + gi * HS_GRP;
    const bf16_t* HQ = C.h(SCR_HQ); const bf16_t* HV = C.h(SCR_HV); const float* LF = C.f(dir == 0 ? SCR_LFF : SCR_LFB); float* OD = C.f(dir == 0 ? SCR_OF : SCR_OB);
    f32x16 St[4];
#pragma unroll
    for (int dt = 0; dt < 4; ++dt) {
        if (samp) { const float* s0 = C.in[4] + ((((size_t)sq * 2 + dir) * 8 + hd) * 128) * 128;
#pragma unroll
            for (int r = 0; r < 16; ++r) St[dt][r] = s0[(size_t)(32 * dt + rowidx(r, h)) * 128 + 32 * w4 + c]; }
        else St[dt] = (f32x16){};
    }
    const int pd = tg & 127, ph = tg >> 7;
    for (int ch = 0; ch < nchunk; ++ch) {
        float cl[16], qv[16], kv[16];
        {
            float run = 0.f;
#pragma unroll
            for (int i = 0; i < 16; ++i) { const int pos = 32 * ch + 16 * ph + i, t = dir == 0 ? pos : S - 1 - pos; const size_t off = (size_t)(rowbase + t) * D + hd * 128 + pd;
                const float lf = LF[off]; run += lf; cl[i] = run; kv[i] = 1.f - __expf(lf); qv[i] = bf2f(HQ[off]); }
            if (ph == 0) *(LAS float*)(L + HS_T1 + pd * 4) = run;
        }
        unsigned vtw[8];
#pragma unroll
        for (int i = 0; i < 8; ++i) { const int pos = 32 * ch + 16 * ph + 2 * i, t0 = dir == 0 ? pos : S - 1 - pos, t1 = dir == 0 ? pos + 1 : S - 2 - pos;
            vtw[i] = (unsigned)HV[(size_t)(rowbase + t0) * D + hd * 128 + pd] | ((unsigned)HV[(size_t)(rowbase + t1) * D + hd * 128 + pd] << 16); }
        __syncthreads();
        {
            const float t1v = *(LAS float*)(L + HS_T1 + pd * 4);
            unsigned ktw[8];
#pragma unroll
            for (int i = 0; i < 16; i += 2) {
                const float e0 = ph == 0 ? cl[i] - t1v : cl[i], e1 = ph == 0 ? cl[i + 1] - t1v : cl[i + 1];
                const float q0 = qv[i] * __expf(e0), q1 = qv[i + 1] * __expf(e1), k0 = kv[i] * __expf(-e0), k1 = kv[i + 1] * __expf(-e1);
                const unsigned qw0 = cvtpk(q0, 0.f), qw1 = cvtpk(q1, 0.f), kw = cvtpk(k0, k1);
                *(LAS unsigned short*)(L + HS_QT + (16 * ph + i) * HS_QSTR + pd * 2) = (unsigned short)qw0; *(LAS unsigned short*)(L + HS_QT + (16 * ph + i + 1) * HS_QSTR + pd * 2) = (unsigned short)qw1;
                *(LAS unsigned short*)(L + HS_KT + (16 * ph + i) * HS_QSTR + pd * 2) = (unsigned short)(kw & 0xffffu); *(LAS unsigned short*)(L + HS_KT + (16 * ph + i + 1) * HS_QSTR + pd * 2) = (unsigned short)(kw >> 16);
                ktw[i >> 1] = kw;
            }
            *(LAS u32x4*)(L + HS_KTT + pd * HS_TSTR + ph * 32) = (u32x4){ktw[0], ktw[1], ktw[2], ktw[3]}; *(LAS u32x4*)(L + HS_KTT + pd * HS_TSTR + ph * 32 + 16) = (u32x4){ktw[4], ktw[5], ktw[6], ktw[7]};
            *(LAS u32x4*)(L + HS_VT + pd * HS_TSTR + ph * 32) = (u32x4){vtw[0], vtw[1], vtw[2], vtw[3]}; *(LAS u32x4*)(L + HS_VT + pd * HS_TSTR + ph * 32 + 16) = (u32x4){vtw[4], vtw[5], vtw[6], vtw[7]};
            if (ph == 0) *(LAS float*)(L + HS_E1 + pd * 4) = __expf(t1v); else *(LAS float*)(L + HS_E2 + pd * 4) = __expf(cl[15]);
        }
        __syncthreads();
#pragma unroll
        for (int dt = 0; dt < 4; ++dt)
#pragma unroll
            for (int g = 0; g < 4; ++g) { const f32x4 e = *(const LAS f32x4*)(L + HS_E1 + (32 * dt + 8 * g + 4 * h) * 4);
#pragma unroll
                for (int q = 0; q < 4; ++q) St[dt][4 * g + q] *= e[q]; }
        f32x16 X = {};
#pragma unroll
        for (int s = 0; s < 8; ++s) {
            const bf16x8 a = *(const LAS bf16x8*)(L + HS_KT + c * HS_QSTR + (16 * s + 8 * h) * 2), bq = *(const LAS bf16x8*)(L + HS_QT + c * HS_QSTR + (16 * s + 8 * h) * 2);
            X = __builtin_amdgcn_mfma_f32_32x32x16_bf16(a, bq, X, 0, 0, 0);
        }
#pragma unroll
        for (int r = 0; r < 16; ++r) if (rowidx(r, h) > c) X[r] = 0.f;
        f32x16 OT = {};
#pragma unroll
        for (int ks = 0; ks < 2; ++ks) {
            const LAS unsigned char* vrow = L + HS_VT + (32 * w4 + c) * HS_TSTR + (16 * ks + 4 * h) * 2;
            const bf16x8 va = cat44(*(const LAS u32x2*)(vrow), *(const LAS u32x2*)(vrow + 16));
            OT = __builtin_amdgcn_mfma_f32_32x32x16_bf16(va, pack8(X, 8 * ks), OT, 0, 0, 0);
        }
#pragma unroll
        for (int dt = 0; dt < 4; ++dt)
#pragma unroll
            for (int ks = 0; ks < 2; ++ks) {
                const LAS unsigned char* qrow = L + HS_QT + c * HS_QSTR + (32 * dt + 16 * ks + 4 * h) * 2;
                const bf16x8 bq = cat44(*(const LAS u32x2*)(qrow), *(const LAS u32x2*)(qrow + 16));
                OT = __builtin_amdgcn_mfma_f32_32x32x16_bf16(pack8(St[dt], 8 * ks), bq, OT, 0, 0, 0);
            }
#pragma unroll
        for (int dt = 0; dt < 4; ++dt)
#pragma unroll
            for (int ks = 0; ks < 2; ++ks) {
                const bf16x8 a = *(const LAS bf16x8*)(L + HS_KTT + (32 * dt + c) * HS_TSTR + (16 * ks + 8 * h) * 2), bv = *(const LAS bf16x8*)(L + HS_VT + (32 * w4 + c) * HS_TSTR + (16 * ks + 8 * h) * 2);
                St[dt] = __builtin_amdgcn_mfma_f32_32x32x16_bf16(a, bv, St[dt], 0, 0, 0);
            }
#pragma unroll
        for (int dt = 0; dt < 4; ++dt)
#pragma unroll
            for (int g = 0; g < 4; ++g) { const f32x4 e = *(const LAS f32x4*)(L + HS_E2 + (32 * dt + 8 * g + 4 * h) * 4);
#pragma unroll
                for (int q = 0; q < 4; ++q) St[dt][4 * g + q] *= e[q]; }
        { const int pos = 32 * ch + c, t = dir == 0 ? pos : S - 1 - pos; float* op = OD + (size_t)(rowbase + t) * D + hd * 128 + 32 * w4 + 4 * h;
#pragma unroll
            for (int g = 0; g < 4; ++g) *(f32x4*)(op + 8 * g) = (f32x4){OT[4 * g], OT[4 * g + 1], OT[4 * g + 2], OT[4 * g + 3]}; }
    }
    if (!samp) { float* so = C.out + 8388608 + 2 * 2097152 + ((((size_t)sq * 2 + dir) * 8 + hd) * 128) * 128;
#pragma unroll
        for (int dt = 0; dt < 4; ++dt)
#pragma unroll
            for (int r = 0; r < 16; ++r) so[(size_t)(32 * dt + rowidx(r, h)) * 128 + 32 * w4 + c] = St[dt][r]; }
}
__device__ __forceinline__ void phase_hscan(const Ctx& C) {
    const int gi = C.wave >> 2;
    for (int bi = C.bid; bi < 160; bi += C.G) { const int item = bi < 32 ? 2 * bi + gi : 64 + 2 * (bi - 32) + gi; hscan_item(C, item, gi); __syncthreads(); }
}
__device__ __forceinline__ void phase_hpost(const Ctx& C) {
    const int gw = C.bid * NWAVES + C.wave, NGW = C.G * NWAVES;
    for (int r = gw; r < M; r += NGW) {
        const size_t off = (size_t)r * D + 16 * C.lane; float o[16]; float sq = 0.f;
#pragma unroll
        for (int q = 0; q < 4; ++q) { const f32x4 a = *(const f32x4*)(C.f(SCR_OF) + off + 4 * q), b = *(const f32x4*)(C.f(SCR_OB) + off + 4 * q);
#pragma unroll
            for (int e = 0; e < 4; ++e) { o[4 * q + e] = a[e] + b[e]; sq += o[4 * q + e] * o[4 * q + e]; } }
        sq += __shfl_xor(sq, 1); sq += __shfl_xor(sq, 2); sq += __shfl_xor(sq, 4);
        const float rs = rsqrtf(sq * (1.f / 128.f) + EPS);
        const u32x4 g0 = *(const u32x4*)(C.h(SCR_HG) + off), g1 = *(const u32x4*)(C.h(SCR_HG) + off + 8);
        const float* gn = C.in[17] + (16 * C.lane & 127);
        float sg[16];
#pragma unroll
        for (int e = 0; e < 4; ++e) { sg[2 * e] = bflo(g0[e]); sg[2 * e + 1] = bfhi(g0[e]); sg[8 + 2 * e] = bflo(g1[e]); sg[8 + 2 * e + 1] = bfhi(g1[e]); }
        u32x4 w0, w1;
#pragma unroll
        for (int e = 0; e < 4; ++e) { w0[e] = cvtpk(o[2 * e] * rs * gn[2 * e] * sg[2 * e], o[2 * e + 1] * rs * gn[2 * e + 1] * sg[2 * e + 1]);
            w1[e] = cvtpk(o[8 + 2 * e] * rs * gn[8 + 2 * e] * sg[8 + 2 * e], o[8 + 2 * e + 1] * rs * gn[8 + 2 * e + 1] * sg[8 + 2 * e + 1]); }
        *(u32x4*)(C.h(SCR_AWO) + off) = w0; *(u32x4*)(C.h(SCR_AWO) + off + 8) = w1;
    }
}

constexpr int SS_RSTR = 528;
constexpr int SS_WAVE = 32 * SS_RSTR;
__device__ __forceinline__ void sscan_seq(const Ctx& C, int l, bool samp, int sq, int dir, int g) {
    const int lane = C.lane, c = lane & 31, h = lane >> 5, dg = dir * 64 + g;
    const int S = samp ? 1024 : 256, rowbase = samp ? MP + sq * 1024 : sq * 256, nchunk = S >> 5, cond = samp ? 1 + sq : 0;
    LAS unsigned char* L = C.lds + C.wave * SS_WAVE;
    const float* X = C.f(WS_X); const float* ss = C.f(WS_SS) + (size_t)(l * 2) * M; float* Y = C.f(dir == 0 ? SCR_YF : SCR_YB);
    bf16x8 bfr[4], cfr[4];
#pragma unroll
    for (int ct = 0; ct < 4; ++ct) bfr[ct] = *(const bf16x8*)(C.h(WS_SBB) + ((size_t)dg * 128 + 32 * ct + c) * 16 + 8 * h);
#pragma unroll
    for (int s = 0; s < 4; ++s) cfr[s] = *(const bf16x8*)(C.h(WS_SCB) + ((size_t)dg * 16 + (lane & 15)) * 128 + 32 * s + 8 * (lane >> 4));
    const float lr = C.f(WS_SLAM)[2 * (dg * 64 + lane)], li = C.f(WS_SLAM)[2 * (dg * 64 + lane) + 1];
    f32x4 gm0, gm1, sh0, sh1;
    { const float* gm = C.f(WS_GMOD) + ((size_t)(l * 2) * 5 + cond) * 1024 + g * 16 + 8 * h; gm0 = *(const f32x4*)gm; gm1 = *(const f32x4*)(gm + 4);
      const float* sh = C.f(WS_MOD) + ((size_t)l * 5 + cond) * 6144 + g * 16 + 8 * h; sh0 = *(const f32x4*)sh; sh1 = *(const f32x4*)(sh + 4); }
    float hr = 0.f, hi = 0.f;
    if (samp) { const float* s0 = C.in[5] + ((((size_t)sq * 2 + dir) * 64 + g) * 64 + lane) * 2; hr = s0[0]; hi = s0[1]; }
    for (int ch = 0; ch < nchunk; ++ch) {
        const int pos = 32 * ch + c, t = dir == 0 ? pos : S - 1 - pos, r = rowbase + t;
        const float rs = rsqrtf(ss[r] * (1.f / D) + EPS);
        const f32x4 x0 = *(const f32x4*)(X + (size_t)r * D + g * 16 + 8 * h), x1 = *(const f32x4*)(X + (size_t)r * D + g * 16 + 8 * h + 4);
        const f32x4 u0 = x0 * rs * gm0 + sh0, u1 = x1 * rs * gm1 + sh1;
        u32x4 uw = {cvtpk(u0[0], u0[1]), cvtpk(u0[2], u0[3]), cvtpk(u1[0], u1[1]), cvtpk(u1[2], u1[3])};
        const bf16x8 uf = __builtin_bit_cast(bf16x8, uw);
#pragma unroll
        for (int ct = 0; ct < 4; ++ct) {
            f32x16 bu = {}; bu = __builtin_amdgcn_mfma_f32_32x32x16_bf16(uf, bfr[ct], bu, 0, 0, 0);
#pragma unroll
            for (int rr = 0; rr < 16; ++rr) *(LAS float*)(L + rowidx(rr, h) * SS_RSTR + (32 * ct + c) * 4) = bu[rr];
        }
        LDS_WAIT();
#pragma unroll 1
        for (int t8 = 0; t8 < 32; t8 += 8) {
            float br[8], bi[8]; unsigned wv[8];
#pragma unroll
            for (int k = 0; k < 8; ++k) { br[k] = *(LAS float*)(L + (t8 + k) * SS_RSTR + lane * 4); bi[k] = *(LAS float*)(L + (t8 + k) * SS_RSTR + (64 + lane) * 4); }
#pragma unroll
            for (int k = 0; k < 8; ++k) { const float nr = lr * hr - li * hi + br[k], ni = lr * hi + li * hr + bi[k]; hr = nr; hi = ni; wv[k] = cvtpk(hr, hi); }
#pragma unroll
            for (int k = 0; k < 8; ++k) { *(LAS unsigned short*)(L + (t8 + k) * SS_RSTR + lane * 2) = (unsigned short)(wv[k] & 0xffffu); *(LAS unsigned short*)(L + (t8 + k) * SS_RSTR + (64 + lane) * 2) = (unsigned short)(wv[k] >> 16); }
        }
        LDS_WAIT();
        f32x4 y0 = {}, y1 = {};
#pragma unroll
        for (int s = 0; s < 4; ++s) {
            const bf16x8 a0 = *(const LAS bf16x8*)(L + (lane & 15) * SS_RSTR + (32 * s + 8 * (lane >> 4)) * 2), a1 = *(const LAS bf16x8*)(L + (16 + (lane & 15)) * SS_RSTR + (32 * s + 8 * (lane >> 4)) * 2);
            y0 = __builtin_amdgcn_mfma_f32_16x16x32_bf16(a0, cfr[s], y0, 0, 0, 0); y1 = __builtin_amdgcn_mfma_f32_16x16x32_bf16(a1, cfr[s], y1, 0, 0, 0);
        }
#pragma unroll
        for (int q = 0; q < 4; ++q) {
            const int p0 = 32 * ch + 4 * (lane >> 4) + q, p1 = p0 + 16, t0 = dir == 0 ? p0 : S - 1 - p0, t1 = dir == 0 ? p1 : S - 1 - p1;
            Y[(size_t)(rowbase + t0) * D + g * 16 + (lane & 15)] = y0[q]; Y[(size_t)(rowbase + t1) * D + g * 16 + (lane & 15)] = y1[q];
        }
        LDS_WAIT();
    }
    if (!samp) { float* so = C.out + 8388608 + 2 * 2097152 + 4194304 + ((((size_t)sq * 2 + dir) * 64 + g) * 64 + lane) * 2; so[0] = hr; so[1] = hi; }
}
__device__ __forceinline__ void phase_sscan(const Ctx& C, int l) {
    for (int bb = C.bid; bb < 256; bb += C.G) {
        const int w = C.wave;
        if (w < 2) { const int id = 2 * bb + w; sscan_seq(C, l, true, id >> 7, (id >> 6) & 1, id & 63); }
        else { int id = 8 * bb + (w - 2); sscan_seq(C, l, false, id >> 7, (id >> 6) & 1, id & 63);
            if (w < 4) { id = 8 * bb + 6 + (w - 2); sscan_seq(C, l, false, id >> 7, (id >> 6) & 1, id & 63); } }
    }
}
__device__ __forceinline__ void phase_spost(const Ctx& C, int l) {
    const int gw = C.bid * NWAVES + C.wave, NGW = C.G * NWAVES; const float* ss = C.f(WS_SS) + (size_t)(l * 2) * M;
    for (int r = gw; r < M; r += NGW) {
        const int cond = cond_of_row(r); const float rs = rsqrtf(ss[r] * (1.f / D) + EPS);
#pragma unroll
        for (int jq = 0; jq < 4; ++jq) {
            const int n = 4 * C.lane + 256 * jq; const size_t off = (size_t)r * D + n;
            const f32x4 x = *(const f32x4*)(C.f(WS_X) + off), gm = *(const f32x4*)(C.f(WS_GMOD) + ((size_t)(l * 2) * 5 + cond) * 1024 + n), sh = *(const f32x4*)(C.f(WS_MOD) + ((size_t)l * 5 + cond) * 6144 + n);
            const f32x4 u = x * rs * gm + sh, y = *(const f32x4*)(C.in[26] + n) * u + *(const f32x4*)(C.f(SCR_YF) + off) + *(const f32x4*)(C.f(SCR_YB) + off);
            f32x4 o;
#pragma unroll
            for (int e = 0; e < 4; ++e) { const float v = y[e], uu = 0.7978845608028654f * (v + 0.044715f * v * v * v); const float th = 1.f - 2.f / (1.f + __expf(2.f * uu)); o[e] = 0.5f * v * (1.f + th); }
            st_bf16x4(C.h(SCR_AGLU) + off, o);
        }
    }
}
__device__ __forceinline__ void grid_barrier(const Ctx& C) { cooperative_groups::this_grid().sync(); }
}
namespace om {
enum { PH_P0A = 0, PH_P0C, PH_GLUE, PH_QKV, PH_ATTN, PH_WO, PH_HIN, PH_HSCAN, PH_HPOST, PH_HWO, PH_SSCAN, PH_SPOST, PH_GLU, PH_UP, PH_CONV, PH_DOWN, PH_FINAL };

struct Args { const float* in[33]; float* out; unsigned char* ws; int nph; int pad; unsigned char ptype[64]; unsigned char parg[64]; };

__device__ __forceinline__ void run_phase(const Ctx& C0, int type, int arg) {
    Ctx C = C0; asm volatile("" : "+v"(C.tid)); asm volatile("" : "+s"(C.bid), "+s"(C.G));
    C.lane = C.tid & 63; C.wave = __builtin_amdgcn_readfirstlane(C.tid >> 6);
    const int l = arg & 3;
#ifndef PHASE_MASK
#define PHASE_MASK 0xFFFFFFFFu
#endif
    if (!((PHASE_MASK >> type) & 1u)) return;
    pg8::Gemm g{nullptr, nullptr, D, 256, 128}; int nN = 0; EpiAny E{};
    const float* ss1 = C.f(WS_SS) + (size_t)(l * 2) * M; const float* sw1 = C.f(WS_SW) + (size_t)(l * 2) * 5 * SW_STRIDE;
    switch (type) {
    case PH_P0A: phase_p0a(C); break;
    case PH_P0C: phase_p0c(C); break;
    case PH_GLUE: phase_glue(C, arg >> 1, arg & 1); break;
    case PH_QKV: { const int j = l / 3; g.A = C.h(WS_AP); g.Bt = C.h(WS_WQKV) + (size_t)j * NQKV * D; nN = 6;
        E.kind = EK_QKV; E.j = j; E.ss = ss1; E.sw = sw1; E.b0 = C.h(SCR_Q); E.b1 = C.h(SCR_KB); E.b2 = C.h(SCR_VB); E.f0 = C.out + 8388608; E.f1 = C.out + 8388608 + 2097152; E.ropec = C.f(WS_ROPE); E.ropes = C.f(WS_ROPE) + 32768; } break;
    case PH_ATTN: phase_attn(C, l); break;
    case PH_WO: case PH_HWO: case PH_GLU: {
        if (type == PH_WO) { g.A = C.h(SCR_O); g.Bt = C.h(WS_WO) + (size_t)(l / 3) * D * D; nN = 4; E.kind = EK_RES; }
        else if (type == PH_HWO) { g.A = C.h(SCR_AWO); g.Bt = C.h(WS_HWO); nN = 4; E.kind = EK_RES; }
        else { g.A = C.h(SCR_AGLU); g.Bt = C.h(WS_GLU); g.b_tile_rows = 128; g.b_half_rows = 1024; nN = 8; E.kind = EK_RES_GLU; }
        E.xin = C.f(WS_X); E.xout = C.f(WS_X); E.ap = C.h(WS_AP); E.ssn = C.f(WS_SS) + (size_t)(l * 2 + 1) * M; E.gate = C.f(WS_MOD) + (size_t)l * 5 * 6144 + 2 * 1024; E.gmodn = C.f(WS_GMOD) + (size_t)(l * 2 + 1) * 5 * 1024; } break;
    case PH_HIN: { g.A = C.h(WS_AP); g.Bt = C.h(WS_HWIN); nN = 20;
        E.kind = EK_HIN; E.ss = ss1; E.sw = sw1; E.lb1 = C.f(WS_LB1); E.b0 = C.h(SCR_HQ); E.b1 = C.h(SCR_HV); E.b2 = C.h(SCR_HG); E.f0 = C.f(SCR_LFF); E.f1 = C.f(SCR_LFB); } break;
    case PH_HSCAN: phase_hscan(C); break;
    case PH_HPOST: phase_hpost(C); break;
    case PH_SSCAN: phase_sscan(C, l); break;
    case PH_SPOST: phase_spost(C, l); break;
    case PH_UP: { g.A = C.h(WS_AP); g.Bt = C.h(WS_UP) + (size_t)l * NUP * D; nN = 22;
        E.kind = EK_UPRAW; E.ss = ss1 + M; E.sw = sw1 + 5 * SW_STRIDE; E.b0 = C.h(WS_SCR); } break;
    case PH_CONV: phase_conv(C, l); break;
    case PH_DOWN: { const bool to_out = (arg >> 4) & 1; g.A = C.h(WS_ACT); g.Bt = C.h(WS_DOWN) + (size_t)l * D * DFF; g.K = DFF; nN = 4;
        E.kind = EK_RES; E.xin = C.f(WS_X); E.xout = to_out ? C.out : C.f(WS_X); E.ap = C.h(WS_AP); E.ssn = C.f(WS_SS) + (size_t)((l + 1) * 2) * M; E.gate = C.f(WS_MOD) + (size_t)l * 5 * 6144 + 5 * 1024;
        E.gmodn = l < 3 ? C.f(WS_GMOD) + (size_t)((l + 1) * 2) * 5 * 1024 : nullptr; } break;
    case PH_FINAL: phase_final(C); break;
    default: break;
    }
    if (nN) { pg8::StaticOrder S; S.init(32, nN, C.G, C.bid); pg8::gemm_phase(C.lds, g, S, E); }
}

__global__ void __launch_bounds__(NTHREADS, 2) mk_fwd(Args a) {
    extern __shared__ __attribute__((aligned(16))) unsigned char lds[];
    Ctx C;
#pragma unroll
    for (int i = 0; i < 33; ++i) C.in[i] = a.in[i];
    C.out = a.out; C.ws = a.ws; C.lds = (LAS unsigned char*)lds; C.tid = threadIdx.x; C.lane = C.tid & 63; C.wave = __builtin_amdgcn_readfirstlane(C.tid >> 6); C.G = gridDim.x; C.bid = blockIdx.x;
    for (int i = 0; i < a.nph; ++i) {
        run_phase(C, a.ptype[i], a.parg[i]);
        if (i + 1 < a.nph) grid_barrier(C);
    }
}
}
extern "C" void kernel_launch(void* const* d_in, const int* in_sizes, int n_in, void* d_out, int out_size, void* d_ws, size_t ws_size, hipStream_t stream) {
    using namespace om;
    static int grid = 0;
    if (grid == 0) {
        if (n_in != 33 || out_size != 17039360 || ws_size < WS_END) { fprintf(stderr, "kernel_launch: unexpected sizes n_in %d out %d ws %zu; nothing launched\n", n_in, out_size, ws_size); grid = -1; return; }
        int dev = 0, cus = 0, per_cu = 0;
        (void)hipGetDevice(&dev); (void)hipDeviceGetAttribute(&cus, hipDeviceAttributeMultiprocessorCount, dev);
        (void)hipFuncSetAttribute((const void*)mk_fwd, hipFuncAttributeMaxDynamicSharedMemorySize, LDS_BYTES);
        if (hipOccupancyMaxActiveBlocksPerMultiprocessor(&per_cu, (const void*)mk_fwd, NTHREADS, LDS_BYTES) != hipSuccess || per_cu < 1) { fprintf(stderr, "kernel_launch: occupancy query gives %d blocks per CU\n", per_cu); per_cu = 1; }
        (void)hipGetLastError();
        grid = cus;
        if (grid > 256) grid = 256;
    }
    if (grid < 0) return;
    (void)hipMemsetAsync((char*)d_ws + WS_CTL, 0, CTL_ZERO_BYTES, stream);
    Args a{};
    for (int i = 0; i < 33; ++i) a.in[i] = (const float*)d_in[i];
    a.out = (float*)d_out; a.ws = (unsigned char*)d_ws;
    int n = 0;
    auto add = [&](int t, int p) { a.ptype[n] = (unsigned char)t; a.parg[n] = (unsigned char)p; ++n; };
    add(PH_P0A, 0); add(PH_P0C, 0);
    for (int l = 0; l < 4; ++l) {
        const int kind = l % 3;
        if (kind == 0) { add(PH_QKV, l); add(PH_ATTN, l); add(PH_WO, l); }
        else if (kind == 1) { add(PH_HIN, l); add(PH_HSCAN, l); add(PH_HPOST, l); add(PH_HWO, l); }
        else { add(PH_SSCAN, l); add(PH_SPOST, l); add(PH_GLU, l); }
        add(PH_UP, l); add(PH_CONV, l); add(PH_DOWN, l == 3 ? (l | 16) : l);
    }
    add(PH_FINAL, 0);
    a.nph = n;
    void* args[] = {&a};
    const hipError_t e = hipLaunchCooperativeKernel((const void*)mk_fwd, dim3(grid), dim3(NTHREADS), args, LDS_BYTES, stream);
    if (e != hipSuccess) fprintf(stderr, "kernel_launch: cooperative launch failed: %s (grid %d)\n", hipGetErrorString(e), grid);
}
```

```cpp
#include <hip/hip_runtime.h>
#include <hip/hip_cooperative_groups.h>
#include <cstdio>
#include <cstdint>
#include <cmath>
#define LAS __attribute__((address_space(3)))
#define GAS __attribute__((address_space(1)))
typedef unsigned short bf16_t;
typedef short bf16x8 __attribute__((ext_vector_type(8)));
typedef short s16x4 __attribute__((ext_vector_type(4)));
typedef float f32x2 __attribute__((ext_vector_type(2)));
typedef float f32x4 __attribute__((ext_vector_type(4)));
typedef float f32x16 __attribute__((ext_vector_type(16)));
typedef unsigned u32x2 __attribute__((ext_vector_type(2)));
typedef unsigned u32x4 __attribute__((ext_vector_type(4)));
typedef __bf16 bf16x2_t __attribute__((ext_vector_type(2)));

namespace om {
constexpr int D = 1024, MP = 4096, M = 8192, DFF = 2816, NUP = 5632, NQKV = 1536, NHIN = 5120;
constexpr float EPS = 1e-6f, LOG2E = 1.4426950408889634f, QSCALE = 0.125f * 1.4426950408889634f;
constexpr int NTHREADS = 512, NWAVES = 8, LDS_BYTES = 147456, RING_BYTES = 131072;
constexpr int SW_STRIDE = 5632;
constexpr float SS_FIX = 16777216.f, SS_INV = 1.f / (16777216.f * 1024.f);
typedef unsigned long long u64_t;
__device__ __forceinline__ float rstd_of(const u64_t* ss, int r) { return rsqrtf((float)ss[r] * SS_INV + 1e-6f); }
constexpr size_t MiB = 1u << 20;
constexpr size_t WS_CTL = 0, CTL_ZERO_BYTES = 64 * 1024;
constexpr size_t WS_MODP = 1 * MiB, WS_MOD = 3 * MiB, WS_SW = 4 * MiB, WS_GMOD = 5 * MiB, WS_SS = 6 * MiB, WS_ROPE = 7 * MiB;
constexpr size_t WS_LB1 = 8 * MiB, WS_SLAM = 8 * MiB + 64 * 1024, WS_SBB = 8 * MiB + 512 * 1024, WS_SCB = 9 * MiB;
constexpr size_t WS_CTXK = 10 * MiB, WS_CTXV = 12 * MiB;
constexpr size_t WS_NAIVE_MOD = 14 * MiB;
constexpr size_t WS_WQKV = 16 * MiB, WS_WO = 22 * MiB, WS_HWIN = 26 * MiB, WS_HWO = 36 * MiB, WS_GLU = 38 * MiB, WS_UP = 42 * MiB, WS_DOWN = 86 * MiB;
constexpr size_t WS_X = 108 * MiB, WS_R = 140 * MiB;
constexpr size_t WS_AP = WS_R, WS_ACT = WS_R + 16 * MiB, WS_SCR = WS_R + 60 * MiB, WS_END = WS_SCR + 176 * MiB;

constexpr size_t SCR_Q = WS_SCR, SCR_KB = WS_SCR + 16 * MiB, SCR_VB = WS_SCR + 20 * MiB, SCR_O = WS_SCR + 24 * MiB;
constexpr size_t SCR_HQ = WS_SCR, SCR_HV = WS_SCR + 16 * MiB, SCR_HG = WS_SCR + 32 * MiB, SCR_LFF = WS_SCR + 48 * MiB, SCR_LFB = WS_SCR + 80 * MiB, SCR_OF = WS_SCR + 112 * MiB, SCR_OB = WS_SCR + 144 * MiB, SCR_AWO = WS_SCR;
constexpr size_t SCR_YF = WS_SCR, SCR_YB = WS_SCR + 32 * MiB, SCR_AGLU = WS_SCR + 64 * MiB;

__device__ __forceinline__ int cond_of_tile(int pm) { return pm < 16 ? 0 : 1 + ((pm - 16) >> 2); }
__device__ __forceinline__ int cond_of_row(int r) { return r < MP ? 0 : 1 + ((r - MP) >> 10); }
__device__ __forceinline__ unsigned cvtpk(float lo, float hi) { f32x2 v = {lo, hi}; bf16x2_t b = __builtin_convertvector(v, bf16x2_t); return __builtin_bit_cast(unsigned, b); }
__device__ __forceinline__ float bf2f(unsigned short h) { return __uint_as_float(((unsigned)h) << 16); }
__device__ __forceinline__ float bflo(unsigned w) { return __uint_as_float(w << 16); }
__device__ __forceinline__ float bfhi(unsigned w) { return __uint_as_float(w & 0xffff0000u); }
__device__ __forceinline__ float sigm(float x) { return 1.f / (1.f + __expf(-x)); }
__device__ __forceinline__ float wave_sum(float v) {
#pragma unroll
    for (int o = 1; o < 64; o <<= 1) v += __shfl_xor(v, o);
    return v;
}

struct Ctx {
    const unsigned char __attribute__((address_space(4)))* kp;
    float* out; unsigned char* ws;
    LAS unsigned char* lds; int tid, lane, wave, G, bid;
    __device__ __forceinline__ const float* in(int i) const { return *(const float* const __attribute__((address_space(4)))*)(kp + 8 * i); }
    __device__ __forceinline__ float* f(size_t off) const { return (float*)(ws + off); }
    __device__ __forceinline__ bf16_t* h(size_t off) const { return (bf16_t*)(ws + off); }
};

namespace pg8 {
constexpr int BM = 256, BK = 64, HALF = 128, HTB = HALF * BK * 2, STAGE_BYTES = 8 * HTB, NXCD = 8, WGM = 8;
__host__ __device__ __forceinline__ int lds_byte(int r, int c) { const int st = (r >> 4) * 2 + (c >> 5), rr = r & 15, cc = c & 31, ob = rr * 64 + cc * 2; return st * 1024 + (ob ^ (((ob >> 9) & 1) << 5)); }
__host__ __device__ __forceinline__ void stage_rc(int b, int& R, int& C) { const int st = b / 1024, sb = b % 1024, swz = sb ^ (((sb >> 9) & 1) << 5); R = (st >> 1) * 16 + swz / 64; C = (st & 1) * 32 + (swz % 64) / 2; }
struct Unit { int pm, pn; };
struct Gemm { const bf16_t* A; const bf16_t* Bt; int K; int b_tile_rows, b_half_rows; };
struct StaticOrder {
    int nM, nN, nwg, G, c;
    __device__ void init(int nM_, int nN_, int G_, int c_) { nM = nM_; nN = nN_; nwg = nM * nN; G = G_; c = c_; }
    __device__ bool next(int i, Unit& u) const {
        const long L = (long)i * G + c; if (L >= nwg) return false;
        int wgid = (int)L; { const int q = nwg / NXCD, r = nwg % NXCD, xcd = wgid % NXCD, off = wgid / NXCD; wgid = (xcd < r ? xcd * (q + 1) : r * (q + 1) + (xcd - r) * q) + off; }
        const int nig = WGM * nN, gid = wgid / nig, fm = gid * WGM, gsz = (nM - fm) < WGM ? (nM - fm) : WGM;
        u.pm = fm + ((wgid % nig) % gsz); u.pn = (wgid % nig) / gsz; return true;
    }
};
template <class Epi>
__device__ __forceinline__ void gemm_phase(LAS unsigned char* lds, const Gemm g, const StaticOrder& S, const Epi& E) {
    int tid_ = threadIdx.x; asm volatile("" : "+v"(tid_));
    const int tid = tid_, wid = __builtin_amdgcn_readfirstlane(tid >> 6), lane = tid & 63, wr = wid >> 2, wc = wid & 3, fr = lane & 15, fq = lane >> 4;
    const int K = g.K, nt = K / BK;
    unsigned voffA[2];
#pragma unroll
    for (int i = 0; i < 2; ++i) { int R, C; stage_rc(tid * 16 + i * 8192, R, C); voffA[i] = (unsigned)(R * K + C) * 2u; }
    const size_t kstep = (size_t)(BK * 2);
    const size_t hstepA = (size_t)HALF * K * 2, tstepA = 2 * hstepA;
    const size_t hstepB = (size_t)g.b_half_rows * K * 2, tstepB = (size_t)g.b_tile_rows * K * 2;
    const unsigned ldsw = (unsigned)wid * 1024u;
    const int aoff = lds_byte(wr * 64 + fr, fq * 8), boff = lds_byte(wc * 32 + fr, fq * 8);
#define PG8_SA(b, h) (((b) * 2 + (h)) * HTB)
#define PG8_SB(b, h) ((4 + (b) * 2 + (h)) * HTB)
#define PG8_STAGE(bufoff, gbase) do { _Pragma("unroll") for (int _i = 0; _i < 2; ++_i) \
        __builtin_amdgcn_global_load_lds((const unsigned*)((const char*)(gbase) + voffA[_i]), (LAS unsigned*)(lds + (bufoff) + ldsw + _i * 8192), 16, 0, 0); } while (0)
#define PG8_LDA(dst, b, h) do { _Pragma("unroll") for (int m = 0; m < 4; ++m) _Pragma("unroll") for (int k = 0; k < 2; ++k) dst[m][k] = *(const LAS bf16x8*)(lds + PG8_SA(b, h) + aoff + m * 2048 + k * 1024); } while (0)
#define PG8_LDB(dst, b, h) do { _Pragma("unroll") for (int n = 0; n < 2; ++n) _Pragma("unroll") for (int k = 0; k < 2; ++k) dst[n][k] = *(const LAS bf16x8*)(lds + PG8_SB(b, h) + boff + n * 2048 + k * 1024); } while (0)
#define PG8_MMA(ai, bj, At, Bt) do { __builtin_amdgcn_s_setprio(1); _Pragma("unroll") for (int m = 0; m < 4; ++m) _Pragma("unroll") for (int n = 0; n < 2; ++n) _Pragma("unroll") for (int k = 0; k < 2; ++k) \
        acc[ai][bj][m][n] = __builtin_amdgcn_mfma_f32_16x16x32_bf16(Bt[n][k], At[m][k], acc[ai][bj][m][n], 0, 0, 0); __builtin_amdgcn_s_setprio(0); } while (0)
#define PG8_WAIT_V(n) asm volatile("s_waitcnt vmcnt(" #n ")" ::: "memory")
#define PG8_WAIT_L(n) asm volatile("s_waitcnt lgkmcnt(" #n ")" ::: "memory")
#define PG8_BAR __builtin_amdgcn_s_barrier()
#define PG8_SCHED __builtin_amdgcn_sched_barrier(0)
    Unit cur, nxt; int ui = 0;
    if (!S.next(0, cur)) return;
    f32x4 acc[2][2][4][2];
#pragma unroll
    for (int a = 0; a < 2; ++a)
#pragma unroll
        for (int b = 0; b < 2; ++b)
#pragma unroll
            for (int m = 0; m < 4; ++m)
#pragma unroll
                for (int n = 0; n < 2; ++n) acc[a][b][m][n] = (f32x4){0.f, 0.f, 0.f, 0.f};
    bf16x8 At[4][2], B0[2][2], B1[2][2];
    const char* cA = (const char*)g.A + (size_t)cur.pm * tstepA; const char* cB = (const char*)g.Bt + (size_t)cur.pn * tstepB;
    PG8_STAGE(PG8_SB(0, 0), cB); PG8_STAGE(PG8_SB(0, 1), cB + hstepB); PG8_STAGE(PG8_SA(0, 0), cA); PG8_STAGE(PG8_SA(0, 1), cA + hstepA);
    if (wr == 1) PG8_BAR;
    PG8_WAIT_V(2); PG8_BAR;
    PG8_STAGE(PG8_SB(1, 0), cB + kstep); PG8_STAGE(PG8_SA(1, 0), cA + kstep); PG8_STAGE(PG8_SB(1, 1), cB + hstepB + kstep);
    PG8_WAIT_V(6); PG8_BAR;
    for (;;) {
        const bool has_next = S.next(ui + 1, nxt);
        const char* nA = has_next ? (const char*)g.A + (size_t)nxt.pm * tstepA : cA; const char* nB = has_next ? (const char*)g.Bt + (size_t)nxt.pn * tstepB : cB;
        for (int t = 0; t < nt; t += 2) {
            const bool last = (t == nt - 2);
            const char* a1 = cA + (size_t)(t + 1) * kstep;
            const char* a2 = last ? nA : cA + (size_t)(t + 2) * kstep; const char* b2 = last ? nB : cB + (size_t)(t + 2) * kstep;
            const char* a3 = a2 + kstep; const char* b3 = b2 + kstep;
            PG8_LDB(B0, 0, 0); PG8_LDB(B1, 0, 1); PG8_SCHED; PG8_LDA(At, 0, 0); PG8_STAGE(PG8_SA(1, 1), a1 + hstepA);
            PG8_WAIT_V(8); PG8_WAIT_L(0); PG8_BAR; PG8_MMA(0, 0, At, B0); PG8_MMA(0, 1, At, B1); PG8_BAR; PG8_SCHED;
            PG8_LDA(At, 0, 1); PG8_STAGE(PG8_SB(0, 0), b2); PG8_STAGE(PG8_SB(0, 1), b2 + hstepB); PG8_STAGE(PG8_SA(0, 0), a2);
            PG8_WAIT_V(8); PG8_WAIT_L(0); PG8_BAR; PG8_MMA(1, 0, At, B0); PG8_MMA(1, 1, At, B1); PG8_BAR; PG8_SCHED;
            PG8_LDB(B0, 1, 0); PG8_LDB(B1, 1, 1); PG8_SCHED; PG8_LDA(At, 1, 0); PG8_STAGE(PG8_SA(0, 1), a2 + hstepA);
            PG8_WAIT_V(8); PG8_WAIT_L(0); PG8_BAR; PG8_MMA(0, 0, At, B0); PG8_MMA(0, 1, At, B1); PG8_BAR; PG8_SCHED;
            PG8_LDA(At, 1, 1); PG8_STAGE(PG8_SB(1, 0), b3); PG8_STAGE(PG8_SB(1, 1), b3 + hstepB); PG8_STAGE(PG8_SA(1, 0), a3);
            PG8_WAIT_V(8); PG8_WAIT_L(0); PG8_BAR; PG8_MMA(1, 0, At, B0); PG8_MMA(1, 1, At, B1); PG8_BAR; PG8_SCHED;
        }
        if (wr == 0) PG8_BAR;
        { int fr_e = fr, fq_e = fq, wr_e = wr, wc_e = wc; asm volatile("" : "+v"(fr_e), "+v"(fq_e), "+s"(wr_e), "+s"(wc_e));
          E(acc, cur, wr_e, wc_e, fr_e, fq_e); }
        if (!has_next) break;
#pragma unroll
        for (int a = 0; a < 2; ++a)
#pragma unroll
            for (int b = 0; b < 2; ++b)
#pragma unroll
                for (int m = 0; m < 4; ++m)
#pragma unroll
                    for (int n = 0; n < 2; ++n) acc[a][b][m][n] = (f32x4){0.f, 0.f, 0.f, 0.f};
        cur = nxt; cA = nA; cB = nB; ++ui;
        if (wr == 1) PG8_BAR;
    }
    PG8_WAIT_V(0);
    PG8_BAR;
#undef PG8_SA
#undef PG8_SB
#undef PG8_STAGE
#undef PG8_LDA
#undef PG8_LDB
#undef PG8_MMA
#undef PG8_WAIT_V
#undef PG8_WAIT_L
#undef PG8_BAR
#undef PG8_SCHED
}
}
using pg8::Unit;
typedef f32x4 Acc[2][2][4][2];

__device__ __forceinline__ void st_bf16x4(bf16_t* p, f32x4 v) { u32x2 w; w.x = cvtpk(v[0], v[1]); w.y = cvtpk(v[2], v[3]); *(u32x2*)p = w; }

template <bool PAIRED> struct EpiRes {
    const float* xin; float* xout; bf16_t* ap; u64_t* ssn; const float* gate;   const float* gmodn;
    __device__ __forceinline__ void operator()(const Acc& acc, const Unit& u, int wr, int wc, int fr, int fq) const {
        const int c = cond_of_tile(u.pm);
        const int colb = (PAIRED ? u.pn * 128 : u.pn * 256) + wc * 32 + 4 * fq;
        constexpr int NBJ = PAIRED ? 1 : 2;
        f32x4 gv[NBJ][2], gm[NBJ][2];
#pragma unroll
        for (int bj = 0; bj < NBJ; ++bj)
#pragma unroll
            for (int n = 0; n < 2; ++n) { gv[bj][n] = *(const f32x4*)(gate + (size_t)c * 6144 + colb + bj * 128 + n * 16);
                gm[bj][n] = gmodn ? *(const f32x4*)(gmodn + (size_t)c * 1024 + colb + bj * 128 + n * 16) : (f32x4){0.f, 0.f, 0.f, 0.f}; }
#pragma unroll
        for (int ai = 0; ai < 2; ++ai)
#pragma unroll
            for (int m = 0; m < 4; ++m) {
                const int r = u.pm * 256 + ai * 128 + wr * 64 + m * 16 + fr; float sq = 0.f;
#pragma unroll
                for (int bj = 0; bj < NBJ; ++bj)
#pragma unroll
                    for (int n = 0; n < 2; ++n) {
                        f32x4 o = acc[ai][bj][m][n];
                        if (PAIRED) { const f32x4 gt = acc[ai][1][m][n];
#pragma unroll
                            for (int e = 0; e < 4; ++e) o[e] = o[e] * sigm(gt[e]); }
                        const size_t off = (size_t)r * D + colb + bj * 128 + n * 16;
                        const f32x4 xo = *(const f32x4*)(xin + off) + gv[bj][n] * o;
                        *(f32x4*)(xout + off) = xo;
                        sq += (xo[0] * xo[0] + xo[1] * xo[1]) + (xo[2] * xo[2] + xo[3] * xo[3]);
                        if (gmodn) st_bf16x4(ap + off, xo * gm[bj][n]);
                    }
                sq += __shfl_xor(sq, 16); sq += __shfl_xor(sq, 32);
                if (fq == 0) atomicAdd(ssn + r, (u64_t)(sq * SS_FIX));
            }
    }
};
struct EpiUpRaw {
    const u64_t* ss; const float* sw;   bf16_t* hraw;
    __device__ __forceinline__ void operator()(const Acc& acc, const Unit& u, int wr, int wc, int fr, int fq) const {
        const int c = cond_of_tile(u.pm); const int colb = u.pn * 256 + wc * 32 + 4 * fq;
        f32x4 sv[2][2];
#pragma unroll
        for (int bj = 0; bj < 2; ++bj)
#pragma unroll
            for (int n = 0; n < 2; ++n) sv[bj][n] = *(const f32x4*)(sw + (size_t)c * SW_STRIDE + colb + bj * 128 + n * 16);
#pragma unroll
        for (int ai = 0; ai < 2; ++ai)
#pragma unroll
            for (int m = 0; m < 4; ++m) {
                const int r = u.pm * 256 + ai * 128 + wr * 64 + m * 16 + fr; const float rs = rstd_of(ss, r);
#pragma unroll
                for (int bj = 0; bj < 2; ++bj)
#pragma unroll
                    for (int n = 0; n < 2; ++n) st_bf16x4(hraw + (size_t)r * NUP + colb + bj * 128 + n * 16, acc[ai][bj][m][n] * rs + sv[bj][n]);
            }
    }
};
struct EpiQKV {
    const u64_t* ss; const float* sw; bf16_t *Q, *KB, *VB; float *outK, *outV; const float *ropec, *ropes; int j;
    __device__ __forceinline__ void operator()(const Acc& acc, const Unit& u, int wr, int wc, int fr, int fq) const {
        const int c = cond_of_tile(u.pm); const bool samp = u.pm >= 16; const int colt = u.pn * 256, cl0 = wc * 32 + 4 * fq;
        f32x4 sv[2][2];
#pragma unroll
        for (int bj = 0; bj < 2; ++bj)
#pragma unroll
            for (int n = 0; n < 2; ++n) sv[bj][n] = *(const f32x4*)(sw + (size_t)c * SW_STRIDE + colt + cl0 + bj * 128 + n * 16);
#pragma unroll
        for (int ai = 0; ai < 2; ++ai)
#pragma unroll
            for (int m = 0; m < 4; ++m) {
                const int r = u.pm * 256 + ai * 128 + wr * 64 + m * 16 + fr; const float rs = rstd_of(ss, r);
                f32x4 cs = {1.f, 1.f, 1.f, 1.f}, sn = {0.f, 0.f, 0.f, 0.f};
                if (samp && u.pn < 5) { const int t = (r - MP) & 1023, idx = t * 32 + (wc & 1) * 16 + 4 * fq; cs = *(const f32x4*)(ropec + idx); sn = *(const f32x4*)(ropes + idx); }
#pragma unroll
                for (int bj = 0; bj < 2; ++bj) {
                    f32x4 v0 = acc[ai][bj][m][0] * rs + sv[bj][0], v1 = acc[ai][bj][m][1] * rs + sv[bj][1];
                    if (u.pn < 5) { const f32x4 o0 = v0 * cs - v1 * sn, o1 = v1 * cs + v0 * sn; v0 = o0; v1 = o1; }
                    const int cl = bj * 128 + cl0;
                    if (u.pn < 4) { st_bf16x4(Q + (size_t)r * D + colt + cl, v0 * QSCALE); st_bf16x4(Q + (size_t)r * D + colt + cl + 16, v1 * QSCALE); }
                    else {
                        bf16_t* dst = (u.pn == 4 ? KB : VB) + (size_t)r * 256 + cl; st_bf16x4(dst, v0); st_bf16x4(dst + 16, v1);
                        if (!samp) { float* o = (u.pn == 4 ? outK : outV) + (((size_t)(r >> 8) * 2 + j) * 256 + (r & 255)) * 256 + cl; *(f32x4*)o = v0; *(f32x4*)(o + 16) = v1; }
                    }
                }
            }
    }
};
struct EpiHin {
    const u64_t* ss; const float* sw; const float* lb1; bf16_t *HQ, *HV, *HG; float *LFF, *LFB;
    __device__ __forceinline__ void operator()(const Acc& acc, const Unit& u, int wr, int wc, int fr, int fq) const {
        const int c = cond_of_tile(u.pm); const int seg = u.pn >> 2, colt = u.pn * 256, cl0 = wc * 32 + 4 * fq, cs0 = (u.pn & 3) * 256 + cl0;
        f32x4 sv[2][2], lbv[2][2];
#pragma unroll
        for (int bj = 0; bj < 2; ++bj)
#pragma unroll
            for (int n = 0; n < 2; ++n) { sv[bj][n] = *(const f32x4*)(sw + (size_t)c * SW_STRIDE + colt + cl0 + bj * 128 + n * 16);
                lbv[bj][n] = (seg == 2 || seg == 3) ? *(const f32x4*)(lb1 + (seg - 2) * 1024 + cs0 + bj * 128 + n * 16) : (f32x4){0.f, 0.f, 0.f, 0.f}; }
#pragma unroll
        for (int ai = 0; ai < 2; ++ai)
#pragma unroll
            for (int m = 0; m < 4; ++m) {
                const int r = u.pm * 256 + ai * 128 + wr * 64 + m * 16 + fr; const float rs = rstd_of(ss, r);
#pragma unroll
                for (int bj = 0; bj < 2; ++bj)
#pragma unroll
                    for (int n = 0; n < 2; ++n) {
                        f32x4 v = acc[ai][bj][m][n] * rs + sv[bj][n]; const size_t off = (size_t)r * D + cs0 + bj * 128 + n * 16;
                        if (seg == 0) st_bf16x4(HQ + off, v);
                        else if (seg == 1) st_bf16x4(HV + off, v);
                        else if (seg == 4) {
#pragma unroll
                            for (int e = 0; e < 4; ++e) v[e] = v[e] * sigm(v[e]);
                            st_bf16x4(HG + off, v); }
                        else { const f32x4 lb = lbv[bj][n];
#pragma unroll
                            for (int e = 0; e < 4; ++e) v[e] = __logf(lb[e] + (1.f - lb[e]) * sigm(v[e]));
                            *(f32x4*)((seg == 2 ? LFF : LFB) + off) = v; }
                    }
            }
    }
};
enum { EK_RES = 0, EK_RES_GLU, EK_UPRAW, EK_QKV, EK_HIN };
struct EpiAny {
    int kind, l, flags; unsigned char* ws; float* out;
    __device__ __forceinline__ float* F(size_t o) const { return (float*)(ws + o); }
    __device__ __forceinline__ bf16_t* H(size_t o) const { return (bf16_t*)(ws + o); }
    __device__ __forceinline__ void operator()(const Acc& acc, const Unit& u, int wr, int wc, int fr, int fq) const {
#ifndef EK_MASK
#define EK_MASK 31
#endif
        if (!((EK_MASK >> kind) & 1)) return;
        unsigned char* ws = this->ws; float* out = this->out; asm volatile("" : "+s"(ws), "+s"(out));
        auto F = [&](size_t o) { return (float*)(ws + o); }; auto H = [&](size_t o) { return (bf16_t*)(ws + o); };
        const size_t ss1 = WS_SS + (size_t)(l * 2) * M * 8, sw1 = WS_SW + (size_t)(l * 2) * 5 * SW_STRIDE * 4;
        switch (kind) {
        case EK_RES: case EK_RES_GLU: {
            const bool down = flags & 1;
            const size_t ssn = down ? WS_SS + (size_t)((l + 1) * 2) * M * 8 : ss1 + (size_t)M * 8;
            const size_t gate = WS_MOD + ((size_t)l * 5 * 6144 + (down ? 5 : 2) * 1024) * 4;
            const size_t gmn = down ? WS_GMOD + (size_t)((l + 1) * 2) * 5 * 1024 * 4 : WS_GMOD + (size_t)(l * 2 + 1) * 5 * 1024 * 4;
            const bool has_next = !(down && l == 3);
            float* xo = (flags & 2) ? out : F(WS_X); bf16_t* ap = H(WS_AP); u64_t* sp = (u64_t*)(ws + ssn);
            if (flags & 4) { const size_t dm = WS_SCR + ((flags & 8) ? 48 : 96) * MiB; xo = F(dm); ap = H(dm + 32 * MiB); sp = (u64_t*)(ws + dm + 48 * MiB); }
            if (kind == EK_RES) { EpiRes<false> E{F(WS_X), xo, ap, sp, F(gate), has_next ? F(gmn) : nullptr}; E(acc, u, wr, wc, fr, fq); }
            else { EpiRes<true> E{F(WS_X), xo, ap, sp, F(gate), F(gmn)}; E(acc, u, wr, wc, fr, fq); } } break;
        case EK_UPRAW: { EpiUpRaw E{(const u64_t*)(ws + ss1 + (size_t)M * 8), F(sw1 + (size_t)5 * SW_STRIDE * 4), H(WS_SCR + (size_t)((flags >> 2) & 1) * (88 * MiB))}; E(acc, u, wr, wc, fr, fq); } break;
        case EK_QKV: { EpiQKV E{(const u64_t*)(ws + ss1), F(sw1), H(SCR_Q), H(SCR_KB), H(SCR_VB), out + 8388608, out + 8388608 + 2097152, F(WS_ROPE), F(WS_ROPE) + 32768, l / 3}; E(acc, u, wr, wc, fr, fq); } break;
        default: { EpiHin E{(const u64_t*)(ws + ss1), F(sw1), F(WS_LB1), H(SCR_HQ), H(SCR_HV), H(SCR_HG), F(SCR_LFF), F(SCR_LFB)}; E(acc, u, wr, wc, fr, fq); } break;
        }
    }
};
}
namespace om {
#define LDS_WAIT() asm volatile("s_waitcnt lgkmcnt(0)" ::: "memory")
__device__ __forceinline__ void transpose_item(const float* W, int K, int N, bf16_t* WT, LAS float* scr, int item, int lane) {
    const int nblk = N / 32, kb = item / nblk, nb = item % nblk, k0 = 32 * kb, n0 = 32 * nb;
#pragma unroll 8
    for (int i = 0; i < 16; ++i) { const int kk = 2 * i + (lane >> 5); scr[kk * 33 + (lane & 31)] = W[(size_t)(k0 + kk) * N + n0 + (lane & 31)]; }
    LDS_WAIT(); asm volatile("" ::: "memory");
    const int c = lane & 3;
#pragma unroll
    for (int j = 0; j < 2; ++j) { const int n = (lane >> 2) + 16 * j; const LAS float* s = scr + (8 * c) * 33 + n;
        u32x4 o; o.x = cvtpk(s[0 * 33], s[1 * 33]); o.y = cvtpk(s[2 * 33], s[3 * 33]); o.z = cvtpk(s[4 * 33], s[5 * 33]); o.w = cvtpk(s[6 * 33], s[7 * 33]);
        *(u32x4*)(WT + (size_t)(n0 + n) * K + k0 + 8 * c) = o; }
    LDS_WAIT(); asm volatile("" ::: "memory");
}
__device__ __forceinline__ float modsum(const Ctx& C, int l, int c, int idx) {
    const float* mp = C.f(WS_MODP) + ((size_t)l * 5 + c) * 6144 + idx; float s = C.in(9)[l * 6144 + idx];
#pragma unroll
    for (int kp = 0; kp < 4; ++kp) s += mp[(size_t)kp * 4 * 5 * 6144];
    return s;
}
__device__ __forceinline__ void phase_p0a(const Ctx& C) {
    const int gw = C.bid * NWAVES + C.wave, NGW = C.G * NWAVES, gt = C.bid * NTHREADS + C.tid, NGT = C.G * NTHREADS;
    LAS float* scr = (LAS float*)(C.lds + C.wave * 4352);
#define DO_MAT(src, dst, K, N) for (int it = gw; it < ((K) / 32) * ((N) / 32); it += NGW) transpose_item((src), (K), (N), (dst), scr, it, C.lane)
    for (int j = 0; j < 2; ++j) { DO_MAT(C.in(12) + (size_t)j * D * NQKV, C.h(WS_WQKV) + (size_t)j * NQKV * D, D, NQKV); DO_MAT(C.in(13) + (size_t)j * D * D, C.h(WS_WO) + (size_t)j * D * D, D, D); }
    DO_MAT(C.in(15), C.h(WS_HWIN), D, NHIN); DO_MAT(C.in(18), C.h(WS_HWO), D, D); DO_MAT(C.in(27), C.h(WS_GLU), D, 2048);
    for (int l = 0; l < 4; ++l) { DO_MAT(C.in(28) + (size_t)l * D * NUP, C.h(WS_UP) + (size_t)l * NUP * D, D, NUP); DO_MAT(C.in(31) + (size_t)l * DFF * D, C.h(WS_DOWN) + (size_t)l * D * DFF, DFF, D); }
#undef DO_MAT
    __syncthreads();
    LAS float* sS = (LAS float*)(C.lds + 40960);
    LAS float* red = (LAS float*)(C.lds);
    for (int it = C.bid; it < 384; it += C.G) {
        const int l = it / 96, cb = (it % 96) >> 2, kp = it & 3;
        for (int i = C.tid; i < 5 * 256; i += NTHREADS) { const int c = i >> 8, k = kp * 256 + (i & 255); const float v = c == 0 ? C.in(7)[k] : C.in(6)[(c - 1) * 1024 + k]; sS[i] = v / (1.f + __expf(-v)); }
        __syncthreads();
        f32x4 a[5];
#pragma unroll
        for (int c = 0; c < 5; ++c) a[c] = (f32x4){0.f, 0.f, 0.f, 0.f};
        const float* wp = C.in(8) + ((size_t)l * 1024 + kp * 256 + C.wave * 32) * 6144 + cb * 256 + 4 * C.lane;
#pragma unroll 4
        for (int k = 0; k < 32; ++k) { const f32x4 w = *(const f32x4*)(wp + (size_t)k * 6144);
#pragma unroll
            for (int c = 0; c < 5; ++c) a[c] += w * sS[c * 256 + C.wave * 32 + k]; }
#pragma unroll
        for (int c = 0; c < 5; ++c) *(LAS f32x4*)(red + (C.wave * 5 + c) * 256 + 4 * C.lane) = a[c];
        __syncthreads();
        for (int i = C.tid; i < 5 * 256; i += NTHREADS) { float s = 0.f;
#pragma unroll
            for (int w = 0; w < 8; ++w) s += red[w * 1280 + i];
            C.f(WS_MODP)[(((size_t)kp * 4 + l) * 5 + (i >> 8)) * 6144 + cb * 256 + (i & 255)] = s; }
        __syncthreads();
    }
    for (int i = gt; i < 9 * M; i += NGT) ((u64_t*)(C.ws + WS_SS))[i] = 0ull;
    for (int i = gt; i < 1024 * 32; i += NGT) { const int t = i >> 5, e = i & 31, fi = e & 15; const float pos = (e >> 4) == 0 ? (float)(t >> 6) : (float)(t & 63);
        const float ang = pos * (1.0f / powf(10000.0f, (float)(2 * fi) / 32.0f)); C.f(WS_ROPE)[i] = cosf(ang); C.f(WS_ROPE)[32768 + i] = sinf(ang); }
    for (int i = gt; i < 2 * 131072; i += NGT) { const int which = i >> 17, e = (i & 131071) * 8; const float* s = (which ? C.in(3) : C.in(2)) + e; const f32x4 a = *(const f32x4*)s, b = *(const f32x4*)(s + 4);
        u32x4 o; o.x = cvtpk(a[0], a[1]); o.y = cvtpk(a[2], a[3]); o.z = cvtpk(b[0], b[1]); o.w = cvtpk(b[2], b[3]); *(u32x4*)(C.h(which ? WS_CTXV : WS_CTXK) + e) = o; }
    for (int i = gt; i < 2048; i += NGT) { float v[4], mx = -1e30f;
#pragma unroll
        for (int l = 0; l < 4; ++l) { v[l] = C.in(16)[l * 2048 + i]; mx = fmaxf(mx, v[l]); }
        float s = 0.f;
#pragma unroll
        for (int l = 0; l < 4; ++l) { v[l] = expf(v[l] - mx); s += v[l]; }
        C.f(WS_LB1)[i] = v[1] / s; }
    for (int i = gt; i < 8192; i += NGT) {
        const int dg = i >> 6, p = i & 63;
        const float ar = fminf(C.in(19)[i], -1e-4f), ai = C.in(20)[i], dt = expf(C.in(21)[dg]);
        const float e = expf(ar * dt), lr = e * cosf(ai * dt), li = e * sinf(ai * dt);
        const float den = ar * ar + ai * ai, fr = ((lr - 1.f) * ar + li * ai) / den, fi = (li * ar - (lr - 1.f) * ai) / den;
        C.f(WS_SLAM)[2 * i] = lr; C.f(WS_SLAM)[2 * i + 1] = li;
        unsigned wr_[8], wi_[8];
#pragma unroll
        for (int q = 0; q < 8; ++q) { const float x0 = C.in(22)[(size_t)i * 16 + 2 * q], y0 = C.in(23)[(size_t)i * 16 + 2 * q], x1 = C.in(22)[(size_t)i * 16 + 2 * q + 1], y1 = C.in(23)[(size_t)i * 16 + 2 * q + 1];
            wr_[q] = cvtpk(fr * x0 - fi * y0, fr * x1 - fi * y1); wi_[q] = cvtpk(fr * y0 + fi * x0, fr * y1 + fi * x1); }
        bf16_t* bb = C.h(WS_SBB) + ((size_t)dg * 128 + p) * 16;
        *(u32x4*)bb = (u32x4){wr_[0], wr_[1], wr_[2], wr_[3]}; *(u32x4*)(bb + 8) = (u32x4){wr_[4], wr_[5], wr_[6], wr_[7]};
        *(u32x4*)(bb + 64 * 16) = (u32x4){wi_[0], wi_[1], wi_[2], wi_[3]}; *(u32x4*)(bb + 64 * 16 + 8) = (u32x4){wi_[4], wi_[5], wi_[6], wi_[7]};
    }
    for (int i = gt; i < 2 * 64 * 16 * 64; i += NGT) {
        const int p = i & 63, row = i >> 6; bf16_t* cb = C.h(WS_SCB) + (size_t)row * 128;
        cb[p] = (bf16_t)(cvtpk(C.in(24)[i], 0.f) & 0xffffu); cb[64 + p] = (bf16_t)(cvtpk(-C.in(25)[i], 0.f) & 0xffffu); }
}
__device__ __forceinline__ void rows_ap_ss(const Ctx& C, const float* xsrc_p, const float* xsrc_s, float* xcopy, int l, int s, bool from_table, u64_t* ssdst) {
    for (int gw = C.bid * NWAVES + C.wave; gw < M / 4; gw += C.G * NWAVES) {
    const int r0 = gw * 4;
    const int c = cond_of_row(r0);
    f32x4 gm[4];
#pragma unroll
    for (int j = 0; j < 4; ++j) { const int n = 4 * C.lane + 256 * j;
        if (from_table) gm[j] = *(const f32x4*)(C.f(WS_GMOD) + (((size_t)l * 2 + s) * 5 + c) * 1024 + n);
        else { const float* g = (s == 0 ? C.in(10) : C.in(11)) + l * D + n;
#pragma unroll
            for (int e = 0; e < 4; ++e) gm[j][e] = g[e] * (1.f + modsum(C, l, c, (s == 0 ? 1 : 4) * 1024 + n + e)); } }
    for (int rr = 0; rr < 4; ++rr) {
        const int r = r0 + rr; const float* xr = (r < MP ? xsrc_p + (size_t)r * D : xsrc_s + (size_t)(r - MP) * D);
        f32x4 v[4]; float sq = 0.f;
#pragma unroll
        for (int j = 0; j < 4; ++j) { v[j] = *(const f32x4*)(xr + 4 * C.lane + 256 * j); sq += (v[j][0] * v[j][0] + v[j][1] * v[j][1]) + (v[j][2] * v[j][2] + v[j][3] * v[j][3]); }
        sq = wave_sum(sq);
#pragma unroll
        for (int j = 0; j < 4; ++j) { const size_t off = (size_t)r * D + 4 * C.lane + 256 * j; if (xcopy) *(f32x4*)(xcopy + off) = v[j]; st_bf16x4(C.h(WS_AP) + off, v[j] * gm[j]); }
        if (C.lane == 0) ssdst[r] = (u64_t)(sq * SS_FIX);
    }
    }
}
__device__ __forceinline__ void phase_p0c(const Ctx& C) {
    for (int vb = C.bid; vb < 256; vb += C.G) {
    if (vb < 240) {
        int ch = vb, l = 0, s = 0, N = 0; const bf16_t* Wt = nullptr;
        if (ch < 12) { l = 0; s = 0; N = NQKV; Wt = C.h(WS_WQKV); }
        else if ((ch -= 12) < 44) { l = 0; s = 1; N = NUP; Wt = C.h(WS_UP); }
        else if ((ch -= 44) < 40) { l = 1; s = 0; N = NHIN; Wt = C.h(WS_HWIN); }
        else if ((ch -= 40) < 44) { l = 1; s = 1; N = NUP; Wt = C.h(WS_UP) + (size_t)1 * NUP * D; }
        else if ((ch -= 44) < 44) { l = 2; s = 1; N = NUP; Wt = C.h(WS_UP) + (size_t)2 * NUP * D; }
        else if ((ch -= 44) < 12) { l = 3; s = 0; N = NQKV; Wt = C.h(WS_WQKV) + (size_t)1 * NQKV * D; }
        else { ch -= 12; l = 3; s = 1; N = NUP; Wt = C.h(WS_UP) + (size_t)3 * NUP * D; }
        LAS float* sh = (LAS float*)C.lds;
        for (int i = C.tid; i < 5 * 1024; i += NTHREADS) sh[i] = modsum(C, l, i >> 10, (s == 0 ? 0 : 3) * 1024 + (i & 1023));
        __syncthreads();
        for (int q = 0; q < 16; ++q) {
            const int n = ch * 128 + C.wave * 16 + q;
            const u32x4 w0 = *(const u32x4*)(Wt + (size_t)n * D + 16 * C.lane), w1 = *(const u32x4*)(Wt + (size_t)n * D + 16 * C.lane + 8);
            float wv[16];
#pragma unroll
            for (int e = 0; e < 4; ++e) { wv[2 * e] = bflo(w0[e]); wv[2 * e + 1] = bfhi(w0[e]); wv[8 + 2 * e] = bflo(w1[e]); wv[8 + 2 * e + 1] = bfhi(w1[e]); }
            float a[5];
#pragma unroll
            for (int c = 0; c < 5; ++c) { a[c] = 0.f;
#pragma unroll
                for (int e = 0; e < 16; ++e) a[c] += wv[e] * sh[c * 1024 + 16 * C.lane + e]; a[c] = wave_sum(a[c]); }
            if (C.lane == 0) {
#pragma unroll
                for (int c = 0; c < 5; ++c) C.f(WS_SW)[(((size_t)l * 2 + s) * 5 + c) * SW_STRIDE + n] = a[c]; }
        }
    } else {
        const int t = (vb - 240) * NTHREADS + C.tid, NT = 16 * NTHREADS;
        for (int i = t; i < 4 * 5 * 6144; i += NT) { const int l = i / 30720, c = (i / 6144) % 5, idx = i % 6144; C.f(WS_MOD)[i] = modsum(C, l, c, idx); }
        for (int i = t; i < 4 * 2 * 5 * 1024; i += NT) { const int n = i & 1023, c = (i >> 10) % 5, s = (i / 5120) & 1, l = i / 10240;
            C.f(WS_GMOD)[i] = (s == 0 ? C.in(10) : C.in(11))[l * D + n] * (1.f + modsum(C, l, c, (s == 0 ? 1 : 4) * 1024 + n)); }
    }
    __syncthreads();
    }
    rows_ap_ss(C, C.in(0), C.in(1), C.f(WS_X), 0, 0, false, (u64_t*)(C.ws + WS_SS));
}
__device__ __forceinline__ void phase_glue(const Ctx& C, int l, int s) { rows_ap_ss(C, C.f(WS_X), C.f(WS_X) + (size_t)MP * D, nullptr, l, s, true, (u64_t*)(C.ws + WS_SS) + (size_t)(l * 2 + s) * M); }

__device__ __forceinline__ void phase_conv(const Ctx& C, int l) {
    const bf16_t* h = C.h(WS_SCR); bf16_t* act = C.h(WS_ACT); const float* cw = C.in(29) + (size_t)l * 3 * NUP; const float* cb = C.in(30) + (size_t)l * NUP;
    const int gt = C.bid * NTHREADS + C.tid, NGT = C.G * NTHREADS;
    for (int i = gt; i < M * (DFF / 8); i += NGT) {
        const int r = i / (DFF / 8), n = (i % (DFF / 8)) * 8;
        int t, S; if (r < MP) { t = r & 255; S = 256; } else { t = (r - MP) & 1023; S = 1024; }
        float g[8], v[8];
#pragma unroll
        for (int e = 0; e < 8; ++e) { g[e] = cb[n + e]; v[e] = cb[DFF + n + e]; }
#pragma unroll
        for (int jj = 0; jj < 3; ++jj) { const int tt = t + jj - 1; if (tt >= 0 && tt < S) {
            const u32x4 hg = *(const u32x4*)(h + (size_t)(r + jj - 1) * NUP + n), hv = *(const u32x4*)(h + (size_t)(r + jj - 1) * NUP + DFF + n);
#pragma unroll
            for (int e = 0; e < 4; ++e) { g[2 * e] += cw[jj * NUP + n + 2 * e] * bflo(hg[e]); g[2 * e + 1] += cw[jj * NUP + n + 2 * e + 1] * bfhi(hg[e]);
                v[2 * e] += cw[jj * NUP + DFF + n + 2 * e] * bflo(hv[e]); v[2 * e + 1] += cw[jj * NUP + DFF + n + 2 * e + 1] * bfhi(hv[e]); } } }
        u32x4 o;
#pragma unroll
        for (int e = 0; e < 4; ++e) o[e] = cvtpk(g[2 * e] * sigm(g[2 * e]) * v[2 * e], g[2 * e + 1] * sigm(g[2 * e + 1]) * v[2 * e + 1]);
        *(u32x4*)(act + (size_t)r * DFF + n) = o;
    }
}
__device__ __forceinline__ void phase_final(const Ctx& C, float dbg) {
    const int gw = C.bid * NWAVES + C.wave, NGW = C.G * NWAVES; const u64_t* ss = (const u64_t*)(C.ws + WS_SS) + (size_t)8 * M;
    for (int r = gw; r < M; r += NGW) { const float rs = rstd_of(ss, r);
#pragma unroll
        for (int j = 0; j < 4; ++j) { const int n = 4 * C.lane + 256 * j; float* p = C.out + (size_t)r * D + n; *(f32x4*)p = *(const f32x4*)p * (rs * dbg) * *(const f32x4*)(C.in(32) + n); } }
}
}
namespace om {
__device__ __forceinline__ int rowidx(int r, int h) { return (r & 3) + 8 * (r >> 2) + 4 * h; }
__device__ __forceinline__ float xhalf(float v) {
    auto rr = __builtin_amdgcn_permlane32_swap(__float_as_uint(v), __float_as_uint(v), false, false);
    return __uint_as_float((threadIdx.x & 32) ? rr[0] : rr[1]);
}
__device__ __forceinline__ bf16x8 pack8(const f32x16& x, int base) {
    u32x4 w; w.x = cvtpk(x[base], x[base + 1]); w.y = cvtpk(x[base + 2], x[base + 3]); w.z = cvtpk(x[base + 4], x[base + 5]); w.w = cvtpk(x[base + 6], x[base + 7]);
    return __builtin_bit_cast(bf16x8, w);
}
__device__ __forceinline__ bf16x8 cat44(u32x2 a, u32x2 b) { u32x4 w = {a.x, a.y, b.x, b.y}; return __builtin_bit_cast(bf16x8, w); }

constexpr int AT_KSTR = 144;
constexpr int AT_BUF = 2 * 64 * AT_KSTR;
__device__ __forceinline__ void attn_unit(const Ctx& C, int j, bool samp, int b, int hq, int qb, size_t obuf) {
    const int lane = C.lane, c = lane & 31, h = lane >> 5, w = C.wave, kvh = hq >> 2;
    const int rowbase = samp ? MP + b * 1024 : b * 256, q0 = qb * 256, qlo = q0 + 32 * w;
    const bf16_t* Q = C.h(SCR_Q); const bf16_t* KB = C.h(SCR_KB); const bf16_t* VB = C.h(SCR_VB);
    const bf16_t* CK = C.h(WS_CTXK) + ((size_t)(b * 2 + j) * 512) * 256; const bf16_t* CV = C.h(WS_CTXV) + ((size_t)(b * 2 + j) * 512) * 256;
    int klo = 0, nlat = 4, NT = 4;
    if (samp) { klo = q0 - 128 < 0 ? 0 : q0 - 128; const int khi = q0 + 384 > 1024 ? 1024 : q0 + 384; nlat = (khi - klo) >> 6; NT = nlat + 8; }
    bf16x8 qf[4];
#pragma unroll
    for (int s = 0; s < 4; ++s) qf[s] = *(const bf16x8*)(Q + (size_t)(rowbase + qlo + c) * D + hq * 64 + 16 * s + 8 * h);
    float m = C.in(14)[j * 16 + hq] * LOG2E, lsum = h == 0 ? 1.f : 0.f;
    f32x16 o0 = {}, o1 = {};
    const int lkey = C.tid >> 3, lch = C.tid & 7;
    auto src_k = [&](int t) -> const bf16_t* { return (t < nlat ? KB + (size_t)(rowbase + klo + 64 * t + lkey) * 256 : CK + (size_t)(64 * (t - nlat) + lkey) * 256) + kvh * 64 + lch * 8; };
    auto src_v = [&](int t) -> const bf16_t* { return (t < nlat ? VB + (size_t)(rowbase + klo + 64 * t + lkey) * 256 : CV + (size_t)(64 * (t - nlat) + lkey) * 256) + kvh * 64 + lch * 8; };
    auto put = [&](int buf, u32x4 kr, u32x4 vr) {
        LAS unsigned char* kb = C.lds + buf * AT_BUF; LAS unsigned char* vb = kb + 64 * AT_KSTR;
        *(LAS u32x4*)(kb + lkey * AT_KSTR + lch * 16) = kr;
#pragma unroll
        for (int e = 0; e < 4; ++e) { *(LAS unsigned short*)(vb + (lch * 8 + 2 * e) * AT_KSTR + lkey * 2) = (unsigned short)(vr[e] & 0xffffu); *(LAS unsigned short*)(vb + (lch * 8 + 2 * e + 1) * AT_KSTR + lkey * 2) = (unsigned short)(vr[e] >> 16); }
    };
    { const u32x4 kr = *(const u32x4*)src_k(0), vr = *(const u32x4*)src_v(0); put(0, kr, vr); }
    __syncthreads();
    for (int t = 0; t < NT; ++t) {
        u32x4 kr = {}, vr = {};
        if (t + 1 < NT) { kr = *(const u32x4*)src_k(t + 1); vr = *(const u32x4*)src_v(t + 1); }
        const bool lat = samp && t < nlat; const int key0 = klo + 64 * t;
        const bool skip = lat && (key0 > qlo + 31 + 128 || key0 + 63 < qlo - 128);
        if (!skip) {
            LAS unsigned char* kb = C.lds + (t & 1) * AT_BUF; LAS unsigned char* vb = kb + 64 * AT_KSTR;
            f32x16 x0 = {}, x1 = {};
#pragma unroll
            for (int s = 0; s < 4; ++s) {
                const bf16x8 a0 = *(const LAS bf16x8*)(kb + c * AT_KSTR + (16 * s + 8 * h) * 2), a1 = *(const LAS bf16x8*)(kb + (32 + c) * AT_KSTR + (16 * s + 8 * h) * 2);
                x0 = __builtin_amdgcn_mfma_f32_32x32x16_bf16(a0, qf[s], x0, 0, 0, 0); x1 = __builtin_amdgcn_mfma_f32_32x32x16_bf16(a1, qf[s], x1, 0, 0, 0);
            }
            if (lat && !(key0 >= qlo + 31 - 128 && key0 + 63 <= qlo + 128)) {
                const int tq = qlo + c;
#pragma unroll
                for (int r = 0; r < 16; ++r) { const int k0 = key0 + rowidx(r, h) - tq; if (k0 > 128 || k0 < -128) x0[r] = -INFINITY; if (k0 + 32 > 128 || k0 + 32 < -128) x1[r] = -INFINITY; }
            }
            float mx = fmaxf(x0[0], x1[0]);
#pragma unroll
            for (int r = 1; r < 16; ++r) mx = fmaxf(mx, fmaxf(x0[r], x1[r]));
            mx = fmaxf(mx, xhalf(mx));
            const float mn = fmaxf(m, mx), al = __builtin_amdgcn_exp2f(m - mn); m = mn;
            float ps = 0.f;
#pragma unroll
            for (int r = 0; r < 16; ++r) { x0[r] = __builtin_amdgcn_exp2f(x0[r] - mn); x1[r] = __builtin_amdgcn_exp2f(x1[r] - mn); ps += x0[r] + x1[r]; }
            lsum = lsum * al + ps;
#pragma unroll
            for (int r = 0; r < 16; ++r) { o0[r] *= al; o1[r] *= al; }
#pragma unroll
            for (int ks = 0; ks < 2; ++ks) {
                const bf16x8 p0 = pack8(x0, 8 * ks), p1 = pack8(x1, 8 * ks);
#pragma unroll
                for (int dt = 0; dt < 2; ++dt) {
                    const LAS unsigned char* vrow = vb + (32 * dt + c) * AT_KSTR + (16 * ks + 4 * h) * 2;
                    const bf16x8 v0 = cat44(*(const LAS u32x2*)(vrow), *(const LAS u32x2*)(vrow + 16)), v1 = cat44(*(const LAS u32x2*)(vrow + 64), *(const LAS u32x2*)(vrow + 80));
                    if (dt == 0) { o0 = __builtin_amdgcn_mfma_f32_32x32x16_bf16(v0, p0, o0, 0, 0, 0); o0 = __builtin_amdgcn_mfma_f32_32x32x16_bf16(v1, p1, o0, 0, 0, 0); }
                    else { o1 = __builtin_amdgcn_mfma_f32_32x32x16_bf16(v0, p0, o1, 0, 0, 0); o1 = __builtin_amdgcn_mfma_f32_32x32x16_bf16(v1, p1, o1, 0, 0, 0); }
                }
            }
        }
        if (t + 1 < NT) put((t + 1) & 1, kr, vr);
        __syncthreads();
    }
    lsum += xhalf(lsum);
    const float il = 1.f / lsum;
    bf16_t* O = C.h(obuf) + (size_t)(rowbase + qlo + c) * D + hq * 64 + 4 * h;
#pragma unroll
    for (int g = 0; g < 4; ++g) { st_bf16x4(O + 8 * g, (f32x4){o0[4 * g], o0[4 * g + 1], o0[4 * g + 2], o0[4 * g + 3]} * il); st_bf16x4(O + 32 + 8 * g, (f32x4){o1[4 * g], o1[4 * g + 1], o1[4 * g + 2], o1[4 * g + 3]} * il); }
}
__device__ __forceinline__ void phase_attn(const Ctx& C, int l, size_t obuf) {
    const int j = l / 3;
    for (int u = C.bid; u < 512; u += C.G) {
        if (u < 256) attn_unit(C, j, false, u >> 4, u & 15, 0, obuf);
        else { const int v = u - 256; attn_unit(C, j, true, v >> 6, (v >> 2) & 15, v & 3, obuf); }
    }
}
constexpr size_t CKS_TAB = 376 * MiB; constexpr int CKS_NW = (int)((268 * MiB) / 65536), CKS_NO = (17039360 * 4) / 65536, CKS_N = CKS_NW + CKS_NO;
__device__ __forceinline__ void phase_cks(const Ctx& C, int slot) {
    const int gw = C.bid * NWAVES + C.wave, NGW = C.G * NWAVES; unsigned* tab = (unsigned*)(C.ws + CKS_TAB) + (size_t)slot * 8192;
    for (int ck = gw; ck < CKS_N; ck += NGW) {
        const unsigned char* base = ck < CKS_NW ? C.ws + 108 * MiB + (size_t)ck * 65536 : (const unsigned char*)C.out + (size_t)(ck - CKS_NW) * 65536; unsigned s = 0;
        for (int i = 0; i < 64; ++i) { const u32x4 v = *(const u32x4*)(base + (size_t)i * 1024 + C.lane * 16); s += v[0] + v[1] * 3u + v[2] * 5u + v[3] * 7u; }
#pragma unroll
        for (int o = 1; o < 64; o <<= 1) s += (unsigned)__shfl_xor((int)s, o);
        if (C.lane == 0) tab[ck] = s;
    }
}
__device__ __forceinline__ void phase_clr(const Ctx& C) {
    const int gt = C.bid * NTHREADS + C.tid, NGT = C.G * NTHREADS; const u32x4 z = {0u, 0u, 0u, 0u};
    for (size_t i = gt; i < (268 * MiB) / 16; i += NGT) *(u32x4*)(C.ws + 108 * MiB + i * 16) = z;
    for (size_t i = gt; i < (size_t)17039360 / 4; i += NGT) *(u32x4*)((unsigned char*)C.out + i * 16) = z;
}
__device__ __forceinline__ void phase_clr2(const Ctx& C, size_t off, size_t bytes) {
    const int gt = C.bid * NTHREADS + C.tid, NGT = C.G * NTHREADS; const u32x4 z = {0u, 0u, 0u, 0u};
    for (size_t i = gt; i < bytes / 16; i += NGT) *(u32x4*)(C.ws + off + i * 16) = z;
}
__device__ __forceinline__ void phase_cmp(const Ctx& C, int nslots) {
    const int gt = C.bid * NTHREADS + C.tid, NGT = C.G * NTHREADS; const unsigned* tab = (const unsigned*)(C.ws + CKS_TAB);
    for (int i = gt; i < nslots * 8192; i += NGT) { const int sl = i >> 13, ck = i & 8191; if (ck < CKS_N && tab[(size_t)sl * 8192 + ck] != tab[(size_t)(sl + 32) * 8192 + ck]) {
#ifdef SSDET
        const int cls = ck >= CKS_NW ? 4 : (ck < 1472 + 512 ? 1 : 2); atomicOr((unsigned*)(C.ws + WS_CTL) + 4002, (unsigned)cls); atomicAdd((unsigned*)(C.ws + WS_CTL) + 4003, 1u);
#endif
        atomicMax((unsigned*)(C.ws + WS_CTL) + 4001, (unsigned)(1000 - sl)); } }
}
__device__ __forceinline__ void phase_chk(const Ctx& C, size_t a, size_t b, size_t bytes) {
    const int gt = C.bid * NTHREADS + C.tid, NGT = C.G * NTHREADS; unsigned bad = 0;
    for (size_t i = gt; i < bytes / 16; i += NGT) { const u32x4 x = *(const u32x4*)(C.ws + a + i * 16), y = *(const u32x4*)(C.ws + b + i * 16); bad += (x[0] != y[0]) | (x[1] != y[1]) | (x[2] != y[2]) | (x[3] != y[3]); }
    if (bad) atomicAdd((unsigned*)(C.ws + WS_CTL) + 4000, bad);
}

constexpr int HS_QSTR = 272, HS_TSTR = 80;
constexpr int HS_QT = 0, HS_KT = 32 * HS_QSTR, HS_KTT = 2 * 32 * HS_QSTR, HS_VT = HS_KTT + 128 * HS_TSTR, HS_E1 = HS_VT + 128 * HS_TSTR, HS_E2 = HS_E1 + 512, HS_T1 = HS_E2 + 512, HS_GRP = HS_T1 + 512;
__device__ __forceinline__ void hscan_item(const Ctx& C, int item, int gi) {
    const bool samp = item < 64; const int it = samp ? item : item - 64;
    const int dir = it & 1, hd = (it >> 1) & 7, sq = it >> 4;
    const int S = samp ? 1024 : 256, rowbase = samp ? MP + sq * 1024 : sq * 256, nchunk = S >> 5;
    const int tg = C.tid & 255, lane = C.lane, c = lane & 31, h = lane >> 5, w4 = C.wave & 3;
    LAS unsigned char* L = C.lds + gi * HS_GRP;
    const bf16_t* HQ = C.h(SCR_HQ); const bf16_t* HV = C.h(SCR_HV); const float* LF = C.f(dir == 0 ? SCR_LFF : SCR_LFB); float* OD = C.f(dir == 0 ? SCR_OF : SCR_OB);
    f32x16 St[4];
#pragma unroll
    for (int dt = 0; dt < 4; ++dt) {
        if (samp) { const float* s0 = C.in(4) + ((((size_t)sq * 2 + dir) * 8 + hd) * 128) * 128;
#pragma unroll
            for (int r = 0; r < 16; ++r) St[dt][r] = s0[(size_t)(32 * dt + rowidx(r, h)) * 128 + 32 * w4 + c]; }
        else St[dt] = (f32x16){};
    }
    const int pd = tg & 127, ph = tg >> 7;
    for (int ch = 0; ch < nchunk; ++ch) {
        float cl[16], qv[16], kv[16];
        {
            float run = 0.f;
#pragma unroll
            for (int i = 0; i < 16; ++i) { const int pos = 32 * ch + 16 * ph + i, t = dir == 0 ? pos : S - 1 - pos; const size_t off = (size_t)(rowbase + t) * D + hd * 128 + pd;
                const float lf = LF[off]; run += lf; cl[i] = run; kv[i] = 1.f - __expf(lf); qv[i] = bf2f(HQ[off]); }
            if (ph == 0) *(LAS float*)(L + HS_T1 + pd * 4) = run;
        }
        unsigned vtw[8];
#pragma unroll
        for (int i = 0; i < 8; ++i) { const int pos = 32 * ch + 16 * ph + 2 * i, t0 = dir == 0 ? pos : S - 1 - pos, t1 = dir == 0 ? pos + 1 : S - 2 - pos;
            vtw[i] = (unsigned)HV[(size_t)(rowbase + t0) * D + hd * 128 + pd] | ((unsigned)HV[(size_t)(rowbase + t1) * D + hd * 128 + pd] << 16); }
        __syncthreads();
        {
            const float t1v = *(LAS float*)(L + HS_T1 + pd * 4);
            unsigned ktw[8];
#pragma unroll
            for (int i = 0; i < 16; i += 2) {
                const float e0 = ph == 0 ? cl[i] - t1v : cl[i], e1 = ph == 0 ? cl[i + 1] - t1v : cl[i + 1];
                const float q0 = qv[i] * __expf(e0), q1 = qv[i + 1] * __expf(e1), k0 = kv[i] * __expf(-e0), k1 = kv[i + 1] * __expf(-e1);
                const unsigned qw0 = cvtpk(q0, 0.f), qw1 = cvtpk(q1, 0.f), kw = cvtpk(k0, k1);
                *(LAS unsigned short*)(L + HS_QT + (16 * ph + i) * HS_QSTR + pd * 2) = (unsigned short)qw0; *(LAS unsigned short*)(L + HS_QT + (16 * ph + i + 1) * HS_QSTR + pd * 2) = (unsigned short)qw1;
                *(LAS unsigned short*)(L + HS_KT + (16 * ph + i) * HS_QSTR + pd * 2) = (unsigned short)(kw & 0xffffu); *(LAS unsigned short*)(L + HS_KT + (16 * ph + i + 1) * HS_QSTR + pd * 2) = (unsigned short)(kw >> 16);
                ktw[i >> 1] = kw;
            }
            *(LAS u32x4*)(L + HS_KTT + pd * HS_TSTR + ph * 32) = (u32x4){ktw[0], ktw[1], ktw[2], ktw[3]}; *(LAS u32x4*)(L + HS_KTT + pd * HS_TSTR + ph * 32 + 16) = (u32x4){ktw[4], ktw[5], ktw[6], ktw[7]};
            *(LAS u32x4*)(L + HS_VT + pd * HS_TSTR + ph * 32) = (u32x4){vtw[0], vtw[1], vtw[2], vtw[3]}; *(LAS u32x4*)(L + HS_VT + pd * HS_TSTR + ph * 32 + 16) = (u32x4){vtw[4], vtw[5], vtw[6], vtw[7]};
            if (ph == 0) *(LAS float*)(L + HS_E1 + pd * 4) = __expf(t1v); else *(LAS float*)(L + HS_E2 + pd * 4) = __expf(cl[15]);
        }
        __syncthreads();
#pragma unroll
        for (int dt = 0; dt < 4; ++dt)
#pragma unroll
            for (int g = 0; g < 4; ++g) { const f32x4 e = *(const LAS f32x4*)(L + HS_E1 + (32 * dt + 8 * g + 4 * h) * 4);
#pragma unroll
                for (int q = 0; q < 4; ++q) St[dt][4 * g + q] *= e[q]; }
        f32x16 X = {};
#pragma unroll
        for (int s = 0; s < 8; ++s) {
            const bf16x8 a = *(const LAS bf16x8*)(L + HS_KT + c * HS_QSTR + (16 * s + 8 * h) * 2), bq = *(const LAS bf16x8*)(L + HS_QT + c * HS_QSTR + (16 * s + 8 * h) * 2);
            X = __builtin_amdgcn_mfma_f32_32x32x16_bf16(a, bq, X, 0, 0, 0);
        }
#pragma unroll
        for (int r = 0; r < 16; ++r) if (rowidx(r, h) > c) X[r] = 0.f;
        f32x16 OT = {};
#pragma unroll
        for (int ks = 0; ks < 2; ++ks) {
            const LAS unsigned char* vrow = L + HS_VT + (32 * w4 + c) * HS_TSTR + (16 * ks + 4 * h) * 2;
            const bf16x8 va = cat44(*(const LAS u32x2*)(vrow), *(const LAS u32x2*)(vrow + 16));
            OT = __builtin_amdgcn_mfma_f32_32x32x16_bf16(va, pack8(X, 8 * ks), OT, 0, 0, 0);
        }
#pragma unroll
        for (int dt = 0; dt < 4; ++dt)
#pragma unroll
            for (int ks = 0; ks < 2; ++ks) {
                const LAS unsigned char* qrow = L + HS_QT + c * HS_QSTR + (32 * dt + 16 * ks + 4 * h) * 2;
                const bf16x8 bq = cat44(*(const LAS u32x2*)(qrow), *(const LAS u32x2*)(qrow + 16));
                OT = __builtin_amdgcn_mfma_f32_32x32x16_bf16(pack8(St[dt], 8 * ks), bq, OT, 0, 0, 0);
            }
#pragma unroll
        for (int dt = 0; dt < 4; ++dt)
#pragma unroll
            for (int ks = 0; ks < 2; ++ks) {
                const bf16x8 a = *(const LAS bf16x8*)(L + HS_KTT + (32 * dt + c) * HS_TSTR + (16 * ks + 8 * h) * 2), bv = *(const LAS bf16x8*)(L + HS_VT + (32 * w4 + c) * HS_TSTR + (16 * ks + 8 * h) * 2);
                St[dt] = __builtin_amdgcn_mfma_f32_32x32x16_bf16(a, bv, St[dt], 0, 0, 0);
            }
#pragma unroll
        for (int dt = 0; dt < 4; ++dt)
#pragma unroll
            for (int g = 0; g < 4; ++g) { const f32x4 e = *(const LAS f32x4*)(L + HS_E2 + (32 * dt + 8 * g + 4 * h) * 4);
#pragma unroll
                for (int q = 0; q < 4; ++q) St[dt][4 * g + q] *= e[q]; }
        { const int pos = 32 * ch + c, t = dir == 0 ? pos : S - 1 - pos; float* op = OD + (size_t)(rowbase + t) * D + hd * 128 + 32 * w4 + 4 * h;
#pragma unroll
            for (int g = 0; g < 4; ++g) *(f32x4*)(op + 8 * g) = (f32x4){OT[4 * g], OT[4 * g + 1], OT[4 * g + 2], OT[4 * g + 3]}; }
    }
    if (!samp) { float* so = C.out + 8388608 + 2 * 2097152 + ((((size_t)sq * 2 + dir) * 8 + hd) * 128) * 128;
#pragma unroll
        for (int dt = 0; dt < 4; ++dt)
#pragma unroll
            for (int r = 0; r < 16; ++r) so[(size_t)(32 * dt + rowidx(r, h)) * 128 + 32 * w4 + c] = St[dt][r]; }
}
__device__ __forceinline__ void phase_hscan(const Ctx& C) {
    for (int it = C.bid; it < 320; it += C.G) {
        int item = it;
        if (C.G == 256 && it >= 256) item = -1;
        if (item >= 0) { if (C.wave < 4) hscan_item(C, item, 0); else { const int nc = item < 64 ? 32 : 8; for (int q = 0; q < 2 * nc; ++q) __syncthreads(); } __syncthreads(); }
    }
    if (C.G == 256 && C.bid >= 64 && C.bid < 128) { const int item = 256 + (C.bid - 64);
        if (C.wave < 4) hscan_item(C, item, 0); else { for (int q = 0; q < 16; ++q) __syncthreads(); } __syncthreads(); }
}
__device__ __forceinline__ void phase_hpost(const Ctx& C) {
    const int gw = C.bid * NWAVES + C.wave, NGW = C.G * NWAVES;
    for (int r = gw; r < M; r += NGW) {
        const size_t off = (size_t)r * D + 16 * C.lane; float o[16]; float sq = 0.f;
#pragma unroll
        for (int q = 0; q < 4; ++q) { const f32x4 a = *(const f32x4*)(C.f(SCR_OF) + off + 4 * q), b = *(const f32x4*)(C.f(SCR_OB) + off + 4 * q);
#pragma unroll
            for (int e = 0; e < 4; ++e) { o[4 * q + e] = a[e] + b[e]; sq += o[4 * q + e] * o[4 * q + e]; } }
        sq += __shfl_xor(sq, 1); sq += __shfl_xor(sq, 2); sq += __shfl_xor(sq, 4);
        const float rs = rsqrtf(sq * (1.f / 128.f) + EPS);
        const u32x4 g0 = *(const u32x4*)(C.h(SCR_HG) + off), g1 = *(const u32x4*)(C.h(SCR_HG) + off + 8);
        const float* gn = C.in(17) + (16 * C.lane & 127);
        float sg[16];
#pragma unroll
        for (int e = 0; e < 4; ++e) { sg[2 * e] = bflo(g0[e]); sg[2 * e + 1] = bfhi(g0[e]); sg[8 + 2 * e] = bflo(g1[e]); sg[8 + 2 * e + 1] = bfhi(g1[e]); }
        u32x4 w0, w1;
#pragma unroll
        for (int e = 0; e < 4; ++e) { w0[e] = cvtpk(o[2 * e] * rs * gn[2 * e] * sg[2 * e], o[2 * e + 1] * rs * gn[2 * e + 1] * sg[2 * e + 1]);
            w1[e] = cvtpk(o[8 + 2 * e] * rs * gn[8 + 2 * e] * sg[8 + 2 * e], o[8 + 2 * e + 1] * rs * gn[8 + 2 * e + 1] * sg[8 + 2 * e + 1]); }
        *(u32x4*)(C.h(SCR_AWO) + off) = w0; *(u32x4*)(C.h(SCR_AWO) + off + 8) = w1;
    }
}

constexpr int SS_RSTR = 512;
constexpr int SS_WAVE = 16 * SS_RSTR;
__device__ __forceinline__ void sscan_seq(const Ctx& C, int l, bool samp, int sq, int dir, int g, size_t ydbg) {
    const int lane = C.lane, c = lane & 31, h = lane >> 5, dg = dir * 64 + g;
    const int S = samp ? 1024 : 256, rowbase = samp ? MP + sq * 1024 : sq * 256, nchunk = S >> 5, cond = samp ? 1 + sq : 0;
    LAS unsigned char* LB = C.lds + C.wave * SS_WAVE; LAS unsigned char* LH = LB + 4096;
    const float* X = C.f(WS_X); const u64_t* ss = (const u64_t*)(C.ws + WS_SS) + (size_t)(l * 2) * M; float* Y = C.f(ydbg ? ydbg : (dir == 0 ? SCR_YF : SCR_YB)); const bool ywr = !ydbg || dir == 0;
    bf16x8 bfr[4], cfr[4];
#pragma unroll
    for (int ct = 0; ct < 4; ++ct) bfr[ct] = *(const bf16x8*)(C.h(WS_SBB) + ((size_t)dg * 128 + 32 * ct + c) * 16 + 8 * h);
#pragma unroll
    for (int s = 0; s < 4; ++s) cfr[s] = *(const bf16x8*)(C.h(WS_SCB) + ((size_t)dg * 16 + (lane & 15)) * 128 + 32 * s + 8 * (lane >> 4));
    const float lr = C.f(WS_SLAM)[2 * (dg * 64 + lane)], li = C.f(WS_SLAM)[2 * (dg * 64 + lane) + 1];
    f32x4 gm0, gm1, sh0, sh1;
    { const float* gm = C.f(WS_GMOD) + ((size_t)(l * 2) * 5 + cond) * 1024 + g * 16 + 8 * h; gm0 = *(const f32x4*)gm; gm1 = *(const f32x4*)(gm + 4);
      const float* sh = C.f(WS_MOD) + ((size_t)l * 5 + cond) * 6144 + g * 16 + 8 * h; sh0 = *(const f32x4*)sh; sh1 = *(const f32x4*)(sh + 4); }
    float hr = 0.f, hi = 0.f;
    if (samp) { const float* s0 = C.in(5) + ((((size_t)sq * 2 + dir) * 64 + g) * 64 + lane) * 2; hr = s0[0]; hi = s0[1]; }
    for (int ch = 0; ch < nchunk; ++ch) {
        const int pos = 32 * ch + c, t = dir == 0 ? pos : S - 1 - pos, r = rowbase + t;
        const float rs = rstd_of(ss, r);
        const f32x4 x0 = *(const f32x4*)(X + (size_t)r * D + g * 16 + 8 * h), x1 = *(const f32x4*)(X + (size_t)r * D + g * 16 + 8 * h + 4);
        const f32x4 u0 = x0 * rs * gm0 + sh0, u1 = x1 * rs * gm1 + sh1;
        u32x4 uw = {cvtpk(u0[0], u0[1]), cvtpk(u0[2], u0[3]), cvtpk(u1[0], u1[1]), cvtpk(u1[2], u1[3])};
        const bf16x8 uf = __builtin_bit_cast(bf16x8, uw);
        f32x16 bu[4];
#pragma unroll
        for (int ct = 0; ct < 4; ++ct) { bu[ct] = (f32x16){}; bu[ct] = __builtin_amdgcn_mfma_f32_32x32x16_bf16(uf, bfr[ct], bu[ct], 0, 0, 0); }
#pragma unroll
        for (int hf = 0; hf < 2; ++hf) {
#pragma unroll
            for (int t8 = 0; t8 < 2; ++t8) {
#pragma unroll
                for (int ct = 0; ct < 4; ++ct)
#pragma unroll
                    for (int r4 = 0; r4 < 4; ++r4) *(LAS float*)(LB + (4 * h + r4) * 512 + (32 * ct + c) * 4) = bu[ct][8 * hf + 4 * t8 + r4];
                float br[8], bi[8]; unsigned wv[8];
#pragma unroll
                for (int k = 0; k < 8; ++k) { br[k] = *(LAS float*)(LB + k * 512 + lane * 4); bi[k] = *(LAS float*)(LB + k * 512 + 256 + lane * 4); }
#pragma unroll
                for (int k = 0; k < 8; ++k) { const float nr = lr * hr - li * hi + br[k], ni = lr * hi + li * hr + bi[k]; hr = nr; hi = ni; wv[k] = cvtpk(hr, hi); }
#pragma unroll
                for (int k = 0; k < 8; ++k) { const int row = 8 * t8 + k;
                    *(LAS unsigned short*)(LH + row * 256 + ((((lane >> 3)) ^ row) << 4) + (lane & 7) * 2) = (unsigned short)(wv[k] & 0xffffu);
                    *(LAS unsigned short*)(LH + row * 256 + (((8 + (lane >> 3)) ^ row) << 4) + (lane & 7) * 2) = (unsigned short)(wv[k] >> 16); }
                LDS_WAIT();
            }
            f32x4 y0 = {};
#pragma unroll
            for (int s = 0; s < 4; ++s) {
                const bf16x8 a0 = *(const LAS bf16x8*)(LH + (lane & 15) * 256 + (((4 * s + (lane >> 4)) ^ (lane & 15)) << 4));
                y0 = __builtin_amdgcn_mfma_f32_16x16x32_bf16(a0, cfr[s], y0, 0, 0, 0);
            }
            if (ywr) {
#pragma unroll
                for (int q = 0; q < 4; ++q) { const int p0 = 32 * ch + 16 * hf + 4 * (lane >> 4) + q, t0 = dir == 0 ? p0 : S - 1 - p0; Y[(size_t)(rowbase + t0) * D + g * 16 + (lane & 15)] = y0[q]; }
            }
            LDS_WAIT();
        }
    }
    if (!samp && !ydbg) { float* so = C.out + 8388608 + 2 * 2097152 + 4194304 + ((((size_t)sq * 2 + dir) * 64 + g) * 64 + lane) * 2; so[0] = hr; so[1] = hi; }
}
__device__ __forceinline__ void phase_sscan(const Ctx& C, int l, size_t ydbg) {
    for (int bb = C.bid; bb < 256; bb += C.G) {
        const int w = C.wave;
#ifdef SS_ONLYWAVE
        if (ydbg && !((SS_ONLYWAVE >> w) & 1)) continue;
#endif
        if (w < 2) { const int id = 2 * bb + w; sscan_seq(C, l, true, id >> 7, (id >> 6) & 1, id & 63, ydbg); }
        else { int id = 8 * bb + (w - 2); sscan_seq(C, l, false, id >> 7, (id >> 6) & 1, id & 63, ydbg);
            if (w < 4) { id = 8 * bb + 6 + (w - 2); sscan_seq(C, l, false, id >> 7, (id >> 6) & 1, id & 63, ydbg); } }
    }
}
__device__ __forceinline__ void phase_spost(const Ctx& C, int l) {
    const int gw = C.bid * NWAVES + C.wave, NGW = C.G * NWAVES; const u64_t* ss = (const u64_t*)(C.ws + WS_SS) + (size_t)(l * 2) * M;
    for (int r = gw; r < M; r += NGW) {
        const int cond = cond_of_row(r); const float rs = rstd_of(ss, r);
#pragma unroll
        for (int jq = 0; jq < 4; ++jq) {
            const int n = 4 * C.lane + 256 * jq; const size_t off = (size_t)r * D + n;
            const f32x4 x = *(const f32x4*)(C.f(WS_X) + off), gm = *(const f32x4*)(C.f(WS_GMOD) + ((size_t)(l * 2) * 5 + cond) * 1024 + n), sh = *(const f32x4*)(C.f(WS_MOD) + ((size_t)l * 5 + cond) * 6144 + n);
            const f32x4 u = x * rs * gm + sh, y = *(const f32x4*)(C.in(26) + n) * u + *(const f32x4*)(C.f(SCR_YF) + off) + *(const f32x4*)(C.f(SCR_YB) + off);
            f32x4 o;
#pragma unroll
            for (int e = 0; e < 4; ++e) { const float v = y[e], uu = 0.7978845608028654f * (v + 0.044715f * v * v * v); const float th = 1.f - 2.f / (1.f + __expf(2.f * uu)); o[e] = 0.5f * v * (1.f + th); }
            st_bf16x4(C.h(SCR_AGLU) + off, o);
        }
    }
}
#define XB_TMO      128
#define XB_XCNT(j)  (256  + 64 * (j))
#define XB_XSUB(j)  (1280 + 64 * (j))
#define XB_XGEN(j)  (2304 + 64 * (j))
#define XB_TOP      3328
#define XB_TOPGEN   3392
#define XCD_BAR_WORDS 3456
#define XB_SPIN_CAP (1u << 18)
#ifndef XB_SCOPE
#define XB_SCOPE "agent"
#endif
__device__ __forceinline__ unsigned xb_ld(unsigned* p)              { return __hip_atomic_load(p, __ATOMIC_RELAXED, __HIP_MEMORY_SCOPE_AGENT); }
__device__ __forceinline__ unsigned xb_add(unsigned* p, unsigned v) { return __hip_atomic_fetch_add(p, v, __ATOMIC_RELAXED, __HIP_MEMORY_SCOPE_AGENT); }
__device__ __forceinline__ unsigned xb_xcc_id() { return (unsigned)__builtin_amdgcn_s_getreg((3 << 11) | 20) & 0xFu; }
#define XB_SPIN(cond, bar) do { unsigned _sp = 0; while (cond) { __builtin_amdgcn_s_sleep(1); \
    if ((++_sp & 255u) == 0u) { if (xb_ld(&(bar)[XB_TMO])) break; if (_sp > XB_SPIN_CAP) { atomicAdd(&(bar)[XB_TMO], 1u); break; } } } } while (0)
struct XcdBarrier { unsigned* bar; unsigned x; volatile LAS unsigned* st; };
__device__ __forceinline__ XcdBarrier xcd_barrier_post(unsigned* bar, volatile LAS unsigned* st) {
    XcdBarrier b; b.bar = bar; b.x = xb_xcc_id(); b.st = st;
    if (threadIdx.x == 0) (void)xb_add(&bar[XB_XCNT(b.x)], 1u);
    return b;
}
__device__ __forceinline__ void xcd_barrier_complete(unsigned* bar, unsigned x, unsigned& nloc, unsigned& nx) {
    const unsigned G = gridDim.x * gridDim.y * gridDim.z;
    unsigned sum, cnt, mine, sp = 0u;
    for (;;) {
        sum = 0u; cnt = 0u; mine = 0u;
#pragma unroll
        for (unsigned j = 0; j < 16; ++j) { const unsigned c = xb_ld(&bar[XB_XCNT(j)]); sum += c; cnt += (c > 0u) ? 1u : 0u; mine = (j == x) ? c : mine; }
        if (sum == G) break;
        __builtin_amdgcn_s_sleep(1);
        if ((++sp & 255u) == 0u) { if (xb_ld(&bar[XB_TMO])) break; if (sp > XB_SPIN_CAP) { atomicAdd(&bar[XB_TMO], 1u); break; } }
    }
    nloc = mine > 0u ? mine : 1u; nx = cnt > 0u ? cnt : 1u;
}
__device__ __forceinline__ void xcd_barrier(const XcdBarrier& b) {
    asm volatile("s_waitcnt vmcnt(0)" ::: "memory");
    __syncthreads();
    if (threadIdx.x == 0) {
        unsigned* bar = b.bar;
        __builtin_amdgcn_s_waitcnt(0);
        unsigned nloc = b.st[0], nx = b.st[1];
        if (nloc == 0u) { xcd_barrier_complete(bar, b.x, nloc, nx); b.st[0] = nloc; b.st[1] = nx; }
#if 1
        __builtin_amdgcn_fence(__ATOMIC_RELEASE, XB_SCOPE); asm volatile("s_waitcnt vmcnt(0)" ::: "memory");
#endif
        const unsigned old = xb_add(&bar[XB_XSUB(b.x)], 1u);
        const unsigned gen = old / nloc;
        if (old + 1u == (gen + 1u) * nloc) {
            __builtin_amdgcn_fence(__ATOMIC_RELEASE, XB_SCOPE);
            asm volatile("s_waitcnt vmcnt(0)" ::: "memory");
            const unsigned og = xb_add(&bar[XB_TOP], 1u);
            const unsigned tg = og / nx;
            if (og + 1u == (tg + 1u) * nx) xb_add(&bar[XB_TOPGEN], 1u);
            else XB_SPIN(xb_ld(&bar[XB_TOPGEN]) == tg, bar);
            __builtin_amdgcn_fence(__ATOMIC_ACQUIRE, XB_SCOPE);
            xb_add(&bar[XB_XGEN(b.x)], 1u);
            asm volatile("s_waitcnt vmcnt(0)" ::: "memory");
        } else {
            XB_SPIN(xb_ld(&bar[XB_XGEN(b.x)]) == gen, bar);
            __builtin_amdgcn_fence(__ATOMIC_ACQUIRE, XB_SCOPE);
            asm volatile("s_waitcnt vmcnt(0)" ::: "memory");
        }
#ifdef XB_DELAY
        for (int q = 0; q < XB_DELAY; ++q) __builtin_amdgcn_s_sleep(127);
#endif
    }
    __syncthreads();
}
}
namespace om {
enum { PH_P0A = 0, PH_P0C, PH_GLUE, PH_QKV, PH_ATTN, PH_WO, PH_HIN, PH_HSCAN, PH_HPOST, PH_HWO, PH_SSCAN, PH_SPOST, PH_GLU, PH_UP, PH_CONV, PH_DOWN, PH_FINAL };

struct Args { const float* in[33]; float* out; unsigned char* ws; int nph; int pad; unsigned char ptype[160]; unsigned char parg[160]; };

__device__ __forceinline__ void run_phase(const Ctx& C0, int type, int arg) {
    Ctx C = C0; asm volatile("" : "+v"(C.tid)); asm volatile("" : "+s"(C.bid), "+s"(C.G), "+s"(C.kp), "+s"(C.ws), "+s"(C.out));
    C.lane = C.tid & 63; C.wave = __builtin_amdgcn_readfirstlane(C.tid >> 6);
    const int l = arg & 3;
    if (type == 31) return;
#ifndef PHASE_MASK
#define PHASE_MASK 0xFFFFFFFFu
#endif
    if (!((PHASE_MASK >> type) & 1u)) return;
    pg8::Gemm g{nullptr, nullptr, D, 256, 128}; int nN = 0; EpiAny E{}; E.ws = C.ws; E.out = C.out; E.l = l;
    switch (type) {
    case PH_P0A: phase_p0a(C); break;
    case PH_P0C: phase_p0c(C); break;
    case PH_GLUE: phase_glue(C, arg >> 1, arg & 1); break;
    case PH_QKV: { g.A = C.h(WS_AP); g.Bt = C.h(WS_WQKV) + (size_t)(l / 3) * NQKV * D; nN = 6; E.kind = EK_QKV; } break;
    case PH_ATTN: phase_attn(C, l, (arg & 32) ? SCR_O + 96 * MiB : SCR_O); break;
    case 17: phase_chk(C, SCR_O, SCR_O + 96 * MiB, 16 * MiB); break;
    case 18: phase_cks(C, arg); break;
    case 19: phase_cmp(C, arg); break;
    case 20: phase_clr(C); break;
    case PH_WO: case PH_HWO: case PH_GLU: {
        if (type == PH_WO) { g.A = C.h(SCR_O); g.Bt = C.h(WS_WO) + (size_t)(l / 3) * D * D; nN = 4; E.kind = EK_RES; }
        else if (type == PH_HWO) { g.A = C.h(SCR_AWO); g.Bt = C.h(WS_HWO); nN = 4; E.kind = EK_RES; }
        else { g.A = C.h(SCR_AGLU); g.Bt = C.h(WS_GLU); g.b_tile_rows = 128; g.b_half_rows = 1024; nN = 8; E.kind = EK_RES_GLU; }
        E.flags = ((arg & 32) ? 4 : 0) | (type == PH_HWO ? 8 : 0); } break;
    case PH_HIN: { g.A = C.h(WS_AP); g.Bt = C.h(WS_HWIN); nN = 20; E.kind = EK_HIN; } break;
    case PH_HSCAN: phase_hscan(C); break;
    case PH_HPOST: phase_hpost(C); break;
    case PH_SSCAN: phase_sscan(C, l, (arg & 32) ? WS_SCR + 80 * MiB : ((arg & 64) ? WS_SCR + 112 * MiB : 0)); break;
    case 22: phase_clr2(C, WS_SCR + 80 * MiB, 64 * MiB); break;
    case 21: phase_chk(C, WS_SCR + 80 * MiB, WS_SCR + 112 * MiB, 32 * MiB); break;
    case PH_SPOST: phase_spost(C, l); break;
    case PH_UP: { g.A = C.h(WS_AP); g.Bt = C.h(WS_UP) + (size_t)l * NUP * D; nN = 22; E.kind = EK_UPRAW; E.flags = (arg & 32) ? 4 : 0; } break;
    case 23: phase_chk(C, WS_SCR, WS_SCR + 88 * MiB, 88 * MiB); break;
    case PH_CONV: phase_conv(C, l); break;
    case PH_DOWN: { g.A = C.h(WS_ACT); g.Bt = C.h(WS_DOWN) + (size_t)l * D * DFF; g.K = DFF; nN = 4; E.kind = EK_RES; E.flags = 1 | ((arg & 16) ? 2 : 0) | ((arg & 32) ? 4 : 0); } break;
    case PH_FINAL: { const unsigned fl = __hip_atomic_load((unsigned*)(C.ws + WS_CTL) + 4000, __ATOMIC_RELAXED, __HIP_MEMORY_SCOPE_AGENT), fd = __hip_atomic_load((unsigned*)(C.ws + WS_CTL) + 4001, __ATOMIC_RELAXED, __HIP_MEMORY_SCOPE_AGENT);
        #ifdef SSDET_CLS
        const unsigned cls = __hip_atomic_load((unsigned*)(C.ws + WS_CTL) + 4002, __ATOMIC_RELAXED, __HIP_MEMORY_SCOPE_AGENT), cnt = __hip_atomic_load((unsigned*)(C.ws + WS_CTL) + 4003, __ATOMIC_RELAXED, __HIP_MEMORY_SCOPE_AGENT);
        phase_final(C, 1.f + (float)cls / 8.f + (float)(cnt > 63 ? 63 : cnt) / 1024.f); } break;
#else
        phase_final(C, fl ? 3.f : (fd ? exp2f((float)(1001 - fd)) : 1.f)); } break;
#endif
    default: break;
    }
    if (nN) { pg8::StaticOrder S; S.init(32, nN, C.G, C.bid); pg8::gemm_phase(C.lds, g, S, E); }
}

__device__ __forceinline__ void canary(const Ctx& C0, unsigned char* ws, int i, bool check) {
    int tid = C0.tid; asm volatile("" : "+v"(tid)); const int lane = tid & 63, wave = tid >> 6;
    unsigned* can = (unsigned*)(ws + WS_CTL + 32768);
#ifdef CANARY_SC1
    if (!check) { if (wave == 0 && lane < 32) __hip_atomic_store(can + C0.bid * 32 + lane, (unsigned)(i + 1), __ATOMIC_RELAXED, __HIP_MEMORY_SCOPE_AGENT); }
#else
    if (!check) { if (wave == 0 && lane < 32) can[C0.bid * 32 + lane] = (unsigned)(i + 1); }
#endif
#ifdef CANARY_LD_SC1
    else { const unsigned v = __hip_atomic_load(can + (wave * 32 + (lane >> 1)) * 32 + (lane & 1) * 16, __ATOMIC_RELAXED, __HIP_MEMORY_SCOPE_AGENT);
#else
    else { const unsigned v = can[(wave * 32 + (lane >> 1)) * 32 + (lane & 1) * 16];
#endif
      if (v != (unsigned)(i + 1) && v != (unsigned)(i + 2)) atomicAdd((unsigned*)(ws + WS_CTL) + 4000, 1u); }
}
__global__ void __launch_bounds__(NTHREADS, 2) mk_fwd(Args a) {
    extern __shared__ __attribute__((aligned(16))) unsigned char lds[];
    { volatile LAS unsigned* misc = (volatile LAS unsigned*)((LAS unsigned char*)lds + LDS_BYTES - 64); if (threadIdx.x < 16) misc[threadIdx.x] = 0u; }
    __syncthreads();
    (void)xcd_barrier_post((unsigned*)(a.ws + WS_CTL), (volatile LAS unsigned*)((LAS unsigned char*)lds + LDS_BYTES - 64));
    for (int i = 0; i < a.nph; ++i) {
        {
            Ctx C; C.kp = (const unsigned char __attribute__((address_space(4)))*)__builtin_amdgcn_kernarg_segment_ptr();
            C.out = a.out; C.ws = a.ws; C.lds = (LAS unsigned char*)lds; C.tid = threadIdx.x; C.lane = C.tid & 63; C.wave = 0; C.G = gridDim.x; C.bid = blockIdx.x;
            run_phase(C, a.ptype[i], a.parg[i]);
#ifdef CANARY
            canary(C, a.ws, i, false);
#endif
        }
        if (i + 1 < a.nph) { XcdBarrier bar; bar.bar = (unsigned*)(a.ws + WS_CTL); bar.x = xb_xcc_id(); bar.st = (volatile LAS unsigned*)((LAS unsigned char*)lds + LDS_BYTES - 64); xcd_barrier(bar); }
#ifdef CANARY
        if (i + 1 < a.nph) { Ctx C; C.tid = threadIdx.x; C.bid = blockIdx.x; canary(C, a.ws, i, true); }
#endif
    }
}
}
extern "C" void kernel_launch(void* const* d_in, const int* in_sizes, int n_in, void* d_out, int out_size, void* d_ws, size_t ws_size, hipStream_t stream) {
    using namespace om;
    static int grid = 0;
    if (grid == 0) {
        if (n_in != 33 || out_size != 17039360 || ws_size < WS_END) { fprintf(stderr, "kernel_launch: unexpected sizes n_in %d out %d ws %zu; nothing launched\n", n_in, out_size, ws_size); grid = -1; return; }
        int dev = 0, cus = 0, per_cu = 0;
        (void)hipGetDevice(&dev); (void)hipDeviceGetAttribute(&cus, hipDeviceAttributeMultiprocessorCount, dev);
        (void)hipFuncSetAttribute((const void*)mk_fwd, hipFuncAttributeMaxDynamicSharedMemorySize, LDS_BYTES);
        if (hipOccupancyMaxActiveBlocksPerMultiprocessor(&per_cu, (const void*)mk_fwd, NTHREADS, LDS_BYTES) != hipSuccess || per_cu < 1) { fprintf(stderr, "kernel_launch: occupancy query gives %d blocks per CU\n", per_cu); per_cu = 1; }
        (void)hipGetLastError();
        grid = cus;
        if (grid > 256) grid = 256;
    }
    if (grid < 0) return;
    (void)hipMemsetAsync((char*)d_ws + WS_CTL, 0, CTL_ZERO_BYTES, stream);
    Args a{};
    for (int i = 0; i < 33; ++i) a.in[i] = (const float*)d_in[i];
    a.out = (float*)d_out; a.ws = (unsigned char*)d_ws;
    int n = 0;
#ifndef DUP_MASK
#define DUP_MASK 0u
#endif
#ifndef XBAR
#define XBAR 0
#endif
    auto add1 = [&](int t, int p) { a.ptype[n] = (unsigned char)t; a.parg[n] = (unsigned char)p; ++n; };
    auto add = [&](int t, int p) { add1(t, p);
        if ((DUP_MASK >> t) & 1u) { const bool resid = (t == PH_WO || t == PH_HWO || t == PH_GLU || t == PH_DOWN); add1(t, resid ? (p | 32) : p); }
        for (int q = 0; q < XBAR; ++q) add1(31, 0); };
    add(PH_P0A, 0); add(PH_P0C, 0);
    for (int l = 0; l < 4; ++l) {
        const int kind = l % 3;
#ifdef CHK_ATTN
        if (kind == 0) { add(PH_QKV, l); add(PH_ATTN, l); add(PH_ATTN, l | 32); add(17, 0); add(PH_WO, l); }
#else
        if (kind == 0) { add(PH_QKV, l); add(PH_ATTN, l); add(PH_WO, l); }
#endif
        else if (kind == 1) { add(PH_HIN, l); add(PH_HSCAN, l); add(PH_HPOST, l); add(PH_HWO, l); }
        else { add(PH_SSCAN, l); add(PH_SPOST, l); add(PH_GLU, l); }
        add(PH_UP, l); add(PH_CONV, l); add(PH_DOWN, l == 3 ? (l | 16) : l);
    }
    add(PH_FINAL, 0);
    a.nph = n;
    void* args[] = {&a};
    const hipError_t e = hipLaunchCooperativeKernel((const void*)mk_fwd, dim3(grid), dim3(NTHREADS), args, LDS_BYTES, stream);
    if (e != hipSuccess) fprintf(stderr, "kernel_launch: cooperative launch failed: %s (grid %d)\n", hipGetErrorString(e), grid);
}
```

```cpp
#include <hip/hip_runtime.h>
#include <hip/hip_cooperative_groups.h>
#include <cstdio>
#include <cstdint>
#include <cmath>
#define LAS __attribute__((address_space(3)))
#define GAS __attribute__((address_space(1)))
typedef unsigned short bf16_t;
typedef short bf16x8 __attribute__((ext_vector_type(8)));
typedef short s16x4 __attribute__((ext_vector_type(4)));
typedef float f32x2 __attribute__((ext_vector_type(2)));
typedef float f32x4 __attribute__((ext_vector_type(4)));
typedef float f32x16 __attribute__((ext_vector_type(16)));
typedef unsigned u32x2 __attribute__((ext_vector_type(2)));
typedef unsigned u32x4 __attribute__((ext_vector_type(4)));
typedef __bf16 bf16x2_t __attribute__((ext_vector_type(2)));

namespace om {
constexpr int D = 1024, MP = 4096, M = 8192, DFF = 2816, NUP = 5632, NQKV = 1536, NHIN = 5120;
constexpr float EPS = 1e-6f, LOG2E = 1.4426950408889634f, QSCALE = 0.125f * 1.4426950408889634f;
constexpr int NTHREADS = 512, NWAVES = 8, LDS_BYTES = 147456, RING_BYTES = 131072;
constexpr int SW_STRIDE = 5632;
constexpr float SS_FIX = 16777216.f, SS_INV = 1.f / (16777216.f * 1024.f);
typedef unsigned long long u64_t;
__device__ __forceinline__ float rstd_of(const u64_t* ss, int r) { return rsqrtf((float)ss[r] * SS_INV + 1e-6f); }
constexpr size_t MiB = 1u << 20;
constexpr size_t WS_CTL = 0, CTL_ZERO_BYTES = 64 * 1024;
constexpr size_t WS_MODP = 1 * MiB, WS_MOD = 3 * MiB, WS_SW = 4 * MiB, WS_GMOD = 5 * MiB, WS_SS = 6 * MiB, WS_ROPE = 7 * MiB;
constexpr size_t WS_LB1 = 8 * MiB, WS_SLAM = 8 * MiB + 64 * 1024, WS_SBB = 8 * MiB + 512 * 1024, WS_SCB = 9 * MiB;
constexpr size_t WS_CTXK = 10 * MiB, WS_CTXV = 12 * MiB;
constexpr size_t WS_NAIVE_MOD = 14 * MiB;
constexpr size_t WS_WQKV = 16 * MiB, WS_WO = 22 * MiB, WS_HWIN = 26 * MiB, WS_HWO = 36 * MiB, WS_GLU = 38 * MiB, WS_UP = 42 * MiB, WS_DOWN = 86 * MiB;
constexpr size_t WS_X = 108 * MiB, WS_R = 140 * MiB;
constexpr size_t WS_AP = WS_R, WS_ACT = WS_R + 16 * MiB, WS_SCR = WS_R + 60 * MiB, WS_END = WS_SCR + 176 * MiB;

constexpr size_t SCR_Q = WS_SCR, SCR_KB = WS_SCR + 16 * MiB, SCR_VB = WS_SCR + 20 * MiB, SCR_O = WS_SCR + 24 * MiB;
constexpr size_t SCR_HQ = WS_SCR, SCR_HV = WS_SCR + 16 * MiB, SCR_HG = WS_SCR + 32 * MiB, SCR_LFF = WS_SCR + 48 * MiB, SCR_LFB = WS_SCR + 80 * MiB, SCR_OF = WS_SCR + 112 * MiB, SCR_OB = WS_SCR + 144 * MiB, SCR_AWO = WS_SCR;
constexpr size_t SCR_YF = WS_SCR, SCR_YB = WS_SCR + 32 * MiB, SCR_AGLU = WS_SCR + 64 * MiB;

__device__ __forceinline__ int cond_of_tile(int pm) { return pm < 16 ? 0 : 1 + ((pm - 16) >> 2); }
__device__ __forceinline__ int cond_of_row(int r) { return r < MP ? 0 : 1 + ((r - MP) >> 10); }
__device__ __forceinline__ unsigned cvtpk(float lo, float hi) { f32x2 v = {lo, hi}; bf16x2_t b = __builtin_convertvector(v, bf16x2_t); return __builtin_bit_cast(unsigned, b); }
__device__ __forceinline__ float bf2f(unsigned short h) { return __uint_as_float(((unsigned)h) << 16); }
__device__ __forceinline__ float bflo(unsigned w) { return __uint_as_float(w << 16); }
__device__ __forceinline__ float bfhi(unsigned w) { return __uint_as_float(w & 0xffff0000u); }
__device__ __forceinline__ float sigm(float x) { return 1.f / (1.f + __expf(-x)); }
__device__ __forceinline__ float wave_sum(float v) {
#pragma unroll
    for (int o = 1; o < 64; o <<= 1) v += __shfl_xor(v, o);
    return v;
}

struct Ctx {
    const unsigned char __attribute__((address_space(4)))* kp;
    float* out; unsigned char* ws;
    LAS unsigned char* lds; int tid, lane, wave, G, bid;
    __device__ __forceinline__ const float* in(int i) const { return *(const float* const __attribute__((address_space(4)))*)(kp + 8 * i); }
    __device__ __forceinline__ float* f(size_t off) const { return (float*)(ws + off); }
    __device__ __forceinline__ bf16_t* h(size_t off) const { return (bf16_t*)(ws + off); }
};

namespace pg8 {
constexpr int BM = 256, BK = 64, HALF = 128, HTB = HALF * BK * 2, STAGE_BYTES = 8 * HTB, NXCD = 8, WGM = 8;
__host__ __device__ __forceinline__ int lds_byte(int r, int c) { const int st = (r >> 4) * 2 + (c >> 5), rr = r & 15, cc = c & 31, ob = rr * 64 + cc * 2; return st * 1024 + (ob ^ (((ob >> 9) & 1) << 5)); }
__host__ __device__ __forceinline__ void stage_rc(int b, int& R, int& C) { const int st = b / 1024, sb = b % 1024, swz = sb ^ (((sb >> 9) & 1) << 5); R = (st >> 1) * 16 + swz / 64; C = (st & 1) * 32 + (swz % 64) / 2; }
struct Unit { int pm, pn; };
struct Gemm { const bf16_t* A; const bf16_t* Bt; int K; int b_tile_rows, b_half_rows; };
struct StaticOrder {
    int nM, nN, nwg, G, c;
    __device__ void init(int nM_, int nN_, int G_, int c_) { nM = nM_; nN = nN_; nwg = nM * nN; G = G_; c = c_; }
    __device__ bool next(int i, Unit& u) const {
        const long L = (long)i * G + c; if (L >= nwg) return false;
        int wgid = (int)L; { const int q = nwg / NXCD, r = nwg % NXCD, xcd = wgid % NXCD, off = wgid / NXCD; wgid = (xcd < r ? xcd * (q + 1) : r * (q + 1) + (xcd - r) * q) + off; }
        const int nig = WGM * nN, gid = wgid / nig, fm = gid * WGM, gsz = (nM - fm) < WGM ? (nM - fm) : WGM;
        u.pm = fm + ((wgid % nig) % gsz); u.pn = (wgid % nig) / gsz; return true;
    }
};
template <class Epi>
__device__ __forceinline__ void gemm_phase(LAS unsigned char* lds, const Gemm g, const StaticOrder& S, const Epi& E) {
    int tid_ = threadIdx.x; asm volatile("" : "+v"(tid_));
    const int tid = tid_, wid = __builtin_amdgcn_readfirstlane(tid >> 6), lane = tid & 63, wr = wid >> 2, wc = wid & 3, fr = lane & 15, fq = lane >> 4;
    const int K = g.K, nt = K / BK;
    unsigned voffA[2];
#pragma unroll
    for (int i = 0; i < 2; ++i) { int R, C; stage_rc(tid * 16 + i * 8192, R, C); voffA[i] = (unsigned)(R * K + C) * 2u; }
    const size_t kstep = (size_t)(BK * 2);
    const size_t hstepA = (size_t)HALF * K * 2, tstepA = 2 * hstepA;
    const size_t hstepB = (size_t)g.b_half_rows * K * 2, tstepB = (size_t)g.b_tile_rows * K * 2;
    const unsigned ldsw = (unsigned)wid * 1024u;
    const int aoff = lds_byte(wr * 64 + fr, fq * 8), boff = lds_byte(wc * 32 + fr, fq * 8);
#define PG8_SA(b, h) (((b) * 2 + (h)) * HTB)
#define PG8_SB(b, h) ((4 + (b) * 2 + (h)) * HTB)
#define PG8_STAGE(bufoff, gbase) do { _Pragma("unroll") for (int _i = 0; _i < 2; ++_i) \
        __builtin_amdgcn_global_load_lds((const unsigned*)((const char*)(gbase) + voffA[_i]), (LAS unsigned*)(lds + (bufoff) + ldsw + _i * 8192), 16, 0, 0); } while (0)
#define PG8_LDA(dst, b, h) do { _Pragma("unroll") for (int m = 0; m < 4; ++m) _Pragma("unroll") for (int k = 0; k < 2; ++k) dst[m][k] = *(const LAS bf16x8*)(lds + PG8_SA(b, h) + aoff + m * 2048 + k * 1024); } while (0)
#define PG8_LDB(dst, b, h) do { _Pragma("unroll") for (int n = 0; n < 2; ++n) _Pragma("unroll") for (int k = 0; k < 2; ++k) dst[n][k] = *(const LAS bf16x8*)(lds + PG8_SB(b, h) + boff + n * 2048 + k * 1024); } while (0)
#define PG8_MMA(ai, bj, At, Bt) do { __builtin_amdgcn_s_setprio(1); _Pragma("unroll") for (int m = 0; m < 4; ++m) _Pragma("unroll") for (int n = 0; n < 2; ++n) _Pragma("unroll") for (int k = 0; k < 2; ++k) \
        acc[ai][bj][m][n] = __builtin_amdgcn_mfma_f32_16x16x32_bf16(Bt[n][k], At[m][k], acc[ai][bj][m][n], 0, 0, 0); __builtin_amdgcn_s_setprio(0); } while (0)
#define PG8_WAIT_V(n) asm volatile("s_waitcnt vmcnt(" #n ")" ::: "memory")
#define PG8_WAIT_L(n) asm volatile("s_waitcnt lgkmcnt(" #n ")" ::: "memory")
#define PG8_BAR __builtin_amdgcn_s_barrier()
#define PG8_SCHED __builtin_amdgcn_sched_barrier(0)
    Unit cur, nxt; int ui = 0;
    if (!S.next(0, cur)) return;
    f32x4 acc[2][2][4][2];
#pragma unroll
    for (int a = 0; a < 2; ++a)
#pragma unroll
        for (int b = 0; b < 2; ++b)
#pragma unroll
            for (int m = 0; m < 4; ++m)
#pragma unroll
                for (int n = 0; n < 2; ++n) acc[a][b][m][n] = (f32x4){0.f, 0.f, 0.f, 0.f};
    bf16x8 At[4][2], B0[2][2], B1[2][2];
    const char* cA = (const char*)g.A + (size_t)cur.pm * tstepA; const char* cB = (const char*)g.Bt + (size_t)cur.pn * tstepB;
    PG8_STAGE(PG8_SB(0, 0), cB); PG8_STAGE(PG8_SB(0, 1), cB + hstepB); PG8_STAGE(PG8_SA(0, 0), cA); PG8_STAGE(PG8_SA(0, 1), cA + hstepA);
    if (wr == 1) PG8_BAR;
    PG8_WAIT_V(2); PG8_BAR;
    PG8_STAGE(PG8_SB(1, 0), cB + kstep); PG8_STAGE(PG8_SA(1, 0), cA + kstep); PG8_STAGE(PG8_SB(1, 1), cB + hstepB + kstep);
    PG8_WAIT_V(6); PG8_BAR;
    for (;;) {
        const bool has_next = S.next(ui + 1, nxt);
        const char* nA = has_next ? (const char*)g.A + (size_t)nxt.pm * tstepA : cA; const char* nB = has_next ? (const char*)g.Bt + (size_t)nxt.pn * tstepB : cB;
        for (int t = 0; t < nt; t += 2) {
            const bool last = (t == nt - 2);
            const char* a1 = cA + (size_t)(t + 1) * kstep;
            const char* a2 = last ? nA : cA + (size_t)(t + 2) * kstep; const char* b2 = last ? nB : cB + (size_t)(t + 2) * kstep;
            const char* a3 = a2 + kstep; const char* b3 = b2 + kstep;
            PG8_LDB(B0, 0, 0); PG8_LDB(B1, 0, 1); PG8_SCHED; PG8_LDA(At, 0, 0); PG8_STAGE(PG8_SA(1, 1), a1 + hstepA);
            PG8_WAIT_V(8); PG8_WAIT_L(0); PG8_BAR; PG8_MMA(0, 0, At, B0); PG8_MMA(0, 1, At, B1); PG8_BAR; PG8_SCHED;
            PG8_LDA(At, 0, 1); PG8_STAGE(PG8_SB(0, 0), b2); PG8_STAGE(PG8_SB(0, 1), b2 + hstepB); PG8_STAGE(PG8_SA(0, 0), a2);
            PG8_WAIT_V(8); PG8_WAIT_L(0); PG8_BAR; PG8_MMA(1, 0, At, B0); PG8_MMA(1, 1, At, B1); PG8_BAR; PG8_SCHED;
            PG8_LDB(B0, 1, 0); PG8_LDB(B1, 1, 1); PG8_SCHED; PG8_LDA(At, 1, 0); PG8_STAGE(PG8_SA(0, 1), a2 + hstepA);
            PG8_WAIT_V(8); PG8_WAIT_L(0); PG8_BAR; PG8_MMA(0, 0, At, B0); PG8_MMA(0, 1, At, B1); PG8_BAR; PG8_SCHED;
            PG8_LDA(At, 1, 1); PG8_STAGE(PG8_SB(1, 0), b3); PG8_STAGE(PG8_SB(1, 1), b3 + hstepB); PG8_STAGE(PG8_SA(1, 0), a3);
            PG8_WAIT_V(8); PG8_WAIT_L(0); PG8_BAR; PG8_MMA(1, 0, At, B0); PG8_MMA(1, 1, At, B1); PG8_BAR; PG8_SCHED;
        }
        if (wr == 0) PG8_BAR;
        { int fr_e = fr, fq_e = fq, wr_e = wr, wc_e = wc; asm volatile("" : "+v"(fr_e), "+v"(fq_e), "+s"(wr_e), "+s"(wc_e));
          E(acc, cur, wr_e, wc_e, fr_e, fq_e);
          int tid_e = tid; asm volatile("" : "+v"(tid_e)); E.post(cur, tid_e); }
        if (!has_next) break;
#pragma unroll
        for (int a = 0; a < 2; ++a)
#pragma unroll
            for (int b = 0; b < 2; ++b)
#pragma unroll
                for (int m = 0; m < 4; ++m)
#pragma unroll
                    for (int n = 0; n < 2; ++n) acc[a][b][m][n] = (f32x4){0.f, 0.f, 0.f, 0.f};
        cur = nxt; cA = nA; cB = nB; ++ui;
        if (wr == 1) PG8_BAR;
    }
    PG8_WAIT_V(0);
    PG8_BAR;
#undef PG8_SA
#undef PG8_SB
#undef PG8_STAGE
#undef PG8_LDA
#undef PG8_LDB
#undef PG8_MMA
#undef PG8_WAIT_V
#undef PG8_WAIT_L
#undef PG8_BAR
#undef PG8_SCHED
}
}
using pg8::Unit;
typedef f32x4 Acc[2][2][4][2];

__device__ __forceinline__ void st_bf16x4(bf16_t* p, f32x4 v) { u32x2 w; w.x = cvtpk(v[0], v[1]); w.y = cvtpk(v[2], v[3]); *(u32x2*)p = w; }

template <bool PAIRED> struct EpiRes {
    const float* xin; float* xout; bf16_t* ap; u64_t* ssn; const float* gate;   const float* gmodn;
    __device__ __forceinline__ void operator()(const Acc& acc, const Unit& u, int wr, int wc, int fr, int fq) const {
        const int c = cond_of_tile(u.pm);
        const int colb = (PAIRED ? u.pn * 128 : u.pn * 256) + wc * 32 + 4 * fq;
        constexpr int NBJ = PAIRED ? 1 : 2;
        f32x4 gv[NBJ][2], gm[NBJ][2];
#pragma unroll
        for (int bj = 0; bj < NBJ; ++bj)
#pragma unroll
            for (int n = 0; n < 2; ++n) { gv[bj][n] = *(const f32x4*)(gate + (size_t)c * 6144 + colb + bj * 128 + n * 16);
                gm[bj][n] = gmodn ? *(const f32x4*)(gmodn + (size_t)c * 1024 + colb + bj * 128 + n * 16) : (f32x4){0.f, 0.f, 0.f, 0.f}; }
#pragma unroll
        for (int ai = 0; ai < 2; ++ai)
#pragma unroll
            for (int m = 0; m < 4; ++m) {
                const int r = u.pm * 256 + ai * 128 + wr * 64 + m * 16 + fr; float sq = 0.f;
#pragma unroll
                for (int bj = 0; bj < NBJ; ++bj)
#pragma unroll
                    for (int n = 0; n < 2; ++n) {
                        f32x4 o = acc[ai][bj][m][n];
                        if (PAIRED) { const f32x4 gt = acc[ai][1][m][n];
#pragma unroll
                            for (int e = 0; e < 4; ++e) o[e] = o[e] * sigm(gt[e]); }
                        const size_t off = (size_t)r * D + colb + bj * 128 + n * 16;
                        const f32x4 xo = *(const f32x4*)(xin + off) + gv[bj][n] * o;
                        *(f32x4*)(xout + off) = xo;
                        sq += (xo[0] * xo[0] + xo[1] * xo[1]) + (xo[2] * xo[2] + xo[3] * xo[3]);
                        if (gmodn) st_bf16x4(ap + off, xo * gm[bj][n]);
                    }
                sq += __shfl_xor(sq, 16); sq += __shfl_xor(sq, 32);
                if (fq == 0) atomicAdd(ssn + r, (u64_t)(sq * SS_FIX));
            }
    }
};
struct EpiUpRaw {
    const u64_t* ss; const float* sw;   bf16_t* hraw;
    __device__ __forceinline__ void operator()(const Acc& acc, const Unit& u, int wr, int wc, int fr, int fq) const {
        const int c = cond_of_tile(u.pm); const int colb = u.pn * 256 + wc * 32 + 4 * fq;
        f32x4 sv[2][2];
#pragma unroll
        for (int bj = 0; bj < 2; ++bj)
#pragma unroll
            for (int n = 0; n < 2; ++n) sv[bj][n] = *(const f32x4*)(sw + (size_t)c * SW_STRIDE + colb + bj * 128 + n * 16);
#pragma unroll
        for (int ai = 0; ai < 2; ++ai)
#pragma unroll
            for (int m = 0; m < 4; ++m) {
                const int r = u.pm * 256 + ai * 128 + wr * 64 + m * 16 + fr; const float rs = rstd_of(ss, r);
#pragma unroll
                for (int bj = 0; bj < 2; ++bj)
#pragma unroll
                    for (int n = 0; n < 2; ++n) st_bf16x4(hraw + (size_t)r * NUP + colb + bj * 128 + n * 16, acc[ai][bj][m][n] * rs + sv[bj][n]);
            }
    }
};
constexpr size_t WS_EDGE = 14 * MiB;
template <int CTRL> __device__ __forceinline__ float dpp_f(float old, float src) { return __int_as_float(__builtin_amdgcn_update_dpp(__float_as_int(old), __float_as_int(src), CTRL, 0xf, 0xf, false)); }
#define DPP_ROW_SHL1 0x101
#define DPP_ROW_SHR1 0x111
#define DPP_ROW_ROR1 0x121
#define DPP_ROW_ROR15 0x12f
struct EpiUpConv {
    const u64_t* ss; const float* sw; const float* cw; const float* cb; bf16_t* act; float* edge; bf16_t* tile;
    __device__ __forceinline__ void operator()(const Acc& acc, const Unit& u, int wr, int wc, int fr, int fq) const {
        const int c = cond_of_tile(u.pm); const int cc0 = wc * 32 + 4 * fq, colg0 = u.pn * 128 + cc0;
        f32x4 sv[2][2];
#pragma unroll
        for (int bj = 0; bj < 2; ++bj)
#pragma unroll
            for (int n = 0; n < 2; ++n) sv[bj][n] = *(const f32x4*)(sw + (size_t)c * SW_STRIDE + bj * DFF + colg0 + n * 16);
#pragma unroll
        for (int ai = 0; ai < 2; ++ai)
#pragma unroll
            for (int m = 0; m < 4; ++m) { const int rl = ai * 128 + wr * 64 + m * 16 + fr; const float rs = rstd_of(ss, u.pm * 256 + rl);
#pragma unroll
                for (int bj = 0; bj < 2; ++bj)
#pragma unroll
                    for (int n = 0; n < 2; ++n) st_bf16x4(tile + rl * 256 + bj * 128 + cc0 + n * 16, acc[ai][bj][m][n] * rs + sv[bj][n]); }
    }
    __device__ __forceinline__ void post(const Unit& u, int tid) const {
        asm volatile("s_waitcnt vmcnt(0)" ::: "memory"); __builtin_amdgcn_s_barrier(); asm volatile("" ::: "memory");
        const int ch = tid & 15, rg = tid >> 4, colg = u.pn * 128 + 8 * ch, r0 = rg * 8;
        const bool samp = u.pm >= 16; const bool nb_top = samp && (u.pm & 3) != 0, nb_bot = samp && (u.pm & 3) != 3;
        float wg[3][8], wv[3][8], bg[8], bv[8];
#pragma unroll
        for (int q = 0; q < 2; ++q) {
#pragma unroll
            for (int jj = 0; jj < 3; ++jj) { const f32x4 a = *(const f32x4*)(cw + jj * NUP + colg + 4 * q), b = *(const f32x4*)(cw + jj * NUP + DFF + colg + 4 * q);
#pragma unroll
                for (int e = 0; e < 4; ++e) { wg[jj][4 * q + e] = a[e]; wv[jj][4 * q + e] = b[e]; } }
            const f32x4 a = *(const f32x4*)(cb + colg + 4 * q), b = *(const f32x4*)(cb + DFF + colg + 4 * q);
#pragma unroll
            for (int e = 0; e < 4; ++e) { bg[4 * q + e] = a[e]; bv[4 * q + e] = b[e]; } }
        u32x4 pg = {0u, 0u, 0u, 0u}, pv = {0u, 0u, 0u, 0u}, cg, cv;
        if (r0 > 0) { pg = *(const u32x4*)(tile + (r0 - 1) * 256 + 8 * ch); pv = *(const u32x4*)(tile + (r0 - 1) * 256 + 128 + 8 * ch); }
        cg = *(const u32x4*)(tile + r0 * 256 + 8 * ch); cv = *(const u32x4*)(tile + r0 * 256 + 128 + 8 * ch);
#pragma unroll
        for (int k = 0; k < 8; ++k) {
            const int rl = r0 + k; u32x4 ng = {0u, 0u, 0u, 0u}, nv = {0u, 0u, 0u, 0u};
            if (rl < 255) { ng = *(const u32x4*)(tile + (rl + 1) * 256 + 8 * ch); nv = *(const u32x4*)(tile + (rl + 1) * 256 + 128 + 8 * ch); }
            float hg[8], hv[8];
#pragma unroll
            for (int e = 0; e < 4; ++e) {
                hg[2 * e] = wg[0][2 * e] * bflo(pg[e]) + wg[1][2 * e] * bflo(cg[e]) + wg[2][2 * e] * bflo(ng[e]) + bg[2 * e];
                hg[2 * e + 1] = wg[0][2 * e + 1] * bfhi(pg[e]) + wg[1][2 * e + 1] * bfhi(cg[e]) + wg[2][2 * e + 1] * bfhi(ng[e]) + bg[2 * e + 1];
                hv[2 * e] = wv[0][2 * e] * bflo(pv[e]) + wv[1][2 * e] * bflo(cv[e]) + wv[2][2 * e] * bflo(nv[e]) + bv[2 * e];
                hv[2 * e + 1] = wv[0][2 * e + 1] * bfhi(pv[e]) + wv[1][2 * e + 1] * bfhi(cv[e]) + wv[2][2 * e + 1] * bfhi(nv[e]) + bv[2 * e + 1]; }
            u32x4 o;
#pragma unroll
            for (int e = 0; e < 4; ++e) o[e] = cvtpk(hg[2 * e] * sigm(hg[2 * e]) * hv[2 * e], hg[2 * e + 1] * sigm(hg[2 * e + 1]) * hv[2 * e + 1]);
            *(u32x4*)(act + (size_t)(u.pm * 256 + rl) * DFF + colg) = o;
            if ((rl == 0 && nb_top) || (rl == 255 && nb_bot)) {
                float* e0 = edge + ((size_t)((u.pm - 16) * 2 + (rl == 0 ? 0 : 1)) * 4) * DFF + colg;
#pragma unroll
                for (int e = 0; e < 4; ++e) { e0[2 * e] = hg[2 * e]; e0[2 * e + 1] = hg[2 * e + 1]; e0[DFF + 2 * e] = hv[2 * e]; e0[DFF + 2 * e + 1] = hv[2 * e + 1];
                    e0[2 * DFF + 2 * e] = bflo(cg[e]); e0[2 * DFF + 2 * e + 1] = bfhi(cg[e]); e0[3 * DFF + 2 * e] = bflo(cv[e]); e0[3 * DFF + 2 * e + 1] = bfhi(cv[e]); } }
            pg = cg; pv = cv; cg = ng; cv = nv;
        }
    }
};
struct EpiQKV {
    const u64_t* ss; const float* sw; bf16_t *Q, *KB, *VB; float *outK, *outV; const float *ropec, *ropes; int j;
    __device__ __forceinline__ void operator()(const Acc& acc, const Unit& u, int wr, int wc, int fr, int fq) const {
        const int c = cond_of_tile(u.pm); const bool samp = u.pm >= 16; const int colt = u.pn * 256, cl0 = wc * 32 + 4 * fq;
        f32x4 sv[2][2];
#pragma unroll
        for (int bj = 0; bj < 2; ++bj)
#pragma unroll
            for (int n = 0; n < 2; ++n) sv[bj][n] = *(const f32x4*)(sw + (size_t)c * SW_STRIDE + colt + cl0 + bj * 128 + n * 16);
#pragma unroll
        for (int ai = 0; ai < 2; ++ai)
#pragma unroll
            for (int m = 0; m < 4; ++m) {
                const int r = u.pm * 256 + ai * 128 + wr * 64 + m * 16 + fr; const float rs = rstd_of(ss, r);
                f32x4 cs = {1.f, 1.f, 1.f, 1.f}, sn = {0.f, 0.f, 0.f, 0.f};
                if (samp && u.pn < 5) { const int t = (r - MP) & 1023, idx = t * 32 + (wc & 1) * 16 + 4 * fq; cs = *(const f32x4*)(ropec + idx); sn = *(const f32x4*)(ropes + idx); }
#pragma unroll
                for (int bj = 0; bj < 2; ++bj) {
                    f32x4 v0 = acc[ai][bj][m][0] * rs + sv[bj][0], v1 = acc[ai][bj][m][1] * rs + sv[bj][1];
                    if (u.pn < 5) { const f32x4 o0 = v0 * cs - v1 * sn, o1 = v1 * cs + v0 * sn; v0 = o0; v1 = o1; }
                    const int cl = bj * 128 + cl0;
                    if (u.pn < 4) { st_bf16x4(Q + (size_t)r * D + colt + cl, v0 * QSCALE); st_bf16x4(Q + (size_t)r * D + colt + cl + 16, v1 * QSCALE); }
                    else {
                        bf16_t* dst = (u.pn == 4 ? KB : VB) + (size_t)r * 256 + cl; st_bf16x4(dst, v0); st_bf16x4(dst + 16, v1);
                        if (!samp) { float* o = (u.pn == 4 ? outK : outV) + (((size_t)(r >> 8) * 2 + j) * 256 + (r & 255)) * 256 + cl; *(f32x4*)o = v0; *(f32x4*)(o + 16) = v1; }
                    }
                }
            }
    }
};
struct EpiHin {
    const u64_t* ss; const float* sw; const float* lb1; bf16_t *HQ, *HV, *HG; float *LFF, *LFB;
    __device__ __forceinline__ void operator()(const Acc& acc, const Unit& u, int wr, int wc, int fr, int fq) const {
        const int c = cond_of_tile(u.pm); const int seg = u.pn >> 2, colt = u.pn * 256, cl0 = wc * 32 + 4 * fq, cs0 = (u.pn & 3) * 256 + cl0;
        f32x4 sv[2][2], lbv[2][2];
#pragma unroll
        for (int bj = 0; bj < 2; ++bj)
#pragma unroll
            for (int n = 0; n < 2; ++n) { sv[bj][n] = *(const f32x4*)(sw + (size_t)c * SW_STRIDE + colt + cl0 + bj * 128 + n * 16);
                lbv[bj][n] = (seg == 2 || seg == 3) ? *(const f32x4*)(lb1 + (seg - 2) * 1024 + cs0 + bj * 128 + n * 16) : (f32x4){0.f, 0.f, 0.f, 0.f}; }
#pragma unroll
        for (int ai = 0; ai < 2; ++ai)
#pragma unroll
            for (int m = 0; m < 4; ++m) {
                const int r = u.pm * 256 + ai * 128 + wr * 64 + m * 16 + fr; const float rs = rstd_of(ss, r);
#pragma unroll
                for (int bj = 0; bj < 2; ++bj)
#pragma unroll
                    for (int n = 0; n < 2; ++n) {
                        f32x4 v = acc[ai][bj][m][n] * rs + sv[bj][n]; const size_t off = (size_t)r * D + cs0 + bj * 128 + n * 16;
                        if (seg == 0) st_bf16x4(HQ + off, v);
                        else if (seg == 1) st_bf16x4(HV + off, v);
                        else if (seg == 4) {
#pragma unroll
                            for (int e = 0; e < 4; ++e) v[e] = v[e] * sigm(v[e]);
                            st_bf16x4(HG + off, v); }
                        else { const f32x4 lb = lbv[bj][n];
#pragma unroll
                            for (int e = 0; e < 4; ++e) v[e] = __logf(lb[e] + (1.f - lb[e]) * sigm(v[e]));
                            *(f32x4*)((seg == 2 ? LFF : LFB) + off) = v; }
                    }
            }
    }
};
enum { EK_RES = 0, EK_RES_GLU, EK_UPRAW, EK_QKV, EK_HIN, EK_UPCONV };
struct EpiAny {
    int kind, l, flags; unsigned char* ws; float* out; const float *in29, *in30;
    __device__ __forceinline__ float* F(size_t o) const { return (float*)(ws + o); }
    __device__ __forceinline__ bf16_t* H(size_t o) const { return (bf16_t*)(ws + o); }
    __device__ __forceinline__ void post(const Unit& u, int tid) const {
        if (kind != EK_UPCONV) return;
        unsigned char* ws = this->ws; asm volatile("" : "+s"(ws));
        const size_t ss1 = WS_SS + (size_t)(l * 2) * M * 8, sw1 = WS_SW + (size_t)(l * 2) * 5 * SW_STRIDE * 4;
        EpiUpConv E{(const u64_t*)(ws + ss1 + (size_t)M * 8), (const float*)(ws + sw1 + (size_t)5 * SW_STRIDE * 4), in29 + (size_t)l * 3 * NUP, in30 + (size_t)l * NUP, (bf16_t*)(ws + WS_ACT), (float*)(ws + WS_EDGE), (bf16_t*)(ws + WS_SCR + (size_t)blockIdx.x * 131072)}; E.post(u, tid);
    }
    __device__ __forceinline__ void operator()(Acc& acc, const Unit& u, int wr, int wc, int fr, int fq) const {
#ifndef EK_MASK
#define EK_MASK 63
#endif
        if (!((EK_MASK >> kind) & 1)) return;
        unsigned char* ws = this->ws; float* out = this->out; asm volatile("" : "+s"(ws), "+s"(out));
        auto F = [&](size_t o) { return (float*)(ws + o); }; auto H = [&](size_t o) { return (bf16_t*)(ws + o); };
        const size_t ss1 = WS_SS + (size_t)(l * 2) * M * 8, sw1 = WS_SW + (size_t)(l * 2) * 5 * SW_STRIDE * 4;
        switch (kind) {
        case EK_RES: case EK_RES_GLU: {
            const bool down = flags & 1;
            const size_t ssn = down ? WS_SS + (size_t)((l + 1) * 2) * M * 8 : ss1 + (size_t)M * 8;
            const size_t gate = WS_MOD + ((size_t)l * 5 * 6144 + (down ? 5 : 2) * 1024) * 4;
            const size_t gmn = down ? WS_GMOD + (size_t)((l + 1) * 2) * 5 * 1024 * 4 : WS_GMOD + (size_t)(l * 2 + 1) * 5 * 1024 * 4;
            const bool has_next = !(down && l == 3);
            float* xo = (flags & 2) ? out : F(WS_X); bf16_t* ap = H(WS_AP); u64_t* sp = (u64_t*)(ws + ssn);
            if (flags & 4) { const size_t dm = WS_SCR + ((flags & 8) ? 48 : 96) * MiB; xo = F(dm); ap = H(dm + 32 * MiB); sp = (u64_t*)(ws + dm + 48 * MiB); }
            if (kind == EK_RES) { EpiRes<false> E{F(WS_X), xo, ap, sp, F(gate), has_next ? F(gmn) : nullptr}; E(acc, u, wr, wc, fr, fq); }
            else { EpiRes<true> E{F(WS_X), xo, ap, sp, F(gate), F(gmn)}; E(acc, u, wr, wc, fr, fq); } } break;
        case EK_UPRAW: { EpiUpRaw E{(const u64_t*)(ws + ss1 + (size_t)M * 8), F(sw1 + (size_t)5 * SW_STRIDE * 4), H(WS_SCR + (size_t)((flags >> 2) & 1) * (88 * MiB))}; E(acc, u, wr, wc, fr, fq); } break;
        case EK_UPCONV: { EpiUpConv E{(const u64_t*)(ws + ss1 + (size_t)M * 8), F(sw1 + (size_t)5 * SW_STRIDE * 4), in29 + (size_t)l * 3 * NUP, in30 + (size_t)l * NUP, H(WS_ACT), F(WS_EDGE), H(WS_SCR + (size_t)blockIdx.x * 131072)}; E(acc, u, wr, wc, fr, fq); } break;
        case EK_QKV: { EpiQKV E{(const u64_t*)(ws + ss1), F(sw1), H(SCR_Q), H(SCR_KB), H(SCR_VB), out + 8388608, out + 8388608 + 2097152, F(WS_ROPE), F(WS_ROPE) + 32768, l / 3}; E(acc, u, wr, wc, fr, fq); } break;
        default: { EpiHin E{(const u64_t*)(ws + ss1), F(sw1), F(WS_LB1), H(SCR_HQ), H(SCR_HV), H(SCR_HG), F(SCR_LFF), F(SCR_LFB)}; E(acc, u, wr, wc, fr, fq); } break;
        }
    }
};
}
namespace om {
#define LDS_WAIT() asm volatile("s_waitcnt lgkmcnt(0)" ::: "memory")
__device__ __forceinline__ void transpose_item(const float* W, int K, int N, bf16_t* WT, LAS float* scr, int item, int lane) {
    const int nblk = N / 32, kb = item / nblk, nb = item % nblk, k0 = 32 * kb, n0 = 32 * nb;
#pragma unroll 8
    for (int i = 0; i < 16; ++i) { const int kk = 2 * i + (lane >> 5); scr[kk * 33 + (lane & 31)] = W[(size_t)(k0 + kk) * N + n0 + (lane & 31)]; }
    LDS_WAIT(); asm volatile("" ::: "memory");
    const int c = lane & 3;
#pragma unroll
    for (int j = 0; j < 2; ++j) { const int n = (lane >> 2) + 16 * j; const LAS float* s = scr + (8 * c) * 33 + n;
        u32x4 o; o.x = cvtpk(s[0 * 33], s[1 * 33]); o.y = cvtpk(s[2 * 33], s[3 * 33]); o.z = cvtpk(s[4 * 33], s[5 * 33]); o.w = cvtpk(s[6 * 33], s[7 * 33]);
        *(u32x4*)(WT + (size_t)(n0 + n) * K + k0 + 8 * c) = o; }
    LDS_WAIT(); asm volatile("" ::: "memory");
}
__device__ __forceinline__ float modsum(const Ctx& C, int l, int c, int idx) {
    const float* mp = C.f(WS_MODP) + ((size_t)l * 5 + c) * 6144 + idx; float s = C.in(9)[l * 6144 + idx];
#pragma unroll
    for (int kp = 0; kp < 4; ++kp) s += mp[(size_t)kp * 4 * 5 * 6144];
    return s;
}
__device__ __forceinline__ void phase_p0a(const Ctx& C) {
    const int gw = C.bid * NWAVES + C.wave, NGW = C.G * NWAVES, gt = C.bid * NTHREADS + C.tid, NGT = C.G * NTHREADS;
    LAS float* scr = (LAS float*)(C.lds + C.wave * 4352);
#define DO_MAT(src, dst, K, N) for (int it = gw; it < ((K) / 32) * ((N) / 32); it += NGW) transpose_item((src), (K), (N), (dst), scr, it, C.lane)
    for (int j = 0; j < 2; ++j) { DO_MAT(C.in(12) + (size_t)j * D * NQKV, C.h(WS_WQKV) + (size_t)j * NQKV * D, D, NQKV); DO_MAT(C.in(13) + (size_t)j * D * D, C.h(WS_WO) + (size_t)j * D * D, D, D); }
    DO_MAT(C.in(15), C.h(WS_HWIN), D, NHIN); DO_MAT(C.in(18), C.h(WS_HWO), D, D); DO_MAT(C.in(27), C.h(WS_GLU), D, 2048);
    for (int l = 0; l < 4; ++l) { DO_MAT(C.in(28) + (size_t)l * D * NUP, C.h(WS_UP) + (size_t)l * NUP * D, D, NUP); DO_MAT(C.in(31) + (size_t)l * DFF * D, C.h(WS_DOWN) + (size_t)l * D * DFF, DFF, D); }
#undef DO_MAT
    __syncthreads();
    LAS float* sS = (LAS float*)(C.lds + 40960);
    LAS float* red = (LAS float*)(C.lds);
    for (int it = C.bid; it < 384; it += C.G) {
        const int l = it / 96, cb = (it % 96) >> 2, kp = it & 3;
        for (int i = C.tid; i < 5 * 256; i += NTHREADS) { const int c = i >> 8, k = kp * 256 + (i & 255); const float v = c == 0 ? C.in(7)[k] : C.in(6)[(c - 1) * 1024 + k]; sS[i] = v / (1.f + __expf(-v)); }
        __syncthreads();
        f32x4 a[5];
#pragma unroll
        for (int c = 0; c < 5; ++c) a[c] = (f32x4){0.f, 0.f, 0.f, 0.f};
        const float* wp = C.in(8) + ((size_t)l * 1024 + kp * 256 + C.wave * 32) * 6144 + cb * 256 + 4 * C.lane;
#pragma unroll 4
        for (int k = 0; k < 32; ++k) { const f32x4 w = *(const f32x4*)(wp + (size_t)k * 6144);
#pragma unroll
            for (int c = 0; c < 5; ++c) a[c] += w * sS[c * 256 + C.wave * 32 + k]; }
#pragma unroll
        for (int c = 0; c < 5; ++c) *(LAS f32x4*)(red + (C.wave * 5 + c) * 256 + 4 * C.lane) = a[c];
        __syncthreads();
        for (int i = C.tid; i < 5 * 256; i += NTHREADS) { float s = 0.f;
#pragma unroll
            for (int w = 0; w < 8; ++w) s += red[w * 1280 + i];
            C.f(WS_MODP)[(((size_t)kp * 4 + l) * 5 + (i >> 8)) * 6144 + cb * 256 + (i & 255)] = s; }
        __syncthreads();
    }
    for (int i = gt; i < 9 * M; i += NGT) ((u64_t*)(C.ws + WS_SS))[i] = 0ull;
    for (int i = gt; i < 1024 * 32; i += NGT) { const int t = i >> 5, e = i & 31, fi = e & 15; const float pos = (e >> 4) == 0 ? (float)(t >> 6) : (float)(t & 63);
        const float ang = pos * (1.0f / powf(10000.0f, (float)(2 * fi) / 32.0f)); C.f(WS_ROPE)[i] = cosf(ang); C.f(WS_ROPE)[32768 + i] = sinf(ang); }
    for (int i = gt; i < 2 * 131072; i += NGT) { const int which = i >> 17, e = (i & 131071) * 8; const float* s = (which ? C.in(3) : C.in(2)) + e; const f32x4 a = *(const f32x4*)s, b = *(const f32x4*)(s + 4);
        u32x4 o; o.x = cvtpk(a[0], a[1]); o.y = cvtpk(a[2], a[3]); o.z = cvtpk(b[0], b[1]); o.w = cvtpk(b[2], b[3]); *(u32x4*)(C.h(which ? WS_CTXV : WS_CTXK) + e) = o; }
    for (int i = gt; i < 2048; i += NGT) { float v[4], mx = -1e30f;
#pragma unroll
        for (int l = 0; l < 4; ++l) { v[l] = C.in(16)[l * 2048 + i]; mx = fmaxf(mx, v[l]); }
        float s = 0.f;
#pragma unroll
        for (int l = 0; l < 4; ++l) { v[l] = expf(v[l] - mx); s += v[l]; }
        C.f(WS_LB1)[i] = v[1] / s; }
    for (int i = gt; i < 8192; i += NGT) {
        const int dg = i >> 6, p = i & 63;
        const float ar = fminf(C.in(19)[i], -1e-4f), ai = C.in(20)[i], dt = expf(C.in(21)[dg]);
        const float e = expf(ar * dt), lr = e * cosf(ai * dt), li = e * sinf(ai * dt);
        const float den = ar * ar + ai * ai, fr = ((lr - 1.f) * ar + li * ai) / den, fi = (li * ar - (lr - 1.f) * ai) / den;
        C.f(WS_SLAM)[2 * i] = lr; C.f(WS_SLAM)[2 * i + 1] = li;
        unsigned wr_[8], wi_[8];
#pragma unroll
        for (int q = 0; q < 8; ++q) { const float x0 = C.in(22)[(size_t)i * 16 + 2 * q], y0 = C.in(23)[(size_t)i * 16 + 2 * q], x1 = C.in(22)[(size_t)i * 16 + 2 * q + 1], y1 = C.in(23)[(size_t)i * 16 + 2 * q + 1];
            wr_[q] = cvtpk(fr * x0 - fi * y0, fr * x1 - fi * y1); wi_[q] = cvtpk(fr * y0 + fi * x0, fr * y1 + fi * x1); }
        bf16_t* bb = C.h(WS_SBB) + ((size_t)dg * 128 + p) * 16;
        *(u32x4*)bb = (u32x4){wr_[0], wr_[1], wr_[2], wr_[3]}; *(u32x4*)(bb + 8) = (u32x4){wr_[4], wr_[5], wr_[6], wr_[7]};
        *(u32x4*)(bb + 64 * 16) = (u32x4){wi_[0], wi_[1], wi_[2], wi_[3]}; *(u32x4*)(bb + 64 * 16 + 8) = (u32x4){wi_[4], wi_[5], wi_[6], wi_[7]};
    }
    for (int i = gt; i < 2 * 64 * 16 * 64; i += NGT) {
        const int p = i & 63, row = i >> 6; bf16_t* cb = C.h(WS_SCB) + (size_t)row * 128;
        cb[p] = (bf16_t)(cvtpk(C.in(24)[i], 0.f) & 0xffffu); cb[64 + p] = (bf16_t)(cvtpk(-C.in(25)[i], 0.f) & 0xffffu); }
}
__device__ __forceinline__ void rows_ap_ss(const Ctx& C, const float* xsrc_p, const float* xsrc_s, float* xcopy, int l, int s, bool from_table, u64_t* ssdst) {
    for (int gw = C.bid * NWAVES + C.wave; gw < M / 4; gw += C.G * NWAVES) {
    const int r0 = gw * 4;
    const int c = cond_of_row(r0);
    f32x4 gm[4];
#pragma unroll
    for (int j = 0; j < 4; ++j) { const int n = 4 * C.lane + 256 * j;
        if (from_table) gm[j] = *(const f32x4*)(C.f(WS_GMOD) + (((size_t)l * 2 + s) * 5 + c) * 1024 + n);
        else { const float* g = (s == 0 ? C.in(10) : C.in(11)) + l * D + n;
#pragma unroll
            for (int e = 0; e < 4; ++e) gm[j][e] = g[e] * (1.f + modsum(C, l, c, (s == 0 ? 1 : 4) * 1024 + n + e)); } }
    for (int rr = 0; rr < 4; ++rr) {
        const int r = r0 + rr; const float* xr = (r < MP ? xsrc_p + (size_t)r * D : xsrc_s + (size_t)(r - MP) * D);
        f32x4 v[4]; float sq = 0.f;
#pragma unroll
        for (int j = 0; j < 4; ++j) { v[j] = *(const f32x4*)(xr + 4 * C.lane + 256 * j); sq += (v[j][0] * v[j][0] + v[j][1] * v[j][1]) + (v[j][2] * v[j][2] + v[j][3] * v[j][3]); }
        sq = wave_sum(sq);
#pragma unroll
        for (int j = 0; j < 4; ++j) { const size_t off = (size_t)r * D + 4 * C.lane + 256 * j; if (xcopy) *(f32x4*)(xcopy + off) = v[j]; st_bf16x4(C.h(WS_AP) + off, v[j] * gm[j]); }
        if (C.lane == 0) ssdst[r] = (u64_t)(sq * SS_FIX);
    }
    }
}
__device__ __forceinline__ void phase_p0c(const Ctx& C) {
    for (int vb = C.bid; vb < 256; vb += C.G) {
    if (vb < 240) {
        int ch = vb, l = 0, s = 0, N = 0; const bf16_t* Wt = nullptr;
        if (ch < 12) { l = 0; s = 0; N = NQKV; Wt = C.h(WS_WQKV); }
        else if ((ch -= 12) < 44) { l = 0; s = 1; N = NUP; Wt = C.h(WS_UP); }
        else if ((ch -= 44) < 40) { l = 1; s = 0; N = NHIN; Wt = C.h(WS_HWIN); }
        else if ((ch -= 40) < 44) { l = 1; s = 1; N = NUP; Wt = C.h(WS_UP) + (size_t)1 * NUP * D; }
        else if ((ch -= 44) < 44) { l = 2; s = 1; N = NUP; Wt = C.h(WS_UP) + (size_t)2 * NUP * D; }
        else if ((ch -= 44) < 12) { l = 3; s = 0; N = NQKV; Wt = C.h(WS_WQKV) + (size_t)1 * NQKV * D; }
        else { ch -= 12; l = 3; s = 1; N = NUP; Wt = C.h(WS_UP) + (size_t)3 * NUP * D; }
        LAS float* sh = (LAS float*)C.lds;
        for (int i = C.tid; i < 5 * 1024; i += NTHREADS) sh[i] = modsum(C, l, i >> 10, (s == 0 ? 0 : 3) * 1024 + (i & 1023));
        __syncthreads();
        for (int q = 0; q < 16; ++q) {
            const int n = ch * 128 + C.wave * 16 + q;
            const u32x4 w0 = *(const u32x4*)(Wt + (size_t)n * D + 16 * C.lane), w1 = *(const u32x4*)(Wt + (size_t)n * D + 16 * C.lane + 8);
            float wv[16];
#pragma unroll
            for (int e = 0; e < 4; ++e) { wv[2 * e] = bflo(w0[e]); wv[2 * e + 1] = bfhi(w0[e]); wv[8 + 2 * e] = bflo(w1[e]); wv[8 + 2 * e + 1] = bfhi(w1[e]); }
            float a[5];
#pragma unroll
            for (int c = 0; c < 5; ++c) { a[c] = 0.f;
#pragma unroll
                for (int e = 0; e < 16; ++e) a[c] += wv[e] * sh[c * 1024 + 16 * C.lane + e]; a[c] = wave_sum(a[c]); }
            if (C.lane == 0) {
#pragma unroll
                for (int c = 0; c < 5; ++c) C.f(WS_SW)[(((size_t)l * 2 + s) * 5 + c) * SW_STRIDE + n] = a[c]; }
        }
    } else {
        const int t = (vb - 240) * NTHREADS + C.tid, NT = 16 * NTHREADS;
        for (int i = t; i < 4 * 5 * 6144; i += NT) { const int l = i / 30720, c = (i / 6144) % 5, idx = i % 6144; C.f(WS_MOD)[i] = modsum(C, l, c, idx); }
        for (int i = t; i < 4 * 2 * 5 * 1024; i += NT) { const int n = i & 1023, c = (i >> 10) % 5, s = (i / 5120) & 1, l = i / 10240;
            C.f(WS_GMOD)[i] = (s == 0 ? C.in(10) : C.in(11))[l * D + n] * (1.f + modsum(C, l, c, (s == 0 ? 1 : 4) * 1024 + n)); }
    }
    __syncthreads();
    }
    rows_ap_ss(C, C.in(0), C.in(1), C.f(WS_X), 0, 0, false, (u64_t*)(C.ws + WS_SS));
}
__device__ __forceinline__ void phase_glue(const Ctx& C, int l, int s) { rows_ap_ss(C, C.f(WS_X), C.f(WS_X) + (size_t)MP * D, nullptr, l, s, true, (u64_t*)(C.ws + WS_SS) + (size_t)(l * 2 + s) * M); }

__device__ __forceinline__ void phase_conv(const Ctx& C, int l) {
    const bf16_t* h = C.h(WS_SCR); bf16_t* act = C.h(WS_ACT); const float* cw = C.in(29) + (size_t)l * 3 * NUP; const float* cb = C.in(30) + (size_t)l * NUP;
    const int gt = C.bid * NTHREADS + C.tid, NGT = C.G * NTHREADS;
    for (int i = gt; i < M * (DFF / 8); i += NGT) {
        const int r = i / (DFF / 8), n = (i % (DFF / 8)) * 8;
        int t, S; if (r < MP) { t = r & 255; S = 256; } else { t = (r - MP) & 1023; S = 1024; }
        float g[8], v[8];
#pragma unroll
        for (int e = 0; e < 8; ++e) { g[e] = cb[n + e]; v[e] = cb[DFF + n + e]; }
#pragma unroll
        for (int jj = 0; jj < 3; ++jj) { const int tt = t + jj - 1; if (tt >= 0 && tt < S) {
            const u32x4 hg = *(const u32x4*)(h + (size_t)(r + jj - 1) * NUP + n), hv = *(const u32x4*)(h + (size_t)(r + jj - 1) * NUP + DFF + n);
#pragma unroll
            for (int e = 0; e < 4; ++e) { g[2 * e] += cw[jj * NUP + n + 2 * e] * bflo(hg[e]); g[2 * e + 1] += cw[jj * NUP + n + 2 * e + 1] * bfhi(hg[e]);
                v[2 * e] += cw[jj * NUP + DFF + n + 2 * e] * bflo(hv[e]); v[2 * e + 1] += cw[jj * NUP + DFF + n + 2 * e + 1] * bfhi(hv[e]); } } }
        u32x4 o;
#pragma unroll
        for (int e = 0; e < 4; ++e) o[e] = cvtpk(g[2 * e] * sigm(g[2 * e]) * v[2 * e], g[2 * e + 1] * sigm(g[2 * e + 1]) * v[2 * e + 1]);
        *(u32x4*)(act + (size_t)r * DFF + n) = o;
    }
}
__device__ __forceinline__ void phase_final(const Ctx& C, float dbg) {
    const int gw = C.bid * NWAVES + C.wave, NGW = C.G * NWAVES; const u64_t* ss = (const u64_t*)(C.ws + WS_SS) + (size_t)8 * M;
    for (int r = gw; r < M; r += NGW) { const float rs = rstd_of(ss, r);
#pragma unroll
        for (int j = 0; j < 4; ++j) { const int n = 4 * C.lane + 256 * j; float* p = C.out + (size_t)r * D + n; *(f32x4*)p = *(const f32x4*)p * (rs * dbg) * *(const f32x4*)(C.in(32) + n); } }
}
}
namespace om {
__device__ __forceinline__ int rowidx(int r, int h) { return (r & 3) + 8 * (r >> 2) + 4 * h; }
__device__ __forceinline__ float xhalf(float v) {
    auto rr = __builtin_amdgcn_permlane32_swap(__float_as_uint(v), __float_as_uint(v), false, false);
    return __uint_as_float((threadIdx.x & 32) ? rr[0] : rr[1]);
}
__device__ __forceinline__ bf16x8 pack8(const f32x16& x, int base) {
    u32x4 w; w.x = cvtpk(x[base], x[base + 1]); w.y = cvtpk(x[base + 2], x[base + 3]); w.z = cvtpk(x[base + 4], x[base + 5]); w.w = cvtpk(x[base + 6], x[base + 7]);
    return __builtin_bit_cast(bf16x8, w);
}
__device__ __forceinline__ bf16x8 cat44(u32x2 a, u32x2 b) { u32x4 w = {a.x, a.y, b.x, b.y}; return __builtin_bit_cast(bf16x8, w); }

constexpr int AT_KSTR = 144;
constexpr int AT_BUF = 2 * 64 * AT_KSTR;
__device__ __forceinline__ void attn_unit(const Ctx& C, int j, bool samp, int b, int hq, int qb, size_t obuf) {
    const int lane = C.lane, c = lane & 31, h = lane >> 5, w = C.wave, kvh = hq >> 2;
    const int rowbase = samp ? MP + b * 1024 : b * 256, q0 = qb * 256, qlo = q0 + 32 * w;
    const bf16_t* Q = C.h(SCR_Q); const bf16_t* KB = C.h(SCR_KB); const bf16_t* VB = C.h(SCR_VB);
    const bf16_t* CK = C.h(WS_CTXK) + ((size_t)(b * 2 + j) * 512) * 256; const bf16_t* CV = C.h(WS_CTXV) + ((size_t)(b * 2 + j) * 512) * 256;
    int klo = 0, nlat = 4, NT = 4;
    if (samp) { klo = q0 - 128 < 0 ? 0 : q0 - 128; const int khi = q0 + 384 > 1024 ? 1024 : q0 + 384; nlat = (khi - klo) >> 6; NT = nlat + 8; }
    bf16x8 qf[4];
#pragma unroll
    for (int s = 0; s < 4; ++s) qf[s] = *(const bf16x8*)(Q + (size_t)(rowbase + qlo + c) * D + hq * 64 + 16 * s + 8 * h);
    float m = C.in(14)[j * 16 + hq] * LOG2E, lsum = h == 0 ? 1.f : 0.f;
    f32x16 o0 = {}, o1 = {};
    const int lkey = C.tid >> 3, lch = C.tid & 7;
    auto src_k = [&](int t) -> const bf16_t* { return (t < nlat ? KB + (size_t)(rowbase + klo + 64 * t + lkey) * 256 : CK + (size_t)(64 * (t - nlat) + lkey) * 256) + kvh * 64 + lch * 8; };
    auto src_v = [&](int t) -> const bf16_t* { return (t < nlat ? VB + (size_t)(rowbase + klo + 64 * t + lkey) * 256 : CV + (size_t)(64 * (t - nlat) + lkey) * 256) + kvh * 64 + lch * 8; };
    auto put = [&](int buf, u32x4 kr, u32x4 vr) {
        LAS unsigned char* kb = C.lds + buf * AT_BUF; LAS unsigned char* vb = kb + 64 * AT_KSTR;
        *(LAS u32x4*)(kb + lkey * AT_KSTR + lch * 16) = kr;
#pragma unroll
        for (int e = 0; e < 4; ++e) { *(LAS unsigned short*)(vb + (lch * 8 + 2 * e) * AT_KSTR + lkey * 2) = (unsigned short)(vr[e] & 0xffffu); *(LAS unsigned short*)(vb + (lch * 8 + 2 * e + 1) * AT_KSTR + lkey * 2) = (unsigned short)(vr[e] >> 16); }
    };
    { const u32x4 kr = *(const u32x4*)src_k(0), vr = *(const u32x4*)src_v(0); put(0, kr, vr); }
    __syncthreads();
    for (int t = 0; t < NT; ++t) {
        u32x4 kr = {}, vr = {};
        if (t + 1 < NT) { kr = *(const u32x4*)src_k(t + 1); vr = *(const u32x4*)src_v(t + 1); }
        const bool lat = samp && t < nlat; const int key0 = klo + 64 * t;
        const bool skip = lat && (key0 > qlo + 31 + 128 || key0 + 63 < qlo - 128);
        if (!skip) {
            LAS unsigned char* kb = C.lds + (t & 1) * AT_BUF; LAS unsigned char* vb = kb + 64 * AT_KSTR;
            f32x16 x0 = {}, x1 = {};
#pragma unroll
            for (int s = 0; s < 4; ++s) {
                const bf16x8 a0 = *(const LAS bf16x8*)(kb + c * AT_KSTR + (16 * s + 8 * h) * 2), a1 = *(const LAS bf16x8*)(kb + (32 + c) * AT_KSTR + (16 * s + 8 * h) * 2);
                x0 = __builtin_amdgcn_mfma_f32_32x32x16_bf16(a0, qf[s], x0, 0, 0, 0); x1 = __builtin_amdgcn_mfma_f32_32x32x16_bf16(a1, qf[s], x1, 0, 0, 0);
            }
            if (lat && !(key0 >= qlo + 31 - 128 && key0 + 63 <= qlo + 128)) {
                const int tq = qlo + c;
#pragma unroll
                for (int r = 0; r < 16; ++r) { const int k0 = key0 + rowidx(r, h) - tq; if (k0 > 128 || k0 < -128) x0[r] = -INFINITY; if (k0 + 32 > 128 || k0 + 32 < -128) x1[r] = -INFINITY; }
            }
            float mx = fmaxf(x0[0], x1[0]);
#pragma unroll
            for (int r = 1; r < 16; ++r) mx = fmaxf(mx, fmaxf(x0[r], x1[r]));
            mx = fmaxf(mx, xhalf(mx));
            const float mn = fmaxf(m, mx), al = __builtin_amdgcn_exp2f(m - mn); m = mn;
            float ps = 0.f;
#pragma unroll
            for (int r = 0; r < 16; ++r) { x0[r] = __builtin_amdgcn_exp2f(x0[r] - mn); x1[r] = __builtin_amdgcn_exp2f(x1[r] - mn); ps += x0[r] + x1[r]; }
            lsum = lsum * al + ps;
#pragma unroll
            for (int r = 0; r < 16; ++r) { o0[r] *= al; o1[r] *= al; }
#pragma unroll
            for (int ks = 0; ks < 2; ++ks) {
                const bf16x8 p0 = pack8(x0, 8 * ks), p1 = pack8(x1, 8 * ks);
#pragma unroll
                for (int dt = 0; dt < 2; ++dt) {
                    const LAS unsigned char* vrow = vb + (32 * dt + c) * AT_KSTR + (16 * ks + 4 * h) * 2;
                    const bf16x8 v0 = cat44(*(const LAS u32x2*)(vrow), *(const LAS u32x2*)(vrow + 16)), v1 = cat44(*(const LAS u32x2*)(vrow + 64), *(const LAS u32x2*)(vrow + 80));
                    if (dt == 0) { o0 = __builtin_amdgcn_mfma_f32_32x32x16_bf16(v0, p0, o0, 0, 0, 0); o0 = __builtin_amdgcn_mfma_f32_32x32x16_bf16(v1, p1, o0, 0, 0, 0); }
                    else { o1 = __builtin_amdgcn_mfma_f32_32x32x16_bf16(v0, p0, o1, 0, 0, 0); o1 = __builtin_amdgcn_mfma_f32_32x32x16_bf16(v1, p1, o1, 0, 0, 0); }
                }
            }
        }
        if (t + 1 < NT) put((t + 1) & 1, kr, vr);
        __syncthreads();
    }
    lsum += xhalf(lsum);
    const float il = 1.f / lsum;
    bf16_t* O = C.h(obuf) + (size_t)(rowbase + qlo + c) * D + hq * 64 + 4 * h;
#pragma unroll
    for (int g = 0; g < 4; ++g) { st_bf16x4(O + 8 * g, (f32x4){o0[4 * g], o0[4 * g + 1], o0[4 * g + 2], o0[4 * g + 3]} * il); st_bf16x4(O + 32 + 8 * g, (f32x4){o1[4 * g], o1[4 * g + 1], o1[4 * g + 2], o1[4 * g + 3]} * il); }
}
__device__ __forceinline__ void phase_attn(const Ctx& C, int l, size_t obuf) {
    const int j = l / 3;
    for (int u = C.bid; u < 512; u += C.G) {
        if (u < 256) attn_unit(C, j, false, u >> 4, u & 15, 0, obuf);
        else { const int v = u - 256; attn_unit(C, j, true, v >> 6, (v >> 2) & 15, v & 3, obuf); }
    }
}
constexpr size_t CKS_TAB = 376 * MiB; constexpr int CKS_NW = (int)((268 * MiB) / 65536), CKS_NO = (17039360 * 4) / 65536, CKS_N = CKS_NW + CKS_NO;
__device__ __forceinline__ void phase_cks(const Ctx& C, int slot) {
    const int gw = C.bid * NWAVES + C.wave, NGW = C.G * NWAVES; unsigned* tab = (unsigned*)(C.ws + CKS_TAB) + (size_t)slot * 8192;
    for (int ck = gw; ck < CKS_N; ck += NGW) {
        const unsigned char* base = ck < CKS_NW ? C.ws + 108 * MiB + (size_t)ck * 65536 : (const unsigned char*)C.out + (size_t)(ck - CKS_NW) * 65536; unsigned s = 0;
        for (int i = 0; i < 64; ++i) { const u32x4 v = *(const u32x4*)(base + (size_t)i * 1024 + C.lane * 16); s += v[0] + v[1] * 3u + v[2] * 5u + v[3] * 7u; }
#pragma unroll
        for (int o = 1; o < 64; o <<= 1) s += (unsigned)__shfl_xor((int)s, o);
        if (C.lane == 0) tab[ck] = s;
    }
}
__device__ __forceinline__ void phase_clr(const Ctx& C) {
    const int gt = C.bid * NTHREADS + C.tid, NGT = C.G * NTHREADS; const u32x4 z = {0u, 0u, 0u, 0u};
    for (size_t i = gt; i < (268 * MiB) / 16; i += NGT) *(u32x4*)(C.ws + 108 * MiB + i * 16) = z;
    for (size_t i = gt; i < (size_t)17039360 / 4; i += NGT) *(u32x4*)((unsigned char*)C.out + i * 16) = z;
}
__device__ __forceinline__ void phase_clr2(const Ctx& C, size_t off, size_t bytes) {
    const int gt = C.bid * NTHREADS + C.tid, NGT = C.G * NTHREADS; const u32x4 z = {0u, 0u, 0u, 0u};
    for (size_t i = gt; i < bytes / 16; i += NGT) *(u32x4*)(C.ws + off + i * 16) = z;
}
__device__ __forceinline__ void phase_cmp(const Ctx& C, int nslots) {
    const int gt = C.bid * NTHREADS + C.tid, NGT = C.G * NTHREADS; const unsigned* tab = (const unsigned*)(C.ws + CKS_TAB);
    for (int i = gt; i < nslots * 8192; i += NGT) { const int sl = i >> 13, ck = i & 8191; if (ck < CKS_N && tab[(size_t)sl * 8192 + ck] != tab[(size_t)(sl + 32) * 8192 + ck]) {
#ifdef SSDET
        const int cls = ck >= CKS_NW ? 4 : (ck < 1472 + 512 ? 1 : 2); atomicOr((unsigned*)(C.ws + WS_CTL) + 4002, (unsigned)cls); atomicAdd((unsigned*)(C.ws + WS_CTL) + 4003, 1u);
#endif
        atomicMax((unsigned*)(C.ws + WS_CTL) + 4001, (unsigned)(1000 - sl)); } }
}
__device__ __forceinline__ void phase_chk(const Ctx& C, size_t a, size_t b, size_t bytes) {
    const int gt = C.bid * NTHREADS + C.tid, NGT = C.G * NTHREADS; unsigned bad = 0;
    for (size_t i = gt; i < bytes / 16; i += NGT) { const u32x4 x = *(const u32x4*)(C.ws + a + i * 16), y = *(const u32x4*)(C.ws + b + i * 16); bad += (x[0] != y[0]) | (x[1] != y[1]) | (x[2] != y[2]) | (x[3] != y[3]); }
    if (bad) atomicAdd((unsigned*)(C.ws + WS_CTL) + 4000, bad);
}

constexpr int HS_QSTR = 272, HS_TSTR = 80;
constexpr int HS_QT = 0, HS_KT = 32 * HS_QSTR, HS_KTT = 2 * 32 * HS_QSTR, HS_VT = HS_KTT + 128 * HS_TSTR, HS_E1 = HS_VT + 128 * HS_TSTR, HS_E2 = HS_E1 + 512, HS_T1 = HS_E2 + 512, HS_GRP = HS_T1 + 512;
__device__ __forceinline__ void hscan_item(const Ctx& C, int item, int gi) {
    const bool samp = item < 64; const int it = samp ? item : item - 64;
    const int dir = it & 1, hd = (it >> 1) & 7, sq = it >> 4;
    const int S = samp ? 1024 : 256, rowbase = samp ? MP + sq * 1024 : sq * 256, nchunk = S >> 5;
    const int tg = C.tid & 255, lane = C.lane, c = lane & 31, h = lane >> 5, w4 = C.wave & 3;
    LAS unsigned char* L = C.lds + gi * HS_GRP;
    const bf16_t* HQ = C.h(SCR_HQ); const bf16_t* HV = C.h(SCR_HV); const float* LF = C.f(dir == 0 ? SCR_LFF : SCR_LFB); float* OD = C.f(dir == 0 ? SCR_OF : SCR_OB);
    f32x16 St[4];
#pragma unroll
    for (int dt = 0; dt < 4; ++dt) {
        if (samp) { const float* s0 = C.in(4) + ((((size_t)sq * 2 + dir) * 8 + hd) * 128) * 128;
#pragma unroll
            for (int r = 0; r < 16; ++r) St[dt][r] = s0[(size_t)(32 * dt + rowidx(r, h)) * 128 + 32 * w4 + c]; }
        else St[dt] = (f32x16){};
    }
    const int pd = tg & 127, ph = tg >> 7;
    for (int ch = 0; ch < nchunk; ++ch) {
        float cl[16], qv[16], kv[16];
        {
            float run = 0.f;
#pragma unroll
            for (int i = 0; i < 16; ++i) { const int pos = 32 * ch + 16 * ph + i, t = dir == 0 ? pos : S - 1 - pos; const size_t off = (size_t)(rowbase + t) * D + hd * 128 + pd;
                const float lf = LF[off]; run += lf; cl[i] = run; kv[i] = 1.f - __expf(lf); qv[i] = bf2f(HQ[off]); }
            if (ph == 0) *(LAS float*)(L + HS_T1 + pd * 4) = run;
        }
        unsigned vtw[8];
#pragma unroll
        for (int i = 0; i < 8; ++i) { const int pos = 32 * ch + 16 * ph + 2 * i, t0 = dir == 0 ? pos : S - 1 - pos, t1 = dir == 0 ? pos + 1 : S - 2 - pos;
            vtw[i] = (unsigned)HV[(size_t)(rowbase + t0) * D + hd * 128 + pd] | ((unsigned)HV[(size_t)(rowbase + t1) * D + hd * 128 + pd] << 16); }
        __syncthreads();
        {
            const float t1v = *(LAS float*)(L + HS_T1 + pd * 4);
            unsigned ktw[8];
#pragma unroll
            for (int i = 0; i < 16; i += 2) {
                const float e0 = ph == 0 ? cl[i] - t1v : cl[i], e1 = ph == 0 ? cl[i + 1] - t1v : cl[i + 1];
                const float q0 = qv[i] * __expf(e0), q1 = qv[i + 1] * __expf(e1), k0 = kv[i] * __expf(-e0), k1 = kv[i + 1] * __expf(-e1);
                const unsigned qw0 = cvtpk(q0, 0.f), qw1 = cvtpk(q1, 0.f), kw = cvtpk(k0, k1);
                *(LAS unsigned short*)(L + HS_QT + (16 * ph + i) * HS_QSTR + pd * 2) = (unsigned short)qw0; *(LAS unsigned short*)(L + HS_QT + (16 * ph + i + 1) * HS_QSTR + pd * 2) = (unsigned short)qw1;
                *(LAS unsigned short*)(L + HS_KT + (16 * ph + i) * HS_QSTR + pd * 2) = (unsigned short)(kw & 0xffffu); *(LAS unsigned short*)(L + HS_KT + (16 * ph + i + 1) * HS_QSTR + pd * 2) = (unsigned short)(kw >> 16);
                ktw[i >> 1] = kw;
            }
            *(LAS u32x4*)(L + HS_KTT + pd * HS_TSTR + ph * 32) = (u32x4){ktw[0], ktw[1], ktw[2], ktw[3]}; *(LAS u32x4*)(L + HS_KTT + pd * HS_TSTR + ph * 32 + 16) = (u32x4){ktw[4], ktw[5], ktw[6], ktw[7]};
            *(LAS u32x4*)(L + HS_VT + pd * HS_TSTR + ph * 32) = (u32x4){vtw[0], vtw[1], vtw[2], vtw[3]}; *(LAS u32x4*)(L + HS_VT + pd * HS_TSTR + ph * 32 + 16) = (u32x4){vtw[4], vtw[5], vtw[6], vtw[7]};
            if (ph == 0) *(LAS float*)(L + HS_E1 + pd * 4) = __expf(t1v); else *(LAS float*)(L + HS_E2 + pd * 4) = __expf(cl[15]);
        }
        __syncthreads();
#pragma unroll
        for (int dt = 0; dt < 4; ++dt)
#pragma unroll
            for (int g = 0; g < 4; ++g) { const f32x4 e = *(const LAS f32x4*)(L + HS_E1 + (32 * dt + 8 * g + 4 * h) * 4);
#pragma unroll
                for (int q = 0; q < 4; ++q) St[dt][4 * g + q] *= e[q]; }
        f32x16 X = {};
#pragma unroll
        for (int s = 0; s < 8; ++s) {
            const bf16x8 a = *(const LAS bf16x8*)(L + HS_KT + c * HS_QSTR + (16 * s + 8 * h) * 2), bq = *(const LAS bf16x8*)(L + HS_QT + c * HS_QSTR + (16 * s + 8 * h) * 2);
            X = __builtin_amdgcn_mfma_f32_32x32x16_bf16(a, bq, X, 0, 0, 0);
        }
#pragma unroll
        for (int r = 0; r < 16; ++r) if (rowidx(r, h) > c) X[r] = 0.f;
        f32x16 OT = {};
#pragma unroll
        for (int ks = 0; ks < 2; ++ks) {
            const LAS unsigned char* vrow = L + HS_VT + (32 * w4 + c) * HS_TSTR + (16 * ks + 4 * h) * 2;
            const bf16x8 va = cat44(*(const LAS u32x2*)(vrow), *(const LAS u32x2*)(vrow + 16));
            OT = __builtin_amdgcn_mfma_f32_32x32x16_bf16(va, pack8(X, 8 * ks), OT, 0, 0, 0);
        }
#pragma unroll
        for (int dt = 0; dt < 4; ++dt)
#pragma unroll
            for (int ks = 0; ks < 2; ++ks) {
                const LAS unsigned char* qrow = L + HS_QT + c * HS_QSTR + (32 * dt + 16 * ks + 4 * h) * 2;
                const bf16x8 bq = cat44(*(const LAS u32x2*)(qrow), *(const LAS u32x2*)(qrow + 16));
                OT = __builtin_amdgcn_mfma_f32_32x32x16_bf16(pack8(St[dt], 8 * ks), bq, OT, 0, 0, 0);
            }
#pragma unroll
        for (int dt = 0; dt < 4; ++dt)
#pragma unroll
            for (int ks = 0; ks < 2; ++ks) {
                const bf16x8 a = *(const LAS bf16x8*)(L + HS_KTT + (32 * dt + c) * HS_TSTR + (16 * ks + 8 * h) * 2), bv = *(const LAS bf16x8*)(L + HS_VT + (32 * w4 + c) * HS_TSTR + (16 * ks + 8 * h) * 2);
                St[dt] = __builtin_amdgcn_mfma_f32_32x32x16_bf16(a, bv, St[dt], 0, 0, 0);
            }
#pragma unroll
        for (int dt = 0; dt < 4; ++dt)
#pragma unroll
            for (int g = 0; g < 4; ++g) { const f32x4 e = *(const LAS f32x4*)(L + HS_E2 + (32 * dt + 8 * g + 4 * h) * 4);
#pragma unroll
                for (int q = 0; q < 4; ++q) St[dt][4 * g + q] *= e[q]; }
        { const int pos = 32 * ch + c, t = dir == 0 ? pos : S - 1 - pos; float* op = OD + (size_t)(rowbase + t) * D + hd * 128 + 32 * w4 + 4 * h;
#pragma unroll
            for (int g = 0; g < 4; ++g) *(f32x4*)(op + 8 * g) = (f32x4){OT[4 * g], OT[4 * g + 1], OT[4 * g + 2], OT[4 * g + 3]}; }
    }
    if (!samp) { float* so = C.out + 8388608 + 2 * 2097152 + ((((size_t)sq * 2 + dir) * 8 + hd) * 128) * 128;
#pragma unroll
        for (int dt = 0; dt < 4; ++dt)
#pragma unroll
            for (int r = 0; r < 16; ++r) so[(size_t)(32 * dt + rowidx(r, h)) * 128 + 32 * w4 + c] = St[dt][r]; }
}
__device__ __forceinline__ void phase_hscan(const Ctx& C) {
    for (int it = C.bid; it < 320; it += C.G) {
        int item = it;
        if (C.G == 256 && it >= 256) item = -1;
        if (item >= 0) { if (C.wave < 4) hscan_item(C, item, 0); else { const int nc = item < 64 ? 32 : 8; for (int q = 0; q < 2 * nc; ++q) __syncthreads(); } __syncthreads(); }
    }
    if (C.G == 256 && C.bid >= 64 && C.bid < 128) { const int item = 256 + (C.bid - 64);
        if (C.wave < 4) hscan_item(C, item, 0); else { for (int q = 0; q < 16; ++q) __syncthreads(); } __syncthreads(); }
}
__device__ __forceinline__ void phase_hpost(const Ctx& C) {
    const int gw = C.bid * NWAVES + C.wave, NGW = C.G * NWAVES;
    for (int r = gw; r < M; r += NGW) {
        const size_t off = (size_t)r * D + 16 * C.lane; float o[16]; float sq = 0.f;
#pragma unroll
        for (int q = 0; q < 4; ++q) { const f32x4 a = *(const f32x4*)(C.f(SCR_OF) + off + 4 * q), b = *(const f32x4*)(C.f(SCR_OB) + off + 4 * q);
#pragma unroll
            for (int e = 0; e < 4; ++e) { o[4 * q + e] = a[e] + b[e]; sq += o[4 * q + e] * o[4 * q + e]; } }
        sq += __shfl_xor(sq, 1); sq += __shfl_xor(sq, 2); sq += __shfl_xor(sq, 4);
        const float rs = rsqrtf(sq * (1.f / 128.f) + EPS);
        const u32x4 g0 = *(const u32x4*)(C.h(SCR_HG) + off), g1 = *(const u32x4*)(C.h(SCR_HG) + off + 8);
        const float* gn = C.in(17) + (16 * C.lane & 127);
        float sg[16];
#pragma unroll
        for (int e = 0; e < 4; ++e) { sg[2 * e] = bflo(g0[e]); sg[2 * e + 1] = bfhi(g0[e]); sg[8 + 2 * e] = bflo(g1[e]); sg[8 + 2 * e + 1] = bfhi(g1[e]); }
        u32x4 w0, w1;
#pragma unroll
        for (int e = 0; e < 4; ++e) { w0[e] = cvtpk(o[2 * e] * rs * gn[2 * e] * sg[2 * e], o[2 * e + 1] * rs * gn[2 * e + 1] * sg[2 * e + 1]);
            w1[e] = cvtpk(o[8 + 2 * e] * rs * gn[8 + 2 * e] * sg[8 + 2 * e], o[8 + 2 * e + 1] * rs * gn[8 + 2 * e + 1] * sg[8 + 2 * e + 1]); }
        *(u32x4*)(C.h(SCR_AWO) + off) = w0; *(u32x4*)(C.h(SCR_AWO) + off + 8) = w1;
    }
}

constexpr int SS_RSTR = 512;
constexpr int SS_WAVE = 16 * SS_RSTR;
__device__ __forceinline__ void sscan_seq(const Ctx& C, int l, bool samp, int sq, int dir, int g, size_t ydbg) {
    const int lane = C.lane, c = lane & 31, h = lane >> 5, dg = dir * 64 + g;
    const int S = samp ? 1024 : 256, rowbase = samp ? MP + sq * 1024 : sq * 256, nchunk = S >> 5, cond = samp ? 1 + sq : 0;
    LAS unsigned char* LB = C.lds + C.wave * SS_WAVE; LAS unsigned char* LH = LB + 4096;
    const float* X = C.f(WS_X); const u64_t* ss = (const u64_t*)(C.ws + WS_SS) + (size_t)(l * 2) * M; float* Y = C.f(ydbg ? ydbg : (dir == 0 ? SCR_YF : SCR_YB)); const bool ywr = !ydbg || dir == 0;
    bf16x8 bfr[4], cfr[4];
#pragma unroll
    for (int ct = 0; ct < 4; ++ct) bfr[ct] = *(const bf16x8*)(C.h(WS_SBB) + ((size_t)dg * 128 + 32 * ct + c) * 16 + 8 * h);
#pragma unroll
    for (int s = 0; s < 4; ++s) cfr[s] = *(const bf16x8*)(C.h(WS_SCB) + ((size_t)dg * 16 + (lane & 15)) * 128 + 32 * s + 8 * (lane >> 4));
    const float lr = C.f(WS_SLAM)[2 * (dg * 64 + lane)], li = C.f(WS_SLAM)[2 * (dg * 64 + lane) + 1];
    f32x4 gm0, gm1, sh0, sh1;
    { const float* gm = C.f(WS_GMOD) + ((size_t)(l * 2) * 5 + cond) * 1024 + g * 16 + 8 * h; gm0 = *(const f32x4*)gm; gm1 = *(const f32x4*)(gm + 4);
      const float* sh = C.f(WS_MOD) + ((size_t)l * 5 + cond) * 6144 + g * 16 + 8 * h; sh0 = *(const f32x4*)sh; sh1 = *(const f32x4*)(sh + 4); }
    float hr = 0.f, hi = 0.f;
    if (samp) { const float* s0 = C.in(5) + ((((size_t)sq * 2 + dir) * 64 + g) * 64 + lane) * 2; hr = s0[0]; hi = s0[1]; }
    for (int ch = 0; ch < nchunk; ++ch) {
        const int pos = 32 * ch + c, t = dir == 0 ? pos : S - 1 - pos, r = rowbase + t;
        const float rs = rstd_of(ss, r);
        const f32x4 x0 = *(const f32x4*)(X + (size_t)r * D + g * 16 + 8 * h), x1 = *(const f32x4*)(X + (size_t)r * D + g * 16 + 8 * h + 4);
        const f32x4 u0 = x0 * rs * gm0 + sh0, u1 = x1 * rs * gm1 + sh1;
        u32x4 uw = {cvtpk(u0[0], u0[1]), cvtpk(u0[2], u0[3]), cvtpk(u1[0], u1[1]), cvtpk(u1[2], u1[3])};
        const bf16x8 uf = __builtin_bit_cast(bf16x8, uw);
        f32x16 bu[4];
#pragma unroll
        for (int ct = 0; ct < 4; ++ct) { bu[ct] = (f32x16){}; bu[ct] = __builtin_amdgcn_mfma_f32_32x32x16_bf16(uf, bfr[ct], bu[ct], 0, 0, 0); }
#pragma unroll
        for (int hf = 0; hf < 2; ++hf) {
#pragma unroll
            for (int t8 = 0; t8 < 2; ++t8) {
#pragma unroll
                for (int ct = 0; ct < 4; ++ct)
#pragma unroll
                    for (int r4 = 0; r4 < 4; ++r4) *(LAS float*)(LB + (4 * h + r4) * 512 + (32 * ct + c) * 4) = bu[ct][8 * hf + 4 * t8 + r4];
                float br[8], bi[8]; unsigned wv[8];
#pragma unroll
                for (int k = 0; k < 8; ++k) { br[k] = *(LAS float*)(LB + k * 512 + lane * 4); bi[k] = *(LAS float*)(LB + k * 512 + 256 + lane * 4); }
#pragma unroll
                for (int k = 0; k < 8; ++k) { const float nr = lr * hr - li * hi + br[k], ni = lr * hi + li * hr + bi[k]; hr = nr; hi = ni; wv[k] = cvtpk(hr, hi); }
#pragma unroll
                for (int k = 0; k < 8; ++k) { const int row = 8 * t8 + k;
                    *(LAS unsigned short*)(LH + row * 256 + ((((lane >> 3)) ^ row) << 4) + (lane & 7) * 2) = (unsigned short)(wv[k] & 0xffffu);
                    *(LAS unsigned short*)(LH + row * 256 + (((8 + (lane >> 3)) ^ row) << 4) + (lane & 7) * 2) = (unsigned short)(wv[k] >> 16); }
                LDS_WAIT();
            }
            f32x4 y0 = {};
#pragma unroll
            for (int s = 0; s < 4; ++s) {
                const bf16x8 a0 = *(const LAS bf16x8*)(LH + (lane & 15) * 256 + (((4 * s + (lane >> 4)) ^ (lane & 15)) << 4));
                y0 = __builtin_amdgcn_mfma_f32_16x16x32_bf16(a0, cfr[s], y0, 0, 0, 0);
            }
            if (ywr) {
#pragma unroll
                for (int q = 0; q < 4; ++q) { const int p0 = 32 * ch + 16 * hf + 4 * (lane >> 4) + q, t0 = dir == 0 ? p0 : S - 1 - p0; Y[(size_t)(rowbase + t0) * D + g * 16 + (lane & 15)] = y0[q]; }
            }
            LDS_WAIT();
        }
    }
    if (!samp && !ydbg) { float* so = C.out + 8388608 + 2 * 2097152 + 4194304 + ((((size_t)sq * 2 + dir) * 64 + g) * 64 + lane) * 2; so[0] = hr; so[1] = hi; }
}
__device__ __forceinline__ void phase_sscan(const Ctx& C, int l, size_t ydbg) {
    for (int bb = C.bid; bb < 256; bb += C.G) {
        const int w = C.wave;
#ifdef SS_ONLYWAVE
        if (ydbg && !((SS_ONLYWAVE >> w) & 1)) continue;
#endif
        if (w < 2) { const int id = 2 * bb + w; sscan_seq(C, l, true, id >> 7, (id >> 6) & 1, id & 63, ydbg); }
        else { int id = 8 * bb + (w - 2); sscan_seq(C, l, false, id >> 7, (id >> 6) & 1, id & 63, ydbg);
            if (w < 4) { id = 8 * bb + 6 + (w - 2); sscan_seq(C, l, false, id >> 7, (id >> 6) & 1, id & 63, ydbg); } }
    }
}
__device__ __forceinline__ void phase_spost(const Ctx& C, int l) {
    const int gw = C.bid * NWAVES + C.wave, NGW = C.G * NWAVES; const u64_t* ss = (const u64_t*)(C.ws + WS_SS) + (size_t)(l * 2) * M;
    for (int r = gw; r < M; r += NGW) {
        const int cond = cond_of_row(r); const float rs = rstd_of(ss, r);
#pragma unroll
        for (int jq = 0; jq < 4; ++jq) {
            const int n = 4 * C.lane + 256 * jq; const size_t off = (size_t)r * D + n;
            const f32x4 x = *(const f32x4*)(C.f(WS_X) + off), gm = *(const f32x4*)(C.f(WS_GMOD) + ((size_t)(l * 2) * 5 + cond) * 1024 + n), sh = *(const f32x4*)(C.f(WS_MOD) + ((size_t)l * 5 + cond) * 6144 + n);
            const f32x4 u = x * rs * gm + sh, y = *(const f32x4*)(C.in(26) + n) * u + *(const f32x4*)(C.f(SCR_YF) + off) + *(const f32x4*)(C.f(SCR_YB) + off);
            f32x4 o;
#pragma unroll
            for (int e = 0; e < 4; ++e) { const float v = y[e], uu = 0.7978845608028654f * (v + 0.044715f * v * v * v); const float th = 1.f - 2.f / (1.f + __expf(2.f * uu)); o[e] = 0.5f * v * (1.f + th); }
            st_bf16x4(C.h(SCR_AGLU) + off, o);
        }
    }
}
#define XB_TMO      128
#define XB_XCNT(j)  (256  + 64 * (j))
#define XB_XSUB(j)  (1280 + 64 * (j))
#define XB_XGEN(j)  (2304 + 64 * (j))
#define XB_TOP      3328
#define XB_TOPGEN   3392
#define XCD_BAR_WORDS 3456
#define XB_SPIN_CAP (1u << 18)
#ifndef XB_SCOPE
#define XB_SCOPE "agent"
#endif
__device__ __forceinline__ unsigned xb_ld(unsigned* p)              { return __hip_atomic_load(p, __ATOMIC_RELAXED, __HIP_MEMORY_SCOPE_AGENT); }
__device__ __forceinline__ unsigned xb_add(unsigned* p, unsigned v) { return __hip_atomic_fetch_add(p, v, __ATOMIC_RELAXED, __HIP_MEMORY_SCOPE_AGENT); }
__device__ __forceinline__ unsigned xb_xcc_id() { return (unsigned)__builtin_amdgcn_s_getreg((3 << 11) | 20) & 0xFu; }
#define XB_SPIN(cond, bar) do { unsigned _sp = 0; while (cond) { __builtin_amdgcn_s_sleep(1); \
    if ((++_sp & 255u) == 0u) { if (xb_ld(&(bar)[XB_TMO])) break; if (_sp > XB_SPIN_CAP) { atomicAdd(&(bar)[XB_TMO], 1u); break; } } } } while (0)
struct XcdBarrier { unsigned* bar; unsigned x; volatile LAS unsigned* st; };
__device__ __forceinline__ XcdBarrier xcd_barrier_post(unsigned* bar, volatile LAS unsigned* st) {
    XcdBarrier b; b.bar = bar; b.x = xb_xcc_id(); b.st = st;
    if (threadIdx.x == 0) (void)xb_add(&bar[XB_XCNT(b.x)], 1u);
    return b;
}
__device__ __forceinline__ void xcd_barrier_complete(unsigned* bar, unsigned x, unsigned& nloc, unsigned& nx) {
    const unsigned G = gridDim.x * gridDim.y * gridDim.z;
    unsigned sum, cnt, mine, sp = 0u;
    for (;;) {
        sum = 0u; cnt = 0u; mine = 0u;
#pragma unroll
        for (unsigned j = 0; j < 16; ++j) { const unsigned c = xb_ld(&bar[XB_XCNT(j)]); sum += c; cnt += (c > 0u) ? 1u : 0u; mine = (j == x) ? c : mine; }
        if (sum == G) break;
        __builtin_amdgcn_s_sleep(1);
        if ((++sp & 255u) == 0u) { if (xb_ld(&bar[XB_TMO])) break; if (sp > XB_SPIN_CAP) { atomicAdd(&bar[XB_TMO], 1u); break; } }
    }
    nloc = mine > 0u ? mine : 1u; nx = cnt > 0u ? cnt : 1u;
}
__device__ __forceinline__ void xcd_barrier(const XcdBarrier& b) {
    asm volatile("s_waitcnt vmcnt(0)" ::: "memory");
    __syncthreads();
    if (threadIdx.x == 0) {
        unsigned* bar = b.bar;
        __builtin_amdgcn_s_waitcnt(0);
        unsigned nloc = b.st[0], nx = b.st[1];
        if (nloc == 0u) { xcd_barrier_complete(bar, b.x, nloc, nx); b.st[0] = nloc; b.st[1] = nx; }
#ifdef XB_ALL_RELEASE
        __builtin_amdgcn_fence(__ATOMIC_RELEASE, XB_SCOPE); asm volatile("s_waitcnt vmcnt(0)" ::: "memory");
#endif
        const unsigned old = xb_add(&bar[XB_XSUB(b.x)], 1u);
        const unsigned gen = old / nloc;
        if (old + 1u == (gen + 1u) * nloc) {
            __builtin_amdgcn_fence(__ATOMIC_RELEASE, XB_SCOPE);
            asm volatile("s_waitcnt vmcnt(0)" ::: "memory");
            const unsigned og = xb_add(&bar[XB_TOP], 1u);
            const unsigned tg = og / nx;
            if (og + 1u == (tg + 1u) * nx) xb_add(&bar[XB_TOPGEN], 1u);
            else XB_SPIN(xb_ld(&bar[XB_TOPGEN]) == tg, bar);
            __builtin_amdgcn_fence(__ATOMIC_ACQUIRE, XB_SCOPE);
            xb_add(&bar[XB_XGEN(b.x)], 1u);
            asm volatile("s_waitcnt vmcnt(0)" ::: "memory");
        } else {
            XB_SPIN(xb_ld(&bar[XB_XGEN(b.x)]) == gen, bar);
            __builtin_amdgcn_fence(__ATOMIC_ACQUIRE, XB_SCOPE);
            asm volatile("s_waitcnt vmcnt(0)" ::: "memory");
        }
#ifdef XB_DELAY
        for (int q = 0; q < XB_DELAY; ++q) __builtin_amdgcn_s_sleep(127);
#endif
    }
    __syncthreads();
}
}
namespace om {
enum { PH_P0A = 0, PH_P0C, PH_GLUE, PH_QKV, PH_ATTN, PH_WO, PH_HIN, PH_HSCAN, PH_HPOST, PH_HWO, PH_SSCAN, PH_SPOST, PH_GLU, PH_UP, PH_CONV, PH_DOWN, PH_FINAL };

struct Args { const float* in[33]; float* out; unsigned char* ws; int nph; int pad; unsigned char ptype[160]; unsigned char parg[160]; };

__device__ __forceinline__ void down_patch(const Ctx& C, int l, const pg8::StaticOrder& S) {
    Unit u; const float* cw = C.in(29) + (size_t)l * 3 * NUP; const float* E0 = C.f(WS_EDGE); bf16_t* act = C.h(WS_ACT);
    for (int i = 0; S.next(i, u); ++i) {
        if (u.pm < 16) continue;
        const bool top = (u.pm & 3) != 0, bot = (u.pm & 3) != 3;
        for (int n = C.tid; n < DFF; n += NTHREADS) {
            if (top) { const float* e = E0 + ((size_t)((u.pm - 16) * 2 + 0) * 4) * DFF; const float* ep = E0 + ((size_t)((u.pm - 17) * 2 + 1) * 4) * DFF;
                const float hg = e[n] + cw[n] * ep[2 * DFF + n], hv = e[DFF + n] + cw[DFF + n] * ep[3 * DFF + n];
                act[(size_t)(u.pm * 256) * DFF + n] = (bf16_t)(cvtpk(hg * sigm(hg) * hv, 0.f) & 0xffffu); }
            if (bot) { const float* e = E0 + ((size_t)((u.pm - 16) * 2 + 1) * 4) * DFF; const float* en = E0 + ((size_t)((u.pm - 15) * 2 + 0) * 4) * DFF;
                const float hg = e[n] + cw[2 * NUP + n] * en[2 * DFF + n], hv = e[DFF + n] + cw[2 * NUP + DFF + n] * en[3 * DFF + n];
                act[(size_t)(u.pm * 256 + 255) * DFF + n] = (bf16_t)(cvtpk(hg * sigm(hg) * hv, 0.f) & 0xffffu); }
        }
    }
    asm volatile("s_waitcnt vmcnt(0)" ::: "memory"); __syncthreads();
}
__device__ __forceinline__ void run_phase(const Ctx& C0, int type, int arg) {
    Ctx C = C0; asm volatile("" : "+v"(C.tid)); asm volatile("" : "+s"(C.bid), "+s"(C.G), "+s"(C.kp), "+s"(C.ws), "+s"(C.out));
    C.lane = C.tid & 63; C.wave = __builtin_amdgcn_readfirstlane(C.tid >> 6);
    const int l = arg & 3;
    if (type == 31) return;
#ifndef PHASE_MASK
#define PHASE_MASK 0xFFFFFFFFu
#endif
    if (!((PHASE_MASK >> type) & 1u)) return;
    pg8::Gemm g{nullptr, nullptr, D, 256, 128}; int nN = 0; EpiAny E{}; E.ws = C.ws; E.out = C.out; E.l = l;
    switch (type) {
    case PH_P0A: phase_p0a(C); break;
    case PH_P0C: phase_p0c(C); break;
    case PH_GLUE: phase_glue(C, arg >> 1, arg & 1); break;
    case PH_QKV: { g.A = C.h(WS_AP); g.Bt = C.h(WS_WQKV) + (size_t)(l / 3) * NQKV * D; nN = 6; E.kind = EK_QKV; } break;
    case PH_ATTN: phase_attn(C, l, (arg & 32) ? SCR_O + 96 * MiB : SCR_O); break;
    case 17: phase_chk(C, SCR_O, SCR_O + 96 * MiB, 16 * MiB); break;
    case 18: phase_cks(C, arg); break;
    case 19: phase_cmp(C, arg); break;
    case 20: phase_clr(C); break;
    case PH_WO: case PH_HWO: case PH_GLU: {
        if (type == PH_WO) { g.A = C.h(SCR_O); g.Bt = C.h(WS_WO) + (size_t)(l / 3) * D * D; nN = 4; E.kind = EK_RES; }
        else if (type == PH_HWO) { g.A = C.h(SCR_AWO); g.Bt = C.h(WS_HWO); nN = 4; E.kind = EK_RES; }
        else { g.A = C.h(SCR_AGLU); g.Bt = C.h(WS_GLU); g.b_tile_rows = 128; g.b_half_rows = 1024; nN = 8; E.kind = EK_RES_GLU; }
        E.flags = ((arg & 32) ? 4 : 0) | (type == PH_HWO ? 8 : 0); } break;
    case PH_HIN: { g.A = C.h(WS_AP); g.Bt = C.h(WS_HWIN); nN = 20; E.kind = EK_HIN; } break;
    case PH_HSCAN: phase_hscan(C); break;
    case PH_HPOST: phase_hpost(C); break;
    case PH_SSCAN: phase_sscan(C, l, (arg & 32) ? WS_SCR + 80 * MiB : ((arg & 64) ? WS_SCR + 112 * MiB : 0)); break;
    case 22: phase_clr2(C, WS_SCR + 80 * MiB, 64 * MiB); break;
    case 21: phase_chk(C, WS_SCR + 80 * MiB, WS_SCR + 112 * MiB, 32 * MiB); break;
    case PH_SPOST: phase_spost(C, l); break;
    case PH_UP: { g.A = C.h(WS_AP); g.Bt = C.h(WS_UP) + (size_t)l * NUP * D; g.b_tile_rows = 128; g.b_half_rows = DFF; nN = 22; E.kind = EK_UPCONV; E.in29 = C.in(29); E.in30 = C.in(30); } break;
    case 23: phase_chk(C, WS_SCR, WS_SCR + 88 * MiB, 88 * MiB); break;
    case PH_CONV: phase_conv(C, l); break;
    case PH_DOWN: { { pg8::StaticOrder S0; S0.init(32, 4, C.G, C.bid); down_patch(C, l, S0); }
        g.A = C.h(WS_ACT); g.Bt = C.h(WS_DOWN) + (size_t)l * D * DFF; g.K = DFF; nN = 4; E.kind = EK_RES; E.flags = 1 | ((arg & 16) ? 2 : 0) | ((arg & 32) ? 4 : 0); } break;
    case PH_FINAL: { const unsigned fl = __hip_atomic_load((unsigned*)(C.ws + WS_CTL) + 4000, __ATOMIC_RELAXED, __HIP_MEMORY_SCOPE_AGENT), fd = __hip_atomic_load((unsigned*)(C.ws + WS_CTL) + 4001, __ATOMIC_RELAXED, __HIP_MEMORY_SCOPE_AGENT);
        #ifdef SSDET_CLS
        const unsigned cls = __hip_atomic_load((unsigned*)(C.ws + WS_CTL) + 4002, __ATOMIC_RELAXED, __HIP_MEMORY_SCOPE_AGENT), cnt = __hip_atomic_load((unsigned*)(C.ws + WS_CTL) + 4003, __ATOMIC_RELAXED, __HIP_MEMORY_SCOPE_AGENT);
        phase_final(C, 1.f + (float)cls / 8.f + (float)(cnt > 63 ? 63 : cnt) / 1024.f); } break;
#else
        phase_final(C, fl ? 3.f : (fd ? exp2f((float)(1001 - fd)) : 1.f)); } break;
#endif
    default: break;
    }
    if (nN) { pg8::StaticOrder S; S.init(32, nN, C.G, C.bid); pg8::gemm_phase(C.lds, g, S, E); }
}

__device__ __forceinline__ void canary(const Ctx& C0, unsigned char* ws, int i, bool check) {
    int tid = C0.tid; asm volatile("" : "+v"(tid)); const int lane = tid & 63, wave = tid >> 6;
    unsigned* can = (unsigned*)(ws + WS_CTL + 32768);
#ifdef CANARY_SC1
    if (!check) { if (wave == 0 && lane < 32) __hip_atomic_store(can + C0.bid * 32 + lane, (unsigned)(i + 1), __ATOMIC_RELAXED, __HIP_MEMORY_SCOPE_AGENT); }
#else
    if (!check) { if (wave == 0 && lane < 32) can[C0.bid * 32 + lane] = (unsigned)(i + 1); }
#endif
#ifdef CANARY_LD_SC1
    else { const unsigned v = __hip_atomic_load(can + (wave * 32 + (lane >> 1)) * 32 + (lane & 1) * 16, __ATOMIC_RELAXED, __HIP_MEMORY_SCOPE_AGENT);
#else
    else { const unsigned v = can[(wave * 32 + (lane >> 1)) * 32 + (lane & 1) * 16];
#endif
      if (v != (unsigned)(i + 1) && v != (unsigned)(i + 2)) atomicAdd((unsigned*)(ws + WS_CTL) + 4000, 1u); }
}
__global__ void __launch_bounds__(NTHREADS, 2) mk_fwd(Args a) {
    extern __shared__ __attribute__((aligned(16))) unsigned char lds[];
    { volatile LAS unsigned* misc = (volatile LAS unsigned*)((LAS unsigned char*)lds + LDS_BYTES - 64); if (threadIdx.x < 16) misc[threadIdx.x] = 0u; }
    __syncthreads();
    (void)xcd_barrier_post((unsigned*)(a.ws + WS_CTL), (volatile LAS unsigned*)((LAS unsigned char*)lds + LDS_BYTES - 64));
    for (int i = 0; i < a.nph; ++i) {
        {
            Ctx C; C.kp = (const unsigned char __attribute__((address_space(4)))*)__builtin_amdgcn_kernarg_segment_ptr();
            C.out = a.out; C.ws = a.ws; C.lds = (LAS unsigned char*)lds; C.tid = threadIdx.x; C.lane = C.tid & 63; C.wave = 0; C.G = gridDim.x; C.bid = blockIdx.x;
            run_phase(C, a.ptype[i], a.parg[i]);
#ifdef CANARY
            canary(C, a.ws, i, false);
#endif
        }
        if (i + 1 < a.nph) { XcdBarrier bar; bar.bar = (unsigned*)(a.ws + WS_CTL); bar.x = xb_xcc_id(); bar.st = (volatile LAS unsigned*)((LAS unsigned char*)lds + LDS_BYTES - 64); xcd_barrier(bar); }
#ifdef CANARY
        if (i + 1 < a.nph) { Ctx C; C.tid = threadIdx.x; C.bid = blockIdx.x; canary(C, a.ws, i, true); }
#endif
    }
}
}
extern "C" void kernel_launch(void* const* d_in, const int* in_sizes, int n_in, void* d_out, int out_size, void* d_ws, size_t ws_size, hipStream_t stream) {
    using namespace om;
    static int grid = 0;
    if (grid == 0) {
        if (n_in != 33 || out_size != 17039360 || ws_size < WS_END) { fprintf(stderr, "kernel_launch: unexpected sizes n_in %d out %d ws %zu; nothing launched\n", n_in, out_size, ws_size); grid = -1; return; }
        int dev = 0, cus = 0, per_cu = 0;
        (void)hipGetDevice(&dev); (void)hipDeviceGetAttribute(&cus, hipDeviceAttributeMultiprocessorCount, dev);
        (void)hipFuncSetAttribute((const void*)mk_fwd, hipFuncAttributeMaxDynamicSharedMemorySize, LDS_BYTES);
        if (hipOccupancyMaxActiveBlocksPerMultiprocessor(&per_cu, (const void*)mk_fwd, NTHREADS, LDS_BYTES) != hipSuccess || per_cu < 1) { fprintf(stderr, "kernel_launch: occupancy query gives %d blocks per CU\n", per_cu); per_cu = 1; }
        (void)hipGetLastError();
        grid = cus;
        if (grid > 256) grid = 256;
    }
    if (grid < 0) return;
    (void)hipMemsetAsync((char*)d_ws + WS_CTL, 0, CTL_ZERO_BYTES, stream);
    Args a{};
    for (int i = 0; i < 33; ++i) a.in[i] = (const float*)d_in[i];
    a.out = (float*)d_out; a.ws = (unsigned char*)d_ws;
    int n = 0;
#ifndef DUP_MASK
#define DUP_MASK 0u
#endif
#ifndef XBAR
#define XBAR 0
#endif
    auto add1 = [&](int t, int p) { a.ptype[n] = (unsigned char)t; a.parg[n] = (unsigned char)p; ++n; };
    auto add = [&](int t, int p) { add1(t, p);
        if ((DUP_MASK >> t) & 1u) { const bool resid = (t == PH_WO || t == PH_HWO || t == PH_GLU || t == PH_DOWN); add1(t, resid ? (p | 32) : p); }
        for (int q = 0; q < XBAR; ++q) add1(31, 0); };
#ifdef UPDET
    add1(PH_P0A, 0); add1(PH_P0C, 0);
    for (int l = 0; l < 4; ++l) { const int kind = l % 3;
        if (kind == 0) { add1(PH_QKV, l); add1(PH_ATTN, l); add1(PH_WO, l); }
        else if (kind == 1) { add1(PH_HIN, l); add1(PH_HSCAN, l); add1(PH_HPOST, l); add1(PH_HWO, l); }
        else { add1(PH_SSCAN, l); add1(PH_SPOST, l); add1(PH_GLU, l); }
        add1(PH_UP, l); add1(PH_UP, l | 32); add1(23, 0); add1(PH_CONV, l); add1(PH_DOWN, l == 3 ? (l | 16) : l); }
    add1(PH_FINAL, 0);
#elif defined(SSDET)
    add1(PH_P0A, 0); add1(PH_P0C, 0);
    for (int l = 0; l < 4; ++l) { const int kind = l % 3;
        if (kind == 0) { add1(PH_QKV, l); add1(PH_ATTN, l); add1(PH_WO, l); }
        else if (kind == 1) { add1(PH_HIN, l); add1(PH_HSCAN, l); add1(PH_HPOST, l); add1(PH_HWO, l); }
        else { add1(22, 0); add1(PH_SSCAN, l | 32); add1(PH_SSCAN, l | 64); add1(21, 0); add1(PH_SSCAN, l); add1(PH_SPOST, l); add1(PH_GLU, l); }
        add1(PH_UP, l); add1(PH_DOWN, l == 3 ? (l | 16) : l); }
    add1(PH_FINAL, 0);
#elif defined(LOCALIZE)
    for (int fwd = 0; fwd < 2; ++fwd) { int idx = 0;
        auto addc = [&](int t, int p) { add1(t, p); add1(18, fwd * 32 + idx); ++idx; };
        add1(20, 0); addc(PH_P0A, 0); addc(PH_P0C, 0);
        for (int l = 0; l < 4; ++l) { const int kind = l % 3;
            if (kind == 0) { addc(PH_QKV, l); addc(PH_ATTN, l); addc(PH_WO, l); }
            else if (kind == 1) { addc(PH_HIN, l); addc(PH_HSCAN, l); addc(PH_HPOST, l); addc(PH_HWO, l); }
            else { addc(PH_SSCAN, l); addc(PH_SPOST, l); addc(PH_GLU, l); }
            addc(PH_UP, l); addc(PH_DOWN, l == 3 ? (l | 16) : l); }
        if (fwd == 1) { add1(19, idx); add1(PH_FINAL, 0); } }
#else
    add(PH_P0A, 0); add(PH_P0C, 0);
    for (int l = 0; l < 4; ++l) {
        const int kind = l % 3;
        if (kind == 0) { add(PH_QKV, l); add(PH_ATTN, l); add(PH_WO, l); }
        else if (kind == 1) { add(PH_HIN, l); add(PH_HSCAN, l); add(PH_HPOST, l); add(PH_HWO, l); }
        else { add(PH_SSCAN, l); add(PH_SPOST, l); add(PH_GLU, l); }
        add(PH_UP, l); add(PH_DOWN, l == 3 ? (l | 16) : l);
    }
    add(PH_FINAL, 0);
#endif
    a.nph = n;
    void* args[] = {&a};
    const hipError_t e = hipLaunchCooperativeKernel((const void*)mk_fwd, dim3(grid), dim3(NTHREADS), args, LDS_BYTES, stream);
    if (e != hipSuccess) fprintf(stderr, "kernel_launch: cooperative launch failed: %s (grid %d)\n", hipGetErrorString(e), grid);
}
```

```cpp
#include <hip/hip_runtime.h>
#include <hip/hip_cooperative_groups.h>
#include <cstdio>
#include <cstdint>
#include <cmath>
#define LAS __attribute__((address_space(3)))
#define GAS __attribute__((address_space(1)))
typedef unsigned short bf16_t;
typedef short bf16x8 __attribute__((ext_vector_type(8)));
typedef short s16x4 __attribute__((ext_vector_type(4)));
typedef float f32x2 __attribute__((ext_vector_type(2)));
typedef float f32x4 __attribute__((ext_vector_type(4)));
typedef float f32x16 __attribute__((ext_vector_type(16)));
typedef unsigned u32x2 __attribute__((ext_vector_type(2)));
typedef unsigned u32x4 __attribute__((ext_vector_type(4)));
typedef __bf16 bf16x2_t __attribute__((ext_vector_type(2)));

namespace om {
constexpr int D = 1024, MP = 4096, M = 8192, DFF = 2816, NUP = 5632, NQKV = 1536, NHIN = 5120;
constexpr float EPS = 1e-6f, LOG2E = 1.4426950408889634f, QSCALE = 0.125f * 1.4426950408889634f;
constexpr int NTHREADS = 512, NWAVES = 8, LDS_BYTES = 147456, RING_BYTES = 131072;
constexpr int SW_STRIDE = 5632;
constexpr float SS_FIX = 16777216.f, SS_INV = 1.f / (16777216.f * 1024.f);
typedef unsigned long long u64_t;
__device__ __forceinline__ float rstd_of(const u64_t* ss, int r) { return rsqrtf((float)ss[r] * SS_INV + 1e-6f); }
constexpr size_t MiB = 1u << 20;
constexpr size_t WS_CTL = 0, CTL_ZERO_BYTES = 64 * 1024;
constexpr size_t WS_MODP = 1 * MiB, WS_MOD = 3 * MiB, WS_SW = 4 * MiB, WS_GMOD = 5 * MiB, WS_SS = 6 * MiB, WS_ROPE = 7 * MiB;
constexpr size_t WS_LB1 = 8 * MiB, WS_SLAM = 8 * MiB + 64 * 1024, WS_SBB = 8 * MiB + 512 * 1024, WS_SCB = 9 * MiB;
constexpr size_t WS_CTXK = 10 * MiB, WS_CTXV = 12 * MiB;
constexpr size_t WS_NAIVE_MOD = 14 * MiB;
constexpr size_t WS_WQKV = 16 * MiB, WS_WO = 22 * MiB, WS_HWIN = 26 * MiB, WS_HWO = 36 * MiB, WS_GLU = 38 * MiB, WS_UP = 42 * MiB, WS_DOWN = 86 * MiB;
constexpr size_t WS_X = 108 * MiB, WS_R = 140 * MiB;
constexpr size_t WS_AP = WS_R, WS_ACT = WS_R + 16 * MiB, WS_SCR = WS_R + 60 * MiB, WS_END = WS_SCR + 176 * MiB;

constexpr size_t SCR_Q = WS_SCR, SCR_KB = WS_SCR + 16 * MiB, SCR_VB = WS_SCR + 20 * MiB, SCR_O = WS_SCR + 24 * MiB;
constexpr size_t SCR_HQ = WS_SCR, SCR_HV = WS_SCR + 16 * MiB, SCR_HG = WS_SCR + 32 * MiB, SCR_LFF = WS_SCR + 48 * MiB, SCR_LFB = WS_SCR + 80 * MiB, SCR_OF = WS_SCR + 112 * MiB, SCR_OB = WS_SCR + 144 * MiB, SCR_AWO = WS_SCR;
constexpr size_t SCR_YF = WS_SCR, SCR_YB = WS_SCR + 32 * MiB, SCR_AGLU = WS_SCR + 64 * MiB;

__device__ __forceinline__ int cond_of_tile(int pm) { return pm < 16 ? 0 : 1 + ((pm - 16) >> 2); }
__device__ __forceinline__ int cond_of_row(int r) { return r < MP ? 0 : 1 + ((r - MP) >> 10); }
__device__ __forceinline__ unsigned cvtpk(float lo, float hi) { f32x2 v = {lo, hi}; bf16x2_t b = __builtin_convertvector(v, bf16x2_t); return __builtin_bit_cast(unsigned, b); }
__device__ __forceinline__ float bf2f(unsigned short h) { return __uint_as_float(((unsigned)h) << 16); }
__device__ __forceinline__ float bflo(unsigned w) { return __uint_as_float(w << 16); }
__device__ __forceinline__ float bfhi(unsigned w) { return __uint_as_float(w & 0xffff0000u); }
__device__ __forceinline__ float sigm(float x) { return 1.f / (1.f + __expf(-x)); }
__device__ __forceinline__ int lane_id() { return (int)__builtin_amdgcn_mbcnt_hi(~0u, __builtin_amdgcn_mbcnt_lo(~0u, 0u)); }
__device__ __forceinline__ float wave_sum(float v) {
#pragma unroll
    for (int o = 1; o < 64; o <<= 1) v += __shfl_xor(v, o);
    return v;
}

struct Ctx {
    const unsigned char __attribute__((address_space(4)))* kp;
    float* out; unsigned char* ws;
    LAS unsigned char* lds; int tid, lane, wave, G, bid;
    __device__ __forceinline__ const float* in(int i) const { return *(const float* const __attribute__((address_space(4)))*)(kp + 8 * i); }
    __device__ __forceinline__ float* f(size_t off) const { return (float*)(ws + off); }
    __device__ __forceinline__ bf16_t* h(size_t off) const { return (bf16_t*)(ws + off); }
};

namespace pg8 {
constexpr int BM = 256, BK = 64, HALF = 128, HTB = HALF * BK * 2, STAGE_BYTES = 8 * HTB, NXCD = 8, WGM = 8;
__host__ __device__ __forceinline__ int lds_byte(int r, int c) { const int st = (r >> 4) * 2 + (c >> 5), rr = r & 15, cc = c & 31, ob = rr * 64 + cc * 2; return st * 1024 + (ob ^ (((ob >> 9) & 1) << 5)); }
__host__ __device__ __forceinline__ void stage_rc(int b, int& R, int& C) { const int st = b / 1024, sb = b % 1024, swz = sb ^ (((sb >> 9) & 1) << 5); R = (st >> 1) * 16 + swz / 64; C = (st & 1) * 32 + (swz % 64) / 2; }
struct Unit { int pm, pn; };
struct Gemm { const bf16_t* A; const bf16_t* Bt; int K; int b_tile_rows, b_half_rows; int ld; int split; };
struct StaticOrder {
    int nM, nN, nwg, G, c;
    __device__ void init(int nM_, int nN_, int G_, int c_) { nM = nM_; nN = nN_; nwg = nM * nN; G = G_; c = c_; }
    __device__ bool next(int i, Unit& u) const {
        const long L = (long)i * G + c; if (L >= nwg) return false;
        int wgid = (int)L; { const int q = nwg / NXCD, r = nwg % NXCD, xcd = wgid % NXCD, off = wgid / NXCD; wgid = (xcd < r ? xcd * (q + 1) : r * (q + 1) + (xcd - r) * q) + off; }
        const int nig = WGM * nN, gid = wgid / nig, fm = gid * WGM, gsz = (nM - fm) < WGM ? (nM - fm) : WGM;
        u.pm = fm + ((wgid % nig) % gsz); u.pn = (wgid % nig) / gsz; return true;
    }
};
template <class Epi>
__device__ __forceinline__ void gemm_phase(LAS unsigned char* lds, const Gemm g, const StaticOrder& S, const Epi& E, int tid_in) {
    int tid_ = tid_in; asm volatile("" : "+v"(tid_));
    const int tid = tid_, wid = __builtin_amdgcn_readfirstlane(tid >> 6), lane = tid & 63, wr = wid >> 2, wc = wid & 3, fr = lane & 15, fq = lane >> 4;
    const int K = g.K, nt = K / BK, ld = g.ld;
    unsigned voffA[2];
#pragma unroll
    for (int i = 0; i < 2; ++i) { int R, C; stage_rc(tid * 16 + i * 8192, R, C); voffA[i] = (unsigned)(R * ld + C) * 2u; }
    const size_t kstep = (size_t)(BK * 2);
    const size_t hstepA = (size_t)HALF * ld * 2, tstepA = 2 * hstepA;
    const size_t hstepB = (size_t)g.b_half_rows * ld * 2, tstepB = (size_t)g.b_tile_rows * ld * 2, khb = (size_t)K * 2;
#define PG8_UA(u) ((const char*)g.A + (size_t)(u).pm * tstepA + (g.split ? (size_t)((u).pn & 1) * khb : 0))
#define PG8_UB(u) ((const char*)g.Bt + (size_t)(g.split ? (u).pn >> 1 : (u).pn) * tstepB + (g.split ? (size_t)((u).pn & 1) * khb : 0))
    const unsigned ldsw = (unsigned)wid * 1024u;
    const int aoff = lds_byte(wr * 64 + fr, fq * 8), boff = lds_byte(wc * 32 + fr, fq * 8);
#define PG8_SA(b, h) (((b) * 2 + (h)) * HTB)
#define PG8_SB(b, h) ((4 + (b) * 2 + (h)) * HTB)
#define PG8_STAGE(bufoff, gbase) do { _Pragma("unroll") for (int _i = 0; _i < 2; ++_i) \
        __builtin_amdgcn_global_load_lds((const unsigned*)((const char*)(gbase) + voffA[_i]), (LAS unsigned*)(lds + (bufoff) + ldsw + _i * 8192), 16, 0, 0); } while (0)
#define PG8_LDA(dst, b, h) do { _Pragma("unroll") for (int m = 0; m < 4; ++m) _Pragma("unroll") for (int k = 0; k < 2; ++k) dst[m][k] = *(const LAS bf16x8*)(lds + PG8_SA(b, h) + aoff + m * 2048 + k * 1024); } while (0)
#define PG8_LDB(dst, b, h) do { _Pragma("unroll") for (int n = 0; n < 2; ++n) _Pragma("unroll") for (int k = 0; k < 2; ++k) dst[n][k] = *(const LAS bf16x8*)(lds + PG8_SB(b, h) + boff + n * 2048 + k * 1024); } while (0)
#define PG8_MMA(ai, bj, At, Bt) do { __builtin_amdgcn_s_setprio(1); _Pragma("unroll") for (int m = 0; m < 4; ++m) _Pragma("unroll") for (int n = 0; n < 2; ++n) _Pragma("unroll") for (int k = 0; k < 2; ++k) \
        acc[ai][bj][m][n] = __builtin_amdgcn_mfma_f32_16x16x32_bf16(Bt[n][k], At[m][k], acc[ai][bj][m][n], 0, 0, 0); __builtin_amdgcn_s_setprio(0); } while (0)
#define PG8_WAIT_V(n) asm volatile("s_waitcnt vmcnt(" #n ")" ::: "memory")
#define PG8_WAIT_L(n) asm volatile("s_waitcnt lgkmcnt(" #n ")" ::: "memory")
#define PG8_BAR __builtin_amdgcn_s_barrier()
#define PG8_SCHED __builtin_amdgcn_sched_barrier(0)
    Unit cur, nxt; int ui = 0;
    if (!S.next(0, cur)) return;
    f32x4 acc[2][2][4][2];
#pragma unroll
    for (int a = 0; a < 2; ++a)
#pragma unroll
        for (int b = 0; b < 2; ++b)
#pragma unroll
            for (int m = 0; m < 4; ++m)
#pragma unroll
                for (int n = 0; n < 2; ++n) acc[a][b][m][n] = (f32x4){0.f, 0.f, 0.f, 0.f};
    bf16x8 At[4][2], B0[2][2], B1[2][2];
    const char* cA = PG8_UA(cur); const char* cB = PG8_UB(cur);
    PG8_STAGE(PG8_SB(0, 0), cB); PG8_STAGE(PG8_SB(0, 1), cB + hstepB); PG8_STAGE(PG8_SA(0, 0), cA); PG8_STAGE(PG8_SA(0, 1), cA + hstepA);
    if (wr == 1) PG8_BAR;
    PG8_WAIT_V(2); PG8_BAR;
    PG8_STAGE(PG8_SB(1, 0), cB + kstep); PG8_STAGE(PG8_SA(1, 0), cA + kstep); PG8_STAGE(PG8_SB(1, 1), cB + hstepB + kstep);
    PG8_WAIT_V(6); PG8_BAR;
    for (;;) {
        const bool has_next = S.next(ui + 1, nxt);
        const char* nA = has_next ? PG8_UA(nxt) : cA; const char* nB = has_next ? PG8_UB(nxt) : cB;
        for (int t = 0; t < nt; t += 2) {
            const bool last = (t == nt - 2);
            const char* a1 = cA + (size_t)(t + 1) * kstep;
            const char* a2 = last ? nA : cA + (size_t)(t + 2) * kstep; const char* b2 = last ? nB : cB + (size_t)(t + 2) * kstep;
            const char* a3 = a2 + kstep; const char* b3 = b2 + kstep;
            PG8_LDB(B0, 0, 0); PG8_LDB(B1, 0, 1); PG8_SCHED; PG8_LDA(At, 0, 0); PG8_STAGE(PG8_SA(1, 1), a1 + hstepA);
            PG8_WAIT_V(8); PG8_WAIT_L(0); PG8_BAR; PG8_MMA(0, 0, At, B0); PG8_MMA(0, 1, At, B1); PG8_BAR; PG8_SCHED;
            PG8_LDA(At, 0, 1); PG8_STAGE(PG8_SB(0, 0), b2); PG8_STAGE(PG8_SB(0, 1), b2 + hstepB); PG8_STAGE(PG8_SA(0, 0), a2);
            PG8_WAIT_V(8); PG8_WAIT_L(0); PG8_BAR; PG8_MMA(1, 0, At, B0); PG8_MMA(1, 1, At, B1); PG8_BAR; PG8_SCHED;
            PG8_LDB(B0, 1, 0); PG8_LDB(B1, 1, 1); PG8_SCHED; PG8_LDA(At, 1, 0); PG8_STAGE(PG8_SA(0, 1), a2 + hstepA);
            PG8_WAIT_V(8); PG8_WAIT_L(0); PG8_BAR; PG8_MMA(0, 0, At, B0); PG8_MMA(0, 1, At, B1); PG8_BAR; PG8_SCHED;
            PG8_LDA(At, 1, 1); PG8_STAGE(PG8_SB(1, 0), b3); PG8_STAGE(PG8_SB(1, 1), b3 + hstepB); PG8_STAGE(PG8_SA(1, 0), a3);
            PG8_WAIT_V(8); PG8_WAIT_L(0); PG8_BAR; PG8_MMA(1, 0, At, B0); PG8_MMA(1, 1, At, B1); PG8_BAR; PG8_SCHED;
        }
        if (wr == 0) PG8_BAR;
        { int fr_e = fr, fq_e = fq, wr_e = wr, wc_e = wc; asm volatile("" : "+v"(fr_e), "+v"(fq_e), "+s"(wr_e), "+s"(wc_e));
          int tid_e = tid; asm volatile("" : "+v"(tid_e));
          const Unit ue{cur.pm, g.split ? cur.pn >> 1 : cur.pn};
          E(acc, ue, wr_e, wc_e, fr_e, fq_e, g.split ? (cur.pn & 1) : -1, tid_e);
          E.post(ue, tid_e); }
        if (!has_next) break;
#pragma unroll
        for (int a = 0; a < 2; ++a)
#pragma unroll
            for (int b = 0; b < 2; ++b)
#pragma unroll
                for (int m = 0; m < 4; ++m)
#pragma unroll
                    for (int n = 0; n < 2; ++n) acc[a][b][m][n] = (f32x4){0.f, 0.f, 0.f, 0.f};
        cur = nxt; cA = nA; cB = nB; ++ui;
        if (wr == 1) PG8_BAR;
    }
    PG8_WAIT_V(0);
    PG8_BAR;
#undef PG8_SA
#undef PG8_UA
#undef PG8_UB
#undef PG8_SB
#undef PG8_STAGE
#undef PG8_LDA
#undef PG8_LDB
#undef PG8_MMA
#undef PG8_WAIT_V
#undef PG8_WAIT_L
#undef PG8_BAR
#undef PG8_SCHED
}
}
using pg8::Unit;
typedef f32x4 Acc[2][2][4][2];

__device__ __forceinline__ void st_bf16x4(bf16_t* p, f32x4 v) { u32x2 w; w.x = cvtpk(v[0], v[1]); w.y = cvtpk(v[2], v[3]); *(u32x2*)p = w; }

template <bool PAIRED> struct EpiRes {
    const float* xin; float* xout; bf16_t* ap; u64_t* ssn; const float* gate;   const float* gmodn;
    __device__ __forceinline__ void operator()(const Acc& acc, const Unit& u, int wr, int wc, int fr, int fq) const {
        const int c = cond_of_tile(u.pm);
        const int colb = (PAIRED ? u.pn * 128 : u.pn * 256) + wc * 32 + 4 * fq;
        constexpr int NBJ = PAIRED ? 1 : 2;
        f32x4 gv[NBJ][2], gm[NBJ][2];
#pragma unroll
        for (int bj = 0; bj < NBJ; ++bj)
#pragma unroll
            for (int n = 0; n < 2; ++n) { gv[bj][n] = *(const f32x4*)(gate + (size_t)c * 6144 + colb + bj * 128 + n * 16);
                gm[bj][n] = gmodn ? *(const f32x4*)(gmodn + (size_t)c * 1024 + colb + bj * 128 + n * 16) : (f32x4){0.f, 0.f, 0.f, 0.f}; }
#pragma unroll
        for (int ai = 0; ai < 2; ++ai)
#pragma unroll
            for (int m = 0; m < 4; ++m) {
                const int r = u.pm * 256 + ai * 128 + wr * 64 + m * 16 + fr; float sq = 0.f;
#pragma unroll
                for (int bj = 0; bj < NBJ; ++bj)
#pragma unroll
                    for (int n = 0; n < 2; ++n) {
                        f32x4 o = acc[ai][bj][m][n];
                        if (PAIRED) { const f32x4 gt = acc[ai][1][m][n];
#pragma unroll
                            for (int e = 0; e < 4; ++e) o[e] = o[e] * sigm(gt[e]); }
                        const size_t off = (size_t)r * D + colb + bj * 128 + n * 16;
                        const f32x4 xo = *(const f32x4*)(xin + off) + gv[bj][n] * o;
                        *(f32x4*)(xout + off) = xo;
                        sq += (xo[0] * xo[0] + xo[1] * xo[1]) + (xo[2] * xo[2] + xo[3] * xo[3]);
                        if (gmodn) st_bf16x4(ap + off, xo * gm[bj][n]);
                    }
                sq += __shfl_xor(sq, 16); sq += __shfl_xor(sq, 32);
                if (fq == 0) atomicAdd(ssn + r, (u64_t)(sq * SS_FIX));
            }
    }
};
struct EpiUpRaw {
    const u64_t* ss; const float* sw;   bf16_t* hraw;
    __device__ __forceinline__ void operator()(const Acc& acc, const Unit& u, int wr, int wc, int fr, int fq) const {
        const int c = cond_of_tile(u.pm); const int colb = u.pn * 256 + wc * 32 + 4 * fq;
        f32x4 sv[2][2];
#pragma unroll
        for (int bj = 0; bj < 2; ++bj)
#pragma unroll
            for (int n = 0; n < 2; ++n) sv[bj][n] = *(const f32x4*)(sw + (size_t)c * SW_STRIDE + colb + bj * 128 + n * 16);
#pragma unroll
        for (int ai = 0; ai < 2; ++ai)
#pragma unroll
            for (int m = 0; m < 4; ++m) {
                const int r = u.pm * 256 + ai * 128 + wr * 64 + m * 16 + fr; const float rs = rstd_of(ss, r);
#pragma unroll
                for (int bj = 0; bj < 2; ++bj)
#pragma unroll
                    for (int n = 0; n < 2; ++n) st_bf16x4(hraw + (size_t)r * NUP + colb + bj * 128 + n * 16, acc[ai][bj][m][n] * rs + sv[bj][n]);
            }
    }
};
constexpr size_t WS_EDGE = 14 * MiB;
template <int CTRL> __device__ __forceinline__ float dpp_f(float old, float src) { return __int_as_float(__builtin_amdgcn_update_dpp(__float_as_int(old), __float_as_int(src), CTRL, 0xf, 0xf, false)); }
#define DPP_ROW_SHL1 0x101
#define DPP_ROW_SHR1 0x111
#define DPP_ROW_ROR1 0x121
#define DPP_ROW_ROR15 0x12f
struct EpiUpConv {
    const u64_t* ss; const float* sw; const float* cw; const float* cb; bf16_t* act; float* edge; bf16_t* tile;
    __device__ __forceinline__ void operator()(const Acc& acc, const Unit& u, int wr, int wc, int fr, int fq) const {
        const int c = cond_of_tile(u.pm); const int cc0 = wc * 32 + 4 * fq, colg0 = u.pn * 128 + cc0;
        f32x4 sv[2][2];
#pragma unroll
        for (int bj = 0; bj < 2; ++bj)
#pragma unroll
            for (int n = 0; n < 2; ++n) sv[bj][n] = *(const f32x4*)(sw + (size_t)c * SW_STRIDE + bj * DFF + colg0 + n * 16);
#pragma unroll
        for (int ai = 0; ai < 2; ++ai)
#pragma unroll
            for (int m = 0; m < 4; ++m) { const int rl = ai * 128 + wr * 64 + m * 16 + fr; const float rs = rstd_of(ss, u.pm * 256 + rl);
#pragma unroll
                for (int bj = 0; bj < 2; ++bj)
#pragma unroll
                    for (int n = 0; n < 2; ++n) st_bf16x4(tile + rl * 256 + bj * 128 + cc0 + n * 16, acc[ai][bj][m][n] * rs + sv[bj][n]); }
    }
    __device__ __forceinline__ void post(const Unit& u, int tid) const {
        asm volatile("s_waitcnt vmcnt(0)" ::: "memory"); __builtin_amdgcn_s_barrier(); asm volatile("" ::: "memory");
        const int ch = tid & 15, rg = tid >> 4, colg = u.pn * 128 + 8 * ch, r0 = rg * 8;
        const bool samp = u.pm >= 16; const bool nb_top = samp && (u.pm & 3) != 0, nb_bot = samp && (u.pm & 3) != 3;
        float wg[3][8], wv[3][8], bg[8], bv[8];
#pragma unroll
        for (int q = 0; q < 2; ++q) {
#pragma unroll
            for (int jj = 0; jj < 3; ++jj) { const f32x4 a = *(const f32x4*)(cw + jj * NUP + colg + 4 * q), b = *(const f32x4*)(cw + jj * NUP + DFF + colg + 4 * q);
#pragma unroll
                for (int e = 0; e < 4; ++e) { wg[jj][4 * q + e] = a[e]; wv[jj][4 * q + e] = b[e]; } }
            const f32x4 a = *(const f32x4*)(cb + colg + 4 * q), b = *(const f32x4*)(cb + DFF + colg + 4 * q);
#pragma unroll
            for (int e = 0; e < 4; ++e) { bg[4 * q + e] = a[e]; bv[4 * q + e] = b[e]; } }
        u32x4 rg_[10], rv_[10];
#pragma unroll
        for (int k = 0; k < 10; ++k) { const int rl = r0 - 1 + k; const bool ok = rl >= 0 && rl <= 255;
            rg_[k] = ok ? *(const u32x4*)(tile + rl * 256 + 8 * ch) : (u32x4){0u, 0u, 0u, 0u}; rv_[k] = ok ? *(const u32x4*)(tile + rl * 256 + 128 + 8 * ch) : (u32x4){0u, 0u, 0u, 0u}; }
#pragma unroll
        for (int k = 0; k < 8; ++k) {
            const int rl = r0 + k; const u32x4 pg = rg_[k], pv = rv_[k], cg = rg_[k + 1], cv = rv_[k + 1], ng = rg_[k + 2], nv = rv_[k + 2];
            float hg[8], hv[8];
#pragma unroll
            for (int e = 0; e < 4; ++e) {
                hg[2 * e] = wg[0][2 * e] * bflo(pg[e]) + wg[1][2 * e] * bflo(cg[e]) + wg[2][2 * e] * bflo(ng[e]) + bg[2 * e];
                hg[2 * e + 1] = wg[0][2 * e + 1] * bfhi(pg[e]) + wg[1][2 * e + 1] * bfhi(cg[e]) + wg[2][2 * e + 1] * bfhi(ng[e]) + bg[2 * e + 1];
                hv[2 * e] = wv[0][2 * e] * bflo(pv[e]) + wv[1][2 * e] * bflo(cv[e]) + wv[2][2 * e] * bflo(nv[e]) + bv[2 * e];
                hv[2 * e + 1] = wv[0][2 * e + 1] * bfhi(pv[e]) + wv[1][2 * e + 1] * bfhi(cv[e]) + wv[2][2 * e + 1] * bfhi(nv[e]) + bv[2 * e + 1]; }
            u32x4 o;
#pragma unroll
            for (int e = 0; e < 4; ++e) o[e] = cvtpk(hg[2 * e] * sigm(hg[2 * e]) * hv[2 * e], hg[2 * e + 1] * sigm(hg[2 * e + 1]) * hv[2 * e + 1]);
            *(u32x4*)(act + (size_t)(u.pm * 256 + rl) * DFF + colg) = o;
            if ((rl == 0 && nb_top) || (rl == 255 && nb_bot)) {
                float* e0 = edge + ((size_t)((u.pm - 16) * 2 + (rl == 0 ? 0 : 1)) * 4) * DFF + colg;
#pragma unroll
                for (int e = 0; e < 4; ++e) { e0[2 * e] = hg[2 * e]; e0[2 * e + 1] = hg[2 * e + 1]; e0[DFF + 2 * e] = hv[2 * e]; e0[DFF + 2 * e + 1] = hv[2 * e + 1];
                    e0[2 * DFF + 2 * e] = bflo(cg[e]); e0[2 * DFF + 2 * e + 1] = bfhi(cg[e]); e0[3 * DFF + 2 * e] = bflo(cv[e]); e0[3 * DFF + 2 * e + 1] = bfhi(cv[e]); } }
        }
    }
};
struct EpiQKV {
    const u64_t* ss; const float* sw; bf16_t *Q, *KB, *VB; float *outK, *outV; const float *ropec, *ropes; int j;
    __device__ __forceinline__ void operator()(const Acc& acc, const Unit& u, int wr, int wc, int fr, int fq) const {
        const int c = cond_of_tile(u.pm); const bool samp = u.pm >= 16; const int colt = u.pn * 256, cl0 = wc * 32 + 4 * fq;
        f32x4 sv[2][2];
#pragma unroll
        for (int bj = 0; bj < 2; ++bj)
#pragma unroll
            for (int n = 0; n < 2; ++n) sv[bj][n] = *(const f32x4*)(sw + (size_t)c * SW_STRIDE + colt + cl0 + bj * 128 + n * 16);
#pragma unroll
        for (int ai = 0; ai < 2; ++ai)
#pragma unroll
            for (int m = 0; m < 4; ++m) {
                const int r = u.pm * 256 + ai * 128 + wr * 64 + m * 16 + fr; const float rs = rstd_of(ss, r);
                f32x4 cs = {1.f, 1.f, 1.f, 1.f}, sn = {0.f, 0.f, 0.f, 0.f};
                if (samp && u.pn < 5) { const int t = (r - MP) & 1023, idx = t * 32 + (wc & 1) * 16 + 4 * fq; cs = *(const f32x4*)(ropec + idx); sn = *(const f32x4*)(ropes + idx); }
#pragma unroll
                for (int bj = 0; bj < 2; ++bj) {
                    f32x4 v0 = acc[ai][bj][m][0] * rs + sv[bj][0], v1 = acc[ai][bj][m][1] * rs + sv[bj][1];
                    if (u.pn < 5) { const f32x4 o0 = v0 * cs - v1 * sn, o1 = v1 * cs + v0 * sn; v0 = o0; v1 = o1; }
                    const int cl = bj * 128 + cl0;
                    if (u.pn < 4) { st_bf16x4(Q + (size_t)r * D + colt + cl, v0 * QSCALE); st_bf16x4(Q + (size_t)r * D + colt + cl + 16, v1 * QSCALE); }
                    else {
                        bf16_t* dst = (u.pn == 4 ? KB : VB) + (size_t)r * 256 + cl; st_bf16x4(dst, v0); st_bf16x4(dst + 16, v1);
                        if (!samp) { float* o = (u.pn == 4 ? outK : outV) + (((size_t)(r >> 8) * 2 + j) * 256 + (r & 255)) * 256 + cl; *(f32x4*)o = v0; *(f32x4*)(o + 16) = v1; }
                    }
                }
            }
    }
};
struct EpiHin {
    const u64_t* ss; const float* sw; const float* lb1; bf16_t *HQ, *HV, *HG; float *LFF, *LFB;
    __device__ __forceinline__ void operator()(const Acc& acc, const Unit& u, int wr, int wc, int fr, int fq) const {
        const int c = cond_of_tile(u.pm); const int seg = u.pn >> 2, colt = u.pn * 256, cl0 = wc * 32 + 4 * fq, cs0 = (u.pn & 3) * 256 + cl0;
        f32x4 sv[2][2], lbv[2][2];
#pragma unroll
        for (int bj = 0; bj < 2; ++bj)
#pragma unroll
            for (int n = 0; n < 2; ++n) { sv[bj][n] = *(const f32x4*)(sw + (size_t)c * SW_STRIDE + colt + cl0 + bj * 128 + n * 16);
                lbv[bj][n] = (seg == 2 || seg == 3) ? *(const f32x4*)(lb1 + (seg - 2) * 1024 + cs0 + bj * 128 + n * 16) : (f32x4){0.f, 0.f, 0.f, 0.f}; }
#pragma unroll
        for (int ai = 0; ai < 2; ++ai)
#pragma unroll
            for (int m = 0; m < 4; ++m) {
                const int r = u.pm * 256 + ai * 128 + wr * 64 + m * 16 + fr; const float rs = rstd_of(ss, r);
#pragma unroll
                for (int bj = 0; bj < 2; ++bj)
#pragma unroll
                    for (int n = 0; n < 2; ++n) {
                        f32x4 v = acc[ai][bj][m][n] * rs + sv[bj][n]; const size_t off = (size_t)r * D + cs0 + bj * 128 + n * 16;
                        if (seg == 0) st_bf16x4(HQ + off, v);
                        else if (seg == 1) st_bf16x4(HV + off, v);
                        else if (seg == 4) {
#pragma unroll
                            for (int e = 0; e < 4; ++e) v[e] = v[e] * sigm(v[e]);
                            st_bf16x4(HG + off, v); }
                        else { const f32x4 lb = lbv[bj][n];
#pragma unroll
                            for (int e = 0; e < 4; ++e) v[e] = __logf(lb[e] + (1.f - lb[e]) * sigm(v[e]));
                            *(f32x4*)((seg == 2 ? LFF : LFB) + off) = v; }
                    }
            }
    }
};
enum { EK_RES = 0, EK_RES_GLU, EK_UPRAW, EK_QKV, EK_HIN, EK_UPCONV };
struct EpiAny {
    int kind, l, flags, epoch; unsigned char* ws; float* out; const float *in29, *in30;
    __device__ __forceinline__ float* F(size_t o) const { return (float*)(ws + o); }
    __device__ __forceinline__ bf16_t* H(size_t o) const { return (bf16_t*)(ws + o); }
    __device__ __forceinline__ void post(const Unit& u, int tid) const {
        if (kind != EK_UPCONV) return;
        unsigned char* ws = this->ws; asm volatile("" : "+s"(ws));
        const size_t ss1 = WS_SS + (size_t)(l * 2) * M * 8, sw1 = WS_SW + (size_t)(l * 2) * 5 * SW_STRIDE * 4;
        EpiUpConv E{(const u64_t*)(ws + ss1 + (size_t)M * 8), (const float*)(ws + sw1 + (size_t)5 * SW_STRIDE * 4), in29 + (size_t)l * 3 * NUP, in30 + (size_t)l * NUP, (bf16_t*)(ws + WS_ACT), (float*)(ws + WS_EDGE), (bf16_t*)(ws + WS_SCR + (size_t)blockIdx.x * 131072)}; E.post(u, tid);
    }
    __device__ __forceinline__ void operator()(Acc& acc, const Unit& u, int wr, int wc, int fr, int fq, int kh, int tid) const {
#ifndef EK_MASK
#define EK_MASK 63
#endif
        if (!((EK_MASK >> kind) & 1)) return;
        unsigned char* ws = this->ws; float* out = this->out; asm volatile("" : "+s"(ws), "+s"(out));
        if (kh >= 0) {
            const int tile = u.pm * 4 + u.pn; unsigned* flag = (unsigned*)(ws + WS_CTL + 40960) + tile * 16;
            unsigned char* slab = ws + WS_SCR + 64 * MiB + (size_t)tile * 262144 + (size_t)tid * 16;
            if (kh == 1) {
                __amdgpu_buffer_rsrc_t rs = __builtin_amdgcn_make_buffer_rsrc(ws + WS_SCR + 64 * MiB + (size_t)tile * 262144, 0, 262144, 0x00020000);
#pragma unroll
                for (int j = 0; j < 32; ++j) __builtin_amdgcn_raw_buffer_store_b128(__builtin_bit_cast(u32x4, acc[j >> 4][(j >> 3) & 1][(j >> 1) & 3][j & 1]), rs, tid * 16 + j * 8192, 0, 16);
                asm volatile("s_waitcnt vmcnt(0)" ::: "memory"); __builtin_amdgcn_s_barrier(); asm volatile("" ::: "memory");
                if (tid == 0) __hip_atomic_store(flag, (unsigned)epoch, __ATOMIC_RELAXED, __HIP_MEMORY_SCOPE_AGENT);
                return;
            }
            if (tid < 64) {
                unsigned sp = 0;
                while ((unsigned)__builtin_amdgcn_readfirstlane((int)__hip_atomic_load(flag, __ATOMIC_RELAXED, __HIP_MEMORY_SCOPE_AGENT)) != (unsigned)epoch) { __builtin_amdgcn_s_sleep(2); if (++sp > (1u << 22)) break; }
                __builtin_amdgcn_fence(__ATOMIC_ACQUIRE, "agent"); asm volatile("s_waitcnt vmcnt(0)" ::: "memory");
            }
            asm volatile("" ::: "memory"); __builtin_amdgcn_s_barrier(); asm volatile("" ::: "memory");
#pragma unroll
            for (int j = 0; j < 32; ++j) acc[j >> 4][(j >> 3) & 1][(j >> 1) & 3][j & 1] += *(const f32x4*)(slab + (size_t)j * 8192);
        }
        auto F = [&](size_t o) { return (float*)(ws + o); }; auto H = [&](size_t o) { return (bf16_t*)(ws + o); };
        const size_t ss1 = WS_SS + (size_t)(l * 2) * M * 8, sw1 = WS_SW + (size_t)(l * 2) * 5 * SW_STRIDE * 4;
        switch (kind) {
        case EK_RES: case EK_RES_GLU: {
            const bool down = flags & 1;
            const size_t ssn = down ? WS_SS + (size_t)((l + 1) * 2) * M * 8 : ss1 + (size_t)M * 8;
            const size_t gate = WS_MOD + ((size_t)l * 5 * 6144 + (down ? 5 : 2) * 1024) * 4;
            const size_t gmn = down ? WS_GMOD + (size_t)((l + 1) * 2) * 5 * 1024 * 4 : WS_GMOD + (size_t)(l * 2 + 1) * 5 * 1024 * 4;
            const bool has_next = !(down && l == 3);
            float* xo = (flags & 2) ? out : F(WS_X); bf16_t* ap = H(WS_AP); u64_t* sp = (u64_t*)(ws + ssn);
            if (flags & 4) { const size_t dm = WS_SCR + ((flags & 8) ? 48 : 96) * MiB; xo = F(dm); ap = H(dm + 32 * MiB); sp = (u64_t*)(ws + dm + 48 * MiB); }
            if (kind == EK_RES) { EpiRes<false> E{F(WS_X), xo, ap, sp, F(gate), has_next ? F(gmn) : nullptr}; E(acc, u, wr, wc, fr, fq); }
            else { EpiRes<true> E{F(WS_X), xo, ap, sp, F(gate), F(gmn)}; E(acc, u, wr, wc, fr, fq); } } break;
        case EK_UPRAW: { EpiUpRaw E{(const u64_t*)(ws + ss1 + (size_t)M * 8), F(sw1 + (size_t)5 * SW_STRIDE * 4), H(WS_SCR + (size_t)((flags >> 2) & 1) * (88 * MiB))}; E(acc, u, wr, wc, fr, fq); } break;
        case EK_UPCONV: { EpiUpConv E{(const u64_t*)(ws + ss1 + (size_t)M * 8), F(sw1 + (size_t)5 * SW_STRIDE * 4), in29 + (size_t)l * 3 * NUP, in30 + (size_t)l * NUP, H(WS_ACT), F(WS_EDGE), H(WS_SCR + (size_t)blockIdx.x * 131072)}; E(acc, u, wr, wc, fr, fq); } break;
        case EK_QKV: { EpiQKV E{(const u64_t*)(ws + ss1), F(sw1), H(SCR_Q), H(SCR_KB), H(SCR_VB), out + 8388608, out + 8388608 + 2097152, F(WS_ROPE), F(WS_ROPE) + 32768, l / 3}; E(acc, u, wr, wc, fr, fq); } break;
        default: { EpiHin E{(const u64_t*)(ws + ss1), F(sw1), F(WS_LB1), H(SCR_HQ), H(SCR_HV), H(SCR_HG), F(SCR_LFF), F(SCR_LFB)}; E(acc, u, wr, wc, fr, fq); } break;
        }
    }
};
}
namespace om {
#define LDS_WAIT() asm volatile("s_waitcnt lgkmcnt(0)" ::: "memory")
__device__ __forceinline__ void transpose_item(const float* W, int K, int N, bf16_t* WT, LAS unsigned short* scr, int item, int lane) {
    const int nblk = N / 32, kb = item / nblk, nb = item % nblk, k0 = 64 * kb, n0 = 32 * nb;
    float v[32];
#pragma unroll
    for (int i = 0; i < 32; ++i) v[i] = W[(size_t)(k0 + 2 * i + (lane >> 5)) * N + n0 + (lane & 31)];
#pragma unroll
    for (int i = 0; i < 32; ++i) scr[(2 * i + (lane >> 5)) * 33 + (lane & 31)] = (unsigned short)(cvtpk(v[i], 0.f) & 0xffffu);
    LDS_WAIT(); asm volatile("" ::: "memory");
    const int c = lane & 7;
#pragma unroll
    for (int j = 0; j < 4; ++j) { const int n = (lane >> 3) + 8 * j; const LAS unsigned short* s = scr + (8 * c) * 33 + n;
        u32x4 o; o.x = (unsigned)s[0 * 33] | ((unsigned)s[1 * 33] << 16); o.y = (unsigned)s[2 * 33] | ((unsigned)s[3 * 33] << 16); o.z = (unsigned)s[4 * 33] | ((unsigned)s[5 * 33] << 16); o.w = (unsigned)s[6 * 33] | ((unsigned)s[7 * 33] << 16);
        *(u32x4*)(WT + (size_t)(n0 + n) * K + k0 + 8 * c) = o; }
    LDS_WAIT(); asm volatile("" ::: "memory");
}
__device__ __forceinline__ float modsum(const Ctx& C, int l, int c, int idx) {
    const float* mp = C.f(WS_MODP) + ((size_t)l * 5 + c) * 6144 + idx; float s = C.in(9)[l * 6144 + idx];
#pragma unroll
    for (int kp = 0; kp < 4; ++kp) s += mp[(size_t)kp * 4 * 5 * 6144];
    return s;
}
__device__ __forceinline__ void phase_p0a(const Ctx& C) {
    const int gw = C.bid * NWAVES + C.wave, NGW = C.G * NWAVES, gt = C.bid * NTHREADS + C.tid, NGT = C.G * NTHREADS;
    LAS unsigned short* scr = (LAS unsigned short*)(C.lds + C.wave * 4352);
#define DO_MAT(src, dst, K, N) for (int it = gw; it < ((K) / 64) * ((N) / 32); it += NGW) transpose_item((src), (K), (N), (dst), scr, it, C.lane)
    for (int j = 0; j < 2; ++j) { DO_MAT(C.in(12) + (size_t)j * D * NQKV, C.h(WS_WQKV) + (size_t)j * NQKV * D, D, NQKV); DO_MAT(C.in(13) + (size_t)j * D * D, C.h(WS_WO) + (size_t)j * D * D, D, D); }
    DO_MAT(C.in(15), C.h(WS_HWIN), D, NHIN); DO_MAT(C.in(18), C.h(WS_HWO), D, D); DO_MAT(C.in(27), C.h(WS_GLU), D, 2048);
    for (int l = 0; l < 4; ++l) { DO_MAT(C.in(28) + (size_t)l * D * NUP, C.h(WS_UP) + (size_t)l * NUP * D, D, NUP); DO_MAT(C.in(31) + (size_t)l * DFF * D, C.h(WS_DOWN) + (size_t)l * D * DFF, DFF, D); }
#undef DO_MAT
    __syncthreads();
    LAS float* sS = (LAS float*)(C.lds + 40960);
    LAS float* red = (LAS float*)(C.lds);
    for (int it = C.bid; it < 384; it += C.G) {
        const int l = it / 96, cb = (it % 96) >> 2, kp = it & 3;
        for (int i = C.tid; i < 5 * 256; i += NTHREADS) { const int c = i >> 8, k = kp * 256 + (i & 255); const float v = c == 0 ? C.in(7)[k] : C.in(6)[(c - 1) * 1024 + k]; sS[i] = v / (1.f + __expf(-v)); }
        __syncthreads();
        f32x4 a[5];
#pragma unroll
        for (int c = 0; c < 5; ++c) a[c] = (f32x4){0.f, 0.f, 0.f, 0.f};
        const float* wp = C.in(8) + ((size_t)l * 1024 + kp * 256 + C.wave * 32) * 6144 + cb * 256 + 4 * C.lane;
#pragma unroll 4
        for (int k = 0; k < 32; ++k) { const f32x4 w = *(const f32x4*)(wp + (size_t)k * 6144);
#pragma unroll
            for (int c = 0; c < 5; ++c) a[c] += w * sS[c * 256 + C.wave * 32 + k]; }
#pragma unroll
        for (int c = 0; c < 5; ++c) *(LAS f32x4*)(red + (C.wave * 5 + c) * 256 + 4 * C.lane) = a[c];
        __syncthreads();
        for (int i = C.tid; i < 5 * 256; i += NTHREADS) { float s = 0.f;
#pragma unroll
            for (int w = 0; w < 8; ++w) s += red[w * 1280 + i];
            C.f(WS_MODP)[(((size_t)kp * 4 + l) * 5 + (i >> 8)) * 6144 + cb * 256 + (i & 255)] = s; }
        __syncthreads();
    }
    { unsigned zero = 0u; asm volatile("" : "+v"(zero));
      for (int i = gt; i < 9 * M; i += NGT) ((u32x2*)(C.ws + WS_SS))[i] = (u32x2){zero, zero}; }
    for (int i = gt; i < 1024 * 32; i += NGT) { const int t = i >> 5, e = i & 31, fi = e & 15; const float pos = (e >> 4) == 0 ? (float)(t >> 6) : (float)(t & 63);
        const float ang = pos * (1.0f / powf(10000.0f, (float)(2 * fi) / 32.0f)); C.f(WS_ROPE)[i] = cosf(ang); C.f(WS_ROPE)[32768 + i] = sinf(ang); }
    for (int i = gt; i < 2 * 131072; i += NGT) { const int which = i >> 17, e = (i & 131071) * 8; const float* s = (which ? C.in(3) : C.in(2)) + e; const f32x4 a = *(const f32x4*)s, b = *(const f32x4*)(s + 4);
        u32x4 o; o.x = cvtpk(a[0], a[1]); o.y = cvtpk(a[2], a[3]); o.z = cvtpk(b[0], b[1]); o.w = cvtpk(b[2], b[3]); *(u32x4*)(C.h(which ? WS_CTXV : WS_CTXK) + e) = o; }
    for (int i = gt; i < 2048; i += NGT) { float v[4], mx = -1e30f;
#pragma unroll
        for (int l = 0; l < 4; ++l) { v[l] = C.in(16)[l * 2048 + i]; mx = fmaxf(mx, v[l]); }
        float s = 0.f;
#pragma unroll
        for (int l = 0; l < 4; ++l) { v[l] = expf(v[l] - mx); s += v[l]; }
        C.f(WS_LB1)[i] = v[1] / s; }
    for (int i = gt; i < 8192; i += NGT) {
        const int dg = i >> 6, p = i & 63;
        const float ar = fminf(C.in(19)[i], -1e-4f), ai = C.in(20)[i], dt = expf(C.in(21)[dg]);
        const float e = expf(ar * dt), lr = e * cosf(ai * dt), li = e * sinf(ai * dt);
        const float den = ar * ar + ai * ai, fr = ((lr - 1.f) * ar + li * ai) / den, fi = (li * ar - (lr - 1.f) * ai) / den;
        C.f(WS_SLAM)[2 * i] = lr; C.f(WS_SLAM)[2 * i + 1] = li;
        unsigned wr_[8], wi_[8];
#pragma unroll
        for (int q = 0; q < 8; ++q) { const float x0 = C.in(22)[(size_t)i * 16 + 2 * q], y0 = C.in(23)[(size_t)i * 16 + 2 * q], x1 = C.in(22)[(size_t)i * 16 + 2 * q + 1], y1 = C.in(23)[(size_t)i * 16 + 2 * q + 1];
            wr_[q] = cvtpk(fr * x0 - fi * y0, fr * x1 - fi * y1); wi_[q] = cvtpk(fr * y0 + fi * x0, fr * y1 + fi * x1); }
        bf16_t* bb = C.h(WS_SBB) + ((size_t)dg * 128 + p) * 16;
        *(u32x4*)bb = (u32x4){wr_[0], wr_[1], wr_[2], wr_[3]}; *(u32x4*)(bb + 8) = (u32x4){wr_[4], wr_[5], wr_[6], wr_[7]};
        *(u32x4*)(bb + 64 * 16) = (u32x4){wi_[0], wi_[1], wi_[2], wi_[3]}; *(u32x4*)(bb + 64 * 16 + 8) = (u32x4){wi_[4], wi_[5], wi_[6], wi_[7]};
    }
    for (int i = gt; i < 2 * 64 * 16 * 64; i += NGT) {
        const int p = i & 63, row = i >> 6; bf16_t* cb = C.h(WS_SCB) + (size_t)row * 128;
        cb[p] = (bf16_t)(cvtpk(C.in(24)[i], 0.f) & 0xffffu); cb[64 + p] = (bf16_t)(cvtpk(-C.in(25)[i], 0.f) & 0xffffu); }
}
__device__ __forceinline__ void rows_ap_ss(const Ctx& C, const float* xsrc_p, const float* xsrc_s, float* xcopy, int l, int s, bool from_table, u64_t* ssdst) {
    for (int gw = C.bid * NWAVES + C.wave; gw < M / 4; gw += C.G * NWAVES) {
    const int r0 = gw * 4;
    const int c = cond_of_row(r0);
    f32x4 gm[4];
#pragma unroll
    for (int j = 0; j < 4; ++j) { const int n = 4 * C.lane + 256 * j;
        if (from_table) gm[j] = *(const f32x4*)(C.f(WS_GMOD) + (((size_t)l * 2 + s) * 5 + c) * 1024 + n);
        else { const float* g = (s == 0 ? C.in(10) : C.in(11)) + l * D + n;
#pragma unroll
            for (int e = 0; e < 4; ++e) gm[j][e] = g[e] * (1.f + modsum(C, l, c, (s == 0 ? 1 : 4) * 1024 + n + e)); } }
    for (int rr = 0; rr < 4; ++rr) {
        const int r = r0 + rr; const float* xr = (r < MP ? xsrc_p + (size_t)r * D : xsrc_s + (size_t)(r - MP) * D);
        f32x4 v[4]; float sq = 0.f;
#pragma unroll
        for (int j = 0; j < 4; ++j) { v[j] = *(const f32x4*)(xr + 4 * C.lane + 256 * j); sq += (v[j][0] * v[j][0] + v[j][1] * v[j][1]) + (v[j][2] * v[j][2] + v[j][3] * v[j][3]); }
        sq = wave_sum(sq);
#pragma unroll
        for (int j = 0; j < 4; ++j) { const size_t off = (size_t)r * D + 4 * C.lane + 256 * j; if (xcopy) *(f32x4*)(xcopy + off) = v[j]; st_bf16x4(C.h(WS_AP) + off, v[j] * gm[j]); }
        if (C.lane == 0) ssdst[r] = (u64_t)(sq * SS_FIX);
    }
    }
}
__device__ __forceinline__ void phase_p0c(const Ctx& C) {
    for (int vb = C.bid; vb < 256; vb += C.G) {
    if (vb < 240) {
        int ch = vb, l = 0, s = 0, N = 0; const bf16_t* Wt = nullptr;
        if (ch < 12) { l = 0; s = 0; N = NQKV; Wt = C.h(WS_WQKV); }
        else if ((ch -= 12) < 44) { l = 0; s = 1; N = NUP; Wt = C.h(WS_UP); }
        else if ((ch -= 44) < 40) { l = 1; s = 0; N = NHIN; Wt = C.h(WS_HWIN); }
        else if ((ch -= 40) < 44) { l = 1; s = 1; N = NUP; Wt = C.h(WS_UP) + (size_t)1 * NUP * D; }
        else if ((ch -= 44) < 44) { l = 2; s = 1; N = NUP; Wt = C.h(WS_UP) + (size_t)2 * NUP * D; }
        else if ((ch -= 44) < 12) { l = 3; s = 0; N = NQKV; Wt = C.h(WS_WQKV) + (size_t)1 * NQKV * D; }
        else { ch -= 12; l = 3; s = 1; N = NUP; Wt = C.h(WS_UP) + (size_t)3 * NUP * D; }
        LAS float* sh = (LAS float*)C.lds;
        for (int i = C.tid; i < 5 * 1024; i += NTHREADS) sh[i] = modsum(C, l, i >> 10, (s == 0 ? 0 : 3) * 1024 + (i & 1023));
        __syncthreads();
        for (int q = 0; q < 16; ++q) {
            const int n = ch * 128 + C.wave * 16 + q;
            const u32x4 w0 = *(const u32x4*)(Wt + (size_t)n * D + 16 * C.lane), w1 = *(const u32x4*)(Wt + (size_t)n * D + 16 * C.lane + 8);
            float wv[16];
#pragma unroll
            for (int e = 0; e < 4; ++e) { wv[2 * e] = bflo(w0[e]); wv[2 * e + 1] = bfhi(w0[e]); wv[8 + 2 * e] = bflo(w1[e]); wv[8 + 2 * e + 1] = bfhi(w1[e]); }
            float a[5];
#pragma unroll
            for (int c = 0; c < 5; ++c) { a[c] = 0.f;
#pragma unroll
                for (int e = 0; e < 16; ++e) a[c] += wv[e] * sh[c * 1024 + 16 * C.lane + e]; a[c] = wave_sum(a[c]); }
            if (C.lane == 0) {
#pragma unroll
                for (int c = 0; c < 5; ++c) C.f(WS_SW)[(((size_t)l * 2 + s) * 5 + c) * SW_STRIDE + n] = a[c]; }
        }
    } else {
        const int t = (vb - 240) * NTHREADS + C.tid, NT = 16 * NTHREADS;
        for (int i = t; i < 4 * 5 * 6144; i += NT) { const int l = i / 30720, c = (i / 6144) % 5, idx = i % 6144; C.f(WS_MOD)[i] = modsum(C, l, c, idx); }
        for (int i = t; i < 4 * 2 * 5 * 1024; i += NT) { const int n = i & 1023, c = (i >> 10) % 5, s = (i / 5120) & 1, l = i / 10240;
            C.f(WS_GMOD)[i] = (s == 0 ? C.in(10) : C.in(11))[l * D + n] * (1.f + modsum(C, l, c, (s == 0 ? 1 : 4) * 1024 + n)); }
    }
    __syncthreads();
    }
    rows_ap_ss(C, C.in(0), C.in(1), C.f(WS_X), 0, 0, false, (u64_t*)(C.ws + WS_SS));
}
__device__ __forceinline__ void phase_glue(const Ctx& C, int l, int s) { rows_ap_ss(C, C.f(WS_X), C.f(WS_X) + (size_t)MP * D, nullptr, l, s, true, (u64_t*)(C.ws + WS_SS) + (size_t)(l * 2 + s) * M); }

__device__ __forceinline__ void phase_conv(const Ctx& C, int l) {
    const bf16_t* h = C.h(WS_SCR); bf16_t* act = C.h(WS_ACT); const float* cw = C.in(29) + (size_t)l * 3 * NUP; const float* cb = C.in(30) + (size_t)l * NUP;
    const int gt = C.bid * NTHREADS + C.tid, NGT = C.G * NTHREADS;
    for (int i = gt; i < M * (DFF / 8); i += NGT) {
        const int r = i / (DFF / 8), n = (i % (DFF / 8)) * 8;
        int t, S; if (r < MP) { t = r & 255; S = 256; } else { t = (r - MP) & 1023; S = 1024; }
        float g[8], v[8];
#pragma unroll
        for (int e = 0; e < 8; ++e) { g[e] = cb[n + e]; v[e] = cb[DFF + n + e]; }
#pragma unroll
        for (int jj = 0; jj < 3; ++jj) { const int tt = t + jj - 1; if (tt >= 0 && tt < S) {
            const u32x4 hg = *(const u32x4*)(h + (size_t)(r + jj - 1) * NUP + n), hv = *(const u32x4*)(h + (size_t)(r + jj - 1) * NUP + DFF + n);
#pragma unroll
            for (int e = 0; e < 4; ++e) { g[2 * e] += cw[jj * NUP + n + 2 * e] * bflo(hg[e]); g[2 * e + 1] += cw[jj * NUP + n + 2 * e + 1] * bfhi(hg[e]);
                v[2 * e] += cw[jj * NUP + DFF + n + 2 * e] * bflo(hv[e]); v[2 * e + 1] += cw[jj * NUP + DFF + n + 2 * e + 1] * bfhi(hv[e]); } } }
        u32x4 o;
#pragma unroll
        for (int e = 0; e < 4; ++e) o[e] = cvtpk(g[2 * e] * sigm(g[2 * e]) * v[2 * e], g[2 * e + 1] * sigm(g[2 * e + 1]) * v[2 * e + 1]);
        *(u32x4*)(act + (size_t)r * DFF + n) = o;
    }
}
__device__ __forceinline__ void phase_final(const Ctx& C, float dbg) {
    const int gw = C.bid * NWAVES + C.wave, NGW = C.G * NWAVES; const u64_t* ss = (const u64_t*)(C.ws + WS_SS) + (size_t)8 * M;
    for (int r = gw; r < M; r += NGW) { const float rs = rstd_of(ss, r);
#pragma unroll
        for (int j = 0; j < 4; ++j) { const int n = 4 * C.lane + 256 * j; float* p = C.out + (size_t)r * D + n; *(f32x4*)p = *(const f32x4*)p * (rs * dbg) * *(const f32x4*)(C.in(32) + n); } }
}
}
namespace om {
__device__ __forceinline__ int rowidx(int r, int h) { return (r & 3) + 8 * (r >> 2) + 4 * h; }
__device__ __forceinline__ float xhalf(float v) {
    auto rr = __builtin_amdgcn_permlane32_swap(__float_as_uint(v), __float_as_uint(v), false, false);
    return __uint_as_float((lane_id() & 32) ? rr[0] : rr[1]);
}
__device__ __forceinline__ bf16x8 pack8(const f32x16& x, int base) {
    u32x4 w; w.x = cvtpk(x[base], x[base + 1]); w.y = cvtpk(x[base + 2], x[base + 3]); w.z = cvtpk(x[base + 4], x[base + 5]); w.w = cvtpk(x[base + 6], x[base + 7]);
    return __builtin_bit_cast(bf16x8, w);
}
__device__ __forceinline__ bf16x8 cat44(u32x2 a, u32x2 b) { u32x4 w = {a.x, a.y, b.x, b.y}; return __builtin_bit_cast(bf16x8, w); }

constexpr int AT_KSTR = 144;
constexpr int AT_BUF = 2 * 64 * AT_KSTR;
__device__ __forceinline__ void attn_unit(const Ctx& C, int j, bool samp, int b, int hq, int qb, size_t obuf) {
    const int lane = C.lane, c = lane & 31, h = lane >> 5, w = C.wave, kvh = hq >> 2;
    const int rowbase = samp ? MP + b * 1024 : b * 256, q0 = qb * 256, qlo = q0 + 32 * w;
    const bf16_t* Q = C.h(SCR_Q); const bf16_t* KB = C.h(SCR_KB); const bf16_t* VB = C.h(SCR_VB);
    const bf16_t* CK = C.h(WS_CTXK) + ((size_t)(b * 2 + j) * 512) * 256; const bf16_t* CV = C.h(WS_CTXV) + ((size_t)(b * 2 + j) * 512) * 256;
    int klo = 0, nlat = 4, NT = 4;
    if (samp) { klo = q0 - 128 < 0 ? 0 : q0 - 128; const int khi = q0 + 384 > 1024 ? 1024 : q0 + 384; nlat = (khi - klo) >> 6; NT = nlat + 8; }
    bf16x8 qf[4];
#pragma unroll
    for (int s = 0; s < 4; ++s) qf[s] = *(const bf16x8*)(Q + (size_t)(rowbase + qlo + c) * D + hq * 64 + 16 * s + 8 * h);
    float m = C.in(14)[j * 16 + hq] * LOG2E, lsum = h == 0 ? 1.f : 0.f;
    f32x16 o0 = {}, o1 = {};
    const int lkey = C.tid >> 3, lch = C.tid & 7;
    auto src_k = [&](int t) -> const bf16_t* { return (t < nlat ? KB + (size_t)(rowbase + klo + 64 * t + lkey) * 256 : CK + (size_t)(64 * (t - nlat) + lkey) * 256) + kvh * 64 + lch * 8; };
    auto src_v = [&](int t) -> const bf16_t* { return (t < nlat ? VB + (size_t)(rowbase + klo + 64 * t + lkey) * 256 : CV + (size_t)(64 * (t - nlat) + lkey) * 256) + kvh * 64 + lch * 8; };
    auto put = [&](int buf, u32x4 kr, u32x4 vr) {
        LAS unsigned char* kb = C.lds + buf * AT_BUF; LAS unsigned char* vb = kb + 64 * AT_KSTR;
        *(LAS u32x4*)(kb + lkey * AT_KSTR + lch * 16) = kr;
#pragma unroll
        for (int e = 0; e < 4; ++e) { *(LAS unsigned short*)(vb + (lch * 8 + 2 * e) * AT_KSTR + lkey * 2) = (unsigned short)(vr[e] & 0xffffu); *(LAS unsigned short*)(vb + (lch * 8 + 2 * e + 1) * AT_KSTR + lkey * 2) = (unsigned short)(vr[e] >> 16); }
    };
    { const u32x4 kr = *(const u32x4*)src_k(0), vr = *(const u32x4*)src_v(0); put(0, kr, vr); }
    __syncthreads();
    for (int t = 0; t < NT; ++t) {
        u32x4 kr = {}, vr = {};
        if (t + 1 < NT) { kr = *(const u32x4*)src_k(t + 1); vr = *(const u32x4*)src_v(t + 1); }
        const bool lat = samp && t < nlat; const int key0 = klo + 64 * t;
        const bool skip = lat && (key0 > qlo + 31 + 128 || key0 + 63 < qlo - 128);
        if (!skip) {
            LAS unsigned char* kb = C.lds + (t & 1) * AT_BUF; LAS unsigned char* vb = kb + 64 * AT_KSTR;
            f32x16 x0 = {}, x1 = {};
#pragma unroll
            for (int s = 0; s < 4; ++s) {
                const bf16x8 a0 = *(const LAS bf16x8*)(kb + c * AT_KSTR + (16 * s + 8 * h) * 2), a1 = *(const LAS bf16x8*)(kb + (32 + c) * AT_KSTR + (16 * s + 8 * h) * 2);
                x0 = __builtin_amdgcn_mfma_f32_32x32x16_bf16(a0, qf[s], x0, 0, 0, 0); x1 = __builtin_amdgcn_mfma_f32_32x32x16_bf16(a1, qf[s], x1, 0, 0, 0);
            }
            if (lat && !(key0 >= qlo + 31 - 128 && key0 + 63 <= qlo + 128)) {
                const int tq = qlo + c;
#pragma unroll
                for (int r = 0; r < 16; ++r) { const int k0 = key0 + rowidx(r, h) - tq; if (k0 > 128 || k0 < -128) x0[r] = -INFINITY; if (k0 + 32 > 128 || k0 + 32 < -128) x1[r] = -INFINITY; }
            }
            float mx = fmaxf(x0[0], x1[0]);
#pragma unroll
            for (int r = 1; r < 16; ++r) mx = fmaxf(mx, fmaxf(x0[r], x1[r]));
            mx = fmaxf(mx, xhalf(mx));
            const float mn = fmaxf(m, mx), al = __builtin_amdgcn_exp2f(m - mn); m = mn;
            float ps = 0.f;
#pragma unroll
            for (int r = 0; r < 16; ++r) { x0[r] = __builtin_amdgcn_exp2f(x0[r] - mn); x1[r] = __builtin_amdgcn_exp2f(x1[r] - mn); ps += x0[r] + x1[r]; }
            lsum = lsum * al + ps;
#pragma unroll
            for (int r = 0; r < 16; ++r) { o0[r] *= al; o1[r] *= al; }
#pragma unroll
            for (int ks = 0; ks < 2; ++ks) {
                const bf16x8 p0 = pack8(x0, 8 * ks), p1 = pack8(x1, 8 * ks);
#pragma unroll
                for (int dt = 0; dt < 2; ++dt) {
                    const LAS unsigned char* vrow = vb + (32 * dt + c) * AT_KSTR + (16 * ks + 4 * h) * 2;
                    const bf16x8 v0 = cat44(*(const LAS u32x2*)(vrow), *(const LAS u32x2*)(vrow + 16)), v1 = cat44(*(const LAS u32x2*)(vrow + 64), *(const LAS u32x2*)(vrow + 80));
                    if (dt == 0) { o0 = __builtin_amdgcn_mfma_f32_32x32x16_bf16(v0, p0, o0, 0, 0, 0); o0 = __builtin_amdgcn_mfma_f32_32x32x16_bf16(v1, p1, o0, 0, 0, 0); }
                    else { o1 = __builtin_amdgcn_mfma_f32_32x32x16_bf16(v0, p0, o1, 0, 0, 0); o1 = __builtin_amdgcn_mfma_f32_32x32x16_bf16(v1, p1, o1, 0, 0, 0); }
                }
            }
        }
        if (t + 1 < NT) put((t + 1) & 1, kr, vr);
        __syncthreads();
    }
    lsum += xhalf(lsum);
    const float il = 1.f / lsum;
    bf16_t* O = C.h(obuf) + (size_t)(rowbase + qlo + c) * D + hq * 64 + 4 * h;
#pragma unroll
    for (int g = 0; g < 4; ++g) { st_bf16x4(O + 8 * g, (f32x4){o0[4 * g], o0[4 * g + 1], o0[4 * g + 2], o0[4 * g + 3]} * il); st_bf16x4(O + 32 + 8 * g, (f32x4){o1[4 * g], o1[4 * g + 1], o1[4 * g + 2], o1[4 * g + 3]} * il); }
}
__device__ __forceinline__ void phase_attn(const Ctx& C, int l, size_t obuf) {
    const int j = l / 3;
    for (int u = C.bid; u < 512; u += C.G) {
        if (u < 256) attn_unit(C, j, false, u >> 4, u & 15, 0, obuf);
        else { const int v = u - 256; attn_unit(C, j, true, v >> 6, (v >> 2) & 15, v & 3, obuf); }
    }
}
constexpr size_t CKS_TAB = 376 * MiB; constexpr int CKS_NW = (int)((268 * MiB) / 65536), CKS_NO = (17039360 * 4) / 65536, CKS_N = CKS_NW + CKS_NO;
__device__ __forceinline__ void phase_cks(const Ctx& C, int slot) {
    const int gw = C.bid * NWAVES + C.wave, NGW = C.G * NWAVES; unsigned* tab = (unsigned*)(C.ws + CKS_TAB) + (size_t)slot * 8192;
    for (int ck = gw; ck < CKS_N; ck += NGW) {
        const unsigned char* base = ck < CKS_NW ? C.ws + 108 * MiB + (size_t)ck * 65536 : (const unsigned char*)C.out + (size_t)(ck - CKS_NW) * 65536; unsigned s = 0;
        for (int i = 0; i < 64; ++i) { const u32x4 v = *(const u32x4*)(base + (size_t)i * 1024 + C.lane * 16); s += v[0] + v[1] * 3u + v[2] * 5u + v[3] * 7u; }
#pragma unroll
        for (int o = 1; o < 64; o <<= 1) s += (unsigned)__shfl_xor((int)s, o);
        if (C.lane == 0) tab[ck] = s;
    }
}
__device__ __forceinline__ void phase_clr(const Ctx& C) {
    const int gt = C.bid * NTHREADS + C.tid, NGT = C.G * NTHREADS; const u32x4 z = {0u, 0u, 0u, 0u};
    for (size_t i = gt; i < (268 * MiB) / 16; i += NGT) *(u32x4*)(C.ws + 108 * MiB + i * 16) = z;
    for (size_t i = gt; i < (size_t)17039360 / 4; i += NGT) *(u32x4*)((unsigned char*)C.out + i * 16) = z;
}
__device__ __forceinline__ void phase_clr2(const Ctx& C, size_t off, size_t bytes) {
    const int gt = C.bid * NTHREADS + C.tid, NGT = C.G * NTHREADS; const u32x4 z = {0u, 0u, 0u, 0u};
    for (size_t i = gt; i < bytes / 16; i += NGT) *(u32x4*)(C.ws + off + i * 16) = z;
}
__device__ __forceinline__ void phase_cmp(const Ctx& C, int nslots) {
    const int gt = C.bid * NTHREADS + C.tid, NGT = C.G * NTHREADS; const unsigned* tab = (const unsigned*)(C.ws + CKS_TAB);
    for (int i = gt; i < nslots * 8192; i += NGT) { const int sl = i >> 13, ck = i & 8191; if (ck < CKS_N && tab[(size_t)sl * 8192 + ck] != tab[(size_t)(sl + 32) * 8192 + ck]) {
#ifdef SSDET
        const int cls = ck >= CKS_NW ? 4 : (ck < 1472 + 512 ? 1 : 2); atomicOr((unsigned*)(C.ws + WS_CTL) + 4002, (unsigned)cls); atomicAdd((unsigned*)(C.ws + WS_CTL) + 4003, 1u);
#endif
        atomicMax((unsigned*)(C.ws + WS_CTL) + 4001, (unsigned)(1000 - sl)); } }
}
__device__ __forceinline__ void phase_chk(const Ctx& C, size_t a, size_t b, size_t bytes) {
    const int gt = C.bid * NTHREADS + C.tid, NGT = C.G * NTHREADS; unsigned bad = 0;
    for (size_t i = gt; i < bytes / 16; i += NGT) { const u32x4 x = *(const u32x4*)(C.ws + a + i * 16), y = *(const u32x4*)(C.ws + b + i * 16); bad += (x[0] != y[0]) | (x[1] != y[1]) | (x[2] != y[2]) | (x[3] != y[3]); }
    if (bad) atomicAdd((unsigned*)(C.ws + WS_CTL) + 4000, bad);
}

constexpr int HS_QSTR = 272, HS_TSTR = 80;
constexpr int HS_QT = 0, HS_KT = 32 * HS_QSTR, HS_KTT = 2 * 32 * HS_QSTR, HS_VT = HS_KTT + 128 * HS_TSTR, HS_E1 = HS_VT + 128 * HS_TSTR, HS_E2 = HS_E1 + 512, HS_T1 = HS_E2 + 512, HS_GRP = HS_T1 + 512;
__device__ __forceinline__ void hscan_item(const Ctx& C, int item) {
    const bool samp = item < 64; const int it = samp ? item : item - 64;
    const int dir = it & 1, hd = (it >> 1) & 7, sq = it >> 4;
    const int S = samp ? 1024 : 256, rowbase = samp ? MP + sq * 1024 : sq * 256, nchunk = S >> 5;
    const int tg = C.tid & 255, lane = C.lane, c = lane & 31, h = lane >> 5, w4 = C.wave & 3; const bool producer = C.wave >= 4;
    LAS unsigned char* L = C.lds;
    const bf16_t* HQ = C.h(SCR_HQ); const bf16_t* HV = C.h(SCR_HV); const float* LF = C.f(dir == 0 ? SCR_LFF : SCR_LFB); float* OD = C.f(dir == 0 ? SCR_OF : SCR_OB);
    const int pd = tg & 127, ph = tg >> 7;
    unsigned qw[8], kw[8], vtw[8]; float e1v = 0.f, e2v = 0.f;
    auto produce = [&](int ch) {
        float cl[16], qv[16], kv[16]; float pre = 0.f;
        if (ph == 1) {
#pragma unroll
            for (int i = 0; i < 16; ++i) { const int pos = 32 * ch + i, t = dir == 0 ? pos : S - 1 - pos; pre += LF[(size_t)(rowbase + t) * D + hd * 128 + pd]; } }
        float run = 0.f;
#pragma unroll
        for (int i = 0; i < 16; ++i) { const int pos = 32 * ch + 16 * ph + i, t = dir == 0 ? pos : S - 1 - pos; const size_t off = (size_t)(rowbase + t) * D + hd * 128 + pd;
            const float lf = LF[off]; run += lf; cl[i] = run; kv[i] = 1.f - __expf(lf); qv[i] = bf2f(HQ[off]); }
#pragma unroll
        for (int i = 0; i < 8; ++i) { const int pos = 32 * ch + 16 * ph + 2 * i, t0 = dir == 0 ? pos : S - 1 - pos, t1 = dir == 0 ? pos + 1 : S - 2 - pos;
            vtw[i] = (unsigned)HV[(size_t)(rowbase + t0) * D + hd * 128 + pd] | ((unsigned)HV[(size_t)(rowbase + t1) * D + hd * 128 + pd] << 16); }
        const float t1v = ph == 0 ? cl[15] : pre;
#pragma unroll
        for (int i = 0; i < 16; i += 2) {
            const float e0 = ph == 0 ? cl[i] - t1v : cl[i], e1 = ph == 0 ? cl[i + 1] - t1v : cl[i + 1];
            qw[i >> 1] = cvtpk(qv[i] * __expf(e0), qv[i + 1] * __expf(e1)); kw[i >> 1] = cvtpk(kv[i] * __expf(-e0), kv[i + 1] * __expf(-e1)); }
        e1v = __expf(t1v); e2v = __expf(cl[15]);
    };
    auto put = [&]() {
#pragma unroll
        for (int i = 0; i < 8; ++i) {
            *(LAS unsigned short*)(L + HS_QT + (16 * ph + 2 * i) * HS_QSTR + pd * 2) = (unsigned short)(qw[i] & 0xffffu); *(LAS unsigned short*)(L + HS_QT + (16 * ph + 2 * i + 1) * HS_QSTR + pd * 2) = (unsigned short)(qw[i] >> 16);
            *(LAS unsigned short*)(L + HS_KT + (16 * ph + 2 * i) * HS_QSTR + pd * 2) = (unsigned short)(kw[i] & 0xffffu); *(LAS unsigned short*)(L + HS_KT + (16 * ph + 2 * i + 1) * HS_QSTR + pd * 2) = (unsigned short)(kw[i] >> 16); }
        *(LAS u32x4*)(L + HS_KTT + pd * HS_TSTR + ph * 32) = (u32x4){kw[0], kw[1], kw[2], kw[3]}; *(LAS u32x4*)(L + HS_KTT + pd * HS_TSTR + ph * 32 + 16) = (u32x4){kw[4], kw[5], kw[6], kw[7]};
        *(LAS u32x4*)(L + HS_VT + pd * HS_TSTR + ph * 32) = (u32x4){vtw[0], vtw[1], vtw[2], vtw[3]}; *(LAS u32x4*)(L + HS_VT + pd * HS_TSTR + ph * 32 + 16) = (u32x4){vtw[4], vtw[5], vtw[6], vtw[7]};
        if (ph == 0) *(LAS float*)(L + HS_E1 + pd * 4) = e1v; else *(LAS float*)(L + HS_E2 + pd * 4) = e2v;
    };
    f32x16 St[4];
    if (!producer) {
#pragma unroll
        for (int dt = 0; dt < 4; ++dt) {
            if (samp) { const float* s0 = C.in(4) + ((((size_t)sq * 2 + dir) * 8 + hd) * 128) * 128;
#pragma unroll
                for (int r = 0; r < 16; ++r) St[dt][r] = s0[(size_t)(32 * dt + rowidx(r, h)) * 128 + 32 * w4 + c]; }
            else St[dt] = (f32x16){};
        }
    } else produce(0);
    for (int ch = 0; ch < nchunk; ++ch) {
        if (producer) put();
        __syncthreads();
        if (producer) { if (ch + 1 < nchunk) produce(ch + 1); }
        else {
#pragma unroll
        for (int dt = 0; dt < 4; ++dt)
#pragma unroll
            for (int g = 0; g < 4; ++g) { const f32x4 e = *(const LAS f32x4*)(L + HS_E1 + (32 * dt + 8 * g + 4 * h) * 4);
#pragma unroll
                for (int q = 0; q < 4; ++q) St[dt][4 * g + q] *= e[q]; }
        f32x16 X = {};
#pragma unroll
        for (int s = 0; s < 8; ++s) {
            const bf16x8 a = *(const LAS bf16x8*)(L + HS_KT + c * HS_QSTR + (16 * s + 8 * h) * 2), bq = *(const LAS bf16x8*)(L + HS_QT + c * HS_QSTR + (16 * s + 8 * h) * 2);
            X = __builtin_amdgcn_mfma_f32_32x32x16_bf16(a, bq, X, 0, 0, 0);
        }
#pragma unroll
        for (int r = 0; r < 16; ++r) if (rowidx(r, h) > c) X[r] = 0.f;
        f32x16 OT = {};
#pragma unroll
        for (int ks = 0; ks < 2; ++ks) {
            const LAS unsigned char* vrow = L + HS_VT + (32 * w4 + c) * HS_TSTR + (16 * ks + 4 * h) * 2;
            const bf16x8 va = cat44(*(const LAS u32x2*)(vrow), *(const LAS u32x2*)(vrow + 16));
            OT = __builtin_amdgcn_mfma_f32_32x32x16_bf16(va, pack8(X, 8 * ks), OT, 0, 0, 0);
        }
#pragma unroll
        for (int dt = 0; dt < 4; ++dt)
#pragma unroll
            for (int ks = 0; ks < 2; ++ks) {
                const LAS unsigned char* qrow = L + HS_QT + c * HS_QSTR + (32 * dt + 16 * ks + 4 * h) * 2;
                const bf16x8 bq = cat44(*(const LAS u32x2*)(qrow), *(const LAS u32x2*)(qrow + 16));
                OT = __builtin_amdgcn_mfma_f32_32x32x16_bf16(pack8(St[dt], 8 * ks), bq, OT, 0, 0, 0);
            }
#pragma unroll
        for (int dt = 0; dt < 4; ++dt)
#pragma unroll
            for (int ks = 0; ks < 2; ++ks) {
                const bf16x8 a = *(const LAS bf16x8*)(L + HS_KTT + (32 * dt + c) * HS_TSTR + (16 * ks + 8 * h) * 2), bv = *(const LAS bf16x8*)(L + HS_VT + (32 * w4 + c) * HS_TSTR + (16 * ks + 8 * h) * 2);
                St[dt] = __builtin_amdgcn_mfma_f32_32x32x16_bf16(a, bv, St[dt], 0, 0, 0);
            }
#pragma unroll
        for (int dt = 0; dt < 4; ++dt)
#pragma unroll
            for (int g = 0; g < 4; ++g) { const f32x4 e = *(const LAS f32x4*)(L + HS_E2 + (32 * dt + 8 * g + 4 * h) * 4);
#pragma unroll
                for (int q = 0; q < 4; ++q) St[dt][4 * g + q] *= e[q]; }
        { const int pos = 32 * ch + c, t = dir == 0 ? pos : S - 1 - pos; float* op = OD + (size_t)(rowbase + t) * D + hd * 128 + 32 * w4 + 4 * h;
#pragma unroll
            for (int g = 0; g < 4; ++g) *(f32x4*)(op + 8 * g) = (f32x4){OT[4 * g], OT[4 * g + 1], OT[4 * g + 2], OT[4 * g + 3]}; }
        }
        __syncthreads();
    }
    if (!samp && !producer) { float* so = C.out + 8388608 + 2 * 2097152 + ((((size_t)sq * 2 + dir) * 8 + hd) * 128) * 128;
        int c2 = c, h2 = h; asm volatile("" : "+v"(c2), "+v"(h2));
        unsigned base = (unsigned)((4 * h2) * 128 + 32 * w4 + c2);
#pragma unroll
        for (int dt = 0; dt < 4; ++dt)
#pragma unroll
            for (int r = 0; r < 16; ++r) so[base + (unsigned)((32 * dt + (r & 3) + 8 * (r >> 2)) * 128)] = St[dt][r]; }
}
__device__ __forceinline__ void phase_hscan(const Ctx& C) {
    if (C.G == 256) {
        hscan_item(C, C.bid);
        if (C.bid >= 64 && C.bid < 128) hscan_item(C, 256 + (C.bid - 64));
    } else for (int it = C.bid; it < 320; it += C.G) hscan_item(C, it);
}
__device__ __forceinline__ void phase_hpost(const Ctx& C) {
    const int gw = C.bid * NWAVES + C.wave, NGW = C.G * NWAVES;
    for (int r = gw; r < M; r += NGW) {
        const size_t off = (size_t)r * D + 16 * C.lane; float o[16]; float sq = 0.f;
#pragma unroll
        for (int q = 0; q < 4; ++q) { const f32x4 a = *(const f32x4*)(C.f(SCR_OF) + off + 4 * q), b = *(const f32x4*)(C.f(SCR_OB) + off + 4 * q);
#pragma unroll
            for (int e = 0; e < 4; ++e) { o[4 * q + e] = a[e] + b[e]; sq += o[4 * q + e] * o[4 * q + e]; } }
        sq += __shfl_xor(sq, 1); sq += __shfl_xor(sq, 2); sq += __shfl_xor(sq, 4);
        const float rs = rsqrtf(sq * (1.f / 128.f) + EPS);
        const u32x4 g0 = *(const u32x4*)(C.h(SCR_HG) + off), g1 = *(const u32x4*)(C.h(SCR_HG) + off + 8);
        const float* gn = C.in(17) + (16 * C.lane & 127);
        float sg[16];
#pragma unroll
        for (int e = 0; e < 4; ++e) { sg[2 * e] = bflo(g0[e]); sg[2 * e + 1] = bfhi(g0[e]); sg[8 + 2 * e] = bflo(g1[e]); sg[8 + 2 * e + 1] = bfhi(g1[e]); }
        u32x4 w0, w1;
#pragma unroll
        for (int e = 0; e < 4; ++e) { w0[e] = cvtpk(o[2 * e] * rs * gn[2 * e] * sg[2 * e], o[2 * e + 1] * rs * gn[2 * e + 1] * sg[2 * e + 1]);
            w1[e] = cvtpk(o[8 + 2 * e] * rs * gn[8 + 2 * e] * sg[8 + 2 * e], o[8 + 2 * e + 1] * rs * gn[8 + 2 * e + 1] * sg[8 + 2 * e + 1]); }
        *(u32x4*)(C.h(SCR_AWO) + off) = w0; *(u32x4*)(C.h(SCR_AWO) + off + 8) = w1;
    }
}

constexpr int SS_RSTR = 512;
constexpr int SS_WAVE = 16 * SS_RSTR;
__device__ __forceinline__ void sscan_seq(const Ctx& C, int l, bool samp, int sq, int dir, int g, size_t ydbg) {
    const int lane = C.lane, c = lane & 31, h = lane >> 5, dg = dir * 64 + g;
    const int S = samp ? 1024 : 256, rowbase = samp ? MP + sq * 1024 : sq * 256, nchunk = S >> 5, cond = samp ? 1 + sq : 0;
    LAS unsigned char* LB = C.lds + C.wave * SS_WAVE; LAS unsigned char* LH = LB + 4096;
    const float* X = C.f(WS_X); const u64_t* ss = (const u64_t*)(C.ws + WS_SS) + (size_t)(l * 2) * M; float* Y = C.f(ydbg ? ydbg : (dir == 0 ? SCR_YF : SCR_YB)); const bool ywr = !ydbg || dir == 0;
    bf16x8 bfr[4], cfr[4];
#pragma unroll
    for (int ct = 0; ct < 4; ++ct) bfr[ct] = *(const bf16x8*)(C.h(WS_SBB) + ((size_t)dg * 128 + 32 * ct + c) * 16 + 8 * h);
#pragma unroll
    for (int s = 0; s < 4; ++s) cfr[s] = *(const bf16x8*)(C.h(WS_SCB) + ((size_t)dg * 16 + (lane & 15)) * 128 + 32 * s + 8 * (lane >> 4));
    const float lr = C.f(WS_SLAM)[2 * (dg * 64 + lane)], li = C.f(WS_SLAM)[2 * (dg * 64 + lane) + 1];
    f32x4 gm0, gm1, sh0, sh1;
    { const float* gm = C.f(WS_GMOD) + ((size_t)(l * 2) * 5 + cond) * 1024 + g * 16 + 8 * h; gm0 = *(const f32x4*)gm; gm1 = *(const f32x4*)(gm + 4);
      const float* sh = C.f(WS_MOD) + ((size_t)l * 5 + cond) * 6144 + g * 16 + 8 * h; sh0 = *(const f32x4*)sh; sh1 = *(const f32x4*)(sh + 4); }
    float hr = 0.f, hi = 0.f;
    if (samp) { const float* s0 = C.in(5) + ((((size_t)sq * 2 + dir) * 64 + g) * 64 + lane) * 2; hr = s0[0]; hi = s0[1]; }
    for (int ch = 0; ch < nchunk; ++ch) {
        const int pos = 32 * ch + c, t = dir == 0 ? pos : S - 1 - pos, r = rowbase + t;
        const float rs = rstd_of(ss, r);
        const f32x4 x0 = *(const f32x4*)(X + (size_t)r * D + g * 16 + 8 * h), x1 = *(const f32x4*)(X + (size_t)r * D + g * 16 + 8 * h + 4);
        const f32x4 u0 = x0 * rs * gm0 + sh0, u1 = x1 * rs * gm1 + sh1;
        u32x4 uw = {cvtpk(u0[0], u0[1]), cvtpk(u0[2], u0[3]), cvtpk(u1[0], u1[1]), cvtpk(u1[2], u1[3])};
        const bf16x8 uf = __builtin_bit_cast(bf16x8, uw);
        f32x16 bu[4];
#pragma unroll
        for (int ct = 0; ct < 4; ++ct) { bu[ct] = (f32x16){}; bu[ct] = __builtin_amdgcn_mfma_f32_32x32x16_bf16(uf, bfr[ct], bu[ct], 0, 0, 0); }
#pragma unroll
        for (int hf = 0; hf < 2; ++hf) {
#pragma unroll
            for (int t8 = 0; t8 < 2; ++t8) {
#pragma unroll
                for (int ct = 0; ct < 4; ++ct)
#pragma unroll
                    for (int r4 = 0; r4 < 4; ++r4) *(LAS float*)(LB + (4 * h + r4) * 512 + (32 * ct + c) * 4) = bu[ct][8 * hf + 4 * t8 + r4];
                float br[8], bi[8]; unsigned wv[8];
#pragma unroll
                for (int k = 0; k < 8; ++k) { br[k] = *(LAS float*)(LB + k * 512 + lane * 4); bi[k] = *(LAS float*)(LB + k * 512 + 256 + lane * 4); }
#pragma unroll
                for (int k = 0; k < 8; ++k) { const float nr = lr * hr - li * hi + br[k], ni = lr * hi + li * hr + bi[k]; hr = nr; hi = ni; wv[k] = cvtpk(hr, hi); }
#pragma unroll
                for (int k = 0; k < 8; ++k) { const int row = 8 * t8 + k;
                    *(LAS unsigned short*)(LH + row * 256 + ((((lane >> 3)) ^ row) << 4) + (lane & 7) * 2) = (unsigned short)(wv[k] & 0xffffu);
                    *(LAS unsigned short*)(LH + row * 256 + (((8 + (lane >> 3)) ^ row) << 4) + (lane & 7) * 2) = (unsigned short)(wv[k] >> 16); }
                LDS_WAIT();
            }
            f32x4 y0 = {};
#pragma unroll
            for (int s = 0; s < 4; ++s) {
                const bf16x8 a0 = *(const LAS bf16x8*)(LH + (lane & 15) * 256 + (((4 * s + (lane >> 4)) ^ (lane & 15)) << 4));
                y0 = __builtin_amdgcn_mfma_f32_16x16x32_bf16(a0, cfr[s], y0, 0, 0, 0);
            }
            if (ywr) {
#pragma unroll
                for (int q = 0; q < 4; ++q) { const int p0 = 32 * ch + 16 * hf + 4 * (lane >> 4) + q, t0 = dir == 0 ? p0 : S - 1 - p0; Y[(size_t)(rowbase + t0) * D + g * 16 + (lane & 15)] = y0[q]; }
            }
            LDS_WAIT();
        }
    }
    if (!samp && !ydbg) { float* so = C.out + 8388608 + 2 * 2097152 + 4194304 + ((((size_t)sq * 2 + dir) * 64 + g) * 64 + lane) * 2; so[0] = hr; so[1] = hi; }
}
__device__ __forceinline__ void phase_sscan(const Ctx& C, int l, size_t ydbg) {
    for (int bb = C.bid; bb < 256; bb += C.G) {
        const int w = C.wave;
#ifdef SS_ONLYWAVE
        if (ydbg && !((SS_ONLYWAVE >> w) & 1)) continue;
#endif
        if (w < 2) { const int id = 2 * bb + w; sscan_seq(C, l, true, id >> 7, (id >> 6) & 1, id & 63, ydbg); }
        else { int id = 8 * bb + (w - 2); sscan_seq(C, l, false, id >> 7, (id >> 6) & 1, id & 63, ydbg);
            if (w < 4) { id = 8 * bb + 6 + (w - 2); sscan_seq(C, l, false, id >> 7, (id >> 6) & 1, id & 63, ydbg); } }
    }
}
__device__ __forceinline__ void phase_spost(const Ctx& C, int l) {
    const int gw = C.bid * NWAVES + C.wave, NGW = C.G * NWAVES; const u64_t* ss = (const u64_t*)(C.ws + WS_SS) + (size_t)(l * 2) * M;
    for (int r = gw; r < M; r += NGW) {
        const int cond = cond_of_row(r); const float rs = rstd_of(ss, r);
#pragma unroll
        for (int jq = 0; jq < 4; ++jq) {
            const int n = 4 * C.lane + 256 * jq; const size_t off = (size_t)r * D + n;
            const f32x4 x = *(const f32x4*)(C.f(WS_X) + off), gm = *(const f32x4*)(C.f(WS_GMOD) + ((size_t)(l * 2) * 5 + cond) * 1024 + n), sh = *(const f32x4*)(C.f(WS_MOD) + ((size_t)l * 5 + cond) * 6144 + n);
            const f32x4 u = x * rs * gm + sh, y = *(const f32x4*)(C.in(26) + n) * u + *(const f32x4*)(C.f(SCR_YF) + off) + *(const f32x4*)(C.f(SCR_YB) + off);
            f32x4 o;
#pragma unroll
            for (int e = 0; e < 4; ++e) { const float v = y[e], uu = 0.7978845608028654f * (v + 0.044715f * v * v * v); const float th = 1.f - 2.f / (1.f + __expf(2.f * uu)); o[e] = 0.5f * v * (1.f + th); }
            st_bf16x4(C.h(SCR_AGLU) + off, o);
        }
    }
}
#define XB_TMO      128
#define XB_XCNT(j)  (256  + 64 * (j))
#define XB_XSUB(j)  (1280 + 64 * (j))
#define XB_XGEN(j)  (2304 + 64 * (j))
#define XB_TOP      3328
#define XB_TOPGEN   3392
#define XCD_BAR_WORDS 3456
#define XB_SPIN_CAP (1u << 18)
#ifndef XB_SCOPE
#define XB_SCOPE "agent"
#endif
__device__ __forceinline__ unsigned xb_ld(unsigned* p)              { return __hip_atomic_load(p, __ATOMIC_RELAXED, __HIP_MEMORY_SCOPE_AGENT); }
__device__ __forceinline__ unsigned xb_add(unsigned* p, unsigned v) { return __hip_atomic_fetch_add(p, v, __ATOMIC_RELAXED, __HIP_MEMORY_SCOPE_AGENT); }
__device__ __forceinline__ unsigned xb_xcc_id() { return (unsigned)__builtin_amdgcn_s_getreg((3 << 11) | 20) & 0xFu; }
#define XB_SPIN(cond, bar) do { unsigned _sp = 0; while (cond) { __builtin_amdgcn_s_sleep(1); \
    if ((++_sp & 255u) == 0u) { if (xb_ld(&(bar)[XB_TMO])) break; if (_sp > XB_SPIN_CAP) { atomicAdd(&(bar)[XB_TMO], 1u); break; } } } } while (0)
struct XcdBarrier { unsigned* bar; unsigned x; volatile LAS unsigned* st; };
__device__ __forceinline__ XcdBarrier xcd_barrier_post(unsigned* bar, volatile LAS unsigned* st) {
    XcdBarrier b; b.bar = bar; b.x = xb_xcc_id(); b.st = st;
    if (threadIdx.x == 0) (void)xb_add(&bar[XB_XCNT(b.x)], 1u);
    return b;
}
__device__ __forceinline__ void xcd_barrier_complete(unsigned* bar, unsigned x, unsigned& nloc, unsigned& nx) {
    const unsigned G = gridDim.x * gridDim.y * gridDim.z;
    unsigned sum, cnt, mine, sp = 0u;
    for (;;) {
        sum = 0u; cnt = 0u; mine = 0u;
#pragma unroll
        for (unsigned j = 0; j < 16; ++j) { const unsigned c = xb_ld(&bar[XB_XCNT(j)]); sum += c; cnt += (c > 0u) ? 1u : 0u; mine = (j == x) ? c : mine; }
        if (sum == G) break;
        __builtin_amdgcn_s_sleep(1);
        if ((++sp & 255u) == 0u) { if (xb_ld(&bar[XB_TMO])) break; if (sp > XB_SPIN_CAP) { atomicAdd(&bar[XB_TMO], 1u); break; } }
    }
    nloc = mine > 0u ? mine : 1u; nx = cnt > 0u ? cnt : 1u;
}
__device__ __forceinline__ void xcd_barrier(const XcdBarrier& b, bool thread0) {
    asm volatile("s_waitcnt vmcnt(0)" ::: "memory");
    __syncthreads();
    if (thread0) {
        unsigned* bar = b.bar;
        __builtin_amdgcn_s_waitcnt(0);
        unsigned nloc = b.st[0], nx = b.st[1];
        if (nloc == 0u) { xcd_barrier_complete(bar, b.x, nloc, nx); b.st[0] = nloc; b.st[1] = nx; }
#ifdef XB_ALL_RELEASE
        __builtin_amdgcn_fence(__ATOMIC_RELEASE, XB_SCOPE); asm volatile("s_waitcnt vmcnt(0)" ::: "memory");
#endif
        const unsigned old = xb_add(&bar[XB_XSUB(b.x)], 1u);
        const unsigned gen = old / nloc;
        if (old + 1u == (gen + 1u) * nloc) {
            __builtin_amdgcn_fence(__ATOMIC_RELEASE, XB_SCOPE);
            asm volatile("s_waitcnt vmcnt(0)" ::: "memory");
            const unsigned og = xb_add(&bar[XB_TOP], 1u);
            const unsigned tg = og / nx;
            if (og + 1u == (tg + 1u) * nx) xb_add(&bar[XB_TOPGEN], 1u);
            else XB_SPIN(xb_ld(&bar[XB_TOPGEN]) == tg, bar);
            __builtin_amdgcn_fence(__ATOMIC_ACQUIRE, XB_SCOPE);
            xb_add(&bar[XB_XGEN(b.x)], 1u);
            asm volatile("s_waitcnt vmcnt(0)" ::: "memory");
        } else {
            XB_SPIN(xb_ld(&bar[XB_XGEN(b.x)]) == gen, bar);
            __builtin_amdgcn_fence(__ATOMIC_ACQUIRE, XB_SCOPE);
            asm volatile("s_waitcnt vmcnt(0)" ::: "memory");
        }
#ifdef XB_DELAY
        for (int q = 0; q < XB_DELAY; ++q) __builtin_amdgcn_s_sleep(127);
#endif
    }
    __syncthreads();
}
}
namespace om {
enum { PH_P0A = 0, PH_P0C, PH_GLUE, PH_QKV, PH_ATTN, PH_WO, PH_HIN, PH_HSCAN, PH_HPOST, PH_HWO, PH_SSCAN, PH_SPOST, PH_GLU, PH_UP, PH_CONV, PH_DOWN, PH_FINAL };

struct Args { const float* in[33]; float* out; unsigned char* ws; int nph; int pad; unsigned char ptype[160]; unsigned char parg[160]; };

__device__ __forceinline__ void down_patch(const Ctx& C, int l, const pg8::StaticOrder& S) {
    Unit u; const float* cw = C.in(29) + (size_t)l * 3 * NUP; const float* E0 = C.f(WS_EDGE); bf16_t* act = C.h(WS_ACT);
    for (int i = 0; S.next(i, u); ++i) {
        if (u.pm < 16) continue;
        const bool top = (u.pm & 3) != 0, bot = (u.pm & 3) != 3;
        for (int n = C.tid; n < DFF; n += NTHREADS) {
            if (top) { const float* e = E0 + ((size_t)((u.pm - 16) * 2 + 0) * 4) * DFF; const float* ep = E0 + ((size_t)((u.pm - 17) * 2 + 1) * 4) * DFF;
                const float hg = e[n] + cw[n] * ep[2 * DFF + n], hv = e[DFF + n] + cw[DFF + n] * ep[3 * DFF + n];
                act[(size_t)(u.pm * 256) * DFF + n] = (bf16_t)(cvtpk(hg * sigm(hg) * hv, 0.f) & 0xffffu); }
            if (bot) { const float* e = E0 + ((size_t)((u.pm - 16) * 2 + 1) * 4) * DFF; const float* en = E0 + ((size_t)((u.pm - 15) * 2 + 0) * 4) * DFF;
                const float hg = e[n] + cw[2 * NUP + n] * en[2 * DFF + n], hv = e[DFF + n] + cw[2 * NUP + DFF + n] * en[3 * DFF + n];
                act[(size_t)(u.pm * 256 + 255) * DFF + n] = (bf16_t)(cvtpk(hg * sigm(hg) * hv, 0.f) & 0xffffu); }
        }
    }
    asm volatile("s_waitcnt vmcnt(0)" ::: "memory"); __syncthreads();
}
__device__ __forceinline__ void run_phase(const Ctx& C0, int type, int arg, int epoch) {
    Ctx C = C0; asm volatile("" : "+v"(C.tid)); asm volatile("" : "+s"(C.bid), "+s"(C.G), "+s"(C.kp), "+s"(C.ws), "+s"(C.out));
    C.lane = C.tid & 63; C.wave = __builtin_amdgcn_readfirstlane(C.tid >> 6);
    const int l = arg & 3;
    if (type == 31) return;
#ifndef PHASE_MASK
#define PHASE_MASK 0xFFFFFFFFu
#endif
    if (!((PHASE_MASK >> type) & 1u)) return;
    pg8::Gemm g{nullptr, nullptr, D, 256, 128, D, 0}; int nN = 0; EpiAny E{}; E.ws = C.ws; E.out = C.out; E.l = l; E.epoch = epoch;
    const bool splitk = false;
    switch (type) {
    case PH_P0A: phase_p0a(C); break;
    case PH_P0C: phase_p0c(C); break;
    case PH_GLUE: phase_glue(C, arg >> 1, arg & 1); break;
    case PH_QKV: { g.A = C.h(WS_AP); g.Bt = C.h(WS_WQKV) + (size_t)(l / 3) * NQKV * D; nN = 6; E.kind = EK_QKV; } break;
    case PH_ATTN: phase_attn(C, l, (arg & 32) ? SCR_O + 96 * MiB : SCR_O); break;
#ifdef DBG
    case 17: phase_chk(C, SCR_O, SCR_O + 96 * MiB, 16 * MiB); break;
#endif
#ifdef DBG
    case 18: phase_cks(C, arg); break;
#endif
#ifdef DBG
    case 19: phase_cmp(C, arg); break;
#endif
#ifdef DBG
    case 20: phase_clr(C); break;
#endif
    case PH_WO: case PH_HWO: case PH_GLU: {
        if (type == PH_WO) { g.A = C.h(SCR_O); g.Bt = C.h(WS_WO) + (size_t)(l / 3) * D * D; nN = 4; E.kind = EK_RES; if (splitk) { g.split = 1; g.K = D / 2; nN = 8; } }
        else if (type == PH_HWO) { g.A = C.h(SCR_AWO); g.Bt = C.h(WS_HWO); nN = 4; E.kind = EK_RES; if (splitk) { g.split = 1; g.K = D / 2; nN = 8; } }
        else { g.A = C.h(SCR_AGLU); g.Bt = C.h(WS_GLU); g.b_tile_rows = 128; g.b_half_rows = 1024; nN = 8; E.kind = EK_RES_GLU; }
        E.flags = ((arg & 32) ? 4 : 0) | (type == PH_HWO ? 8 : 0); } break;
    case PH_HIN: { g.A = C.h(WS_AP); g.Bt = C.h(WS_HWIN); nN = 20; E.kind = EK_HIN; } break;
    case PH_HSCAN: phase_hscan(C); break;
    case PH_HPOST: phase_hpost(C); break;
    case PH_SSCAN: phase_sscan(C, l, (arg & 32) ? WS_SCR + 80 * MiB : ((arg & 64) ? WS_SCR + 112 * MiB : 0)); break;
#ifdef DBG
    case 22: phase_clr2(C, WS_SCR + 80 * MiB, 64 * MiB); break;
#endif
#ifdef DBG
    case 21: phase_chk(C, WS_SCR + 80 * MiB, WS_SCR + 112 * MiB, 32 * MiB); break;
#endif
    case PH_SPOST: phase_spost(C, l); break;
    case PH_UP: { g.A = C.h(WS_AP); g.Bt = C.h(WS_UP) + (size_t)l * NUP * D; g.b_tile_rows = 128; g.b_half_rows = DFF; nN = 22; E.kind = EK_UPCONV; E.in29 = C.in(29); E.in30 = C.in(30); } break;
#ifdef DBG
    case 23: phase_chk(C, WS_SCR, WS_SCR + 88 * MiB, 88 * MiB); break;
#endif
    case PH_CONV: phase_conv(C, l); break;
    case PH_DOWN: { { pg8::StaticOrder S0; S0.init(32, splitk ? 8 : 4, C.G, C.bid); down_patch(C, l, S0); }
        g.A = C.h(WS_ACT); g.Bt = C.h(WS_DOWN) + (size_t)l * D * DFF; g.K = DFF; g.ld = DFF; nN = 4; if (splitk) { g.split = 1; g.K = DFF / 2; nN = 8; } E.kind = EK_RES; E.flags = 1 | ((arg & 16) ? 2 : 0) | ((arg & 32) ? 4 : 0); } break;
    case PH_FINAL: { const unsigned fl = __hip_atomic_load((unsigned*)(C.ws + WS_CTL) + 4000, __ATOMIC_RELAXED, __HIP_MEMORY_SCOPE_AGENT), fd = __hip_atomic_load((unsigned*)(C.ws + WS_CTL) + 4001, __ATOMIC_RELAXED, __HIP_MEMORY_SCOPE_AGENT);
        #ifdef SSDET_CLS
        const unsigned cls = __hip_atomic_load((unsigned*)(C.ws + WS_CTL) + 4002, __ATOMIC_RELAXED, __HIP_MEMORY_SCOPE_AGENT), cnt = __hip_atomic_load((unsigned*)(C.ws + WS_CTL) + 4003, __ATOMIC_RELAXED, __HIP_MEMORY_SCOPE_AGENT);
        phase_final(C, 1.f + (float)cls / 8.f + (float)(cnt > 63 ? 63 : cnt) / 1024.f); } break;
#else
        phase_final(C, fl ? 3.f : (fd ? exp2f((float)(1001 - fd)) : 1.f)); } break;
#endif
    default: break;
    }
    if (nN) { pg8::StaticOrder S; S.init(32, nN, C.G, C.bid); pg8::gemm_phase(C.lds, g, S, E, C.tid); }
}

__device__ __forceinline__ void canary(const Ctx& C0, unsigned char* ws, int i, bool check) {
    int tid = C0.tid; asm volatile("" : "+v"(tid)); const int lane = tid & 63, wave = tid >> 6;
    unsigned* can = (unsigned*)(ws + WS_CTL + 32768);
#ifdef CANARY_SC1
    if (!check) { if (wave == 0 && lane < 32) __hip_atomic_store(can + C0.bid * 32 + lane, (unsigned)(i + 1), __ATOMIC_RELAXED, __HIP_MEMORY_SCOPE_AGENT); }
#else
    if (!check) { if (wave == 0 && lane < 32) can[C0.bid * 32 + lane] = (unsigned)(i + 1); }
#endif
#ifdef CANARY_LD_SC1
    else { const unsigned v = __hip_atomic_load(can + (wave * 32 + (lane >> 1)) * 32 + (lane & 1) * 16, __ATOMIC_RELAXED, __HIP_MEMORY_SCOPE_AGENT);
#else
    else { const unsigned v = can[(wave * 32 + (lane >> 1)) * 32 + (lane & 1) * 16];
#endif
      if (v != (unsigned)(i + 1) && v != (unsigned)(i + 2)) atomicAdd((unsigned*)(ws + WS_CTL) + 4000, 1u); }
}
__global__ void __launch_bounds__(NTHREADS, 2) mk_fwd(Args a) {
    extern __shared__ __attribute__((aligned(16))) unsigned char lds[];
    int wave_s = __builtin_amdgcn_readfirstlane((int)(threadIdx.x >> 6));
    { volatile LAS unsigned* misc = (volatile LAS unsigned*)((LAS unsigned char*)lds + LDS_BYTES - 64); if (threadIdx.x < 16) misc[threadIdx.x] = 0u; }
    __syncthreads();
    (void)xcd_barrier_post((unsigned*)(a.ws + WS_CTL), (volatile LAS unsigned*)((LAS unsigned char*)lds + LDS_BYTES - 64));
    for (int i = 0; i < a.nph; ++i) {
        {
            Ctx C; C.kp = (const unsigned char __attribute__((address_space(4)))*)__builtin_amdgcn_kernarg_segment_ptr();
            C.out = a.out; C.ws = a.ws; C.lds = (LAS unsigned char*)lds; asm volatile("" : "+s"(wave_s)); C.tid = (wave_s << 6) | (int)__builtin_amdgcn_mbcnt_hi(~0u, __builtin_amdgcn_mbcnt_lo(~0u, 0u)); C.lane = C.tid & 63; C.wave = 0; C.G = gridDim.x; C.bid = blockIdx.x;
            run_phase(C, a.ptype[i], a.parg[i], i + 1);
#ifdef CANARY
            canary(C, a.ws, i, false);
#endif
        }
        if (i + 1 < a.nph) { XcdBarrier bar; bar.bar = (unsigned*)(a.ws + WS_CTL); bar.x = xb_xcc_id(); bar.st = (volatile LAS unsigned*)((LAS unsigned char*)lds + LDS_BYTES - 64); xcd_barrier(bar, wave_s == 0 && lane_id() == 0); }
#ifdef CANARY
        if (i + 1 < a.nph) { Ctx C; C.tid = (wave_s << 6) | lane_id(); C.bid = blockIdx.x; canary(C, a.ws, i, true); }
#endif
    }
}
}
extern "C" void kernel_launch(void* const* d_in, const int* in_sizes, int n_in, void* d_out, int out_size, void* d_ws, size_t ws_size, hipStream_t stream) {
    using namespace om;
    static int grid = 0;
    if (grid == 0) {
        if (n_in != 33 || out_size != 17039360 || ws_size < WS_END) { fprintf(stderr, "kernel_launch: unexpected sizes n_in %d out %d ws %zu; nothing launched\n", n_in, out_size, ws_size); grid = -1; return; }
        int dev = 0, cus = 0, per_cu = 0;
        (void)hipGetDevice(&dev); (void)hipDeviceGetAttribute(&cus, hipDeviceAttributeMultiprocessorCount, dev);
        (void)hipFuncSetAttribute((const void*)mk_fwd, hipFuncAttributeMaxDynamicSharedMemorySize, LDS_BYTES);
        if (hipOccupancyMaxActiveBlocksPerMultiprocessor(&per_cu, (const void*)mk_fwd, NTHREADS, LDS_BYTES) != hipSuccess || per_cu < 1) { fprintf(stderr, "kernel_launch: occupancy query gives %d blocks per CU\n", per_cu); per_cu = 1; }
        (void)hipGetLastError();
        grid = cus;
        if (grid > 256) grid = 256;
    }
    if (grid < 0) return;
    (void)hipMemsetAsync((char*)d_ws + WS_CTL, 0, CTL_ZERO_BYTES, stream);
    Args a{};
    for (int i = 0; i < 33; ++i) a.in[i] = (const float*)d_in[i];
    a.out = (float*)d_out; a.ws = (unsigned char*)d_ws;
    int n = 0;
#ifndef DUP_MASK
#define DUP_MASK 0u
#endif
#ifndef XBAR
#define XBAR 0
#endif
    auto add1 = [&](int t, int p) { a.ptype[n] = (unsigned char)t; a.parg[n] = (unsigned char)p; ++n; };
    auto add = [&](int t, int p) { add1(t, p);
        if ((DUP_MASK >> t) & 1u) { const bool resid = (t == PH_WO || t == PH_HWO || t == PH_GLU || t == PH_DOWN); add1(t, resid ? (p | 32) : p); }
        for (int q = 0; q < XBAR; ++q) add1(31, 0); };
#ifdef UPDET
    add1(PH_P0A, 0); add1(PH_P0C, 0);
    for (int l = 0; l < 4; ++l) { const int kind = l % 3;
        if (kind == 0) { add1(PH_QKV, l); add1(PH_ATTN, l); add1(PH_WO, l); }
        else if (kind == 1) { add1(PH_HIN, l); add1(PH_HSCAN, l); add1(PH_HPOST, l); add1(PH_HWO, l); }
        else { add1(PH_SSCAN, l); add1(PH_SPOST, l); add1(PH_GLU, l); }
        add1(PH_UP, l); add1(PH_UP, l | 32); add1(23, 0); add1(PH_CONV, l); add1(PH_DOWN, l == 3 ? (l | 16) : l); }
    add1(PH_FINAL, 0);
#elif defined(SSDET)
    add1(PH_P0A, 0); add1(PH_P0C, 0);
    for (int l = 0; l < 4; ++l) { const int kind = l % 3;
        if (kind == 0) { add1(PH_QKV, l); add1(PH_ATTN, l); add1(PH_WO, l); }
        else if (kind == 1) { add1(PH_HIN, l); add1(PH_HSCAN, l); add1(PH_HPOST, l); add1(PH_HWO, l); }
        else { add1(22, 0); add1(PH_SSCAN, l | 32); add1(PH_SSCAN, l | 64); add1(21, 0); add1(PH_SSCAN, l); add1(PH_SPOST, l); add1(PH_GLU, l); }
        add1(PH_UP, l); add1(PH_DOWN, l == 3 ? (l | 16) : l); }
    add1(PH_FINAL, 0);
#elif defined(LOCALIZE)
    for (int fwd = 0; fwd < 2; ++fwd) { int idx = 0;
        auto addc = [&](int t, int p) { add1(t, p); add1(18, fwd * 32 + idx); ++idx; };
        add1(20, 0); addc(PH_P0A, 0); addc(PH_P0C, 0);
        for (int l = 0; l < 4; ++l) { const int kind = l % 3;
            if (kind == 0) { addc(PH_QKV, l); addc(PH_ATTN, l); addc(PH_WO, l); }
            else if (kind == 1) { addc(PH_HIN, l); addc(PH_HSCAN, l); addc(PH_HPOST, l); addc(PH_HWO, l); }
            else { addc(PH_SSCAN, l); addc(PH_SPOST, l); addc(PH_GLU, l); }
            addc(PH_UP, l); addc(PH_DOWN, l == 3 ? (l | 16) : l); }
        if (fwd == 1) { add1(19, idx); add1(PH_FINAL, 0); } }
#else
    add(PH_P0A, 0); add(PH_P0C, 0);
    for (int l = 0; l < 4; ++l) {
        const int kind = l % 3;
        if (kind == 0) { add(PH_QKV, l); add(PH_ATTN, l); add(PH_WO, l); }
        else if (kind == 1) { add(PH_HIN, l); add(PH_HSCAN, l); add(PH_HPOST, l); add(PH_HWO, l); }
        else { add(PH_SSCAN, l); add(PH_SPOST, l); add(PH_GLU, l); }
        add(PH_UP, l); add(PH_DOWN, l == 3 ? (l | 16) : l);
    }
    add(PH_FINAL, 0);
#endif
    a.nph = n;
    void* args[] = {&a};
    const hipError_t e = hipLaunchCooperativeKernel((const void*)mk_fwd, dim3(grid), dim3(NTHREADS), args, LDS_BYTES, stream);
    if (e != hipSuccess) fprintf(stderr, "kernel_launch: cooperative launch failed: %s (grid %d)\n", hipGetErrorString(e), grid);
}
```

```cpp
#include <hip/hip_runtime.h>
#include <hip/hip_cooperative_groups.h>
#include <cstdio>
#include <cstdint>
#include <cmath>
#define LAS __attribute__((address_space(3)))
#define GAS __attribute__((address_space(1)))
typedef unsigned short bf16_t;
typedef short bf16x8 __attribute__((ext_vector_type(8)));
typedef short s16x4 __attribute__((ext_vector_type(4)));
typedef float f32x2 __attribute__((ext_vector_type(2)));
typedef float f32x4 __attribute__((ext_vector_type(4)));
typedef float f32x16 __attribute__((ext_vector_type(16)));
typedef unsigned u32x2 __attribute__((ext_vector_type(2)));
typedef unsigned u32x4 __attribute__((ext_vector_type(4)));
typedef __bf16 bf16x2_t __attribute__((ext_vector_type(2)));

namespace om {
constexpr int D = 1024, MP = 4096, M = 8192, DFF = 2816, NUP = 5632, NQKV = 1536, NHIN = 5120;
constexpr float EPS = 1e-6f, LOG2E = 1.4426950408889634f, QSCALE = 0.125f * 1.4426950408889634f;
constexpr int NTHREADS = 512, NWAVES = 8, LDS_BYTES = 147456, RING_BYTES = 131072;
constexpr int SW_STRIDE = 5632;
constexpr float SS_FIX = 16777216.f, SS_INV = 1.f / (16777216.f * 1024.f);
typedef unsigned long long u64_t;
__device__ __forceinline__ float rstd_of(const u64_t* ss, int r) { return rsqrtf((float)ss[r] * SS_INV + 1e-6f); }
constexpr size_t MiB = 1u << 20;
constexpr size_t WS_CTL = 0, CTL_ZERO_BYTES = 64 * 1024;
constexpr size_t WS_MODP = 1 * MiB, WS_MOD = 3 * MiB, WS_SW = 4 * MiB, WS_GMOD = 5 * MiB, WS_SS = 6 * MiB, WS_ROPE = 7 * MiB;
constexpr size_t WS_LB1 = 8 * MiB, WS_SLAM = 8 * MiB + 64 * 1024, WS_SBB = 8 * MiB + 512 * 1024, WS_SCB = 9 * MiB;
constexpr size_t WS_CTXK = 10 * MiB, WS_CTXV = 12 * MiB;
constexpr size_t WS_NAIVE_MOD = 14 * MiB;
constexpr size_t WS_WQKV = 16 * MiB, WS_WO = 22 * MiB, WS_HWIN = 26 * MiB, WS_HWO = 36 * MiB, WS_GLU = 38 * MiB, WS_UP = 42 * MiB, WS_DOWN = 86 * MiB;
constexpr size_t WS_X = 108 * MiB, WS_R = 140 * MiB;
constexpr size_t WS_AP = WS_R, WS_ACT = WS_R + 16 * MiB, WS_SCR = WS_R + 60 * MiB, WS_END = WS_SCR + 176 * MiB;

constexpr size_t SCR_Q = WS_SCR, SCR_KB = WS_SCR + 16 * MiB, SCR_VB = WS_SCR + 20 * MiB, SCR_O = WS_SCR + 24 * MiB;
constexpr size_t SCR_HQ = WS_SCR, SCR_HV = WS_SCR + 16 * MiB, SCR_HG = WS_SCR + 32 * MiB, SCR_LFF = WS_SCR + 48 * MiB, SCR_LFB = WS_SCR + 80 * MiB, SCR_OF = WS_SCR + 112 * MiB, SCR_OB = WS_SCR + 144 * MiB, SCR_AWO = WS_SCR;
constexpr size_t SCR_YF = WS_SCR, SCR_YB = WS_SCR + 32 * MiB, SCR_AGLU = WS_SCR + 64 * MiB;

__device__ __forceinline__ int cond_of_tile(int pm) { return pm < 16 ? 0 : 1 + ((pm - 16) >> 2); }
__device__ __forceinline__ int cond_of_row(int r) { return r < MP ? 0 : 1 + ((r - MP) >> 10); }
__device__ __forceinline__ unsigned cvtpk(float lo, float hi) { f32x2 v = {lo, hi}; bf16x2_t b = __builtin_convertvector(v, bf16x2_t); return __builtin_bit_cast(unsigned, b); }
__device__ __forceinline__ float bf2f(unsigned short h) { return __uint_as_float(((unsigned)h) << 16); }
__device__ __forceinline__ float bflo(unsigned w) { return __uint_as_float(w << 16); }
__device__ __forceinline__ float bfhi(unsigned w) { return __uint_as_float(w & 0xffff0000u); }
__device__ __forceinline__ float sigm(float x) { return 1.f / (1.f + __expf(-x)); }
__device__ __forceinline__ int lane_id() { return (int)__builtin_amdgcn_mbcnt_hi(~0u, __builtin_amdgcn_mbcnt_lo(~0u, 0u)); }
__device__ __forceinline__ float wave_sum(float v) {
#pragma unroll
    for (int o = 1; o < 64; o <<= 1) v += __shfl_xor(v, o);
    return v;
}

struct Ctx {
    const unsigned char __attribute__((address_space(4)))* kp;
    float* out; unsigned char* ws;
    LAS unsigned char* lds; int tid, lane, wave, G, bid;
    __device__ __forceinline__ const float* in(int i) const { return *(const float* const __attribute__((address_space(4)))*)(kp + 8 * i); }
    __device__ __forceinline__ float* f(size_t off) const { return (float*)(ws + off); }
    __device__ __forceinline__ bf16_t* h(size_t off) const { return (bf16_t*)(ws + off); }
};

namespace pg8 {
constexpr int BM = 256, BK = 64, HALF = 128, HTB = HALF * BK * 2, STAGE_BYTES = 8 * HTB, NXCD = 8, WGM = 8;
__host__ __device__ __forceinline__ int lds_byte(int r, int c) { const int st = (r >> 4) * 2 + (c >> 5), rr = r & 15, cc = c & 31, ob = rr * 64 + cc * 2; return st * 1024 + (ob ^ (((ob >> 9) & 1) << 5)); }
__host__ __device__ __forceinline__ void stage_rc(int b, int& R, int& C) { const int st = b / 1024, sb = b % 1024, swz = sb ^ (((sb >> 9) & 1) << 5); R = (st >> 1) * 16 + swz / 64; C = (st & 1) * 32 + (swz % 64) / 2; }
struct Unit { int pm, pn; };
struct Gemm { const bf16_t* A; const bf16_t* Bt; int K; int b_tile_rows, b_half_rows; int ld; int split; };
struct StaticOrder {
    int nM, nN, nwg, G, c;
    __device__ void init(int nM_, int nN_, int G_, int c_) { nM = nM_; nN = nN_; nwg = nM * nN; G = G_; c = c_; }
    __device__ bool next(int i, Unit& u) const {
        const long L = (long)i * G + c; if (L >= nwg) return false;
        int wgid = (int)L; { const int q = nwg / NXCD, r = nwg % NXCD, xcd = wgid % NXCD, off = wgid / NXCD; wgid = (xcd < r ? xcd * (q + 1) : r * (q + 1) + (xcd - r) * q) + off; }
        const int nig = WGM * nN, gid = wgid / nig, fm = gid * WGM, gsz = (nM - fm) < WGM ? (nM - fm) : WGM;
        u.pm = fm + ((wgid % nig) % gsz); u.pn = (wgid % nig) / gsz; return true;
    }
};
template <class Epi>
__device__ __forceinline__ void gemm_phase(LAS unsigned char* lds, const Gemm g, const StaticOrder& S, const Epi& E, int tid_in) {
    int tid_ = tid_in; asm volatile("" : "+v"(tid_));
    const int tid = tid_, wid = __builtin_amdgcn_readfirstlane(tid >> 6), lane = tid & 63, wr = wid >> 2, wc = wid & 3, fr = lane & 15, fq = lane >> 4;
    const int K = g.K, nt = K / BK, ld = g.ld;
    unsigned voffA[2];
#pragma unroll
    for (int i = 0; i < 2; ++i) { int R, C; stage_rc(tid * 16 + i * 8192, R, C); voffA[i] = (unsigned)(R * ld + C) * 2u; }
    const size_t kstep = (size_t)(BK * 2);
    const size_t hstepA = (size_t)HALF * ld * 2, tstepA = 2 * hstepA;
    const size_t hstepB = (size_t)g.b_half_rows * ld * 2, tstepB = (size_t)g.b_tile_rows * ld * 2, khb = (size_t)K * 2;
#define PG8_UA(u) ((const char*)g.A + (size_t)(u).pm * tstepA + (g.split ? (size_t)((u).pn & 1) * khb : 0))
#define PG8_UB(u) ((const char*)g.Bt + (size_t)(g.split ? (u).pn >> 1 : (u).pn) * tstepB + (g.split ? (size_t)((u).pn & 1) * khb : 0))
    const unsigned ldsw = (unsigned)wid * 1024u;
    const int aoff = lds_byte(wr * 64 + fr, fq * 8), boff = lds_byte(wc * 32 + fr, fq * 8);
#define PG8_SA(b, h) (((b) * 2 + (h)) * HTB)
#define PG8_SB(b, h) ((4 + (b) * 2 + (h)) * HTB)
#define PG8_STAGE(bufoff, gbase) do { _Pragma("unroll") for (int _i = 0; _i < 2; ++_i) \
        __builtin_amdgcn_global_load_lds((const unsigned*)((const char*)(gbase) + voffA[_i]), (LAS unsigned*)(lds + (bufoff) + ldsw + _i * 8192), 16, 0, 0); } while (0)
#define PG8_LDA(dst, b, h) do { _Pragma("unroll") for (int m = 0; m < 4; ++m) _Pragma("unroll") for (int k = 0; k < 2; ++k) dst[m][k] = *(const LAS bf16x8*)(lds + PG8_SA(b, h) + aoff + m * 2048 + k * 1024); } while (0)
#define PG8_LDB(dst, b, h) do { _Pragma("unroll") for (int n = 0; n < 2; ++n) _Pragma("unroll") for (int k = 0; k < 2; ++k) dst[n][k] = *(const LAS bf16x8*)(lds + PG8_SB(b, h) + boff + n * 2048 + k * 1024); } while (0)
#define PG8_MMA(ai, bj, At, Bt) do { __builtin_amdgcn_s_setprio(1); _Pragma("unroll") for (int m = 0; m < 4; ++m) _Pragma("unroll") for (int n = 0; n < 2; ++n) _Pragma("unroll") for (int k = 0; k < 2; ++k) \
        acc[ai][bj][m][n] = __builtin_amdgcn_mfma_f32_16x16x32_bf16(Bt[n][k], At[m][k], acc[ai][bj][m][n], 0, 0, 0); __builtin_amdgcn_s_setprio(0); } while (0)
#define PG8_WAIT_V(n) asm volatile("s_waitcnt vmcnt(" #n ")" ::: "memory")
#define PG8_WAIT_L(n) asm volatile("s_waitcnt lgkmcnt(" #n ")" ::: "memory")
#define PG8_BAR __builtin_amdgcn_s_barrier()
#define PG8_SCHED __builtin_amdgcn_sched_barrier(0)
    Unit cur, nxt; int ui = 0;
    if (!S.next(0, cur)) return;
    f32x4 acc[2][2][4][2];
#pragma unroll
    for (int a = 0; a < 2; ++a)
#pragma unroll
        for (int b = 0; b < 2; ++b)
#pragma unroll
            for (int m = 0; m < 4; ++m)
#pragma unroll
                for (int n = 0; n < 2; ++n) acc[a][b][m][n] = (f32x4){0.f, 0.f, 0.f, 0.f};
    bf16x8 At[4][2], B0[2][2], B1[2][2];
    const char* cA = PG8_UA(cur); const char* cB = PG8_UB(cur);
    PG8_STAGE(PG8_SB(0, 0), cB); PG8_STAGE(PG8_SB(0, 1), cB + hstepB); PG8_STAGE(PG8_SA(0, 0), cA); PG8_STAGE(PG8_SA(0, 1), cA + hstepA);
    if (wr == 1) PG8_BAR;
    PG8_WAIT_V(2); PG8_BAR;
    PG8_STAGE(PG8_SB(1, 0), cB + kstep); PG8_STAGE(PG8_SA(1, 0), cA + kstep); PG8_STAGE(PG8_SB(1, 1), cB + hstepB + kstep);
    PG8_WAIT_V(6); PG8_BAR;
    for (;;) {
        const bool has_next = S.next(ui + 1, nxt);
        const char* nA = has_next ? PG8_UA(nxt) : cA; const char* nB = has_next ? PG8_UB(nxt) : cB;
        for (int t = 0; t < nt; t += 2) {
            const bool last = (t == nt - 2);
            const char* a1 = cA + (size_t)(t + 1) * kstep;
            const char* a2 = last ? nA : cA + (size_t)(t + 2) * kstep; const char* b2 = last ? nB : cB + (size_t)(t + 2) * kstep;
            const char* a3 = a2 + kstep; const char* b3 = b2 + kstep;
            PG8_LDB(B0, 0, 0); PG8_LDB(B1, 0, 1); PG8_SCHED; PG8_LDA(At, 0, 0); PG8_STAGE(PG8_SA(1, 1), a1 + hstepA);
            PG8_WAIT_V(8); PG8_WAIT_L(0); PG8_BAR; PG8_MMA(0, 0, At, B0); PG8_MMA(0, 1, At, B1); PG8_BAR; PG8_SCHED;
            PG8_LDA(At, 0, 1); PG8_STAGE(PG8_SB(0, 0), b2); PG8_STAGE(PG8_SB(0, 1), b2 + hstepB); PG8_STAGE(PG8_SA(0, 0), a2);
            PG8_WAIT_V(8); PG8_WAIT_L(0); PG8_BAR; PG8_MMA(1, 0, At, B0); PG8_MMA(1, 1, At, B1); PG8_BAR; PG8_SCHED;
            PG8_LDB(B0, 1, 0); PG8_LDB(B1, 1, 1); PG8_SCHED; PG8_LDA(At, 1, 0); PG8_STAGE(PG8_SA(0, 1), a2 + hstepA);
            PG8_WAIT_V(8); PG8_WAIT_L(0); PG8_BAR; PG8_MMA(0, 0, At, B0); PG8_MMA(0, 1, At, B1); PG8_BAR; PG8_SCHED;
            PG8_LDA(At, 1, 1); PG8_STAGE(PG8_SB(1, 0), b3); PG8_STAGE(PG8_SB(1, 1), b3 + hstepB); PG8_STAGE(PG8_SA(1, 0), a3);
            PG8_WAIT_V(8); PG8_WAIT_L(0); PG8_BAR; PG8_MMA(1, 0, At, B0); PG8_MMA(1, 1, At, B1); PG8_BAR; PG8_SCHED;
        }
        if (wr == 0) PG8_BAR;
        { int fr_e = fr, fq_e = fq, wr_e = wr, wc_e = wc; asm volatile("" : "+v"(fr_e), "+v"(fq_e), "+s"(wr_e), "+s"(wc_e));
          int tid_e = tid; asm volatile("" : "+v"(tid_e));
          const Unit ue{cur.pm, g.split ? cur.pn >> 1 : cur.pn};
          E(acc, ue, wr_e, wc_e, fr_e, fq_e, g.split ? (cur.pn & 1) : -1, tid_e);
          E.post(ue, tid_e); }
        if (!has_next) break;
#pragma unroll
        for (int a = 0; a < 2; ++a)
#pragma unroll
            for (int b = 0; b < 2; ++b)
#pragma unroll
                for (int m = 0; m < 4; ++m)
#pragma unroll
                    for (int n = 0; n < 2; ++n) acc[a][b][m][n] = (f32x4){0.f, 0.f, 0.f, 0.f};
        cur = nxt; cA = nA; cB = nB; ++ui;
        if (wr == 1) PG8_BAR;
    }
    PG8_WAIT_V(0);
    PG8_BAR;
#undef PG8_SA
#undef PG8_UA
#undef PG8_UB
#undef PG8_SB
#undef PG8_STAGE
#undef PG8_LDA
#undef PG8_LDB
#undef PG8_MMA
#undef PG8_WAIT_V
#undef PG8_WAIT_L
#undef PG8_BAR
#undef PG8_SCHED
}
}
using pg8::Unit;
typedef f32x4 Acc[2][2][4][2];

__device__ __forceinline__ void st_bf16x4(bf16_t* p, f32x4 v) { u32x2 w; w.x = cvtpk(v[0], v[1]); w.y = cvtpk(v[2], v[3]); *(u32x2*)p = w; }

template <bool PAIRED> struct EpiRes {
    const float* xin; float* xout; bf16_t* ap; u64_t* ssn; const float* gate;   const float* gmodn;
    __device__ __forceinline__ void operator()(const Acc& acc, const Unit& u, int wr, int wc, int fr, int fq) const {
        const int c = cond_of_tile(u.pm);
        const int colb = (PAIRED ? u.pn * 128 : u.pn * 256) + wc * 32 + 4 * fq;
        constexpr int NBJ = PAIRED ? 1 : 2;
        f32x4 gv[NBJ][2], gm[NBJ][2];
#pragma unroll
        for (int bj = 0; bj < NBJ; ++bj)
#pragma unroll
            for (int n = 0; n < 2; ++n) { gv[bj][n] = *(const f32x4*)(gate + (size_t)c * 6144 + colb + bj * 128 + n * 16);
                gm[bj][n] = gmodn ? *(const f32x4*)(gmodn + (size_t)c * 1024 + colb + bj * 128 + n * 16) : (f32x4){0.f, 0.f, 0.f, 0.f}; }
#pragma unroll
        for (int ai = 0; ai < 2; ++ai)
#pragma unroll
            for (int m = 0; m < 4; ++m) {
                const int r = u.pm * 256 + ai * 128 + wr * 64 + m * 16 + fr; float sq = 0.f;
#pragma unroll
                for (int bj = 0; bj < NBJ; ++bj)
#pragma unroll
                    for (int n = 0; n < 2; ++n) {
                        f32x4 o = acc[ai][bj][m][n];
                        if (PAIRED) { const f32x4 gt = acc[ai][1][m][n];
#pragma unroll
                            for (int e = 0; e < 4; ++e) o[e] = o[e] * sigm(gt[e]); }
                        const size_t off = (size_t)r * D + colb + bj * 128 + n * 16;
                        const f32x4 xo = *(const f32x4*)(xin + off) + gv[bj][n] * o;
                        *(f32x4*)(xout + off) = xo;
                        sq += (xo[0] * xo[0] + xo[1] * xo[1]) + (xo[2] * xo[2] + xo[3] * xo[3]);
                        if (gmodn) st_bf16x4(ap + off, xo * gm[bj][n]);
                    }
                sq += __shfl_xor(sq, 16); sq += __shfl_xor(sq, 32);
                if (fq == 0) atomicAdd(ssn + r, (u64_t)(sq * SS_FIX));
            }
    }
};
struct EpiUpRaw {
    const u64_t* ss; const float* sw;   bf16_t* hraw;
    __device__ __forceinline__ void operator()(const Acc& acc, const Unit& u, int wr, int wc, int fr, int fq) const {
        const int c = cond_of_tile(u.pm); const int colb = u.pn * 256 + wc * 32 + 4 * fq;
        f32x4 sv[2][2];
#pragma unroll
        for (int bj = 0; bj < 2; ++bj)
#pragma unroll
            for (int n = 0; n < 2; ++n) sv[bj][n] = *(const f32x4*)(sw + (size_t)c * SW_STRIDE + colb + bj * 128 + n * 16);
#pragma unroll
        for (int ai = 0; ai < 2; ++ai)
#pragma unroll
            for (int m = 0; m < 4; ++m) {
                const int r = u.pm * 256 + ai * 128 + wr * 64 + m * 16 + fr; const float rs = rstd_of(ss, r);
#pragma unroll
                for (int bj = 0; bj < 2; ++bj)
#pragma unroll
                    for (int n = 0; n < 2; ++n) st_bf16x4(hraw + (size_t)r * NUP + colb + bj * 128 + n * 16, acc[ai][bj][m][n] * rs + sv[bj][n]);
            }
    }
};
constexpr size_t WS_EDGE = 14 * MiB;
template <int CTRL> __device__ __forceinline__ float dpp_f(float old, float src) { return __int_as_float(__builtin_amdgcn_update_dpp(__float_as_int(old), __float_as_int(src), CTRL, 0xf, 0xf, false)); }
#define DPP_ROW_SHL1 0x101
#define DPP_ROW_SHR1 0x111
#define DPP_ROW_ROR1 0x121
#define DPP_ROW_ROR15 0x12f
struct EpiUpConv {
    const u64_t* ss; const float* sw; const float* cw; const float* cb; bf16_t* act; float* edge; bf16_t* tile;
    __device__ __forceinline__ void operator()(const Acc& acc, const Unit& u, int wr, int wc, int fr, int fq) const {
        const int c = cond_of_tile(u.pm); const int cc0 = wc * 32 + 4 * fq, colg0 = u.pn * 128 + cc0;
        f32x4 sv[2][2];
#pragma unroll
        for (int bj = 0; bj < 2; ++bj)
#pragma unroll
            for (int n = 0; n < 2; ++n) sv[bj][n] = *(const f32x4*)(sw + (size_t)c * SW_STRIDE + bj * DFF + colg0 + n * 16);
#pragma unroll
        for (int ai = 0; ai < 2; ++ai)
#pragma unroll
            for (int m = 0; m < 4; ++m) { const int rl = ai * 128 + wr * 64 + m * 16 + fr; const float rs = rstd_of(ss, u.pm * 256 + rl);
#pragma unroll
                for (int bj = 0; bj < 2; ++bj)
#pragma unroll
                    for (int n = 0; n < 2; ++n) st_bf16x4(tile + rl * 256 + bj * 128 + cc0 + n * 16, acc[ai][bj][m][n] * rs + sv[bj][n]); }
    }
    __device__ __forceinline__ void post(const Unit& u, int tid) const {
        asm volatile("s_waitcnt vmcnt(0)" ::: "memory"); __builtin_amdgcn_s_barrier(); asm volatile("" ::: "memory");
        const int ch = tid & 15, rg = tid >> 4, colg = u.pn * 128 + 8 * ch, r0 = rg * 8;
        const bool samp = u.pm >= 16; const bool nb_top = samp && (u.pm & 3) != 0, nb_bot = samp && (u.pm & 3) != 3;
        float wg[3][8], wv[3][8], bg[8], bv[8];
#pragma unroll
        for (int q = 0; q < 2; ++q) {
#pragma unroll
            for (int jj = 0; jj < 3; ++jj) { const f32x4 a = *(const f32x4*)(cw + jj * NUP + colg + 4 * q), b = *(const f32x4*)(cw + jj * NUP + DFF + colg + 4 * q);
#pragma unroll
                for (int e = 0; e < 4; ++e) { wg[jj][4 * q + e] = a[e]; wv[jj][4 * q + e] = b[e]; } }
            const f32x4 a = *(const f32x4*)(cb + colg + 4 * q), b = *(const f32x4*)(cb + DFF + colg + 4 * q);
#pragma unroll
            for (int e = 0; e < 4; ++e) { bg[4 * q + e] = a[e]; bv[4 * q + e] = b[e]; } }
        u32x4 rg_[10], rv_[10];
#pragma unroll
        for (int k = 0; k < 10; ++k) { const int rl = r0 - 1 + k; const bool ok = rl >= 0 && rl <= 255;
            rg_[k] = ok ? *(const u32x4*)(tile + rl * 256 + 8 * ch) : (u32x4){0u, 0u, 0u, 0u}; rv_[k] = ok ? *(const u32x4*)(tile + rl * 256 + 128 + 8 * ch) : (u32x4){0u, 0u, 0u, 0u}; }
#pragma unroll
        for (int k = 0; k < 8; ++k) {
            const int rl = r0 + k; const u32x4 pg = rg_[k], pv = rv_[k], cg = rg_[k + 1], cv = rv_[k + 1], ng = rg_[k + 2], nv = rv_[k + 2];
            float hg[8], hv[8];
#pragma unroll
            for (int e = 0; e < 4; ++e) {
                hg[2 * e] = wg[0][2 * e] * bflo(pg[e]) + wg[1][2 * e] * bflo(cg[e]) + wg[2][2 * e] * bflo(ng[e]) + bg[2 * e];
                hg[2 * e + 1] = wg[0][2 * e + 1] * bfhi(pg[e]) + wg[1][2 * e + 1] * bfhi(cg[e]) + wg[2][2 * e + 1] * bfhi(ng[e]) + bg[2 * e + 1];
                hv[2 * e] = wv[0][2 * e] * bflo(pv[e]) + wv[1][2 * e] * bflo(cv[e]) + wv[2][2 * e] * bflo(nv[e]) + bv[2 * e];
                hv[2 * e + 1] = wv[0][2 * e + 1] * bfhi(pv[e]) + wv[1][2 * e + 1] * bfhi(cv[e]) + wv[2][2 * e + 1] * bfhi(nv[e]) + bv[2 * e + 1]; }
            u32x4 o;
#pragma unroll
            for (int e = 0; e < 4; ++e) o[e] = cvtpk(hg[2 * e] * sigm(hg[2 * e]) * hv[2 * e], hg[2 * e + 1] * sigm(hg[2 * e + 1]) * hv[2 * e + 1]);
            *(u32x4*)(act + (size_t)(u.pm * 256 + rl) * DFF + colg) = o;
            if ((rl == 0 && nb_top) || (rl == 255 && nb_bot)) {
                float* e0 = edge + ((size_t)((u.pm - 16) * 2 + (rl == 0 ? 0 : 1)) * 4) * DFF + colg;
#pragma unroll
                for (int e = 0; e < 4; ++e) { e0[2 * e] = hg[2 * e]; e0[2 * e + 1] = hg[2 * e + 1]; e0[DFF + 2 * e] = hv[2 * e]; e0[DFF + 2 * e + 1] = hv[2 * e + 1];
                    e0[2 * DFF + 2 * e] = bflo(cg[e]); e0[2 * DFF + 2 * e + 1] = bfhi(cg[e]); e0[3 * DFF + 2 * e] = bflo(cv[e]); e0[3 * DFF + 2 * e + 1] = bfhi(cv[e]); } }
        }
    }
};
struct EpiQKV {
    const u64_t* ss; const float* sw; bf16_t *Q, *KB, *VB; float *outK, *outV; const float *ropec, *ropes; int j;
    __device__ __forceinline__ void operator()(const Acc& acc, const Unit& u, int wr, int wc, int fr, int fq) const {
        const int c = cond_of_tile(u.pm); const bool samp = u.pm >= 16; const int colt = u.pn * 256, cl0 = wc * 32 + 4 * fq;
        f32x4 sv[2][2];
#pragma unroll
        for (int bj = 0; bj < 2; ++bj)
#pragma unroll
            for (int n = 0; n < 2; ++n) sv[bj][n] = *(const f32x4*)(sw + (size_t)c * SW_STRIDE + colt + cl0 + bj * 128 + n * 16);
#pragma unroll
        for (int ai = 0; ai < 2; ++ai)
#pragma unroll
            for (int m = 0; m < 4; ++m) {
                const int r = u.pm * 256 + ai * 128 + wr * 64 + m * 16 + fr; const float rs = rstd_of(ss, r);
                f32x4 cs = {1.f, 1.f, 1.f, 1.f}, sn = {0.f, 0.f, 0.f, 0.f};
                if (samp && u.pn < 5) { const int t = (r - MP) & 1023, idx = t * 32 + (wc & 1) * 16 + 4 * fq; cs = *(const f32x4*)(ropec + idx); sn = *(const f32x4*)(ropes + idx); }
#pragma unroll
                for (int bj = 0; bj < 2; ++bj) {
                    f32x4 v0 = acc[ai][bj][m][0] * rs + sv[bj][0], v1 = acc[ai][bj][m][1] * rs + sv[bj][1];
                    if (u.pn < 5) { const f32x4 o0 = v0 * cs - v1 * sn, o1 = v1 * cs + v0 * sn; v0 = o0; v1 = o1; }
                    const int cl = bj * 128 + cl0;
                    if (u.pn < 4) { st_bf16x4(Q + (size_t)r * D + colt + cl, v0 * QSCALE); st_bf16x4(Q + (size_t)r * D + colt + cl + 16, v1 * QSCALE); }
                    else {
                        bf16_t* dst = (u.pn == 4 ? KB : VB) + (size_t)r * 256 + cl; st_bf16x4(dst, v0); st_bf16x4(dst + 16, v1);
                        if (!samp) { float* o = (u.pn == 4 ? outK : outV) + (((size_t)(r >> 8) * 2 + j) * 256 + (r & 255)) * 256 + cl; *(f32x4*)o = v0; *(f32x4*)(o + 16) = v1; }
                    }
                }
            }
    }
};
struct EpiHin {
    const u64_t* ss; const float* sw; const float* lb1; bf16_t *HQ, *HV, *HG; float *LFF, *LFB;
    __device__ __forceinline__ void operator()(const Acc& acc, const Unit& u, int wr, int wc, int fr, int fq) const {
        const int c = cond_of_tile(u.pm); const int seg = u.pn >> 2, colt = u.pn * 256, cl0 = wc * 32 + 4 * fq, cs0 = (u.pn & 3) * 256 + cl0;
        f32x4 sv[2][2], lbv[2][2];
#pragma unroll
        for (int bj = 0; bj < 2; ++bj)
#pragma unroll
            for (int n = 0; n < 2; ++n) { sv[bj][n] = *(const f32x4*)(sw + (size_t)c * SW_STRIDE + colt + cl0 + bj * 128 + n * 16);
                lbv[bj][n] = (seg == 2 || seg == 3) ? *(const f32x4*)(lb1 + (seg - 2) * 1024 + cs0 + bj * 128 + n * 16) : (f32x4){0.f, 0.f, 0.f, 0.f}; }
#pragma unroll
        for (int ai = 0; ai < 2; ++ai)
#pragma unroll
            for (int m = 0; m < 4; ++m) {
                const int r = u.pm * 256 + ai * 128 + wr * 64 + m * 16 + fr; const float rs = rstd_of(ss, r);
#pragma unroll
                for (int bj = 0; bj < 2; ++bj)
#pragma unroll
                    for (int n = 0; n < 2; ++n) {
                        f32x4 v = acc[ai][bj][m][n] * rs + sv[bj][n]; const size_t off = (size_t)r * D + cs0 + bj * 128 + n * 16;
                        if (seg == 0) st_bf16x4(HQ + off, v);
                        else if (seg == 1) st_bf16x4(HV + off, v);
                        else if (seg == 4) {
#pragma unroll
                            for (int e = 0; e < 4; ++e) v[e] = v[e] * sigm(v[e]);
                            st_bf16x4(HG + off, v); }
                        else { const f32x4 lb = lbv[bj][n];
#pragma unroll
                            for (int e = 0; e < 4; ++e) v[e] = __logf(lb[e] + (1.f - lb[e]) * sigm(v[e]));
                            *(f32x4*)((seg == 2 ? LFF : LFB) + off) = v; }
                    }
            }
    }
};
enum { EK_RES = 0, EK_RES_GLU, EK_UPRAW, EK_QKV, EK_HIN, EK_UPCONV };
struct EpiAny {
    int kind, l, flags, epoch; unsigned char* ws; float* out; const float *in29, *in30;
    __device__ __forceinline__ float* F(size_t o) const { return (float*)(ws + o); }
    __device__ __forceinline__ bf16_t* H(size_t o) const { return (bf16_t*)(ws + o); }
    __device__ __forceinline__ void post(const Unit& u, int tid) const {
        if (kind != EK_UPCONV) return;
        unsigned char* ws = this->ws; asm volatile("" : "+s"(ws));
        const size_t ss1 = WS_SS + (size_t)(l * 2) * M * 8, sw1 = WS_SW + (size_t)(l * 2) * 5 * SW_STRIDE * 4;
        EpiUpConv E{(const u64_t*)(ws + ss1 + (size_t)M * 8), (const float*)(ws + sw1 + (size_t)5 * SW_STRIDE * 4), in29 + (size_t)l * 3 * NUP, in30 + (size_t)l * NUP, (bf16_t*)(ws + WS_ACT), (float*)(ws + WS_EDGE), (bf16_t*)(ws + WS_SCR + (size_t)blockIdx.x * 131072)}; E.post(u, tid);
    }
    __device__ __forceinline__ void operator()(Acc& acc, const Unit& u, int wr, int wc, int fr, int fq, int kh, int tid) const {
#ifndef EK_MASK
#define EK_MASK 63
#endif
        if (!((EK_MASK >> kind) & 1)) return;
        unsigned char* ws = this->ws; float* out = this->out; asm volatile("" : "+s"(ws), "+s"(out));
        if (kh >= 0) {
            const int tile = u.pm * 4 + u.pn; unsigned* flag = (unsigned*)(ws + WS_CTL + 40960) + tile * 16;
            unsigned char* slab = ws + WS_SCR + 64 * MiB + (size_t)tile * 262144 + (size_t)tid * 16;
            if (kh == 1) {
                __amdgpu_buffer_rsrc_t rs = __builtin_amdgcn_make_buffer_rsrc(ws + WS_SCR + 64 * MiB + (size_t)tile * 262144, 0, 262144, 0x00020000);
#pragma unroll
                for (int j = 0; j < 32; ++j) __builtin_amdgcn_raw_buffer_store_b128(__builtin_bit_cast(u32x4, acc[j >> 4][(j >> 3) & 1][(j >> 1) & 3][j & 1]), rs, tid * 16 + j * 8192, 0, 16);
                asm volatile("s_waitcnt vmcnt(0)" ::: "memory"); __builtin_amdgcn_s_barrier(); asm volatile("" ::: "memory");
                if (tid == 0) __hip_atomic_store(flag, (unsigned)epoch, __ATOMIC_RELAXED, __HIP_MEMORY_SCOPE_AGENT);
                return;
            }
            if (tid < 64) {
                unsigned sp = 0;
                while ((unsigned)__builtin_amdgcn_readfirstlane((int)__hip_atomic_load(flag, __ATOMIC_RELAXED, __HIP_MEMORY_SCOPE_AGENT)) != (unsigned)epoch) { __builtin_amdgcn_s_sleep(2); if (++sp > (1u << 22)) break; }
                __builtin_amdgcn_fence(__ATOMIC_ACQUIRE, "agent"); asm volatile("s_waitcnt vmcnt(0)" ::: "memory");
            }
            asm volatile("" ::: "memory"); __builtin_amdgcn_s_barrier(); asm volatile("" ::: "memory");
#pragma unroll
            for (int j = 0; j < 32; ++j) acc[j >> 4][(j >> 3) & 1][(j >> 1) & 3][j & 1] += *(const f32x4*)(slab + (size_t)j * 8192);
        }
        auto F = [&](size_t o) { return (float*)(ws + o); }; auto H = [&](size_t o) { return (bf16_t*)(ws + o); };
        const size_t ss1 = WS_SS + (size_t)(l * 2) * M * 8, sw1 = WS_SW + (size_t)(l * 2) * 5 * SW_STRIDE * 4;
        switch (kind) {
        case EK_RES: case EK_RES_GLU: {
            const bool down = flags & 1;
            const size_t ssn = down ? WS_SS + (size_t)((l + 1) * 2) * M * 8 : ss1 + (size_t)M * 8;
            const size_t gate = WS_MOD + ((size_t)l * 5 * 6144 + (down ? 5 : 2) * 1024) * 4;
            const size_t gmn = down ? WS_GMOD + (size_t)((l + 1) * 2) * 5 * 1024 * 4 : WS_GMOD + (size_t)(l * 2 + 1) * 5 * 1024 * 4;
            const bool has_next = !(down && l == 3);
            float* xo = (flags & 2) ? out : F(WS_X); bf16_t* ap = H(WS_AP); u64_t* sp = (u64_t*)(ws + ssn);
            if (flags & 4) { const size_t dm = WS_SCR + ((flags & 8) ? 48 : 96) * MiB; xo = F(dm); ap = H(dm + 32 * MiB); sp = (u64_t*)(ws + dm + 48 * MiB); }
            if (kind == EK_RES) { EpiRes<false> E{F(WS_X), xo, ap, sp, F(gate), has_next ? F(gmn) : nullptr}; E(acc, u, wr, wc, fr, fq); }
            else { EpiRes<true> E{F(WS_X), xo, ap, sp, F(gate), F(gmn)}; E(acc, u, wr, wc, fr, fq); } } break;
        case EK_UPRAW: { EpiUpRaw E{(const u64_t*)(ws + ss1 + (size_t)M * 8), F(sw1 + (size_t)5 * SW_STRIDE * 4), H(WS_SCR + (size_t)((flags >> 2) & 1) * (88 * MiB))}; E(acc, u, wr, wc, fr, fq); } break;
        case EK_UPCONV: { EpiUpConv E{(const u64_t*)(ws + ss1 + (size_t)M * 8), F(sw1 + (size_t)5 * SW_STRIDE * 4), in29 + (size_t)l * 3 * NUP, in30 + (size_t)l * NUP, H(WS_ACT), F(WS_EDGE), H(WS_SCR + (size_t)blockIdx.x * 131072)}; E(acc, u, wr, wc, fr, fq); } break;
        case EK_QKV: { EpiQKV E{(const u64_t*)(ws + ss1), F(sw1), H(SCR_Q), H(SCR_KB), H(SCR_VB), out + 8388608, out + 8388608 + 2097152, F(WS_ROPE), F(WS_ROPE) + 32768, l / 3}; E(acc, u, wr, wc, fr, fq); } break;
        default: { EpiHin E{(const u64_t*)(ws + ss1), F(sw1), F(WS_LB1), H(SCR_HQ), H(SCR_HV), H(SCR_HG), F(SCR_LFF), F(SCR_LFB)}; E(acc, u, wr, wc, fr, fq); } break;
        }
    }
};
}
namespace om {
#define LDS_WAIT() asm volatile("s_waitcnt lgkmcnt(0)" ::: "memory")
__device__ __forceinline__ void transpose_item(const float* W, int K, int N, bf16_t* WT, LAS unsigned short* scr, int item, int lane) {
    const int nblk = N / 32, kb = item / nblk, nb = item % nblk, k0 = 64 * kb, n0 = 32 * nb;
    float v[32];
#pragma unroll
    for (int i = 0; i < 32; ++i) v[i] = W[(size_t)(k0 + 2 * i + (lane >> 5)) * N + n0 + (lane & 31)];
#pragma unroll
    for (int i = 0; i < 32; ++i) scr[(2 * i + (lane >> 5)) * 33 + (lane & 31)] = (unsigned short)(cvtpk(v[i], 0.f) & 0xffffu);
    LDS_WAIT(); asm volatile("" ::: "memory");
    const int c = lane & 7;
#pragma unroll
    for (int j = 0; j < 4; ++j) { const int n = (lane >> 3) + 8 * j; const LAS unsigned short* s = scr + (8 * c) * 33 + n;
        u32x4 o; o.x = (unsigned)s[0 * 33] | ((unsigned)s[1 * 33] << 16); o.y = (unsigned)s[2 * 33] | ((unsigned)s[3 * 33] << 16); o.z = (unsigned)s[4 * 33] | ((unsigned)s[5 * 33] << 16); o.w = (unsigned)s[6 * 33] | ((unsigned)s[7 * 33] << 16);
        *(u32x4*)(WT + (size_t)(n0 + n) * K + k0 + 8 * c) = o; }
    LDS_WAIT(); asm volatile("" ::: "memory");
}
__device__ __forceinline__ float modsum(const Ctx& C, int l, int c, int idx) {
    const float* mp = C.f(WS_MODP) + ((size_t)l * 5 + c) * 6144 + idx; float s = C.in(9)[l * 6144 + idx];
#pragma unroll
    for (int kp = 0; kp < 4; ++kp) s += mp[(size_t)kp * 4 * 5 * 6144];
    return s;
}
__device__ __forceinline__ void convert_layer(const Ctx& C, int layer, int vb, int nvb) {
    const int gw = vb * NWAVES + C.wave, NGW = nvb * NWAVES;
    LAS unsigned short* scr = (LAS unsigned short*)(C.lds + C.wave * 4352);
#define DO_MAT(src, dst, K, N) for (int it = gw; it < ((K) / 64) * ((N) / 32); it += NGW) transpose_item((src), (K), (N), (dst), scr, it, C.lane)
    if (layer == 0 || layer == 3) { const int j = layer / 3; DO_MAT(C.in(12) + (size_t)j * D * NQKV, C.h(WS_WQKV) + (size_t)j * NQKV * D, D, NQKV); DO_MAT(C.in(13) + (size_t)j * D * D, C.h(WS_WO) + (size_t)j * D * D, D, D); }
    else if (layer == 1) { DO_MAT(C.in(15), C.h(WS_HWIN), D, NHIN); DO_MAT(C.in(18), C.h(WS_HWO), D, D); }
    else { DO_MAT(C.in(27), C.h(WS_GLU), D, 2048); }
    DO_MAT(C.in(28) + (size_t)layer * D * NUP, C.h(WS_UP) + (size_t)layer * NUP * D, D, NUP); DO_MAT(C.in(31) + (size_t)layer * DFF * D, C.h(WS_DOWN) + (size_t)layer * D * DFF, DFF, D);
#undef DO_MAT
}
__device__ __forceinline__ void phase_p0a(const Ctx& C) {
    const int gt = C.bid * NTHREADS + C.tid, NGT = C.G * NTHREADS;
    for (int layer = 0; layer < 4; ++layer) if (layer == 0 || C.G != 256) convert_layer(C, layer, C.bid, C.G);
    __syncthreads();
    LAS float* sS = (LAS float*)(C.lds + 40960);
    LAS float* red = (LAS float*)(C.lds);
    for (int it = C.bid; it < 384; it += C.G) {
        const int l = it / 96, cb = (it % 96) >> 2, kp = it & 3;
        for (int i = C.tid; i < 5 * 256; i += NTHREADS) { const int c = i >> 8, k = kp * 256 + (i & 255); const float v = c == 0 ? C.in(7)[k] : C.in(6)[(c - 1) * 1024 + k]; sS[i] = v / (1.f + __expf(-v)); }
        __syncthreads();
        f32x4 a[5];
#pragma unroll
        for (int c = 0; c < 5; ++c) a[c] = (f32x4){0.f, 0.f, 0.f, 0.f};
        const float* wp = C.in(8) + ((size_t)l * 1024 + kp * 256 + C.wave * 32) * 6144 + cb * 256 + 4 * C.lane;
#pragma unroll 4
        for (int k = 0; k < 32; ++k) { const f32x4 w = *(const f32x4*)(wp + (size_t)k * 6144);
#pragma unroll
            for (int c = 0; c < 5; ++c) a[c] += w * sS[c * 256 + C.wave * 32 + k]; }
#pragma unroll
        for (int c = 0; c < 5; ++c) *(LAS f32x4*)(red + (C.wave * 5 + c) * 256 + 4 * C.lane) = a[c];
        __syncthreads();
        for (int i = C.tid; i < 5 * 256; i += NTHREADS) { float s = 0.f;
#pragma unroll
            for (int w = 0; w < 8; ++w) s += red[w * 1280 + i];
            C.f(WS_MODP)[(((size_t)kp * 4 + l) * 5 + (i >> 8)) * 6144 + cb * 256 + (i & 255)] = s; }
        __syncthreads();
    }
    { unsigned zero = 0u; asm volatile("" : "+v"(zero));
      for (int i = gt; i < 9 * M; i += NGT) ((u32x2*)(C.ws + WS_SS))[i] = (u32x2){zero, zero}; }
    for (int i = gt; i < 1024 * 32; i += NGT) { const int t = i >> 5, e = i & 31, fi = e & 15; const float pos = (e >> 4) == 0 ? (float)(t >> 6) : (float)(t & 63);
        const float ang = pos * (1.0f / powf(10000.0f, (float)(2 * fi) / 32.0f)); C.f(WS_ROPE)[i] = cosf(ang); C.f(WS_ROPE)[32768 + i] = sinf(ang); }
    for (int i = gt; i < 2 * 131072; i += NGT) { const int which = i >> 17, e = (i & 131071) * 8; const float* s = (which ? C.in(3) : C.in(2)) + e; const f32x4 a = *(const f32x4*)s, b = *(const f32x4*)(s + 4);
        u32x4 o; o.x = cvtpk(a[0], a[1]); o.y = cvtpk(a[2], a[3]); o.z = cvtpk(b[0], b[1]); o.w = cvtpk(b[2], b[3]); *(u32x4*)(C.h(which ? WS_CTXV : WS_CTXK) + e) = o; }
    for (int i = gt; i < 2048; i += NGT) { float v[4], mx = -1e30f;
#pragma unroll
        for (int l = 0; l < 4; ++l) { v[l] = C.in(16)[l * 2048 + i]; mx = fmaxf(mx, v[l]); }
        float s = 0.f;
#pragma unroll
        for (int l = 0; l < 4; ++l) { v[l] = expf(v[l] - mx); s += v[l]; }
        C.f(WS_LB1)[i] = v[1] / s; }
    for (int i = gt; i < 8192; i += NGT) {
        const int dg = i >> 6, p = i & 63;
        const float ar = fminf(C.in(19)[i], -1e-4f), ai = C.in(20)[i], dt = expf(C.in(21)[dg]);
        const float e = expf(ar * dt), lr = e * cosf(ai * dt), li = e * sinf(ai * dt);
        const float den = ar * ar + ai * ai, fr = ((lr - 1.f) * ar + li * ai) / den, fi = (li * ar - (lr - 1.f) * ai) / den;
        C.f(WS_SLAM)[2 * i] = lr; C.f(WS_SLAM)[2 * i + 1] = li;
        unsigned wr_[8], wi_[8];
#pragma unroll
        for (int q = 0; q < 8; ++q) { const float x0 = C.in(22)[(size_t)i * 16 + 2 * q], y0 = C.in(23)[(size_t)i * 16 + 2 * q], x1 = C.in(22)[(size_t)i * 16 + 2 * q + 1], y1 = C.in(23)[(size_t)i * 16 + 2 * q + 1];
            wr_[q] = cvtpk(fr * x0 - fi * y0, fr * x1 - fi * y1); wi_[q] = cvtpk(fr * y0 + fi * x0, fr * y1 + fi * x1); }
        bf16_t* bb = C.h(WS_SBB) + ((size_t)dg * 128 + p) * 16;
        *(u32x4*)bb = (u32x4){wr_[0], wr_[1], wr_[2], wr_[3]}; *(u32x4*)(bb + 8) = (u32x4){wr_[4], wr_[5], wr_[6], wr_[7]};
        *(u32x4*)(bb + 64 * 16) = (u32x4){wi_[0], wi_[1], wi_[2], wi_[3]}; *(u32x4*)(bb + 64 * 16 + 8) = (u32x4){wi_[4], wi_[5], wi_[6], wi_[7]};
    }
    for (int i = gt; i < 2 * 64 * 16 * 64; i += NGT) {
        const int p = i & 63, row = i >> 6; bf16_t* cb = C.h(WS_SCB) + (size_t)row * 128;
        cb[p] = (bf16_t)(cvtpk(C.in(24)[i], 0.f) & 0xffffu); cb[64 + p] = (bf16_t)(cvtpk(-C.in(25)[i], 0.f) & 0xffffu); }
}
__device__ __forceinline__ void rows_ap_ss(const Ctx& C, const float* xsrc_p, const float* xsrc_s, float* xcopy, int l, int s, bool from_table, u64_t* ssdst) {
    for (int gw = C.bid * NWAVES + C.wave; gw < M / 4; gw += C.G * NWAVES) {
    const int r0 = gw * 4;
    const int c = cond_of_row(r0);
    f32x4 gm[4];
#pragma unroll
    for (int j = 0; j < 4; ++j) { const int n = 4 * C.lane + 256 * j;
        if (from_table) gm[j] = *(const f32x4*)(C.f(WS_GMOD) + (((size_t)l * 2 + s) * 5 + c) * 1024 + n);
        else { const float* g = (s == 0 ? C.in(10) : C.in(11)) + l * D + n;
#pragma unroll
            for (int e = 0; e < 4; ++e) gm[j][e] = g[e] * (1.f + modsum(C, l, c, (s == 0 ? 1 : 4) * 1024 + n + e)); } }
    for (int rr = 0; rr < 4; ++rr) {
        const int r = r0 + rr; const float* xr = (r < MP ? xsrc_p + (size_t)r * D : xsrc_s + (size_t)(r - MP) * D);
        f32x4 v[4]; float sq = 0.f;
#pragma unroll
        for (int j = 0; j < 4; ++j) { v[j] = *(const f32x4*)(xr + 4 * C.lane + 256 * j); sq += (v[j][0] * v[j][0] + v[j][1] * v[j][1]) + (v[j][2] * v[j][2] + v[j][3] * v[j][3]); }
        sq = wave_sum(sq);
#pragma unroll
        for (int j = 0; j < 4; ++j) { const size_t off = (size_t)r * D + 4 * C.lane + 256 * j; if (xcopy) *(f32x4*)(xcopy + off) = v[j]; st_bf16x4(C.h(WS_AP) + off, v[j] * gm[j]); }
        if (C.lane == 0) ssdst[r] = (u64_t)(sq * SS_FIX);
    }
    }
}
__device__ __forceinline__ void phase_p0c(const Ctx& C) {
    for (int vb = C.bid; vb < 256; vb += C.G) {
    if (vb < 240) {
        int ch = vb, l = 0, s = 0, N = 0; const float* Wf = nullptr;
        if (ch < 12) { l = 0; s = 0; N = NQKV; Wf = C.in(12); }
        else if ((ch -= 12) < 44) { l = 0; s = 1; N = NUP; Wf = C.in(28); }
        else if ((ch -= 44) < 40) { l = 1; s = 0; N = NHIN; Wf = C.in(15); }
        else if ((ch -= 40) < 44) { l = 1; s = 1; N = NUP; Wf = C.in(28) + (size_t)1 * D * NUP; }
        else if ((ch -= 44) < 44) { l = 2; s = 1; N = NUP; Wf = C.in(28) + (size_t)2 * D * NUP; }
        else if ((ch -= 44) < 12) { l = 3; s = 0; N = NQKV; Wf = C.in(12) + (size_t)1 * D * NQKV; }
        else { ch -= 12; l = 3; s = 1; N = NUP; Wf = C.in(28) + (size_t)3 * D * NUP; }
        LAS float* sh = (LAS float*)C.lds;
        for (int i = C.tid; i < 5 * 1024; i += NTHREADS) sh[i] = modsum(C, l, i >> 10, (s == 0 ? 0 : 3) * 1024 + (i & 1023));
        __syncthreads();
        const int n0 = ch * 128 + 4 * (C.lane & 31);
        f32x4 a[5];
#pragma unroll
        for (int c = 0; c < 5; ++c) a[c] = (f32x4){0.f, 0.f, 0.f, 0.f};
        const float* wp = Wf + (size_t)(C.wave * 128 + (C.lane >> 5)) * N + n0;
#pragma unroll 4
        for (int k = 0; k < 64; ++k) { const f32x4 w = *(const f32x4*)(wp + (size_t)(2 * k) * N); const int kk = C.wave * 128 + 2 * k + (C.lane >> 5);
#pragma unroll
            for (int c = 0; c < 5; ++c) a[c] += w * sh[c * 1024 + kk]; }
        LAS float* red = (LAS float*)(C.lds + 20480);
#pragma unroll
        for (int c = 0; c < 5; ++c) *(LAS f32x4*)(red + ((C.wave * 2 + (C.lane >> 5)) * 5 + c) * 128 + 4 * (C.lane & 31)) = a[c];
        __syncthreads();
        for (int i = C.tid; i < 5 * 128; i += NTHREADS) { float sum = 0.f;
#pragma unroll
            for (int w = 0; w < 16; ++w) sum += red[w * 640 + i];
            C.f(WS_SW)[(((size_t)l * 2 + s) * 5 + (i >> 7)) * SW_STRIDE + ch * 128 + (i & 127)] = sum; }
    } else {
        const int t = (vb - 240) * NTHREADS + C.tid, NT = 16 * NTHREADS;
        for (int i = t; i < 4 * 5 * 6144; i += NT) { const int l = i / 30720, c = (i / 6144) % 5, idx = i % 6144; C.f(WS_MOD)[i] = modsum(C, l, c, idx); }
        for (int i = t; i < 4 * 2 * 5 * 1024; i += NT) { const int n = i & 1023, c = (i >> 10) % 5, s = (i / 5120) & 1, l = i / 10240;
            C.f(WS_GMOD)[i] = (s == 0 ? C.in(10) : C.in(11))[l * D + n] * (1.f + modsum(C, l, c, (s == 0 ? 1 : 4) * 1024 + n)); }
    }
    __syncthreads();
    }
    rows_ap_ss(C, C.in(0), C.in(1), C.f(WS_X), 0, 0, false, (u64_t*)(C.ws + WS_SS));
}
__device__ __forceinline__ void phase_glue(const Ctx& C, int l, int s) { rows_ap_ss(C, C.f(WS_X), C.f(WS_X) + (size_t)MP * D, nullptr, l, s, true, (u64_t*)(C.ws + WS_SS) + (size_t)(l * 2 + s) * M); }

__device__ __forceinline__ void phase_conv(const Ctx& C, int l) {
    const bf16_t* h = C.h(WS_SCR); bf16_t* act = C.h(WS_ACT); const float* cw = C.in(29) + (size_t)l * 3 * NUP; const float* cb = C.in(30) + (size_t)l * NUP;
    const int gt = C.bid * NTHREADS + C.tid, NGT = C.G * NTHREADS;
    for (int i = gt; i < M * (DFF / 8); i += NGT) {
        const int r = i / (DFF / 8), n = (i % (DFF / 8)) * 8;
        int t, S; if (r < MP) { t = r & 255; S = 256; } else { t = (r - MP) & 1023; S = 1024; }
        float g[8], v[8];
#pragma unroll
        for (int e = 0; e < 8; ++e) { g[e] = cb[n + e]; v[e] = cb[DFF + n + e]; }
#pragma unroll
        for (int jj = 0; jj < 3; ++jj) { const int tt = t + jj - 1; if (tt >= 0 && tt < S) {
            const u32x4 hg = *(const u32x4*)(h + (size_t)(r + jj - 1) * NUP + n), hv = *(const u32x4*)(h + (size_t)(r + jj - 1) * NUP + DFF + n);
#pragma unroll
            for (int e = 0; e < 4; ++e) { g[2 * e] += cw[jj * NUP + n + 2 * e] * bflo(hg[e]); g[2 * e + 1] += cw[jj * NUP + n + 2 * e + 1] * bfhi(hg[e]);
                v[2 * e] += cw[jj * NUP + DFF + n + 2 * e] * bflo(hv[e]); v[2 * e + 1] += cw[jj * NUP + DFF + n + 2 * e + 1] * bfhi(hv[e]); } } }
        u32x4 o;
#pragma unroll
        for (int e = 0; e < 4; ++e) o[e] = cvtpk(g[2 * e] * sigm(g[2 * e]) * v[2 * e], g[2 * e + 1] * sigm(g[2 * e + 1]) * v[2 * e + 1]);
        *(u32x4*)(act + (size_t)r * DFF + n) = o;
    }
}
__device__ __forceinline__ void phase_final(const Ctx& C, float dbg) {
    const int gw = C.bid * NWAVES + C.wave, NGW = C.G * NWAVES; const u64_t* ss = (const u64_t*)(C.ws + WS_SS) + (size_t)8 * M;
    for (int r = gw; r < M; r += NGW) { const float rs = rstd_of(ss, r);
#pragma unroll
        for (int j = 0; j < 4; ++j) { const int n = 4 * C.lane + 256 * j; float* p = C.out + (size_t)r * D + n; *(f32x4*)p = *(const f32x4*)p * (rs * dbg) * *(const f32x4*)(C.in(32) + n); } }
}
}
namespace om {
__device__ __forceinline__ int rowidx(int r, int h) { return (r & 3) + 8 * (r >> 2) + 4 * h; }
__device__ __forceinline__ float xhalf(float v) {
    auto rr = __builtin_amdgcn_permlane32_swap(__float_as_uint(v), __float_as_uint(v), false, false);
    return __uint_as_float((lane_id() & 32) ? rr[0] : rr[1]);
}
__device__ __forceinline__ bf16x8 pack8(const f32x16& x, int base) {
    u32x4 w; w.x = cvtpk(x[base], x[base + 1]); w.y = cvtpk(x[base + 2], x[base + 3]); w.z = cvtpk(x[base + 4], x[base + 5]); w.w = cvtpk(x[base + 6], x[base + 7]);
    return __builtin_bit_cast(bf16x8, w);
}
__device__ __forceinline__ bf16x8 cat44(u32x2 a, u32x2 b) { u32x4 w = {a.x, a.y, b.x, b.y}; return __builtin_bit_cast(bf16x8, w); }

constexpr int AT_KSTR = 144;
constexpr int AT_BUF = 2 * 64 * AT_KSTR;
__device__ __forceinline__ void attn_unit(const Ctx& C, int j, bool samp, int b, int hq, int qb, size_t obuf) {
    const int lane = C.lane, c = lane & 31, h = lane >> 5, w = C.wave, kvh = hq >> 2;
    const int rowbase = samp ? MP + b * 1024 : b * 256, q0 = qb * 256, qlo = q0 + 32 * w;
    const bf16_t* Q = C.h(SCR_Q); const bf16_t* KB = C.h(SCR_KB); const bf16_t* VB = C.h(SCR_VB);
    const bf16_t* CK = C.h(WS_CTXK) + ((size_t)(b * 2 + j) * 512) * 256; const bf16_t* CV = C.h(WS_CTXV) + ((size_t)(b * 2 + j) * 512) * 256;
    int klo = 0, nlat = 4, NT = 4;
    if (samp) { klo = q0 - 128 < 0 ? 0 : q0 - 128; const int khi = q0 + 384 > 1024 ? 1024 : q0 + 384; nlat = (khi - klo) >> 6; NT = nlat + 8; }
    bf16x8 qf[4];
#pragma unroll
    for (int s = 0; s < 4; ++s) qf[s] = *(const bf16x8*)(Q + (size_t)(rowbase + qlo + c) * D + hq * 64 + 16 * s + 8 * h);
    float m = C.in(14)[j * 16 + hq] * LOG2E, lsum = h == 0 ? 1.f : 0.f;
    f32x16 o0 = {}, o1 = {};
    const int lkey = C.tid >> 3, lch = C.tid & 7;
    auto src_k = [&](int t) -> const bf16_t* { return (t < nlat ? KB + (size_t)(rowbase + klo + 64 * t + lkey) * 256 : CK + (size_t)(64 * (t - nlat) + lkey) * 256) + kvh * 64 + lch * 8; };
    auto src_v = [&](int t) -> const bf16_t* { return (t < nlat ? VB + (size_t)(rowbase + klo + 64 * t + lkey) * 256 : CV + (size_t)(64 * (t - nlat) + lkey) * 256) + kvh * 64 + lch * 8; };
    auto put = [&](int buf, u32x4 kr, u32x4 vr) {
        LAS unsigned char* kb = C.lds + buf * AT_BUF; LAS unsigned char* vb = kb + 64 * AT_KSTR;
        *(LAS u32x4*)(kb + lkey * AT_KSTR + lch * 16) = kr;
#pragma unroll
        for (int e = 0; e < 4; ++e) { *(LAS unsigned short*)(vb + (lch * 8 + 2 * e) * AT_KSTR + lkey * 2) = (unsigned short)(vr[e] & 0xffffu); *(LAS unsigned short*)(vb + (lch * 8 + 2 * e + 1) * AT_KSTR + lkey * 2) = (unsigned short)(vr[e] >> 16); }
    };
    { const u32x4 kr = *(const u32x4*)src_k(0), vr = *(const u32x4*)src_v(0); put(0, kr, vr); }
    __syncthreads();
    for (int t = 0; t < NT; ++t) {
        u32x4 kr = {}, vr = {};
        if (t + 1 < NT) { kr = *(const u32x4*)src_k(t + 1); vr = *(const u32x4*)src_v(t + 1); }
        const bool lat = samp && t < nlat; const int key0 = klo + 64 * t;
        const bool skip = lat && (key0 > qlo + 31 + 128 || key0 + 63 < qlo - 128);
        if (!skip) {
            LAS unsigned char* kb = C.lds + (t & 1) * AT_BUF; LAS unsigned char* vb = kb + 64 * AT_KSTR;
            f32x16 x0 = {}, x1 = {};
#pragma unroll
            for (int s = 0; s < 4; ++s) {
                const bf16x8 a0 = *(const LAS bf16x8*)(kb + c * AT_KSTR + (16 * s + 8 * h) * 2), a1 = *(const LAS bf16x8*)(kb + (32 + c) * AT_KSTR + (16 * s + 8 * h) * 2);
                x0 = __builtin_amdgcn_mfma_f32_32x32x16_bf16(a0, qf[s], x0, 0, 0, 0); x1 = __builtin_amdgcn_mfma_f32_32x32x16_bf16(a1, qf[s], x1, 0, 0, 0);
            }
            if (lat && !(key0 >= qlo + 31 - 128 && key0 + 63 <= qlo + 128)) {
                const int tq = qlo + c;
#pragma unroll
                for (int r = 0; r < 16; ++r) { const int k0 = key0 + rowidx(r, h) - tq; if (k0 > 128 || k0 < -128) x0[r] = -INFINITY; if (k0 + 32 > 128 || k0 + 32 < -128) x1[r] = -INFINITY; }
            }
            float mx = fmaxf(x0[0], x1[0]);
#pragma unroll
            for (int r = 1; r < 16; ++r) mx = fmaxf(mx, fmaxf(x0[r], x1[r]));
            mx = fmaxf(mx, xhalf(mx));
            const float mn = fmaxf(m, mx), al = __builtin_amdgcn_exp2f(m - mn); m = mn;
            float ps = 0.f;
#pragma unroll
            for (int r = 0; r < 16; ++r) { x0[r] = __builtin_amdgcn_exp2f(x0[r] - mn); x1[r] = __builtin_amdgcn_exp2f(x1[r] - mn); ps += x0[r] + x1[r]; }
            lsum = lsum * al + ps;
#pragma unroll
            for (int r = 0; r < 16; ++r) { o0[r] *= al; o1[r] *= al; }
#pragma unroll
            for (int ks = 0; ks < 2; ++ks) {
                const bf16x8 p0 = pack8(x0, 8 * ks), p1 = pack8(x1, 8 * ks);
#pragma unroll
                for (int dt = 0; dt < 2; ++dt) {
                    const LAS unsigned char* vrow = vb + (32 * dt + c) * AT_KSTR + (16 * ks + 4 * h) * 2;
                    const bf16x8 v0 = cat44(*(const LAS u32x2*)(vrow), *(const LAS u32x2*)(vrow + 16)), v1 = cat44(*(const LAS u32x2*)(vrow + 64), *(const LAS u32x2*)(vrow + 80));
                    if (dt == 0) { o0 = __builtin_amdgcn_mfma_f32_32x32x16_bf16(v0, p0, o0, 0, 0, 0); o0 = __builtin_amdgcn_mfma_f32_32x32x16_bf16(v1, p1, o0, 0, 0, 0); }
                    else { o1 = __builtin_amdgcn_mfma_f32_32x32x16_bf16(v0, p0, o1, 0, 0, 0); o1 = __builtin_amdgcn_mfma_f32_32x32x16_bf16(v1, p1, o1, 0, 0, 0); }
                }
            }
        }
        if (t + 1 < NT) put((t + 1) & 1, kr, vr);
        __syncthreads();
    }
    lsum += xhalf(lsum);
    const float il = 1.f / lsum;
    bf16_t* O = C.h(obuf) + (size_t)(rowbase + qlo + c) * D + hq * 64 + 4 * h;
#pragma unroll
    for (int g = 0; g < 4; ++g) { st_bf16x4(O + 8 * g, (f32x4){o0[4 * g], o0[4 * g + 1], o0[4 * g + 2], o0[4 * g + 3]} * il); st_bf16x4(O + 32 + 8 * g, (f32x4){o1[4 * g], o1[4 * g + 1], o1[4 * g + 2], o1[4 * g + 3]} * il); }
}
__device__ __forceinline__ void phase_attn(const Ctx& C, int l, size_t obuf) {
    const int j = l / 3;
    for (int u = C.bid; u < 512; u += C.G) {
        if (u < 256) attn_unit(C, j, false, u >> 4, u & 15, 0, obuf);
        else { const int v = u - 256; attn_unit(C, j, true, v >> 6, (v >> 2) & 15, v & 3, obuf); }
    }
}
constexpr size_t CKS_TAB = 376 * MiB; constexpr int CKS_NW = (int)((268 * MiB) / 65536), CKS_NO = (17039360 * 4) / 65536, CKS_N = CKS_NW + CKS_NO;
__device__ __forceinline__ void phase_cks(const Ctx& C, int slot) {
    const int gw = C.bid * NWAVES + C.wave, NGW = C.G * NWAVES; unsigned* tab = (unsigned*)(C.ws + CKS_TAB) + (size_t)slot * 8192;
    for (int ck = gw; ck < CKS_N; ck += NGW) {
        const unsigned char* base = ck < CKS_NW ? C.ws + 108 * MiB + (size_t)ck * 65536 : (const unsigned char*)C.out + (size_t)(ck - CKS_NW) * 65536; unsigned s = 0;
        for (int i = 0; i < 64; ++i) { const u32x4 v = *(const u32x4*)(base + (size_t)i * 1024 + C.lane * 16); s += v[0] + v[1] * 3u + v[2] * 5u + v[3] * 7u; }
#pragma unroll
        for (int o = 1; o < 64; o <<= 1) s += (unsigned)__shfl_xor((int)s, o);
        if (C.lane == 0) tab[ck] = s;
    }
}
__device__ __forceinline__ void phase_clr(const Ctx& C) {
    const int gt = C.bid * NTHREADS + C.tid, NGT = C.G * NTHREADS; const u32x4 z = {0u, 0u, 0u, 0u};
    for (size_t i = gt; i < (268 * MiB) / 16; i += NGT) *(u32x4*)(C.ws + 108 * MiB + i * 16) = z;
    for (size_t i = gt; i < (size_t)17039360 / 4; i += NGT) *(u32x4*)((unsigned char*)C.out + i * 16) = z;
}
__device__ __forceinline__ void phase_clr2(const Ctx& C, size_t off, size_t bytes) {
    const int gt = C.bid * NTHREADS + C.tid, NGT = C.G * NTHREADS; const u32x4 z = {0u, 0u, 0u, 0u};
    for (size_t i = gt; i < bytes / 16; i += NGT) *(u32x4*)(C.ws + off + i * 16) = z;
}
__device__ __forceinline__ void phase_cmp(const Ctx& C, int nslots) {
    const int gt = C.bid * NTHREADS + C.tid, NGT = C.G * NTHREADS; const unsigned* tab = (const unsigned*)(C.ws + CKS_TAB);
    for (int i = gt; i < nslots * 8192; i += NGT) { const int sl = i >> 13, ck = i & 8191; if (ck < CKS_N && tab[(size_t)sl * 8192 + ck] != tab[(size_t)(sl + 32) * 8192 + ck]) {
#ifdef SSDET
        const int cls = ck >= CKS_NW ? 4 : (ck < 1472 + 512 ? 1 : 2); atomicOr((unsigned*)(C.ws + WS_CTL) + 4002, (unsigned)cls); atomicAdd((unsigned*)(C.ws + WS_CTL) + 4003, 1u);
#endif
        atomicMax((unsigned*)(C.ws + WS_CTL) + 4001, (unsigned)(1000 - sl)); } }
}
__device__ __forceinline__ void phase_chk(const Ctx& C, size_t a, size_t b, size_t bytes) {
    const int gt = C.bid * NTHREADS + C.tid, NGT = C.G * NTHREADS; unsigned bad = 0;
    for (size_t i = gt; i < bytes / 16; i += NGT) { const u32x4 x = *(const u32x4*)(C.ws + a + i * 16), y = *(const u32x4*)(C.ws + b + i * 16); bad += (x[0] != y[0]) | (x[1] != y[1]) | (x[2] != y[2]) | (x[3] != y[3]); }
    if (bad) atomicAdd((unsigned*)(C.ws + WS_CTL) + 4000, bad);
}

constexpr int HS_QSTR = 272, HS_TSTR = 80;
constexpr int HS_QT = 0, HS_KT = 32 * HS_QSTR, HS_KTT = 2 * 32 * HS_QSTR, HS_VT = HS_KTT + 128 * HS_TSTR, HS_E1 = HS_VT + 128 * HS_TSTR, HS_E2 = HS_E1 + 512, HS_T1 = HS_E2 + 512, HS_GRP = HS_T1 + 512;
__device__ __forceinline__ void hscan_item(const Ctx& C, int item) {
    const bool samp = item < 64; const int it = samp ? item : item - 64;
    const int dir = it & 1, hd = (it >> 1) & 7, sq = it >> 4;
    const int S = samp ? 1024 : 256, rowbase = samp ? MP + sq * 1024 : sq * 256, nchunk = S >> 5;
    const int tg = C.tid & 255, lane = C.lane, c = lane & 31, h = lane >> 5, w4 = C.wave & 3; const bool producer = C.wave >= 4;
    LAS unsigned char* L = C.lds;
    const bf16_t* HQ = C.h(SCR_HQ); const bf16_t* HV = C.h(SCR_HV); const float* LF = C.f(dir == 0 ? SCR_LFF : SCR_LFB); float* OD = C.f(dir == 0 ? SCR_OF : SCR_OB);
    const int pd = tg & 127, ph = tg >> 7;
    unsigned qw[8], kw[8], vtw[8]; float e1v = 0.f, e2v = 0.f;
    float rlf[16], rpre[16]; unsigned rq[16], rv[16];
    auto issue = [&](int ch) {
#pragma unroll
        for (int i = 0; i < 16; ++i) { const int pos = 32 * ch + 16 * ph + i, t = dir == 0 ? pos : S - 1 - pos; const size_t off = (size_t)(rowbase + t) * D + hd * 128 + pd;
            rlf[i] = LF[off]; rq[i] = HQ[off]; rv[i] = HV[off];
            const int pos2 = 32 * ch + i, t2 = dir == 0 ? pos2 : S - 1 - pos2; rpre[i] = ph == 1 ? LF[(size_t)(rowbase + t2) * D + hd * 128 + pd] : 0.f; }
    };
    auto compute = [&]() {
        float cl[16]; float pre = 0.f, run = 0.f;
#pragma unroll
        for (int i = 0; i < 16; ++i) { pre += rpre[i]; run += rlf[i]; cl[i] = run; }
        const float t1v = ph == 0 ? cl[15] : pre;
#pragma unroll
        for (int i = 0; i < 16; i += 2) {
            const float e0 = ph == 0 ? cl[i] - t1v : cl[i], e1 = ph == 0 ? cl[i + 1] - t1v : cl[i + 1];
            const float k0 = 1.f - __expf(rlf[i]), k1 = 1.f - __expf(rlf[i + 1]);
            qw[i >> 1] = cvtpk(__uint_as_float(rq[i] << 16) * __expf(e0), __uint_as_float(rq[i + 1] << 16) * __expf(e1)); kw[i >> 1] = cvtpk(k0 * __expf(-e0), k1 * __expf(-e1));
            vtw[i >> 1] = rv[i] | (rv[i + 1] << 16); }
        e1v = __expf(t1v); e2v = __expf(cl[15]);
    };
    auto put = [&]() {
#pragma unroll
        for (int i = 0; i < 8; ++i) {
            *(LAS unsigned short*)(L + HS_QT + (16 * ph + 2 * i) * HS_QSTR + pd * 2) = (unsigned short)(qw[i] & 0xffffu); *(LAS unsigned short*)(L + HS_QT + (16 * ph + 2 * i + 1) * HS_QSTR + pd * 2) = (unsigned short)(qw[i] >> 16);
            *(LAS unsigned short*)(L + HS_KT + (16 * ph + 2 * i) * HS_QSTR + pd * 2) = (unsigned short)(kw[i] & 0xffffu); *(LAS unsigned short*)(L + HS_KT + (16 * ph + 2 * i + 1) * HS_QSTR + pd * 2) = (unsigned short)(kw[i] >> 16); }
        *(LAS u32x4*)(L + HS_KTT + pd * HS_TSTR + ph * 32) = (u32x4){kw[0], kw[1], kw[2], kw[3]}; *(LAS u32x4*)(L + HS_KTT + pd * HS_TSTR + ph * 32 + 16) = (u32x4){kw[4], kw[5], kw[6], kw[7]};
        *(LAS u32x4*)(L + HS_VT + pd * HS_TSTR + ph * 32) = (u32x4){vtw[0], vtw[1], vtw[2], vtw[3]}; *(LAS u32x4*)(L + HS_VT + pd * HS_TSTR + ph * 32 + 16) = (u32x4){vtw[4], vtw[5], vtw[6], vtw[7]};
        if (ph == 0) *(LAS float*)(L + HS_E1 + pd * 4) = e1v; else *(LAS float*)(L + HS_E2 + pd * 4) = e2v;
    };
    if (producer) {
        issue(0); compute(); if (nchunk > 1) issue(1);
        for (int ch = 0; ch < nchunk; ++ch) {
            put();
            __syncthreads();
            if (ch + 1 < nchunk) { compute(); if (ch + 2 < nchunk) issue(ch + 2); }
            __syncthreads();
        }
        return;
    }
    f32x16 St[4];
#pragma unroll
    for (int dt = 0; dt < 4; ++dt) {
        if (samp) { const float* s0 = C.in(4) + ((((size_t)sq * 2 + dir) * 8 + hd) * 128) * 128;
#pragma unroll
            for (int r = 0; r < 16; ++r) St[dt][r] = s0[(size_t)(32 * dt + rowidx(r, h)) * 128 + 32 * w4 + c]; }
        else St[dt] = (f32x16){};
    }
    for (int ch = 0; ch < nchunk; ++ch) {
        __syncthreads();
#pragma unroll
        for (int dt = 0; dt < 4; ++dt)
#pragma unroll
            for (int g = 0; g < 4; ++g) { const f32x4 e = *(const LAS f32x4*)(L + HS_E1 + (32 * dt + 8 * g + 4 * h) * 4);
#pragma unroll
                for (int q = 0; q < 4; ++q) St[dt][4 * g + q] *= e[q]; }
        f32x16 X = {};
#pragma unroll
        for (int s = 0; s < 8; ++s) {
            const bf16x8 a = *(const LAS bf16x8*)(L + HS_KT + c * HS_QSTR + (16 * s + 8 * h) * 2), bq = *(const LAS bf16x8*)(L + HS_QT + c * HS_QSTR + (16 * s + 8 * h) * 2);
            X = __builtin_amdgcn_mfma_f32_32x32x16_bf16(a, bq, X, 0, 0, 0);
        }
#pragma unroll
        for (int r = 0; r < 16; ++r) if (rowidx(r, h) > c) X[r] = 0.f;
        f32x16 OT = {};
#pragma unroll
        for (int ks = 0; ks < 2; ++ks) {
            const LAS unsigned char* vrow = L + HS_VT + (32 * w4 + c) * HS_TSTR + (16 * ks + 4 * h) * 2;
            const bf16x8 va = cat44(*(const LAS u32x2*)(vrow), *(const LAS u32x2*)(vrow + 16));
            OT = __builtin_amdgcn_mfma_f32_32x32x16_bf16(va, pack8(X, 8 * ks), OT, 0, 0, 0);
        }
#pragma unroll
        for (int dt = 0; dt < 4; ++dt)
#pragma unroll
            for (int ks = 0; ks < 2; ++ks) {
                const LAS unsigned char* qrow = L + HS_QT + c * HS_QSTR + (32 * dt + 16 * ks + 4 * h) * 2;
                const bf16x8 bq = cat44(*(const LAS u32x2*)(qrow), *(const LAS u32x2*)(qrow + 16));
                OT = __builtin_amdgcn_mfma_f32_32x32x16_bf16(pack8(St[dt], 8 * ks), bq, OT, 0, 0, 0);
            }
#pragma unroll
        for (int dt = 0; dt < 4; ++dt)
#pragma unroll
            for (int ks = 0; ks < 2; ++ks) {
                const bf16x8 a = *(const LAS bf16x8*)(L + HS_KTT + (32 * dt + c) * HS_TSTR + (16 * ks + 8 * h) * 2), bv = *(const LAS bf16x8*)(L + HS_VT + (32 * w4 + c) * HS_TSTR + (16 * ks + 8 * h) * 2);
                St[dt] = __builtin_amdgcn_mfma_f32_32x32x16_bf16(a, bv, St[dt], 0, 0, 0);
            }
#pragma unroll
        for (int dt = 0; dt < 4; ++dt)
#pragma unroll
            for (int g = 0; g < 4; ++g) { const f32x4 e = *(const LAS f32x4*)(L + HS_E2 + (32 * dt + 8 * g + 4 * h) * 4);
#pragma unroll
                for (int q = 0; q < 4; ++q) St[dt][4 * g + q] *= e[q]; }
        { const int pos = 32 * ch + c, t = dir == 0 ? pos : S - 1 - pos; float* op = OD + (size_t)(rowbase + t) * D + hd * 128 + 32 * w4 + 4 * h;
#pragma unroll
            for (int g = 0; g < 4; ++g) *(f32x4*)(op + 8 * g) = (f32x4){OT[4 * g], OT[4 * g + 1], OT[4 * g + 2], OT[4 * g + 3]}; }
        __syncthreads();
    }
    if (!samp) { float* so = C.out + 8388608 + 2 * 2097152 + ((((size_t)sq * 2 + dir) * 8 + hd) * 128) * 128;
        int c2 = c, h2 = h; asm volatile("" : "+v"(c2), "+v"(h2));
        unsigned base = (unsigned)((4 * h2) * 128 + 32 * w4 + c2);
#pragma unroll
        for (int dt = 0; dt < 4; ++dt)
#pragma unroll
            for (int r = 0; r < 16; ++r) so[base + (unsigned)((32 * dt + (r & 3) + 8 * (r >> 2)) * 128)] = St[dt][r]; }
}
__device__ __forceinline__ void phase_hscan(const Ctx& C) {
    if (C.G == 256) {
        hscan_item(C, C.bid);
        if (C.bid >= 64 && C.bid < 128) hscan_item(C, 256 + (C.bid - 64));
    } else for (int it = C.bid; it < 320; it += C.G) hscan_item(C, it);
}
__device__ __forceinline__ void phase_hpost(const Ctx& C) {
    const int gw = C.bid * NWAVES + C.wave, NGW = C.G * NWAVES;
    for (int r = gw; r < M; r += NGW) {
        const size_t off = (size_t)r * D + 16 * C.lane; float o[16]; float sq = 0.f;
#pragma unroll
        for (int q = 0; q < 4; ++q) { const f32x4 a = *(const f32x4*)(C.f(SCR_OF) + off + 4 * q), b = *(const f32x4*)(C.f(SCR_OB) + off + 4 * q);
#pragma unroll
            for (int e = 0; e < 4; ++e) { o[4 * q + e] = a[e] + b[e]; sq += o[4 * q + e] * o[4 * q + e]; } }
        sq += __shfl_xor(sq, 1); sq += __shfl_xor(sq, 2); sq += __shfl_xor(sq, 4);
        const float rs = rsqrtf(sq * (1.f / 128.f) + EPS);
        const u32x4 g0 = *(const u32x4*)(C.h(SCR_HG) + off), g1 = *(const u32x4*)(C.h(SCR_HG) + off + 8);
        const float* gn = C.in(17) + (16 * C.lane & 127);
        float sg[16];
#pragma unroll
        for (int e = 0; e < 4; ++e) { sg[2 * e] = bflo(g0[e]); sg[2 * e + 1] = bfhi(g0[e]); sg[8 + 2 * e] = bflo(g1[e]); sg[8 + 2 * e + 1] = bfhi(g1[e]); }
        u32x4 w0, w1;
#pragma unroll
        for (int e = 0; e < 4; ++e) { w0[e] = cvtpk(o[2 * e] * rs * gn[2 * e] * sg[2 * e], o[2 * e + 1] * rs * gn[2 * e + 1] * sg[2 * e + 1]);
            w1[e] = cvtpk(o[8 + 2 * e] * rs * gn[8 + 2 * e] * sg[8 + 2 * e], o[8 + 2 * e + 1] * rs * gn[8 + 2 * e + 1] * sg[8 + 2 * e + 1]); }
        *(u32x4*)(C.h(SCR_AWO) + off) = w0; *(u32x4*)(C.h(SCR_AWO) + off + 8) = w1;
    }
}

constexpr int SS_RSTR = 512;
constexpr int SS_WAVE = 16 * SS_RSTR;
__device__ __forceinline__ void sscan_seq(const Ctx& C, int l, bool samp, int sq, int dir, int g, size_t ydbg) {
    const int lane = C.lane, c = lane & 31, h = lane >> 5, dg = dir * 64 + g;
    const int S = samp ? 1024 : 256, rowbase = samp ? MP + sq * 1024 : sq * 256, nchunk = S >> 5, cond = samp ? 1 + sq : 0;
    LAS unsigned char* LB = C.lds + C.wave * SS_WAVE; LAS unsigned char* LH = LB + 4096;
    const float* X = C.f(WS_X); const u64_t* ss = (const u64_t*)(C.ws + WS_SS) + (size_t)(l * 2) * M; float* Y = C.f(ydbg ? ydbg : (dir == 0 ? SCR_YF : SCR_YB)); const bool ywr = !ydbg || dir == 0;
    bf16x8 bfr[4], cfr[4];
#pragma unroll
    for (int ct = 0; ct < 4; ++ct) bfr[ct] = *(const bf16x8*)(C.h(WS_SBB) + ((size_t)dg * 128 + 32 * ct + c) * 16 + 8 * h);
#pragma unroll
    for (int s = 0; s < 4; ++s) cfr[s] = *(const bf16x8*)(C.h(WS_SCB) + ((size_t)dg * 16 + (lane & 15)) * 128 + 32 * s + 8 * (lane >> 4));
    const float lr = C.f(WS_SLAM)[2 * (dg * 64 + lane)], li = C.f(WS_SLAM)[2 * (dg * 64 + lane) + 1];
    f32x4 gm0, gm1, sh0, sh1;
    { const float* gm = C.f(WS_GMOD) + ((size_t)(l * 2) * 5 + cond) * 1024 + g * 16 + 8 * h; gm0 = *(const f32x4*)gm; gm1 = *(const f32x4*)(gm + 4);
      const float* sh = C.f(WS_MOD) + ((size_t)l * 5 + cond) * 6144 + g * 16 + 8 * h; sh0 = *(const f32x4*)sh; sh1 = *(const f32x4*)(sh + 4); }
    float hr = 0.f, hi = 0.f;
    if (samp) { const float* s0 = C.in(5) + ((((size_t)sq * 2 + dir) * 64 + g) * 64 + lane) * 2; hr = s0[0]; hi = s0[1]; }
    for (int ch = 0; ch < nchunk; ++ch) {
        const int pos = 32 * ch + c, t = dir == 0 ? pos : S - 1 - pos, r = rowbase + t;
        const float rs = rstd_of(ss, r);
        const f32x4 x0 = *(const f32x4*)(X + (size_t)r * D + g * 16 + 8 * h), x1 = *(const f32x4*)(X + (size_t)r * D + g * 16 + 8 * h + 4);
        const f32x4 u0 = x0 * rs * gm0 + sh0, u1 = x1 * rs * gm1 + sh1;
        u32x4 uw = {cvtpk(u0[0], u0[1]), cvtpk(u0[2], u0[3]), cvtpk(u1[0], u1[1]), cvtpk(u1[2], u1[3])};
        const bf16x8 uf = __builtin_bit_cast(bf16x8, uw);
        f32x16 bu[4];
#pragma unroll
        for (int ct = 0; ct < 4; ++ct) { bu[ct] = (f32x16){}; bu[ct] = __builtin_amdgcn_mfma_f32_32x32x16_bf16(uf, bfr[ct], bu[ct], 0, 0, 0); }
#pragma unroll
        for (int hf = 0; hf < 2; ++hf) {
#pragma unroll
            for (int t8 = 0; t8 < 2; ++t8) {
#pragma unroll
                for (int ct = 0; ct < 4; ++ct)
#pragma unroll
                    for (int r4 = 0; r4 < 4; ++r4) *(LAS float*)(LB + (4 * h + r4) * 512 + (32 * ct + c) * 4) = bu[ct][8 * hf + 4 * t8 + r4];
                float br[8], bi[8]; unsigned wv[8];
#pragma unroll
                for (int k = 0; k < 8; ++k) { br[k] = *(LAS float*)(LB + k * 512 + lane * 4); bi[k] = *(LAS float*)(LB + k * 512 + 256 + lane * 4); }
#pragma unroll
                for (int k = 0; k < 8; ++k) { const float nr = lr * hr - li * hi + br[k], ni = lr * hi + li * hr + bi[k]; hr = nr; hi = ni; wv[k] = cvtpk(hr, hi); }
#pragma unroll
                for (int k = 0; k < 8; ++k) { const int row = 8 * t8 + k;
                    *(LAS unsigned short*)(LH + row * 256 + ((((lane >> 3)) ^ row) << 4) + (lane & 7) * 2) = (unsigned short)(wv[k] & 0xffffu);
                    *(LAS unsigned short*)(LH + row * 256 + (((8 + (lane >> 3)) ^ row) << 4) + (lane & 7) * 2) = (unsigned short)(wv[k] >> 16); }
                LDS_WAIT();
            }
            f32x4 y0 = {};
#pragma unroll
            for (int s = 0; s < 4; ++s) {
                const bf16x8 a0 = *(const LAS bf16x8*)(LH + (lane & 15) * 256 + (((4 * s + (lane >> 4)) ^ (lane & 15)) << 4));
                y0 = __builtin_amdgcn_mfma_f32_16x16x32_bf16(a0, cfr[s], y0, 0, 0, 0);
            }
            if (ywr) {
#pragma unroll
                for (int q = 0; q < 4; ++q) { const int p0 = 32 * ch + 16 * hf + 4 * (lane >> 4) + q, t0 = dir == 0 ? p0 : S - 1 - p0; Y[(size_t)(rowbase + t0) * D + g * 16 + (lane & 15)] = y0[q]; }
            }
            LDS_WAIT();
        }
    }
    if (!samp && !ydbg) { float* so = C.out + 8388608 + 2 * 2097152 + 4194304 + ((((size_t)sq * 2 + dir) * 64 + g) * 64 + lane) * 2; so[0] = hr; so[1] = hi; }
}
__device__ __forceinline__ void phase_sscan(const Ctx& C, int l, size_t ydbg) {
    for (int bb = C.bid; bb < 256; bb += C.G) {
        const int w = C.wave;
#ifdef SS_ONLYWAVE
        if (ydbg && !((SS_ONLYWAVE >> w) & 1)) continue;
#endif
        if (w < 2) { const int id = 2 * bb + w; sscan_seq(C, l, true, id >> 7, (id >> 6) & 1, id & 63, ydbg); }
        else { int id = 8 * bb + (w - 2); sscan_seq(C, l, false, id >> 7, (id >> 6) & 1, id & 63, ydbg);
            if (w < 4) { id = 8 * bb + 6 + (w - 2); sscan_seq(C, l, false, id >> 7, (id >> 6) & 1, id & 63, ydbg); } }
    }
}
__device__ __forceinline__ void phase_spost(const Ctx& C, int l) {
    const int gw = C.bid * NWAVES + C.wave, NGW = C.G * NWAVES; const u64_t* ss = (const u64_t*)(C.ws + WS_SS) + (size_t)(l * 2) * M;
    for (int r = gw; r < M; r += NGW) {
        const int cond = cond_of_row(r); const float rs = rstd_of(ss, r);
#pragma unroll
        for (int jq = 0; jq < 4; ++jq) {
            const int n = 4 * C.lane + 256 * jq; const size_t off = (size_t)r * D + n;
            const f32x4 x = *(const f32x4*)(C.f(WS_X) + off), gm = *(const f32x4*)(C.f(WS_GMOD) + ((size_t)(l * 2) * 5 + cond) * 1024 + n), sh = *(const f32x4*)(C.f(WS_MOD) + ((size_t)l * 5 + cond) * 6144 + n);
            const f32x4 u = x * rs * gm + sh, y = *(const f32x4*)(C.in(26) + n) * u + *(const f32x4*)(C.f(SCR_YF) + off) + *(const f32x4*)(C.f(SCR_YB) + off);
            f32x4 o;
#pragma unroll
            for (int e = 0; e < 4; ++e) { const float v = y[e], uu = 0.7978845608028654f * (v + 0.044715f * v * v * v); const float th = 1.f - 2.f / (1.f + __expf(2.f * uu)); o[e] = 0.5f * v * (1.f + th); }
            st_bf16x4(C.h(SCR_AGLU) + off, o);
        }
    }
}
#define XB_TMO      128
#define XB_XCNT(j)  (256  + 64 * (j))
#define XB_XSUB(j)  (1280 + 64 * (j))
#define XB_XGEN(j)  (2304 + 64 * (j))
#define XB_TOP      3328
#define XB_TOPGEN   3392
#define XCD_BAR_WORDS 3456
#define XB_SPIN_CAP (1u << 18)
#ifndef XB_SCOPE
#define XB_SCOPE "agent"
#endif
__device__ __forceinline__ unsigned xb_ld(unsigned* p)              { return __hip_atomic_load(p, __ATOMIC_RELAXED, __HIP_MEMORY_SCOPE_AGENT); }
__device__ __forceinline__ unsigned xb_add(unsigned* p, unsigned v) { return __hip_atomic_fetch_add(p, v, __ATOMIC_RELAXED, __HIP_MEMORY_SCOPE_AGENT); }
__device__ __forceinline__ unsigned xb_xcc_id() { return (unsigned)__builtin_amdgcn_s_getreg((3 << 11) | 20) & 0xFu; }
#define XB_SPIN(cond, bar) do { unsigned _sp = 0; while (cond) { __builtin_amdgcn_s_sleep(1); \
    if ((++_sp & 255u) == 0u) { if (xb_ld(&(bar)[XB_TMO])) break; if (_sp > XB_SPIN_CAP) { atomicAdd(&(bar)[XB_TMO], 1u); break; } } } } while (0)
struct XcdBarrier { unsigned* bar; unsigned x; volatile LAS unsigned* st; };
__device__ __forceinline__ XcdBarrier xcd_barrier_post(unsigned* bar, volatile LAS unsigned* st) {
    XcdBarrier b; b.bar = bar; b.x = xb_xcc_id(); b.st = st;
    if (threadIdx.x == 0) (void)xb_add(&bar[XB_XCNT(b.x)], 1u);
    return b;
}
__device__ __forceinline__ void xcd_barrier_complete(unsigned* bar, unsigned x, unsigned& nloc, unsigned& nx) {
    const unsigned G = gridDim.x * gridDim.y * gridDim.z;
    unsigned sum, cnt, mine, sp = 0u;
    for (;;) {
        sum = 0u; cnt = 0u; mine = 0u;
#pragma unroll
        for (unsigned j = 0; j < 16; ++j) { const unsigned c = xb_ld(&bar[XB_XCNT(j)]); sum += c; cnt += (c > 0u) ? 1u : 0u; mine = (j == x) ? c : mine; }
        if (sum == G) break;
        __builtin_amdgcn_s_sleep(1);
        if ((++sp & 255u) == 0u) { if (xb_ld(&bar[XB_TMO])) break; if (sp > XB_SPIN_CAP) { atomicAdd(&bar[XB_TMO], 1u); break; } }
    }
    nloc = mine > 0u ? mine : 1u; nx = cnt > 0u ? cnt : 1u;
}
__device__ __forceinline__ void xcd_barrier(const XcdBarrier& b, bool thread0) {
    asm volatile("s_waitcnt vmcnt(0)" ::: "memory");
    __syncthreads();
    if (thread0) {
        unsigned* bar = b.bar;
        __builtin_amdgcn_s_waitcnt(0);
        unsigned nloc = b.st[0], nx = b.st[1];
        if (nloc == 0u) { xcd_barrier_complete(bar, b.x, nloc, nx); b.st[0] = nloc; b.st[1] = nx; }
#ifdef XB_ALL_RELEASE
        __builtin_amdgcn_fence(__ATOMIC_RELEASE, XB_SCOPE); asm volatile("s_waitcnt vmcnt(0)" ::: "memory");
#endif
        const unsigned old = xb_add(&bar[XB_XSUB(b.x)], 1u);
        const unsigned gen = old / nloc;
        if (old + 1u == (gen + 1u) * nloc) {
            __builtin_amdgcn_fence(__ATOMIC_RELEASE, XB_SCOPE);
            asm volatile("s_waitcnt vmcnt(0)" ::: "memory");
            const unsigned og = xb_add(&bar[XB_TOP], 1u);
            const unsigned tg = og / nx;
            if (og + 1u == (tg + 1u) * nx) xb_add(&bar[XB_TOPGEN], 1u);
            else XB_SPIN(xb_ld(&bar[XB_TOPGEN]) == tg, bar);
            __builtin_amdgcn_fence(__ATOMIC_ACQUIRE, XB_SCOPE);
            xb_add(&bar[XB_XGEN(b.x)], 1u);
            asm volatile("s_waitcnt vmcnt(0)" ::: "memory");
        } else {
            XB_SPIN(xb_ld(&bar[XB_XGEN(b.x)]) == gen, bar);
            __builtin_amdgcn_fence(__ATOMIC_ACQUIRE, XB_SCOPE);
            asm volatile("s_waitcnt vmcnt(0)" ::: "memory");
        }
#ifdef XB_DELAY
        for (int q = 0; q < XB_DELAY; ++q) __builtin_amdgcn_s_sleep(127);
#endif
    }
    __syncthreads();
}
}
namespace om {
enum { PH_P0A = 0, PH_P0C, PH_GLUE, PH_QKV, PH_ATTN, PH_WO, PH_HIN, PH_HSCAN, PH_HPOST, PH_HWO, PH_SSCAN, PH_SPOST, PH_GLU, PH_UP, PH_CONV, PH_DOWN, PH_FINAL };

struct Args { const float* in[33]; float* out; unsigned char* ws; int nph; int pad; unsigned char ptype[160]; unsigned char parg[160]; };

__device__ __forceinline__ void down_patch(const Ctx& C, int l, const pg8::StaticOrder& S) {
    Unit u; const float* cw = C.in(29) + (size_t)l * 3 * NUP; const float* E0 = C.f(WS_EDGE); bf16_t* act = C.h(WS_ACT);
    for (int i = 0; S.next(i, u); ++i) {
        if (u.pm < 16) continue;
        const bool top = (u.pm & 3) != 0, bot = (u.pm & 3) != 3;
        for (int n = C.tid; n < DFF; n += NTHREADS) {
            if (top) { const float* e = E0 + ((size_t)((u.pm - 16) * 2 + 0) * 4) * DFF; const float* ep = E0 + ((size_t)((u.pm - 17) * 2 + 1) * 4) * DFF;
                const float hg = e[n] + cw[n] * ep[2 * DFF + n], hv = e[DFF + n] + cw[DFF + n] * ep[3 * DFF + n];
                act[(size_t)(u.pm * 256) * DFF + n] = (bf16_t)(cvtpk(hg * sigm(hg) * hv, 0.f) & 0xffffu); }
            if (bot) { const float* e = E0 + ((size_t)((u.pm - 16) * 2 + 1) * 4) * DFF; const float* en = E0 + ((size_t)((u.pm - 15) * 2 + 0) * 4) * DFF;
                const float hg = e[n] + cw[2 * NUP + n] * en[2 * DFF + n], hv = e[DFF + n] + cw[2 * NUP + DFF + n] * en[3 * DFF + n];
                act[(size_t)(u.pm * 256 + 255) * DFF + n] = (bf16_t)(cvtpk(hg * sigm(hg) * hv, 0.f) & 0xffffu); }
        }
    }
    asm volatile("s_waitcnt vmcnt(0)" ::: "memory"); __syncthreads();
}
__device__ __forceinline__ void run_phase(const Ctx& C0, int type, int arg, int epoch) {
    Ctx C = C0; asm volatile("" : "+v"(C.tid)); asm volatile("" : "+s"(C.bid), "+s"(C.G), "+s"(C.kp), "+s"(C.ws), "+s"(C.out));
    C.lane = C.tid & 63; C.wave = __builtin_amdgcn_readfirstlane(C.tid >> 6);
    const int l = arg & 3;
    if (type == 31) return;
#ifndef PHASE_MASK
#define PHASE_MASK 0xFFFFFFFFu
#endif
    if (!((PHASE_MASK >> type) & 1u)) return;
    pg8::Gemm g{nullptr, nullptr, D, 256, 128, D, 0}; int nN = 0; EpiAny E{}; E.ws = C.ws; E.out = C.out; E.l = l; E.epoch = epoch;
    const bool splitk = false;
    switch (type) {
    case PH_P0A: phase_p0a(C); break;
    case PH_P0C: phase_p0c(C); break;
    case PH_GLUE: phase_glue(C, arg >> 1, arg & 1); break;
    case PH_QKV: { g.A = C.h(WS_AP); g.Bt = C.h(WS_WQKV) + (size_t)(l / 3) * NQKV * D; nN = 6; E.kind = EK_QKV; } break;
    case PH_ATTN: phase_attn(C, l, (arg & 32) ? SCR_O + 96 * MiB : SCR_O); break;
#ifdef DBG
    case 17: phase_chk(C, SCR_O, SCR_O + 96 * MiB, 16 * MiB); break;
#endif
#ifdef DBG
    case 18: phase_cks(C, arg); break;
#endif
#ifdef DBG
    case 19: phase_cmp(C, arg); break;
#endif
#ifdef DBG
    case 20: phase_clr(C); break;
#endif
    case PH_WO: case PH_HWO: case PH_GLU: {
        if (type == PH_WO) { g.A = C.h(SCR_O); g.Bt = C.h(WS_WO) + (size_t)(l / 3) * D * D; nN = 4; E.kind = EK_RES; if (splitk) { g.split = 1; g.K = D / 2; nN = 8; } }
        else if (type == PH_HWO) { g.A = C.h(SCR_AWO); g.Bt = C.h(WS_HWO); nN = 4; E.kind = EK_RES; if (splitk) { g.split = 1; g.K = D / 2; nN = 8; } }
        else { g.A = C.h(SCR_AGLU); g.Bt = C.h(WS_GLU); g.b_tile_rows = 128; g.b_half_rows = 1024; nN = 8; E.kind = EK_RES_GLU; }
        E.flags = ((arg & 32) ? 4 : 0) | (type == PH_HWO ? 8 : 0); } break;
    case PH_HIN: { g.A = C.h(WS_AP); g.Bt = C.h(WS_HWIN); nN = 20; E.kind = EK_HIN; } break;
    case PH_HSCAN: phase_hscan(C); break;
    case PH_HPOST: phase_hpost(C); break;
    case PH_SSCAN: phase_sscan(C, l, (arg & 32) ? WS_SCR + 80 * MiB : ((arg & 64) ? WS_SCR + 112 * MiB : 0)); break;
#ifdef DBG
    case 22: phase_clr2(C, WS_SCR + 80 * MiB, 64 * MiB); break;
#endif
#ifdef DBG
    case 21: phase_chk(C, WS_SCR + 80 * MiB, WS_SCR + 112 * MiB, 32 * MiB); break;
#endif
    case PH_SPOST: phase_spost(C, l); break;
    case PH_UP: { g.A = C.h(WS_AP); g.Bt = C.h(WS_UP) + (size_t)l * NUP * D; g.b_tile_rows = 128; g.b_half_rows = DFF; nN = 22; E.kind = EK_UPCONV; E.in29 = C.in(29); E.in30 = C.in(30); } break;
#ifdef DBG
    case 23: phase_chk(C, WS_SCR, WS_SCR + 88 * MiB, 88 * MiB); break;
#endif
    case PH_CONV: phase_conv(C, l); break;
    case PH_DOWN: { if (l < 3 && C.G == 256 && C.bid >= 128) convert_layer(C, l + 1, C.bid - 128, 128);
        { pg8::StaticOrder S0; S0.init(32, splitk ? 8 : 4, C.G, C.bid); down_patch(C, l, S0); }
        g.A = C.h(WS_ACT); g.Bt = C.h(WS_DOWN) + (size_t)l * D * DFF; g.K = DFF; g.ld = DFF; nN = 4; if (splitk) { g.split = 1; g.K = DFF / 2; nN = 8; } E.kind = EK_RES; E.flags = 1 | ((arg & 16) ? 2 : 0) | ((arg & 32) ? 4 : 0); } break;
    case PH_FINAL: { const unsigned fl = __hip_atomic_load((unsigned*)(C.ws + WS_CTL) + 4000, __ATOMIC_RELAXED, __HIP_MEMORY_SCOPE_AGENT), fd = __hip_atomic_load((unsigned*)(C.ws + WS_CTL) + 4001, __ATOMIC_RELAXED, __HIP_MEMORY_SCOPE_AGENT);
        #ifdef SSDET_CLS
        const unsigned cls = __hip_atomic_load((unsigned*)(C.ws + WS_CTL) + 4002, __ATOMIC_RELAXED, __HIP_MEMORY_SCOPE_AGENT), cnt = __hip_atomic_load((unsigned*)(C.ws + WS_CTL) + 4003, __ATOMIC_RELAXED, __HIP_MEMORY_SCOPE_AGENT);
        phase_final(C, 1.f + (float)cls / 8.f + (float)(cnt > 63 ? 63 : cnt) / 1024.f); } break;
#else
        phase_final(C, fl ? 3.f : (fd ? exp2f((float)(1001 - fd)) : 1.f)); } break;
#endif
    default: break;
    }
    if (nN) { pg8::StaticOrder S; S.init(32, nN, C.G, C.bid); pg8::gemm_phase(C.lds, g, S, E, C.tid); }
}

__device__ __forceinline__ void canary(const Ctx& C0, unsigned char* ws, int i, bool check) {
    int tid = C0.tid; asm volatile("" : "+v"(tid)); const int lane = tid & 63, wave = tid >> 6;
    unsigned* can = (unsigned*)(ws + WS_CTL + 32768);
#ifdef CANARY_SC1
    if (!check) { if (wave == 0 && lane < 32) __hip_atomic_store(can + C0.bid * 32 + lane, (unsigned)(i + 1), __ATOMIC_RELAXED, __HIP_MEMORY_SCOPE_AGENT); }
#else
    if (!check) { if (wave == 0 && lane < 32) can[C0.bid * 32 + lane] = (unsigned)(i + 1); }
#endif
#ifdef CANARY_LD_SC1
    else { const unsigned v = __hip_atomic_load(can + (wave * 32 + (lane >> 1)) * 32 + (lane & 1) * 16, __ATOMIC_RELAXED, __HIP_MEMORY_SCOPE_AGENT);
#else
    else { const unsigned v = can[(wave * 32 + (lane >> 1)) * 32 + (lane & 1) * 16];
#endif
      if (v != (unsigned)(i + 1) && v != (unsigned)(i + 2)) atomicAdd((unsigned*)(ws + WS_CTL) + 4000, 1u); }
}
__global__ void __launch_bounds__(NTHREADS, 2) mk_fwd(Args a) {
    extern __shared__ __attribute__((aligned(16))) unsigned char lds[];
    int wave_s = __builtin_amdgcn_readfirstlane((int)(threadIdx.x >> 6));
    { volatile LAS unsigned* misc = (volatile LAS unsigned*)((LAS unsigned char*)lds + LDS_BYTES - 64); if (threadIdx.x < 16) misc[threadIdx.x] = 0u; }
    __syncthreads();
    (void)xcd_barrier_post((unsigned*)(a.ws + WS_CTL), (volatile LAS unsigned*)((LAS unsigned char*)lds + LDS_BYTES - 64));
    for (int i = 0; i < a.nph; ++i) {
        {
            Ctx C; C.kp = (const unsigned char __attribute__((address_space(4)))*)__builtin_amdgcn_kernarg_segment_ptr();
            C.out = a.out; C.ws = a.ws; C.lds = (LAS unsigned char*)lds; asm volatile("" : "+s"(wave_s)); C.tid = (wave_s << 6) | (int)__builtin_amdgcn_mbcnt_hi(~0u, __builtin_amdgcn_mbcnt_lo(~0u, 0u)); C.lane = C.tid & 63; C.wave = 0; C.G = gridDim.x; C.bid = blockIdx.x;
            run_phase(C, a.ptype[i], a.parg[i], i + 1);
#ifdef CANARY
            canary(C, a.ws, i, false);
#endif
        }
        if (i + 1 < a.nph) { XcdBarrier bar; bar.bar = (unsigned*)(a.ws + WS_CTL); bar.x = xb_xcc_id(); bar.st = (volatile LAS unsigned*)((LAS unsigned char*)lds + LDS_BYTES - 64); xcd_barrier(bar, wave_s == 0 && lane_id() == 0); }
#ifdef CANARY
        if (i + 1 < a.nph) { Ctx C; C.tid = (wave_s << 6) | lane_id(); C.bid = blockIdx.x; canary(C, a.ws, i, true); }
#endif
    }
}
}
extern "C" void kernel_launch(void* const* d_in, const int* in_sizes, int n_in, void* d_out, int out_size, void* d_ws, size_t ws_size, hipStream_t stream) {
    using namespace om;
    static int grid = 0;
    if (grid == 0) {
        if (n_in != 33 || out_size != 17039360 || ws_size < WS_END) { fprintf(stderr, "kernel_launch: unexpected sizes n_in %d out %d ws %zu; nothing launched\n", n_in, out_size, ws_size); grid = -1; return; }
        int dev = 0, cus = 0, per_cu = 0;
        (void)hipGetDevice(&dev); (void)hipDeviceGetAttribute(&cus, hipDeviceAttributeMultiprocessorCount, dev);
        (void)hipFuncSetAttribute((const void*)mk_fwd, hipFuncAttributeMaxDynamicSharedMemorySize, LDS_BYTES);
        if (hipOccupancyMaxActiveBlocksPerMultiprocessor(&per_cu, (const void*)mk_fwd, NTHREADS, LDS_BYTES) != hipSuccess || per_cu < 1) { fprintf(stderr, "kernel_launch: occupancy query gives %d blocks per CU\n", per_cu); per_cu = 1; }
        (void)hipGetLastError();
        grid = cus;
        if (grid > 256) grid = 256;
    }
    if (grid < 0) return;
    (void)hipMemsetAsync((char*)d_ws + WS_CTL, 0, CTL_ZERO_BYTES, stream);
    Args a{};
    for (int i = 0; i < 33; ++i) a.in[i] = (const float*)d_in[i];
    a.out = (float*)d_out; a.ws = (unsigned char*)d_ws;
    int n = 0;
#ifndef DUP_MASK
#define DUP_MASK 0u
#endif
#ifndef XBAR
#define XBAR 0
#endif
    auto add1 = [&](int t, int p) { a.ptype[n] = (unsigned char)t; a.parg[n] = (unsigned char)p; ++n; };
    auto add = [&](int t, int p) { add1(t, p);
        if ((DUP_MASK >> t) & 1u) { const bool resid = (t == PH_WO || t == PH_HWO || t == PH_GLU || t == PH_DOWN); add1(t, resid ? (p | 32) : p); }
        for (int q = 0; q < XBAR; ++q) add1(31, 0); };
#ifdef UPDET
    add1(PH_P0A, 0); add1(PH_P0C, 0);
    for (int l = 0; l < 4; ++l) { const int kind = l % 3;
        if (kind == 0) { add1(PH_QKV, l); add1(PH_ATTN, l); add1(PH_WO, l); }
        else if (kind == 1) { add1(PH_HIN, l); add1(PH_HSCAN, l); add1(PH_HPOST, l); add1(PH_HWO, l); }
        else { add1(PH_SSCAN, l); add1(PH_SPOST, l); add1(PH_GLU, l); }
        add1(PH_UP, l); add1(PH_UP, l | 32); add1(23, 0); add1(PH_CONV, l); add1(PH_DOWN, l == 3 ? (l | 16) : l); }
    add1(PH_FINAL, 0);
#elif defined(SSDET)
    add1(PH_P0A, 0); add1(PH_P0C, 0);
    for (int l = 0; l < 4; ++l) { const int kind = l % 3;
        if (kind == 0) { add1(PH_QKV, l); add1(PH_ATTN, l); add1(PH_WO, l); }
        else if (kind == 1) { add1(PH_HIN, l); add1(PH_HSCAN, l); add1(PH_HPOST, l); add1(PH_HWO, l); }
        else { add1(22, 0); add1(PH_SSCAN, l | 32); add1(PH_SSCAN, l | 64); add1(21, 0); add1(PH_SSCAN, l); add1(PH_SPOST, l); add1(PH_GLU, l); }
        add1(PH_UP, l); add1(PH_DOWN, l == 3 ? (l | 16) : l); }
    add1(PH_FINAL, 0);
#elif defined(LOCALIZE)
    for (int fwd = 0; fwd < 2; ++fwd) { int idx = 0;
        auto addc = [&](int t, int p) { add1(t, p); add1(18, fwd * 32 + idx); ++idx; };
        add1(20, 0); addc(PH_P0A, 0); addc(PH_P0C, 0);
        for (int l = 0; l < 4; ++l) { const int kind = l % 3;
            if (kind == 0) { addc(PH_QKV, l); addc(PH_ATTN, l); addc(PH_WO, l); }
            else if (kind == 1) { addc(PH_HIN, l); addc(PH_HSCAN, l); addc(PH_HPOST, l); addc(PH_HWO, l); }
            else { addc(PH_SSCAN, l); addc(PH_SPOST, l); addc(PH_GLU, l); }
            addc(PH_UP, l); addc(PH_DOWN, l == 3 ? (l | 16) : l); }
        if (fwd == 1) { add1(19, idx); add1(PH_FINAL, 0); } }
#else
    add(PH_P0A, 0); add(PH_P0C, 0);
    for (int l = 0; l < 4; ++l) {
        const int kind = l % 3;
        if (kind == 0) { add(PH_QKV, l); add(PH_ATTN, l); add(PH_WO, l); }
        else if (kind == 1) { add(PH_HIN, l); add(PH_HSCAN, l); add(PH_HPOST, l); add(PH_HWO, l); }
        else { add(PH_SSCAN, l); add(PH_SPOST, l); add(PH_GLU, l); }
        add(PH_UP, l); add(PH_DOWN, l == 3 ? (l | 16) : l);
    }
    add(PH_FINAL, 0);
#endif
    a.nph = n;
    void* args[] = {&a};
    const hipError_t e = hipLaunchCooperativeKernel((const void*)mk_fwd, dim3(grid), dim3(NTHREADS), args, LDS_BYTES, stream);
    if (e != hipSuccess) fprintf(stderr, "kernel_launch: cooperative launch failed: %s (grid %d)\n", hipGetErrorString(e), grid);
}
```

```cpp
#include <hip/hip_runtime.h>
#include <hip/hip_cooperative_groups.h>
#include <cstdio>
#include <cstdint>
#include <cmath>
#define LAS __attribute__((address_space(3)))
#define GAS __attribute__((address_space(1)))
typedef unsigned short bf16_t;
typedef short bf16x8 __attribute__((ext_vector_type(8)));
typedef short s16x4 __attribute__((ext_vector_type(4)));
typedef float f32x2 __attribute__((ext_vector_type(2)));
typedef float f32x4 __attribute__((ext_vector_type(4)));
typedef float f32x16 __attribute__((ext_vector_type(16)));
typedef unsigned u32x2 __attribute__((ext_vector_type(2)));
typedef unsigned u32x4 __attribute__((ext_vector_type(4)));
typedef __bf16 bf16x2_t __attribute__((ext_vector_type(2)));

namespace om {
constexpr int D = 1024, MP = 4096, M = 8192, DFF = 2816, NUP = 5632, NQKV = 1536, NHIN = 5120;
constexpr float EPS = 1e-6f, LOG2E = 1.4426950408889634f, QSCALE = 0.125f * 1.4426950408889634f;
constexpr int NTHREADS = 512, NWAVES = 8, LDS_BYTES = 147456, RING_BYTES = 131072;
constexpr int SW_STRIDE = 5632;
constexpr float SS_FIX = 16777216.f, SS_INV = 1.f / (16777216.f * 1024.f);
typedef unsigned long long u64_t;
__device__ __forceinline__ float rstd_of(const u64_t* ss, int r) { return rsqrtf((float)ss[r] * SS_INV + 1e-6f); }
constexpr size_t MiB = 1u << 20;
constexpr size_t WS_CTL = 0, CTL_ZERO_BYTES = 64 * 1024;
constexpr size_t WS_MODP = 1 * MiB, WS_MOD = 3 * MiB, WS_SW = 4 * MiB, WS_GMOD = 5 * MiB, WS_SS = 6 * MiB, WS_ROPE = 7 * MiB;
constexpr size_t WS_LB1 = 8 * MiB, WS_SLAM = 8 * MiB + 64 * 1024, WS_SBB = 8 * MiB + 512 * 1024, WS_SCB = 9 * MiB;
constexpr size_t WS_CTXK = 10 * MiB, WS_CTXV = 12 * MiB;
constexpr size_t WS_NAIVE_MOD = 14 * MiB;
constexpr size_t WS_WQKV = 16 * MiB, WS_WO = 22 * MiB, WS_HWIN = 26 * MiB, WS_HWO = 36 * MiB, WS_GLU = 38 * MiB, WS_UP = 42 * MiB, WS_DOWN = 86 * MiB;
constexpr size_t WS_X = 108 * MiB, WS_R = 140 * MiB;
constexpr size_t WS_AP = WS_R, WS_ACT = WS_R + 16 * MiB, WS_SCR = WS_R + 60 * MiB, WS_END = WS_SCR + 176 * MiB;

constexpr size_t SCR_Q = WS_SCR, SCR_KB = WS_SCR + 16 * MiB, SCR_VB = WS_SCR + 20 * MiB, SCR_O = WS_SCR + 24 * MiB;
constexpr size_t SCR_HQ = WS_SCR, SCR_HV = WS_SCR + 16 * MiB, SCR_HG = WS_SCR + 32 * MiB, SCR_LFF = WS_SCR + 48 * MiB, SCR_LFB = WS_SCR + 80 * MiB, SCR_OF = WS_SCR + 112 * MiB, SCR_OB = WS_SCR + 144 * MiB, SCR_AWO = WS_SCR;
constexpr size_t SCR_YF = WS_SCR, SCR_YB = WS_SCR + 32 * MiB, SCR_AGLU = WS_SCR + 64 * MiB;

__device__ __forceinline__ int cond_of_tile(int pm) { return pm < 16 ? 0 : 1 + ((pm - 16) >> 2); }
__device__ __forceinline__ int cond_of_row(int r) { return r < MP ? 0 : 1 + ((r - MP) >> 10); }
__device__ __forceinline__ unsigned cvtpk(float lo, float hi) { f32x2 v = {lo, hi}; bf16x2_t b = __builtin_convertvector(v, bf16x2_t); return __builtin_bit_cast(unsigned, b); }
__device__ __forceinline__ float bf2f(unsigned short h) { return __uint_as_float(((unsigned)h) << 16); }
__device__ __forceinline__ float bflo(unsigned w) { return __uint_as_float(w << 16); }
__device__ __forceinline__ float bfhi(unsigned w) { return __uint_as_float(w & 0xffff0000u); }
__device__ __forceinline__ float sigm(float x) { return __builtin_amdgcn_rcpf(1.f + __expf(-x)); }
__device__ __forceinline__ int lane_id() { return (int)__builtin_amdgcn_mbcnt_hi(~0u, __builtin_amdgcn_mbcnt_lo(~0u, 0u)); }
__device__ __forceinline__ float wave_sum(float v) {
#pragma unroll
    for (int o = 1; o < 64; o <<= 1) v += __shfl_xor(v, o);
    return v;
}

struct Ctx {
    const unsigned char __attribute__((address_space(4)))* kp;
    float* out; unsigned char* ws;
    LAS unsigned char* lds; int tid, lane, wave, G, bid;
    __device__ __forceinline__ const float* in(int i) const { return *(const float* const __attribute__((address_space(4)))*)(kp + 8 * i); }
    __device__ __forceinline__ float* f(size_t off) const { return (float*)(ws + off); }
    __device__ __forceinline__ bf16_t* h(size_t off) const { return (bf16_t*)(ws + off); }
};

namespace pg8 {
constexpr int BM = 256, BK = 64, HALF = 128, HTB = HALF * BK * 2, STAGE_BYTES = 8 * HTB, NXCD = 8, WGM = 8;
__host__ __device__ __forceinline__ int lds_byte(int r, int c) { const int st = (r >> 4) * 2 + (c >> 5), rr = r & 15, cc = c & 31, ob = rr * 64 + cc * 2; return st * 1024 + (ob ^ (((ob >> 9) & 1) << 5)); }
__host__ __device__ __forceinline__ void stage_rc(int b, int& R, int& C) { const int st = b / 1024, sb = b % 1024, swz = sb ^ (((sb >> 9) & 1) << 5); R = (st >> 1) * 16 + swz / 64; C = (st & 1) * 32 + (swz % 64) / 2; }
struct Unit { int pm, pn; };
struct Gemm { const bf16_t* A; const bf16_t* Bt; int K; int b_tile_rows, b_half_rows; int ld; int split; };
struct StaticOrder {
    int nM, nN, nwg, G, c;
    __device__ void init(int nM_, int nN_, int G_, int c_) { nM = nM_; nN = nN_; nwg = nM * nN; G = G_; c = c_; }
    __device__ bool next(int i, Unit& u) const {
        const long L = (long)i * G + c; if (L >= nwg) return false;
        int wgid = (int)L; { const int q = nwg / NXCD, r = nwg % NXCD, xcd = wgid % NXCD, off = wgid / NXCD; wgid = (xcd < r ? xcd * (q + 1) : r * (q + 1) + (xcd - r) * q) + off; }
        const int nig = WGM * nN, gid = wgid / nig, fm = gid * WGM, gsz = (nM - fm) < WGM ? (nM - fm) : WGM;
        u.pm = fm + ((wgid % nig) % gsz); u.pn = (wgid % nig) / gsz; return true;
    }
};
template <class Epi>
__device__ __forceinline__ void gemm_phase(LAS unsigned char* lds, const Gemm g, const StaticOrder& S, const Epi& E, int tid_in) {
    int tid_ = tid_in; asm volatile("" : "+v"(tid_));
    const int tid = tid_, wid = __builtin_amdgcn_readfirstlane(tid >> 6), lane = tid & 63, wr = wid >> 2, wc = wid & 3, fr = lane & 15, fq = lane >> 4;
    const int K = g.K, nt = K / BK, ld = g.ld;
    unsigned voffA[2];
#pragma unroll
    for (int i = 0; i < 2; ++i) { int R, C; stage_rc(tid * 16 + i * 8192, R, C); voffA[i] = (unsigned)(R * ld + C) * 2u; }
    const size_t kstep = (size_t)(BK * 2);
    const size_t hstepA = (size_t)HALF * ld * 2, tstepA = 2 * hstepA;
    const size_t hstepB = (size_t)g.b_half_rows * ld * 2, tstepB = (size_t)g.b_tile_rows * ld * 2, khb = (size_t)K * 2;
#define PG8_UA(u) ((const char*)g.A + (size_t)(u).pm * tstepA + (g.split ? (size_t)((u).pn & 1) * khb : 0))
#define PG8_UB(u) ((const char*)g.Bt + (size_t)(g.split ? (u).pn >> 1 : (u).pn) * tstepB + (g.split ? (size_t)((u).pn & 1) * khb : 0))
    const unsigned ldsw = (unsigned)wid * 1024u;
    const int aoff = lds_byte(wr * 64 + fr, fq * 8), boff = lds_byte(wc * 32 + fr, fq * 8);
#define PG8_SA(b, h) (((b) * 2 + (h)) * HTB)
#define PG8_SB(b, h) ((4 + (b) * 2 + (h)) * HTB)
#define PG8_STAGE(bufoff, gbase) do { _Pragma("unroll") for (int _i = 0; _i < 2; ++_i) \
        __builtin_amdgcn_global_load_lds((const unsigned*)((const char*)(gbase) + voffA[_i]), (LAS unsigned*)(lds + (bufoff) + ldsw + _i * 8192), 16, 0, 0); } while (0)
#define PG8_LDA(dst, b, h) do { _Pragma("unroll") for (int m = 0; m < 4; ++m) _Pragma("unroll") for (int k = 0; k < 2; ++k) dst[m][k] = *(const LAS bf16x8*)(lds + PG8_SA(b, h) + aoff + m * 2048 + k * 1024); } while (0)
#define PG8_LDB(dst, b, h) do { _Pragma("unroll") for (int n = 0; n < 2; ++n) _Pragma("unroll") for (int k = 0; k < 2; ++k) dst[n][k] = *(const LAS bf16x8*)(lds + PG8_SB(b, h) + boff + n * 2048 + k * 1024); } while (0)
#define PG8_MMA(ai, bj, At, Bt) do { __builtin_amdgcn_s_setprio(1); _Pragma("unroll") for (int m = 0; m < 4; ++m) _Pragma("unroll") for (int n = 0; n < 2; ++n) _Pragma("unroll") for (int k = 0; k < 2; ++k) \
        acc[ai][bj][m][n] = __builtin_amdgcn_mfma_f32_16x16x32_bf16(Bt[n][k], At[m][k], acc[ai][bj][m][n], 0, 0, 0); __builtin_amdgcn_s_setprio(0); } while (0)
#define PG8_WAIT_V(n) asm volatile("s_waitcnt vmcnt(" #n ")" ::: "memory")
#define PG8_WAIT_L(n) asm volatile("s_waitcnt lgkmcnt(" #n ")" ::: "memory")
#define PG8_BAR __builtin_amdgcn_s_barrier()
#define PG8_SCHED __builtin_amdgcn_sched_barrier(0)
    Unit cur, nxt; int ui = 0;
    if (!S.next(0, cur)) return;
    f32x4 acc[2][2][4][2];
#pragma unroll
    for (int a = 0; a < 2; ++a)
#pragma unroll
        for (int b = 0; b < 2; ++b)
#pragma unroll
            for (int m = 0; m < 4; ++m)
#pragma unroll
                for (int n = 0; n < 2; ++n) acc[a][b][m][n] = (f32x4){0.f, 0.f, 0.f, 0.f};
    bf16x8 At[4][2], B0[2][2], B1[2][2];
    const char* cA = PG8_UA(cur); const char* cB = PG8_UB(cur);
    PG8_STAGE(PG8_SB(0, 0), cB); PG8_STAGE(PG8_SB(0, 1), cB + hstepB); PG8_STAGE(PG8_SA(0, 0), cA); PG8_STAGE(PG8_SA(0, 1), cA + hstepA);
    if (wr == 1) PG8_BAR;
    PG8_WAIT_V(2); PG8_BAR;
    PG8_STAGE(PG8_SB(1, 0), cB + kstep); PG8_STAGE(PG8_SA(1, 0), cA + kstep); PG8_STAGE(PG8_SB(1, 1), cB + hstepB + kstep);
    PG8_WAIT_V(6); PG8_BAR;
    for (;;) {
        const bool has_next = S.next(ui + 1, nxt);
        const char* nA = has_next ? PG8_UA(nxt) : cA; const char* nB = has_next ? PG8_UB(nxt) : cB;
        for (int t = 0; t < nt; t += 2) {
            const bool last = (t == nt - 2);
            const char* a1 = cA + (size_t)(t + 1) * kstep;
            const char* a2 = last ? nA : cA + (size_t)(t + 2) * kstep; const char* b2 = last ? nB : cB + (size_t)(t + 2) * kstep;
            const char* a3 = a2 + kstep; const char* b3 = b2 + kstep;
            PG8_LDB(B0, 0, 0); PG8_LDB(B1, 0, 1); PG8_SCHED; PG8_LDA(At, 0, 0); PG8_STAGE(PG8_SA(1, 1), a1 + hstepA);
            PG8_WAIT_V(8); PG8_WAIT_L(0); PG8_BAR; PG8_MMA(0, 0, At, B0); PG8_MMA(0, 1, At, B1); PG8_BAR; PG8_SCHED;
            PG8_LDA(At, 0, 1); PG8_STAGE(PG8_SB(0, 0), b2); PG8_STAGE(PG8_SB(0, 1), b2 + hstepB); PG8_STAGE(PG8_SA(0, 0), a2);
            PG8_WAIT_V(8); PG8_WAIT_L(0); PG8_BAR; PG8_MMA(1, 0, At, B0); PG8_MMA(1, 1, At, B1); PG8_BAR; PG8_SCHED;
            PG8_LDB(B0, 1, 0); PG8_LDB(B1, 1, 1); PG8_SCHED; PG8_LDA(At, 1, 0); PG8_STAGE(PG8_SA(0, 1), a2 + hstepA);
            PG8_WAIT_V(8); PG8_WAIT_L(0); PG8_BAR; PG8_MMA(0, 0, At, B0); PG8_MMA(0, 1, At, B1); PG8_BAR; PG8_SCHED;
            PG8_LDA(At, 1, 1); PG8_STAGE(PG8_SB(1, 0), b3); PG8_STAGE(PG8_SB(1, 1), b3 + hstepB); PG8_STAGE(PG8_SA(1, 0), a3);
            PG8_WAIT_V(8); PG8_WAIT_L(0); PG8_BAR; PG8_MMA(1, 0, At, B0); PG8_MMA(1, 1, At, B1); PG8_BAR; PG8_SCHED;
        }
        if (wr == 0) PG8_BAR;
        { int fr_e = fr, fq_e = fq, wr_e = wr, wc_e = wc; asm volatile("" : "+v"(fr_e), "+v"(fq_e), "+s"(wr_e), "+s"(wc_e));
          int tid_e = tid; asm volatile("" : "+v"(tid_e));
          const Unit ue{cur.pm, g.split ? cur.pn >> 1 : cur.pn};
          E(acc, ue, wr_e, wc_e, fr_e, fq_e, g.split ? (cur.pn & 1) : -1, tid_e);
          E.post(ue, tid_e);
#ifdef DUP_POST
          E.post(ue, tid_e);
#endif
          }
        if (!has_next) break;
#pragma unroll
        for (int a = 0; a < 2; ++a)
#pragma unroll
            for (int b = 0; b < 2; ++b)
#pragma unroll
                for (int m = 0; m < 4; ++m)
#pragma unroll
                    for (int n = 0; n < 2; ++n) acc[a][b][m][n] = (f32x4){0.f, 0.f, 0.f, 0.f};
        cur = nxt; cA = nA; cB = nB; ++ui;
        if (wr == 1) PG8_BAR;
    }
    PG8_WAIT_V(0);
    PG8_BAR;
#undef PG8_SA
#undef PG8_UA
#undef PG8_UB
#undef PG8_SB
#undef PG8_STAGE
#undef PG8_LDA
#undef PG8_LDB
#undef PG8_MMA
#undef PG8_WAIT_V
#undef PG8_WAIT_L
#undef PG8_BAR
#undef PG8_SCHED
}
}
using pg8::Unit;
typedef f32x4 Acc[2][2][4][2];

__device__ __forceinline__ void st_bf16x4(bf16_t* p, f32x4 v) { u32x2 w; w.x = cvtpk(v[0], v[1]); w.y = cvtpk(v[2], v[3]); *(u32x2*)p = w; }

template <bool PAIRED> struct EpiRes {
    const float* xin; float* xout; bf16_t* ap; u64_t* ssn; const float* gate;   const float* gmodn;
    __device__ __forceinline__ void operator()(const Acc& acc, const Unit& u, int wr, int wc, int fr, int fq) const {
        const int c = cond_of_tile(u.pm);
        const int colb = (PAIRED ? u.pn * 128 : u.pn * 256) + wc * 32 + 4 * fq;
        constexpr int NBJ = PAIRED ? 1 : 2;
        f32x4 gv[NBJ][2], gm[NBJ][2];
#pragma unroll
        for (int bj = 0; bj < NBJ; ++bj)
#pragma unroll
            for (int n = 0; n < 2; ++n) { gv[bj][n] = *(const f32x4*)(gate + (size_t)c * 6144 + colb + bj * 128 + n * 16);
                gm[bj][n] = gmodn ? *(const f32x4*)(gmodn + (size_t)c * 1024 + colb + bj * 128 + n * 16) : (f32x4){0.f, 0.f, 0.f, 0.f}; }
#pragma unroll
        for (int ai = 0; ai < 2; ++ai)
#pragma unroll
            for (int m = 0; m < 4; ++m) {
                const int r = u.pm * 256 + ai * 128 + wr * 64 + m * 16 + fr; float sq = 0.f;
#pragma unroll
                for (int bj = 0; bj < NBJ; ++bj)
#pragma unroll
                    for (int n = 0; n < 2; ++n) {
                        f32x4 o = acc[ai][bj][m][n];
                        if (PAIRED) { const f32x4 gt = acc[ai][1][m][n];
#pragma unroll
                            for (int e = 0; e < 4; ++e) o[e] = o[e] * sigm(gt[e]); }
                        const size_t off = (size_t)r * D + colb + bj * 128 + n * 16;
                        const f32x4 xo = *(const f32x4*)(xin + off) + gv[bj][n] * o;
                        *(f32x4*)(xout + off) = xo;
                        sq += (xo[0] * xo[0] + xo[1] * xo[1]) + (xo[2] * xo[2] + xo[3] * xo[3]);
                        if (gmodn) st_bf16x4(ap + off, xo * gm[bj][n]);
                    }
                sq += __shfl_xor(sq, 16); sq += __shfl_xor(sq, 32);
                if (fq == 0) atomicAdd(ssn + r, (u64_t)(sq * SS_FIX));
            }
    }
};
struct EpiUpRaw {
    const u64_t* ss; const float* sw;   bf16_t* hraw;
    __device__ __forceinline__ void operator()(const Acc& acc, const Unit& u, int wr, int wc, int fr, int fq) const {
        const int c = cond_of_tile(u.pm); const int colb = u.pn * 256 + wc * 32 + 4 * fq;
        f32x4 sv[2][2];
#pragma unroll
        for (int bj = 0; bj < 2; ++bj)
#pragma unroll
            for (int n = 0; n < 2; ++n) sv[bj][n] = *(const f32x4*)(sw + (size_t)c * SW_STRIDE + colb + bj * 128 + n * 16);
#pragma unroll
        for (int ai = 0; ai < 2; ++ai)
#pragma unroll
            for (int m = 0; m < 4; ++m) {
                const int r = u.pm * 256 + ai * 128 + wr * 64 + m * 16 + fr; const float rs = rstd_of(ss, r);
#pragma unroll
                for (int bj = 0; bj < 2; ++bj)
#pragma unroll
                    for (int n = 0; n < 2; ++n) st_bf16x4(hraw + (size_t)r * NUP + colb + bj * 128 + n * 16, acc[ai][bj][m][n] * rs + sv[bj][n]);
            }
    }
};
constexpr size_t WS_EDGE = 14 * MiB;
template <int CTRL> __device__ __forceinline__ float dpp_f(float old, float src) { return __int_as_float(__builtin_amdgcn_update_dpp(__float_as_int(old), __float_as_int(src), CTRL, 0xf, 0xf, false)); }
#define DPP_ROW_SHL1 0x101
#define DPP_ROW_SHR1 0x111
#define DPP_ROW_ROR1 0x121
#define DPP_ROW_ROR15 0x12f
struct EpiUpConv {
    const u64_t* ss; const float* sw; const float* cw; const float* cb; bf16_t* act; float* edge; bf16_t* tile;
    __device__ __forceinline__ void operator()(const Acc& acc, const Unit& u, int wr, int wc, int fr, int fq) const {
        const int c = cond_of_tile(u.pm); const int cc0 = wc * 32 + 4 * fq, colg0 = u.pn * 128 + cc0;
        f32x4 sv[2][2];
#pragma unroll
        for (int bj = 0; bj < 2; ++bj)
#pragma unroll
            for (int n = 0; n < 2; ++n) sv[bj][n] = *(const f32x4*)(sw + (size_t)c * SW_STRIDE + bj * DFF + colg0 + n * 16);
#pragma unroll
        for (int ai = 0; ai < 2; ++ai)
#pragma unroll
            for (int m = 0; m < 4; ++m) { const int rl = ai * 128 + wr * 64 + m * 16 + fr; const float rs = rstd_of(ss, u.pm * 256 + rl);
#pragma unroll
                for (int bj = 0; bj < 2; ++bj)
#pragma unroll
                    for (int n = 0; n < 2; ++n) st_bf16x4(tile + rl * 256 + bj * 128 + cc0 + n * 16, acc[ai][bj][m][n] * rs + sv[bj][n]); }
    }
    __device__ __forceinline__ void post(const Unit& u, int tid) const {
        asm volatile("s_waitcnt vmcnt(0)" ::: "memory"); __builtin_amdgcn_s_barrier(); asm volatile("" ::: "memory");
        const int ch = tid & 15, rg = tid >> 4, colg = u.pn * 128 + 8 * ch, r0 = rg * 8;
        const bool samp = u.pm >= 16; const bool nb_top = samp && (u.pm & 3) != 0, nb_bot = samp && (u.pm & 3) != 3;
        float wg[3][8], wv[3][8], bg[8], bv[8];
#pragma unroll
        for (int q = 0; q < 2; ++q) {
#pragma unroll
            for (int jj = 0; jj < 3; ++jj) { const f32x4 a = *(const f32x4*)(cw + jj * NUP + colg + 4 * q), b = *(const f32x4*)(cw + jj * NUP + DFF + colg + 4 * q);
#pragma unroll
                for (int e = 0; e < 4; ++e) { wg[jj][4 * q + e] = a[e]; wv[jj][4 * q + e] = b[e]; } }
            const f32x4 a = *(const f32x4*)(cb + colg + 4 * q), b = *(const f32x4*)(cb + DFF + colg + 4 * q);
#pragma unroll
            for (int e = 0; e < 4; ++e) { bg[4 * q + e] = a[e]; bv[4 * q + e] = b[e]; } }
        u32x4 rg_[10], rv_[10];
#pragma unroll
        for (int k = 0; k < 10; ++k) { const int rl = r0 - 1 + k; const bool ok = rl >= 0 && rl <= 255;
            rg_[k] = ok ? *(const u32x4*)(tile + rl * 256 + 8 * ch) : (u32x4){0u, 0u, 0u, 0u}; rv_[k] = ok ? *(const u32x4*)(tile + rl * 256 + 128 + 8 * ch) : (u32x4){0u, 0u, 0u, 0u}; }
#pragma unroll
        for (int k = 0; k < 8; ++k) {
            const int rl = r0 + k; const u32x4 pg = rg_[k], pv = rv_[k], cg = rg_[k + 1], cv = rv_[k + 1], ng = rg_[k + 2], nv = rv_[k + 2];
            float hg[8], hv[8];
#pragma unroll
            for (int e = 0; e < 4; ++e) {
                hg[2 * e] = wg[0][2 * e] * bflo(pg[e]) + wg[1][2 * e] * bflo(cg[e]) + wg[2][2 * e] * bflo(ng[e]) + bg[2 * e];
                hg[2 * e + 1] = wg[0][2 * e + 1] * bfhi(pg[e]) + wg[1][2 * e + 1] * bfhi(cg[e]) + wg[2][2 * e + 1] * bfhi(ng[e]) + bg[2 * e + 1];
                hv[2 * e] = wv[0][2 * e] * bflo(pv[e]) + wv[1][2 * e] * bflo(cv[e]) + wv[2][2 * e] * bflo(nv[e]) + bv[2 * e];
                hv[2 * e + 1] = wv[0][2 * e + 1] * bfhi(pv[e]) + wv[1][2 * e + 1] * bfhi(cv[e]) + wv[2][2 * e + 1] * bfhi(nv[e]) + bv[2 * e + 1]; }
            u32x4 o;
#pragma unroll
            for (int e = 0; e < 4; ++e) o[e] = cvtpk(hg[2 * e] * sigm(hg[2 * e]) * hv[2 * e], hg[2 * e + 1] * sigm(hg[2 * e + 1]) * hv[2 * e + 1]);
            *(u32x4*)(act + (size_t)(u.pm * 256 + rl) * DFF + colg) = o;
            if ((rl == 0 && nb_top) || (rl == 255 && nb_bot)) {
                float* e0 = edge + ((size_t)((u.pm - 16) * 2 + (rl == 0 ? 0 : 1)) * 4) * DFF + colg;
#pragma unroll
                for (int e = 0; e < 4; ++e) { e0[2 * e] = hg[2 * e]; e0[2 * e + 1] = hg[2 * e + 1]; e0[DFF + 2 * e] = hv[2 * e]; e0[DFF + 2 * e + 1] = hv[2 * e + 1];
                    e0[2 * DFF + 2 * e] = bflo(cg[e]); e0[2 * DFF + 2 * e + 1] = bfhi(cg[e]); e0[3 * DFF + 2 * e] = bflo(cv[e]); e0[3 * DFF + 2 * e + 1] = bfhi(cv[e]); } }
        }
    }
};
struct EpiQKV {
    const u64_t* ss; const float* sw; bf16_t *Q, *KB, *VB; float *outK, *outV; const float *ropec, *ropes; int j;
    __device__ __forceinline__ void operator()(const Acc& acc, const Unit& u, int wr, int wc, int fr, int fq) const {
        const int c = cond_of_tile(u.pm); const bool samp = u.pm >= 16; const int colt = u.pn * 256, cl0 = wc * 32 + 4 * fq;
        f32x4 sv[2][2];
#pragma unroll
        for (int bj = 0; bj < 2; ++bj)
#pragma unroll
            for (int n = 0; n < 2; ++n) sv[bj][n] = *(const f32x4*)(sw + (size_t)c * SW_STRIDE + colt + cl0 + bj * 128 + n * 16);
#pragma unroll
        for (int ai = 0; ai < 2; ++ai)
#pragma unroll
            for (int m = 0; m < 4; ++m) {
                const int r = u.pm * 256 + ai * 128 + wr * 64 + m * 16 + fr; const float rs = rstd_of(ss, r);
                f32x4 cs = {1.f, 1.f, 1.f, 1.f}, sn = {0.f, 0.f, 0.f, 0.f};
                if (samp && u.pn < 5) { const int t = (r - MP) & 1023, idx = t * 32 + (wc & 1) * 16 + 4 * fq; cs = *(const f32x4*)(ropec + idx); sn = *(const f32x4*)(ropes + idx); }
#pragma unroll
                for (int bj = 0; bj < 2; ++bj) {
                    f32x4 v0 = acc[ai][bj][m][0] * rs + sv[bj][0], v1 = acc[ai][bj][m][1] * rs + sv[bj][1];
                    if (u.pn < 5) { const f32x4 o0 = v0 * cs - v1 * sn, o1 = v1 * cs + v0 * sn; v0 = o0; v1 = o1; }
                    const int cl = bj * 128 + cl0;
                    if (u.pn < 4) { st_bf16x4(Q + (size_t)r * D + colt + cl, v0 * QSCALE); st_bf16x4(Q + (size_t)r * D + colt + cl + 16, v1 * QSCALE); }
                    else {
                        bf16_t* dst = (u.pn == 4 ? KB : VB) + (size_t)r * 256 + cl; st_bf16x4(dst, v0); st_bf16x4(dst + 16, v1);
                        if (!samp) { float* o = (u.pn == 4 ? outK : outV) + (((size_t)(r >> 8) * 2 + j) * 256 + (r & 255)) * 256 + cl; *(f32x4*)o = v0; *(f32x4*)(o + 16) = v1; }
                    }
                }
            }
    }
};
struct EpiHin {
    const u64_t* ss; const float* sw; const float* lb1; bf16_t *HQ, *HV, *HG; float *LFF, *LFB;
    __device__ __forceinline__ void operator()(const Acc& acc, const Unit& u, int wr, int wc, int fr, int fq) const {
        const int c = cond_of_tile(u.pm); const int seg = u.pn >> 2, colt = u.pn * 256, cl0 = wc * 32 + 4 * fq, cs0 = (u.pn & 3) * 256 + cl0;
        f32x4 sv[2][2], lbv[2][2];
#pragma unroll
        for (int bj = 0; bj < 2; ++bj)
#pragma unroll
            for (int n = 0; n < 2; ++n) { sv[bj][n] = *(const f32x4*)(sw + (size_t)c * SW_STRIDE + colt + cl0 + bj * 128 + n * 16);
                lbv[bj][n] = (seg == 2 || seg == 3) ? *(const f32x4*)(lb1 + (seg - 2) * 1024 + cs0 + bj * 128 + n * 16) : (f32x4){0.f, 0.f, 0.f, 0.f}; }
#pragma unroll
        for (int ai = 0; ai < 2; ++ai)
#pragma unroll
            for (int m = 0; m < 4; ++m) {
                const int r = u.pm * 256 + ai * 128 + wr * 64 + m * 16 + fr; const float rs = rstd_of(ss, r);
#pragma unroll
                for (int bj = 0; bj < 2; ++bj)
#pragma unroll
                    for (int n = 0; n < 2; ++n) {
                        f32x4 v = acc[ai][bj][m][n] * rs + sv[bj][n]; const size_t off = (size_t)r * D + cs0 + bj * 128 + n * 16;
                        if (seg == 0) st_bf16x4(HQ + off, v);
                        else if (seg == 1) st_bf16x4(HV + off, v);
                        else if (seg == 4) {
#pragma unroll
                            for (int e = 0; e < 4; ++e) v[e] = v[e] * sigm(v[e]);
                            st_bf16x4(HG + off, v); }
                        else { const f32x4 lb = lbv[bj][n];
#pragma unroll
                            for (int e = 0; e < 4; ++e) v[e] = __logf(lb[e] + (1.f - lb[e]) * sigm(v[e]));
                            *(f32x4*)((seg == 2 ? LFF : LFB) + off) = v; }
                    }
            }
    }
};
enum { EK_RES = 0, EK_RES_GLU, EK_UPRAW, EK_QKV, EK_HIN, EK_UPCONV };
struct EpiAny {
    int kind, l, flags, epoch; unsigned char* ws; float* out; const float *in29, *in30;
    __device__ __forceinline__ float* F(size_t o) const { return (float*)(ws + o); }
    __device__ __forceinline__ bf16_t* H(size_t o) const { return (bf16_t*)(ws + o); }
    __device__ __forceinline__ void post(const Unit& u, int tid) const {
        if (kind != EK_UPCONV) return;
        unsigned char* ws = this->ws; asm volatile("" : "+s"(ws));
        const size_t ss1 = WS_SS + (size_t)(l * 2) * M * 8, sw1 = WS_SW + (size_t)(l * 2) * 5 * SW_STRIDE * 4;
        EpiUpConv E{(const u64_t*)(ws + ss1 + (size_t)M * 8), (const float*)(ws + sw1 + (size_t)5 * SW_STRIDE * 4), in29 + (size_t)l * 3 * NUP, in30 + (size_t)l * NUP, (bf16_t*)(ws + WS_ACT), (float*)(ws + WS_EDGE), (bf16_t*)(ws + WS_SCR + (size_t)blockIdx.x * 131072)}; E.post(u, tid);
    }
    __device__ __forceinline__ void operator()(Acc& acc, const Unit& u, int wr, int wc, int fr, int fq, int kh, int tid) const {
#ifndef EK_MASK
#define EK_MASK 63
#endif
        if (!((EK_MASK >> kind) & 1)) return;
        unsigned char* ws = this->ws; float* out = this->out; asm volatile("" : "+s"(ws), "+s"(out));
        if (kh >= 0) {
            const int tile = u.pm * 4 + u.pn; unsigned* flag = (unsigned*)(ws + WS_CTL + 40960) + tile * 16;
            unsigned char* slab = ws + WS_SCR + 64 * MiB + (size_t)tile * 262144 + (size_t)tid * 16;
            if (kh == 1) {
                __amdgpu_buffer_rsrc_t rs = __builtin_amdgcn_make_buffer_rsrc(ws + WS_SCR + 64 * MiB + (size_t)tile * 262144, 0, 262144, 0x00020000);
#pragma unroll
                for (int j = 0; j < 32; ++j) __builtin_amdgcn_raw_buffer_store_b128(__builtin_bit_cast(u32x4, acc[j >> 4][(j >> 3) & 1][(j >> 1) & 3][j & 1]), rs, tid * 16 + j * 8192, 0, 16);
                asm volatile("s_waitcnt vmcnt(0)" ::: "memory"); __builtin_amdgcn_s_barrier(); asm volatile("" ::: "memory");
                if (tid == 0) __hip_atomic_store(flag, (unsigned)epoch, __ATOMIC_RELAXED, __HIP_MEMORY_SCOPE_AGENT);
                return;
            }
            if (tid < 64) {
                unsigned sp = 0;
                while ((unsigned)__builtin_amdgcn_readfirstlane((int)__hip_atomic_load(flag, __ATOMIC_RELAXED, __HIP_MEMORY_SCOPE_AGENT)) != (unsigned)epoch) { __builtin_amdgcn_s_sleep(2); if (++sp > (1u << 22)) break; }
                __builtin_amdgcn_fence(__ATOMIC_ACQUIRE, "agent"); asm volatile("s_waitcnt vmcnt(0)" ::: "memory");
            }
            asm volatile("" ::: "memory"); __builtin_amdgcn_s_barrier(); asm volatile("" ::: "memory");
#pragma unroll
            for (int j = 0; j < 32; ++j) acc[j >> 4][(j >> 3) & 1][(j >> 1) & 3][j & 1] += *(const f32x4*)(slab + (size_t)j * 8192);
        }
        auto F = [&](size_t o) { return (float*)(ws + o); }; auto H = [&](size_t o) { return (bf16_t*)(ws + o); };
        const size_t ss1 = WS_SS + (size_t)(l * 2) * M * 8, sw1 = WS_SW + (size_t)(l * 2) * 5 * SW_STRIDE * 4;
        switch (kind) {
        case EK_RES: case EK_RES_GLU: {
            const bool down = flags & 1;
            const size_t ssn = down ? WS_SS + (size_t)((l + 1) * 2) * M * 8 : ss1 + (size_t)M * 8;
            const size_t gate = WS_MOD + ((size_t)l * 5 * 6144 + (down ? 5 : 2) * 1024) * 4;
            const size_t gmn = down ? WS_GMOD + (size_t)((l + 1) * 2) * 5 * 1024 * 4 : WS_GMOD + (size_t)(l * 2 + 1) * 5 * 1024 * 4;
            const bool has_next = !(down && l == 3);
            float* xo = (flags & 2) ? out : F(WS_X); bf16_t* ap = H(WS_AP); u64_t* sp = (u64_t*)(ws + ssn);
            if (flags & 4) { const size_t dm = WS_SCR + ((flags & 8) ? 48 : 96) * MiB; xo = F(dm); ap = H(dm + 32 * MiB); sp = (u64_t*)(ws + dm + 48 * MiB); }
            if (kind == EK_RES) { EpiRes<false> E{F(WS_X), xo, ap, sp, F(gate), has_next ? F(gmn) : nullptr}; E(acc, u, wr, wc, fr, fq); }
            else { EpiRes<true> E{F(WS_X), xo, ap, sp, F(gate), F(gmn)}; E(acc, u, wr, wc, fr, fq); } } break;
        case EK_UPRAW: { EpiUpRaw E{(const u64_t*)(ws + ss1 + (size_t)M * 8), F(sw1 + (size_t)5 * SW_STRIDE * 4), H(WS_SCR + (size_t)((flags >> 2) & 1) * (88 * MiB))}; E(acc, u, wr, wc, fr, fq); } break;
        case EK_UPCONV: { EpiUpConv E{(const u64_t*)(ws + ss1 + (size_t)M * 8), F(sw1 + (size_t)5 * SW_STRIDE * 4), in29 + (size_t)l * 3 * NUP, in30 + (size_t)l * NUP, H(WS_ACT), F(WS_EDGE), H(WS_SCR + (size_t)blockIdx.x * 131072)}; E(acc, u, wr, wc, fr, fq); } break;
        case EK_QKV: { EpiQKV E{(const u64_t*)(ws + ss1), F(sw1), H(SCR_Q), H(SCR_KB), H(SCR_VB), out + 8388608, out + 8388608 + 2097152, F(WS_ROPE), F(WS_ROPE) + 32768, l / 3}; E(acc, u, wr, wc, fr, fq); } break;
        default: { EpiHin E{(const u64_t*)(ws + ss1), F(sw1), F(WS_LB1), H(SCR_HQ), H(SCR_HV), H(SCR_HG), F(SCR_LFF), F(SCR_LFB)}; E(acc, u, wr, wc, fr, fq); } break;
        }
    }
};
}
namespace om {
#define LDS_WAIT() asm volatile("s_waitcnt lgkmcnt(0)" ::: "memory")
__device__ __forceinline__ void transpose_item(const float* W, int K, int N, bf16_t* WT, LAS unsigned short* scr, int item, int lane) {
    const int nblk = N / 32, kb = item / nblk, nb = item % nblk, k0 = 64 * kb, n0 = 32 * nb;
    float v[32];
#pragma unroll
    for (int i = 0; i < 32; ++i) v[i] = W[(size_t)(k0 + 2 * i + (lane >> 5)) * N + n0 + (lane & 31)];
#pragma unroll
    for (int i = 0; i < 32; ++i) scr[(2 * i + (lane >> 5)) * 33 + (lane & 31)] = (unsigned short)(cvtpk(v[i], 0.f) & 0xffffu);
    LDS_WAIT(); asm volatile("" ::: "memory");
    const int c = lane & 7;
#pragma unroll
    for (int j = 0; j < 4; ++j) { const int n = (lane >> 3) + 8 * j; const LAS unsigned short* s = scr + (8 * c) * 33 + n;
        u32x4 o; o.x = (unsigned)s[0 * 33] | ((unsigned)s[1 * 33] << 16); o.y = (unsigned)s[2 * 33] | ((unsigned)s[3 * 33] << 16); o.z = (unsigned)s[4 * 33] | ((unsigned)s[5 * 33] << 16); o.w = (unsigned)s[6 * 33] | ((unsigned)s[7 * 33] << 16);
        *(u32x4*)(WT + (size_t)(n0 + n) * K + k0 + 8 * c) = o; }
    LDS_WAIT(); asm volatile("" ::: "memory");
}
__device__ __forceinline__ float modsum(const Ctx& C, int l, int c, int idx) {
    const float* mp = C.f(WS_MODP) + ((size_t)l * 5 + c) * 6144 + idx; float s = C.in(9)[l * 6144 + idx];
#pragma unroll
    for (int kp = 0; kp < 4; ++kp) s += mp[(size_t)kp * 4 * 5 * 6144];
    return s;
}
__device__ __forceinline__ void convert_layer(const Ctx& C, int layer, int vb, int nvb) {
    const int gw = vb * NWAVES + C.wave, NGW = nvb * NWAVES;
    LAS unsigned short* scr = (LAS unsigned short*)(C.lds + C.wave * 4352);
#define DO_MAT(src, dst, K, N) for (int it = gw; it < ((K) / 64) * ((N) / 32); it += NGW) transpose_item((src), (K), (N), (dst), scr, it, C.lane)
    if (layer == 0 || layer == 3) { const int j = layer / 3; DO_MAT(C.in(12) + (size_t)j * D * NQKV, C.h(WS_WQKV) + (size_t)j * NQKV * D, D, NQKV); DO_MAT(C.in(13) + (size_t)j * D * D, C.h(WS_WO) + (size_t)j * D * D, D, D); }
    else if (layer == 1) { DO_MAT(C.in(15), C.h(WS_HWIN), D, NHIN); DO_MAT(C.in(18), C.h(WS_HWO), D, D); }
    else { DO_MAT(C.in(27), C.h(WS_GLU), D, 2048); }
    DO_MAT(C.in(28) + (size_t)layer * D * NUP, C.h(WS_UP) + (size_t)layer * NUP * D, D, NUP); DO_MAT(C.in(31) + (size_t)layer * DFF * D, C.h(WS_DOWN) + (size_t)layer * D * DFF, DFF, D);
#undef DO_MAT
}
__device__ __forceinline__ void phase_p0a(const Ctx& C) {
    const int gt = C.bid * NTHREADS + C.tid, NGT = C.G * NTHREADS;
    for (int layer = 0; layer < 4; ++layer) if (layer == 0 || C.G != 256) convert_layer(C, layer, C.bid, C.G);
    __syncthreads();
    LAS float* sS = (LAS float*)(C.lds + 40960);
    LAS float* red = (LAS float*)(C.lds);
    for (int it = C.bid; it < 384; it += C.G) {
        const int l = it / 96, cb = (it % 96) >> 2, kp = it & 3;
        for (int i = C.tid; i < 5 * 256; i += NTHREADS) { const int c = i >> 8, k = kp * 256 + (i & 255); const float v = c == 0 ? C.in(7)[k] : C.in(6)[(c - 1) * 1024 + k]; sS[i] = v / (1.f + __expf(-v)); }
        __syncthreads();
        f32x4 a[5];
#pragma unroll
        for (int c = 0; c < 5; ++c) a[c] = (f32x4){0.f, 0.f, 0.f, 0.f};
        const float* wp = C.in(8) + ((size_t)l * 1024 + kp * 256 + C.wave * 32) * 6144 + cb * 256 + 4 * C.lane;
#pragma unroll 4
        for (int k = 0; k < 32; ++k) { const f32x4 w = *(const f32x4*)(wp + (size_t)k * 6144);
#pragma unroll
            for (int c = 0; c < 5; ++c) a[c] += w * sS[c * 256 + C.wave * 32 + k]; }
#pragma unroll
        for (int c = 0; c < 5; ++c) *(LAS f32x4*)(red + (C.wave * 5 + c) * 256 + 4 * C.lane) = a[c];
        __syncthreads();
        for (int i = C.tid; i < 5 * 256; i += NTHREADS) { float s = 0.f;
#pragma unroll
            for (int w = 0; w < 8; ++w) s += red[w * 1280 + i];
            C.f(WS_MODP)[(((size_t)kp * 4 + l) * 5 + (i >> 8)) * 6144 + cb * 256 + (i & 255)] = s; }
        __syncthreads();
    }
    { unsigned zero = 0u; asm volatile("" : "+v"(zero));
      for (int i = gt; i < 9 * M; i += NGT) ((u32x2*)(C.ws + WS_SS))[i] = (u32x2){zero, zero}; }
    for (int i = gt; i < 1024 * 32; i += NGT) { const int t = i >> 5, e = i & 31, fi = e & 15; const float pos = (e >> 4) == 0 ? (float)(t >> 6) : (float)(t & 63);
        const float ang = pos * (1.0f / powf(10000.0f, (float)(2 * fi) / 32.0f)); C.f(WS_ROPE)[i] = cosf(ang); C.f(WS_ROPE)[32768 + i] = sinf(ang); }
    for (int i = gt; i < 2 * 131072; i += NGT) { const int which = i >> 17, e = (i & 131071) * 8; const float* s = (which ? C.in(3) : C.in(2)) + e; const f32x4 a = *(const f32x4*)s, b = *(const f32x4*)(s + 4);
        u32x4 o; o.x = cvtpk(a[0], a[1]); o.y = cvtpk(a[2], a[3]); o.z = cvtpk(b[0], b[1]); o.w = cvtpk(b[2], b[3]); *(u32x4*)(C.h(which ? WS_CTXV : WS_CTXK) + e) = o; }
    for (int i = gt; i < 2048; i += NGT) { float v[4], mx = -1e30f;
#pragma unroll
        for (int l = 0; l < 4; ++l) { v[l] = C.in(16)[l * 2048 + i]; mx = fmaxf(mx, v[l]); }
        float s = 0.f;
#pragma unroll
        for (int l = 0; l < 4; ++l) { v[l] = expf(v[l] - mx); s += v[l]; }
        C.f(WS_LB1)[i] = v[1] / s; }
    for (int i = gt; i < 8192; i += NGT) {
        const int dg = i >> 6, p = i & 63;
        const float ar = fminf(C.in(19)[i], -1e-4f), ai = C.in(20)[i], dt = expf(C.in(21)[dg]);
        const float e = expf(ar * dt), lr = e * cosf(ai * dt), li = e * sinf(ai * dt);
        const float den = ar * ar + ai * ai, fr = ((lr - 1.f) * ar + li * ai) / den, fi = (li * ar - (lr - 1.f) * ai) / den;
        C.f(WS_SLAM)[2 * i] = lr; C.f(WS_SLAM)[2 * i + 1] = li;
        unsigned wr_[8], wi_[8];
#pragma unroll
        for (int q = 0; q < 8; ++q) { const float x0 = C.in(22)[(size_t)i * 16 + 2 * q], y0 = C.in(23)[(size_t)i * 16 + 2 * q], x1 = C.in(22)[(size_t)i * 16 + 2 * q + 1], y1 = C.in(23)[(size_t)i * 16 + 2 * q + 1];
            wr_[q] = cvtpk(fr * x0 - fi * y0, fr * x1 - fi * y1); wi_[q] = cvtpk(fr * y0 + fi * x0, fr * y1 + fi * x1); }
        bf16_t* bb = C.h(WS_SBB) + ((size_t)dg * 128 + p) * 16;
        *(u32x4*)bb = (u32x4){wr_[0], wr_[1], wr_[2], wr_[3]}; *(u32x4*)(bb + 8) = (u32x4){wr_[4], wr_[5], wr_[6], wr_[7]};
        *(u32x4*)(bb + 64 * 16) = (u32x4){wi_[0], wi_[1], wi_[2], wi_[3]}; *(u32x4*)(bb + 64 * 16 + 8) = (u32x4){wi_[4], wi_[5], wi_[6], wi_[7]};
    }
    for (int i = gt; i < 2 * 64 * 16 * 64; i += NGT) {
        const int p = i & 63, row = i >> 6; bf16_t* cb = C.h(WS_SCB) + (size_t)row * 128;
        cb[p] = (bf16_t)(cvtpk(C.in(24)[i], 0.f) & 0xffffu); cb[64 + p] = (bf16_t)(cvtpk(-C.in(25)[i], 0.f) & 0xffffu); }
}
__device__ __forceinline__ void rows_ap_ss(const Ctx& C, const float* xsrc_p, const float* xsrc_s, float* xcopy, int l, int s, bool from_table, u64_t* ssdst) {
    for (int gw = C.bid * NWAVES + C.wave; gw < M / 4; gw += C.G * NWAVES) {
    const int r0 = gw * 4;
    const int c = cond_of_row(r0);
    f32x4 gm[4];
#pragma unroll
    for (int j = 0; j < 4; ++j) { const int n = 4 * C.lane + 256 * j;
        if (from_table) gm[j] = *(const f32x4*)(C.f(WS_GMOD) + (((size_t)l * 2 + s) * 5 + c) * 1024 + n);
        else { const float* g = (s == 0 ? C.in(10) : C.in(11)) + l * D + n;
#pragma unroll
            for (int e = 0; e < 4; ++e) gm[j][e] = g[e] * (1.f + modsum(C, l, c, (s == 0 ? 1 : 4) * 1024 + n + e)); } }
    for (int rr = 0; rr < 4; ++rr) {
        const int r = r0 + rr; const float* xr = (r < MP ? xsrc_p + (size_t)r * D : xsrc_s + (size_t)(r - MP) * D);
        f32x4 v[4]; float sq = 0.f;
#pragma unroll
        for (int j = 0; j < 4; ++j) { v[j] = *(const f32x4*)(xr + 4 * C.lane + 256 * j); sq += (v[j][0] * v[j][0] + v[j][1] * v[j][1]) + (v[j][2] * v[j][2] + v[j][3] * v[j][3]); }
        sq = wave_sum(sq);
#pragma unroll
        for (int j = 0; j < 4; ++j) { const size_t off = (size_t)r * D + 4 * C.lane + 256 * j; if (xcopy) *(f32x4*)(xcopy + off) = v[j]; st_bf16x4(C.h(WS_AP) + off, v[j] * gm[j]); }
        if (C.lane == 0) ssdst[r] = (u64_t)(sq * SS_FIX);
    }
    }
}
template <bool FROM_TABLE> __device__ __forceinline__ void sw_item_t(const Ctx& C, int item) {
    int ch = item, l = 0, s = 0, N = 0; const float* Wf = nullptr;
    if (ch < 12) { l = 0; s = 0; N = NQKV; Wf = C.in(12); }
    else if ((ch -= 12) < 44) { l = 0; s = 1; N = NUP; Wf = C.in(28); }
    else if ((ch -= 44) < 40) { l = 1; s = 0; N = NHIN; Wf = C.in(15); }
    else if ((ch -= 40) < 44) { l = 1; s = 1; N = NUP; Wf = C.in(28) + (size_t)1 * D * NUP; }
    else if ((ch -= 44) < 44) { l = 2; s = 1; N = NUP; Wf = C.in(28) + (size_t)2 * D * NUP; }
    else if ((ch -= 44) < 12) { l = 3; s = 0; N = NQKV; Wf = C.in(12) + (size_t)1 * D * NQKV; }
    else { ch -= 12; l = 3; s = 1; N = NUP; Wf = C.in(28) + (size_t)3 * D * NUP; }
    LAS float* sh = (LAS float*)C.lds;
    for (int i = C.tid; i < 5 * 1024; i += NTHREADS) sh[i] = FROM_TABLE ? C.f(WS_MOD)[((size_t)l * 5 + (i >> 10)) * 6144 + (s == 0 ? 0 : 3) * 1024 + (i & 1023)] : modsum(C, l, i >> 10, (s == 0 ? 0 : 3) * 1024 + (i & 1023));
    __syncthreads();
    const int n0 = ch * 128 + 4 * (C.lane & 31);
    f32x4 a[5];
#pragma unroll
    for (int c = 0; c < 5; ++c) a[c] = (f32x4){0.f, 0.f, 0.f, 0.f};
    const float* wp = Wf + (size_t)(C.wave * 128 + (C.lane >> 5)) * N + n0;
#pragma unroll 4
    for (int k = 0; k < 64; ++k) { const f32x4 w = *(const f32x4*)(wp + (size_t)(2 * k) * N); const int kk = C.wave * 128 + 2 * k + (C.lane >> 5);
#pragma unroll
        for (int c = 0; c < 5; ++c) a[c] += w * sh[c * 1024 + kk]; }
    LAS float* red = (LAS float*)(C.lds + 20480);
#pragma unroll
    for (int c = 0; c < 5; ++c) *(LAS f32x4*)(red + ((C.wave * 2 + (C.lane >> 5)) * 5 + c) * 128 + 4 * (C.lane & 31)) = a[c];
    __syncthreads();
    for (int i = C.tid; i < 5 * 128; i += NTHREADS) { float sum = 0.f;
#pragma unroll
        for (int w = 0; w < 16; ++w) sum += red[w * 640 + i];
        C.f(WS_SW)[(((size_t)l * 2 + s) * 5 + (i >> 7)) * SW_STRIDE + ch * 128 + (i & 127)] = sum; }
    __syncthreads();
}
__device__ __forceinline__ void sw_item_p0(const Ctx& C, int item) { sw_item_t<false>(C, item); }
__device__ __forceinline__ void sw_item(const Ctx& C, int item) { sw_item_t<true>(C, item); }
__device__ __forceinline__ void phase_p0c(const Ctx& C) {
    for (int vb = C.bid; vb < 256; vb += C.G) {
    if (vb < 240) {
        sw_item_p0(C, vb);
    } else {
        const int t = (vb - 240) * NTHREADS + C.tid, NT = 16 * NTHREADS;
        for (int i = t; i < 4 * 5 * 6144; i += NT) { const int l = i / 30720, c = (i / 6144) % 5, idx = i % 6144; C.f(WS_MOD)[i] = modsum(C, l, c, idx); }
        for (int i = t; i < 4 * 2 * 5 * 1024; i += NT) { const int n = i & 1023, c = (i >> 10) % 5, s = (i / 5120) & 1, l = i / 10240;
            C.f(WS_GMOD)[i] = (s == 0 ? C.in(10) : C.in(11))[l * D + n] * (1.f + modsum(C, l, c, (s == 0 ? 1 : 4) * 1024 + n)); }
    }
    __syncthreads();
    }
    rows_ap_ss(C, C.in(0), C.in(1), C.f(WS_X), 0, 0, false, (u64_t*)(C.ws + WS_SS));
}
__device__ __forceinline__ void phase_glue(const Ctx& C, int l, int s) { rows_ap_ss(C, C.f(WS_X), C.f(WS_X) + (size_t)MP * D, nullptr, l, s, true, (u64_t*)(C.ws + WS_SS) + (size_t)(l * 2 + s) * M); }

__device__ __forceinline__ void phase_conv(const Ctx& C, int l) {
    const bf16_t* h = C.h(WS_SCR); bf16_t* act = C.h(WS_ACT); const float* cw = C.in(29) + (size_t)l * 3 * NUP; const float* cb = C.in(30) + (size_t)l * NUP;
    const int gt = C.bid * NTHREADS + C.tid, NGT = C.G * NTHREADS;
    for (int i = gt; i < M * (DFF / 8); i += NGT) {
        const int r = i / (DFF / 8), n = (i % (DFF / 8)) * 8;
        int t, S; if (r < MP) { t = r & 255; S = 256; } else { t = (r - MP) & 1023; S = 1024; }
        float g[8], v[8];
#pragma unroll
        for (int e = 0; e < 8; ++e) { g[e] = cb[n + e]; v[e] = cb[DFF + n + e]; }
#pragma unroll
        for (int jj = 0; jj < 3; ++jj) { const int tt = t + jj - 1; if (tt >= 0 && tt < S) {
            const u32x4 hg = *(const u32x4*)(h + (size_t)(r + jj - 1) * NUP + n), hv = *(const u32x4*)(h + (size_t)(r + jj - 1) * NUP + DFF + n);
#pragma unroll
            for (int e = 0; e < 4; ++e) { g[2 * e] += cw[jj * NUP + n + 2 * e] * bflo(hg[e]); g[2 * e + 1] += cw[jj * NUP + n + 2 * e + 1] * bfhi(hg[e]);
                v[2 * e] += cw[jj * NUP + DFF + n + 2 * e] * bflo(hv[e]); v[2 * e + 1] += cw[jj * NUP + DFF + n + 2 * e + 1] * bfhi(hv[e]); } } }
        u32x4 o;
#pragma unroll
        for (int e = 0; e < 4; ++e) o[e] = cvtpk(g[2 * e] * sigm(g[2 * e]) * v[2 * e], g[2 * e + 1] * sigm(g[2 * e + 1]) * v[2 * e + 1]);
        *(u32x4*)(act + (size_t)r * DFF + n) = o;
    }
}
__device__ __forceinline__ void phase_final(const Ctx& C, float dbg) {
    const int gw = C.bid * NWAVES + C.wave, NGW = C.G * NWAVES; const u64_t* ss = (const u64_t*)(C.ws + WS_SS) + (size_t)8 * M;
    for (int r = gw; r < M; r += NGW) { const float rs = rstd_of(ss, r);
#pragma unroll
        for (int j = 0; j < 4; ++j) { const int n = 4 * C.lane + 256 * j; float* p = C.out + (size_t)r * D + n; *(f32x4*)p = *(const f32x4*)p * (rs * dbg) * *(const f32x4*)(C.in(32) + n); } }
}
}
namespace om {
__device__ __forceinline__ int rowidx(int r, int h) { return (r & 3) + 8 * (r >> 2) + 4 * h; }
__device__ __forceinline__ float xhalf(float v) {
    auto rr = __builtin_amdgcn_permlane32_swap(__float_as_uint(v), __float_as_uint(v), false, false);
    return __uint_as_float((lane_id() & 32) ? rr[0] : rr[1]);
}
__device__ __forceinline__ bf16x8 pack8(const f32x16& x, int base) {
    u32x4 w; w.x = cvtpk(x[base], x[base + 1]); w.y = cvtpk(x[base + 2], x[base + 3]); w.z = cvtpk(x[base + 4], x[base + 5]); w.w = cvtpk(x[base + 6], x[base + 7]);
    return __builtin_bit_cast(bf16x8, w);
}
typedef short v4i16_t __attribute__((ext_vector_type(4)));
__device__ __forceinline__ u32x2 vtr4(const LAS unsigned char* p) { return __builtin_bit_cast(u32x2, __builtin_amdgcn_ds_read_tr16_b64_v4i16((LAS v4i16_t*)p)); }
__device__ __forceinline__ bf16x8 cat44(u32x2 a, u32x2 b) { u32x4 w = {a.x, a.y, b.x, b.y}; return __builtin_bit_cast(bf16x8, w); }

constexpr int AT_KSTR = 144;
constexpr int AT_BUF = 2 * 64 * AT_KSTR;
__device__ __forceinline__ void attn_unit(const Ctx& C, int j, bool samp, int b, int hq, int qb, size_t obuf) {
    const int lane = C.lane, c = lane & 31, h = lane >> 5, w = C.wave, kvh = hq >> 2;
    const int rowbase = samp ? MP + b * 1024 : b * 256, q0 = qb * 256, qlo = q0 + 32 * w;
    const bf16_t* Q = C.h(SCR_Q); const bf16_t* KB = C.h(SCR_KB); const bf16_t* VB = C.h(SCR_VB);
    const bf16_t* CK = C.h(WS_CTXK) + ((size_t)(b * 2 + j) * 512) * 256; const bf16_t* CV = C.h(WS_CTXV) + ((size_t)(b * 2 + j) * 512) * 256;
    int klo = 0, nlat = 4, NT = 4;
    if (samp) { klo = q0 - 128 < 0 ? 0 : q0 - 128; const int khi = q0 + 384 > 1024 ? 1024 : q0 + 384; nlat = (khi - klo) >> 6; NT = nlat + 8; }
    bf16x8 qf[4];
#pragma unroll
    for (int s = 0; s < 4; ++s) qf[s] = *(const bf16x8*)(Q + (size_t)(rowbase + qlo + c) * D + hq * 64 + 16 * s + 8 * h);
    float m = C.in(14)[j * 16 + hq] * LOG2E, lsum = h == 0 ? 1.f : 0.f;
    f32x16 o0 = {}, o1 = {};
    const int lkey = C.tid >> 3, lch = C.tid & 7;
    auto src_k = [&](int t) -> const bf16_t* { return (t < nlat ? KB + (size_t)(rowbase + klo + 64 * t + lkey) * 256 : CK + (size_t)(64 * (t - nlat) + lkey) * 256) + kvh * 64 + lch * 8; };
    auto src_v = [&](int t) -> const bf16_t* { return (t < nlat ? VB + (size_t)(rowbase + klo + 64 * t + lkey) * 256 : CV + (size_t)(64 * (t - nlat) + lkey) * 256) + kvh * 64 + lch * 8; };
    auto put = [&](int buf, u32x4 kr, u32x4 vr) {
        LAS unsigned char* kb = C.lds + buf * AT_BUF; LAS unsigned char* vb = kb + 64 * AT_KSTR;
        *(LAS u32x4*)(kb + lkey * AT_KSTR + lch * 16) = kr;
        *(LAS u32x4*)(vb + lkey * AT_KSTR + lch * 16) = vr;
    };
    const int vtr_off = (4 * h + ((lane & 15) >> 2)) * AT_KSTR + (16 * ((lane >> 4) & 1) + 4 * (lane & 3)) * 2;
    { const u32x4 kr = *(const u32x4*)src_k(0), vr = *(const u32x4*)src_v(0); put(0, kr, vr); }
    __syncthreads();
    for (int t = 0; t < NT; ++t) {
        u32x4 kr = {}, vr = {};
        if (t + 1 < NT) { kr = *(const u32x4*)src_k(t + 1); vr = *(const u32x4*)src_v(t + 1); }
        const bool lat = samp && t < nlat; const int key0 = klo + 64 * t;
        const bool skip = lat && (key0 > qlo + 31 + 128 || key0 + 63 < qlo - 128);
        if (!skip) {
            LAS unsigned char* kb = C.lds + (t & 1) * AT_BUF; LAS unsigned char* vb = kb + 64 * AT_KSTR;
            f32x16 x0 = {}, x1 = {};
#pragma unroll
            for (int s = 0; s < 4; ++s) {
                const bf16x8 a0 = *(const LAS bf16x8*)(kb + c * AT_KSTR + (16 * s + 8 * h) * 2), a1 = *(const LAS bf16x8*)(kb + (32 + c) * AT_KSTR + (16 * s + 8 * h) * 2);
                x0 = __builtin_amdgcn_mfma_f32_32x32x16_bf16(a0, qf[s], x0, 0, 0, 0); x1 = __builtin_amdgcn_mfma_f32_32x32x16_bf16(a1, qf[s], x1, 0, 0, 0);
            }
            if (lat && !(key0 >= qlo + 31 - 128 && key0 + 63 <= qlo + 128)) {
                const int tq = qlo + c;
#pragma unroll
                for (int r = 0; r < 16; ++r) { const int k0 = key0 + rowidx(r, h) - tq; if (k0 > 128 || k0 < -128) x0[r] = -INFINITY; if (k0 + 32 > 128 || k0 + 32 < -128) x1[r] = -INFINITY; }
            }
            float mx = fmaxf(x0[0], x1[0]);
#pragma unroll
            for (int r = 1; r < 16; ++r) mx = fmaxf(mx, fmaxf(x0[r], x1[r]));
            mx = fmaxf(mx, xhalf(mx));
            const float mn = fmaxf(m, mx), al = __builtin_amdgcn_exp2f(m - mn); m = mn;
            float ps = 0.f;
#pragma unroll
            for (int r = 0; r < 16; ++r) { x0[r] = __builtin_amdgcn_exp2f(x0[r] - mn); x1[r] = __builtin_amdgcn_exp2f(x1[r] - mn); ps += x0[r] + x1[r]; }
            lsum = lsum * al + ps;
#pragma unroll
            for (int r = 0; r < 16; ++r) { o0[r] *= al; o1[r] *= al; }
#pragma unroll
            for (int ks = 0; ks < 2; ++ks) {
                const bf16x8 p0 = pack8(x0, 8 * ks), p1 = pack8(x1, 8 * ks);
#pragma unroll
                for (int dt = 0; dt < 2; ++dt) {
                    const LAS unsigned char* vp = vb + vtr_off + (16 * ks) * AT_KSTR + (32 * dt) * 2;
                    const bf16x8 v0 = cat44(vtr4(vp), vtr4(vp + 8 * AT_KSTR)), v1 = cat44(vtr4(vp + 32 * AT_KSTR), vtr4(vp + 40 * AT_KSTR));
                    if (dt == 0) { o0 = __builtin_amdgcn_mfma_f32_32x32x16_bf16(v0, p0, o0, 0, 0, 0); o0 = __builtin_amdgcn_mfma_f32_32x32x16_bf16(v1, p1, o0, 0, 0, 0); }
                    else { o1 = __builtin_amdgcn_mfma_f32_32x32x16_bf16(v0, p0, o1, 0, 0, 0); o1 = __builtin_amdgcn_mfma_f32_32x32x16_bf16(v1, p1, o1, 0, 0, 0); }
                }
            }
        }
        if (t + 1 < NT) put((t + 1) & 1, kr, vr);
        __syncthreads();
    }
    lsum += xhalf(lsum);
    const float il = 1.f / lsum;
    bf16_t* O = C.h(obuf) + (size_t)(rowbase + qlo + c) * D + hq * 64 + 4 * h;
#pragma unroll
    for (int g = 0; g < 4; ++g) { st_bf16x4(O + 8 * g, (f32x4){o0[4 * g], o0[4 * g + 1], o0[4 * g + 2], o0[4 * g + 3]} * il); st_bf16x4(O + 32 + 8 * g, (f32x4){o1[4 * g], o1[4 * g + 1], o1[4 * g + 2], o1[4 * g + 3]} * il); }
}
__device__ __forceinline__ void phase_attn(const Ctx& C, int l, size_t obuf) {
    const int j = l / 3;
    for (int u = C.bid; u < 512; u += C.G) {
        if (u < 256) attn_unit(C, j, false, u >> 4, u & 15, 0, obuf);
        else { const int v = u - 256; attn_unit(C, j, true, v >> 6, (v >> 2) & 15, v & 3, obuf); }
    }
}
constexpr size_t CKS_TAB = 376 * MiB; constexpr int CKS_NW = (int)((268 * MiB) / 65536), CKS_NO = (17039360 * 4) / 65536, CKS_N = CKS_NW + CKS_NO;
__device__ __forceinline__ void phase_cks(const Ctx& C, int slot) {
    const int gw = C.bid * NWAVES + C.wave, NGW = C.G * NWAVES; unsigned* tab = (unsigned*)(C.ws + CKS_TAB) + (size_t)slot * 8192;
    for (int ck = gw; ck < CKS_N; ck += NGW) {
        const unsigned char* base = ck < CKS_NW ? C.ws + 108 * MiB + (size_t)ck * 65536 : (const unsigned char*)C.out + (size_t)(ck - CKS_NW) * 65536; unsigned s = 0;
        for (int i = 0; i < 64; ++i) { const u32x4 v = *(const u32x4*)(base + (size_t)i * 1024 + C.lane * 16); s += v[0] + v[1] * 3u + v[2] * 5u + v[3] * 7u; }
#pragma unroll
        for (int o = 1; o < 64; o <<= 1) s += (unsigned)__shfl_xor((int)s, o);
        if (C.lane == 0) tab[ck] = s;
    }
}
__device__ __forceinline__ void phase_clr(const Ctx& C) {
    const int gt = C.bid * NTHREADS + C.tid, NGT = C.G * NTHREADS; const u32x4 z = {0u, 0u, 0u, 0u};
    for (size_t i = gt; i < (268 * MiB) / 16; i += NGT) *(u32x4*)(C.ws + 108 * MiB + i * 16) = z;
    for (size_t i = gt; i < (size_t)17039360 / 4; i += NGT) *(u32x4*)((unsigned char*)C.out + i * 16) = z;
}
__device__ __forceinline__ void phase_clr2(const Ctx& C, size_t off, size_t bytes) {
    const int gt = C.bid * NTHREADS + C.tid, NGT = C.G * NTHREADS; const u32x4 z = {0u, 0u, 0u, 0u};
    for (size_t i = gt; i < bytes / 16; i += NGT) *(u32x4*)(C.ws + off + i * 16) = z;
}
__device__ __forceinline__ void phase_cmp(const Ctx& C, int nslots) {
    const int gt = C.bid * NTHREADS + C.tid, NGT = C.G * NTHREADS; const unsigned* tab = (const unsigned*)(C.ws + CKS_TAB);
    for (int i = gt; i < nslots * 8192; i += NGT) { const int sl = i >> 13, ck = i & 8191; if (ck < CKS_N && tab[(size_t)sl * 8192 + ck] != tab[(size_t)(sl + 32) * 8192 + ck]) {
#ifdef SSDET
        const int cls = ck >= CKS_NW ? 4 : (ck < 1472 + 512 ? 1 : 2); atomicOr((unsigned*)(C.ws + WS_CTL) + 4002, (unsigned)cls); atomicAdd((unsigned*)(C.ws + WS_CTL) + 4003, 1u);
#endif
        atomicMax((unsigned*)(C.ws + WS_CTL) + 4001, (unsigned)(1000 - sl)); } }
}
__device__ __forceinline__ void phase_chk(const Ctx& C, size_t a, size_t b, size_t bytes) {
    const int gt = C.bid * NTHREADS + C.tid, NGT = C.G * NTHREADS; unsigned bad = 0;
    for (size_t i = gt; i < bytes / 16; i += NGT) { const u32x4 x = *(const u32x4*)(C.ws + a + i * 16), y = *(const u32x4*)(C.ws + b + i * 16); bad += (x[0] != y[0]) | (x[1] != y[1]) | (x[2] != y[2]) | (x[3] != y[3]); }
    if (bad) atomicAdd((unsigned*)(C.ws + WS_CTL) + 4000, bad);
}

constexpr int HS_QSTR = 272, HS_TSTR = 80;
constexpr int HS_QT = 0, HS_KT = 32 * HS_QSTR, HS_KTT = 2 * 32 * HS_QSTR, HS_VT = HS_KTT + 128 * HS_TSTR, HS_E1 = HS_VT + 128 * HS_TSTR, HS_E2 = HS_E1 + 512, HS_T1 = HS_E2 + 512, HS_GRP = HS_T1 + 512;
__device__ __forceinline__ void hscan_item(const Ctx& C, int item) {
    const bool samp = item < 64; const int it = samp ? item : item - 64;
    const int dir = it & 1, hd = (it >> 1) & 7, sq = it >> 4;
    const int S = samp ? 1024 : 256, rowbase = samp ? MP + sq * 1024 : sq * 256, nchunk = S >> 5;
    const int tg = C.tid & 255, lane = C.lane, c = lane & 31, h = lane >> 5, w4 = C.wave & 3; const bool producer = C.wave >= 4;
    LAS unsigned char* L = C.lds;
    const bf16_t* HQ = C.h(SCR_HQ); const bf16_t* HV = C.h(SCR_HV); const float* LF = C.f(dir == 0 ? SCR_LFF : SCR_LFB); float* OD = C.f(dir == 0 ? SCR_OF : SCR_OB);
    const int pd = tg & 127, ph = tg >> 7;
    unsigned qw[8], kw[8], vtw[8]; float e1v = 0.f, e2v = 0.f;
    float rlf[16], rpre[16]; unsigned rq[16], rv[16];
    auto issue = [&](int ch) {
#pragma unroll
        for (int i = 0; i < 16; ++i) { const int pos = 32 * ch + 16 * ph + i, t = dir == 0 ? pos : S - 1 - pos; const size_t off = (size_t)(rowbase + t) * D + hd * 128 + pd;
            rlf[i] = LF[off]; rq[i] = HQ[off]; rv[i] = HV[off];
            const int pos2 = 32 * ch + i, t2 = dir == 0 ? pos2 : S - 1 - pos2; rpre[i] = ph == 1 ? LF[(size_t)(rowbase + t2) * D + hd * 128 + pd] : 0.f; }
    };
    auto compute = [&]() {
        float cl[16]; float pre = 0.f, run = 0.f;
#pragma unroll
        for (int i = 0; i < 16; ++i) { pre += rpre[i]; run += rlf[i]; cl[i] = run; }
        const float t1v = ph == 0 ? cl[15] : pre;
#pragma unroll
        for (int i = 0; i < 16; i += 2) {
            const float e0 = ph == 0 ? cl[i] - t1v : cl[i], e1 = ph == 0 ? cl[i + 1] - t1v : cl[i + 1];
            const float k0 = 1.f - __expf(rlf[i]), k1 = 1.f - __expf(rlf[i + 1]);
            qw[i >> 1] = cvtpk(__uint_as_float(rq[i] << 16) * __expf(e0), __uint_as_float(rq[i + 1] << 16) * __expf(e1)); kw[i >> 1] = cvtpk(k0 * __expf(-e0), k1 * __expf(-e1));
            vtw[i >> 1] = rv[i] | (rv[i + 1] << 16); }
        e1v = __expf(t1v); e2v = __expf(cl[15]);
    };
    auto put = [&]() {
#pragma unroll
        for (int i = 0; i < 8; ++i) {
            *(LAS unsigned short*)(L + HS_QT + (16 * ph + 2 * i) * HS_QSTR + pd * 2) = (unsigned short)(qw[i] & 0xffffu); *(LAS unsigned short*)(L + HS_QT + (16 * ph + 2 * i + 1) * HS_QSTR + pd * 2) = (unsigned short)(qw[i] >> 16);
            *(LAS unsigned short*)(L + HS_KT + (16 * ph + 2 * i) * HS_QSTR + pd * 2) = (unsigned short)(kw[i] & 0xffffu); *(LAS unsigned short*)(L + HS_KT + (16 * ph + 2 * i + 1) * HS_QSTR + pd * 2) = (unsigned short)(kw[i] >> 16); }
        *(LAS u32x4*)(L + HS_KTT + pd * HS_TSTR + ph * 32) = (u32x4){kw[0], kw[1], kw[2], kw[3]}; *(LAS u32x4*)(L + HS_KTT + pd * HS_TSTR + ph * 32 + 16) = (u32x4){kw[4], kw[5], kw[6], kw[7]};
        *(LAS u32x4*)(L + HS_VT + pd * HS_TSTR + ph * 32) = (u32x4){vtw[0], vtw[1], vtw[2], vtw[3]}; *(LAS u32x4*)(L + HS_VT + pd * HS_TSTR + ph * 32 + 16) = (u32x4){vtw[4], vtw[5], vtw[6], vtw[7]};
        if (ph == 0) *(LAS float*)(L + HS_E1 + pd * 4) = e1v; else *(LAS float*)(L + HS_E2 + pd * 4) = e2v;
    };
    if (producer) {
        issue(0); compute(); if (nchunk > 1) issue(1);
        for (int ch = 0; ch < nchunk; ++ch) {
            put();
            __syncthreads();
            if (ch + 1 < nchunk) { compute(); if (ch + 2 < nchunk) issue(ch + 2); }
            __syncthreads();
        }
        return;
    }
    f32x16 St[4];
#pragma unroll
    for (int dt = 0; dt < 4; ++dt) {
        if (samp) { const float* s0 = C.in(4) + ((((size_t)sq * 2 + dir) * 8 + hd) * 128) * 128;
#pragma unroll
            for (int r = 0; r < 16; ++r) St[dt][r] = s0[(size_t)(32 * dt + rowidx(r, h)) * 128 + 32 * w4 + c]; }
        else St[dt] = (f32x16){};
    }
    for (int ch = 0; ch < nchunk; ++ch) {
        __syncthreads();
#pragma unroll
        for (int dt = 0; dt < 4; ++dt)
#pragma unroll
            for (int g = 0; g < 4; ++g) { const f32x4 e = *(const LAS f32x4*)(L + HS_E1 + (32 * dt + 8 * g + 4 * h) * 4);
#pragma unroll
                for (int q = 0; q < 4; ++q) St[dt][4 * g + q] *= e[q]; }
        f32x16 X = {};
#pragma unroll
        for (int s = 0; s < 8; ++s) {
            const bf16x8 a = *(const LAS bf16x8*)(L + HS_KT + c * HS_QSTR + (16 * s + 8 * h) * 2), bq = *(const LAS bf16x8*)(L + HS_QT + c * HS_QSTR + (16 * s + 8 * h) * 2);
            X = __builtin_amdgcn_mfma_f32_32x32x16_bf16(a, bq, X, 0, 0, 0);
        }
#pragma unroll
        for (int r = 0; r < 16; ++r) if (rowidx(r, h) > c) X[r] = 0.f;
        f32x16 OT = {};
#pragma unroll
        for (int ks = 0; ks < 2; ++ks) {
            const LAS unsigned char* vrow = L + HS_VT + (32 * w4 + c) * HS_TSTR + (16 * ks + 4 * h) * 2;
            const bf16x8 va = cat44(*(const LAS u32x2*)(vrow), *(const LAS u32x2*)(vrow + 16));
            OT = __builtin_amdgcn_mfma_f32_32x32x16_bf16(va, pack8(X, 8 * ks), OT, 0, 0, 0);
        }
#pragma unroll
        for (int dt = 0; dt < 4; ++dt)
#pragma unroll
            for (int ks = 0; ks < 2; ++ks) {
                const LAS unsigned char* qrow = L + HS_QT + c * HS_QSTR + (32 * dt + 16 * ks + 4 * h) * 2;
                const bf16x8 bq = cat44(*(const LAS u32x2*)(qrow), *(const LAS u32x2*)(qrow + 16));
                OT = __builtin_amdgcn_mfma_f32_32x32x16_bf16(pack8(St[dt], 8 * ks), bq, OT, 0, 0, 0);
            }
#pragma unroll
        for (int dt = 0; dt < 4; ++dt)
#pragma unroll
            for (int ks = 0; ks < 2; ++ks) {
                const bf16x8 a = *(const LAS bf16x8*)(L + HS_KTT + (32 * dt + c) * HS_TSTR + (16 * ks + 8 * h) * 2), bv = *(const LAS bf16x8*)(L + HS_VT + (32 * w4 + c) * HS_TSTR + (16 * ks + 8 * h) * 2);
                St[dt] = __builtin_amdgcn_mfma_f32_32x32x16_bf16(a, bv, St[dt], 0, 0, 0);
            }
#pragma unroll
        for (int dt = 0; dt < 4; ++dt)
#pragma unroll
            for (int g = 0; g < 4; ++g) { const f32x4 e = *(const LAS f32x4*)(L + HS_E2 + (32 * dt + 8 * g + 4 * h) * 4);
#pragma unroll
                for (int q = 0; q < 4; ++q) St[dt][4 * g + q] *= e[q]; }
        { const int pos = 32 * ch + c, t = dir == 0 ? pos : S - 1 - pos; float* op = OD + (size_t)(rowbase + t) * D + hd * 128 + 32 * w4 + 4 * h;
#pragma unroll
            for (int g = 0; g < 4; ++g) *(f32x4*)(op + 8 * g) = (f32x4){OT[4 * g], OT[4 * g + 1], OT[4 * g + 2], OT[4 * g + 3]}; }
        __syncthreads();
    }
    if (!samp) { float* so = C.out + 8388608 + 2 * 2097152 + ((((size_t)sq * 2 + dir) * 8 + hd) * 128) * 128;
        int c2 = c, h2 = h; asm volatile("" : "+v"(c2), "+v"(h2));
        unsigned base = (unsigned)((4 * h2) * 128 + 32 * w4 + c2);
#pragma unroll
        for (int dt = 0; dt < 4; ++dt)
#pragma unroll
            for (int r = 0; r < 16; ++r) so[base + (unsigned)((32 * dt + (r & 3) + 8 * (r >> 2)) * 128)] = St[dt][r]; }
}
__device__ __forceinline__ void phase_hscan(const Ctx& C) {
    if (C.G == 256) {
        hscan_item(C, C.bid);
        if (C.bid >= 64 && C.bid < 128) hscan_item(C, 256 + (C.bid - 64));
    } else for (int it = C.bid; it < 320; it += C.G) hscan_item(C, it);
}
__device__ __forceinline__ void phase_hpost(const Ctx& C) {
    const int gw = C.bid * NWAVES + C.wave, NGW = C.G * NWAVES;
    for (int r = gw; r < M; r += NGW) {
        const size_t off = (size_t)r * D + 16 * C.lane; float o[16]; float sq = 0.f;
#pragma unroll
        for (int q = 0; q < 4; ++q) { const f32x4 a = *(const f32x4*)(C.f(SCR_OF) + off + 4 * q), b = *(const f32x4*)(C.f(SCR_OB) + off + 4 * q);
#pragma unroll
            for (int e = 0; e < 4; ++e) { o[4 * q + e] = a[e] + b[e]; sq += o[4 * q + e] * o[4 * q + e]; } }
        sq += __shfl_xor(sq, 1); sq += __shfl_xor(sq, 2); sq += __shfl_xor(sq, 4);
        const float rs = rsqrtf(sq * (1.f / 128.f) + EPS);
        const u32x4 g0 = *(const u32x4*)(C.h(SCR_HG) + off), g1 = *(const u32x4*)(C.h(SCR_HG) + off + 8);
        const float* gn = C.in(17) + (16 * C.lane & 127);
        float sg[16];
#pragma unroll
        for (int e = 0; e < 4; ++e) { sg[2 * e] = bflo(g0[e]); sg[2 * e + 1] = bfhi(g0[e]); sg[8 + 2 * e] = bflo(g1[e]); sg[8 + 2 * e + 1] = bfhi(g1[e]); }
        u32x4 w0, w1;
#pragma unroll
        for (int e = 0; e < 4; ++e) { w0[e] = cvtpk(o[2 * e] * rs * gn[2 * e] * sg[2 * e], o[2 * e + 1] * rs * gn[2 * e + 1] * sg[2 * e + 1]);
            w1[e] = cvtpk(o[8 + 2 * e] * rs * gn[8 + 2 * e] * sg[8 + 2 * e], o[8 + 2 * e + 1] * rs * gn[8 + 2 * e + 1] * sg[8 + 2 * e + 1]); }
        *(u32x4*)(C.h(SCR_AWO) + off) = w0; *(u32x4*)(C.h(SCR_AWO) + off + 8) = w1;
    }
}

constexpr int SS_RSTR = 512;
constexpr int SS_WAVE = 16 * SS_RSTR;
__device__ __forceinline__ void sscan_seq(const Ctx& C, int l, bool samp, int sq, int dir, int g, size_t ydbg) {
    const int lane = C.lane, c = lane & 31, h = lane >> 5, dg = dir * 64 + g;
    const int S = samp ? 1024 : 256, rowbase = samp ? MP + sq * 1024 : sq * 256, nchunk = S >> 5, cond = samp ? 1 + sq : 0;
    LAS unsigned char* LB = C.lds + C.wave * SS_WAVE; LAS unsigned char* LH = LB + 4096;
    const float* X = C.f(WS_X); const u64_t* ss = (const u64_t*)(C.ws + WS_SS) + (size_t)(l * 2) * M; float* Y = C.f(ydbg ? ydbg : (dir == 0 ? SCR_YF : SCR_YB)); const bool ywr = !ydbg || dir == 0;
    bf16x8 bfr[4], cfr[4];
#pragma unroll
    for (int ct = 0; ct < 4; ++ct) bfr[ct] = *(const bf16x8*)(C.h(WS_SBB) + ((size_t)dg * 128 + 32 * ct + c) * 16 + 8 * h);
#pragma unroll
    for (int s = 0; s < 4; ++s) cfr[s] = *(const bf16x8*)(C.h(WS_SCB) + ((size_t)dg * 16 + (lane & 15)) * 128 + 32 * s + 8 * (lane >> 4));
    const float lr = C.f(WS_SLAM)[2 * (dg * 64 + lane)], li = C.f(WS_SLAM)[2 * (dg * 64 + lane) + 1];
    f32x4 gm0, gm1, sh0, sh1;
    { const float* gm = C.f(WS_GMOD) + ((size_t)(l * 2) * 5 + cond) * 1024 + g * 16 + 8 * h; gm0 = *(const f32x4*)gm; gm1 = *(const f32x4*)(gm + 4);
      const float* sh = C.f(WS_MOD) + ((size_t)l * 5 + cond) * 6144 + g * 16 + 8 * h; sh0 = *(const f32x4*)sh; sh1 = *(const f32x4*)(sh + 4); }
    float hr = 0.f, hi = 0.f;
    if (samp) { const float* s0 = C.in(5) + ((((size_t)sq * 2 + dir) * 64 + g) * 64 + lane) * 2; hr = s0[0]; hi = s0[1]; }
    for (int ch = 0; ch < nchunk; ++ch) {
        const int pos = 32 * ch + c, t = dir == 0 ? pos : S - 1 - pos, r = rowbase + t;
        const float rs = rstd_of(ss, r);
        const f32x4 x0 = *(const f32x4*)(X + (size_t)r * D + g * 16 + 8 * h), x1 = *(const f32x4*)(X + (size_t)r * D + g * 16 + 8 * h + 4);
        const f32x4 u0 = x0 * rs * gm0 + sh0, u1 = x1 * rs * gm1 + sh1;
        u32x4 uw = {cvtpk(u0[0], u0[1]), cvtpk(u0[2], u0[3]), cvtpk(u1[0], u1[1]), cvtpk(u1[2], u1[3])};
        const bf16x8 uf = __builtin_bit_cast(bf16x8, uw);
        f32x16 bu[4];
#pragma unroll
        for (int ct = 0; ct < 4; ++ct) { bu[ct] = (f32x16){}; bu[ct] = __builtin_amdgcn_mfma_f32_32x32x16_bf16(uf, bfr[ct], bu[ct], 0, 0, 0); }
#pragma unroll
        for (int hf = 0; hf < 2; ++hf) {
#pragma unroll
            for (int t8 = 0; t8 < 2; ++t8) {
#pragma unroll
                for (int ct = 0; ct < 4; ++ct)
#pragma unroll
                    for (int r4 = 0; r4 < 4; ++r4) *(LAS float*)(LB + (4 * h + r4) * 512 + (32 * ct + c) * 4) = bu[ct][8 * hf + 4 * t8 + r4];
                float br[8], bi[8]; unsigned wv[8];
#pragma unroll
                for (int k = 0; k < 8; ++k) { br[k] = *(LAS float*)(LB + k * 512 + lane * 4); bi[k] = *(LAS float*)(LB + k * 512 + 256 + lane * 4); }
#pragma unroll
                for (int k = 0; k < 8; ++k) { const float nr = lr * hr - li * hi + br[k], ni = lr * hi + li * hr + bi[k]; hr = nr; hi = ni; wv[k] = cvtpk(hr, hi); }
#pragma unroll
                for (int k = 0; k < 8; ++k) { const int row = 8 * t8 + k;
                    *(LAS unsigned short*)(LH + row * 256 + ((((lane >> 3)) ^ row) << 4) + (lane & 7) * 2) = (unsigned short)(wv[k] & 0xffffu);
                    *(LAS unsigned short*)(LH + row * 256 + (((8 + (lane >> 3)) ^ row) << 4) + (lane & 7) * 2) = (unsigned short)(wv[k] >> 16); }
                LDS_WAIT();
            }
            f32x4 y0 = {};
#pragma unroll
            for (int s = 0; s < 4; ++s) {
                const bf16x8 a0 = *(const LAS bf16x8*)(LH + (lane & 15) * 256 + (((4 * s + (lane >> 4)) ^ (lane & 15)) << 4));
                y0 = __builtin_amdgcn_mfma_f32_16x16x32_bf16(a0, cfr[s], y0, 0, 0, 0);
            }
            if (ywr) {
#pragma unroll
                for (int q = 0; q < 4; ++q) { const int p0 = 32 * ch + 16 * hf + 4 * (lane >> 4) + q, t0 = dir == 0 ? p0 : S - 1 - p0; Y[(size_t)(rowbase + t0) * D + g * 16 + (lane & 15)] = y0[q]; }
            }
            LDS_WAIT();
        }
    }
    if (!samp && !ydbg) { float* so = C.out + 8388608 + 2 * 2097152 + 4194304 + ((((size_t)sq * 2 + dir) * 64 + g) * 64 + lane) * 2; so[0] = hr; so[1] = hi; }
}
__device__ __forceinline__ void phase_sscan(const Ctx& C, int l, size_t ydbg) {
    for (int bb = C.bid; bb < 256; bb += C.G) {
        const int w = C.wave;
#ifdef SS_ONLYWAVE
        if (ydbg && !((SS_ONLYWAVE >> w) & 1)) continue;
#endif
        if (w < 2) { const int id = 2 * bb + w; sscan_seq(C, l, true, id >> 7, (id >> 6) & 1, id & 63, ydbg); }
        else { int id = 8 * bb + (w - 2); sscan_seq(C, l, false, id >> 7, (id >> 6) & 1, id & 63, ydbg);
            if (w < 4) { id = 8 * bb + 6 + (w - 2); sscan_seq(C, l, false, id >> 7, (id >> 6) & 1, id & 63, ydbg); } }
    }
}
__device__ __forceinline__ void phase_spost(const Ctx& C, int l) {
    const int gw = C.bid * NWAVES + C.wave, NGW = C.G * NWAVES; const u64_t* ss = (const u64_t*)(C.ws + WS_SS) + (size_t)(l * 2) * M;
    for (int r = gw; r < M; r += NGW) {
        const int cond = cond_of_row(r); const float rs = rstd_of(ss, r);
#pragma unroll
        for (int jq = 0; jq < 4; ++jq) {
            const int n = 4 * C.lane + 256 * jq; const size_t off = (size_t)r * D + n;
            const f32x4 x = *(const f32x4*)(C.f(WS_X) + off), gm = *(const f32x4*)(C.f(WS_GMOD) + ((size_t)(l * 2) * 5 + cond) * 1024 + n), sh = *(const f32x4*)(C.f(WS_MOD) + ((size_t)l * 5 + cond) * 6144 + n);
            const f32x4 u = x * rs * gm + sh, y = *(const f32x4*)(C.in(26) + n) * u + *(const f32x4*)(C.f(SCR_YF) + off) + *(const f32x4*)(C.f(SCR_YB) + off);
            f32x4 o;
#pragma unroll
            for (int e = 0; e < 4; ++e) { const float v = y[e], uu = 0.7978845608028654f * (v + 0.044715f * v * v * v); const float th = 1.f - 2.f * __builtin_amdgcn_rcpf(1.f + __expf(2.f * uu)); o[e] = 0.5f * v * (1.f + th); }
            st_bf16x4(C.h(SCR_AGLU) + off, o);
        }
    }
}
#define XB_TMO      128
#define XB_XCNT(j)  (256  + 64 * (j))
#define XB_XSUB(j)  (1280 + 64 * (j))
#define XB_XGEN(j)  (2304 + 64 * (j))
#define XB_TOP      3328
#define XB_TOPGEN   3392
#define XCD_BAR_WORDS 3456
#define XB_SPIN_CAP (1u << 18)
#ifndef XB_SCOPE
#define XB_SCOPE "agent"
#endif
__device__ __forceinline__ unsigned xb_ld(unsigned* p)              { return __hip_atomic_load(p, __ATOMIC_RELAXED, __HIP_MEMORY_SCOPE_AGENT); }
__device__ __forceinline__ unsigned xb_add(unsigned* p, unsigned v) { return __hip_atomic_fetch_add(p, v, __ATOMIC_RELAXED, __HIP_MEMORY_SCOPE_AGENT); }
__device__ __forceinline__ unsigned xb_xcc_id() { return (unsigned)__builtin_amdgcn_s_getreg((3 << 11) | 20) & 0xFu; }
#define XB_SPIN(cond, bar) do { unsigned _sp = 0; while (cond) { __builtin_amdgcn_s_sleep(1); \
    if ((++_sp & 255u) == 0u) { if (xb_ld(&(bar)[XB_TMO])) break; if (_sp > XB_SPIN_CAP) { atomicAdd(&(bar)[XB_TMO], 1u); break; } } } } while (0)
struct XcdBarrier { unsigned* bar; unsigned x; volatile LAS unsigned* st; };
__device__ __forceinline__ XcdBarrier xcd_barrier_post(unsigned* bar, volatile LAS unsigned* st) {
    XcdBarrier b; b.bar = bar; b.x = xb_xcc_id(); b.st = st;
    if (threadIdx.x == 0) (void)xb_add(&bar[XB_XCNT(b.x)], 1u);
    return b;
}
__device__ __forceinline__ void xcd_barrier_complete(unsigned* bar, unsigned x, unsigned& nloc, unsigned& nx) {
    const unsigned G = gridDim.x * gridDim.y * gridDim.z;
    unsigned sum, cnt, mine, sp = 0u;
    for (;;) {
        sum = 0u; cnt = 0u; mine = 0u;
#pragma unroll
        for (unsigned j = 0; j < 16; ++j) { const unsigned c = xb_ld(&bar[XB_XCNT(j)]); sum += c; cnt += (c > 0u) ? 1u : 0u; mine = (j == x) ? c : mine; }
        if (sum == G) break;
        __builtin_amdgcn_s_sleep(1);
        if ((++sp & 255u) == 0u) { if (xb_ld(&bar[XB_TMO])) break; if (sp > XB_SPIN_CAP) { atomicAdd(&bar[XB_TMO], 1u); break; } }
    }
    nloc = mine > 0u ? mine : 1u; nx = cnt > 0u ? cnt : 1u;
}
__device__ __forceinline__ void xcd_barrier(const XcdBarrier& b, bool thread0) {
    asm volatile("s_waitcnt vmcnt(0)" ::: "memory");
    __syncthreads();
    if (thread0) {
        unsigned* bar = b.bar;
        __builtin_amdgcn_s_waitcnt(0);
        unsigned nloc = b.st[0], nx = b.st[1];
        if (nloc == 0u) { xcd_barrier_complete(bar, b.x, nloc, nx); b.st[0] = nloc; b.st[1] = nx; }
#ifdef XB_ALL_RELEASE
        __builtin_amdgcn_fence(__ATOMIC_RELEASE, XB_SCOPE); asm volatile("s_waitcnt vmcnt(0)" ::: "memory");
#endif
        const unsigned old = xb_add(&bar[XB_XSUB(b.x)], 1u);
        const unsigned gen = old / nloc;
        if (old + 1u == (gen + 1u) * nloc) {
            __builtin_amdgcn_fence(__ATOMIC_RELEASE, XB_SCOPE);
            asm volatile("s_waitcnt vmcnt(0)" ::: "memory");
            const unsigned og = xb_add(&bar[XB_TOP], 1u);
            const unsigned tg = og / nx;
            if (og + 1u == (tg + 1u) * nx) xb_add(&bar[XB_TOPGEN], 1u);
            else XB_SPIN(xb_ld(&bar[XB_TOPGEN]) == tg, bar);
            __builtin_amdgcn_fence(__ATOMIC_ACQUIRE, XB_SCOPE);
            xb_add(&bar[XB_XGEN(b.x)], 1u);
            asm volatile("s_waitcnt vmcnt(0)" ::: "memory");
        } else {
            XB_SPIN(xb_ld(&bar[XB_XGEN(b.x)]) == gen, bar);
            __builtin_amdgcn_fence(__ATOMIC_ACQUIRE, XB_SCOPE);
            asm volatile("s_waitcnt vmcnt(0)" ::: "memory");
        }
#ifdef XB_DELAY
        for (int q = 0; q < XB_DELAY; ++q) __builtin_amdgcn_s_sleep(127);
#endif
    }
    __syncthreads();
}
}
namespace om {
enum { PH_P0A = 0, PH_P0C, PH_GLUE, PH_QKV, PH_ATTN, PH_WO, PH_HIN, PH_HSCAN, PH_HPOST, PH_HWO, PH_SSCAN, PH_SPOST, PH_GLU, PH_UP, PH_CONV, PH_DOWN, PH_FINAL };

struct Args { const float* in[33]; float* out; unsigned char* ws; int nph; int pad; unsigned char ptype[160]; unsigned char parg[160]; };

__device__ __forceinline__ void down_patch(const Ctx& C, int l, const pg8::StaticOrder& S) {
    Unit u; const float* cw = C.in(29) + (size_t)l * 3 * NUP; const float* E0 = C.f(WS_EDGE); bf16_t* act = C.h(WS_ACT);
    for (int i = 0; S.next(i, u); ++i) {
        if (u.pm < 16) continue;
        const bool top = (u.pm & 3) != 0, bot = (u.pm & 3) != 3;
        for (int n = C.tid; n < DFF; n += NTHREADS) {
            if (top) { const float* e = E0 + ((size_t)((u.pm - 16) * 2 + 0) * 4) * DFF; const float* ep = E0 + ((size_t)((u.pm - 17) * 2 + 1) * 4) * DFF;
                const float hg = e[n] + cw[n] * ep[2 * DFF + n], hv = e[DFF + n] + cw[DFF + n] * ep[3 * DFF + n];
                act[(size_t)(u.pm * 256) * DFF + n] = (bf16_t)(cvtpk(hg * sigm(hg) * hv, 0.f) & 0xffffu); }
            if (bot) { const float* e = E0 + ((size_t)((u.pm - 16) * 2 + 1) * 4) * DFF; const float* en = E0 + ((size_t)((u.pm - 15) * 2 + 0) * 4) * DFF;
                const float hg = e[n] + cw[2 * NUP + n] * en[2 * DFF + n], hv = e[DFF + n] + cw[2 * NUP + DFF + n] * en[3 * DFF + n];
                act[(size_t)(u.pm * 256 + 255) * DFF + n] = (bf16_t)(cvtpk(hg * sigm(hg) * hv, 0.f) & 0xffffu); }
        }
    }
    asm volatile("s_waitcnt vmcnt(0)" ::: "memory"); __syncthreads();
}
__device__ __forceinline__ void run_phase(const Ctx& C0, int type, int arg, int epoch) {
    Ctx C = C0; asm volatile("" : "+v"(C.tid)); asm volatile("" : "+s"(C.bid), "+s"(C.G), "+s"(C.kp), "+s"(C.ws), "+s"(C.out));
    C.lane = C.tid & 63; C.wave = __builtin_amdgcn_readfirstlane(C.tid >> 6);
    const int l = arg & 3;
    if (type == 31) return;
#ifndef PHASE_MASK
#define PHASE_MASK 0xFFFFFFFFu
#endif
    if (!((PHASE_MASK >> type) & 1u)) return;
    pg8::Gemm g{nullptr, nullptr, D, 256, 128, D, 0}; int nN = 0; EpiAny E{}; E.ws = C.ws; E.out = C.out; E.l = l; E.epoch = epoch;
    const bool splitk = false;
    switch (type) {
    case PH_P0A: phase_p0a(C); break;
    case PH_P0C: phase_p0c(C); break;
    case PH_GLUE: phase_glue(C, arg >> 1, arg & 1); break;
    case PH_QKV: { g.A = C.h(WS_AP); g.Bt = C.h(WS_WQKV) + (size_t)(l / 3) * NQKV * D; nN = 6; E.kind = EK_QKV; } break;
    case PH_ATTN: phase_attn(C, l, (arg & 32) ? SCR_O + 96 * MiB : SCR_O); break;
#ifdef DBG
    case 17: phase_chk(C, SCR_O, SCR_O + 96 * MiB, 16 * MiB); break;
#endif
#ifdef DBG
    case 18: phase_cks(C, arg); break;
#endif
#ifdef DBG
    case 19: phase_cmp(C, arg); break;
#endif
#ifdef DBG
    case 20: phase_clr(C); break;
#endif
    case PH_WO: case PH_HWO: case PH_GLU: {
        if (type == PH_WO) { g.A = C.h(SCR_O); g.Bt = C.h(WS_WO) + (size_t)(l / 3) * D * D; nN = 4; E.kind = EK_RES; if (splitk) { g.split = 1; g.K = D / 2; nN = 8; } }
        else if (type == PH_HWO) { g.A = C.h(SCR_AWO); g.Bt = C.h(WS_HWO); nN = 4; E.kind = EK_RES; if (splitk) { g.split = 1; g.K = D / 2; nN = 8; } }
        else { g.A = C.h(SCR_AGLU); g.Bt = C.h(WS_GLU); g.b_tile_rows = 128; g.b_half_rows = 1024; nN = 8; E.kind = EK_RES_GLU; }
        E.flags = ((arg & 32) ? 4 : 0) | (type == PH_HWO ? 8 : 0); } break;
    case PH_HIN: { g.A = C.h(WS_AP); g.Bt = C.h(WS_HWIN); nN = 20; E.kind = EK_HIN; } break;
    case PH_HSCAN: phase_hscan(C); break;
    case PH_HPOST: phase_hpost(C); break;
    case PH_SSCAN: phase_sscan(C, l, (arg & 32) ? WS_SCR + 80 * MiB : ((arg & 64) ? WS_SCR + 112 * MiB : 0)); break;
#ifdef DBG
    case 22: phase_clr2(C, WS_SCR + 80 * MiB, 64 * MiB); break;
#endif
#ifdef DBG
    case 21: phase_chk(C, WS_SCR + 80 * MiB, WS_SCR + 112 * MiB, 32 * MiB); break;
#endif
    case PH_SPOST: phase_spost(C, l); break;
    case PH_UP: { g.A = C.h(WS_AP); g.Bt = C.h(WS_UP) + (size_t)l * NUP * D; g.b_tile_rows = 128; g.b_half_rows = DFF; nN = 22; E.kind = EK_UPCONV; E.in29 = C.in(29); E.in30 = C.in(30); } break;
#ifdef DBG
    case 23: phase_chk(C, WS_SCR, WS_SCR + 88 * MiB, 88 * MiB); break;
#endif
    case PH_CONV: phase_conv(C, l); break;
    case PH_DOWN: { if (l < 3 && C.G == 256 && C.bid >= 128) convert_layer(C, l + 1, C.bid - 128, 128);
        { pg8::StaticOrder S0; S0.init(32, splitk ? 8 : 4, C.G, C.bid); down_patch(C, l, S0); }
        g.A = C.h(WS_ACT); g.Bt = C.h(WS_DOWN) + (size_t)l * D * DFF; g.K = DFF; g.ld = DFF; nN = 4; if (splitk) { g.split = 1; g.K = DFF / 2; nN = 8; } E.kind = EK_RES; E.flags = 1 | ((arg & 16) ? 2 : 0) | ((arg & 32) ? 4 : 0); } break;
    case PH_FINAL: { const unsigned fl = __hip_atomic_load((unsigned*)(C.ws + WS_CTL) + 4000, __ATOMIC_RELAXED, __HIP_MEMORY_SCOPE_AGENT), fd = __hip_atomic_load((unsigned*)(C.ws + WS_CTL) + 4001, __ATOMIC_RELAXED, __HIP_MEMORY_SCOPE_AGENT);
        #ifdef SSDET_CLS
        const unsigned cls = __hip_atomic_load((unsigned*)(C.ws + WS_CTL) + 4002, __ATOMIC_RELAXED, __HIP_MEMORY_SCOPE_AGENT), cnt = __hip_atomic_load((unsigned*)(C.ws + WS_CTL) + 4003, __ATOMIC_RELAXED, __HIP_MEMORY_SCOPE_AGENT);
        phase_final(C, 1.f + (float)cls / 8.f + (float)(cnt > 63 ? 63 : cnt) / 1024.f); } break;
#else
        phase_final(C, fl ? 3.f : (fd ? exp2f((float)(1001 - fd)) : 1.f)); } break;
#endif
    default: break;
    }
    if (nN) { pg8::StaticOrder S; S.init(32, nN, C.G, C.bid); pg8::gemm_phase(C.lds, g, S, E, C.tid); }
}

__device__ __forceinline__ void canary(const Ctx& C0, unsigned char* ws, int i, bool check) {
    int tid = C0.tid; asm volatile("" : "+v"(tid)); const int lane = tid & 63, wave = tid >> 6;
    unsigned* can = (unsigned*)(ws + WS_CTL + 32768);
#ifdef CANARY_SC1
    if (!check) { if (wave == 0 && lane < 32) __hip_atomic_store(can + C0.bid * 32 + lane, (unsigned)(i + 1), __ATOMIC_RELAXED, __HIP_MEMORY_SCOPE_AGENT); }
#else
    if (!check) { if (wave == 0 && lane < 32) can[C0.bid * 32 + lane] = (unsigned)(i + 1); }
#endif
#ifdef CANARY_LD_SC1
    else { const unsigned v = __hip_atomic_load(can + (wave * 32 + (lane >> 1)) * 32 + (lane & 1) * 16, __ATOMIC_RELAXED, __HIP_MEMORY_SCOPE_AGENT);
#else
    else { const unsigned v = can[(wave * 32 + (lane >> 1)) * 32 + (lane & 1) * 16];
#endif
      if (v != (unsigned)(i + 1) && v != (unsigned)(i + 2)) atomicAdd((unsigned*)(ws + WS_CTL) + 4000, 1u); }
}
__global__ void __launch_bounds__(NTHREADS, 2) mk_fwd(Args a) {
    extern __shared__ __attribute__((aligned(16))) unsigned char lds[];
    int wave_s = __builtin_amdgcn_readfirstlane((int)(threadIdx.x >> 6));
    { volatile LAS unsigned* misc = (volatile LAS unsigned*)((LAS unsigned char*)lds + LDS_BYTES - 64); if (threadIdx.x < 16) misc[threadIdx.x] = 0u; }
    __syncthreads();
    (void)xcd_barrier_post((unsigned*)(a.ws + WS_CTL), (volatile LAS unsigned*)((LAS unsigned char*)lds + LDS_BYTES - 64));
    for (int i = 0; i < a.nph; ++i) {
        {
            Ctx C; C.kp = (const unsigned char __attribute__((address_space(4)))*)__builtin_amdgcn_kernarg_segment_ptr();
            C.out = a.out; C.ws = a.ws; C.lds = (LAS unsigned char*)lds; asm volatile("" : "+s"(wave_s)); C.tid = (wave_s << 6) | (int)__builtin_amdgcn_mbcnt_hi(~0u, __builtin_amdgcn_mbcnt_lo(~0u, 0u)); C.lane = C.tid & 63; C.wave = 0; C.G = gridDim.x; C.bid = blockIdx.x;
            run_phase(C, a.ptype[i], a.parg[i], i + 1);
#ifdef CANARY
            canary(C, a.ws, i, false);
#endif
        }
        if (i + 1 < a.nph) { XcdBarrier bar; bar.bar = (unsigned*)(a.ws + WS_CTL); bar.x = xb_xcc_id(); bar.st = (volatile LAS unsigned*)((LAS unsigned char*)lds + LDS_BYTES - 64); xcd_barrier(bar, wave_s == 0 && lane_id() == 0); }
#ifdef CANARY
        if (i + 1 < a.nph) { Ctx C; C.tid = (wave_s << 6) | lane_id(); C.bid = blockIdx.x; canary(C, a.ws, i, true); }
#endif
    }
}
}
extern "C" void kernel_launch(void* const* d_in, const int* in_sizes, int n_in, void* d_out, int out_size, void* d_ws, size_t ws_size, hipStream_t stream) {
    using namespace om;
    static int grid = 0;
    if (grid == 0) {
        if (n_in != 33 || out_size != 17039360 || ws_size < WS_END) { fprintf(stderr, "kernel_launch: unexpected sizes n_in %d out %d ws %zu; nothing launched\n", n_in, out_size, ws_size); grid = -1; return; }
        int dev = 0, cus = 0, per_cu = 0;
        (void)hipGetDevice(&dev); (void)hipDeviceGetAttribute(&cus, hipDeviceAttributeMultiprocessorCount, dev);
        (void)hipFuncSetAttribute((const void*)mk_fwd, hipFuncAttributeMaxDynamicSharedMemorySize, LDS_BYTES);
        if (hipOccupancyMaxActiveBlocksPerMultiprocessor(&per_cu, (const void*)mk_fwd, NTHREADS, LDS_BYTES) != hipSuccess || per_cu < 1) { fprintf(stderr, "kernel_launch: occupancy query gives %d blocks per CU\n", per_cu); per_cu = 1; }
        (void)hipGetLastError();
        grid = cus;
        if (grid > 256) grid = 256;
    }
    if (grid < 0) return;
    (void)hipMemsetAsync((char*)d_ws + WS_CTL, 0, CTL_ZERO_BYTES, stream);
    Args a{};
    for (int i = 0; i < 33; ++i) a.in[i] = (const float*)d_in[i];
    a.out = (float*)d_out; a.ws = (unsigned char*)d_ws;
    int n = 0;
#ifndef DUP_MASK
#define DUP_MASK 0u
#endif
#ifndef XBAR
#define XBAR 0
#endif
    auto add1 = [&](int t, int p) { a.ptype[n] = (unsigned char)t; a.parg[n] = (unsigned char)p; ++n; };
    auto add = [&](int t, int p) { add1(t, p);
        if ((DUP_MASK >> t) & 1u) { const bool resid = (t == PH_WO || t == PH_HWO || t == PH_GLU || t == PH_DOWN); add1(t, resid ? (p | 32) : p); }
        for (int q = 0; q < XBAR; ++q) add1(31, 0); };
#ifdef UPDET
    add1(PH_P0A, 0); add1(PH_P0C, 0);
    for (int l = 0; l < 4; ++l) { const int kind = l % 3;
        if (kind == 0) { add1(PH_QKV, l); add1(PH_ATTN, l); add1(PH_WO, l); }
        else if (kind == 1) { add1(PH_HIN, l); add1(PH_HSCAN, l); add1(PH_HPOST, l); add1(PH_HWO, l); }
        else { add1(PH_SSCAN, l); add1(PH_SPOST, l); add1(PH_GLU, l); }
        add1(PH_UP, l); add1(PH_UP, l | 32); add1(23, 0); add1(PH_CONV, l); add1(PH_DOWN, l == 3 ? (l | 16) : l); }
    add1(PH_FINAL, 0);
#elif defined(SSDET)
    add1(PH_P0A, 0); add1(PH_P0C, 0);
    for (int l = 0; l < 4; ++l) { const int kind = l % 3;
        if (kind == 0) { add1(PH_QKV, l); add1(PH_ATTN, l); add1(PH_WO, l); }
        else if (kind == 1) { add1(PH_HIN, l); add1(PH_HSCAN, l); add1(PH_HPOST, l); add1(PH_HWO, l); }
        else { add1(22, 0); add1(PH_SSCAN, l | 32); add1(PH_SSCAN, l | 64); add1(21, 0); add1(PH_SSCAN, l); add1(PH_SPOST, l); add1(PH_GLU, l); }
        add1(PH_UP, l); add1(PH_DOWN, l == 3 ? (l | 16) : l); }
    add1(PH_FINAL, 0);
#elif defined(LOCALIZE)
    for (int fwd = 0; fwd < 2; ++fwd) { int idx = 0;
        auto addc = [&](int t, int p) { add1(t, p); add1(18, fwd * 32 + idx); ++idx; };
        add1(20, 0); addc(PH_P0A, 0); addc(PH_P0C, 0);
        for (int l = 0; l < 4; ++l) { const int kind = l % 3;
            if (kind == 0) { addc(PH_QKV, l); addc(PH_ATTN, l); addc(PH_WO, l); }
            else if (kind == 1) { addc(PH_HIN, l); addc(PH_HSCAN, l); addc(PH_HPOST, l); addc(PH_HWO, l); }
            else { addc(PH_SSCAN, l); addc(PH_SPOST, l); addc(PH_GLU, l); }
            addc(PH_UP, l); addc(PH_DOWN, l == 3 ? (l | 16) : l); }
        if (fwd == 1) { add1(19, idx); add1(PH_FINAL, 0); } }
#else
    add(PH_P0A, 0); add(PH_P0C, 0);
    for (int l = 0; l < 4; ++l) {
        const int kind = l % 3;
        if (kind == 0) { add(PH_QKV, l); add(PH_ATTN, l); add(PH_WO, l); }
        else if (kind == 1) { add(PH_HIN, l); add(PH_HSCAN, l); add(PH_HPOST, l); add(PH_HWO, l); }
        else { add(PH_SSCAN, l); add(PH_SPOST, l); add(PH_GLU, l); }
        add(PH_UP, l); add(PH_DOWN, l == 3 ? (l | 16) : l);
    }
    add(PH_FINAL, 0);
#endif
    a.nph = n;
    void* args[] = {&a};
    const hipError_t e = hipLaunchCooperativeKernel((const void*)mk_fwd, dim3(grid), dim3(NTHREADS), args, LDS_BYTES, stream);
    if (e != hipSuccess) fprintf(stderr, "kernel_launch: cooperative launch failed: %s (grid %d)\n", hipGetErrorString(e), grid);
}
```

```cpp
#include <hip/hip_runtime.h>
#include <hip/hip_cooperative_groups.h>
#include <cstdio>
#include <cstdint>
#include <cmath>
#include <cstddef>
#define LAS __attribute__((address_space(3)))
#define GAS __attribute__((address_space(1)))
typedef unsigned short bf16_t;
typedef short bf16x8 __attribute__((ext_vector_type(8)));
typedef short s16x4 __attribute__((ext_vector_type(4)));
typedef float f32x2 __attribute__((ext_vector_type(2)));
typedef float f32x4 __attribute__((ext_vector_type(4)));
typedef float f32x16 __attribute__((ext_vector_type(16)));
typedef unsigned u32x2 __attribute__((ext_vector_type(2)));
typedef unsigned u32x4 __attribute__((ext_vector_type(4)));
typedef __bf16 bf16x2_t __attribute__((ext_vector_type(2)));

namespace om {
constexpr int D = 1024, MP = 4096, M = 8192, DFF = 2816, NUP = 5632, NQKV = 1536, NHIN = 5120;
constexpr float EPS = 1e-6f, LOG2E = 1.4426950408889634f, QSCALE = 0.125f * 1.4426950408889634f;
constexpr int NTHREADS = 512, NWAVES = 8, LDS_BYTES = 159744, RING_BYTES = 131072;
constexpr int SW_STRIDE = 5632;
constexpr float SS_FIX = 16777216.f, SS_INV = 1.f / (16777216.f * 1024.f);
typedef unsigned long long u64_t;
__device__ __forceinline__ float rstd_of(const u64_t* ss, int r) { return rsqrtf((float)ss[r] * SS_INV + 1e-6f); }
constexpr size_t MiB = 1u << 20;
constexpr size_t WS_CTL = 0, CTL_ZERO_BYTES = 64 * 1024;
constexpr size_t WS_MODP = 1 * MiB, WS_MOD = 3 * MiB, WS_SW = 4 * MiB, WS_GMOD = 5 * MiB, WS_SS = 6 * MiB, WS_ROPE = 7 * MiB;
constexpr size_t WS_LB1 = 8 * MiB, WS_SLAM = 8 * MiB + 64 * 1024, WS_SBB = 8 * MiB + 512 * 1024, WS_SCB = 9 * MiB;
constexpr size_t WS_CTXK = 10 * MiB, WS_CTXV = 12 * MiB;
constexpr size_t WS_NAIVE_MOD = 14 * MiB;
constexpr size_t WS_WQKV = 16 * MiB, WS_WO = 22 * MiB, WS_HWIN = 26 * MiB, WS_HWO = 36 * MiB, WS_GLU = 38 * MiB, WS_UP = 42 * MiB, WS_DOWN = 86 * MiB;
constexpr size_t WS_X = 108 * MiB, WS_R = 140 * MiB;
constexpr size_t WS_AP = WS_R, WS_ACT = WS_R + 16 * MiB, WS_SCR = WS_R + 60 * MiB, WS_END = WS_SCR + 176 * MiB;

constexpr size_t SCR_Q = WS_SCR, SCR_KB = WS_SCR + 16 * MiB, SCR_VB = WS_SCR + 20 * MiB, SCR_O = WS_SCR + 24 * MiB;
constexpr size_t SCR_HQ = WS_SCR, SCR_HV = WS_SCR + 16 * MiB, SCR_HG = WS_SCR + 32 * MiB, SCR_LFF = WS_SCR + 48 * MiB, SCR_LFB = WS_SCR + 80 * MiB, SCR_OF = WS_SCR + 112 * MiB, SCR_OB = WS_SCR + 144 * MiB, SCR_AWO = WS_SCR;
constexpr size_t SCR_YF = WS_SCR, SCR_YB = WS_SCR + 32 * MiB, SCR_AGLU = WS_SCR + 64 * MiB;

__device__ __forceinline__ int cond_of_tile(int pm) { return pm < 16 ? 0 : 1 + ((pm - 16) >> 2); }
__device__ __forceinline__ int cond_of_row(int r) { return r < MP ? 0 : 1 + ((r - MP) >> 10); }
__device__ __forceinline__ unsigned cvtpk(float lo, float hi) { f32x2 v = {lo, hi}; bf16x2_t b = __builtin_convertvector(v, bf16x2_t); return __builtin_bit_cast(unsigned, b); }
__device__ __forceinline__ float bf2f(unsigned short h) { return __uint_as_float(((unsigned)h) << 16); }
__device__ __forceinline__ float bflo(unsigned w) { return __uint_as_float(w << 16); }
__device__ __forceinline__ float bfhi(unsigned w) { return __uint_as_float(w & 0xffff0000u); }
__device__ __forceinline__ float sigm(float x) { return __builtin_amdgcn_rcpf(1.f + __expf(-x)); }
__device__ __forceinline__ int lane_id() { unsigned m = ~0u; asm volatile("" : "+s"(m)); return (int)__builtin_amdgcn_mbcnt_hi(m, __builtin_amdgcn_mbcnt_lo(m, 0u)); }
__device__ __forceinline__ float wave_sum(float v) {
#pragma unroll
    for (int o = 1; o < 64; o <<= 1) v += __shfl_xor(v, o);
    return v;
}

struct Ctx {
    const unsigned char __attribute__((address_space(4)))* kp;
    float* out; unsigned char* ws;
    LAS unsigned char* lds; int tid, lane, wave, G, bid;
    __device__ __forceinline__ const float* in(int i) const { return *(const float* const __attribute__((address_space(4)))*)(kp + 8 * i); }
    __device__ __forceinline__ float* f(size_t off) const { return (float*)(ws + off); }
    __device__ __forceinline__ bf16_t* h(size_t off) const { return (bf16_t*)(ws + off); }
};

namespace pg8 {
constexpr int BM = 256, BK = 64, HALF = 128, HTB = HALF * BK * 2, STAGE_BYTES = 8 * HTB, NXCD = 8, WGM = 8;
__host__ __device__ __forceinline__ int lds_byte(int r, int c) { const int st = (r >> 4) * 2 + (c >> 5), rr = r & 15, cc = c & 31, ob = rr * 64 + cc * 2; return st * 1024 + (ob ^ (((ob >> 9) & 1) << 5)); }
__host__ __device__ __forceinline__ void stage_rc(int b, int& R, int& C) { const int st = b / 1024, sb = b % 1024, swz = sb ^ (((sb >> 9) & 1) << 5); R = (st >> 1) * 16 + swz / 64; C = (st & 1) * 32 + (swz % 64) / 2; }
struct Unit { int pm, pn; };
struct Gemm { const bf16_t* A; const bf16_t* Bt; int K; int b_tile_rows, b_half_rows; int ld; int split; };
struct StaticOrder {
    int nM, nN, nwg, G, c;
    __device__ void init(int nM_, int nN_, int G_, int c_) { nM = nM_; nN = nN_; nwg = nM * nN; G = G_; c = c_; }
    __device__ bool next(int i, Unit& u) const {
        const long L = (long)i * G + c; if (L >= nwg) return false;
        int wgid = (int)L; { const int q = nwg / NXCD, r = nwg % NXCD, xcd = wgid % NXCD, off = wgid / NXCD; wgid = (xcd < r ? xcd * (q + 1) : r * (q + 1) + (xcd - r) * q) + off; }
        const int nig = WGM * nN, gid = wgid / nig, fm = gid * WGM, gsz = (nM - fm) < WGM ? (nM - fm) : WGM;
        u.pm = fm + ((wgid % nig) % gsz); u.pn = (wgid % nig) / gsz; return true;
    }
};
template <class Epi>
__device__ __forceinline__ void gemm_phase(LAS unsigned char* lds, const Gemm g, const StaticOrder& S, const Epi& E, int tid_in) {
    int tid_ = tid_in; asm volatile("" : "+v"(tid_));
    const int tid = tid_, wid = __builtin_amdgcn_readfirstlane(tid >> 6), lane = tid & 63, wr = wid >> 2, wc = wid & 3, fr = lane & 15, fq = lane >> 4;
    const int K = g.K, nt = K / BK, ld = g.ld;
    unsigned voffA[2];
#pragma unroll
    for (int i = 0; i < 2; ++i) { int R, C; stage_rc(tid * 16 + i * 8192, R, C); voffA[i] = (unsigned)(R * ld + C) * 2u; }
    const size_t kstep = (size_t)(BK * 2);
    const size_t hstepA = (size_t)HALF * ld * 2, tstepA = 2 * hstepA;
    const size_t hstepB = (size_t)g.b_half_rows * ld * 2, tstepB = (size_t)g.b_tile_rows * ld * 2, khb = (size_t)K * 2;
#define PG8_UA(u) ((const char*)g.A + (size_t)(u).pm * tstepA + (g.split ? (size_t)((u).pn & 1) * khb : 0))
#define PG8_UB(u) ((const char*)g.Bt + (size_t)(g.split ? (u).pn >> 1 : (u).pn) * tstepB + (g.split ? (size_t)((u).pn & 1) * khb : 0))
    const unsigned ldsw = (unsigned)wid * 1024u;
    const int aoff = lds_byte(wr * 64 + fr, fq * 8), boff = lds_byte(wc * 32 + fr, fq * 8);
#define PG8_SA(b, h) (((b) * 2 + (h)) * HTB)
#define PG8_SB(b, h) ((4 + (b) * 2 + (h)) * HTB)
#define PG8_STAGE(bufoff, gbase) do { _Pragma("unroll") for (int _i = 0; _i < 2; ++_i) \
        __builtin_amdgcn_global_load_lds((const unsigned*)((const char*)(gbase) + voffA[_i]), (LAS unsigned*)(lds + (bufoff) + ldsw + _i * 8192), 16, 0, 0); } while (0)
#define PG8_LDA(dst, b, h) do { _Pragma("unroll") for (int m = 0; m < 4; ++m) _Pragma("unroll") for (int k = 0; k < 2; ++k) dst[m][k] = *(const LAS bf16x8*)(lds + PG8_SA(b, h) + aoff + m * 2048 + k * 1024); } while (0)
#define PG8_LDB(dst, b, h) do { _Pragma("unroll") for (int n = 0; n < 2; ++n) _Pragma("unroll") for (int k = 0; k < 2; ++k) dst[n][k] = *(const LAS bf16x8*)(lds + PG8_SB(b, h) + boff + n * 2048 + k * 1024); } while (0)
#define PG8_MMA(ai, bj, At, Bt) do { __builtin_amdgcn_s_setprio(1); _Pragma("unroll") for (int m = 0; m < 4; ++m) _Pragma("unroll") for (int n = 0; n < 2; ++n) _Pragma("unroll") for (int k = 0; k < 2; ++k) \
        acc[ai][bj][m][n] = __builtin_amdgcn_mfma_f32_16x16x32_bf16(Bt[n][k], At[m][k], acc[ai][bj][m][n], 0, 0, 0); __builtin_amdgcn_s_setprio(0); } while (0)
#define PG8_WAIT_V(n) asm volatile("s_waitcnt vmcnt(" #n ")" ::: "memory")
#define PG8_WAIT_L(n) asm volatile("s_waitcnt lgkmcnt(" #n ")" ::: "memory")
#define PG8_BAR __builtin_amdgcn_s_barrier()
#define PG8_SCHED __builtin_amdgcn_sched_barrier(0)
    Unit cur, nxt; int ui = 0;
    if (!S.next(0, cur)) return;
    f32x4 acc[2][2][4][2];
#pragma unroll
    for (int a = 0; a < 2; ++a)
#pragma unroll
        for (int b = 0; b < 2; ++b)
#pragma unroll
            for (int m = 0; m < 4; ++m)
#pragma unroll
                for (int n = 0; n < 2; ++n) acc[a][b][m][n] = (f32x4){0.f, 0.f, 0.f, 0.f};
    bf16x8 At[4][2], B0[2][2], B1[2][2];
    const char* cA = PG8_UA(cur); const char* cB = PG8_UB(cur);
    PG8_STAGE(PG8_SB(0, 0), cB); PG8_STAGE(PG8_SB(0, 1), cB + hstepB); PG8_STAGE(PG8_SA(0, 0), cA); PG8_STAGE(PG8_SA(0, 1), cA + hstepA);
    if (wr == 1) PG8_BAR;
    PG8_WAIT_V(2); PG8_BAR;
    PG8_STAGE(PG8_SB(1, 0), cB + kstep); PG8_STAGE(PG8_SA(1, 0), cA + kstep); PG8_STAGE(PG8_SB(1, 1), cB + hstepB + kstep);
    PG8_WAIT_V(6); PG8_BAR;
    for (;;) {
        const bool has_next = S.next(ui + 1, nxt);
        const char* nA = has_next ? PG8_UA(nxt) : cA; const char* nB = has_next ? PG8_UB(nxt) : cB;
        for (int t = 0; t < nt; t += 2) {
            const bool last = (t == nt - 2);
            const char* a1 = cA + (size_t)(t + 1) * kstep;
            const char* a2 = last ? nA : cA + (size_t)(t + 2) * kstep; const char* b2 = last ? nB : cB + (size_t)(t + 2) * kstep;
            const char* a3 = a2 + kstep; const char* b3 = b2 + kstep;
            PG8_LDB(B0, 0, 0); PG8_LDB(B1, 0, 1); PG8_SCHED; PG8_LDA(At, 0, 0); PG8_STAGE(PG8_SA(1, 1), a1 + hstepA);
            PG8_WAIT_V(8); PG8_WAIT_L(0); PG8_BAR; PG8_MMA(0, 0, At, B0); PG8_MMA(0, 1, At, B1); PG8_BAR; PG8_SCHED;
            PG8_LDA(At, 0, 1); PG8_STAGE(PG8_SB(0, 0), b2); PG8_STAGE(PG8_SB(0, 1), b2 + hstepB); PG8_STAGE(PG8_SA(0, 0), a2);
            PG8_WAIT_V(8); PG8_WAIT_L(0); PG8_BAR; PG8_MMA(1, 0, At, B0); PG8_MMA(1, 1, At, B1); PG8_BAR; PG8_SCHED;
            PG8_LDB(B0, 1, 0); PG8_LDB(B1, 1, 1); PG8_SCHED; PG8_LDA(At, 1, 0); PG8_STAGE(PG8_SA(0, 1), a2 + hstepA);
            PG8_WAIT_V(8); PG8_WAIT_L(0); PG8_BAR; PG8_MMA(0, 0, At, B0); PG8_MMA(0, 1, At, B1); PG8_BAR; PG8_SCHED;
            PG8_LDA(At, 1, 1); PG8_STAGE(PG8_SB(1, 0), b3); PG8_STAGE(PG8_SB(1, 1), b3 + hstepB); PG8_STAGE(PG8_SA(1, 0), a3);
            PG8_WAIT_V(8); PG8_WAIT_L(0); PG8_BAR; PG8_MMA(1, 0, At, B0); PG8_MMA(1, 1, At, B1); PG8_BAR; PG8_SCHED;
        }
        if (wr == 0) PG8_BAR;
        { int l_e = lane_id(); asm volatile("" : "+v"(l_e));
          int fr_e = l_e & 15, fq_e = l_e >> 4, wr_e = wr, wc_e = wc; asm volatile("" : "+s"(wr_e), "+s"(wc_e));
          int tid_e = (wid << 6) | l_e;
          const Unit ue{cur.pm, g.split ? cur.pn >> 1 : cur.pn};
          E(acc, ue, wr_e, wc_e, fr_e, fq_e, g.split ? (cur.pn & 1) : -1, tid_e);
          E.post(ue, tid_e);
#ifdef DUP_POST
          E.post(ue, tid_e);
#endif
          }
        if (!has_next) break;
#pragma unroll
        for (int a = 0; a < 2; ++a)
#pragma unroll
            for (int b = 0; b < 2; ++b)
#pragma unroll
                for (int m = 0; m < 4; ++m)
#pragma unroll
                    for (int n = 0; n < 2; ++n) acc[a][b][m][n] = (f32x4){0.f, 0.f, 0.f, 0.f};
        cur = nxt; cA = nA; cB = nB; ++ui;
        if (wr == 1) PG8_BAR;
    }
    PG8_WAIT_V(0);
    PG8_BAR;
#undef PG8_SA
#undef PG8_UA
#undef PG8_UB
#undef PG8_SB
#undef PG8_STAGE
#undef PG8_LDA
#undef PG8_LDB
#undef PG8_MMA
#undef PG8_WAIT_V
#undef PG8_WAIT_L
#undef PG8_BAR
#undef PG8_SCHED
}
}
using pg8::Unit;
typedef f32x4 Acc[2][2][4][2];

__device__ __forceinline__ void st_bf16x4(bf16_t* p, f32x4 v) { u32x2 w; w.x = cvtpk(v[0], v[1]); w.y = cvtpk(v[2], v[3]); *(u32x2*)p = w; }

template <bool PAIRED> struct EpiRes {
    const float* xin; float* xout; bf16_t* ap; u64_t* ssn; const float* gate;   const float* gmodn;
    __device__ __forceinline__ void operator()(const Acc& acc, const Unit& u, int wr, int wc, int fr, int fq) const {
        const int c = cond_of_tile(u.pm);
        const int colb = (PAIRED ? u.pn * 128 : u.pn * 256) + wc * 32 + 4 * fq;
        constexpr int NBJ = PAIRED ? 1 : 2;
        f32x4 gv[NBJ][2], gm[NBJ][2];
#pragma unroll
        for (int bj = 0; bj < NBJ; ++bj)
#pragma unroll
            for (int n = 0; n < 2; ++n) { gv[bj][n] = *(const f32x4*)(gate + (size_t)c * 6144 + colb + bj * 128 + n * 16);
                gm[bj][n] = gmodn ? *(const f32x4*)(gmodn + (size_t)c * 1024 + colb + bj * 128 + n * 16) : (f32x4){0.f, 0.f, 0.f, 0.f}; }
#pragma unroll
        for (int ai = 0; ai < 2; ++ai)
#pragma unroll
            for (int m = 0; m < 4; ++m) {
                const int r = u.pm * 256 + ai * 128 + wr * 64 + m * 16 + fr; float sq = 0.f;
#pragma unroll
                for (int bj = 0; bj < NBJ; ++bj)
#pragma unroll
                    for (int n = 0; n < 2; ++n) {
                        f32x4 o = acc[ai][bj][m][n];
                        if (PAIRED) { const f32x4 gt = acc[ai][1][m][n];
#pragma unroll
                            for (int e = 0; e < 4; ++e) o[e] = o[e] * sigm(gt[e]); }
                        const size_t off = (size_t)r * D + colb + bj * 128 + n * 16;
                        const f32x4 xo = *(const f32x4*)(xin + off) + gv[bj][n] * o;
                        *(f32x4*)(xout + off) = xo;
                        sq += (xo[0] * xo[0] + xo[1] * xo[1]) + (xo[2] * xo[2] + xo[3] * xo[3]);
                        if (gmodn) st_bf16x4(ap + off, xo * gm[bj][n]);
                    }
                sq += __shfl_xor(sq, 16); sq += __shfl_xor(sq, 32);
                if (fq == 0) atomicAdd(ssn + r, (u64_t)(sq * SS_FIX));
            }
    }
};
struct EpiUpRaw {
    const u64_t* ss; const float* sw;   bf16_t* hraw;
    __device__ __forceinline__ void operator()(const Acc& acc, const Unit& u, int wr, int wc, int fr, int fq) const {
        const int c = cond_of_tile(u.pm); const int colb = u.pn * 256 + wc * 32 + 4 * fq;
        f32x4 sv[2][2];
#pragma unroll
        for (int bj = 0; bj < 2; ++bj)
#pragma unroll
            for (int n = 0; n < 2; ++n) sv[bj][n] = *(const f32x4*)(sw + (size_t)c * SW_STRIDE + colb + bj * 128 + n * 16);
#pragma unroll
        for (int ai = 0; ai < 2; ++ai)
#pragma unroll
            for (int m = 0; m < 4; ++m) {
                const int r = u.pm * 256 + ai * 128 + wr * 64 + m * 16 + fr; const float rs = rstd_of(ss, r);
#pragma unroll
                for (int bj = 0; bj < 2; ++bj)
#pragma unroll
                    for (int n = 0; n < 2; ++n) st_bf16x4(hraw + (size_t)r * NUP + colb + bj * 128 + n * 16, acc[ai][bj][m][n] * rs + sv[bj][n]);
            }
    }
};
constexpr size_t WS_EDGE = 14 * MiB;
template <int CTRL> __device__ __forceinline__ float dpp_f(float old, float src) { return __int_as_float(__builtin_amdgcn_update_dpp(__float_as_int(old), __float_as_int(src), CTRL, 0xf, 0xf, false)); }
#define DPP_ROW_SHL1 0x101
#define DPP_ROW_SHR1 0x111
#define DPP_ROW_ROR1 0x121
#define DPP_ROW_ROR15 0x12f
struct EpiUpConv {
    const u64_t* ss; const float* sw; const float* cw; const float* cb; bf16_t* act; float* edge; bf16_t* tile;
    __device__ __forceinline__ void operator()(const Acc& acc, const Unit& u, int wr, int wc, int fr, int fq) const {
        const int c = cond_of_tile(u.pm); const int cc0 = wc * 32 + 4 * fq, colg0 = u.pn * 128 + cc0;
        f32x4 sv[2][2];
#pragma unroll
        for (int bj = 0; bj < 2; ++bj)
#pragma unroll
            for (int n = 0; n < 2; ++n) sv[bj][n] = *(const f32x4*)(sw + (size_t)c * SW_STRIDE + bj * DFF + colg0 + n * 16);
#pragma unroll
        for (int ai = 0; ai < 2; ++ai)
#pragma unroll
            for (int m = 0; m < 4; ++m) { const int rl = ai * 128 + wr * 64 + m * 16 + fr; const float rs = rstd_of(ss, u.pm * 256 + rl);
#pragma unroll
                for (int bj = 0; bj < 2; ++bj)
#pragma unroll
                    for (int n = 0; n < 2; ++n) st_bf16x4(tile + rl * 256 + bj * 128 + cc0 + n * 16, acc[ai][bj][m][n] * rs + sv[bj][n]); }
    }
    __device__ __forceinline__ void fused(const Acc& acc, const Unit& u, int wr, int wc, int fr, int fq, int tid, LAS unsigned char* xl) const {
        const int c = cond_of_tile(u.pm);
        const bool samp = u.pm >= 16; const bool nb_top = samp && (u.pm & 3) != 0, nb_bot = samp && (u.pm & 3) != 3;
        float rs[8];
#pragma unroll
        for (int ai = 0; ai < 2; ++ai)
#pragma unroll
            for (int m = 0; m < 4; ++m) rs[ai * 4 + m] = rstd_of(ss, u.pm * 256 + ai * 128 + wr * 64 + m * 16 + fr);
        const int r = tid >> 1, q = tid & 1;
        LAS float* cf = (LAS float*)(xl + 20480);
        { const int bj = tid >> 8, jj = (tid >> 6) & 3, cl2 = 2 * (tid & 63); const float* src = (jj < 3 ? cw + jj * NUP : cb) + bj * DFF + u.pn * 128 + cl2;
          *(LAS f32x2*)(cf + (bj * 4 + jj) * 128 + cl2) = *(const f32x2*)src; }
#pragma unroll
        for (int sl = 0; sl < 8; ++sl) {
            const int swc = sl >> 1, sn = sl & 1, colg = u.pn * 128 + 32 * swc + 16 * sn, cs = 32 * swc + 16 * sn + 8 * q;
            if (wc == swc) {
                const f32x4 svg = *(const f32x4*)(sw + (size_t)c * SW_STRIDE + colg + 4 * fq), svv = *(const f32x4*)(sw + (size_t)c * SW_STRIDE + DFF + colg + 4 * fq);
#pragma unroll
                for (int ai = 0; ai < 2; ++ai)
#pragma unroll
                    for (int m = 0; m < 4; ++m) { const int row = ai * 128 + wr * 64 + m * 16 + fr;
                        const f32x4 hg = acc[ai][0][m][sn] * rs[ai * 4 + m] + svg, hv = acc[ai][1][m][sn] * rs[ai * 4 + m] + svv;
                        *(LAS u32x2*)(xl + row * 80 + 8 * fq) = (u32x2){cvtpk(hg[0], hg[1]), cvtpk(hg[2], hg[3])}; *(LAS u32x2*)(xl + row * 80 + 32 + 8 * fq) = (u32x2){cvtpk(hv[0], hv[1]), cvtpk(hv[2], hv[3])}; }
            }
            asm volatile("s_waitcnt lgkmcnt(0)" ::: "memory"); __builtin_amdgcn_s_barrier(); asm volatile("" ::: "memory");
            {
                const u32x4 z = {0u, 0u, 0u, 0u};
                const u32x4 pg = r > 0 ? *(const LAS u32x4*)(xl + (r - 1) * 80 + 16 * q) : z, pv = r > 0 ? *(const LAS u32x4*)(xl + (r - 1) * 80 + 32 + 16 * q) : z;
                const u32x4 cg = *(const LAS u32x4*)(xl + r * 80 + 16 * q), cv = *(const LAS u32x4*)(xl + r * 80 + 32 + 16 * q);
                const u32x4 ng = r < 255 ? *(const LAS u32x4*)(xl + (r + 1) * 80 + 16 * q) : z, nv = r < 255 ? *(const LAS u32x4*)(xl + (r + 1) * 80 + 32 + 16 * q) : z;
                float hg[8], hv[8];
                f32x4 wA[2][3], bA[2];
#pragma unroll
                for (int bj = 0; bj < 2; ++bj) {
#pragma unroll
                    for (int jj = 0; jj < 3; ++jj) wA[bj][jj] = *(const LAS f32x4*)(cf + (bj * 4 + jj) * 128 + cs);
                    bA[bj] = *(const LAS f32x4*)(cf + (bj * 4 + 3) * 128 + cs); }
#pragma unroll
                for (int e = 0; e < 2; ++e) { const int k0 = 2 * e;
                    hg[2 * e] = wA[0][0][k0] * bflo(pg[e]) + wA[0][1][k0] * bflo(cg[e]) + wA[0][2][k0] * bflo(ng[e]) + bA[0][k0];
                    hg[2 * e + 1] = wA[0][0][k0 + 1] * bfhi(pg[e]) + wA[0][1][k0 + 1] * bfhi(cg[e]) + wA[0][2][k0 + 1] * bfhi(ng[e]) + bA[0][k0 + 1];
                    hv[2 * e] = wA[1][0][k0] * bflo(pv[e]) + wA[1][1][k0] * bflo(cv[e]) + wA[1][2][k0] * bflo(nv[e]) + bA[1][k0];
                    hv[2 * e + 1] = wA[1][0][k0 + 1] * bfhi(pv[e]) + wA[1][1][k0 + 1] * bfhi(cv[e]) + wA[1][2][k0 + 1] * bfhi(nv[e]) + bA[1][k0 + 1]; }
                f32x4 wB[2][3], bB[2];
#pragma unroll
                for (int bj = 0; bj < 2; ++bj) {
#pragma unroll
                    for (int jj = 0; jj < 3; ++jj) wB[bj][jj] = *(const LAS f32x4*)(cf + (bj * 4 + jj) * 128 + cs + 4);
                    bB[bj] = *(const LAS f32x4*)(cf + (bj * 4 + 3) * 128 + cs + 4); }
#pragma unroll
                for (int e = 2; e < 4; ++e) { const int k0 = 2 * (e - 2);
                    hg[2 * e] = wB[0][0][k0] * bflo(pg[e]) + wB[0][1][k0] * bflo(cg[e]) + wB[0][2][k0] * bflo(ng[e]) + bB[0][k0];
                    hg[2 * e + 1] = wB[0][0][k0 + 1] * bfhi(pg[e]) + wB[0][1][k0 + 1] * bfhi(cg[e]) + wB[0][2][k0 + 1] * bfhi(ng[e]) + bB[0][k0 + 1];
                    hv[2 * e] = wB[1][0][k0] * bflo(pv[e]) + wB[1][1][k0] * bflo(cv[e]) + wB[1][2][k0] * bflo(nv[e]) + bB[1][k0];
                    hv[2 * e + 1] = wB[1][0][k0 + 1] * bfhi(pv[e]) + wB[1][1][k0 + 1] * bfhi(cv[e]) + wB[1][2][k0 + 1] * bfhi(nv[e]) + bB[1][k0 + 1]; }
                u32x4 o;
#pragma unroll
                for (int e = 0; e < 4; ++e) o[e] = cvtpk(hg[2 * e] * sigm(hg[2 * e]) * hv[2 * e], hg[2 * e + 1] * sigm(hg[2 * e + 1]) * hv[2 * e + 1]);
                *(u32x4*)(act + (size_t)(u.pm * 256 + r) * DFF + colg + 8 * q) = o;
                if ((r == 0 && nb_top) || (r == 255 && nb_bot)) {
                    float* e0 = edge + ((size_t)((u.pm - 16) * 2 + (r == 0 ? 0 : 1)) * 4) * DFF + colg + 8 * q;
#pragma unroll
                    for (int e = 0; e < 4; ++e) { e0[2 * e] = hg[2 * e]; e0[2 * e + 1] = hg[2 * e + 1]; e0[DFF + 2 * e] = hv[2 * e]; e0[DFF + 2 * e + 1] = hv[2 * e + 1];
                        e0[2 * DFF + 2 * e] = bflo(cg[e]); e0[2 * DFF + 2 * e + 1] = bfhi(cg[e]); e0[3 * DFF + 2 * e] = bflo(cv[e]); e0[3 * DFF + 2 * e + 1] = bfhi(cv[e]); } }
            }
            asm volatile("s_waitcnt lgkmcnt(0)" ::: "memory"); __builtin_amdgcn_s_barrier(); asm volatile("" ::: "memory"); __builtin_amdgcn_sched_barrier(0);
        }
    }
};
struct EpiQKV {
    const u64_t* ss; const float* sw; bf16_t *Q, *KB, *VB; float *outK, *outV; const float *ropec, *ropes; int j;
    __device__ __forceinline__ void operator()(const Acc& acc, const Unit& u, int wr, int wc, int fr, int fq) const {
        const int c = cond_of_tile(u.pm); const bool samp = u.pm >= 16; const int colt = u.pn * 256, cl0 = wc * 32 + 4 * fq;
        f32x4 sv[2][2];
#pragma unroll
        for (int bj = 0; bj < 2; ++bj)
#pragma unroll
            for (int n = 0; n < 2; ++n) sv[bj][n] = *(const f32x4*)(sw + (size_t)c * SW_STRIDE + colt + cl0 + bj * 128 + n * 16);
#pragma unroll
        for (int ai = 0; ai < 2; ++ai)
#pragma unroll
            for (int m = 0; m < 4; ++m) {
                const int r = u.pm * 256 + ai * 128 + wr * 64 + m * 16 + fr; const float rs = rstd_of(ss, r);
                f32x4 cs = {1.f, 1.f, 1.f, 1.f}, sn = {0.f, 0.f, 0.f, 0.f};
                if (samp && u.pn < 5) { const int t = (r - MP) & 1023, idx = t * 32 + (wc & 1) * 16 + 4 * fq; cs = *(const f32x4*)(ropec + idx); sn = *(const f32x4*)(ropes + idx); }
#pragma unroll
                for (int bj = 0; bj < 2; ++bj) {
                    f32x4 v0 = acc[ai][bj][m][0] * rs + sv[bj][0], v1 = acc[ai][bj][m][1] * rs + sv[bj][1];
                    if (u.pn < 5) { const f32x4 o0 = v0 * cs - v1 * sn, o1 = v1 * cs + v0 * sn; v0 = o0; v1 = o1; }
                    const int cl = bj * 128 + cl0;
                    if (u.pn < 4) { st_bf16x4(Q + (size_t)r * D + colt + cl, v0 * QSCALE); st_bf16x4(Q + (size_t)r * D + colt + cl + 16, v1 * QSCALE); }
                    else {
                        bf16_t* dst = (u.pn == 4 ? KB : VB) + (size_t)r * 256 + cl; st_bf16x4(dst, v0); st_bf16x4(dst + 16, v1);
                        if (!samp) { float* o = (u.pn == 4 ? outK : outV) + (((size_t)(r >> 8) * 2 + j) * 256 + (r & 255)) * 256 + cl; *(f32x4*)o = v0; *(f32x4*)(o + 16) = v1; }
                    }
                }
            }
    }
};
struct EpiHin {
    const u64_t* ss; const float* sw; const float* lb1; bf16_t *HQ, *HV, *HG; float *LFF, *LFB;
    __device__ __forceinline__ void operator()(const Acc& acc, const Unit& u, int wr, int wc, int fr, int fq) const {
        const int c = cond_of_tile(u.pm); const int seg = u.pn >> 2, colt = u.pn * 256, cl0 = wc * 32 + 4 * fq, cs0 = (u.pn & 3) * 256 + cl0;
        f32x4 sv[2][2], lbv[2][2];
#pragma unroll
        for (int bj = 0; bj < 2; ++bj)
#pragma unroll
            for (int n = 0; n < 2; ++n) { sv[bj][n] = *(const f32x4*)(sw + (size_t)c * SW_STRIDE + colt + cl0 + bj * 128 + n * 16);
                lbv[bj][n] = (seg == 2 || seg == 3) ? *(const f32x4*)(lb1 + (seg - 2) * 1024 + cs0 + bj * 128 + n * 16) : (f32x4){0.f, 0.f, 0.f, 0.f}; }
#pragma unroll
        for (int ai = 0; ai < 2; ++ai)
#pragma unroll
            for (int m = 0; m < 4; ++m) {
                const int r = u.pm * 256 + ai * 128 + wr * 64 + m * 16 + fr; const float rs = rstd_of(ss, r);
#pragma unroll
                for (int bj = 0; bj < 2; ++bj)
#pragma unroll
                    for (int n = 0; n < 2; ++n) {
                        f32x4 v = acc[ai][bj][m][n] * rs + sv[bj][n]; const size_t off = (size_t)r * D + cs0 + bj * 128 + n * 16;
                        if (seg == 0) st_bf16x4(HQ + off, v);
                        else if (seg == 1) st_bf16x4(HV + off, v);
                        else if (seg == 4) {
#pragma unroll
                            for (int e = 0; e < 4; ++e) v[e] = v[e] * sigm(v[e]);
                            st_bf16x4(HG + off, v); }
                        else { const f32x4 lb = lbv[bj][n];
#pragma unroll
                            for (int e = 0; e < 4; ++e) v[e] = __logf(lb[e] + (1.f - lb[e]) * sigm(v[e]));
                            *(f32x4*)((seg == 2 ? LFF : LFB) + off) = v; }
                    }
            }
    }
};
enum { EK_RES = 0, EK_RES_GLU, EK_UPRAW, EK_QKV, EK_HIN, EK_UPCONV };
struct EpiAny {
    int kind, l, flags, epoch; unsigned char* ws; float* out; const float *in29, *in30; LAS unsigned char* xl;
    __device__ __forceinline__ float* F(size_t o) const { return (float*)(ws + o); }
    __device__ __forceinline__ bf16_t* H(size_t o) const { return (bf16_t*)(ws + o); }
    __device__ __forceinline__ void post(const Unit&, int) const {}
    __device__ __forceinline__ void operator()(Acc& acc, const Unit& u, int wr, int wc, int fr, int fq, int kh, int tid) const {
#ifndef EK_MASK
#define EK_MASK 63
#endif
        if (!((EK_MASK >> this->kind) & 1)) return;
        unsigned char* ws = this->ws; float* out = this->out; int kind = this->kind, l = this->l, flags = this->flags;
        asm volatile("" : "+s"(ws), "+s"(out), "+s"(kind), "+s"(l), "+s"(flags));
        if (kh >= 0) {
            const int tile = u.pm * 4 + u.pn; unsigned* flag = (unsigned*)(ws + WS_CTL + 40960) + tile * 16;
            unsigned char* slab = ws + WS_SCR + 64 * MiB + (size_t)tile * 262144 + (size_t)tid * 16;
            if (kh == 1) {
                __amdgpu_buffer_rsrc_t rs = __builtin_amdgcn_make_buffer_rsrc(ws + WS_SCR + 64 * MiB + (size_t)tile * 262144, 0, 262144, 0x00020000);
#pragma unroll
                for (int j = 0; j < 32; ++j) __builtin_amdgcn_raw_buffer_store_b128(__builtin_bit_cast(u32x4, acc[j >> 4][(j >> 3) & 1][(j >> 1) & 3][j & 1]), rs, tid * 16 + j * 8192, 0, 16);
                asm volatile("s_waitcnt vmcnt(0)" ::: "memory"); __builtin_amdgcn_s_barrier(); asm volatile("" ::: "memory");
                if (tid == 0) __hip_atomic_store(flag, (unsigned)epoch, __ATOMIC_RELAXED, __HIP_MEMORY_SCOPE_AGENT);
                return;
            }
            if (tid < 64) {
                unsigned sp = 0;
                while ((unsigned)__builtin_amdgcn_readfirstlane((int)__hip_atomic_load(flag, __ATOMIC_RELAXED, __HIP_MEMORY_SCOPE_AGENT)) != (unsigned)epoch) { __builtin_amdgcn_s_sleep(2); if (++sp > (1u << 22)) break; }
                __builtin_amdgcn_fence(__ATOMIC_ACQUIRE, "agent"); asm volatile("s_waitcnt vmcnt(0)" ::: "memory");
            }
            asm volatile("" ::: "memory"); __builtin_amdgcn_s_barrier(); asm volatile("" ::: "memory");
#pragma unroll
            for (int j = 0; j < 32; ++j) acc[j >> 4][(j >> 3) & 1][(j >> 1) & 3][j & 1] += *(const f32x4*)(slab + (size_t)j * 8192);
        }
        auto F = [&](size_t o) { return (float*)(ws + o); }; auto H = [&](size_t o) { return (bf16_t*)(ws + o); };
        const size_t ss1 = WS_SS + (size_t)(l * 2) * M * 8, sw1 = WS_SW + (size_t)(l * 2) * 5 * SW_STRIDE * 4;
        switch (kind) {
        case EK_RES: case EK_RES_GLU: {
            const bool down = flags & 1;
            const size_t ssn = down ? WS_SS + (size_t)((l + 1) * 2) * M * 8 : ss1 + (size_t)M * 8;
            const size_t gate = WS_MOD + ((size_t)l * 5 * 6144 + (down ? 5 : 2) * 1024) * 4;
            const size_t gmn = down ? WS_GMOD + (size_t)((l + 1) * 2) * 5 * 1024 * 4 : WS_GMOD + (size_t)(l * 2 + 1) * 5 * 1024 * 4;
            const bool has_next = !(down && l == 3);
            float* xo = (flags & 2) ? out : F(WS_X); bf16_t* ap = H(WS_AP); u64_t* sp = (u64_t*)(ws + ssn);
            if (flags & 4) { const size_t dm = WS_SCR + ((flags & 8) ? 48 : 96) * MiB; xo = F(dm); ap = H(dm + 32 * MiB); sp = (u64_t*)(ws + dm + 48 * MiB); }
            if (kind == EK_RES) { EpiRes<false> E{F(WS_X), xo, ap, sp, F(gate), has_next ? F(gmn) : nullptr}; E(acc, u, wr, wc, fr, fq); }
            else { EpiRes<true> E{F(WS_X), xo, ap, sp, F(gate), F(gmn)}; E(acc, u, wr, wc, fr, fq); } } break;
        case EK_UPRAW: { EpiUpRaw E{(const u64_t*)(ws + ss1 + (size_t)M * 8), F(sw1 + (size_t)5 * SW_STRIDE * 4), H(WS_SCR + (size_t)((flags >> 2) & 1) * (88 * MiB))}; E(acc, u, wr, wc, fr, fq); } break;
        case EK_UPCONV: { EpiUpConv E{(const u64_t*)(ws + ss1 + (size_t)M * 8), F(sw1 + (size_t)5 * SW_STRIDE * 4), in29 + (size_t)l * 3 * NUP, in30 + (size_t)l * NUP, H(WS_ACT), F(WS_EDGE), nullptr}; E.fused(acc, u, wr, wc, fr, fq, tid, xl); } break;
        case EK_QKV: { EpiQKV E{(const u64_t*)(ws + ss1), F(sw1), H(SCR_Q), H(SCR_KB), H(SCR_VB), out + 8388608, out + 8388608 + 2097152, F(WS_ROPE), F(WS_ROPE) + 32768, l / 3}; E(acc, u, wr, wc, fr, fq); } break;
        default: { EpiHin E{(const u64_t*)(ws + ss1), F(sw1), F(WS_LB1), H(SCR_HQ), H(SCR_HV), H(SCR_HG), F(SCR_LFF), F(SCR_LFB)}; E(acc, u, wr, wc, fr, fq); } break;
        }
    }
};
}
namespace om {
#define LDS_WAIT() asm volatile("s_waitcnt lgkmcnt(0)" ::: "memory")
__device__ __forceinline__ void transpose_item(const float* W, int K, int N, bf16_t* WT, LAS unsigned short* scr, int item, int lane) {
    const int nblk = N / 32, kb = item / nblk, nb = item % nblk, k0 = 64 * kb, n0 = 32 * nb;
    float v[32];
#pragma unroll
    for (int i = 0; i < 32; ++i) v[i] = W[(size_t)(k0 + 2 * i + (lane >> 5)) * N + n0 + (lane & 31)];
#pragma unroll
    for (int i = 0; i < 32; ++i) scr[(2 * i + (lane >> 5)) * 33 + (lane & 31)] = (unsigned short)(cvtpk(v[i], 0.f) & 0xffffu);
    LDS_WAIT(); asm volatile("" ::: "memory");
    const int c = lane & 7;
#pragma unroll
    for (int j = 0; j < 4; ++j) { const int n = (lane >> 3) + 8 * j; const LAS unsigned short* s = scr + (8 * c) * 33 + n;
        u32x4 o; o.x = (unsigned)s[0 * 33] | ((unsigned)s[1 * 33] << 16); o.y = (unsigned)s[2 * 33] | ((unsigned)s[3 * 33] << 16); o.z = (unsigned)s[4 * 33] | ((unsigned)s[5 * 33] << 16); o.w = (unsigned)s[6 * 33] | ((unsigned)s[7 * 33] << 16);
        *(u32x4*)(WT + (size_t)(n0 + n) * K + k0 + 8 * c) = o; }
    LDS_WAIT(); asm volatile("" ::: "memory");
}
__device__ __forceinline__ float modsum(const Ctx& C, int l, int c, int idx) {
    const float* mp = C.f(WS_MODP) + ((size_t)l * 5 + c) * 6144 + idx; float s = C.in(9)[l * 6144 + idx];
#pragma unroll
    for (int kp = 0; kp < 4; ++kp) s += mp[(size_t)kp * 4 * 5 * 6144];
    return s;
}
__device__ __forceinline__ void convert_layer(const Ctx& C, int layer, int vb, int nvb) {
    const int gw = vb * NWAVES + C.wave, NGW = nvb * NWAVES;
    LAS unsigned short* scr = (LAS unsigned short*)(C.lds + C.wave * 4352);
#define DO_MAT(src, dst, K, N) for (int it = gw; it < ((K) / 64) * ((N) / 32); it += NGW) transpose_item((src), (K), (N), (dst), scr, it, C.lane)
    if (layer == 0 || layer == 3) { const int j = layer / 3; DO_MAT(C.in(12) + (size_t)j * D * NQKV, C.h(WS_WQKV) + (size_t)j * NQKV * D, D, NQKV); DO_MAT(C.in(13) + (size_t)j * D * D, C.h(WS_WO) + (size_t)j * D * D, D, D); }
    else if (layer == 1) { DO_MAT(C.in(15), C.h(WS_HWIN), D, NHIN); DO_MAT(C.in(18), C.h(WS_HWO), D, D); }
    else { DO_MAT(C.in(27), C.h(WS_GLU), D, 2048); }
    DO_MAT(C.in(28) + (size_t)layer * D * NUP, C.h(WS_UP) + (size_t)layer * NUP * D, D, NUP); DO_MAT(C.in(31) + (size_t)layer * DFF * D, C.h(WS_DOWN) + (size_t)layer * D * DFF, DFF, D);
#undef DO_MAT
}
__device__ __forceinline__ void phase_p0a(const Ctx& C) {
    const int gt = C.bid * NTHREADS + C.tid, NGT = C.G * NTHREADS;
    for (int layer = 0; layer < 4; ++layer) if (layer == 0 || C.G != 256) convert_layer(C, layer, C.bid, C.G);
    __syncthreads();
    LAS float* sS = (LAS float*)(C.lds + 40960);
    LAS float* red = (LAS float*)(C.lds);
    for (int it = C.bid; it < 384; it += C.G) {
        const int l = it / 96, cb = (it % 96) >> 2, kp = it & 3;
        for (int i = C.tid; i < 5 * 256; i += NTHREADS) { const int c = i >> 8, k = kp * 256 + (i & 255); const float v = c == 0 ? C.in(7)[k] : C.in(6)[(c - 1) * 1024 + k]; sS[i] = v / (1.f + __expf(-v)); }
        __syncthreads();
        f32x4 a[5];
#pragma unroll
        for (int c = 0; c < 5; ++c) a[c] = (f32x4){0.f, 0.f, 0.f, 0.f};
        const float* wp = C.in(8) + ((size_t)l * 1024 + kp * 256 + C.wave * 32) * 6144 + cb * 256 + 4 * C.lane;
#pragma unroll 4
        for (int k = 0; k < 32; ++k) { const f32x4 w = *(const f32x4*)(wp + (size_t)k * 6144);
#pragma unroll
            for (int c = 0; c < 5; ++c) a[c] += w * sS[c * 256 + C.wave * 32 + k]; }
#pragma unroll
        for (int c = 0; c < 5; ++c) *(LAS f32x4*)(red + (C.wave * 5 + c) * 256 + 4 * C.lane) = a[c];
        __syncthreads();
        for (int i = C.tid; i < 5 * 256; i += NTHREADS) { float s = 0.f;
#pragma unroll
            for (int w = 0; w < 8; ++w) s += red[w * 1280 + i];
            C.f(WS_MODP)[(((size_t)kp * 4 + l) * 5 + (i >> 8)) * 6144 + cb * 256 + (i & 255)] = s; }
        __syncthreads();
    }
    { unsigned zero = 0u; asm volatile("" : "+v"(zero));
      for (int i = gt; i < 9 * M; i += NGT) ((u32x2*)(C.ws + WS_SS))[i] = (u32x2){zero, zero}; }
    for (int i = gt; i < 1024 * 32; i += NGT) { const int t = i >> 5, e = i & 31, fi = e & 15; const float pos = (e >> 4) == 0 ? (float)(t >> 6) : (float)(t & 63);
        const float ang = pos * __builtin_amdgcn_exp2f(-(float)fi * (13.287712379549449f / 16.0f))  ; C.f(WS_ROPE)[i] = cosf(ang); C.f(WS_ROPE)[32768 + i] = sinf(ang); }
    for (int i = gt; i < 2 * 131072; i += NGT) { const int which = i >> 17, e = (i & 131071) * 8; const float* s = (which ? C.in(3) : C.in(2)) + e; const f32x4 a = *(const f32x4*)s, b = *(const f32x4*)(s + 4);
        u32x4 o; o.x = cvtpk(a[0], a[1]); o.y = cvtpk(a[2], a[3]); o.z = cvtpk(b[0], b[1]); o.w = cvtpk(b[2], b[3]); *(u32x4*)(C.h(which ? WS_CTXV : WS_CTXK) + e) = o; }
    for (int i = gt; i < 2048; i += NGT) { float v[4], mx = -1e30f;
#pragma unroll
        for (int l = 0; l < 4; ++l) { v[l] = C.in(16)[l * 2048 + i]; mx = fmaxf(mx, v[l]); }
        float s = 0.f;
#pragma unroll
        for (int l = 0; l < 4; ++l) { v[l] = expf(v[l] - mx); s += v[l]; }
        C.f(WS_LB1)[i] = v[1] / s; }
    for (int i = gt; i < 8192; i += NGT) {
        const int dg = i >> 6, p = i & 63;
        const float ar = fminf(C.in(19)[i], -1e-4f), ai = C.in(20)[i], dt = expf(C.in(21)[dg]);
        const float e = expf(ar * dt), lr = e * cosf(ai * dt), li = e * sinf(ai * dt);
        const float den = ar * ar + ai * ai, fr = ((lr - 1.f) * ar + li * ai) / den, fi = (li * ar - (lr - 1.f) * ai) / den;
        C.f(WS_SLAM)[2 * i] = lr; C.f(WS_SLAM)[2 * i + 1] = li;
        unsigned wr_[8], wi_[8];
#pragma unroll
        for (int q = 0; q < 8; ++q) { const float x0 = C.in(22)[(size_t)i * 16 + 2 * q], y0 = C.in(23)[(size_t)i * 16 + 2 * q], x1 = C.in(22)[(size_t)i * 16 + 2 * q + 1], y1 = C.in(23)[(size_t)i * 16 + 2 * q + 1];
            wr_[q] = cvtpk(fr * x0 - fi * y0, fr * x1 - fi * y1); wi_[q] = cvtpk(fr * y0 + fi * x0, fr * y1 + fi * x1); }
        bf16_t* bb = C.h(WS_SBB) + ((size_t)dg * 128 + p) * 16;
        *(u32x4*)bb = (u32x4){wr_[0], wr_[1], wr_[2], wr_[3]}; *(u32x4*)(bb + 8) = (u32x4){wr_[4], wr_[5], wr_[6], wr_[7]};
        *(u32x4*)(bb + 64 * 16) = (u32x4){wi_[0], wi_[1], wi_[2], wi_[3]}; *(u32x4*)(bb + 64 * 16 + 8) = (u32x4){wi_[4], wi_[5], wi_[6], wi_[7]};
    }
    for (int i = gt; i < 2 * 64 * 16 * 64; i += NGT) {
        const int p = i & 63, row = i >> 6; bf16_t* cb = C.h(WS_SCB) + (size_t)row * 128;
        cb[p] = (bf16_t)(cvtpk(C.in(24)[i], 0.f) & 0xffffu); cb[64 + p] = (bf16_t)(cvtpk(-C.in(25)[i], 0.f) & 0xffffu); }
}
__device__ __forceinline__ void rows_ap_ss(const Ctx& C, const float* xsrc_p, const float* xsrc_s, float* xcopy, int l, int s, bool from_table, u64_t* ssdst) {
    for (int gw = C.bid * NWAVES + C.wave; gw < M / 4; gw += C.G * NWAVES) {
    const int r0 = gw * 4;
    const int c = cond_of_row(r0);
    f32x4 gm[4];
#pragma unroll
    for (int j = 0; j < 4; ++j) { const int n = 4 * C.lane + 256 * j;
        if (from_table) gm[j] = *(const f32x4*)(C.f(WS_GMOD) + (((size_t)l * 2 + s) * 5 + c) * 1024 + n);
        else { const float* g = (s == 0 ? C.in(10) : C.in(11)) + l * D + n;
#pragma unroll
            for (int e = 0; e < 4; ++e) gm[j][e] = g[e] * (1.f + modsum(C, l, c, (s == 0 ? 1 : 4) * 1024 + n + e)); } }
    for (int rr = 0; rr < 4; ++rr) {
        const int r = r0 + rr; const float* xr = (r < MP ? xsrc_p + (size_t)r * D : xsrc_s + (size_t)(r - MP) * D);
        f32x4 v[4]; float sq = 0.f;
#pragma unroll
        for (int j = 0; j < 4; ++j) { v[j] = *(const f32x4*)(xr + 4 * C.lane + 256 * j); sq += (v[j][0] * v[j][0] + v[j][1] * v[j][1]) + (v[j][2] * v[j][2] + v[j][3] * v[j][3]); }
        sq = wave_sum(sq);
#pragma unroll
        for (int j = 0; j < 4; ++j) { const size_t off = (size_t)r * D + 4 * C.lane + 256 * j; if (xcopy) *(f32x4*)(xcopy + off) = v[j]; st_bf16x4(C.h(WS_AP) + off, v[j] * gm[j]); }
        if (C.lane == 0) ssdst[r] = (u64_t)(sq * SS_FIX);
    }
    }
}
template <bool FROM_TABLE> __device__ __forceinline__ void sw_item_t(const Ctx& C, int item) {
    int ch = item, l = 0, s = 0, N = 0; const float* Wf = nullptr;
    if (ch < 12) { l = 0; s = 0; N = NQKV; Wf = C.in(12); }
    else if ((ch -= 12) < 44) { l = 0; s = 1; N = NUP; Wf = C.in(28); }
    else if ((ch -= 44) < 40) { l = 1; s = 0; N = NHIN; Wf = C.in(15); }
    else if ((ch -= 40) < 44) { l = 1; s = 1; N = NUP; Wf = C.in(28) + (size_t)1 * D * NUP; }
    else if ((ch -= 44) < 44) { l = 2; s = 1; N = NUP; Wf = C.in(28) + (size_t)2 * D * NUP; }
    else if ((ch -= 44) < 12) { l = 3; s = 0; N = NQKV; Wf = C.in(12) + (size_t)1 * D * NQKV; }
    else { ch -= 12; l = 3; s = 1; N = NUP; Wf = C.in(28) + (size_t)3 * D * NUP; }
    LAS float* sh = (LAS float*)C.lds;
    for (int i = C.tid; i < 5 * 1024; i += NTHREADS) sh[i] = FROM_TABLE ? C.f(WS_MOD)[((size_t)l * 5 + (i >> 10)) * 6144 + (s == 0 ? 0 : 3) * 1024 + (i & 1023)] : modsum(C, l, i >> 10, (s == 0 ? 0 : 3) * 1024 + (i & 1023));
    __syncthreads();
    const int n0 = ch * 128 + 4 * (C.lane & 31);
    f32x4 a[5];
#pragma unroll
    for (int c = 0; c < 5; ++c) a[c] = (f32x4){0.f, 0.f, 0.f, 0.f};
    const float* wp = Wf + (size_t)(C.wave * 128 + (C.lane >> 5)) * N + n0;
#pragma unroll 4
    for (int k = 0; k < 64; ++k) { const f32x4 w = *(const f32x4*)(wp + (size_t)(2 * k) * N); const int kk = C.wave * 128 + 2 * k + (C.lane >> 5);
#pragma unroll
        for (int c = 0; c < 5; ++c) a[c] += w * sh[c * 1024 + kk]; }
    LAS float* red = (LAS float*)(C.lds + 20480);
#pragma unroll
    for (int c = 0; c < 5; ++c) *(LAS f32x4*)(red + ((C.wave * 2 + (C.lane >> 5)) * 5 + c) * 128 + 4 * (C.lane & 31)) = a[c];
    __syncthreads();
    for (int i = C.tid; i < 5 * 128; i += NTHREADS) { float sum = 0.f;
#pragma unroll
        for (int w = 0; w < 16; ++w) sum += red[w * 640 + i];
        C.f(WS_SW)[(((size_t)l * 2 + s) * 5 + (i >> 7)) * SW_STRIDE + ch * 128 + (i & 127)] = sum; }
    __syncthreads();
}
__device__ __forceinline__ void sw_item_p0(const Ctx& C, int item) { sw_item_t<false>(C, item); }
__device__ __forceinline__ void sw_item(const Ctx& C, int item) { sw_item_t<true>(C, item); }
__device__ __forceinline__ void phase_p0c(const Ctx& C) {
    for (int vb = C.bid; vb < 256; vb += C.G) {
    if (vb < 240) {
        sw_item_p0(C, vb);
    } else {
        const int t = (vb - 240) * NTHREADS + C.tid, NT = 16 * NTHREADS;
        for (int i = t; i < 4 * 5 * 6144; i += NT) { const int l = i / 30720, c = (i / 6144) % 5, idx = i % 6144; C.f(WS_MOD)[i] = modsum(C, l, c, idx); }
        for (int i = t; i < 4 * 2 * 5 * 1024; i += NT) { const int n = i & 1023, c = (i >> 10) % 5, s = (i / 5120) & 1, l = i / 10240;
            C.f(WS_GMOD)[i] = (s == 0 ? C.in(10) : C.in(11))[l * D + n] * (1.f + modsum(C, l, c, (s == 0 ? 1 : 4) * 1024 + n)); }
    }
    __syncthreads();
    }
    rows_ap_ss(C, C.in(0), C.in(1), C.f(WS_X), 0, 0, false, (u64_t*)(C.ws + WS_SS));
}
__device__ __forceinline__ void phase_glue(const Ctx& C, int l, int s) { rows_ap_ss(C, C.f(WS_X), C.f(WS_X) + (size_t)MP * D, nullptr, l, s, true, (u64_t*)(C.ws + WS_SS) + (size_t)(l * 2 + s) * M); }

__device__ __forceinline__ void phase_conv(const Ctx& C, int l) {
    const bf16_t* h = C.h(WS_SCR); bf16_t* act = C.h(WS_ACT); const float* cw = C.in(29) + (size_t)l * 3 * NUP; const float* cb = C.in(30) + (size_t)l * NUP;
    const int gt = C.bid * NTHREADS + C.tid, NGT = C.G * NTHREADS;
    for (int i = gt; i < M * (DFF / 8); i += NGT) {
        const int r = i / (DFF / 8), n = (i % (DFF / 8)) * 8;
        int t, S; if (r < MP) { t = r & 255; S = 256; } else { t = (r - MP) & 1023; S = 1024; }
        float g[8], v[8];
#pragma unroll
        for (int e = 0; e < 8; ++e) { g[e] = cb[n + e]; v[e] = cb[DFF + n + e]; }
#pragma unroll
        for (int jj = 0; jj < 3; ++jj) { const int tt = t + jj - 1; if (tt >= 0 && tt < S) {
            const u32x4 hg = *(const u32x4*)(h + (size_t)(r + jj - 1) * NUP + n), hv = *(const u32x4*)(h + (size_t)(r + jj - 1) * NUP + DFF + n);
#pragma unroll
            for (int e = 0; e < 4; ++e) { g[2 * e] += cw[jj * NUP + n + 2 * e] * bflo(hg[e]); g[2 * e + 1] += cw[jj * NUP + n + 2 * e + 1] * bfhi(hg[e]);
                v[2 * e] += cw[jj * NUP + DFF + n + 2 * e] * bflo(hv[e]); v[2 * e + 1] += cw[jj * NUP + DFF + n + 2 * e + 1] * bfhi(hv[e]); } } }
        u32x4 o;
#pragma unroll
        for (int e = 0; e < 4; ++e) o[e] = cvtpk(g[2 * e] * sigm(g[2 * e]) * v[2 * e], g[2 * e + 1] * sigm(g[2 * e + 1]) * v[2 * e + 1]);
        *(u32x4*)(act + (size_t)r * DFF + n) = o;
    }
}
__device__ __forceinline__ void phase_final(const Ctx& C, float dbg) {
    const int gw = C.bid * NWAVES + C.wave, NGW = C.G * NWAVES; const u64_t* ss = (const u64_t*)(C.ws + WS_SS) + (size_t)8 * M;
    for (int r = gw; r < M; r += NGW) { const float rs = rstd_of(ss, r);
#pragma unroll
        for (int j = 0; j < 4; ++j) { const int n = 4 * C.lane + 256 * j; float* p = C.out + (size_t)r * D + n; *(f32x4*)p = *(const f32x4*)p * (rs * dbg) * *(const f32x4*)(C.in(32) + n); } }
}
}
namespace om {
__device__ __forceinline__ int rowidx(int r, int h) { return (r & 3) + 8 * (r >> 2) + 4 * h; }
__device__ __forceinline__ float xhalf(float v) {
    auto rr = __builtin_amdgcn_permlane32_swap(__float_as_uint(v), __float_as_uint(v), false, false);
    return __uint_as_float((lane_id() & 32) ? rr[0] : rr[1]);
}
__device__ __forceinline__ bf16x8 pack8(const f32x16& x, int base) {
    u32x4 w; w.x = cvtpk(x[base], x[base + 1]); w.y = cvtpk(x[base + 2], x[base + 3]); w.z = cvtpk(x[base + 4], x[base + 5]); w.w = cvtpk(x[base + 6], x[base + 7]);
    return __builtin_bit_cast(bf16x8, w);
}
typedef short v4i16_t __attribute__((ext_vector_type(4)));
__device__ __forceinline__ u32x2 vtr4(const LAS unsigned char* p) { return __builtin_bit_cast(u32x2, __builtin_amdgcn_ds_read_tr16_b64_v4i16((LAS v4i16_t*)p)); }
__device__ __forceinline__ bf16x8 cat44(u32x2 a, u32x2 b) { u32x4 w = {a.x, a.y, b.x, b.y}; return __builtin_bit_cast(bf16x8, w); }

constexpr int AT_KSTR = 144;
constexpr int AT_BUF = 2 * 64 * AT_KSTR;
__device__ __forceinline__ void attn_unit(const Ctx& C, int j, bool samp, int b, int hq, int qb, size_t obuf) {
    const int lane = C.lane, c = lane & 31, h = lane >> 5, w = C.wave, kvh = hq >> 2;
    const int rowbase = samp ? MP + b * 1024 : b * 256, q0 = qb * 256, qlo = q0 + 32 * w;
    const bf16_t* Q = C.h(SCR_Q); const bf16_t* KB = C.h(SCR_KB); const bf16_t* VB = C.h(SCR_VB);
    const bf16_t* CK = C.h(WS_CTXK) + ((size_t)(b * 2 + j) * 512) * 256; const bf16_t* CV = C.h(WS_CTXV) + ((size_t)(b * 2 + j) * 512) * 256;
    int klo = 0, nlat = 4, NT = 4;
    if (samp) { klo = q0 - 128 < 0 ? 0 : q0 - 128; const int khi = q0 + 384 > 1024 ? 1024 : q0 + 384; nlat = (khi - klo) >> 6; NT = nlat + 8; }
    bf16x8 qf[4];
#pragma unroll
    for (int s = 0; s < 4; ++s) qf[s] = *(const bf16x8*)(Q + (size_t)(rowbase + qlo + c) * D + hq * 64 + 16 * s + 8 * h);
    float m = C.in(14)[j * 16 + hq] * LOG2E, lsum = h == 0 ? 1.f : 0.f;
    f32x16 o0 = {}, o1 = {};
    const int lkey = C.tid >> 3, lch = C.tid & 7;
    auto src_k = [&](int t) -> const bf16_t* { return (t < nlat ? KB + (size_t)(rowbase + klo + 64 * t + lkey) * 256 : CK + (size_t)(64 * (t - nlat) + lkey) * 256) + kvh * 64 + lch * 8; };
    auto src_v = [&](int t) -> const bf16_t* { return (t < nlat ? VB + (size_t)(rowbase + klo + 64 * t + lkey) * 256 : CV + (size_t)(64 * (t - nlat) + lkey) * 256) + kvh * 64 + lch * 8; };
    auto put = [&](int buf, u32x4 kr, u32x4 vr) {
        LAS unsigned char* kb = C.lds + buf * AT_BUF; LAS unsigned char* vb = kb + 64 * AT_KSTR;
        *(LAS u32x4*)(kb + lkey * AT_KSTR + lch * 16) = kr;
        *(LAS u32x4*)(vb + lkey * AT_KSTR + lch * 16) = vr;
    };
    const int vtr_off = (4 * h + ((lane & 15) >> 2)) * AT_KSTR + (16 * ((lane >> 4) & 1) + 4 * (lane & 3)) * 2;
    { const u32x4 kr = *(const u32x4*)src_k(0), vr = *(const u32x4*)src_v(0); put(0, kr, vr); }
    __syncthreads();
    for (int t = 0; t < NT; ++t) {
        u32x4 kr = {}, vr = {};
        if (t + 1 < NT) { kr = *(const u32x4*)src_k(t + 1); vr = *(const u32x4*)src_v(t + 1); }
        const bool lat = samp && t < nlat; const int key0 = klo + 64 * t;
        const bool skip = lat && (key0 > qlo + 31 + 128 || key0 + 63 < qlo - 128);
        if (!skip) {
            LAS unsigned char* kb = C.lds + (t & 1) * AT_BUF; LAS unsigned char* vb = kb + 64 * AT_KSTR;
            f32x16 x0 = {}, x1 = {};
#pragma unroll
            for (int s = 0; s < 4; ++s) {
                const bf16x8 a0 = *(const LAS bf16x8*)(kb + c * AT_KSTR + (16 * s + 8 * h) * 2), a1 = *(const LAS bf16x8*)(kb + (32 + c) * AT_KSTR + (16 * s + 8 * h) * 2);
                x0 = __builtin_amdgcn_mfma_f32_32x32x16_bf16(a0, qf[s], x0, 0, 0, 0); x1 = __builtin_amdgcn_mfma_f32_32x32x16_bf16(a1, qf[s], x1, 0, 0, 0);
            }
            if (lat && !(key0 >= qlo + 31 - 128 && key0 + 63 <= qlo + 128)) {
                const int tq = qlo + c;
#pragma unroll
                for (int r = 0; r < 16; ++r) { const int k0 = key0 + rowidx(r, h) - tq; if (k0 > 128 || k0 < -128) x0[r] = -INFINITY; if (k0 + 32 > 128 || k0 + 32 < -128) x1[r] = -INFINITY; }
            }
            float mx = fmaxf(x0[0], x1[0]);
#pragma unroll
            for (int r = 1; r < 16; ++r) mx = fmaxf(mx, fmaxf(x0[r], x1[r]));
            mx = fmaxf(mx, xhalf(mx));
            const float mn = fmaxf(m, mx), al = __builtin_amdgcn_exp2f(m - mn); m = mn;
            float ps = 0.f;
#pragma unroll
            for (int r = 0; r < 16; ++r) { x0[r] = __builtin_amdgcn_exp2f(x0[r] - mn); x1[r] = __builtin_amdgcn_exp2f(x1[r] - mn); ps += x0[r] + x1[r]; }
            lsum = lsum * al + ps;
#pragma unroll
            for (int r = 0; r < 16; ++r) { o0[r] *= al; o1[r] *= al; }
#pragma unroll
            for (int ks = 0; ks < 2; ++ks) {
                const bf16x8 p0 = pack8(x0, 8 * ks), p1 = pack8(x1, 8 * ks);
#pragma unroll
                for (int dt = 0; dt < 2; ++dt) {
                    const LAS unsigned char* vp = vb + vtr_off + (16 * ks) * AT_KSTR + (32 * dt) * 2;
                    const bf16x8 v0 = cat44(vtr4(vp), vtr4(vp + 8 * AT_KSTR)), v1 = cat44(vtr4(vp + 32 * AT_KSTR), vtr4(vp + 40 * AT_KSTR));
                    if (dt == 0) { o0 = __builtin_amdgcn_mfma_f32_32x32x16_bf16(v0, p0, o0, 0, 0, 0); o0 = __builtin_amdgcn_mfma_f32_32x32x16_bf16(v1, p1, o0, 0, 0, 0); }
                    else { o1 = __builtin_amdgcn_mfma_f32_32x32x16_bf16(v0, p0, o1, 0, 0, 0); o1 = __builtin_amdgcn_mfma_f32_32x32x16_bf16(v1, p1, o1, 0, 0, 0); }
                }
            }
        }
        if (t + 1 < NT) put((t + 1) & 1, kr, vr);
        __syncthreads();
    }
    lsum += xhalf(lsum);
    const float il = 1.f / lsum;
    bf16_t* O = C.h(obuf) + (size_t)(rowbase + qlo + c) * D + hq * 64 + 4 * h;
#pragma unroll
    for (int g = 0; g < 4; ++g) { st_bf16x4(O + 8 * g, (f32x4){o0[4 * g], o0[4 * g + 1], o0[4 * g + 2], o0[4 * g + 3]} * il); st_bf16x4(O + 32 + 8 * g, (f32x4){o1[4 * g], o1[4 * g + 1], o1[4 * g + 2], o1[4 * g + 3]} * il); }
}
__device__ __forceinline__ void phase_attn(const Ctx& C, int l, size_t obuf) {
    const int j = l / 3;
    for (int u = C.bid; u < 512; u += C.G) {
        if (u < 256) attn_unit(C, j, false, u >> 4, u & 15, 0, obuf);
        else { const int v = u - 256; attn_unit(C, j, true, v >> 6, (v >> 2) & 15, v & 3, obuf); }
    }
}
constexpr size_t CKS_TAB = 376 * MiB; constexpr int CKS_NW = (int)((268 * MiB) / 65536), CKS_NO = (17039360 * 4) / 65536, CKS_N = CKS_NW + CKS_NO;
__device__ __forceinline__ void phase_cks(const Ctx& C, int slot) {
    const int gw = C.bid * NWAVES + C.wave, NGW = C.G * NWAVES; unsigned* tab = (unsigned*)(C.ws + CKS_TAB) + (size_t)slot * 8192;
    for (int ck = gw; ck < CKS_N; ck += NGW) {
        const unsigned char* base = ck < CKS_NW ? C.ws + 108 * MiB + (size_t)ck * 65536 : (const unsigned char*)C.out + (size_t)(ck - CKS_NW) * 65536; unsigned s = 0;
        for (int i = 0; i < 64; ++i) { const u32x4 v = *(const u32x4*)(base + (size_t)i * 1024 + C.lane * 16); s += v[0] + v[1] * 3u + v[2] * 5u + v[3] * 7u; }
#pragma unroll
        for (int o = 1; o < 64; o <<= 1) s += (unsigned)__shfl_xor((int)s, o);
        if (C.lane == 0) tab[ck] = s;
    }
}
__device__ __forceinline__ void phase_clr(const Ctx& C) {
    const int gt = C.bid * NTHREADS + C.tid, NGT = C.G * NTHREADS; const u32x4 z = {0u, 0u, 0u, 0u};
    for (size_t i = gt; i < (268 * MiB) / 16; i += NGT) *(u32x4*)(C.ws + 108 * MiB + i * 16) = z;
    for (size_t i = gt; i < (size_t)17039360 / 4; i += NGT) *(u32x4*)((unsigned char*)C.out + i * 16) = z;
}
__device__ __forceinline__ void phase_clr2(const Ctx& C, size_t off, size_t bytes) {
    const int gt = C.bid * NTHREADS + C.tid, NGT = C.G * NTHREADS; const u32x4 z = {0u, 0u, 0u, 0u};
    for (size_t i = gt; i < bytes / 16; i += NGT) *(u32x4*)(C.ws + off + i * 16) = z;
}
__device__ __forceinline__ void phase_cmp(const Ctx& C, int nslots) {
    const int gt = C.bid * NTHREADS + C.tid, NGT = C.G * NTHREADS; const unsigned* tab = (const unsigned*)(C.ws + CKS_TAB);
    for (int i = gt; i < nslots * 8192; i += NGT) { const int sl = i >> 13, ck = i & 8191; if (ck < CKS_N && tab[(size_t)sl * 8192 + ck] != tab[(size_t)(sl + 32) * 8192 + ck]) {
#ifdef SSDET
        const int cls = ck >= CKS_NW ? 4 : (ck < 1472 + 512 ? 1 : 2); atomicOr((unsigned*)(C.ws + WS_CTL) + 4002, (unsigned)cls); atomicAdd((unsigned*)(C.ws + WS_CTL) + 4003, 1u);
#endif
        atomicMax((unsigned*)(C.ws + WS_CTL) + 4001, (unsigned)(1000 - sl)); } }
}
__device__ __forceinline__ void phase_chk(const Ctx& C, size_t a, size_t b, size_t bytes) {
    const int gt = C.bid * NTHREADS + C.tid, NGT = C.G * NTHREADS; unsigned bad = 0;
    for (size_t i = gt; i < bytes / 16; i += NGT) { const u32x4 x = *(const u32x4*)(C.ws + a + i * 16), y = *(const u32x4*)(C.ws + b + i * 16); bad += (x[0] != y[0]) | (x[1] != y[1]) | (x[2] != y[2]) | (x[3] != y[3]); }
    if (bad) atomicAdd((unsigned*)(C.ws + WS_CTL) + 4000, bad);
}

constexpr int HS_QSTR = 272, HS_TSTR = 80;
constexpr int HS_QT = 0, HS_KT = 32 * HS_QSTR, HS_KTT = 2 * 32 * HS_QSTR, HS_VT = HS_KTT + 128 * HS_TSTR, HS_E1 = HS_VT + 128 * HS_TSTR, HS_E2 = HS_E1 + 512, HS_T1 = HS_E2 + 512, HS_GRP = HS_T1 + 512;
__device__ __forceinline__ void hscan_item(const Ctx& C, int item) {
    const bool samp = item < 64; const int it = samp ? item : item - 64;
    const int dir = it & 1, hd = (it >> 1) & 7, sq = it >> 4;
    const int S = samp ? 1024 : 256, rowbase = samp ? MP + sq * 1024 : sq * 256, nchunk = S >> 5;
    const int tg = C.tid & 255, lane = C.lane, c = lane & 31, h = lane >> 5, w4 = C.wave & 3; const bool producer = C.wave >= 4;
    LAS unsigned char* L = C.lds;
    const bf16_t* HQ = C.h(SCR_HQ); const bf16_t* HV = C.h(SCR_HV); const float* LF = C.f(dir == 0 ? SCR_LFF : SCR_LFB); float* OD = C.f(dir == 0 ? SCR_OF : SCR_OB);
    const int pd = tg & 127, ph = tg >> 7;
    unsigned qw[8], kw[8], vtw[8]; float e1v = 0.f, e2v = 0.f;
    float rlf[16], rpre[16]; unsigned rq[16], rv[16];
    auto issue = [&](int ch) {
#pragma unroll
        for (int i = 0; i < 16; ++i) { const int pos = 32 * ch + 16 * ph + i, t = dir == 0 ? pos : S - 1 - pos; const size_t off = (size_t)(rowbase + t) * D + hd * 128 + pd;
            rlf[i] = LF[off]; rq[i] = HQ[off]; rv[i] = HV[off];
            const int pos2 = 32 * ch + i, t2 = dir == 0 ? pos2 : S - 1 - pos2; rpre[i] = ph == 1 ? LF[(size_t)(rowbase + t2) * D + hd * 128 + pd] : 0.f; }
    };
    auto compute = [&]() {
        float cl[16]; float pre = 0.f, run = 0.f;
#pragma unroll
        for (int i = 0; i < 16; ++i) { pre += rpre[i]; run += rlf[i]; cl[i] = run; }
        const float t1v = ph == 0 ? cl[15] : pre;
#pragma unroll
        for (int i = 0; i < 16; i += 2) {
            const float e0 = ph == 0 ? cl[i] - t1v : cl[i], e1 = ph == 0 ? cl[i + 1] - t1v : cl[i + 1];
            const float k0 = 1.f - __expf(rlf[i]), k1 = 1.f - __expf(rlf[i + 1]);
            qw[i >> 1] = cvtpk(__uint_as_float(rq[i] << 16) * __expf(e0), __uint_as_float(rq[i + 1] << 16) * __expf(e1)); kw[i >> 1] = cvtpk(k0 * __expf(-e0), k1 * __expf(-e1));
            vtw[i >> 1] = rv[i] | (rv[i + 1] << 16); }
        e1v = __expf(t1v); e2v = __expf(cl[15]);
    };
    auto put = [&]() {
#pragma unroll
        for (int i = 0; i < 8; ++i) {
            *(LAS unsigned short*)(L + HS_QT + (16 * ph + 2 * i) * HS_QSTR + pd * 2) = (unsigned short)(qw[i] & 0xffffu); *(LAS unsigned short*)(L + HS_QT + (16 * ph + 2 * i + 1) * HS_QSTR + pd * 2) = (unsigned short)(qw[i] >> 16);
            *(LAS unsigned short*)(L + HS_KT + (16 * ph + 2 * i) * HS_QSTR + pd * 2) = (unsigned short)(kw[i] & 0xffffu); *(LAS unsigned short*)(L + HS_KT + (16 * ph + 2 * i + 1) * HS_QSTR + pd * 2) = (unsigned short)(kw[i] >> 16); }
        *(LAS u32x4*)(L + HS_KTT + pd * HS_TSTR + ph * 32) = (u32x4){kw[0], kw[1], kw[2], kw[3]}; *(LAS u32x4*)(L + HS_KTT + pd * HS_TSTR + ph * 32 + 16) = (u32x4){kw[4], kw[5], kw[6], kw[7]};
        *(LAS u32x4*)(L + HS_VT + pd * HS_TSTR + ph * 32) = (u32x4){vtw[0], vtw[1], vtw[2], vtw[3]}; *(LAS u32x4*)(L + HS_VT + pd * HS_TSTR + ph * 32 + 16) = (u32x4){vtw[4], vtw[5], vtw[6], vtw[7]};
        if (ph == 0) *(LAS float*)(L + HS_E1 + pd * 4) = e1v; else *(LAS float*)(L + HS_E2 + pd * 4) = e2v;
    };
    if (producer) {
        issue(0); compute(); if (nchunk > 1) issue(1);
        for (int ch = 0; ch < nchunk; ++ch) {
            put();
            __syncthreads();
            if (ch + 1 < nchunk) { compute(); if (ch + 2 < nchunk) issue(ch + 2); }
            __syncthreads();
        }
        return;
    }
    f32x16 St[4];
#pragma unroll
    for (int dt = 0; dt < 4; ++dt) {
        if (samp) { const float* s0 = C.in(4) + ((((size_t)sq * 2 + dir) * 8 + hd) * 128) * 128;
#pragma unroll
            for (int r = 0; r < 16; ++r) St[dt][r] = s0[(size_t)(32 * dt + rowidx(r, h)) * 128 + 32 * w4 + c]; }
        else St[dt] = (f32x16){};
    }
    for (int ch = 0; ch < nchunk; ++ch) {
        __syncthreads();
#pragma unroll
        for (int dt = 0; dt < 4; ++dt)
#pragma unroll
            for (int g = 0; g < 4; ++g) { const f32x4 e = *(const LAS f32x4*)(L + HS_E1 + (32 * dt + 8 * g + 4 * h) * 4);
#pragma unroll
                for (int q = 0; q < 4; ++q) St[dt][4 * g + q] *= e[q]; }
        f32x16 X = {};
#pragma unroll
        for (int s = 0; s < 8; ++s) {
            const bf16x8 a = *(const LAS bf16x8*)(L + HS_KT + c * HS_QSTR + (16 * s + 8 * h) * 2), bq = *(const LAS bf16x8*)(L + HS_QT + c * HS_QSTR + (16 * s + 8 * h) * 2);
            X = __builtin_amdgcn_mfma_f32_32x32x16_bf16(a, bq, X, 0, 0, 0);
        }
#pragma unroll
        for (int r = 0; r < 16; ++r) if (rowidx(r, h) > c) X[r] = 0.f;
        f32x16 OT = {};
#pragma unroll
        for (int ks = 0; ks < 2; ++ks) {
            const LAS unsigned char* vrow = L + HS_VT + (32 * w4 + c) * HS_TSTR + (16 * ks + 4 * h) * 2;
            const bf16x8 va = cat44(*(const LAS u32x2*)(vrow), *(const LAS u32x2*)(vrow + 16));
            OT = __builtin_amdgcn_mfma_f32_32x32x16_bf16(va, pack8(X, 8 * ks), OT, 0, 0, 0);
        }
#pragma unroll
        for (int dt = 0; dt < 4; ++dt)
#pragma unroll
            for (int ks = 0; ks < 2; ++ks) {
                const LAS unsigned char* qrow = L + HS_QT + c * HS_QSTR + (32 * dt + 16 * ks + 4 * h) * 2;
                const bf16x8 bq = cat44(*(const LAS u32x2*)(qrow), *(const LAS u32x2*)(qrow + 16));
                OT = __builtin_amdgcn_mfma_f32_32x32x16_bf16(pack8(St[dt], 8 * ks), bq, OT, 0, 0, 0);
            }
#pragma unroll
        for (int dt = 0; dt < 4; ++dt)
#pragma unroll
            for (int ks = 0; ks < 2; ++ks) {
                const bf16x8 a = *(const LAS bf16x8*)(L + HS_KTT + (32 * dt + c) * HS_TSTR + (16 * ks + 8 * h) * 2), bv = *(const LAS bf16x8*)(L + HS_VT + (32 * w4 + c) * HS_TSTR + (16 * ks + 8 * h) * 2);
                St[dt] = __builtin_amdgcn_mfma_f32_32x32x16_bf16(a, bv, St[dt], 0, 0, 0);
            }
#pragma unroll
        for (int dt = 0; dt < 4; ++dt)
#pragma unroll
            for (int g = 0; g < 4; ++g) { const f32x4 e = *(const LAS f32x4*)(L + HS_E2 + (32 * dt + 8 * g + 4 * h) * 4);
#pragma unroll
                for (int q = 0; q < 4; ++q) St[dt][4 * g + q] *= e[q]; }
        { const int pos = 32 * ch + c, t = dir == 0 ? pos : S - 1 - pos; float* op = OD + (size_t)(rowbase + t) * D + hd * 128 + 32 * w4 + 4 * h;
#pragma unroll
            for (int g = 0; g < 4; ++g) *(f32x4*)(op + 8 * g) = (f32x4){OT[4 * g], OT[4 * g + 1], OT[4 * g + 2], OT[4 * g + 3]}; }
        __syncthreads();
    }
    if (!samp) { float* so = C.out + 8388608 + 2 * 2097152 + ((((size_t)sq * 2 + dir) * 8 + hd) * 128) * 128;
        int c2 = c, h2 = h; asm volatile("" : "+v"(c2), "+v"(h2));
        unsigned base = (unsigned)((4 * h2) * 128 + 32 * w4 + c2);
#pragma unroll
        for (int dt = 0; dt < 4; ++dt)
#pragma unroll
            for (int r = 0; r < 16; ++r) so[base + (unsigned)((32 * dt + (r & 3) + 8 * (r >> 2)) * 128)] = St[dt][r]; }
}
__device__ __forceinline__ void phase_hscan(const Ctx& C) {
    if (C.G == 256) {
        hscan_item(C, C.bid);
        if (C.bid >= 64 && C.bid < 128) hscan_item(C, 256 + (C.bid - 64));
    } else for (int it = C.bid; it < 320; it += C.G) hscan_item(C, it);
}
__device__ __forceinline__ void phase_hpost(const Ctx& C) {
    const int gw = C.bid * NWAVES + C.wave, NGW = C.G * NWAVES;
    for (int r = gw; r < M; r += NGW) {
        const size_t off = (size_t)r * D + 16 * C.lane; float o[16]; float sq = 0.f;
#pragma unroll
        for (int q = 0; q < 4; ++q) { const f32x4 a = *(const f32x4*)(C.f(SCR_OF) + off + 4 * q), b = *(const f32x4*)(C.f(SCR_OB) + off + 4 * q);
#pragma unroll
            for (int e = 0; e < 4; ++e) { o[4 * q + e] = a[e] + b[e]; sq += o[4 * q + e] * o[4 * q + e]; } }
        sq += __shfl_xor(sq, 1); sq += __shfl_xor(sq, 2); sq += __shfl_xor(sq, 4);
        const float rs = rsqrtf(sq * (1.f / 128.f) + EPS);
        const u32x4 g0 = *(const u32x4*)(C.h(SCR_HG) + off), g1 = *(const u32x4*)(C.h(SCR_HG) + off + 8);
        const float* gn = C.in(17) + (16 * C.lane & 127);
        float sg[16];
#pragma unroll
        for (int e = 0; e < 4; ++e) { sg[2 * e] = bflo(g0[e]); sg[2 * e + 1] = bfhi(g0[e]); sg[8 + 2 * e] = bflo(g1[e]); sg[8 + 2 * e + 1] = bfhi(g1[e]); }
        u32x4 w0, w1;
#pragma unroll
        for (int e = 0; e < 4; ++e) { w0[e] = cvtpk(o[2 * e] * rs * gn[2 * e] * sg[2 * e], o[2 * e + 1] * rs * gn[2 * e + 1] * sg[2 * e + 1]);
            w1[e] = cvtpk(o[8 + 2 * e] * rs * gn[8 + 2 * e] * sg[8 + 2 * e], o[8 + 2 * e + 1] * rs * gn[8 + 2 * e + 1] * sg[8 + 2 * e + 1]); }
        *(u32x4*)(C.h(SCR_AWO) + off) = w0; *(u32x4*)(C.h(SCR_AWO) + off + 8) = w1;
    }
}

constexpr int SS_RSTR = 512;
constexpr int SS_WAVE = 16 * SS_RSTR;
__device__ __forceinline__ void sscan_seq(const Ctx& C, int l, bool samp, int sq, int dir, int g, size_t ydbg) {
    const int lane = C.lane, c = lane & 31, h = lane >> 5, dg = dir * 64 + g;
    const int S = samp ? 1024 : 256, rowbase = samp ? MP + sq * 1024 : sq * 256, nchunk = S >> 5, cond = samp ? 1 + sq : 0;
    LAS unsigned char* LB = C.lds + C.wave * SS_WAVE; LAS unsigned char* LH = LB + 4096;
    const float* X = C.f(WS_X); const u64_t* ss = (const u64_t*)(C.ws + WS_SS) + (size_t)(l * 2) * M; float* Y = C.f(ydbg ? ydbg : (dir == 0 ? SCR_YF : SCR_YB)); const bool ywr = !ydbg || dir == 0;
    bf16x8 bfr[4], cfr[4];
#pragma unroll
    for (int ct = 0; ct < 4; ++ct) bfr[ct] = *(const bf16x8*)(C.h(WS_SBB) + ((size_t)dg * 128 + 32 * ct + c) * 16 + 8 * h);
#pragma unroll
    for (int s = 0; s < 4; ++s) cfr[s] = *(const bf16x8*)(C.h(WS_SCB) + ((size_t)dg * 16 + (lane & 15)) * 128 + 32 * s + 8 * (lane >> 4));
    const float lr = C.f(WS_SLAM)[2 * (dg * 64 + lane)], li = C.f(WS_SLAM)[2 * (dg * 64 + lane) + 1];
    f32x4 gm0, gm1, sh0, sh1;
    { const float* gm = C.f(WS_GMOD) + ((size_t)(l * 2) * 5 + cond) * 1024 + g * 16 + 8 * h; gm0 = *(const f32x4*)gm; gm1 = *(const f32x4*)(gm + 4);
      const float* sh = C.f(WS_MOD) + ((size_t)l * 5 + cond) * 6144 + g * 16 + 8 * h; sh0 = *(const f32x4*)sh; sh1 = *(const f32x4*)(sh + 4); }
    float hr = 0.f, hi = 0.f;
    if (samp) { const float* s0 = C.in(5) + ((((size_t)sq * 2 + dir) * 64 + g) * 64 + lane) * 2; hr = s0[0]; hi = s0[1]; }
    for (int ch = 0; ch < nchunk; ++ch) {
        const int pos = 32 * ch + c, t = dir == 0 ? pos : S - 1 - pos, r = rowbase + t;
        const float rs = rstd_of(ss, r);
        const f32x4 x0 = *(const f32x4*)(X + (size_t)r * D + g * 16 + 8 * h), x1 = *(const f32x4*)(X + (size_t)r * D + g * 16 + 8 * h + 4);
        const f32x4 u0 = x0 * rs * gm0 + sh0, u1 = x1 * rs * gm1 + sh1;
        u32x4 uw = {cvtpk(u0[0], u0[1]), cvtpk(u0[2], u0[3]), cvtpk(u1[0], u1[1]), cvtpk(u1[2], u1[3])};
        const bf16x8 uf = __builtin_bit_cast(bf16x8, uw);
        f32x16 bu[4];
#pragma unroll
        for (int ct = 0; ct < 4; ++ct) { bu[ct] = (f32x16){}; bu[ct] = __builtin_amdgcn_mfma_f32_32x32x16_bf16(uf, bfr[ct], bu[ct], 0, 0, 0); }
#pragma unroll
        for (int hf = 0; hf < 2; ++hf) {
#pragma unroll
            for (int t8 = 0; t8 < 2; ++t8) {
#pragma unroll
                for (int ct = 0; ct < 4; ++ct)
#pragma unroll
                    for (int r4 = 0; r4 < 4; ++r4) *(LAS float*)(LB + (4 * h + r4) * 512 + (32 * ct + c) * 4) = bu[ct][8 * hf + 4 * t8 + r4];
                float br[8], bi[8]; unsigned wv[8];
#pragma unroll
                for (int k = 0; k < 8; ++k) { br[k] = *(LAS float*)(LB + k * 512 + lane * 4); bi[k] = *(LAS float*)(LB + k * 512 + 256 + lane * 4); }
#pragma unroll
                for (int k = 0; k < 8; ++k) { const float nr = lr * hr - li * hi + br[k], ni = lr * hi + li * hr + bi[k]; hr = nr; hi = ni; wv[k] = cvtpk(hr, hi); }
#pragma unroll
                for (int k = 0; k < 8; ++k) { const int row = 8 * t8 + k;
                    *(LAS unsigned short*)(LH + row * 256 + ((((lane >> 3)) ^ row) << 4) + (lane & 7) * 2) = (unsigned short)(wv[k] & 0xffffu);
                    *(LAS unsigned short*)(LH + row * 256 + (((8 + (lane >> 3)) ^ row) << 4) + (lane & 7) * 2) = (unsigned short)(wv[k] >> 16); }
                LDS_WAIT();
            }
            f32x4 y0 = {};
#pragma unroll
            for (int s = 0; s < 4; ++s) {
                const bf16x8 a0 = *(const LAS bf16x8*)(LH + (lane & 15) * 256 + (((4 * s + (lane >> 4)) ^ (lane & 15)) << 4));
                y0 = __builtin_amdgcn_mfma_f32_16x16x32_bf16(a0, cfr[s], y0, 0, 0, 0);
            }
            if (ywr) {
#pragma unroll
                for (int q = 0; q < 4; ++q) { const int p0 = 32 * ch + 16 * hf + 4 * (lane >> 4) + q, t0 = dir == 0 ? p0 : S - 1 - p0; Y[(size_t)(rowbase + t0) * D + g * 16 + (lane & 15)] = y0[q]; }
            }
            LDS_WAIT();
        }
    }
    if (!samp && !ydbg) { float* so = C.out + 8388608 + 2 * 2097152 + 4194304 + ((((size_t)sq * 2 + dir) * 64 + g) * 64 + lane) * 2; so[0] = hr; so[1] = hi; }
}
__device__ __forceinline__ void phase_sscan(const Ctx& C, int l, size_t ydbg) {
    for (int bb = C.bid; bb < 256; bb += C.G) {
        const int w = C.wave;
#ifdef SS_ONLYWAVE
        if (ydbg && !((SS_ONLYWAVE >> w) & 1)) continue;
#endif
        if (w < 2) { const int id = 2 * bb + w; sscan_seq(C, l, true, id >> 7, (id >> 6) & 1, id & 63, ydbg); }
        else { int id = 8 * bb + (w - 2); sscan_seq(C, l, false, id >> 7, (id >> 6) & 1, id & 63, ydbg);
            if (w < 4) { id = 8 * bb + 6 + (w - 2); sscan_seq(C, l, false, id >> 7, (id >> 6) & 1, id & 63, ydbg); } }
    }
}
__device__ __forceinline__ void phase_spost(const Ctx& C, int l) {
    const int gw = C.bid * NWAVES + C.wave, NGW = C.G * NWAVES; const u64_t* ss = (const u64_t*)(C.ws + WS_SS) + (size_t)(l * 2) * M;
    for (int r = gw; r < M; r += NGW) {
        const int cond = cond_of_row(r); const float rs = rstd_of(ss, r);
#pragma unroll
        for (int jq = 0; jq < 4; ++jq) {
            const int n = 4 * C.lane + 256 * jq; const size_t off = (size_t)r * D + n;
            const f32x4 x = *(const f32x4*)(C.f(WS_X) + off), gm = *(const f32x4*)(C.f(WS_GMOD) + ((size_t)(l * 2) * 5 + cond) * 1024 + n), sh = *(const f32x4*)(C.f(WS_MOD) + ((size_t)l * 5 + cond) * 6144 + n);
            const f32x4 u = x * rs * gm + sh, y = *(const f32x4*)(C.in(26) + n) * u + *(const f32x4*)(C.f(SCR_YF) + off) + *(const f32x4*)(C.f(SCR_YB) + off);
            f32x4 o;
#pragma unroll
            for (int e = 0; e < 4; ++e) { const float v = y[e], uu = 0.7978845608028654f * (v + 0.044715f * v * v * v); const float th = 1.f - 2.f * __builtin_amdgcn_rcpf(1.f + __expf(2.f * uu)); o[e] = 0.5f * v * (1.f + th); }
            st_bf16x4(C.h(SCR_AGLU) + off, o);
        }
    }
}
#define XB_TMO      128
#define XB_XCNT(j)  (256  + 64 * (j))
#define XB_XSUB(j)  (1280 + 64 * (j))
#define XB_XGEN(j)  (2304 + 64 * (j))
#define XB_TOP      3328
#define XB_TOPGEN   3392
#define XCD_BAR_WORDS 3456
#define XB_SPIN_CAP (1u << 18)
#ifndef XB_SCOPE
#define XB_SCOPE "agent"
#endif
__device__ __forceinline__ unsigned xb_ld(unsigned* p)              { return __hip_atomic_load(p, __ATOMIC_RELAXED, __HIP_MEMORY_SCOPE_AGENT); }
__device__ __forceinline__ unsigned xb_add(unsigned* p, unsigned v) { return __hip_atomic_fetch_add(p, v, __ATOMIC_RELAXED, __HIP_MEMORY_SCOPE_AGENT); }
__device__ __forceinline__ unsigned xb_xcc_id() { return (unsigned)__builtin_amdgcn_s_getreg((3 << 11) | 20) & 0xFu; }
#define XB_SPIN(cond, bar) do { unsigned _sp = 0; while (cond) { __builtin_amdgcn_s_sleep(1); \
    if ((++_sp & 255u) == 0u) { if (xb_ld(&(bar)[XB_TMO])) break; if (_sp > XB_SPIN_CAP) { atomicAdd(&(bar)[XB_TMO], 1u); break; } } } } while (0)
struct XcdBarrier { unsigned* bar; unsigned x; volatile LAS unsigned* st; };
__device__ __forceinline__ XcdBarrier xcd_barrier_post(unsigned* bar, volatile LAS unsigned* st) {
    XcdBarrier b; b.bar = bar; b.x = xb_xcc_id(); b.st = st;
    if (threadIdx.x == 0) (void)xb_add(&bar[XB_XCNT(b.x)], 1u);
    return b;
}
__device__ __forceinline__ void xcd_barrier_complete(unsigned* bar, unsigned x, unsigned& nloc, unsigned& nx) {
    const unsigned G = gridDim.x * gridDim.y * gridDim.z;
    unsigned sum, cnt, mine, sp = 0u;
    for (;;) {
        sum = 0u; cnt = 0u; mine = 0u;
#pragma unroll
        for (unsigned j = 0; j < 16; ++j) { const unsigned c = xb_ld(&bar[XB_XCNT(j)]); sum += c; cnt += (c > 0u) ? 1u : 0u; mine = (j == x) ? c : mine; }
        if (sum == G) break;
        __builtin_amdgcn_s_sleep(1);
        if ((++sp & 255u) == 0u) { if (xb_ld(&bar[XB_TMO])) break; if (sp > XB_SPIN_CAP) { atomicAdd(&bar[XB_TMO], 1u); break; } }
    }
    nloc = mine > 0u ? mine : 1u; nx = cnt > 0u ? cnt : 1u;
}
__device__ __forceinline__ void xcd_barrier(const XcdBarrier& b, bool thread0) {
    asm volatile("s_waitcnt vmcnt(0)" ::: "memory");
    __syncthreads();
    if (thread0) {
        unsigned* bar = b.bar;
        __builtin_amdgcn_s_waitcnt(0);
        unsigned nloc = b.st[0], nx = b.st[1];
        if (nloc == 0u) { xcd_barrier_complete(bar, b.x, nloc, nx); b.st[0] = nloc; b.st[1] = nx; }
#ifdef XB_ALL_RELEASE
        __builtin_amdgcn_fence(__ATOMIC_RELEASE, XB_SCOPE); asm volatile("s_waitcnt vmcnt(0)" ::: "memory");
#endif
        const unsigned old = xb_add(&bar[XB_XSUB(b.x)], 1u);
        const unsigned gen = old / nloc;
        if (old + 1u == (gen + 1u) * nloc) {
            __builtin_amdgcn_fence(__ATOMIC_RELEASE, XB_SCOPE);
            asm volatile("s_waitcnt vmcnt(0)" ::: "memory");
            const unsigned og = xb_add(&bar[XB_TOP], 1u);
            const unsigned tg = og / nx;
            if (og + 1u == (tg + 1u) * nx) xb_add(&bar[XB_TOPGEN], 1u);
            else XB_SPIN(xb_ld(&bar[XB_TOPGEN]) == tg, bar);
            __builtin_amdgcn_fence(__ATOMIC_ACQUIRE, XB_SCOPE);
            xb_add(&bar[XB_XGEN(b.x)], 1u);
            asm volatile("s_waitcnt vmcnt(0)" ::: "memory");
        } else {
            XB_SPIN(xb_ld(&bar[XB_XGEN(b.x)]) == gen, bar);
            __builtin_amdgcn_fence(__ATOMIC_ACQUIRE, XB_SCOPE);
            asm volatile("s_waitcnt vmcnt(0)" ::: "memory");
        }
#ifdef XB_DELAY
        for (int q = 0; q < XB_DELAY; ++q) __builtin_amdgcn_s_sleep(127);
#endif
    }
    __syncthreads();
}
}
namespace om {
enum { PH_P0A = 0, PH_P0C, PH_GLUE, PH_QKV, PH_ATTN, PH_WO, PH_HIN, PH_HSCAN, PH_HPOST, PH_HWO, PH_SSCAN, PH_SPOST, PH_GLU, PH_UP, PH_CONV, PH_DOWN, PH_FINAL };

struct Args { const float* in[33]; float* out; unsigned char* ws; int nph; int pad; unsigned char ptype[160]; unsigned char parg[160]; };
static_assert(offsetof(Args, ptype) == 288 && offsetof(Args, parg) == 448, "Args layout");

__device__ __forceinline__ void down_patch(const Ctx& C, int l, const pg8::StaticOrder& S) {
    Unit u; const float* cw = C.in(29) + (size_t)l * 3 * NUP; const float* E0 = C.f(WS_EDGE); bf16_t* act = C.h(WS_ACT);
    for (int i = 0; S.next(i, u); ++i) {
        if (u.pm < 16) continue;
        const bool top = (u.pm & 3) != 0, bot = (u.pm & 3) != 3;
        for (int n = C.tid; n < DFF; n += NTHREADS) {
            if (top) { const float* e = E0 + ((size_t)((u.pm - 16) * 2 + 0) * 4) * DFF; const float* ep = E0 + ((size_t)((u.pm - 17) * 2 + 1) * 4) * DFF;
                const float hg = e[n] + cw[n] * ep[2 * DFF + n], hv = e[DFF + n] + cw[DFF + n] * ep[3 * DFF + n];
                act[(size_t)(u.pm * 256) * DFF + n] = (bf16_t)(cvtpk(hg * sigm(hg) * hv, 0.f) & 0xffffu); }
            if (bot) { const float* e = E0 + ((size_t)((u.pm - 16) * 2 + 1) * 4) * DFF; const float* en = E0 + ((size_t)((u.pm - 15) * 2 + 0) * 4) * DFF;
                const float hg = e[n] + cw[2 * NUP + n] * en[2 * DFF + n], hv = e[DFF + n] + cw[2 * NUP + DFF + n] * en[3 * DFF + n];
                act[(size_t)(u.pm * 256 + 255) * DFF + n] = (bf16_t)(cvtpk(hg * sigm(hg) * hv, 0.f) & 0xffffu); }
        }
    }
    asm volatile("s_waitcnt vmcnt(0)" ::: "memory"); __syncthreads();
}
__device__ __forceinline__ void run_phase(const Ctx& C0, int type, int arg, int epoch) {
    Ctx C = C0; asm volatile("" : "+v"(C.tid)); asm volatile("" : "+s"(C.bid), "+s"(C.G), "+s"(C.kp), "+s"(C.ws), "+s"(C.out));
    C.lane = C.tid & 63; C.wave = __builtin_amdgcn_readfirstlane(C.tid >> 6);
    const int l = arg & 3;
    if (type == 31) return;
#ifndef PHASE_MASK
#define PHASE_MASK 0xFFFFFFFFu
#endif
    if (!((PHASE_MASK >> type) & 1u)) return;
    pg8::Gemm g{nullptr, nullptr, D, 256, 128, D, 0}; int nN = 0; EpiAny E{}; E.ws = C.ws; E.out = C.out; E.l = l; E.epoch = epoch;
    const bool splitk = false;
    switch (type) {
    case PH_P0A: phase_p0a(C); break;
    case PH_P0C: phase_p0c(C); break;
    case PH_GLUE: phase_glue(C, arg >> 1, arg & 1); break;
    case PH_QKV: { g.A = C.h(WS_AP); g.Bt = C.h(WS_WQKV) + (size_t)(l / 3) * NQKV * D; nN = 6; E.kind = EK_QKV; } break;
    case PH_ATTN: phase_attn(C, l, (arg & 32) ? SCR_O + 96 * MiB : SCR_O); break;
#ifdef DBG
    case 17: phase_chk(C, SCR_O, SCR_O + 96 * MiB, 16 * MiB); break;
#endif
#ifdef DBG
    case 18: phase_cks(C, arg); break;
#endif
#ifdef DBG
    case 19: phase_cmp(C, arg); break;
#endif
#ifdef DBG
    case 20: phase_clr(C); break;
#endif
    case PH_WO: case PH_HWO: case PH_GLU: {
        if (type == PH_WO) { g.A = C.h(SCR_O); g.Bt = C.h(WS_WO) + (size_t)(l / 3) * D * D; nN = 4; E.kind = EK_RES; if (splitk) { g.split = 1; g.K = D / 2; nN = 8; } }
        else if (type == PH_HWO) { g.A = C.h(SCR_AWO); g.Bt = C.h(WS_HWO); nN = 4; E.kind = EK_RES; if (splitk) { g.split = 1; g.K = D / 2; nN = 8; } }
        else { g.A = C.h(SCR_AGLU); g.Bt = C.h(WS_GLU); g.b_tile_rows = 128; g.b_half_rows = 1024; nN = 8; E.kind = EK_RES_GLU; }
        E.flags = ((arg & 32) ? 4 : 0) | (type == PH_HWO ? 8 : 0); } break;
    case PH_HIN: { g.A = C.h(WS_AP); g.Bt = C.h(WS_HWIN); nN = 20; E.kind = EK_HIN; } break;
    case PH_HSCAN: phase_hscan(C); break;
    case PH_HPOST: phase_hpost(C); break;
    case PH_SSCAN: phase_sscan(C, l, (arg & 32) ? WS_SCR + 80 * MiB : ((arg & 64) ? WS_SCR + 112 * MiB : 0)); break;
#ifdef DBG
    case 22: phase_clr2(C, WS_SCR + 80 * MiB, 64 * MiB); break;
#endif
#ifdef DBG
    case 21: phase_chk(C, WS_SCR + 80 * MiB, WS_SCR + 112 * MiB, 32 * MiB); break;
#endif
    case PH_SPOST: phase_spost(C, l); break;
    case PH_UP: { g.A = C.h(WS_AP); g.Bt = C.h(WS_UP) + (size_t)l * NUP * D; g.b_tile_rows = 128; g.b_half_rows = DFF; nN = 22; E.kind = EK_UPCONV; E.in29 = C.in(29); E.in30 = C.in(30); E.xl = C.lds + RING_BYTES; } break;
#ifdef DBG
    case 23: phase_chk(C, WS_SCR, WS_SCR + 88 * MiB, 88 * MiB); break;
#endif
    case PH_CONV: phase_conv(C, l); break;
    case PH_DOWN: { if (l < 3 && C.G == 256 && C.bid >= 128) convert_layer(C, l + 1, C.bid - 128, 128);
        { pg8::StaticOrder S0; S0.init(32, splitk ? 8 : 4, C.G, C.bid); down_patch(C, l, S0); }
        g.A = C.h(WS_ACT); g.Bt = C.h(WS_DOWN) + (size_t)l * D * DFF; g.K = DFF; g.ld = DFF; nN = 4; if (splitk) { g.split = 1; g.K = DFF / 2; nN = 8; } E.kind = EK_RES; E.flags = 1 | ((arg & 16) ? 2 : 0) | ((arg & 32) ? 4 : 0); } break;
    case PH_FINAL: { const unsigned fl = __hip_atomic_load((unsigned*)(C.ws + WS_CTL) + 4000, __ATOMIC_RELAXED, __HIP_MEMORY_SCOPE_AGENT), fd = __hip_atomic_load((unsigned*)(C.ws + WS_CTL) + 4001, __ATOMIC_RELAXED, __HIP_MEMORY_SCOPE_AGENT);
        #ifdef SSDET_CLS
        const unsigned cls = __hip_atomic_load((unsigned*)(C.ws + WS_CTL) + 4002, __ATOMIC_RELAXED, __HIP_MEMORY_SCOPE_AGENT), cnt = __hip_atomic_load((unsigned*)(C.ws + WS_CTL) + 4003, __ATOMIC_RELAXED, __HIP_MEMORY_SCOPE_AGENT);
        phase_final(C, 1.f + (float)cls / 8.f + (float)(cnt > 63 ? 63 : cnt) / 1024.f); } break;
#else
        phase_final(C, fl ? 3.f : (fd ? exp2f((float)(1001 - fd)) : 1.f)); } break;
#endif
    default: break;
    }
    if (nN) { pg8::StaticOrder S; S.init(32, nN, C.G, C.bid); pg8::gemm_phase(C.lds, g, S, E, C.tid); }
}

__device__ __forceinline__ void canary(const Ctx& C0, unsigned char* ws, int i, bool check) {
    int tid = C0.tid; asm volatile("" : "+v"(tid)); const int lane = tid & 63, wave = tid >> 6;
    unsigned* can = (unsigned*)(ws + WS_CTL + 32768);
#ifdef CANARY_SC1
    if (!check) { if (wave == 0 && lane < 32) __hip_atomic_store(can + C0.bid * 32 + lane, (unsigned)(i + 1), __ATOMIC_RELAXED, __HIP_MEMORY_SCOPE_AGENT); }
#else
    if (!check) { if (wave == 0 && lane < 32) can[C0.bid * 32 + lane] = (unsigned)(i + 1); }
#endif
#ifdef CANARY_LD_SC1
    else { const unsigned v = __hip_atomic_load(can + (wave * 32 + (lane >> 1)) * 32 + (lane & 1) * 16, __ATOMIC_RELAXED, __HIP_MEMORY_SCOPE_AGENT);
#else
    else { const unsigned v = can[(wave * 32 + (lane >> 1)) * 32 + (lane & 1) * 16];
#endif
      if (v != (unsigned)(i + 1) && v != (unsigned)(i + 2)) atomicAdd((unsigned*)(ws + WS_CTL) + 4000, 1u); }
}
__global__ void __launch_bounds__(NTHREADS, 2) mk_fwd(Args a) {
    extern __shared__ __attribute__((aligned(16))) unsigned char lds[];
    int wave_s = __builtin_amdgcn_readfirstlane((int)(threadIdx.x >> 6));
    { volatile LAS unsigned* misc = (volatile LAS unsigned*)((LAS unsigned char*)lds + LDS_BYTES - 64); if (threadIdx.x < 16) misc[threadIdx.x] = 0u; }
    __syncthreads();
    (void)xcd_barrier_post((unsigned*)(a.ws + WS_CTL), (volatile LAS unsigned*)((LAS unsigned char*)lds + LDS_BYTES - 64));
    for (int i = 0; i < a.nph; ++i) {
        {
            Ctx C; C.kp = (const unsigned char __attribute__((address_space(4)))*)__builtin_amdgcn_kernarg_segment_ptr();
            C.out = a.out; C.ws = a.ws; C.lds = (LAS unsigned char*)lds; asm volatile("" : "+s"(wave_s)); C.tid = (wave_s << 6) | lane_id(); C.lane = C.tid & 63; C.wave = 0; C.G = gridDim.x; C.bid = blockIdx.x;
            const unsigned wt = *(const unsigned __attribute__((address_space(4)))*)(C.kp + 288 + (i & ~3)), wa = *(const unsigned __attribute__((address_space(4)))*)(C.kp + 448 + (i & ~3));
            run_phase(C, (int)((wt >> (8 * (i & 3))) & 255u), (int)((wa >> (8 * (i & 3))) & 255u), i + 1);
#ifdef CANARY
            canary(C, a.ws, i, false);
#endif
        }
        if (i + 1 < a.nph) { XcdBarrier bar; bar.bar = (unsigned*)(a.ws + WS_CTL); bar.x = xb_xcc_id(); bar.st = (volatile LAS unsigned*)((LAS unsigned char*)lds + LDS_BYTES - 64); xcd_barrier(bar, wave_s == 0 && lane_id() == 0); }
#ifdef CANARY
        if (i + 1 < a.nph) { Ctx C; C.tid = (wave_s << 6) | lane_id(); C.bid = blockIdx.x; canary(C, a.ws, i, true); }
#endif
    }
}
}
extern "C" void kernel_launch(void* const* d_in, const int* in_sizes, int n_in, void* d_out, int out_size, void* d_ws, size_t ws_size, hipStream_t stream) {
    using namespace om;
    static int grid = 0;
    if (grid == 0) {
        if (n_in != 33 || out_size != 17039360 || ws_size < WS_END) { fprintf(stderr, "kernel_launch: unexpected sizes n_in %d out %d ws %zu; nothing launched\n", n_in, out_size, ws_size); grid = -1; return; }
        int dev = 0, cus = 0, per_cu = 0;
        (void)hipGetDevice(&dev); (void)hipDeviceGetAttribute(&cus, hipDeviceAttributeMultiprocessorCount, dev);
        (void)hipFuncSetAttribute((const void*)mk_fwd, hipFuncAttributeMaxDynamicSharedMemorySize, LDS_BYTES);
        if (hipOccupancyMaxActiveBlocksPerMultiprocessor(&per_cu, (const void*)mk_fwd, NTHREADS, LDS_BYTES) != hipSuccess || per_cu < 1) { fprintf(stderr, "kernel_launch: occupancy query gives %d blocks per CU\n", per_cu); per_cu = 1; }
        (void)hipGetLastError();
        grid = cus;
        if (grid > 256) grid = 256;
    }
    if (grid < 0) return;
    (void)hipMemsetAsync((char*)d_ws + WS_CTL, 0, CTL_ZERO_BYTES, stream);
    Args a{};
    for (int i = 0; i < 33; ++i) a.in[i] = (const float*)d_in[i];
    a.out = (float*)d_out; a.ws = (unsigned char*)d_ws;
    int n = 0;
#ifndef DUP_MASK
#define DUP_MASK 0u
#endif
#ifndef XBAR
#define XBAR 0
#endif
    auto add1 = [&](int t, int p) { a.ptype[n] = (unsigned char)t; a.parg[n] = (unsigned char)p; ++n; };
    auto add = [&](int t, int p) { add1(t, p);
        if ((DUP_MASK >> t) & 1u) { const bool resid = (t == PH_WO || t == PH_HWO || t == PH_GLU || t == PH_DOWN); add1(t, resid ? (p | 32) : p); }
        for (int q = 0; q < XBAR; ++q) add1(31, 0); };
#ifdef UPDET
    add1(PH_P0A, 0); add1(PH_P0C, 0);
    for (int l = 0; l < 4; ++l) { const int kind = l % 3;
        if (kind == 0) { add1(PH_QKV, l); add1(PH_ATTN, l); add1(PH_WO, l); }
        else if (kind == 1) { add1(PH_HIN, l); add1(PH_HSCAN, l); add1(PH_HPOST, l); add1(PH_HWO, l); }
        else { add1(PH_SSCAN, l); add1(PH_SPOST, l); add1(PH_GLU, l); }
        add1(PH_UP, l); add1(PH_UP, l | 32); add1(23, 0); add1(PH_CONV, l); add1(PH_DOWN, l == 3 ? (l | 16) : l); }
    add1(PH_FINAL, 0);
#elif defined(SSDET)
    add1(PH_P0A, 0); add1(PH_P0C, 0);
    for (int l = 0; l < 4; ++l) { const int kind = l % 3;
        if (kind == 0) { add1(PH_QKV, l); add1(PH_ATTN, l); add1(PH_WO, l); }
        else if (kind == 1) { add1(PH_HIN, l); add1(PH_HSCAN, l); add1(PH_HPOST, l); add1(PH_HWO, l); }
        else { add1(22, 0); add1(PH_SSCAN, l | 32); add1(PH_SSCAN, l | 64); add1(21, 0); add1(PH_SSCAN, l); add1(PH_SPOST, l); add1(PH_GLU, l); }
        add1(PH_UP, l); add1(PH_DOWN, l == 3 ? (l | 16) : l); }
    add1(PH_FINAL, 0);
#elif defined(LOCALIZE)
    for (int fwd = 0; fwd < 2; ++fwd) { int idx = 0;
        auto addc = [&](int t, int p) { add1(t, p); add1(18, fwd * 32 + idx); ++idx; };
        add1(20, 0); addc(PH_P0A, 0); addc(PH_P0C, 0);
        for (int l = 0; l < 4; ++l) { const int kind = l % 3;
            if (kind == 0) { addc(PH_QKV, l); addc(PH_ATTN, l); addc(PH_WO, l); }
            else if (kind == 1) { addc(PH_HIN, l); addc(PH_HSCAN, l); addc(PH_HPOST, l); addc(PH_HWO, l); }
            else { addc(PH_SSCAN, l); addc(PH_SPOST, l); addc(PH_GLU, l); }
            addc(PH_UP, l); addc(PH_DOWN, l == 3 ? (l | 16) : l); }
        if (fwd == 1) { add1(19, idx); add1(PH_FINAL, 0); } }
#else
    add(PH_P0A, 0); add(PH_P0C, 0);
    for (int l = 0; l < 4; ++l) {
        const int kind = l % 3;
        if (kind == 0) { add(PH_QKV, l); add(PH_ATTN, l); add(PH_WO, l); }
        else if (kind == 1) { add(PH_HIN, l); add(PH_HSCAN, l); add(PH_HPOST, l); add(PH_HWO, l); }
        else { add(PH_SSCAN, l); add(PH_SPOST, l); add(PH_GLU, l); }
        add(PH_UP, l); add(PH_DOWN, l == 3 ? (l | 16) : l);
    }
    add(PH_FINAL, 0);
#endif
    a.nph = n;
    void* args[] = {&a};
    const hipError_t e = hipLaunchCooperativeKernel((const void*)mk_fwd, dim3(grid), dim3(NTHREADS), args, LDS_BYTES, stream);
    if (e != hipSuccess) fprintf(stderr, "kernel_launch: cooperative launch failed: %s (grid %d)\n", hipGetErrorString(e), grid);
}
```

```cpp
#include <hip/hip_runtime.h>
#include <hip/hip_cooperative_groups.h>
#include <cstdio>
#include <cstdint>
#include <cmath>
#include <cstddef>
#define LAS __attribute__((address_space(3)))
#define GAS __attribute__((address_space(1)))
typedef unsigned short bf16_t;
typedef short bf16x8 __attribute__((ext_vector_type(8)));
typedef short s16x4 __attribute__((ext_vector_type(4)));
typedef float f32x2 __attribute__((ext_vector_type(2)));
typedef float f32x4 __attribute__((ext_vector_type(4)));
typedef float f32x16 __attribute__((ext_vector_type(16)));
typedef unsigned u32x2 __attribute__((ext_vector_type(2)));
typedef unsigned u32x4 __attribute__((ext_vector_type(4)));
typedef __bf16 bf16x2_t __attribute__((ext_vector_type(2)));

namespace om {
constexpr int D = 1024, MP = 4096, M = 8192, DFF = 2816, NUP = 5632, NQKV = 1536, NHIN = 5120;
constexpr float EPS = 1e-6f, LOG2E = 1.4426950408889634f, QSCALE = 0.125f * 1.4426950408889634f;
constexpr int NTHREADS = 512, NWAVES = 8, LDS_BYTES = 159744, RING_BYTES = 131072;
constexpr int SW_STRIDE = 5632;
constexpr float SS_FIX = 16777216.f, SS_INV = 1.f / (16777216.f * 1024.f);
typedef unsigned long long u64_t;
__device__ __forceinline__ float rstd_of(const u64_t* ss, int r) { return rsqrtf((float)ss[r] * SS_INV + 1e-6f); }
constexpr size_t MiB = 1u << 20;
constexpr size_t WS_CTL = 0, CTL_ZERO_BYTES = 64 * 1024;
constexpr size_t WS_MODP = 1 * MiB, WS_MOD = 3 * MiB, WS_SW = 4 * MiB, WS_GMOD = 5 * MiB, WS_SS = 6 * MiB, WS_ROPE = 7 * MiB;
constexpr size_t WS_LB1 = 8 * MiB, WS_SLAM = 8 * MiB + 64 * 1024, WS_SBB = 8 * MiB + 512 * 1024, WS_SCB = 9 * MiB;
constexpr size_t WS_CTXK = 10 * MiB, WS_CTXV = 12 * MiB;
constexpr size_t WS_NAIVE_MOD = 14 * MiB;
constexpr size_t WS_WQKV = 16 * MiB, WS_WO = 22 * MiB, WS_HWIN = 26 * MiB, WS_HWO = 36 * MiB, WS_GLU = 38 * MiB, WS_UP = 42 * MiB, WS_DOWN = 86 * MiB;
constexpr size_t WS_X = 108 * MiB, WS_R = 140 * MiB;
constexpr size_t WS_AP = WS_R, WS_ACT = WS_R + 16 * MiB, WS_SCR = WS_R + 60 * MiB, WS_END = WS_SCR + 176 * MiB;

constexpr size_t SCR_Q = WS_SCR, SCR_KB = WS_SCR + 16 * MiB, SCR_VB = WS_SCR + 20 * MiB, SCR_O = WS_SCR + 24 * MiB;
constexpr size_t SCR_HQ = WS_SCR, SCR_HV = WS_SCR + 16 * MiB, SCR_HG = WS_SCR + 32 * MiB, SCR_LFF = WS_SCR + 48 * MiB, SCR_LFB = WS_SCR + 80 * MiB, SCR_OF = WS_SCR + 112 * MiB, SCR_OB = WS_SCR + 144 * MiB, SCR_AWO = WS_SCR;
constexpr size_t SCR_YF = WS_SCR, SCR_YB = WS_SCR + 32 * MiB, SCR_AGLU = WS_SCR + 64 * MiB;

__device__ __forceinline__ int cond_of_tile(int pm) { return pm < 16 ? 0 : 1 + ((pm - 16) >> 2); }
__device__ __forceinline__ int cond_of_row(int r) { return r < MP ? 0 : 1 + ((r - MP) >> 10); }
__device__ __forceinline__ unsigned cvtpk(float lo, float hi) { f32x2 v = {lo, hi}; bf16x2_t b = __builtin_convertvector(v, bf16x2_t); return __builtin_bit_cast(unsigned, b); }
__device__ __forceinline__ float bf2f(unsigned short h) { return __uint_as_float(((unsigned)h) << 16); }
__device__ __forceinline__ float bflo(unsigned w) { return __uint_as_float(w << 16); }
__device__ __forceinline__ float bfhi(unsigned w) { return __uint_as_float(w & 0xffff0000u); }
__device__ __forceinline__ float sigm(float x) { return __builtin_amdgcn_rcpf(1.f + __expf(-x)); }
__device__ __forceinline__ int lane_id() { unsigned m = ~0u; asm volatile("" : "+s"(m)); return (int)__builtin_amdgcn_mbcnt_hi(m, __builtin_amdgcn_mbcnt_lo(m, 0u)); }
__device__ __forceinline__ float wave_sum(float v) {
#pragma unroll
    for (int o = 1; o < 64; o <<= 1) v += __shfl_xor(v, o);
    return v;
}

struct Ctx {
    const unsigned char __attribute__((address_space(4)))* kp;
    float* out; unsigned char* ws;
    LAS unsigned char* lds; int tid, lane, wave, G, bid;
    __device__ __forceinline__ const float* in(int i) const { return *(const float* const __attribute__((address_space(4)))*)(kp + 8 * i); }
    __device__ __forceinline__ float* f(size_t off) const { return (float*)(ws + off); }
    __device__ __forceinline__ bf16_t* h(size_t off) const { return (bf16_t*)(ws + off); }
};

namespace pg8 {
constexpr int BM = 256, BK = 64, HALF = 128, HTB = HALF * BK * 2, STAGE_BYTES = 8 * HTB, NXCD = 8, WGM = 8;
__host__ __device__ __forceinline__ int lds_byte(int r, int c) { const int st = (r >> 4) * 2 + (c >> 5), rr = r & 15, cc = c & 31, ob = rr * 64 + cc * 2; return st * 1024 + (ob ^ (((ob >> 9) & 1) << 5)); }
__host__ __device__ __forceinline__ void stage_rc(int b, int& R, int& C) { const int st = b / 1024, sb = b % 1024, swz = sb ^ (((sb >> 9) & 1) << 5); R = (st >> 1) * 16 + swz / 64; C = (st & 1) * 32 + (swz % 64) / 2; }
struct Unit { int pm, pn; };
struct Gemm { const bf16_t* A; const bf16_t* Bt; int K; int b_tile_rows, b_half_rows; int ld; int split; };
struct StaticOrder {
    int nM, nN, nwg, G, c;
    __device__ void init(int nM_, int nN_, int G_, int c_) { nM = nM_; nN = nN_; nwg = nM * nN; G = G_; c = c_; }
    __device__ bool next(int i, Unit& u) const {
        const long L = (long)i * G + c; if (L >= nwg) return false;
        int wgid = (int)L; { const int q = nwg / NXCD, r = nwg % NXCD, xcd = wgid % NXCD, off = wgid / NXCD; wgid = (xcd < r ? xcd * (q + 1) : r * (q + 1) + (xcd - r) * q) + off; }
        const int nig = WGM * nN, gid = wgid / nig, fm = gid * WGM, gsz = (nM - fm) < WGM ? (nM - fm) : WGM;
        u.pm = fm + ((wgid % nig) % gsz); u.pn = (wgid % nig) / gsz; return true;
    }
};
template <class Epi>
__device__ __forceinline__ void gemm_phase(LAS unsigned char* lds, const Gemm g, const StaticOrder& S, const Epi& E, int tid_in) {
    int tid_ = tid_in; asm volatile("" : "+v"(tid_));
    const int tid = tid_, wid = __builtin_amdgcn_readfirstlane(tid >> 6), lane = tid & 63, wr = wid >> 2, wc = wid & 3, fr = lane & 15, fq = lane >> 4;
    const int K = g.K, nt = K / BK, ld = g.ld;
    unsigned voffA[2];
#pragma unroll
    for (int i = 0; i < 2; ++i) { int R, C; stage_rc(tid * 16 + i * 8192, R, C); voffA[i] = (unsigned)(R * ld + C) * 2u; }
    const size_t kstep = (size_t)(BK * 2);
    const size_t hstepA = (size_t)HALF * ld * 2, tstepA = 2 * hstepA;
    const size_t hstepB = (size_t)g.b_half_rows * ld * 2, tstepB = (size_t)g.b_tile_rows * ld * 2, khb = (size_t)K * 2;
#define PG8_UA(u) ((const char*)g.A + (size_t)(u).pm * tstepA + (g.split ? (size_t)((u).pn & 1) * khb : 0))
#define PG8_UB(u) ((const char*)g.Bt + (size_t)(g.split ? (u).pn >> 1 : (u).pn) * tstepB + (g.split ? (size_t)((u).pn & 1) * khb : 0))
    const unsigned ldsw = (unsigned)wid * 1024u;
    const int aoff = lds_byte(wr * 64 + fr, fq * 8), boff = lds_byte(wc * 32 + fr, fq * 8);
#define PG8_SA(b, h) (((b) * 2 + (h)) * HTB)
#define PG8_SB(b, h) ((4 + (b) * 2 + (h)) * HTB)
#define PG8_STAGE(bufoff, gbase) do { _Pragma("unroll") for (int _i = 0; _i < 2; ++_i) \
        __builtin_amdgcn_global_load_lds((const unsigned*)((const char*)(gbase) + voffA[_i]), (LAS unsigned*)(lds + (bufoff) + ldsw + _i * 8192), 16, 0, 0); } while (0)
#define PG8_LDA(dst, b, h) do { _Pragma("unroll") for (int m = 0; m < 4; ++m) _Pragma("unroll") for (int k = 0; k < 2; ++k) dst[m][k] = *(const LAS bf16x8*)(lds + PG8_SA(b, h) + aoff + m * 2048 + k * 1024); } while (0)
#define PG8_LDB(dst, b, h) do { _Pragma("unroll") for (int n = 0; n < 2; ++n) _Pragma("unroll") for (int k = 0; k < 2; ++k) dst[n][k] = *(const LAS bf16x8*)(lds + PG8_SB(b, h) + boff + n * 2048 + k * 1024); } while (0)
#define PG8_MMA(ai, bj, At, Bt) do { __builtin_amdgcn_s_setprio(1); _Pragma("unroll") for (int m = 0; m < 4; ++m) _Pragma("unroll") for (int n = 0; n < 2; ++n) _Pragma("unroll") for (int k = 0; k < 2; ++k) \
        acc[ai][bj][m][n] = __builtin_amdgcn_mfma_f32_16x16x32_bf16(Bt[n][k], At[m][k], acc[ai][bj][m][n], 0, 0, 0); __builtin_amdgcn_s_setprio(0); } while (0)
#define PG8_WAIT_V(n) asm volatile("s_waitcnt vmcnt(" #n ")" ::: "memory")
#define PG8_WAIT_L(n) asm volatile("s_waitcnt lgkmcnt(" #n ")" ::: "memory")
#define PG8_BAR __builtin_amdgcn_s_barrier()
#define PG8_SCHED __builtin_amdgcn_sched_barrier(0)
    Unit cur, nxt; int ui = 0;
    if (!S.next(0, cur)) return;
    f32x4 acc[2][2][4][2];
#pragma unroll
    for (int a = 0; a < 2; ++a)
#pragma unroll
        for (int b = 0; b < 2; ++b)
#pragma unroll
            for (int m = 0; m < 4; ++m)
#pragma unroll
                for (int n = 0; n < 2; ++n) acc[a][b][m][n] = (f32x4){0.f, 0.f, 0.f, 0.f};
    bf16x8 At[4][2], B0[2][2], B1[2][2];
    const char* cA = PG8_UA(cur); const char* cB = PG8_UB(cur);
    PG8_STAGE(PG8_SB(0, 0), cB); PG8_STAGE(PG8_SB(0, 1), cB + hstepB); PG8_STAGE(PG8_SA(0, 0), cA); PG8_STAGE(PG8_SA(0, 1), cA + hstepA);
    if (wr == 1) PG8_BAR;
    PG8_WAIT_V(2); PG8_BAR;
    PG8_STAGE(PG8_SB(1, 0), cB + kstep); PG8_STAGE(PG8_SA(1, 0), cA + kstep); PG8_STAGE(PG8_SB(1, 1), cB + hstepB + kstep);
    PG8_WAIT_V(6); PG8_BAR;
    for (;;) {
        const bool has_next = S.next(ui + 1, nxt);
        const char* nA = has_next ? PG8_UA(nxt) : cA; const char* nB = has_next ? PG8_UB(nxt) : cB;
        for (int t = 0; t < nt; t += 2) {
            const bool last = (t == nt - 2);
            const char* a1 = cA + (size_t)(t + 1) * kstep;
            const char* a2 = last ? nA : cA + (size_t)(t + 2) * kstep; const char* b2 = last ? nB : cB + (size_t)(t + 2) * kstep;
            const char* a3 = a2 + kstep; const char* b3 = b2 + kstep;
            PG8_LDB(B0, 0, 0); PG8_LDB(B1, 0, 1); PG8_SCHED; PG8_LDA(At, 0, 0); PG8_STAGE(PG8_SA(1, 1), a1 + hstepA);
            PG8_WAIT_V(8); PG8_WAIT_L(0); PG8_BAR; PG8_MMA(0, 0, At, B0); PG8_MMA(0, 1, At, B1); PG8_BAR; PG8_SCHED;
            PG8_LDA(At, 0, 1); PG8_STAGE(PG8_SB(0, 0), b2); PG8_STAGE(PG8_SB(0, 1), b2 + hstepB); PG8_STAGE(PG8_SA(0, 0), a2);
            PG8_WAIT_V(8); PG8_WAIT_L(0); PG8_BAR; PG8_MMA(1, 0, At, B0); PG8_MMA(1, 1, At, B1); PG8_BAR; PG8_SCHED;
            PG8_LDB(B0, 1, 0); PG8_LDB(B1, 1, 1); PG8_SCHED; PG8_LDA(At, 1, 0); PG8_STAGE(PG8_SA(0, 1), a2 + hstepA);
            PG8_WAIT_V(8); PG8_WAIT_L(0); PG8_BAR; PG8_MMA(0, 0, At, B0); PG8_MMA(0, 1, At, B1); PG8_BAR; PG8_SCHED;
            PG8_LDA(At, 1, 1); PG8_STAGE(PG8_SB(1, 0), b3); PG8_STAGE(PG8_SB(1, 1), b3 + hstepB); PG8_STAGE(PG8_SA(1, 0), a3);
            PG8_WAIT_V(8); PG8_WAIT_L(0); PG8_BAR; PG8_MMA(1, 0, At, B0); PG8_MMA(1, 1, At, B1); PG8_BAR; PG8_SCHED;
        }
        if (wr == 0) PG8_BAR;
        { int l_e = lane_id(); asm volatile("" : "+v"(l_e));
          int fr_e = l_e & 15, fq_e = l_e >> 4, wr_e = wr, wc_e = wc; asm volatile("" : "+s"(wr_e), "+s"(wc_e));
          int tid_e = (wid << 6) | l_e;
          const Unit ue{cur.pm, g.split ? cur.pn >> 1 : cur.pn};
          E(acc, ue, wr_e, wc_e, fr_e, fq_e, g.split ? (cur.pn & 1) : -1, tid_e);
          E.post(ue, tid_e);
#ifdef DUP_POST
          E.post(ue, tid_e);
#endif
          }
        if (!has_next) break;
#pragma unroll
        for (int a = 0; a < 2; ++a)
#pragma unroll
            for (int b = 0; b < 2; ++b)
#pragma unroll
                for (int m = 0; m < 4; ++m)
#pragma unroll
                    for (int n = 0; n < 2; ++n) acc[a][b][m][n] = (f32x4){0.f, 0.f, 0.f, 0.f};
        cur = nxt; cA = nA; cB = nB; ++ui;
        if (wr == 1) PG8_BAR;
    }
    PG8_WAIT_V(0);
    PG8_BAR;
#undef PG8_SA
#undef PG8_UA
#undef PG8_UB
#undef PG8_SB
#undef PG8_STAGE
#undef PG8_LDA
#undef PG8_LDB
#undef PG8_MMA
#undef PG8_WAIT_V
#undef PG8_WAIT_L
#undef PG8_BAR
#undef PG8_SCHED
}
}
using pg8::Unit;
typedef f32x4 Acc[2][2][4][2];

__device__ __forceinline__ void st_bf16x4(bf16_t* p, f32x4 v) { u32x2 w; w.x = cvtpk(v[0], v[1]); w.y = cvtpk(v[2], v[3]); *(u32x2*)p = w; }

template <bool PAIRED> struct EpiRes {
    const float* xin; float* xout; bf16_t* ap; u64_t* ssn; const float* gate;   const float* gmodn;
    __device__ __forceinline__ void operator()(const Acc& acc, const Unit& u, int wr, int wc, int fr, int fq) const {
        const int c = cond_of_tile(u.pm);
        const int colb = (PAIRED ? u.pn * 128 : u.pn * 256) + wc * 32 + 4 * fq;
        constexpr int NBJ = PAIRED ? 1 : 2;
        f32x4 gv[NBJ][2], gm[NBJ][2];
#pragma unroll
        for (int bj = 0; bj < NBJ; ++bj)
#pragma unroll
            for (int n = 0; n < 2; ++n) { gv[bj][n] = *(const f32x4*)(gate + (size_t)c * 6144 + colb + bj * 128 + n * 16);
                gm[bj][n] = gmodn ? *(const f32x4*)(gmodn + (size_t)c * 1024 + colb + bj * 128 + n * 16) : (f32x4){0.f, 0.f, 0.f, 0.f}; }
#pragma unroll
        for (int ai = 0; ai < 2; ++ai)
#pragma unroll
            for (int m = 0; m < 4; ++m) {
                const int r = u.pm * 256 + ai * 128 + wr * 64 + m * 16 + fr; float sq = 0.f;
#pragma unroll
                for (int bj = 0; bj < NBJ; ++bj)
#pragma unroll
                    for (int n = 0; n < 2; ++n) {
                        f32x4 o = acc[ai][bj][m][n];
                        if (PAIRED) { const f32x4 gt = acc[ai][1][m][n];
#pragma unroll
                            for (int e = 0; e < 4; ++e) o[e] = o[e] * sigm(gt[e]); }
                        const size_t off = (size_t)r * D + colb + bj * 128 + n * 16;
                        const f32x4 xo = *(const f32x4*)(xin + off) + gv[bj][n] * o;
                        *(f32x4*)(xout + off) = xo;
                        sq += (xo[0] * xo[0] + xo[1] * xo[1]) + (xo[2] * xo[2] + xo[3] * xo[3]);
                        if (gmodn) st_bf16x4(ap + off, xo * gm[bj][n]);
                    }
                sq += __shfl_xor(sq, 16); sq += __shfl_xor(sq, 32);
                if (fq == 0) atomicAdd(ssn + r, (u64_t)(sq * SS_FIX));
            }
    }
};
struct EpiUpRaw {
    const u64_t* ss; const float* sw;   bf16_t* hraw;
    __device__ __forceinline__ void operator()(const Acc& acc, const Unit& u, int wr, int wc, int fr, int fq) const {
        const int c = cond_of_tile(u.pm); const int colb = u.pn * 256 + wc * 32 + 4 * fq;
        f32x4 sv[2][2];
#pragma unroll
        for (int bj = 0; bj < 2; ++bj)
#pragma unroll
            for (int n = 0; n < 2; ++n) sv[bj][n] = *(const f32x4*)(sw + (size_t)c * SW_STRIDE + colb + bj * 128 + n * 16);
#pragma unroll
        for (int ai = 0; ai < 2; ++ai)
#pragma unroll
            for (int m = 0; m < 4; ++m) {
                const int r = u.pm * 256 + ai * 128 + wr * 64 + m * 16 + fr; const float rs = rstd_of(ss, r);
#pragma unroll
                for (int bj = 0; bj < 2; ++bj)
#pragma unroll
                    for (int n = 0; n < 2; ++n) st_bf16x4(hraw + (size_t)r * NUP + colb + bj * 128 + n * 16, acc[ai][bj][m][n] * rs + sv[bj][n]);
            }
    }
};
constexpr size_t WS_EDGE = 14 * MiB;
template <int CTRL> __device__ __forceinline__ float dpp_f(float old, float src) { return __int_as_float(__builtin_amdgcn_update_dpp(__float_as_int(old), __float_as_int(src), CTRL, 0xf, 0xf, false)); }
#define DPP_ROW_SHL1 0x101
#define DPP_ROW_SHR1 0x111
#define DPP_ROW_ROR1 0x121
#define DPP_ROW_ROR15 0x12f
struct EpiUpConv {
    const u64_t* ss; const float* sw; const float* cw; const float* cb; bf16_t* act; float* edge; bf16_t* tile;
    __device__ __forceinline__ void operator()(const Acc& acc, const Unit& u, int wr, int wc, int fr, int fq) const {
        const int c = cond_of_tile(u.pm); const int cc0 = wc * 32 + 4 * fq, colg0 = u.pn * 128 + cc0;
        f32x4 sv[2][2];
#pragma unroll
        for (int bj = 0; bj < 2; ++bj)
#pragma unroll
            for (int n = 0; n < 2; ++n) sv[bj][n] = *(const f32x4*)(sw + (size_t)c * SW_STRIDE + bj * DFF + colg0 + n * 16);
#pragma unroll
        for (int ai = 0; ai < 2; ++ai)
#pragma unroll
            for (int m = 0; m < 4; ++m) { const int rl = ai * 128 + wr * 64 + m * 16 + fr; const float rs = rstd_of(ss, u.pm * 256 + rl);
#pragma unroll
                for (int bj = 0; bj < 2; ++bj)
#pragma unroll
                    for (int n = 0; n < 2; ++n) st_bf16x4(tile + rl * 256 + bj * 128 + cc0 + n * 16, acc[ai][bj][m][n] * rs + sv[bj][n]); }
    }
    __device__ __forceinline__ void fused(const Acc& acc, const Unit& u, int wr, int wc, int fr, int fq, int tid, LAS unsigned char* xl) const {
        const int c = cond_of_tile(u.pm);
        const bool samp = u.pm >= 16; const bool nb_top = samp && (u.pm & 3) != 0, nb_bot = samp && (u.pm & 3) != 3;
        float rs[8];
#pragma unroll
        for (int ai = 0; ai < 2; ++ai)
#pragma unroll
            for (int m = 0; m < 4; ++m) rs[ai * 4 + m] = rstd_of(ss, u.pm * 256 + ai * 128 + wr * 64 + m * 16 + fr);
        const int r = tid >> 1, q = tid & 1;
        LAS float* cf = (LAS float*)(xl + 20480);
        { const int bj = tid >> 8, jj = (tid >> 6) & 3, cl2 = 2 * (tid & 63); const float* src = (jj < 3 ? cw + jj * NUP : cb) + bj * DFF + u.pn * 128 + cl2;
          *(LAS f32x2*)(cf + (bj * 4 + jj) * 128 + cl2) = *(const f32x2*)src; }
#pragma unroll
        for (int sl = 0; sl < 8; ++sl) {
            const int swc = sl >> 1, sn = sl & 1, colg = u.pn * 128 + 32 * swc + 16 * sn, cs = 32 * swc + 16 * sn + 8 * q;
            if (wc == swc) {
                const f32x4 svg = *(const f32x4*)(sw + (size_t)c * SW_STRIDE + colg + 4 * fq), svv = *(const f32x4*)(sw + (size_t)c * SW_STRIDE + DFF + colg + 4 * fq);
#pragma unroll
                for (int ai = 0; ai < 2; ++ai)
#pragma unroll
                    for (int m = 0; m < 4; ++m) { const int row = ai * 128 + wr * 64 + m * 16 + fr;
                        const f32x4 hg = acc[ai][0][m][sn] * rs[ai * 4 + m] + svg, hv = acc[ai][1][m][sn] * rs[ai * 4 + m] + svv;
                        *(LAS u32x2*)(xl + row * 80 + 8 * fq) = (u32x2){cvtpk(hg[0], hg[1]), cvtpk(hg[2], hg[3])}; *(LAS u32x2*)(xl + row * 80 + 32 + 8 * fq) = (u32x2){cvtpk(hv[0], hv[1]), cvtpk(hv[2], hv[3])}; }
            }
            asm volatile("s_waitcnt lgkmcnt(0)" ::: "memory"); __builtin_amdgcn_s_barrier(); asm volatile("" ::: "memory");
            {
                const u32x4 z = {0u, 0u, 0u, 0u};
                const u32x4 pg = r > 0 ? *(const LAS u32x4*)(xl + (r - 1) * 80 + 16 * q) : z, pv = r > 0 ? *(const LAS u32x4*)(xl + (r - 1) * 80 + 32 + 16 * q) : z;
                const u32x4 cg = *(const LAS u32x4*)(xl + r * 80 + 16 * q), cv = *(const LAS u32x4*)(xl + r * 80 + 32 + 16 * q);
                const u32x4 ng = r < 255 ? *(const LAS u32x4*)(xl + (r + 1) * 80 + 16 * q) : z, nv = r < 255 ? *(const LAS u32x4*)(xl + (r + 1) * 80 + 32 + 16 * q) : z;
                float hg[8], hv[8];
                f32x4 wA[2][3], bA[2];
#pragma unroll
                for (int bj = 0; bj < 2; ++bj) {
#pragma unroll
                    for (int jj = 0; jj < 3; ++jj) wA[bj][jj] = *(const LAS f32x4*)(cf + (bj * 4 + jj) * 128 + cs);
                    bA[bj] = *(const LAS f32x4*)(cf + (bj * 4 + 3) * 128 + cs); }
#pragma unroll
                for (int e = 0; e < 2; ++e) { const int k0 = 2 * e;
                    hg[2 * e] = wA[0][0][k0] * bflo(pg[e]) + wA[0][1][k0] * bflo(cg[e]) + wA[0][2][k0] * bflo(ng[e]) + bA[0][k0];
                    hg[2 * e + 1] = wA[0][0][k0 + 1] * bfhi(pg[e]) + wA[0][1][k0 + 1] * bfhi(cg[e]) + wA[0][2][k0 + 1] * bfhi(ng[e]) + bA[0][k0 + 1];
                    hv[2 * e] = wA[1][0][k0] * bflo(pv[e]) + wA[1][1][k0] * bflo(cv[e]) + wA[1][2][k0] * bflo(nv[e]) + bA[1][k0];
                    hv[2 * e + 1] = wA[1][0][k0 + 1] * bfhi(pv[e]) + wA[1][1][k0 + 1] * bfhi(cv[e]) + wA[1][2][k0 + 1] * bfhi(nv[e]) + bA[1][k0 + 1]; }
                f32x4 wB[2][3], bB[2];
#pragma unroll
                for (int bj = 0; bj < 2; ++bj) {
#pragma unroll
                    for (int jj = 0; jj < 3; ++jj) wB[bj][jj] = *(const LAS f32x4*)(cf + (bj * 4 + jj) * 128 + cs + 4);
                    bB[bj] = *(const LAS f32x4*)(cf + (bj * 4 + 3) * 128 + cs + 4); }
#pragma unroll
                for (int e = 2; e < 4; ++e) { const int k0 = 2 * (e - 2);
                    hg[2 * e] = wB[0][0][k0] * bflo(pg[e]) + wB[0][1][k0] * bflo(cg[e]) + wB[0][2][k0] * bflo(ng[e]) + bB[0][k0];
                    hg[2 * e + 1] = wB[0][0][k0 + 1] * bfhi(pg[e]) + wB[0][1][k0 + 1] * bfhi(cg[e]) + wB[0][2][k0 + 1] * bfhi(ng[e]) + bB[0][k0 + 1];
                    hv[2 * e] = wB[1][0][k0] * bflo(pv[e]) + wB[1][1][k0] * bflo(cv[e]) + wB[1][2][k0] * bflo(nv[e]) + bB[1][k0];
                    hv[2 * e + 1] = wB[1][0][k0 + 1] * bfhi(pv[e]) + wB[1][1][k0 + 1] * bfhi(cv[e]) + wB[1][2][k0 + 1] * bfhi(nv[e]) + bB[1][k0 + 1]; }
                u32x4 o;
#pragma unroll
                for (int e = 0; e < 4; ++e) o[e] = cvtpk(hg[2 * e] * sigm(hg[2 * e]) * hv[2 * e], hg[2 * e + 1] * sigm(hg[2 * e + 1]) * hv[2 * e + 1]);
                *(u32x4*)(act + (size_t)(u.pm * 256 + r) * DFF + colg + 8 * q) = o;
                if ((r == 0 && nb_top) || (r == 255 && nb_bot)) {
                    float* e0 = edge + ((size_t)((u.pm - 16) * 2 + (r == 0 ? 0 : 1)) * 4) * DFF + colg + 8 * q;
#pragma unroll
                    for (int e = 0; e < 4; ++e) { e0[2 * e] = hg[2 * e]; e0[2 * e + 1] = hg[2 * e + 1]; e0[DFF + 2 * e] = hv[2 * e]; e0[DFF + 2 * e + 1] = hv[2 * e + 1];
                        e0[2 * DFF + 2 * e] = bflo(cg[e]); e0[2 * DFF + 2 * e + 1] = bfhi(cg[e]); e0[3 * DFF + 2 * e] = bflo(cv[e]); e0[3 * DFF + 2 * e + 1] = bfhi(cv[e]); } }
            }
            asm volatile("s_waitcnt lgkmcnt(0)" ::: "memory"); __builtin_amdgcn_s_barrier(); asm volatile("" ::: "memory"); __builtin_amdgcn_sched_barrier(0);
        }
    }
};
struct EpiQKV {
    const u64_t* ss; const float* sw; bf16_t *Q, *KB, *VB; float *outK, *outV; const float *ropec, *ropes; int j;
    __device__ __forceinline__ void operator()(const Acc& acc, const Unit& u, int wr, int wc, int fr, int fq) const {
        const int c = cond_of_tile(u.pm); const bool samp = u.pm >= 16; const int colt = u.pn * 256, cl0 = wc * 32 + 4 * fq;
        f32x4 sv[2][2];
#pragma unroll
        for (int bj = 0; bj < 2; ++bj)
#pragma unroll
            for (int n = 0; n < 2; ++n) sv[bj][n] = *(const f32x4*)(sw + (size_t)c * SW_STRIDE + colt + cl0 + bj * 128 + n * 16);
#pragma unroll
        for (int ai = 0; ai < 2; ++ai)
#pragma unroll
            for (int m = 0; m < 4; ++m) {
                const int r = u.pm * 256 + ai * 128 + wr * 64 + m * 16 + fr; const float rs = rstd_of(ss, r);
                f32x4 cs = {1.f, 1.f, 1.f, 1.f}, sn = {0.f, 0.f, 0.f, 0.f};
                if (samp && u.pn < 5) { const int t = (r - MP) & 1023, idx = t * 32 + (wc & 1) * 16 + 4 * fq; cs = *(const f32x4*)(ropec + idx); sn = *(const f32x4*)(ropes + idx); }
#pragma unroll
                for (int bj = 0; bj < 2; ++bj) {
                    f32x4 v0 = acc[ai][bj][m][0] * rs + sv[bj][0], v1 = acc[ai][bj][m][1] * rs + sv[bj][1];
                    if (u.pn < 5) { const f32x4 o0 = v0 * cs - v1 * sn, o1 = v1 * cs + v0 * sn; v0 = o0; v1 = o1; }
                    const int cl = bj * 128 + cl0;
                    if (u.pn < 4) { st_bf16x4(Q + (size_t)r * D + colt + cl, v0 * QSCALE); st_bf16x4(Q + (size_t)r * D + colt + cl + 16, v1 * QSCALE); }
                    else {
                        bf16_t* dst = (u.pn == 4 ? KB : VB) + (size_t)r * 256 + cl; st_bf16x4(dst, v0); st_bf16x4(dst + 16, v1);
                        if (!samp) { float* o = (u.pn == 4 ? outK : outV) + (((size_t)(r >> 8) * 2 + j) * 256 + (r & 255)) * 256 + cl; *(f32x4*)o = v0; *(f32x4*)(o + 16) = v1; }
                    }
                }
            }
    }
};
struct EpiHin {
    const u64_t* ss; const float* sw; const float* lb1; bf16_t *HQ, *HV, *HG; float *LFF, *LFB;
    __device__ __forceinline__ void operator()(const Acc& acc, const Unit& u, int wr, int wc, int fr, int fq) const {
        const int c = cond_of_tile(u.pm); const int seg = u.pn >> 2, colt = u.pn * 256, cl0 = wc * 32 + 4 * fq, cs0 = (u.pn & 3) * 256 + cl0;
        f32x4 sv[2][2], lbv[2][2];
#pragma unroll
        for (int bj = 0; bj < 2; ++bj)
#pragma unroll
            for (int n = 0; n < 2; ++n) { sv[bj][n] = *(const f32x4*)(sw + (size_t)c * SW_STRIDE + colt + cl0 + bj * 128 + n * 16);
                lbv[bj][n] = (seg == 2 || seg == 3) ? *(const f32x4*)(lb1 + (seg - 2) * 1024 + cs0 + bj * 128 + n * 16) : (f32x4){0.f, 0.f, 0.f, 0.f}; }
#pragma unroll
        for (int ai = 0; ai < 2; ++ai)
#pragma unroll
            for (int m = 0; m < 4; ++m) {
                const int r = u.pm * 256 + ai * 128 + wr * 64 + m * 16 + fr; const float rs = rstd_of(ss, r);
#pragma unroll
                for (int bj = 0; bj < 2; ++bj)
#pragma unroll
                    for (int n = 0; n < 2; ++n) {
                        f32x4 v = acc[ai][bj][m][n] * rs + sv[bj][n]; const size_t off = (size_t)r * D + cs0 + bj * 128 + n * 16;
                        if (seg == 0) st_bf16x4(HQ + off, v);
                        else if (seg == 1) st_bf16x4(HV + off, v);
                        else if (seg == 4) {
#pragma unroll
                            for (int e = 0; e < 4; ++e) v[e] = v[e] * sigm(v[e]);
                            st_bf16x4(HG + off, v); }
                        else { const f32x4 lb = lbv[bj][n];
#pragma unroll
                            for (int e = 0; e < 4; ++e) v[e] = __logf(lb[e] + (1.f - lb[e]) * sigm(v[e]));
                            *(f32x4*)((seg == 2 ? LFF : LFB) + off) = v; }
                    }
            }
    }
};
enum { EK_RES = 0, EK_RES_GLU, EK_UPRAW, EK_QKV, EK_HIN, EK_UPCONV };
struct EpiAny {
    int kind, l, flags, epoch; unsigned char* ws; float* out; const float *in29, *in30; LAS unsigned char* xl;
    __device__ __forceinline__ float* F(size_t o) const { return (float*)(ws + o); }
    __device__ __forceinline__ bf16_t* H(size_t o) const { return (bf16_t*)(ws + o); }
    __device__ __forceinline__ void post(const Unit&, int) const {}
    __device__ __forceinline__ void operator()(Acc& acc, const Unit& u, int wr, int wc, int fr, int fq, int kh, int tid) const {
#ifndef EK_MASK
#define EK_MASK 63
#endif
        if (!((EK_MASK >> this->kind) & 1)) return;
        unsigned char* ws = this->ws; float* out = this->out; int kind = this->kind, l = this->l, flags = this->flags;
        asm volatile("" : "+s"(ws), "+s"(out), "+s"(kind), "+s"(l), "+s"(flags));
        if (kh >= 0) {
            const int tile = u.pm * 4 + u.pn; unsigned* flag = (unsigned*)(ws + WS_CTL + 40960) + tile * 16;
            unsigned char* slab = ws + WS_SCR + 64 * MiB + (size_t)tile * 262144 + (size_t)tid * 16;
            if (kh == 1) {
                __amdgpu_buffer_rsrc_t rs = __builtin_amdgcn_make_buffer_rsrc(ws + WS_SCR + 64 * MiB + (size_t)tile * 262144, 0, 262144, 0x00020000);
#pragma unroll
                for (int j = 0; j < 32; ++j) __builtin_amdgcn_raw_buffer_store_b128(__builtin_bit_cast(u32x4, acc[j >> 4][(j >> 3) & 1][(j >> 1) & 3][j & 1]), rs, tid * 16 + j * 8192, 0, 16);
                asm volatile("s_waitcnt vmcnt(0)" ::: "memory"); __builtin_amdgcn_s_barrier(); asm volatile("" ::: "memory");
                if (tid == 0) __hip_atomic_store(flag, (unsigned)epoch, __ATOMIC_RELAXED, __HIP_MEMORY_SCOPE_AGENT);
                return;
            }
            if (tid < 64) {
                unsigned sp = 0;
                while ((unsigned)__builtin_amdgcn_readfirstlane((int)__hip_atomic_load(flag, __ATOMIC_RELAXED, __HIP_MEMORY_SCOPE_AGENT)) != (unsigned)epoch) { __builtin_amdgcn_s_sleep(2); if (++sp > (1u << 22)) break; }
                __builtin_amdgcn_fence(__ATOMIC_ACQUIRE, "agent"); asm volatile("s_waitcnt vmcnt(0)" ::: "memory");
            }
            asm volatile("" ::: "memory"); __builtin_amdgcn_s_barrier(); asm volatile("" ::: "memory");
#pragma unroll
            for (int j = 0; j < 32; ++j) acc[j >> 4][(j >> 3) & 1][(j >> 1) & 3][j & 1] += *(const f32x4*)(slab + (size_t)j * 8192);
        }
        auto F = [&](size_t o) { return (float*)(ws + o); }; auto H = [&](size_t o) { return (bf16_t*)(ws + o); };
        const size_t ss1 = WS_SS + (size_t)(l * 2) * M * 8, sw1 = WS_SW + (size_t)(l * 2) * 5 * SW_STRIDE * 4;
        switch (kind) {
        case EK_RES: case EK_RES_GLU: {
            const bool down = flags & 1;
            const size_t ssn = down ? WS_SS + (size_t)((l + 1) * 2) * M * 8 : ss1 + (size_t)M * 8;
            const size_t gate = WS_MOD + ((size_t)l * 5 * 6144 + (down ? 5 : 2) * 1024) * 4;
            const size_t gmn = down ? WS_GMOD + (size_t)((l + 1) * 2) * 5 * 1024 * 4 : WS_GMOD + (size_t)(l * 2 + 1) * 5 * 1024 * 4;
            const bool has_next = !(down && l == 3);
            float* xo = (flags & 2) ? out : F(WS_X); bf16_t* ap = H(WS_AP); u64_t* sp = (u64_t*)(ws + ssn);
            if (flags & 4) { const size_t dm = WS_SCR + ((flags & 8) ? 48 : 96) * MiB; xo = F(dm); ap = H(dm + 32 * MiB); sp = (u64_t*)(ws + dm + 48 * MiB); }
            if (kind == EK_RES) { EpiRes<false> E{F(WS_X), xo, ap, sp, F(gate), has_next ? F(gmn) : nullptr}; E(acc, u, wr, wc, fr, fq); }
            else { EpiRes<true> E{F(WS_X), xo, ap, sp, F(gate), F(gmn)}; E(acc, u, wr, wc, fr, fq); } } break;
        case EK_UPRAW: { EpiUpRaw E{(const u64_t*)(ws + ss1 + (size_t)M * 8), F(sw1 + (size_t)5 * SW_STRIDE * 4), H(WS_SCR + (size_t)((flags >> 2) & 1) * (88 * MiB))}; E(acc, u, wr, wc, fr, fq); } break;
        case EK_UPCONV: { EpiUpConv E{(const u64_t*)(ws + ss1 + (size_t)M * 8), F(sw1 + (size_t)5 * SW_STRIDE * 4), in29 + (size_t)l * 3 * NUP, in30 + (size_t)l * NUP, H(WS_ACT), F(WS_EDGE), nullptr}; E.fused(acc, u, wr, wc, fr, fq, tid, xl); } break;
        case EK_QKV: { EpiQKV E{(const u64_t*)(ws + ss1), F(sw1), H(SCR_Q), H(SCR_KB), H(SCR_VB), out + 8388608, out + 8388608 + 2097152, F(WS_ROPE), F(WS_ROPE) + 32768, l / 3}; E(acc, u, wr, wc, fr, fq); } break;
        default: { EpiHin E{(const u64_t*)(ws + ss1), F(sw1), F(WS_LB1), H(SCR_HQ), H(SCR_HV), H(SCR_HG), F(SCR_LFF), F(SCR_LFB)}; E(acc, u, wr, wc, fr, fq); } break;
        }
    }
};
}
namespace om {
#define LDS_WAIT() asm volatile("s_waitcnt lgkmcnt(0)" ::: "memory")
__device__ __forceinline__ void transpose_item(const float* W, int K, int N, bf16_t* WT, LAS unsigned short* scr, int item, int lane) {
    const int nblk = N / 32, kb = item / nblk, nb = item % nblk, k0 = 64 * kb, n0 = 32 * nb;
    float v[32];
#pragma unroll
    for (int i = 0; i < 32; ++i) v[i] = W[(size_t)(k0 + 2 * i + (lane >> 5)) * N + n0 + (lane & 31)];
#pragma unroll
    for (int i = 0; i < 32; ++i) scr[(2 * i + (lane >> 5)) * 33 + (lane & 31)] = (unsigned short)(cvtpk(v[i], 0.f) & 0xffffu);
    LDS_WAIT(); asm volatile("" ::: "memory");
    const int c = lane & 7;
#pragma unroll
    for (int j = 0; j < 4; ++j) { const int n = (lane >> 3) + 8 * j; const LAS unsigned short* s = scr + (8 * c) * 33 + n;
        u32x4 o; o.x = (unsigned)s[0 * 33] | ((unsigned)s[1 * 33] << 16); o.y = (unsigned)s[2 * 33] | ((unsigned)s[3 * 33] << 16); o.z = (unsigned)s[4 * 33] | ((unsigned)s[5 * 33] << 16); o.w = (unsigned)s[6 * 33] | ((unsigned)s[7 * 33] << 16);
        *(u32x4*)(WT + (size_t)(n0 + n) * K + k0 + 8 * c) = o; }
    LDS_WAIT(); asm volatile("" ::: "memory");
}
__device__ __forceinline__ float modsum(const Ctx& C, int l, int c, int idx) {
    const float* mp = C.f(WS_MODP) + ((size_t)l * 5 + c) * 6144 + idx; float s = C.in(9)[l * 6144 + idx];
#pragma unroll
    for (int kp = 0; kp < 4; ++kp) s += mp[(size_t)kp * 4 * 5 * 6144];
    return s;
}
__device__ __forceinline__ void convert_layer(const Ctx& C, int layer, int vb, int nvb) {
    const int gw = vb * NWAVES + C.wave, NGW = nvb * NWAVES;
    LAS unsigned short* scr = (LAS unsigned short*)(C.lds + C.wave * 4352);
#define DO_MAT(src, dst, K, N) for (int it = gw; it < ((K) / 64) * ((N) / 32); it += NGW) transpose_item((src), (K), (N), (dst), scr, it, C.lane)
    if (layer == 0 || layer == 3) { const int j = layer / 3; DO_MAT(C.in(12) + (size_t)j * D * NQKV, C.h(WS_WQKV) + (size_t)j * NQKV * D, D, NQKV); DO_MAT(C.in(13) + (size_t)j * D * D, C.h(WS_WO) + (size_t)j * D * D, D, D); }
    else if (layer == 1) { DO_MAT(C.in(15), C.h(WS_HWIN), D, NHIN); DO_MAT(C.in(18), C.h(WS_HWO), D, D); }
    else { DO_MAT(C.in(27), C.h(WS_GLU), D, 2048); }
    DO_MAT(C.in(28) + (size_t)layer * D * NUP, C.h(WS_UP) + (size_t)layer * NUP * D, D, NUP); DO_MAT(C.in(31) + (size_t)layer * DFF * D, C.h(WS_DOWN) + (size_t)layer * D * DFF, DFF, D);
#undef DO_MAT
}
__device__ __forceinline__ void phase_p0a(const Ctx& C) {
    const int gt = C.bid * NTHREADS + C.tid, NGT = C.G * NTHREADS;
    for (int layer = 0; layer < 4; ++layer) if (layer == 0 || C.G != 256) convert_layer(C, layer, C.bid, C.G);
    __syncthreads();
    LAS float* sS = (LAS float*)(C.lds + 40960);
    LAS float* red = (LAS float*)(C.lds);
    for (int it = C.bid; it < 384; it += C.G) {
        const int l = it / 96, cb = (it % 96) >> 2, kp = it & 3;
        for (int i = C.tid; i < 5 * 256; i += NTHREADS) { const int c = i >> 8, k = kp * 256 + (i & 255); const float v = c == 0 ? C.in(7)[k] : C.in(6)[(c - 1) * 1024 + k]; sS[i] = v / (1.f + __expf(-v)); }
        __syncthreads();
        f32x4 a[5];
#pragma unroll
        for (int c = 0; c < 5; ++c) a[c] = (f32x4){0.f, 0.f, 0.f, 0.f};
        const float* wp = C.in(8) + ((size_t)l * 1024 + kp * 256 + C.wave * 32) * 6144 + cb * 256 + 4 * C.lane;
#pragma unroll 4
        for (int k = 0; k < 32; ++k) { const f32x4 w = *(const f32x4*)(wp + (size_t)k * 6144);
#pragma unroll
            for (int c = 0; c < 5; ++c) a[c] += w * sS[c * 256 + C.wave * 32 + k]; }
#pragma unroll
        for (int c = 0; c < 5; ++c) *(LAS f32x4*)(red + (C.wave * 5 + c) * 256 + 4 * C.lane) = a[c];
        __syncthreads();
        for (int i = C.tid; i < 5 * 256; i += NTHREADS) { float s = 0.f;
#pragma unroll
            for (int w = 0; w < 8; ++w) s += red[w * 1280 + i];
            C.f(WS_MODP)[(((size_t)kp * 4 + l) * 5 + (i >> 8)) * 6144 + cb * 256 + (i & 255)] = s; }
        __syncthreads();
    }
    { unsigned zero = 0u; asm volatile("" : "+v"(zero));
      for (int i = gt; i < 9 * M; i += NGT) ((u32x2*)(C.ws + WS_SS))[i] = (u32x2){zero, zero}; }
    for (int i = gt; i < 1024 * 32; i += NGT) { const int t = i >> 5, e = i & 31, fi = e & 15; const float pos = (e >> 4) == 0 ? (float)(t >> 6) : (float)(t & 63);
        const float ang = pos * __builtin_amdgcn_exp2f(-(float)fi * (13.287712379549449f / 16.0f))  ; C.f(WS_ROPE)[i] = cosf(ang); C.f(WS_ROPE)[32768 + i] = sinf(ang); }
    for (int i = gt; i < 2 * 131072; i += NGT) { const int which = i >> 17, e = (i & 131071) * 8; const float* s = (which ? C.in(3) : C.in(2)) + e; const f32x4 a = *(const f32x4*)s, b = *(const f32x4*)(s + 4);
        u32x4 o; o.x = cvtpk(a[0], a[1]); o.y = cvtpk(a[2], a[3]); o.z = cvtpk(b[0], b[1]); o.w = cvtpk(b[2], b[3]); *(u32x4*)(C.h(which ? WS_CTXV : WS_CTXK) + e) = o; }
    for (int i = gt; i < 2048; i += NGT) { float v[4], mx = -1e30f;
#pragma unroll
        for (int l = 0; l < 4; ++l) { v[l] = C.in(16)[l * 2048 + i]; mx = fmaxf(mx, v[l]); }
        float s = 0.f;
#pragma unroll
        for (int l = 0; l < 4; ++l) { v[l] = expf(v[l] - mx); s += v[l]; }
        C.f(WS_LB1)[i] = v[1] / s; }
    for (int i = gt; i < 8192; i += NGT) {
        const int dg = i >> 6, p = i & 63;
        const float ar = fminf(C.in(19)[i], -1e-4f), ai = C.in(20)[i], dt = expf(C.in(21)[dg]);
        const float e = expf(ar * dt), lr = e * cosf(ai * dt), li = e * sinf(ai * dt);
        const float den = ar * ar + ai * ai, fr = ((lr - 1.f) * ar + li * ai) / den, fi = (li * ar - (lr - 1.f) * ai) / den;
        C.f(WS_SLAM)[2 * i] = lr; C.f(WS_SLAM)[2 * i + 1] = li;
        unsigned wr_[8], wi_[8];
#pragma unroll
        for (int q = 0; q < 8; ++q) { const float x0 = C.in(22)[(size_t)i * 16 + 2 * q], y0 = C.in(23)[(size_t)i * 16 + 2 * q], x1 = C.in(22)[(size_t)i * 16 + 2 * q + 1], y1 = C.in(23)[(size_t)i * 16 + 2 * q + 1];
            wr_[q] = cvtpk(fr * x0 - fi * y0, fr * x1 - fi * y1); wi_[q] = cvtpk(fr * y0 + fi * x0, fr * y1 + fi * x1); }
        bf16_t* bb = C.h(WS_SBB) + ((size_t)dg * 128 + p) * 16;
        *(u32x4*)bb = (u32x4){wr_[0], wr_[1], wr_[2], wr_[3]}; *(u32x4*)(bb + 8) = (u32x4){wr_[4], wr_[5], wr_[6], wr_[7]};
        *(u32x4*)(bb + 64 * 16) = (u32x4){wi_[0], wi_[1], wi_[2], wi_[3]}; *(u32x4*)(bb + 64 * 16 + 8) = (u32x4){wi_[4], wi_[5], wi_[6], wi_[7]};
    }
    for (int i = gt; i < 2 * 64 * 16 * 64; i += NGT) {
        const int p = i & 63, row = i >> 6; bf16_t* cb = C.h(WS_SCB) + (size_t)row * 128;
        cb[p] = (bf16_t)(cvtpk(C.in(24)[i], 0.f) & 0xffffu); cb[64 + p] = (bf16_t)(cvtpk(-C.in(25)[i], 0.f) & 0xffffu); }
}
__device__ __forceinline__ void rows_ap_ss(const Ctx& C, const float* xsrc_p, const float* xsrc_s, float* xcopy, int l, int s, bool from_table, u64_t* ssdst) {
    for (int gw = C.bid * NWAVES + C.wave; gw < M / 4; gw += C.G * NWAVES) {
    const int r0 = gw * 4;
    const int c = cond_of_row(r0);
    f32x4 gm[4];
#pragma unroll
    for (int j = 0; j < 4; ++j) { const int n = 4 * C.lane + 256 * j;
        if (from_table) gm[j] = *(const f32x4*)(C.f(WS_GMOD) + (((size_t)l * 2 + s) * 5 + c) * 1024 + n);
        else { const float* g = (s == 0 ? C.in(10) : C.in(11)) + l * D + n;
#pragma unroll
            for (int e = 0; e < 4; ++e) gm[j][e] = g[e] * (1.f + modsum(C, l, c, (s == 0 ? 1 : 4) * 1024 + n + e)); } }
    for (int rr = 0; rr < 4; ++rr) {
        const int r = r0 + rr; const float* xr = (r < MP ? xsrc_p + (size_t)r * D : xsrc_s + (size_t)(r - MP) * D);
        f32x4 v[4]; float sq = 0.f;
#pragma unroll
        for (int j = 0; j < 4; ++j) { v[j] = *(const f32x4*)(xr + 4 * C.lane + 256 * j); sq += (v[j][0] * v[j][0] + v[j][1] * v[j][1]) + (v[j][2] * v[j][2] + v[j][3] * v[j][3]); }
        sq = wave_sum(sq);
#pragma unroll
        for (int j = 0; j < 4; ++j) { const size_t off = (size_t)r * D + 4 * C.lane + 256 * j; if (xcopy) *(f32x4*)(xcopy + off) = v[j]; st_bf16x4(C.h(WS_AP) + off, v[j] * gm[j]); }
        if (C.lane == 0) ssdst[r] = (u64_t)(sq * SS_FIX);
    }
    }
}
template <bool FROM_TABLE> __device__ __forceinline__ void sw_item_t(const Ctx& C, int item) {
    int ch = item, l = 0, s = 0, N = 0; const float* Wf = nullptr;
    if (ch < 12) { l = 0; s = 0; N = NQKV; Wf = C.in(12); }
    else if ((ch -= 12) < 44) { l = 0; s = 1; N = NUP; Wf = C.in(28); }
    else if ((ch -= 44) < 40) { l = 1; s = 0; N = NHIN; Wf = C.in(15); }
    else if ((ch -= 40) < 44) { l = 1; s = 1; N = NUP; Wf = C.in(28) + (size_t)1 * D * NUP; }
    else if ((ch -= 44) < 44) { l = 2; s = 1; N = NUP; Wf = C.in(28) + (size_t)2 * D * NUP; }
    else if ((ch -= 44) < 12) { l = 3; s = 0; N = NQKV; Wf = C.in(12) + (size_t)1 * D * NQKV; }
    else { ch -= 12; l = 3; s = 1; N = NUP; Wf = C.in(28) + (size_t)3 * D * NUP; }
    LAS float* sh = (LAS float*)C.lds;
    for (int i = C.tid; i < 5 * 1024; i += NTHREADS) sh[i] = FROM_TABLE ? C.f(WS_MOD)[((size_t)l * 5 + (i >> 10)) * 6144 + (s == 0 ? 0 : 3) * 1024 + (i & 1023)] : modsum(C, l, i >> 10, (s == 0 ? 0 : 3) * 1024 + (i & 1023));
    __syncthreads();
    const int n0 = ch * 128 + 4 * (C.lane & 31);
    f32x4 a[5];
#pragma unroll
    for (int c = 0; c < 5; ++c) a[c] = (f32x4){0.f, 0.f, 0.f, 0.f};
    const float* wp = Wf + (size_t)(C.wave * 128 + (C.lane >> 5)) * N + n0;
#pragma unroll 4
    for (int k = 0; k < 64; ++k) { const f32x4 w = *(const f32x4*)(wp + (size_t)(2 * k) * N); const int kk = C.wave * 128 + 2 * k + (C.lane >> 5);
#pragma unroll
        for (int c = 0; c < 5; ++c) a[c] += w * sh[c * 1024 + kk]; }
    LAS float* red = (LAS float*)(C.lds + 20480);
#pragma unroll
    for (int c = 0; c < 5; ++c) *(LAS f32x4*)(red + ((C.wave * 2 + (C.lane >> 5)) * 5 + c) * 128 + 4 * (C.lane & 31)) = a[c];
    __syncthreads();
    for (int i = C.tid; i < 5 * 128; i += NTHREADS) { float sum = 0.f;
#pragma unroll
        for (int w = 0; w < 16; ++w) sum += red[w * 640 + i];
        C.f(WS_SW)[(((size_t)l * 2 + s) * 5 + (i >> 7)) * SW_STRIDE + ch * 128 + (i & 127)] = sum; }
    __syncthreads();
}
__device__ __forceinline__ void sw_item_p0(const Ctx& C, int item) { sw_item_t<false>(C, item); }
__device__ __forceinline__ void sw_item(const Ctx& C, int item) { sw_item_t<true>(C, item); }
__device__ __forceinline__ void phase_p0c(const Ctx& C) {
    for (int vb = C.bid; vb < 256; vb += C.G) {
    if (vb < 240) {
        sw_item_p0(C, vb);
    } else {
        const int t = (vb - 240) * NTHREADS + C.tid, NT = 16 * NTHREADS;
        for (int i = t; i < 4 * 5 * 6144; i += NT) { const int l = i / 30720, c = (i / 6144) % 5, idx = i % 6144; C.f(WS_MOD)[i] = modsum(C, l, c, idx); }
        for (int i = t; i < 4 * 2 * 5 * 1024; i += NT) { const int n = i & 1023, c = (i >> 10) % 5, s = (i / 5120) & 1, l = i / 10240;
            C.f(WS_GMOD)[i] = (s == 0 ? C.in(10) : C.in(11))[l * D + n] * (1.f + modsum(C, l, c, (s == 0 ? 1 : 4) * 1024 + n)); }
    }
    __syncthreads();
    }
    rows_ap_ss(C, C.in(0), C.in(1), C.f(WS_X), 0, 0, false, (u64_t*)(C.ws + WS_SS));
}
__device__ __forceinline__ void phase_glue(const Ctx& C, int l, int s) { rows_ap_ss(C, C.f(WS_X), C.f(WS_X) + (size_t)MP * D, nullptr, l, s, true, (u64_t*)(C.ws + WS_SS) + (size_t)(l * 2 + s) * M); }

__device__ __forceinline__ void phase_conv(const Ctx& C, int l) {
    const bf16_t* h = C.h(WS_SCR); bf16_t* act = C.h(WS_ACT); const float* cw = C.in(29) + (size_t)l * 3 * NUP; const float* cb = C.in(30) + (size_t)l * NUP;
    const int gt = C.bid * NTHREADS + C.tid, NGT = C.G * NTHREADS;
    for (int i = gt; i < M * (DFF / 8); i += NGT) {
        const int r = i / (DFF / 8), n = (i % (DFF / 8)) * 8;
        int t, S; if (r < MP) { t = r & 255; S = 256; } else { t = (r - MP) & 1023; S = 1024; }
        float g[8], v[8];
#pragma unroll
        for (int e = 0; e < 8; ++e) { g[e] = cb[n + e]; v[e] = cb[DFF + n + e]; }
#pragma unroll
        for (int jj = 0; jj < 3; ++jj) { const int tt = t + jj - 1; if (tt >= 0 && tt < S) {
            const u32x4 hg = *(const u32x4*)(h + (size_t)(r + jj - 1) * NUP + n), hv = *(const u32x4*)(h + (size_t)(r + jj - 1) * NUP + DFF + n);
#pragma unroll
            for (int e = 0; e < 4; ++e) { g[2 * e] += cw[jj * NUP + n + 2 * e] * bflo(hg[e]); g[2 * e + 1] += cw[jj * NUP + n + 2 * e + 1] * bfhi(hg[e]);
                v[2 * e] += cw[jj * NUP + DFF + n + 2 * e] * bflo(hv[e]); v[2 * e + 1] += cw[jj * NUP + DFF + n + 2 * e + 1] * bfhi(hv[e]); } } }
        u32x4 o;
#pragma unroll
        for (int e = 0; e < 4; ++e) o[e] = cvtpk(g[2 * e] * sigm(g[2 * e]) * v[2 * e], g[2 * e + 1] * sigm(g[2 * e + 1]) * v[2 * e + 1]);
        *(u32x4*)(act + (size_t)r * DFF + n) = o;
    }
}
__device__ __forceinline__ void phase_final(const Ctx& C, float dbg) {
    const int gw = C.bid * NWAVES + C.wave, NGW = C.G * NWAVES; const u64_t* ss = (const u64_t*)(C.ws + WS_SS) + (size_t)8 * M;
    for (int r = gw; r < M; r += NGW) { const float rs = rstd_of(ss, r);
#pragma unroll
        for (int j = 0; j < 4; ++j) { const int n = 4 * C.lane + 256 * j; float* p = C.out + (size_t)r * D + n; *(f32x4*)p = *(const f32x4*)p * (rs * dbg) * *(const f32x4*)(C.in(32) + n); } }
}
}
namespace om {
__device__ __forceinline__ int rowidx(int r, int h) { return (r & 3) + 8 * (r >> 2) + 4 * h; }
__device__ __forceinline__ float xhalf(float v) {
    auto rr = __builtin_amdgcn_permlane32_swap(__float_as_uint(v), __float_as_uint(v), false, false);
    return __uint_as_float((lane_id() & 32) ? rr[0] : rr[1]);
}
__device__ __forceinline__ bf16x8 pack8(const f32x16& x, int base) {
    u32x4 w; w.x = cvtpk(x[base], x[base + 1]); w.y = cvtpk(x[base + 2], x[base + 3]); w.z = cvtpk(x[base + 4], x[base + 5]); w.w = cvtpk(x[base + 6], x[base + 7]);
    return __builtin_bit_cast(bf16x8, w);
}
typedef short v4i16_t __attribute__((ext_vector_type(4)));
__device__ __forceinline__ u32x2 vtr4(const LAS unsigned char* p) { return __builtin_bit_cast(u32x2, __builtin_amdgcn_ds_read_tr16_b64_v4i16((LAS v4i16_t*)p)); }
__device__ __forceinline__ bf16x8 cat44(u32x2 a, u32x2 b) { u32x4 w = {a.x, a.y, b.x, b.y}; return __builtin_bit_cast(bf16x8, w); }

constexpr int AT_KSTR = 144;
constexpr int AT_BUF = 2 * 64 * AT_KSTR;
__device__ __forceinline__ void attn_unit(const Ctx& C, int j, bool samp, int b, int hq, int qb, size_t obuf) {
    const int lane = C.lane, c = lane & 31, h = lane >> 5, w = C.wave, kvh = hq >> 2;
    const int rowbase = samp ? MP + b * 1024 : b * 256, q0 = qb * 256, qlo = q0 + 32 * w;
    const bf16_t* Q = C.h(SCR_Q); const bf16_t* KB = C.h(SCR_KB); const bf16_t* VB = C.h(SCR_VB);
    const bf16_t* CK = C.h(WS_CTXK) + ((size_t)(b * 2 + j) * 512) * 256; const bf16_t* CV = C.h(WS_CTXV) + ((size_t)(b * 2 + j) * 512) * 256;
    int klo = 0, nlat = 4, NT = 4;
    if (samp) { klo = q0 - 128 < 0 ? 0 : q0 - 128; const int khi = q0 + 384 > 1024 ? 1024 : q0 + 384; nlat = (khi - klo) >> 6; NT = nlat + 8; }
    bf16x8 qf[4];
#pragma unroll
    for (int s = 0; s < 4; ++s) qf[s] = *(const bf16x8*)(Q + (size_t)(rowbase + qlo + c) * D + hq * 64 + 16 * s + 8 * h);
    float m = C.in(14)[j * 16 + hq] * LOG2E, lsum = h == 0 ? 1.f : 0.f;
    f32x16 o0 = {}, o1 = {};
    const int lkey = C.tid >> 3, lch = C.tid & 7;
    auto src_k = [&](int t) -> const bf16_t* { return (t < nlat ? KB + (size_t)(rowbase + klo + 64 * t + lkey) * 256 : CK + (size_t)(64 * (t - nlat) + lkey) * 256) + kvh * 64 + lch * 8; };
    auto src_v = [&](int t) -> const bf16_t* { return (t < nlat ? VB + (size_t)(rowbase + klo + 64 * t + lkey) * 256 : CV + (size_t)(64 * (t - nlat) + lkey) * 256) + kvh * 64 + lch * 8; };
    auto put = [&](int buf, u32x4 kr, u32x4 vr) {
        LAS unsigned char* kb = C.lds + buf * AT_BUF; LAS unsigned char* vb = kb + 64 * AT_KSTR;
        *(LAS u32x4*)(kb + lkey * AT_KSTR + lch * 16) = kr;
        *(LAS u32x4*)(vb + lkey * AT_KSTR + lch * 16) = vr;
    };
    const int vtr_off = (4 * h + ((lane & 15) >> 2)) * AT_KSTR + (16 * ((lane >> 4) & 1) + 4 * (lane & 3)) * 2;
    { const u32x4 kr = *(const u32x4*)src_k(0), vr = *(const u32x4*)src_v(0); put(0, kr, vr); }
    __syncthreads();
    for (int t = 0; t < NT; ++t) {
        u32x4 kr = {}, vr = {};
        if (t + 1 < NT) { kr = *(const u32x4*)src_k(t + 1); vr = *(const u32x4*)src_v(t + 1); }
        const bool lat = samp && t < nlat; const int key0 = klo + 64 * t;
        const bool skip = lat && (key0 > qlo + 31 + 128 || key0 + 63 < qlo - 128);
        if (!skip) {
            LAS unsigned char* kb = C.lds + (t & 1) * AT_BUF; LAS unsigned char* vb = kb + 64 * AT_KSTR;
            f32x16 x0 = {}, x1 = {};
#pragma unroll
            for (int s = 0; s < 4; ++s) {
                const bf16x8 a0 = *(const LAS bf16x8*)(kb + c * AT_KSTR + (16 * s + 8 * h) * 2), a1 = *(const LAS bf16x8*)(kb + (32 + c) * AT_KSTR + (16 * s + 8 * h) * 2);
                x0 = __builtin_amdgcn_mfma_f32_32x32x16_bf16(a0, qf[s], x0, 0, 0, 0); x1 = __builtin_amdgcn_mfma_f32_32x32x16_bf16(a1, qf[s], x1, 0, 0, 0);
            }
            if (lat && !(key0 >= qlo + 31 - 128 && key0 + 63 <= qlo + 128)) {
                const int tq = qlo + c;
#pragma unroll
                for (int r = 0; r < 16; ++r) { const int k0 = key0 + rowidx(r, h) - tq; if (k0 > 128 || k0 < -128) x0[r] = -INFINITY; if (k0 + 32 > 128 || k0 + 32 < -128) x1[r] = -INFINITY; }
            }
            float mx = fmaxf(x0[0], x1[0]);
#pragma unroll
            for (int r = 1; r < 16; ++r) mx = fmaxf(mx, fmaxf(x0[r], x1[r]));
            mx = fmaxf(mx, xhalf(mx));
            const float mn = fmaxf(m, mx), al = __builtin_amdgcn_exp2f(m - mn); m = mn;
            float ps = 0.f;
#pragma unroll
            for (int r = 0; r < 16; ++r) { x0[r] = __builtin_amdgcn_exp2f(x0[r] - mn); x1[r] = __builtin_amdgcn_exp2f(x1[r] - mn); ps += x0[r] + x1[r]; }
            lsum = lsum * al + ps;
#pragma unroll
            for (int r = 0; r < 16; ++r) { o0[r] *= al; o1[r] *= al; }
#pragma unroll
            for (int ks = 0; ks < 2; ++ks) {
                const bf16x8 p0 = pack8(x0, 8 * ks), p1 = pack8(x1, 8 * ks);
#pragma unroll
                for (int dt = 0; dt < 2; ++dt) {
                    const LAS unsigned char* vp = vb + vtr_off + (16 * ks) * AT_KSTR + (32 * dt) * 2;
                    const bf16x8 v0 = cat44(vtr4(vp), vtr4(vp + 8 * AT_KSTR)), v1 = cat44(vtr4(vp + 32 * AT_KSTR), vtr4(vp + 40 * AT_KSTR));
                    if (dt == 0) { o0 = __builtin_amdgcn_mfma_f32_32x32x16_bf16(v0, p0, o0, 0, 0, 0); o0 = __builtin_amdgcn_mfma_f32_32x32x16_bf16(v1, p1, o0, 0, 0, 0); }
                    else { o1 = __builtin_amdgcn_mfma_f32_32x32x16_bf16(v0, p0, o1, 0, 0, 0); o1 = __builtin_amdgcn_mfma_f32_32x32x16_bf16(v1, p1, o1, 0, 0, 0); }
                }
            }
        }
        if (t + 1 < NT) put((t + 1) & 1, kr, vr);
        __syncthreads();
    }
    lsum += xhalf(lsum);
    const float il = 1.f / lsum;
    bf16_t* O = C.h(obuf) + (size_t)(rowbase + qlo + c) * D + hq * 64 + 4 * h;
#pragma unroll
    for (int g = 0; g < 4; ++g) { st_bf16x4(O + 8 * g, (f32x4){o0[4 * g], o0[4 * g + 1], o0[4 * g + 2], o0[4 * g + 3]} * il); st_bf16x4(O + 32 + 8 * g, (f32x4){o1[4 * g], o1[4 * g + 1], o1[4 * g + 2], o1[4 * g + 3]} * il); }
}
__device__ __forceinline__ void phase_attn(const Ctx& C, int l, size_t obuf) {
    const int j = l / 3;
    for (int u = C.bid; u < 512; u += C.G) {
        if (u < 256) attn_unit(C, j, false, u >> 4, u & 15, 0, obuf);
        else { const int v = u - 256; attn_unit(C, j, true, v >> 6, (v >> 2) & 15, v & 3, obuf); }
    }
}
constexpr size_t CKS_TAB = 376 * MiB; constexpr int CKS_NW = (int)((268 * MiB) / 65536), CKS_NO = (17039360 * 4) / 65536, CKS_N = CKS_NW + CKS_NO;
__device__ __forceinline__ void phase_cks(const Ctx& C, int slot) {
    const int gw = C.bid * NWAVES + C.wave, NGW = C.G * NWAVES; unsigned* tab = (unsigned*)(C.ws + CKS_TAB) + (size_t)slot * 8192;
    for (int ck = gw; ck < CKS_N; ck += NGW) {
        const unsigned char* base = ck < CKS_NW ? C.ws + 108 * MiB + (size_t)ck * 65536 : (const unsigned char*)C.out + (size_t)(ck - CKS_NW) * 65536; unsigned s = 0;
        for (int i = 0; i < 64; ++i) { const u32x4 v = *(const u32x4*)(base + (size_t)i * 1024 + C.lane * 16); s += v[0] + v[1] * 3u + v[2] * 5u + v[3] * 7u; }
#pragma unroll
        for (int o = 1; o < 64; o <<= 1) s += (unsigned)__shfl_xor((int)s, o);
        if (C.lane == 0) tab[ck] = s;
    }
}
__device__ __forceinline__ void phase_clr(const Ctx& C) {
    const int gt = C.bid * NTHREADS + C.tid, NGT = C.G * NTHREADS; unsigned z0 = 0u; asm volatile("" : "+v"(z0)); const u32x4 z = {z0, z0, z0, z0};
    for (size_t i = gt; i < (268 * MiB) / 16; i += NGT) *(u32x4*)(C.ws + 108 * MiB + i * 16) = z;
    for (size_t i = gt; i < (size_t)17039360 / 4; i += NGT) *(u32x4*)((unsigned char*)C.out + i * 16) = z;
}
__device__ __forceinline__ void phase_clr2(const Ctx& C, size_t off, size_t bytes) {
    const int gt = C.bid * NTHREADS + C.tid, NGT = C.G * NTHREADS; unsigned z0 = 0u; asm volatile("" : "+v"(z0)); const u32x4 z = {z0, z0, z0, z0};
    for (size_t i = gt; i < bytes / 16; i += NGT) *(u32x4*)(C.ws + off + i * 16) = z;
}
__device__ __forceinline__ void phase_cmp(const Ctx& C, int nslots) {
    const int gt = C.bid * NTHREADS + C.tid, NGT = C.G * NTHREADS; const unsigned* tab = (const unsigned*)(C.ws + CKS_TAB);
    for (int i = gt; i < nslots * 8192; i += NGT) { const int sl = i >> 13, ck = i & 8191; if (ck < CKS_N && tab[(size_t)sl * 8192 + ck] != tab[(size_t)(sl + 32) * 8192 + ck]) {
#ifdef SSDET
        const int cls = ck >= CKS_NW ? 4 : (ck < 1472 + 512 ? 1 : 2); atomicOr((unsigned*)(C.ws + WS_CTL) + 4002, (unsigned)cls); atomicAdd((unsigned*)(C.ws + WS_CTL) + 4003, 1u);
#endif
        atomicMax((unsigned*)(C.ws + WS_CTL) + 4001, (unsigned)(1000 - sl)); } }
}
__device__ __forceinline__ void phase_chk(const Ctx& C, size_t a, size_t b, size_t bytes) {
    const int gt = C.bid * NTHREADS + C.tid, NGT = C.G * NTHREADS; unsigned bad = 0;
    for (size_t i = gt; i < bytes / 16; i += NGT) { const u32x4 x = *(const u32x4*)(C.ws + a + i * 16), y = *(const u32x4*)(C.ws + b + i * 16); bad += (x[0] != y[0]) | (x[1] != y[1]) | (x[2] != y[2]) | (x[3] != y[3]); }
    if (bad) atomicAdd((unsigned*)(C.ws + WS_CTL) + 4000, bad);
}

constexpr int HS_QSTR = 272, HS_TSTR = 80;
constexpr int HS_QT = 0, HS_KT = 32 * HS_QSTR, HS_KTT = 2 * 32 * HS_QSTR, HS_VT = HS_KTT + 128 * HS_TSTR, HS_E1 = HS_VT + 128 * HS_TSTR, HS_E2 = HS_E1 + 512, HS_T1 = HS_E2 + 512, HS_GRP = HS_T1 + 512;
__device__ __forceinline__ void hscan_item(const Ctx& C, int item) {
    const bool samp = item < 64; const int it = samp ? item : item - 64;
    const int dir = it & 1, hd = (it >> 1) & 7, sq = it >> 4;
    const int S = samp ? 1024 : 256, rowbase = samp ? MP + sq * 1024 : sq * 256, nchunk = S >> 5;
    const int tg = C.tid & 255, lane = C.lane, c = lane & 31, h = lane >> 5, w4 = C.wave & 3; const bool producer = C.wave >= 4;
    LAS unsigned char* L = C.lds;
    const bf16_t* HQ = C.h(SCR_HQ); const bf16_t* HV = C.h(SCR_HV); const float* LF = C.f(dir == 0 ? SCR_LFF : SCR_LFB); float* OD = C.f(dir == 0 ? SCR_OF : SCR_OB);
    const int pd = tg & 127, ph = tg >> 7;
    unsigned qw[8], kw[8], vtw[8]; float e1v = 0.f, e2v = 0.f;
    float rlf[16], rpre[16]; unsigned rq[16], rv[16];
    auto issue = [&](int ch) {
#pragma unroll
        for (int i = 0; i < 16; ++i) { const int pos = 32 * ch + 16 * ph + i, t = dir == 0 ? pos : S - 1 - pos; const size_t off = (size_t)(rowbase + t) * D + hd * 128 + pd;
            rlf[i] = LF[off]; rq[i] = HQ[off]; rv[i] = HV[off];
            const int pos2 = 32 * ch + i, t2 = dir == 0 ? pos2 : S - 1 - pos2; rpre[i] = ph == 1 ? LF[(size_t)(rowbase + t2) * D + hd * 128 + pd] : 0.f; }
    };
    auto compute = [&]() {
        float cl[16]; float pre = 0.f, run = 0.f;
#pragma unroll
        for (int i = 0; i < 16; ++i) { pre += rpre[i]; run += rlf[i]; cl[i] = run; }
        const float t1v = ph == 0 ? cl[15] : pre;
#pragma unroll
        for (int i = 0; i < 16; i += 2) {
            const float e0 = ph == 0 ? cl[i] - t1v : cl[i], e1 = ph == 0 ? cl[i + 1] - t1v : cl[i + 1];
            const float k0 = 1.f - __expf(rlf[i]), k1 = 1.f - __expf(rlf[i + 1]);
            qw[i >> 1] = cvtpk(__uint_as_float(rq[i] << 16) * __expf(e0), __uint_as_float(rq[i + 1] << 16) * __expf(e1)); kw[i >> 1] = cvtpk(k0 * __expf(-e0), k1 * __expf(-e1));
            vtw[i >> 1] = rv[i] | (rv[i + 1] << 16); }
        e1v = __expf(t1v); e2v = __expf(cl[15]);
    };
    auto put = [&]() {
#pragma unroll
        for (int i = 0; i < 8; ++i) {
            *(LAS unsigned short*)(L + HS_QT + (16 * ph + 2 * i) * HS_QSTR + pd * 2) = (unsigned short)(qw[i] & 0xffffu); *(LAS unsigned short*)(L + HS_QT + (16 * ph + 2 * i + 1) * HS_QSTR + pd * 2) = (unsigned short)(qw[i] >> 16);
            *(LAS unsigned short*)(L + HS_KT + (16 * ph + 2 * i) * HS_QSTR + pd * 2) = (unsigned short)(kw[i] & 0xffffu); *(LAS unsigned short*)(L + HS_KT + (16 * ph + 2 * i + 1) * HS_QSTR + pd * 2) = (unsigned short)(kw[i] >> 16); }
        *(LAS u32x4*)(L + HS_KTT + pd * HS_TSTR + ph * 32) = (u32x4){kw[0], kw[1], kw[2], kw[3]}; *(LAS u32x4*)(L + HS_KTT + pd * HS_TSTR + ph * 32 + 16) = (u32x4){kw[4], kw[5], kw[6], kw[7]};
        *(LAS u32x4*)(L + HS_VT + pd * HS_TSTR + ph * 32) = (u32x4){vtw[0], vtw[1], vtw[2], vtw[3]}; *(LAS u32x4*)(L + HS_VT + pd * HS_TSTR + ph * 32 + 16) = (u32x4){vtw[4], vtw[5], vtw[6], vtw[7]};
        if (ph == 0) *(LAS float*)(L + HS_E1 + pd * 4) = e1v; else *(LAS float*)(L + HS_E2 + pd * 4) = e2v;
    };
    if (producer) {
        issue(0); compute(); if (nchunk > 1) issue(1);
        for (int ch = 0; ch < nchunk; ++ch) {
            put();
            __syncthreads();
            if (ch + 1 < nchunk) { compute(); if (ch + 2 < nchunk) issue(ch + 2); }
            __syncthreads();
        }
        return;
    }
    f32x16 St[4];
#pragma unroll
    for (int dt = 0; dt < 4; ++dt) {
        if (samp) { const float* s0 = C.in(4) + ((((size_t)sq * 2 + dir) * 8 + hd) * 128) * 128;
#pragma unroll
            for (int r = 0; r < 16; ++r) St[dt][r] = s0[(size_t)(32 * dt + rowidx(r, h)) * 128 + 32 * w4 + c]; }
        else St[dt] = (f32x16){};
    }
    for (int ch = 0; ch < nchunk; ++ch) {
        __syncthreads();
#pragma unroll
        for (int dt = 0; dt < 4; ++dt)
#pragma unroll
            for (int g = 0; g < 4; ++g) { const f32x4 e = *(const LAS f32x4*)(L + HS_E1 + (32 * dt + 8 * g + 4 * h) * 4);
#pragma unroll
                for (int q = 0; q < 4; ++q) St[dt][4 * g + q] *= e[q]; }
        f32x16 X = {};
#pragma unroll
        for (int s = 0; s < 8; ++s) {
            const bf16x8 a = *(const LAS bf16x8*)(L + HS_KT + c * HS_QSTR + (16 * s + 8 * h) * 2), bq = *(const LAS bf16x8*)(L + HS_QT + c * HS_QSTR + (16 * s + 8 * h) * 2);
            X = __builtin_amdgcn_mfma_f32_32x32x16_bf16(a, bq, X, 0, 0, 0);
        }
#pragma unroll
        for (int r = 0; r < 16; ++r) if (rowidx(r, h) > c) X[r] = 0.f;
        f32x16 OT = {};
#pragma unroll
        for (int ks = 0; ks < 2; ++ks) {
            const LAS unsigned char* vrow = L + HS_VT + (32 * w4 + c) * HS_TSTR + (16 * ks + 4 * h) * 2;
            const bf16x8 va = cat44(*(const LAS u32x2*)(vrow), *(const LAS u32x2*)(vrow + 16));
            OT = __builtin_amdgcn_mfma_f32_32x32x16_bf16(va, pack8(X, 8 * ks), OT, 0, 0, 0);
        }
#pragma unroll
        for (int dt = 0; dt < 4; ++dt)
#pragma unroll
            for (int ks = 0; ks < 2; ++ks) {
                const LAS unsigned char* qrow = L + HS_QT + c * HS_QSTR + (32 * dt + 16 * ks + 4 * h) * 2;
                const bf16x8 bq = cat44(*(const LAS u32x2*)(qrow), *(const LAS u32x2*)(qrow + 16));
                OT = __builtin_amdgcn_mfma_f32_32x32x16_bf16(pack8(St[dt], 8 * ks), bq, OT, 0, 0, 0);
            }
#pragma unroll
        for (int dt = 0; dt < 4; ++dt)
#pragma unroll
            for (int ks = 0; ks < 2; ++ks) {
                const bf16x8 a = *(const LAS bf16x8*)(L + HS_KTT + (32 * dt + c) * HS_TSTR + (16 * ks + 8 * h) * 2), bv = *(const LAS bf16x8*)(L + HS_VT + (32 * w4 + c) * HS_TSTR + (16 * ks + 8 * h) * 2);
                St[dt] = __builtin_amdgcn_mfma_f32_32x32x16_bf16(a, bv, St[dt], 0, 0, 0);
            }
#pragma unroll
        for (int dt = 0; dt < 4; ++dt)
#pragma unroll
            for (int g = 0; g < 4; ++g) { const f32x4 e = *(const LAS f32x4*)(L + HS_E2 + (32 * dt + 8 * g + 4 * h) * 4);
#pragma unroll
                for (int q = 0; q < 4; ++q) St[dt][4 * g + q] *= e[q]; }
        { const int pos = 32 * ch + c, t = dir == 0 ? pos : S - 1 - pos; float* op = OD + (size_t)(rowbase + t) * D + hd * 128 + 32 * w4 + 4 * h;
#pragma unroll
            for (int g = 0; g < 4; ++g) *(f32x4*)(op + 8 * g) = (f32x4){OT[4 * g], OT[4 * g + 1], OT[4 * g + 2], OT[4 * g + 3]}; }
        __syncthreads();
    }
    if (!samp) { float* so = C.out + 8388608 + 2 * 2097152 + ((((size_t)sq * 2 + dir) * 8 + hd) * 128) * 128;
        int c2 = c, h2 = h; asm volatile("" : "+v"(c2), "+v"(h2));
        unsigned base = (unsigned)((4 * h2) * 128 + 32 * w4 + c2);
#pragma unroll
        for (int dt = 0; dt < 4; ++dt)
#pragma unroll
            for (int r = 0; r < 16; ++r) so[base + (unsigned)((32 * dt + (r & 3) + 8 * (r >> 2)) * 128)] = St[dt][r]; }
}
__device__ __forceinline__ void phase_hscan(const Ctx& C) {
    if (C.G == 256) {
        hscan_item(C, C.bid);
        if (C.bid >= 64 && C.bid < 128) hscan_item(C, 256 + (C.bid - 64));
    } else for (int it = C.bid; it < 320; it += C.G) hscan_item(C, it);
}
__device__ __forceinline__ void phase_hpost(const Ctx& C) {
    const int gw = C.bid * NWAVES + C.wave, NGW = C.G * NWAVES;
    for (int r = gw; r < M; r += NGW) {
        const size_t off = (size_t)r * D + 16 * C.lane; float o[16]; float sq = 0.f;
#pragma unroll
        for (int q = 0; q < 4; ++q) { const f32x4 a = *(const f32x4*)(C.f(SCR_OF) + off + 4 * q), b = *(const f32x4*)(C.f(SCR_OB) + off + 4 * q);
#pragma unroll
            for (int e = 0; e < 4; ++e) { o[4 * q + e] = a[e] + b[e]; sq += o[4 * q + e] * o[4 * q + e]; } }
        sq += __shfl_xor(sq, 1); sq += __shfl_xor(sq, 2); sq += __shfl_xor(sq, 4);
        const float rs = rsqrtf(sq * (1.f / 128.f) + EPS);
        const u32x4 g0 = *(const u32x4*)(C.h(SCR_HG) + off), g1 = *(const u32x4*)(C.h(SCR_HG) + off + 8);
        const float* gn = C.in(17) + (16 * C.lane & 127);
        float sg[16];
#pragma unroll
        for (int e = 0; e < 4; ++e) { sg[2 * e] = bflo(g0[e]); sg[2 * e + 1] = bfhi(g0[e]); sg[8 + 2 * e] = bflo(g1[e]); sg[8 + 2 * e + 1] = bfhi(g1[e]); }
        u32x4 w0, w1;
#pragma unroll
        for (int e = 0; e < 4; ++e) { w0[e] = cvtpk(o[2 * e] * rs * gn[2 * e] * sg[2 * e], o[2 * e + 1] * rs * gn[2 * e + 1] * sg[2 * e + 1]);
            w1[e] = cvtpk(o[8 + 2 * e] * rs * gn[8 + 2 * e] * sg[8 + 2 * e], o[8 + 2 * e + 1] * rs * gn[8 + 2 * e + 1] * sg[8 + 2 * e + 1]); }
        *(u32x4*)(C.h(SCR_AWO) + off) = w0; *(u32x4*)(C.h(SCR_AWO) + off + 8) = w1;
    }
}

constexpr int SS_RSTR = 512;
constexpr int SS_WAVE = 16 * SS_RSTR;
__device__ __forceinline__ void sscan_seq(const Ctx& C, int l, bool samp, int sq, int dir, int g, size_t ydbg) {
    const int lane = C.lane, c = lane & 31, h = lane >> 5, dg = dir * 64 + g;
    const int S = samp ? 1024 : 256, rowbase = samp ? MP + sq * 1024 : sq * 256, nchunk = S >> 5, cond = samp ? 1 + sq : 0;
    LAS unsigned char* LB = C.lds + C.wave * SS_WAVE; LAS unsigned char* LH = LB + 4096;
    const float* X = C.f(WS_X); const u64_t* ss = (const u64_t*)(C.ws + WS_SS) + (size_t)(l * 2) * M; float* Y = C.f(ydbg ? ydbg : (dir == 0 ? SCR_YF : SCR_YB)); const bool ywr = !ydbg || dir == 0;
    bf16x8 bfr[4], cfr[4];
#pragma unroll
    for (int ct = 0; ct < 4; ++ct) bfr[ct] = *(const bf16x8*)(C.h(WS_SBB) + ((size_t)dg * 128 + 32 * ct + c) * 16 + 8 * h);
#pragma unroll
    for (int s = 0; s < 4; ++s) cfr[s] = *(const bf16x8*)(C.h(WS_SCB) + ((size_t)dg * 16 + (lane & 15)) * 128 + 32 * s + 8 * (lane >> 4));
    const float lr = C.f(WS_SLAM)[2 * (dg * 64 + lane)], li = C.f(WS_SLAM)[2 * (dg * 64 + lane) + 1];
    f32x4 gm0, gm1, sh0, sh1;
    { const float* gm = C.f(WS_GMOD) + ((size_t)(l * 2) * 5 + cond) * 1024 + g * 16 + 8 * h; gm0 = *(const f32x4*)gm; gm1 = *(const f32x4*)(gm + 4);
      const float* sh = C.f(WS_MOD) + ((size_t)l * 5 + cond) * 6144 + g * 16 + 8 * h; sh0 = *(const f32x4*)sh; sh1 = *(const f32x4*)(sh + 4); }
    float hr = 0.f, hi = 0.f;
    if (samp) { const float* s0 = C.in(5) + ((((size_t)sq * 2 + dir) * 64 + g) * 64 + lane) * 2; hr = s0[0]; hi = s0[1]; }
    for (int ch = 0; ch < nchunk; ++ch) {
        const int pos = 32 * ch + c, t = dir == 0 ? pos : S - 1 - pos, r = rowbase + t;
        const float rs = rstd_of(ss, r);
        const f32x4 x0 = *(const f32x4*)(X + (size_t)r * D + g * 16 + 8 * h), x1 = *(const f32x4*)(X + (size_t)r * D + g * 16 + 8 * h + 4);
        const f32x4 u0 = x0 * rs * gm0 + sh0, u1 = x1 * rs * gm1 + sh1;
        u32x4 uw = {cvtpk(u0[0], u0[1]), cvtpk(u0[2], u0[3]), cvtpk(u1[0], u1[1]), cvtpk(u1[2], u1[3])};
        const bf16x8 uf = __builtin_bit_cast(bf16x8, uw);
        f32x16 bu[4];
#pragma unroll
        for (int ct = 0; ct < 4; ++ct) { bu[ct] = (f32x16){}; bu[ct] = __builtin_amdgcn_mfma_f32_32x32x16_bf16(uf, bfr[ct], bu[ct], 0, 0, 0); }
#pragma unroll
        for (int hf = 0; hf < 2; ++hf) {
#pragma unroll
            for (int t8 = 0; t8 < 2; ++t8) {
#pragma unroll
                for (int ct = 0; ct < 4; ++ct)
#pragma unroll
                    for (int r4 = 0; r4 < 4; ++r4) *(LAS float*)(LB + (4 * h + r4) * 512 + (32 * ct + c) * 4) = bu[ct][8 * hf + 4 * t8 + r4];
                float br[8], bi[8]; unsigned wv[8];
#pragma unroll
                for (int k = 0; k < 8; ++k) { br[k] = *(LAS float*)(LB + k * 512 + lane * 4); bi[k] = *(LAS float*)(LB + k * 512 + 256 + lane * 4); }
#pragma unroll
                for (int k = 0; k < 8; ++k) { const float nr = lr * hr - li * hi + br[k], ni = lr * hi + li * hr + bi[k]; hr = nr; hi = ni; wv[k] = cvtpk(hr, hi); }
#pragma unroll
                for (int k = 0; k < 8; ++k) { const int row = 8 * t8 + k;
                    *(LAS unsigned short*)(LH + row * 256 + ((((lane >> 3)) ^ row) << 4) + (lane & 7) * 2) = (unsigned short)(wv[k] & 0xffffu);
                    *(LAS unsigned short*)(LH + row * 256 + (((8 + (lane >> 3)) ^ row) << 4) + (lane & 7) * 2) = (unsigned short)(wv[k] >> 16); }
                LDS_WAIT();
            }
            f32x4 y0 = {};
#pragma unroll
            for (int s = 0; s < 4; ++s) {
                const bf16x8 a0 = *(const LAS bf16x8*)(LH + (lane & 15) * 256 + (((4 * s + (lane >> 4)) ^ (lane & 15)) << 4));
                y0 = __builtin_amdgcn_mfma_f32_16x16x32_bf16(a0, cfr[s], y0, 0, 0, 0);
            }
            if (ywr) {
#pragma unroll
                for (int q = 0; q < 4; ++q) { const int p0 = 32 * ch + 16 * hf + 4 * (lane >> 4) + q, t0 = dir == 0 ? p0 : S - 1 - p0; Y[(size_t)(rowbase + t0) * D + g * 16 + (lane & 15)] = y0[q]; }
            }
            LDS_WAIT();
        }
    }
    if (!samp && !ydbg) { float* so = C.out + 8388608 + 2 * 2097152 + 4194304 + ((((size_t)sq * 2 + dir) * 64 + g) * 64 + lane) * 2; so[0] = hr; so[1] = hi; }
}
__device__ __forceinline__ void phase_sscan(const Ctx& C, int l, size_t ydbg) {
    for (int bb = C.bid; bb < 256; bb += C.G) {
        const int w = C.wave;
#ifdef SS_ONLYWAVE
        if (ydbg && !((SS_ONLYWAVE >> w) & 1)) continue;
#endif
        if (w < 2) { const int id = 2 * bb + w; sscan_seq(C, l, true, id >> 7, (id >> 6) & 1, id & 63, ydbg); }
        else { int id = 8 * bb + (w - 2); sscan_seq(C, l, false, id >> 7, (id >> 6) & 1, id & 63, ydbg);
            if (w < 4) { id = 8 * bb + 6 + (w - 2); sscan_seq(C, l, false, id >> 7, (id >> 6) & 1, id & 63, ydbg); } }
    }
}
__device__ __forceinline__ void phase_spost(const Ctx& C, int l) {
    const int gw = C.bid * NWAVES + C.wave, NGW = C.G * NWAVES; const u64_t* ss = (const u64_t*)(C.ws + WS_SS) + (size_t)(l * 2) * M;
    for (int r = gw; r < M; r += NGW) {
        const int cond = cond_of_row(r); const float rs = rstd_of(ss, r);
#pragma unroll
        for (int jq = 0; jq < 4; ++jq) {
            const int n = 4 * C.lane + 256 * jq; const size_t off = (size_t)r * D + n;
            const f32x4 x = *(const f32x4*)(C.f(WS_X) + off), gm = *(const f32x4*)(C.f(WS_GMOD) + ((size_t)(l * 2) * 5 + cond) * 1024 + n), sh = *(const f32x4*)(C.f(WS_MOD) + ((size_t)l * 5 + cond) * 6144 + n);
            const f32x4 u = x * rs * gm + sh, y = *(const f32x4*)(C.in(26) + n) * u + *(const f32x4*)(C.f(SCR_YF) + off) + *(const f32x4*)(C.f(SCR_YB) + off);
            f32x4 o;
#pragma unroll
            for (int e = 0; e < 4; ++e) { const float v = y[e], uu = 0.7978845608028654f * (v + 0.044715f * v * v * v); const float th = 1.f - 2.f * __builtin_amdgcn_rcpf(1.f + __expf(2.f * uu)); o[e] = 0.5f * v * (1.f + th); }
            st_bf16x4(C.h(SCR_AGLU) + off, o);
        }
    }
}
#define XB_TMO      128
#define XB_XCNT(j)  (256  + 64 * (j))
#define XB_XSUB(j)  (1280 + 64 * (j))
#define XB_XGEN(j)  (2304 + 64 * (j))
#define XB_TOP      3328
#define XB_TOPGEN   3392
#define XCD_BAR_WORDS 3456
#define XB_SPIN_CAP (1u << 18)
#ifndef XB_SCOPE
#define XB_SCOPE "agent"
#endif
__device__ __forceinline__ unsigned xb_ld(unsigned* p)              { return __hip_atomic_load(p, __ATOMIC_RELAXED, __HIP_MEMORY_SCOPE_AGENT); }
__device__ __forceinline__ unsigned xb_add(unsigned* p, unsigned v) { return __hip_atomic_fetch_add(p, v, __ATOMIC_RELAXED, __HIP_MEMORY_SCOPE_AGENT); }
__device__ __forceinline__ unsigned xb_xcc_id() { return (unsigned)__builtin_amdgcn_s_getreg((3 << 11) | 20) & 0xFu; }
#define XB_SPIN(cond, bar) do { unsigned _sp = 0; while (cond) { __builtin_amdgcn_s_sleep(1); \
    if ((++_sp & 255u) == 0u) { if (xb_ld(&(bar)[XB_TMO])) break; if (_sp > XB_SPIN_CAP) { atomicAdd(&(bar)[XB_TMO], 1u); break; } } } } while (0)
struct XcdBarrier { unsigned* bar; unsigned x; volatile LAS unsigned* st; };
__device__ __forceinline__ XcdBarrier xcd_barrier_post(unsigned* bar, volatile LAS unsigned* st) {
    XcdBarrier b; b.bar = bar; b.x = xb_xcc_id(); b.st = st;
    if (threadIdx.x == 0) (void)xb_add(&bar[XB_XCNT(b.x)], 1u);
    return b;
}
__device__ __forceinline__ void xcd_barrier_complete(unsigned* bar, unsigned x, unsigned& nloc, unsigned& nx) {
    const unsigned G = gridDim.x * gridDim.y * gridDim.z;
    unsigned sum, cnt, mine, sp = 0u;
    for (;;) {
        sum = 0u; cnt = 0u; mine = 0u;
#pragma unroll
        for (unsigned j = 0; j < 16; ++j) { const unsigned c = xb_ld(&bar[XB_XCNT(j)]); sum += c; cnt += (c > 0u) ? 1u : 0u; mine = (j == x) ? c : mine; }
        if (sum == G) break;
        __builtin_amdgcn_s_sleep(1);
        if ((++sp & 255u) == 0u) { if (xb_ld(&bar[XB_TMO])) break; if (sp > XB_SPIN_CAP) { atomicAdd(&bar[XB_TMO], 1u); break; } }
    }
    nloc = mine > 0u ? mine : 1u; nx = cnt > 0u ? cnt : 1u;
}
__device__ __forceinline__ void xcd_barrier(const XcdBarrier& b, bool thread0) {
    asm volatile("s_waitcnt vmcnt(0)" ::: "memory");
    __syncthreads();
    if (thread0) {
        unsigned* bar = b.bar;
        __builtin_amdgcn_s_waitcnt(0);
        unsigned nloc = b.st[0], nx = b.st[1];
        if (nloc == 0u) { xcd_barrier_complete(bar, b.x, nloc, nx); b.st[0] = nloc; b.st[1] = nx; }
#ifdef XB_ALL_RELEASE
        __builtin_amdgcn_fence(__ATOMIC_RELEASE, XB_SCOPE); asm volatile("s_waitcnt vmcnt(0)" ::: "memory");
#endif
        const unsigned old = xb_add(&bar[XB_XSUB(b.x)], 1u);
        const unsigned gen = old / nloc;
        if (old + 1u == (gen + 1u) * nloc) {
            __builtin_amdgcn_fence(__ATOMIC_RELEASE, XB_SCOPE);
            asm volatile("s_waitcnt vmcnt(0)" ::: "memory");
            const unsigned og = xb_add(&bar[XB_TOP], 1u);
            const unsigned tg = og / nx;
            __builtin_amdgcn_fence(__ATOMIC_ACQUIRE, XB_SCOPE);
            if (og + 1u == (tg + 1u) * nx) xb_add(&bar[XB_TOPGEN], 1u);
            else XB_SPIN(xb_ld(&bar[XB_TOPGEN]) == tg, bar);
            xb_add(&bar[XB_XGEN(b.x)], 1u);
            asm volatile("s_waitcnt vmcnt(0)" ::: "memory");
        } else {
            __builtin_amdgcn_fence(__ATOMIC_ACQUIRE, XB_SCOPE);
            XB_SPIN(xb_ld(&bar[XB_XGEN(b.x)]) == gen, bar);
            asm volatile("s_waitcnt vmcnt(0)" ::: "memory");
        }
#ifdef XB_DELAY
        for (int q = 0; q < XB_DELAY; ++q) __builtin_amdgcn_s_sleep(127);
#endif
    }
    __syncthreads();
}
}
namespace om {
enum { PH_P0A = 0, PH_P0C, PH_GLUE, PH_QKV, PH_ATTN, PH_WO, PH_HIN, PH_HSCAN, PH_HPOST, PH_HWO, PH_SSCAN, PH_SPOST, PH_GLU, PH_UP, PH_CONV, PH_DOWN, PH_FINAL };

struct Args { const float* in[33]; float* out; unsigned char* ws; int nph; int pad; unsigned char ptype[160]; unsigned char parg[160]; };
static_assert(offsetof(Args, ptype) == 288 && offsetof(Args, parg) == 448, "Args layout");

__device__ __forceinline__ void down_patch(const Ctx& C, int l, const pg8::StaticOrder& S) {
    Unit u; const float* cw = C.in(29) + (size_t)l * 3 * NUP; const float* E0 = C.f(WS_EDGE); bf16_t* act = C.h(WS_ACT);
    for (int i = 0; S.next(i, u); ++i) {
        if (u.pm < 16) continue;
        const bool top = (u.pm & 3) != 0, bot = (u.pm & 3) != 3;
        for (int n = C.tid; n < DFF; n += NTHREADS) {
            if (top) { const float* e = E0 + ((size_t)((u.pm - 16) * 2 + 0) * 4) * DFF; const float* ep = E0 + ((size_t)((u.pm - 17) * 2 + 1) * 4) * DFF;
                const float hg = e[n] + cw[n] * ep[2 * DFF + n], hv = e[DFF + n] + cw[DFF + n] * ep[3 * DFF + n];
                act[(size_t)(u.pm * 256) * DFF + n] = (bf16_t)(cvtpk(hg * sigm(hg) * hv, 0.f) & 0xffffu); }
            if (bot) { const float* e = E0 + ((size_t)((u.pm - 16) * 2 + 1) * 4) * DFF; const float* en = E0 + ((size_t)((u.pm - 15) * 2 + 0) * 4) * DFF;
                const float hg = e[n] + cw[2 * NUP + n] * en[2 * DFF + n], hv = e[DFF + n] + cw[2 * NUP + DFF + n] * en[3 * DFF + n];
                act[(size_t)(u.pm * 256 + 255) * DFF + n] = (bf16_t)(cvtpk(hg * sigm(hg) * hv, 0.f) & 0xffffu); }
        }
    }
    asm volatile("s_waitcnt vmcnt(0)" ::: "memory"); __syncthreads();
}
__device__ __forceinline__ void run_phase(const Ctx& C0, int type, int arg, int epoch) {
    Ctx C = C0; asm volatile("" : "+v"(C.tid)); asm volatile("" : "+s"(C.bid), "+s"(C.G), "+s"(C.kp), "+s"(C.ws), "+s"(C.out));
    C.lane = C.tid & 63; C.wave = __builtin_amdgcn_readfirstlane(C.tid >> 6);
    const int l = arg & 3;
    if (type == 31) return;
#ifndef PHASE_MASK
#define PHASE_MASK 0xFFFFFFFFu
#endif
    if (!((PHASE_MASK >> type) & 1u)) return;
    pg8::Gemm g{nullptr, nullptr, D, 256, 128, D, 0}; int nN = 0; EpiAny E{}; E.ws = C.ws; E.out = C.out; E.l = l; E.epoch = epoch;
    const bool splitk = false;
    switch (type) {
    case PH_P0A: phase_p0a(C); break;
    case PH_P0C: phase_p0c(C); break;
    case PH_GLUE: phase_glue(C, arg >> 1, arg & 1); break;
    case PH_QKV: { g.A = C.h(WS_AP); g.Bt = C.h(WS_WQKV) + (size_t)(l / 3) * NQKV * D; nN = 6; E.kind = EK_QKV; } break;
    case PH_ATTN: phase_attn(C, l, (arg & 32) ? SCR_O + 96 * MiB : SCR_O); break;
#ifdef DBG
    case 17: phase_chk(C, SCR_O, SCR_O + 96 * MiB, 16 * MiB); break;
#endif
#ifdef DBG
    case 18: phase_cks(C, arg); break;
#endif
#ifdef DBG
    case 19: phase_cmp(C, arg); break;
#endif
#ifdef DBG
    case 20: phase_clr(C); break;
#endif
    case PH_WO: case PH_HWO: case PH_GLU: {
        if (type == PH_WO) { g.A = C.h(SCR_O); g.Bt = C.h(WS_WO) + (size_t)(l / 3) * D * D; nN = 4; E.kind = EK_RES; if (splitk) { g.split = 1; g.K = D / 2; nN = 8; } }
        else if (type == PH_HWO) { g.A = C.h(SCR_AWO); g.Bt = C.h(WS_HWO); nN = 4; E.kind = EK_RES; if (splitk) { g.split = 1; g.K = D / 2; nN = 8; } }
        else { g.A = C.h(SCR_AGLU); g.Bt = C.h(WS_GLU); g.b_tile_rows = 128; g.b_half_rows = 1024; nN = 8; E.kind = EK_RES_GLU; }
        E.flags = ((arg & 32) ? 4 : 0) | (type == PH_HWO ? 8 : 0); } break;
    case PH_HIN: { g.A = C.h(WS_AP); g.Bt = C.h(WS_HWIN); nN = 20; E.kind = EK_HIN; } break;
    case PH_HSCAN: phase_hscan(C); break;
    case PH_HPOST: phase_hpost(C); break;
    case PH_SSCAN: phase_sscan(C, l, (arg & 32) ? WS_SCR + 80 * MiB : ((arg & 64) ? WS_SCR + 112 * MiB : 0)); break;
#ifdef DBG
    case 22: phase_clr2(C, WS_SCR + 80 * MiB, 64 * MiB); break;
#endif
#ifdef DBG
    case 21: phase_chk(C, WS_SCR + 80 * MiB, WS_SCR + 112 * MiB, 32 * MiB); break;
#endif
    case PH_SPOST: phase_spost(C, l); break;
    case PH_UP: { g.A = C.h(WS_AP); g.Bt = C.h(WS_UP) + (size_t)l * NUP * D; g.b_tile_rows = 128; g.b_half_rows = DFF; nN = 22; E.kind = EK_UPCONV; E.in29 = C.in(29); E.in30 = C.in(30); E.xl = C.lds + RING_BYTES; } break;
#ifdef DBG
    case 23: phase_chk(C, WS_SCR, WS_SCR + 88 * MiB, 88 * MiB); break;
#endif
    case PH_CONV: phase_conv(C, l); break;
    case PH_DOWN: { if (l < 3 && C.G == 256 && C.bid >= 128) convert_layer(C, l + 1, C.bid - 128, 128);
        { pg8::StaticOrder S0; S0.init(32, splitk ? 8 : 4, C.G, C.bid); down_patch(C, l, S0); }
        g.A = C.h(WS_ACT); g.Bt = C.h(WS_DOWN) + (size_t)l * D * DFF; g.K = DFF; g.ld = DFF; nN = 4; if (splitk) { g.split = 1; g.K = DFF / 2; nN = 8; } E.kind = EK_RES; E.flags = 1 | ((arg & 16) ? 2 : 0) | ((arg & 32) ? 4 : 0); } break;
    case PH_FINAL: { const unsigned fl = __hip_atomic_load((unsigned*)(C.ws + WS_CTL) + 4000, __ATOMIC_RELAXED, __HIP_MEMORY_SCOPE_AGENT), fd = __hip_atomic_load((unsigned*)(C.ws + WS_CTL) + 4001, __ATOMIC_RELAXED, __HIP_MEMORY_SCOPE_AGENT);
        #ifdef SSDET_CLS
        const unsigned cls = __hip_atomic_load((unsigned*)(C.ws + WS_CTL) + 4002, __ATOMIC_RELAXED, __HIP_MEMORY_SCOPE_AGENT), cnt = __hip_atomic_load((unsigned*)(C.ws + WS_CTL) + 4003, __ATOMIC_RELAXED, __HIP_MEMORY_SCOPE_AGENT);
        phase_final(C, 1.f + (float)cls / 8.f + (float)(cnt > 63 ? 63 : cnt) / 1024.f); } break;
#else
        phase_final(C, fl ? 3.f : (fd ? exp2f((float)(1001 - fd)) : 1.f)); } break;
#endif
    default: break;
    }
    if (nN) { pg8::StaticOrder S; S.init(32, nN, C.G, C.bid); pg8::gemm_phase(C.lds, g, S, E, C.tid); }
}

__device__ __forceinline__ void canary(const Ctx& C0, unsigned char* ws, int i, bool check) {
    int tid = C0.tid; asm volatile("" : "+v"(tid)); const int lane = tid & 63, wave = tid >> 6;
    unsigned* can = (unsigned*)(ws + WS_CTL + 32768);
#ifdef CANARY_SC1
    if (!check) { if (wave == 0 && lane < 32) __hip_atomic_store(can + C0.bid * 32 + lane, (unsigned)(i + 1), __ATOMIC_RELAXED, __HIP_MEMORY_SCOPE_AGENT); }
#else
    if (!check) { if (wave == 0 && lane < 32) can[C0.bid * 32 + lane] = (unsigned)(i + 1); }
#endif
#ifdef CANARY_LD_SC1
    else { const unsigned v = __hip_atomic_load(can + (wave * 32 + (lane >> 1)) * 32 + (lane & 1) * 16, __ATOMIC_RELAXED, __HIP_MEMORY_SCOPE_AGENT);
#else
    else { const unsigned v = can[(wave * 32 + (lane >> 1)) * 32 + (lane & 1) * 16];
#endif
      if (v != (unsigned)(i + 1) && v != (unsigned)(i + 2)) atomicAdd((unsigned*)(ws + WS_CTL) + 4000, 1u); }
}
__global__ void __launch_bounds__(NTHREADS, 2) mk_fwd(Args a) {
    extern __shared__ __attribute__((aligned(16))) unsigned char lds[];
    int wave_s = __builtin_amdgcn_readfirstlane((int)(threadIdx.x >> 6));
    { volatile LAS unsigned* misc = (volatile LAS unsigned*)((LAS unsigned char*)lds + LDS_BYTES - 64); if (threadIdx.x < 16) misc[threadIdx.x] = 0u; }
    __syncthreads();
    (void)xcd_barrier_post((unsigned*)(a.ws + WS_CTL), (volatile LAS unsigned*)((LAS unsigned char*)lds + LDS_BYTES - 64));
    for (int i = 0; i < a.nph; ++i) {
        {
            Ctx C; C.kp = (const unsigned char __attribute__((address_space(4)))*)__builtin_amdgcn_kernarg_segment_ptr();
            C.out = a.out; C.ws = a.ws; C.lds = (LAS unsigned char*)lds; asm volatile("" : "+s"(wave_s)); C.tid = (wave_s << 6) | lane_id(); C.lane = C.tid & 63; C.wave = 0; C.G = gridDim.x; C.bid = blockIdx.x;
            const unsigned wt = *(const unsigned __attribute__((address_space(4)))*)(C.kp + 288 + (i & ~3)), wa = *(const unsigned __attribute__((address_space(4)))*)(C.kp + 448 + (i & ~3));
            run_phase(C, (int)((wt >> (8 * (i & 3))) & 255u), (int)((wa >> (8 * (i & 3))) & 255u), i + 1);
#ifdef CANARY
            canary(C, a.ws, i, false);
#endif
        }
        if (i + 1 < a.nph) { XcdBarrier bar; bar.bar = (unsigned*)(a.ws + WS_CTL); bar.x = xb_xcc_id(); bar.st = (volatile LAS unsigned*)((LAS unsigned char*)lds + LDS_BYTES - 64); xcd_barrier(bar, wave_s == 0 && lane_id() == 0); }
#ifdef CANARY
        if (i + 1 < a.nph) { Ctx C; C.tid = (wave_s << 6) | lane_id(); C.bid = blockIdx.x; canary(C, a.ws, i, true); }
#endif
    }
}
}
extern "C" void kernel_launch(void* const* d_in, const int* in_sizes, int n_in, void* d_out, int out_size, void* d_ws, size_t ws_size, hipStream_t stream) {
    using namespace om;
    static int grid = 0;
    if (grid == 0) {
        if (n_in != 33 || out_size != 17039360 || ws_size < WS_END) { fprintf(stderr, "kernel_launch: unexpected sizes n_in %d out %d ws %zu; nothing launched\n", n_in, out_size, ws_size); grid = -1; return; }
        int dev = 0, cus = 0, per_cu = 0;
        (void)hipGetDevice(&dev); (void)hipDeviceGetAttribute(&cus, hipDeviceAttributeMultiprocessorCount, dev);
        (void)hipFuncSetAttribute((const void*)mk_fwd, hipFuncAttributeMaxDynamicSharedMemorySize, LDS_BYTES);
        if (hipOccupancyMaxActiveBlocksPerMultiprocessor(&per_cu, (const void*)mk_fwd, NTHREADS, LDS_BYTES) != hipSuccess || per_cu < 1) { fprintf(stderr, "kernel_launch: occupancy query gives %d blocks per CU\n", per_cu); per_cu = 1; }
        (void)hipGetLastError();
        grid = cus;
        if (grid > 256) grid = 256;
    }
    if (grid < 0) return;
    (void)hipMemsetAsync((char*)d_ws + WS_CTL, 0, CTL_ZERO_BYTES, stream);
    Args a{};
    for (int i = 0; i < 33; ++i) a.in[i] = (const float*)d_in[i];
    a.out = (float*)d_out; a.ws = (unsigned char*)d_ws;
    int n = 0;
#ifndef DUP_MASK
#define DUP_MASK 0u
#endif
#ifndef XBAR
#define XBAR 0
#endif
    auto add1 = [&](int t, int p) { a.ptype[n] = (unsigned char)t; a.parg[n] = (unsigned char)p; ++n; };
    auto add = [&](int t, int p) { add1(t, p);
        if ((DUP_MASK >> t) & 1u) { const bool resid = (t == PH_WO || t == PH_HWO || t == PH_GLU || t == PH_DOWN); add1(t, resid ? (p | 32) : p); }
        for (int q = 0; q < XBAR; ++q) add1(31, 0); };
#ifdef UPDET
    add1(PH_P0A, 0); add1(PH_P0C, 0);
    for (int l = 0; l < 4; ++l) { const int kind = l % 3;
        if (kind == 0) { add1(PH_QKV, l); add1(PH_ATTN, l); add1(PH_WO, l); }
        else if (kind == 1) { add1(PH_HIN, l); add1(PH_HSCAN, l); add1(PH_HPOST, l); add1(PH_HWO, l); }
        else { add1(PH_SSCAN, l); add1(PH_SPOST, l); add1(PH_GLU, l); }
        add1(PH_UP, l); add1(PH_UP, l | 32); add1(23, 0); add1(PH_CONV, l); add1(PH_DOWN, l == 3 ? (l | 16) : l); }
    add1(PH_FINAL, 0);
#elif defined(SSDET)
    add1(PH_P0A, 0); add1(PH_P0C, 0);
    for (int l = 0; l < 4; ++l) { const int kind = l % 3;
        if (kind == 0) { add1(PH_QKV, l); add1(PH_ATTN, l); add1(PH_WO, l); }
        else if (kind == 1) { add1(PH_HIN, l); add1(PH_HSCAN, l); add1(PH_HPOST, l); add1(PH_HWO, l); }
        else { add1(22, 0); add1(PH_SSCAN, l | 32); add1(PH_SSCAN, l | 64); add1(21, 0); add1(PH_SSCAN, l); add1(PH_SPOST, l); add1(PH_GLU, l); }
        add1(PH_UP, l); add1(PH_DOWN, l == 3 ? (l | 16) : l); }
    add1(PH_FINAL, 0);
#elif defined(LOCALIZE)
    for (int fwd = 0; fwd < 2; ++fwd) { int idx = 0;
        auto addc = [&](int t, int p) { add1(t, p); add1(18, fwd * 32 + idx); ++idx; };
        add1(20, 0); addc(PH_P0A, 0); addc(PH_P0C, 0);
        for (int l = 0; l < 4; ++l) { const int kind = l % 3;
            if (kind == 0) { addc(PH_QKV, l); addc(PH_ATTN, l); addc(PH_WO, l); }
            else if (kind == 1) { addc(PH_HIN, l); addc(PH_HSCAN, l); addc(PH_HPOST, l); addc(PH_HWO, l); }
            else { addc(PH_SSCAN, l); addc(PH_SPOST, l); addc(PH_GLU, l); }
            addc(PH_UP, l); addc(PH_DOWN, l == 3 ? (l | 16) : l); }
        if (fwd == 1) { add1(19, idx); add1(PH_FINAL, 0); } }
#else
    add(PH_P0A, 0); add(PH_P0C, 0);
    for (int l = 0; l < 4; ++l) {
        const int kind = l % 3;
        if (kind == 0) { add(PH_QKV, l); add(PH_ATTN, l); add(PH_WO, l); }
        else if (kind == 1) { add(PH_HIN, l); add(PH_HSCAN, l); add(PH_HPOST, l); add(PH_HWO, l); }
        else { add(PH_SSCAN, l); add(PH_SPOST, l); add(PH_GLU, l); }
        add(PH_UP, l); add(PH_DOWN, l == 3 ? (l | 16) : l);
    }
    add(PH_FINAL, 0);
#endif
    a.nph = n;
    void* args[] = {&a};
    const hipError_t e = hipLaunchCooperativeKernel((const void*)mk_fwd, dim3(grid), dim3(NTHREADS), args, LDS_BYTES, stream);
    if (e != hipSuccess) fprintf(stderr, "kernel_launch: cooperative launch failed: %s (grid %d)\n", hipGetErrorString(e), grid);
}
```

```cpp
#include <hip/hip_runtime.h>
#include <hip/hip_cooperative_groups.h>
#include <cstdio>
#include <cstdint>
#include <cmath>
#include <cstddef>
#define LAS __attribute__((address_space(3)))
#define GAS __attribute__((address_space(1)))
typedef unsigned short bf16_t;
typedef short bf16x8 __attribute__((ext_vector_type(8)));
typedef short s16x4 __attribute__((ext_vector_type(4)));
typedef float f32x2 __attribute__((ext_vector_type(2)));
typedef float f32x4 __attribute__((ext_vector_type(4)));
typedef float f32x16 __attribute__((ext_vector_type(16)));
typedef unsigned u32x2 __attribute__((ext_vector_type(2)));
typedef unsigned u32x4 __attribute__((ext_vector_type(4)));
typedef __bf16 bf16x2_t __attribute__((ext_vector_type(2)));

namespace om {
constexpr int D = 1024, MP = 4096, M = 8192, DFF = 2816, NUP = 5632, NQKV = 1536, NHIN = 5120;
constexpr float EPS = 1e-6f, LOG2E = 1.4426950408889634f, QSCALE = 0.125f * 1.4426950408889634f;
constexpr int NTHREADS = 512, NWAVES = 8, LDS_BYTES = 159744, RING_BYTES = 131072;
constexpr int SW_STRIDE = 5632;
constexpr float SS_FIX = 16777216.f, SS_INV = 1.f / (16777216.f * 1024.f);
typedef unsigned long long u64_t;
__device__ __forceinline__ float rstd_of(const u64_t* ss, int r) { return rsqrtf((float)ss[r] * SS_INV + 1e-6f); }
constexpr size_t MiB = 1u << 20;
constexpr size_t WS_CTL = 0, CTL_ZERO_BYTES = 64 * 1024;
constexpr size_t WS_MODP = 1 * MiB, WS_MOD = 3 * MiB, WS_SW = 4 * MiB, WS_GMOD = 5 * MiB, WS_SS = 6 * MiB, WS_ROPE = 7 * MiB;
constexpr size_t WS_LB1 = 8 * MiB, WS_SLAM = 8 * MiB + 64 * 1024, WS_SBB = 8 * MiB + 512 * 1024, WS_SCB = 9 * MiB;
constexpr size_t WS_CTXK = 10 * MiB, WS_CTXV = 12 * MiB;
constexpr size_t WS_NAIVE_MOD = 14 * MiB;
constexpr size_t WS_WQKV = 16 * MiB, WS_WO = 22 * MiB, WS_HWIN = 26 * MiB, WS_HWO = 36 * MiB, WS_GLU = 38 * MiB, WS_UP = 42 * MiB, WS_DOWN = 86 * MiB;
constexpr size_t WS_X = 108 * MiB, WS_R = 140 * MiB;
constexpr size_t WS_AP = WS_R, WS_ACT = WS_R + 16 * MiB, WS_SCR = WS_R + 60 * MiB, WS_END = WS_SCR + 176 * MiB;

constexpr size_t SCR_Q = WS_SCR, SCR_KB = WS_SCR + 16 * MiB, SCR_VB = WS_SCR + 20 * MiB, SCR_O = WS_SCR + 24 * MiB;
constexpr size_t SCR_HQ = WS_SCR, SCR_HV = WS_SCR + 16 * MiB, SCR_HG = WS_SCR + 32 * MiB, SCR_LFF = WS_SCR + 48 * MiB, SCR_LFB = WS_SCR + 80 * MiB, SCR_OF = WS_SCR + 112 * MiB, SCR_OB = WS_SCR + 144 * MiB, SCR_AWO = WS_SCR;
constexpr size_t SCR_YF = WS_SCR, SCR_YB = WS_SCR + 32 * MiB, SCR_AGLU = WS_SCR + 64 * MiB;

__device__ __forceinline__ int cond_of_tile(int pm) { return pm < 16 ? 0 : 1 + ((pm - 16) >> 2); }
__device__ __forceinline__ int cond_of_row(int r) { return r < MP ? 0 : 1 + ((r - MP) >> 10); }
__device__ __forceinline__ unsigned cvtpk(float lo, float hi) { f32x2 v = {lo, hi}; bf16x2_t b = __builtin_convertvector(v, bf16x2_t); return __builtin_bit_cast(unsigned, b); }
__device__ __forceinline__ float bf2f(unsigned short h) { return __uint_as_float(((unsigned)h) << 16); }
__device__ __forceinline__ float bflo(unsigned w) { return __uint_as_float(w << 16); }
__device__ __forceinline__ float bfhi(unsigned w) { return __uint_as_float(w & 0xffff0000u); }
__device__ __forceinline__ float sigm(float x) { return __builtin_amdgcn_rcpf(1.f + __expf(-x)); }
__device__ __forceinline__ int lane_id() { unsigned m = ~0u; asm volatile("" : "+s"(m)); return (int)__builtin_amdgcn_mbcnt_hi(m, __builtin_amdgcn_mbcnt_lo(m, 0u)); }
__device__ __forceinline__ float wave_sum(float v) {
#pragma unroll
    for (int o = 1; o < 64; o <<= 1) v += __shfl_xor(v, o);
    return v;
}

struct Ctx {
    const unsigned char __attribute__((address_space(4)))* kp;
    float* out; unsigned char* ws;
    LAS unsigned char* lds; int tid, lane, wave, G, bid;
    __device__ __forceinline__ const float* in(int i) const { return *(const float* const __attribute__((address_space(4)))*)(kp + 8 * i); }
    __device__ __forceinline__ float* f(size_t off) const { return (float*)(ws + off); }
    __device__ __forceinline__ bf16_t* h(size_t off) const { return (bf16_t*)(ws + off); }
};

namespace pg8 {
constexpr int BM = 256, BK = 64, HALF = 128, HTB = HALF * BK * 2, STAGE_BYTES = 8 * HTB, NXCD = 8, WGM = 8;
__host__ __device__ __forceinline__ int lds_byte(int r, int c) { const int st = (r >> 4) * 2 + (c >> 5), rr = r & 15, cc = c & 31, ob = rr * 64 + cc * 2; return st * 1024 + (ob ^ (((ob >> 9) & 1) << 5)); }
__host__ __device__ __forceinline__ void stage_rc(int b, int& R, int& C) { const int st = b / 1024, sb = b % 1024, swz = sb ^ (((sb >> 9) & 1) << 5); R = (st >> 1) * 16 + swz / 64; C = (st & 1) * 32 + (swz % 64) / 2; }
struct Unit { int pm, pn; };
struct Gemm { const bf16_t* A; const bf16_t* Bt; int K; int b_tile_rows, b_half_rows; int ld; int split; };
struct StaticOrder {
    int nM, nN, nwg, G, c;
    __device__ void init(int nM_, int nN_, int G_, int c_) { nM = nM_; nN = nN_; nwg = nM * nN; G = G_; c = c_; }
    __device__ bool next(int i, Unit& u) const {
        const long L = (long)i * G + c; if (L >= nwg) return false;
        int wgid = (int)L; { const int q = nwg / NXCD, r = nwg % NXCD, xcd = wgid % NXCD, off = wgid / NXCD; wgid = (xcd < r ? xcd * (q + 1) : r * (q + 1) + (xcd - r) * q) + off; }
        const int nig = WGM * nN, gid = wgid / nig, fm = gid * WGM, gsz = (nM - fm) < WGM ? (nM - fm) : WGM;
        u.pm = fm + ((wgid % nig) % gsz); u.pn = (wgid % nig) / gsz; return true;
    }
};
template <class Epi>
__device__ __forceinline__ void gemm_phase(LAS unsigned char* lds, const Gemm g, const StaticOrder& S, const Epi& E, int tid_in) {
    int tid_ = tid_in; asm volatile("" : "+v"(tid_));
    const int tid = tid_, wid = __builtin_amdgcn_readfirstlane(tid >> 6), lane = tid & 63, wr = wid >> 2, wc = wid & 3, fr = lane & 15, fq = lane >> 4;
    const int K = g.K, nt = K / BK, ld = g.ld;
    unsigned voffA[2];
#pragma unroll
    for (int i = 0; i < 2; ++i) { int R, C; stage_rc(tid * 16 + i * 8192, R, C); voffA[i] = (unsigned)(R * ld + C) * 2u; }
    const size_t kstep = (size_t)(BK * 2);
    const size_t hstepA = (size_t)HALF * ld * 2, tstepA = 2 * hstepA;
    const size_t hstepB = (size_t)g.b_half_rows * ld * 2, tstepB = (size_t)g.b_tile_rows * ld * 2, khb = (size_t)K * 2;
#define PG8_UA(u) ((const char*)g.A + (size_t)(u).pm * tstepA + (g.split ? (size_t)((u).pn & 1) * khb : 0))
#define PG8_UB(u) ((const char*)g.Bt + (size_t)(g.split ? (u).pn >> 1 : (u).pn) * tstepB + (g.split ? (size_t)((u).pn & 1) * khb : 0))
    const unsigned ldsw = (unsigned)wid * 1024u;
    const int aoff = lds_byte(wr * 64 + fr, fq * 8), boff = lds_byte(wc * 32 + fr, fq * 8);
#define PG8_SA(b, h) (((b) * 2 + (h)) * HTB)
#define PG8_SB(b, h) ((4 + (b) * 2 + (h)) * HTB)
#define PG8_STAGE(bufoff, gbase) do { _Pragma("unroll") for (int _i = 0; _i < 2; ++_i) \
        __builtin_amdgcn_global_load_lds((const unsigned*)((const char*)(gbase) + voffA[_i]), (LAS unsigned*)(lds + (bufoff) + ldsw + _i * 8192), 16, 0, 0); } while (0)
#define PG8_LDA(dst, b, h) do { _Pragma("unroll") for (int m = 0; m < 4; ++m) _Pragma("unroll") for (int k = 0; k < 2; ++k) dst[m][k] = *(const LAS bf16x8*)(lds + PG8_SA(b, h) + aoff + m * 2048 + k * 1024); } while (0)
#define PG8_LDB(dst, b, h) do { _Pragma("unroll") for (int n = 0; n < 2; ++n) _Pragma("unroll") for (int k = 0; k < 2; ++k) dst[n][k] = *(const LAS bf16x8*)(lds + PG8_SB(b, h) + boff + n * 2048 + k * 1024); } while (0)
#define PG8_MMA(ai, bj, At, Bt) do { __builtin_amdgcn_s_setprio(1); _Pragma("unroll") for (int m = 0; m < 4; ++m) _Pragma("unroll") for (int n = 0; n < 2; ++n) _Pragma("unroll") for (int k = 0; k < 2; ++k) \
        acc[ai][bj][m][n] = __builtin_amdgcn_mfma_f32_16x16x32_bf16(Bt[n][k], At[m][k], acc[ai][bj][m][n], 0, 0, 0); __builtin_amdgcn_s_setprio(0); } while (0)
#define PG8_WAIT_V(n) asm volatile("s_waitcnt vmcnt(" #n ")" ::: "memory")
#define PG8_WAIT_L(n) asm volatile("s_waitcnt lgkmcnt(" #n ")" ::: "memory")
#define PG8_BAR __builtin_amdgcn_s_barrier()
#define PG8_SCHED __builtin_amdgcn_sched_barrier(0)
    Unit cur, nxt; int ui = 0;
    if (!S.next(0, cur)) return;
    f32x4 acc[2][2][4][2];
#pragma unroll
    for (int a = 0; a < 2; ++a)
#pragma unroll
        for (int b = 0; b < 2; ++b)
#pragma unroll
            for (int m = 0; m < 4; ++m)
#pragma unroll
                for (int n = 0; n < 2; ++n) acc[a][b][m][n] = (f32x4){0.f, 0.f, 0.f, 0.f};
    bf16x8 At[4][2], B0[2][2], B1[2][2];
    const char* cA = PG8_UA(cur); const char* cB = PG8_UB(cur);
    PG8_STAGE(PG8_SB(0, 0), cB); PG8_STAGE(PG8_SB(0, 1), cB + hstepB); PG8_STAGE(PG8_SA(0, 0), cA); PG8_STAGE(PG8_SA(0, 1), cA + hstepA);
    if (wr == 1) PG8_BAR;
    PG8_WAIT_V(2); PG8_BAR;
    PG8_STAGE(PG8_SB(1, 0), cB + kstep); PG8_STAGE(PG8_SA(1, 0), cA + kstep); PG8_STAGE(PG8_SB(1, 1), cB + hstepB + kstep);
    PG8_WAIT_V(6); PG8_BAR;
    for (;;) {
        const bool has_next = S.next(ui + 1, nxt);
        const char* nA = has_next ? PG8_UA(nxt) : cA; const char* nB = has_next ? PG8_UB(nxt) : cB;
        for (int t = 0; t < nt; t += 2) {
            const bool last = (t == nt - 2);
            const char* a1 = cA + (size_t)(t + 1) * kstep;
            const char* a2 = last ? nA : cA + (size_t)(t + 2) * kstep; const char* b2 = last ? nB : cB + (size_t)(t + 2) * kstep;
            const char* a3 = a2 + kstep; const char* b3 = b2 + kstep;
            PG8_LDB(B0, 0, 0); PG8_LDB(B1, 0, 1); PG8_SCHED; PG8_LDA(At, 0, 0); PG8_STAGE(PG8_SA(1, 1), a1 + hstepA);
            PG8_WAIT_V(8); PG8_WAIT_L(0); PG8_BAR; PG8_MMA(0, 0, At, B0); PG8_MMA(0, 1, At, B1); PG8_BAR; PG8_SCHED;
            PG8_LDA(At, 0, 1); PG8_STAGE(PG8_SB(0, 0), b2); PG8_STAGE(PG8_SB(0, 1), b2 + hstepB); PG8_STAGE(PG8_SA(0, 0), a2);
            PG8_WAIT_V(8); PG8_WAIT_L(0); PG8_BAR; PG8_MMA(1, 0, At, B0); PG8_MMA(1, 1, At, B1); PG8_BAR; PG8_SCHED;
            PG8_LDB(B0, 1, 0); PG8_LDB(B1, 1, 1); PG8_SCHED; PG8_LDA(At, 1, 0); PG8_STAGE(PG8_SA(0, 1), a2 + hstepA);
            PG8_WAIT_V(8); PG8_WAIT_L(0); PG8_BAR; PG8_MMA(0, 0, At, B0); PG8_MMA(0, 1, At, B1); PG8_BAR; PG8_SCHED;
            PG8_LDA(At, 1, 1); PG8_STAGE(PG8_SB(1, 0), b3); PG8_STAGE(PG8_SB(1, 1), b3 + hstepB); PG8_STAGE(PG8_SA(1, 0), a3);
            PG8_WAIT_V(8); PG8_WAIT_L(0); PG8_BAR; PG8_MMA(1, 0, At, B0); PG8_MMA(1, 1, At, B1); PG8_BAR; PG8_SCHED;
        }
        if (wr == 0) PG8_BAR;
        { int l_e = lane_id(); asm volatile("" : "+v"(l_e));
          int fr_e = l_e & 15, fq_e = l_e >> 4, wr_e = wr, wc_e = wc; asm volatile("" : "+s"(wr_e), "+s"(wc_e));
          int tid_e = (wid << 6) | l_e;
          const Unit ue{cur.pm, g.split ? cur.pn >> 1 : cur.pn};
          E(acc, ue, wr_e, wc_e, fr_e, fq_e, g.split ? (cur.pn & 1) : -1, tid_e);
          E.post(ue, tid_e);
#ifdef DUP_POST
          E.post(ue, tid_e);
#endif
          }
        if (!has_next) break;
#pragma unroll
        for (int a = 0; a < 2; ++a)
#pragma unroll
            for (int b = 0; b < 2; ++b)
#pragma unroll
                for (int m = 0; m < 4; ++m)
#pragma unroll
                    for (int n = 0; n < 2; ++n) acc[a][b][m][n] = (f32x4){0.f, 0.f, 0.f, 0.f};
        cur = nxt; cA = nA; cB = nB; ++ui;
        if (wr == 1) PG8_BAR;
    }
    PG8_WAIT_V(0);
    PG8_BAR;
#undef PG8_SA
#undef PG8_UA
#undef PG8_UB
#undef PG8_SB
#undef PG8_STAGE
#undef PG8_LDA
#undef PG8_LDB
#undef PG8_MMA
#undef PG8_WAIT_V
#undef PG8_WAIT_L
#undef PG8_BAR
#undef PG8_SCHED
}
}
using pg8::Unit;
typedef f32x4 Acc[2][2][4][2];

__device__ __forceinline__ void st_bf16x4(bf16_t* p, f32x4 v) { u32x2 w; w.x = cvtpk(v[0], v[1]); w.y = cvtpk(v[2], v[3]); *(u32x2*)p = w; }

template <bool PAIRED> struct EpiRes {
    const float* xin; float* xout; bf16_t* ap; u64_t* ssn; const float* gate;   const float* gmodn;
    __device__ __forceinline__ void operator()(const Acc& acc, const Unit& u, int wr, int wc, int fr, int fq) const {
        const int c = cond_of_tile(u.pm);
        const int colb = (PAIRED ? u.pn * 128 : u.pn * 256) + wc * 32 + 4 * fq;
        constexpr int NBJ = PAIRED ? 1 : 2;
        f32x4 gv[NBJ][2], gm[NBJ][2];
#pragma unroll
        for (int bj = 0; bj < NBJ; ++bj)
#pragma unroll
            for (int n = 0; n < 2; ++n) { gv[bj][n] = *(const f32x4*)(gate + (size_t)c * 6144 + colb + bj * 128 + n * 16);
                gm[bj][n] = gmodn ? *(const f32x4*)(gmodn + (size_t)c * 1024 + colb + bj * 128 + n * 16) : (f32x4){0.f, 0.f, 0.f, 0.f}; }
#pragma unroll
        for (int ai = 0; ai < 2; ++ai)
#pragma unroll
            for (int m = 0; m < 4; ++m) {
                const int r = u.pm * 256 + ai * 128 + wr * 64 + m * 16 + fr; float sq = 0.f;
#pragma unroll
                for (int bj = 0; bj < NBJ; ++bj)
#pragma unroll
                    for (int n = 0; n < 2; ++n) {
                        f32x4 o = acc[ai][bj][m][n];
                        if (PAIRED) { const f32x4 gt = acc[ai][1][m][n];
#pragma unroll
                            for (int e = 0; e < 4; ++e) o[e] = o[e] * sigm(gt[e]); }
                        const size_t off = (size_t)r * D + colb + bj * 128 + n * 16;
                        const f32x4 xo = *(const f32x4*)(xin + off) + gv[bj][n] * o;
                        *(f32x4*)(xout + off) = xo;
                        sq += (xo[0] * xo[0] + xo[1] * xo[1]) + (xo[2] * xo[2] + xo[3] * xo[3]);
                        if (gmodn) st_bf16x4(ap + off, xo * gm[bj][n]);
                    }
                sq += __shfl_xor(sq, 16); sq += __shfl_xor(sq, 32);
                if (fq == 0) atomicAdd(ssn + r, (u64_t)(sq * SS_FIX));
            }
    }
};
struct EpiUpRaw {
    const u64_t* ss; const float* sw;   bf16_t* hraw;
    __device__ __forceinline__ void operator()(const Acc& acc, const Unit& u, int wr, int wc, int fr, int fq) const {
        const int c = cond_of_tile(u.pm); const int colb = u.pn * 256 + wc * 32 + 4 * fq;
        f32x4 sv[2][2];
#pragma unroll
        for (int bj = 0; bj < 2; ++bj)
#pragma unroll
            for (int n = 0; n < 2; ++n) sv[bj][n] = *(const f32x4*)(sw + (size_t)c * SW_STRIDE + colb + bj * 128 + n * 16);
#pragma unroll
        for (int ai = 0; ai < 2; ++ai)
#pragma unroll
            for (int m = 0; m < 4; ++m) {
                const int r = u.pm * 256 + ai * 128 + wr * 64 + m * 16 + fr; const float rs = rstd_of(ss, r);
#pragma unroll
                for (int bj = 0; bj < 2; ++bj)
#pragma unroll
                    for (int n = 0; n < 2; ++n) st_bf16x4(hraw + (size_t)r * NUP + colb + bj * 128 + n * 16, acc[ai][bj][m][n] * rs + sv[bj][n]);
            }
    }
};
constexpr size_t WS_EDGE = 14 * MiB;
template <int CTRL> __device__ __forceinline__ float dpp_f(float old, float src) { return __int_as_float(__builtin_amdgcn_update_dpp(__float_as_int(old), __float_as_int(src), CTRL, 0xf, 0xf, false)); }
#define DPP_ROW_SHL1 0x101
#define DPP_ROW_SHR1 0x111
#define DPP_ROW_ROR1 0x121
#define DPP_ROW_ROR15 0x12f
struct EpiUpConv {
    const u64_t* ss; const float* sw; const float* cw; const float* cb; bf16_t* act; float* edge; bf16_t* tile;
    __device__ __forceinline__ void operator()(const Acc& acc, const Unit& u, int wr, int wc, int fr, int fq) const {
        const int c = cond_of_tile(u.pm); const int cc0 = wc * 32 + 4 * fq, colg0 = u.pn * 128 + cc0;
        f32x4 sv[2][2];
#pragma unroll
        for (int bj = 0; bj < 2; ++bj)
#pragma unroll
            for (int n = 0; n < 2; ++n) sv[bj][n] = *(const f32x4*)(sw + (size_t)c * SW_STRIDE + bj * DFF + colg0 + n * 16);
#pragma unroll
        for (int ai = 0; ai < 2; ++ai)
#pragma unroll
            for (int m = 0; m < 4; ++m) { const int rl = ai * 128 + wr * 64 + m * 16 + fr; const float rs = rstd_of(ss, u.pm * 256 + rl);
#pragma unroll
                for (int bj = 0; bj < 2; ++bj)
#pragma unroll
                    for (int n = 0; n < 2; ++n) st_bf16x4(tile + rl * 256 + bj * 128 + cc0 + n * 16, acc[ai][bj][m][n] * rs + sv[bj][n]); }
    }
    __device__ __forceinline__ void fused(const Acc& acc, const Unit& u, int wr, int wc, int fr, int fq, int tid, LAS unsigned char* xl) const {
        const int c = cond_of_tile(u.pm);
        const bool samp = u.pm >= 16; const bool nb_top = samp && (u.pm & 3) != 0, nb_bot = samp && (u.pm & 3) != 3;
        float rs[8];
#pragma unroll
        for (int ai = 0; ai < 2; ++ai)
#pragma unroll
            for (int m = 0; m < 4; ++m) rs[ai * 4 + m] = rstd_of(ss, u.pm * 256 + ai * 128 + wr * 64 + m * 16 + fr);
        const int r = tid >> 1, q = tid & 1;
        LAS float* cf = (LAS float*)(xl + 20480);
        { const int bj = tid >> 8, jj = (tid >> 6) & 3, cl2 = 2 * (tid & 63); const float* src = (jj < 3 ? cw + jj * NUP : cb) + bj * DFF + u.pn * 128 + cl2;
          *(LAS f32x2*)(cf + (bj * 4 + jj) * 128 + cl2) = *(const f32x2*)src; }
#pragma unroll
        for (int sl = 0; sl < 8; ++sl) {
            const int swc = sl >> 1, sn = sl & 1, colg = u.pn * 128 + 32 * swc + 16 * sn, cs = 32 * swc + 16 * sn + 8 * q;
            if (wc == swc) {
                const f32x4 svg = *(const f32x4*)(sw + (size_t)c * SW_STRIDE + colg + 4 * fq), svv = *(const f32x4*)(sw + (size_t)c * SW_STRIDE + DFF + colg + 4 * fq);
#pragma unroll
                for (int ai = 0; ai < 2; ++ai)
#pragma unroll
                    for (int m = 0; m < 4; ++m) { const int row = ai * 128 + wr * 64 + m * 16 + fr;
                        const f32x4 hg = acc[ai][0][m][sn] * rs[ai * 4 + m] + svg, hv = acc[ai][1][m][sn] * rs[ai * 4 + m] + svv;
                        *(LAS u32x2*)(xl + row * 80 + 8 * fq) = (u32x2){cvtpk(hg[0], hg[1]), cvtpk(hg[2], hg[3])}; *(LAS u32x2*)(xl + row * 80 + 32 + 8 * fq) = (u32x2){cvtpk(hv[0], hv[1]), cvtpk(hv[2], hv[3])}; }
            }
            asm volatile("s_waitcnt lgkmcnt(0)" ::: "memory"); __builtin_amdgcn_s_barrier(); asm volatile("" ::: "memory");
            {
                const u32x4 z = {0u, 0u, 0u, 0u};
                const u32x4 pg = r > 0 ? *(const LAS u32x4*)(xl + (r - 1) * 80 + 16 * q) : z, pv = r > 0 ? *(const LAS u32x4*)(xl + (r - 1) * 80 + 32 + 16 * q) : z;
                const u32x4 cg = *(const LAS u32x4*)(xl + r * 80 + 16 * q), cv = *(const LAS u32x4*)(xl + r * 80 + 32 + 16 * q);
                const u32x4 ng = r < 255 ? *(const LAS u32x4*)(xl + (r + 1) * 80 + 16 * q) : z, nv = r < 255 ? *(const LAS u32x4*)(xl + (r + 1) * 80 + 32 + 16 * q) : z;
                float hg[8], hv[8];
                f32x4 wA[2][3], bA[2];
#pragma unroll
                for (int bj = 0; bj < 2; ++bj) {
#pragma unroll
                    for (int jj = 0; jj < 3; ++jj) wA[bj][jj] = *(const LAS f32x4*)(cf + (bj * 4 + jj) * 128 + cs);
                    bA[bj] = *(const LAS f32x4*)(cf + (bj * 4 + 3) * 128 + cs); }
#pragma unroll
                for (int e = 0; e < 2; ++e) { const int k0 = 2 * e;
                    hg[2 * e] = wA[0][0][k0] * bflo(pg[e]) + wA[0][1][k0] * bflo(cg[e]) + wA[0][2][k0] * bflo(ng[e]) + bA[0][k0];
                    hg[2 * e + 1] = wA[0][0][k0 + 1] * bfhi(pg[e]) + wA[0][1][k0 + 1] * bfhi(cg[e]) + wA[0][2][k0 + 1] * bfhi(ng[e]) + bA[0][k0 + 1];
                    hv[2 * e] = wA[1][0][k0] * bflo(pv[e]) + wA[1][1][k0] * bflo(cv[e]) + wA[1][2][k0] * bflo(nv[e]) + bA[1][k0];
                    hv[2 * e + 1] = wA[1][0][k0 + 1] * bfhi(pv[e]) + wA[1][1][k0 + 1] * bfhi(cv[e]) + wA[1][2][k0 + 1] * bfhi(nv[e]) + bA[1][k0 + 1]; }
                f32x4 wB[2][3], bB[2];
#pragma unroll
                for (int bj = 0; bj < 2; ++bj) {
#pragma unroll
                    for (int jj = 0; jj < 3; ++jj) wB[bj][jj] = *(const LAS f32x4*)(cf + (bj * 4 + jj) * 128 + cs + 4);
                    bB[bj] = *(const LAS f32x4*)(cf + (bj * 4 + 3) * 128 + cs + 4); }
#pragma unroll
                for (int e = 2; e < 4; ++e) { const int k0 = 2 * (e - 2);
                    hg[2 * e] = wB[0][0][k0] * bflo(pg[e]) + wB[0][1][k0] * bflo(cg[e]) + wB[0][2][k0] * bflo(ng[e]) + bB[0][k0];
                    hg[2 * e + 1] = wB[0][0][k0 + 1] * bfhi(pg[e]) + wB[0][1][k0 + 1] * bfhi(cg[e]) + wB[0][2][k0 + 1] * bfhi(ng[e]) + bB[0][k0 + 1];
                    hv[2 * e] = wB[1][0][k0] * bflo(pv[e]) + wB[1][1][k0] * bflo(cv[e]) + wB[1][2][k0] * bflo(nv[e]) + bB[1][k0];
                    hv[2 * e + 1] = wB[1][0][k0 + 1] * bfhi(pv[e]) + wB[1][1][k0 + 1] * bfhi(cv[e]) + wB[1][2][k0 + 1] * bfhi(nv[e]) + bB[1][k0 + 1]; }
                u32x4 o;
#pragma unroll
                for (int e = 0; e < 4; ++e) o[e] = cvtpk(hg[2 * e] * sigm(hg[2 * e]) * hv[2 * e], hg[2 * e + 1] * sigm(hg[2 * e + 1]) * hv[2 * e + 1]);
                *(u32x4*)(act + (size_t)(u.pm * 256 + r) * DFF + colg + 8 * q) = o;
                if ((r == 0 && nb_top) || (r == 255 && nb_bot)) {
                    float* e0 = edge + ((size_t)((u.pm - 16) * 2 + (r == 0 ? 0 : 1)) * 4) * DFF + colg + 8 * q;
#pragma unroll
                    for (int e = 0; e < 4; ++e) { e0[2 * e] = hg[2 * e]; e0[2 * e + 1] = hg[2 * e + 1]; e0[DFF + 2 * e] = hv[2 * e]; e0[DFF + 2 * e + 1] = hv[2 * e + 1];
                        e0[2 * DFF + 2 * e] = bflo(cg[e]); e0[2 * DFF + 2 * e + 1] = bfhi(cg[e]); e0[3 * DFF + 2 * e] = bflo(cv[e]); e0[3 * DFF + 2 * e + 1] = bfhi(cv[e]); } }
            }
            asm volatile("s_waitcnt lgkmcnt(0)" ::: "memory"); __builtin_amdgcn_s_barrier(); asm volatile("" ::: "memory"); __builtin_amdgcn_sched_barrier(0);
        }
    }
};
struct EpiQKV {
    const u64_t* ss; const float* sw; bf16_t *Q, *KB, *VB; float *outK, *outV; const float *ropec, *ropes; int j;
    __device__ __forceinline__ void operator()(const Acc& acc, const Unit& u, int wr, int wc, int fr, int fq) const {
        const int c = cond_of_tile(u.pm); const bool samp = u.pm >= 16; const int colt = u.pn * 256, cl0 = wc * 32 + 4 * fq;
        f32x4 sv[2][2];
#pragma unroll
        for (int bj = 0; bj < 2; ++bj)
#pragma unroll
            for (int n = 0; n < 2; ++n) sv[bj][n] = *(const f32x4*)(sw + (size_t)c * SW_STRIDE + colt + cl0 + bj * 128 + n * 16);
#pragma unroll
        for (int ai = 0; ai < 2; ++ai)
#pragma unroll
            for (int m = 0; m < 4; ++m) {
                const int r = u.pm * 256 + ai * 128 + wr * 64 + m * 16 + fr; const float rs = rstd_of(ss, r);
                f32x4 cs = {1.f, 1.f, 1.f, 1.f}, sn = {0.f, 0.f, 0.f, 0.f};
                if (samp && u.pn < 5) { const int t = (r - MP) & 1023, idx = t * 32 + (wc & 1) * 16 + 4 * fq; cs = *(const f32x4*)(ropec + idx); sn = *(const f32x4*)(ropes + idx); }
#pragma unroll
                for (int bj = 0; bj < 2; ++bj) {
                    f32x4 v0 = acc[ai][bj][m][0] * rs + sv[bj][0], v1 = acc[ai][bj][m][1] * rs + sv[bj][1];
                    if (u.pn < 5) { const f32x4 o0 = v0 * cs - v1 * sn, o1 = v1 * cs + v0 * sn; v0 = o0; v1 = o1; }
                    const int cl = bj * 128 + cl0;
                    if (u.pn < 4) { st_bf16x4(Q + (size_t)r * D + colt + cl, v0 * QSCALE); st_bf16x4(Q + (size_t)r * D + colt + cl + 16, v1 * QSCALE); }
                    else {
                        bf16_t* dst = (u.pn == 4 ? KB : VB) + (size_t)r * 256 + cl; st_bf16x4(dst, v0); st_bf16x4(dst + 16, v1);
                        if (!samp) { float* o = (u.pn == 4 ? outK : outV) + (((size_t)(r >> 8) * 2 + j) * 256 + (r & 255)) * 256 + cl; *(f32x4*)o = v0; *(f32x4*)(o + 16) = v1; }
                    }
                }
            }
    }
};
struct EpiHin {
    const u64_t* ss; const float* sw; const float* lb1; bf16_t *HQ, *HV, *HG; float *LFF, *LFB;
    __device__ __forceinline__ void operator()(const Acc& acc, const Unit& u, int wr, int wc, int fr, int fq) const {
        const int c = cond_of_tile(u.pm); const int seg = u.pn >> 2, colt = u.pn * 256, cl0 = wc * 32 + 4 * fq, cs0 = (u.pn & 3) * 256 + cl0;
        f32x4 sv[2][2], lbv[2][2];
#pragma unroll
        for (int bj = 0; bj < 2; ++bj)
#pragma unroll
            for (int n = 0; n < 2; ++n) { sv[bj][n] = *(const f32x4*)(sw + (size_t)c * SW_STRIDE + colt + cl0 + bj * 128 + n * 16);
                lbv[bj][n] = (seg == 2 || seg == 3) ? *(const f32x4*)(lb1 + (seg - 2) * 1024 + cs0 + bj * 128 + n * 16) : (f32x4){0.f, 0.f, 0.f, 0.f}; }
#pragma unroll
        for (int ai = 0; ai < 2; ++ai)
#pragma unroll
            for (int m = 0; m < 4; ++m) {
                const int r = u.pm * 256 + ai * 128 + wr * 64 + m * 16 + fr; const float rs = rstd_of(ss, r);
#pragma unroll
                for (int bj = 0; bj < 2; ++bj)
#pragma unroll
                    for (int n = 0; n < 2; ++n) {
                        f32x4 v = acc[ai][bj][m][n] * rs + sv[bj][n]; const size_t off = (size_t)r * D + cs0 + bj * 128 + n * 16;
                        if (seg == 0) st_bf16x4(HQ + off, v);
                        else if (seg == 1) st_bf16x4(HV + off, v);
                        else if (seg == 4) {
#pragma unroll
                            for (int e = 0; e < 4; ++e) v[e] = v[e] * sigm(v[e]);
                            st_bf16x4(HG + off, v); }
                        else { const f32x4 lb = lbv[bj][n];
#pragma unroll
                            for (int e = 0; e < 4; ++e) v[e] = __logf(lb[e] + (1.f - lb[e]) * sigm(v[e]));
                            *(f32x4*)((seg == 2 ? LFF : LFB) + off) = v; }
                    }
            }
    }
};
enum { EK_RES = 0, EK_RES_GLU, EK_UPRAW, EK_QKV, EK_HIN, EK_UPCONV };
struct EpiAny {
    int kind, l, flags, epoch, pn_off; unsigned char* ws; float* out; const float *in29, *in30; LAS unsigned char* xl;
    __device__ __forceinline__ float* F(size_t o) const { return (float*)(ws + o); }
    __device__ __forceinline__ bf16_t* H(size_t o) const { return (bf16_t*)(ws + o); }
    __device__ __forceinline__ void post(const Unit&, int) const {}
    __device__ __forceinline__ void operator()(Acc& acc, const Unit& u, int wr, int wc, int fr, int fq, int kh, int tid) const {
#ifndef EK_MASK
#define EK_MASK 63
#endif
        if (!((EK_MASK >> this->kind) & 1)) return;
        unsigned char* ws = this->ws; float* out = this->out; int kind = this->kind, l = this->l, flags = this->flags;
        asm volatile("" : "+s"(ws), "+s"(out), "+s"(kind), "+s"(l), "+s"(flags));
        if (kh >= 0) {
            const int tile = u.pm * 4 + u.pn; unsigned* flag = (unsigned*)(ws + WS_CTL + 40960) + tile * 16;
            unsigned char* slab = ws + WS_SCR + 64 * MiB + (size_t)tile * 262144 + (size_t)tid * 16;
            if (kh == 1) {
                __amdgpu_buffer_rsrc_t rs = __builtin_amdgcn_make_buffer_rsrc(ws + WS_SCR + 64 * MiB + (size_t)tile * 262144, 0, 262144, 0x00020000);
#pragma unroll
                for (int j = 0; j < 32; ++j) __builtin_amdgcn_raw_buffer_store_b128(__builtin_bit_cast(u32x4, acc[j >> 4][(j >> 3) & 1][(j >> 1) & 3][j & 1]), rs, tid * 16 + j * 8192, 0, 16);
                asm volatile("s_waitcnt vmcnt(0)" ::: "memory"); __builtin_amdgcn_s_barrier(); asm volatile("" ::: "memory");
                if (tid == 0) __hip_atomic_store(flag, (unsigned)epoch, __ATOMIC_RELAXED, __HIP_MEMORY_SCOPE_AGENT);
                return;
            }
            if (tid < 64) {
                unsigned sp = 0;
                while ((unsigned)__builtin_amdgcn_readfirstlane((int)__hip_atomic_load(flag, __ATOMIC_RELAXED, __HIP_MEMORY_SCOPE_AGENT)) != (unsigned)epoch) { __builtin_amdgcn_s_sleep(2); if (++sp > (1u << 22)) break; }
                __builtin_amdgcn_fence(__ATOMIC_ACQUIRE, "agent"); asm volatile("s_waitcnt vmcnt(0)" ::: "memory");
            }
            asm volatile("" ::: "memory"); __builtin_amdgcn_s_barrier(); asm volatile("" ::: "memory");
#pragma unroll
            for (int j = 0; j < 32; ++j) acc[j >> 4][(j >> 3) & 1][(j >> 1) & 3][j & 1] += *(const f32x4*)(slab + (size_t)j * 8192);
        }
        auto F = [&](size_t o) { return (float*)(ws + o); }; auto H = [&](size_t o) { return (bf16_t*)(ws + o); };
        const size_t ss1 = WS_SS + (size_t)(l * 2) * M * 8, sw1 = WS_SW + (size_t)(l * 2) * 5 * SW_STRIDE * 4;
        switch (kind) {
        case EK_RES: case EK_RES_GLU: {
            const bool down = flags & 1;
            const size_t ssn = down ? WS_SS + (size_t)((l + 1) * 2) * M * 8 : ss1 + (size_t)M * 8;
            const size_t gate = WS_MOD + ((size_t)l * 5 * 6144 + (down ? 5 : 2) * 1024) * 4;
            const size_t gmn = down ? WS_GMOD + (size_t)((l + 1) * 2) * 5 * 1024 * 4 : WS_GMOD + (size_t)(l * 2 + 1) * 5 * 1024 * 4;
            const bool has_next = !(down && l == 3);
            float* xo = (flags & 2) ? out : F(WS_X); bf16_t* ap = H(WS_AP); u64_t* sp = (u64_t*)(ws + ssn);
            if (flags & 4) { const size_t dm = WS_SCR + ((flags & 8) ? 48 : 96) * MiB; xo = F(dm); ap = H(dm + 32 * MiB); sp = (u64_t*)(ws + dm + 48 * MiB); }
            if (kind == EK_RES) { EpiRes<false> E{F(WS_X), xo, ap, sp, F(gate), has_next ? F(gmn) : nullptr}; E(acc, u, wr, wc, fr, fq); }
            else { EpiRes<true> E{F(WS_X), xo, ap, sp, F(gate), F(gmn)}; E(acc, u, wr, wc, fr, fq); } } break;
        case EK_UPRAW: { EpiUpRaw E{(const u64_t*)(ws + ss1 + (size_t)M * 8), F(sw1 + (size_t)5 * SW_STRIDE * 4), H(WS_SCR + (size_t)((flags >> 2) & 1) * (88 * MiB))}; E(acc, u, wr, wc, fr, fq); } break;
        case EK_UPCONV: { EpiUpConv E{(const u64_t*)(ws + ss1 + (size_t)M * 8), F(sw1 + (size_t)5 * SW_STRIDE * 4), in29 + (size_t)l * 3 * NUP, in30 + (size_t)l * NUP, H(WS_ACT), F(WS_EDGE), nullptr}; E.fused(acc, u, wr, wc, fr, fq, tid, xl);
#ifdef DUP_FUSED
            E.fused(acc, u, wr, wc, fr, fq, tid, xl);
#endif
            } break;
        case EK_QKV: { EpiQKV E{(const u64_t*)(ws + ss1), F(sw1), H(SCR_Q), H(SCR_KB), H(SCR_VB), out + 8388608, out + 8388608 + 2097152, F(WS_ROPE), F(WS_ROPE) + 32768, l / 3}; E(acc, u, wr, wc, fr, fq); } break;
        default: { Unit u2{u.pm, u.pn + pn_off}; const Unit& u = u2; EpiHin E{(const u64_t*)(ws + ss1), F(sw1), F(WS_LB1), H(SCR_HQ), H(SCR_HV), H(SCR_HG), F(SCR_LFF), F(SCR_LFB)}; E(acc, u, wr, wc, fr, fq); } break;
        }
    }
};
}
namespace om {
#define LDS_WAIT() asm volatile("s_waitcnt lgkmcnt(0)" ::: "memory")
__device__ __forceinline__ void transpose_item(const float* W, int K, int N, bf16_t* WT, LAS unsigned short* scr, int item, int lane) {
    const int nblk = N / 32, kb = item / nblk, nb = item % nblk, k0 = 64 * kb, n0 = 32 * nb;
    float v[32];
#pragma unroll
    for (int i = 0; i < 32; ++i) v[i] = W[(size_t)(k0 + 2 * i + (lane >> 5)) * N + n0 + (lane & 31)];
#pragma unroll
    for (int i = 0; i < 32; ++i) scr[(2 * i + (lane >> 5)) * 33 + (lane & 31)] = (unsigned short)(cvtpk(v[i], 0.f) & 0xffffu);
    LDS_WAIT(); asm volatile("" ::: "memory");
    const int c = lane & 7;
#pragma unroll
    for (int j = 0; j < 4; ++j) { const int n = (lane >> 3) + 8 * j; const LAS unsigned short* s = scr + (8 * c) * 33 + n;
        u32x4 o; o.x = (unsigned)s[0 * 33] | ((unsigned)s[1 * 33] << 16); o.y = (unsigned)s[2 * 33] | ((unsigned)s[3 * 33] << 16); o.z = (unsigned)s[4 * 33] | ((unsigned)s[5 * 33] << 16); o.w = (unsigned)s[6 * 33] | ((unsigned)s[7 * 33] << 16);
        *(u32x4*)(WT + (size_t)(n0 + n) * K + k0 + 8 * c) = o; }
    LDS_WAIT(); asm volatile("" ::: "memory");
}
__device__ __forceinline__ float modsum(const Ctx& C, int l, int c, int idx) {
    const float* mp = C.f(WS_MODP) + ((size_t)l * 5 + c) * 6144 + idx; float s = C.in(9)[l * 6144 + idx];
#pragma unroll
    for (int kp = 0; kp < 4; ++kp) s += mp[(size_t)kp * 4 * 5 * 6144];
    return s;
}
__device__ __forceinline__ void convert_layer(const Ctx& C, int layer, int vb, int nvb) {
    const int gw = vb * NWAVES + C.wave, NGW = nvb * NWAVES;
    LAS unsigned short* scr = (LAS unsigned short*)(C.lds + C.wave * 4352);
#define DO_MAT(src, dst, K, N) for (int it = gw; it < ((K) / 64) * ((N) / 32); it += NGW) transpose_item((src), (K), (N), (dst), scr, it, C.lane)
    if (layer == 0 || layer == 3) { const int j = layer / 3; DO_MAT(C.in(12) + (size_t)j * D * NQKV, C.h(WS_WQKV) + (size_t)j * NQKV * D, D, NQKV); DO_MAT(C.in(13) + (size_t)j * D * D, C.h(WS_WO) + (size_t)j * D * D, D, D); }
    else if (layer == 1) { DO_MAT(C.in(15), C.h(WS_HWIN), D, NHIN); DO_MAT(C.in(18), C.h(WS_HWO), D, D); }
    else { DO_MAT(C.in(27), C.h(WS_GLU), D, 2048); }
    DO_MAT(C.in(28) + (size_t)layer * D * NUP, C.h(WS_UP) + (size_t)layer * NUP * D, D, NUP); DO_MAT(C.in(31) + (size_t)layer * DFF * D, C.h(WS_DOWN) + (size_t)layer * D * DFF, DFF, D);
#undef DO_MAT
}
__device__ __forceinline__ void phase_p0a(const Ctx& C) {
    const int gt = C.bid * NTHREADS + C.tid, NGT = C.G * NTHREADS;
    for (int layer = 0; layer < 4; ++layer) if (layer == 0 || C.G != 256) convert_layer(C, layer, C.bid, C.G);
    __syncthreads();
    LAS float* sS = (LAS float*)(C.lds + 40960);
    LAS float* red = (LAS float*)(C.lds);
    for (int it = C.bid; it < 384; it += C.G) {
        const int l = it / 96, cb = (it % 96) >> 2, kp = it & 3;
        for (int i = C.tid; i < 5 * 256; i += NTHREADS) { const int c = i >> 8, k = kp * 256 + (i & 255); const float v = c == 0 ? C.in(7)[k] : C.in(6)[(c - 1) * 1024 + k]; sS[i] = v / (1.f + __expf(-v)); }
        __syncthreads();
        f32x4 a[5];
#pragma unroll
        for (int c = 0; c < 5; ++c) a[c] = (f32x4){0.f, 0.f, 0.f, 0.f};
        const float* wp = C.in(8) + ((size_t)l * 1024 + kp * 256 + C.wave * 32) * 6144 + cb * 256 + 4 * C.lane;
#pragma unroll 4
        for (int k = 0; k < 32; ++k) { const f32x4 w = *(const f32x4*)(wp + (size_t)k * 6144);
#pragma unroll
            for (int c = 0; c < 5; ++c) a[c] += w * sS[c * 256 + C.wave * 32 + k]; }
#pragma unroll
        for (int c = 0; c < 5; ++c) *(LAS f32x4*)(red + (C.wave * 5 + c) * 256 + 4 * C.lane) = a[c];
        __syncthreads();
        for (int i = C.tid; i < 5 * 256; i += NTHREADS) { float s = 0.f;
#pragma unroll
            for (int w = 0; w < 8; ++w) s += red[w * 1280 + i];
            C.f(WS_MODP)[(((size_t)kp * 4 + l) * 5 + (i >> 8)) * 6144 + cb * 256 + (i & 255)] = s; }
        __syncthreads();
    }
    { unsigned zero = 0u; asm volatile("" : "+v"(zero));
      for (int i = gt; i < 9 * M; i += NGT) ((u32x2*)(C.ws + WS_SS))[i] = (u32x2){zero, zero}; }
    for (int i = gt; i < 1024 * 32; i += NGT) { const int t = i >> 5, e = i & 31, fi = e & 15; const float pos = (e >> 4) == 0 ? (float)(t >> 6) : (float)(t & 63);
        const float ang = pos * __builtin_amdgcn_exp2f(-(float)fi * (13.287712379549449f / 16.0f))  ; C.f(WS_ROPE)[i] = cosf(ang); C.f(WS_ROPE)[32768 + i] = sinf(ang); }
    for (int i = gt; i < 2 * 131072; i += NGT) { const int which = i >> 17, e = (i & 131071) * 8; const float* s = (which ? C.in(3) : C.in(2)) + e; const f32x4 a = *(const f32x4*)s, b = *(const f32x4*)(s + 4);
        u32x4 o; o.x = cvtpk(a[0], a[1]); o.y = cvtpk(a[2], a[3]); o.z = cvtpk(b[0], b[1]); o.w = cvtpk(b[2], b[3]); *(u32x4*)(C.h(which ? WS_CTXV : WS_CTXK) + e) = o; }
    for (int i = gt; i < 2048; i += NGT) { float v[4], mx = -1e30f;
#pragma unroll
        for (int l = 0; l < 4; ++l) { v[l] = C.in(16)[l * 2048 + i]; mx = fmaxf(mx, v[l]); }
        float s = 0.f;
#pragma unroll
        for (int l = 0; l < 4; ++l) { v[l] = expf(v[l] - mx); s += v[l]; }
        C.f(WS_LB1)[i] = v[1] / s; }
    for (int i = gt; i < 8192; i += NGT) {
        const int dg = i >> 6, p = i & 63;
        const float ar = fminf(C.in(19)[i], -1e-4f), ai = C.in(20)[i], dt = expf(C.in(21)[dg]);
        const float e = expf(ar * dt), lr = e * cosf(ai * dt), li = e * sinf(ai * dt);
        const float den = ar * ar + ai * ai, fr = ((lr - 1.f) * ar + li * ai) / den, fi = (li * ar - (lr - 1.f) * ai) / den;
        C.f(WS_SLAM)[2 * i] = lr; C.f(WS_SLAM)[2 * i + 1] = li;
        unsigned wr_[8], wi_[8];
#pragma unroll
        for (int q = 0; q < 8; ++q) { const float x0 = C.in(22)[(size_t)i * 16 + 2 * q], y0 = C.in(23)[(size_t)i * 16 + 2 * q], x1 = C.in(22)[(size_t)i * 16 + 2 * q + 1], y1 = C.in(23)[(size_t)i * 16 + 2 * q + 1];
            wr_[q] = cvtpk(fr * x0 - fi * y0, fr * x1 - fi * y1); wi_[q] = cvtpk(fr * y0 + fi * x0, fr * y1 + fi * x1); }
        bf16_t* bb = C.h(WS_SBB) + ((size_t)dg * 128 + p) * 16;
        *(u32x4*)bb = (u32x4){wr_[0], wr_[1], wr_[2], wr_[3]}; *(u32x4*)(bb + 8) = (u32x4){wr_[4], wr_[5], wr_[6], wr_[7]};
        *(u32x4*)(bb + 64 * 16) = (u32x4){wi_[0], wi_[1], wi_[2], wi_[3]}; *(u32x4*)(bb + 64 * 16 + 8) = (u32x4){wi_[4], wi_[5], wi_[6], wi_[7]};
    }
    for (int i = gt; i < 2 * 64 * 16 * 64; i += NGT) {
        const int p = i & 63, row = i >> 6; bf16_t* cb = C.h(WS_SCB) + (size_t)row * 128;
        cb[p] = (bf16_t)(cvtpk(C.in(24)[i], 0.f) & 0xffffu); cb[64 + p] = (bf16_t)(cvtpk(-C.in(25)[i], 0.f) & 0xffffu); }
}
__device__ __forceinline__ void rows_ap_ss(const Ctx& C, const float* xsrc_p, const float* xsrc_s, float* xcopy, int l, int s, bool from_table, u64_t* ssdst) {
    for (int gw = C.bid * NWAVES + C.wave; gw < M / 4; gw += C.G * NWAVES) {
    const int r0 = gw * 4;
    const int c = cond_of_row(r0);
    f32x4 gm[4];
#pragma unroll
    for (int j = 0; j < 4; ++j) { const int n = 4 * C.lane + 256 * j;
        if (from_table) gm[j] = *(const f32x4*)(C.f(WS_GMOD) + (((size_t)l * 2 + s) * 5 + c) * 1024 + n);
        else { const float* g = (s == 0 ? C.in(10) : C.in(11)) + l * D + n;
#pragma unroll
            for (int e = 0; e < 4; ++e) gm[j][e] = g[e] * (1.f + modsum(C, l, c, (s == 0 ? 1 : 4) * 1024 + n + e)); } }
    for (int rr = 0; rr < 4; ++rr) {
        const int r = r0 + rr; const float* xr = (r < MP ? xsrc_p + (size_t)r * D : xsrc_s + (size_t)(r - MP) * D);
        f32x4 v[4]; float sq = 0.f;
#pragma unroll
        for (int j = 0; j < 4; ++j) { v[j] = *(const f32x4*)(xr + 4 * C.lane + 256 * j); sq += (v[j][0] * v[j][0] + v[j][1] * v[j][1]) + (v[j][2] * v[j][2] + v[j][3] * v[j][3]); }
        sq = wave_sum(sq);
#pragma unroll
        for (int j = 0; j < 4; ++j) { const size_t off = (size_t)r * D + 4 * C.lane + 256 * j; if (xcopy) *(f32x4*)(xcopy + off) = v[j]; st_bf16x4(C.h(WS_AP) + off, v[j] * gm[j]); }
        if (C.lane == 0) ssdst[r] = (u64_t)(sq * SS_FIX);
    }
    }
}
template <bool FROM_TABLE> __device__ __forceinline__ void sw_item_t(const Ctx& C, int item) {
    int ch = item, l = 0, s = 0, N = 0; const float* Wf = nullptr;
    if (ch < 12) { l = 0; s = 0; N = NQKV; Wf = C.in(12); }
    else if ((ch -= 12) < 44) { l = 0; s = 1; N = NUP; Wf = C.in(28); }
    else if ((ch -= 44) < 40) { l = 1; s = 0; N = NHIN; Wf = C.in(15); }
    else if ((ch -= 40) < 44) { l = 1; s = 1; N = NUP; Wf = C.in(28) + (size_t)1 * D * NUP; }
    else if ((ch -= 44) < 44) { l = 2; s = 1; N = NUP; Wf = C.in(28) + (size_t)2 * D * NUP; }
    else if ((ch -= 44) < 12) { l = 3; s = 0; N = NQKV; Wf = C.in(12) + (size_t)1 * D * NQKV; }
    else { ch -= 12; l = 3; s = 1; N = NUP; Wf = C.in(28) + (size_t)3 * D * NUP; }
    LAS float* sh = (LAS float*)C.lds;
    for (int i = C.tid; i < 5 * 1024; i += NTHREADS) sh[i] = FROM_TABLE ? C.f(WS_MOD)[((size_t)l * 5 + (i >> 10)) * 6144 + (s == 0 ? 0 : 3) * 1024 + (i & 1023)] : modsum(C, l, i >> 10, (s == 0 ? 0 : 3) * 1024 + (i & 1023));
    __syncthreads();
    const int n0 = ch * 128 + 4 * (C.lane & 31);
    f32x4 a[5];
#pragma unroll
    for (int c = 0; c < 5; ++c) a[c] = (f32x4){0.f, 0.f, 0.f, 0.f};
    const float* wp = Wf + (size_t)(C.wave * 128 + (C.lane >> 5)) * N + n0;
#pragma unroll 4
    for (int k = 0; k < 64; ++k) { const f32x4 w = *(const f32x4*)(wp + (size_t)(2 * k) * N); const int kk = C.wave * 128 + 2 * k + (C.lane >> 5);
#pragma unroll
        for (int c = 0; c < 5; ++c) a[c] += w * sh[c * 1024 + kk]; }
    LAS float* red = (LAS float*)(C.lds + 20480);
#pragma unroll
    for (int c = 0; c < 5; ++c) *(LAS f32x4*)(red + ((C.wave * 2 + (C.lane >> 5)) * 5 + c) * 128 + 4 * (C.lane & 31)) = a[c];
    __syncthreads();
    for (int i = C.tid; i < 5 * 128; i += NTHREADS) { float sum = 0.f;
#pragma unroll
        for (int w = 0; w < 16; ++w) sum += red[w * 640 + i];
        C.f(WS_SW)[(((size_t)l * 2 + s) * 5 + (i >> 7)) * SW_STRIDE + ch * 128 + (i & 127)] = sum; }
    __syncthreads();
}
__device__ __forceinline__ void sw_item_p0(const Ctx& C, int item) { sw_item_t<false>(C, item); }
__device__ __forceinline__ void sw_item(const Ctx& C, int item) { sw_item_t<true>(C, item); }
__device__ __forceinline__ void phase_p0c(const Ctx& C) {
    for (int vb = C.bid; vb < 256; vb += C.G) {
    if (vb < 240) {
        sw_item_p0(C, vb);
    } else {
        const int t = (vb - 240) * NTHREADS + C.tid, NT = 16 * NTHREADS;
        for (int i = t; i < 4 * 5 * 6144; i += NT) { const int l = i / 30720, c = (i / 6144) % 5, idx = i % 6144; C.f(WS_MOD)[i] = modsum(C, l, c, idx); }
        for (int i = t; i < 4 * 2 * 5 * 1024; i += NT) { const int n = i & 1023, c = (i >> 10) % 5, s = (i / 5120) & 1, l = i / 10240;
            C.f(WS_GMOD)[i] = (s == 0 ? C.in(10) : C.in(11))[l * D + n] * (1.f + modsum(C, l, c, (s == 0 ? 1 : 4) * 1024 + n)); }
    }
    __syncthreads();
    }
    rows_ap_ss(C, C.in(0), C.in(1), C.f(WS_X), 0, 0, false, (u64_t*)(C.ws + WS_SS));
}
__device__ __forceinline__ void phase_glue(const Ctx& C, int l, int s) { rows_ap_ss(C, C.f(WS_X), C.f(WS_X) + (size_t)MP * D, nullptr, l, s, true, (u64_t*)(C.ws + WS_SS) + (size_t)(l * 2 + s) * M); }

__device__ __forceinline__ void phase_conv(const Ctx& C, int l) {
    const bf16_t* h = C.h(WS_SCR); bf16_t* act = C.h(WS_ACT); const float* cw = C.in(29) + (size_t)l * 3 * NUP; const float* cb = C.in(30) + (size_t)l * NUP;
    const int gt = C.bid * NTHREADS + C.tid, NGT = C.G * NTHREADS;
    for (int i = gt; i < M * (DFF / 8); i += NGT) {
        const int r = i / (DFF / 8), n = (i % (DFF / 8)) * 8;
        int t, S; if (r < MP) { t = r & 255; S = 256; } else { t = (r - MP) & 1023; S = 1024; }
        float g[8], v[8];
#pragma unroll
        for (int e = 0; e < 8; ++e) { g[e] = cb[n + e]; v[e] = cb[DFF + n + e]; }
#pragma unroll
        for (int jj = 0; jj < 3; ++jj) { const int tt = t + jj - 1; if (tt >= 0 && tt < S) {
            const u32x4 hg = *(const u32x4*)(h + (size_t)(r + jj - 1) * NUP + n), hv = *(const u32x4*)(h + (size_t)(r + jj - 1) * NUP + DFF + n);
#pragma unroll
            for (int e = 0; e < 4; ++e) { g[2 * e] += cw[jj * NUP + n + 2 * e] * bflo(hg[e]); g[2 * e + 1] += cw[jj * NUP + n + 2 * e + 1] * bfhi(hg[e]);
                v[2 * e] += cw[jj * NUP + DFF + n + 2 * e] * bflo(hv[e]); v[2 * e + 1] += cw[jj * NUP + DFF + n + 2 * e + 1] * bfhi(hv[e]); } } }
        u32x4 o;
#pragma unroll
        for (int e = 0; e < 4; ++e) o[e] = cvtpk(g[2 * e] * sigm(g[2 * e]) * v[2 * e], g[2 * e + 1] * sigm(g[2 * e + 1]) * v[2 * e + 1]);
        *(u32x4*)(act + (size_t)r * DFF + n) = o;
    }
}
__device__ __forceinline__ void phase_final(const Ctx& C, float dbg) {
    const int gw = C.bid * NWAVES + C.wave, NGW = C.G * NWAVES; const u64_t* ss = (const u64_t*)(C.ws + WS_SS) + (size_t)8 * M;
    for (int r = gw; r < M; r += NGW) { const float rs = rstd_of(ss, r);
#pragma unroll
        for (int j = 0; j < 4; ++j) { const int n = 4 * C.lane + 256 * j; float* p = C.out + (size_t)r * D + n; *(f32x4*)p = *(const f32x4*)p * (rs * dbg) * *(const f32x4*)(C.in(32) + n); } }
}
}
namespace om {
__device__ __forceinline__ int rowidx(int r, int h) { return (r & 3) + 8 * (r >> 2) + 4 * h; }
__device__ __forceinline__ float xhalf(float v) {
    auto rr = __builtin_amdgcn_permlane32_swap(__float_as_uint(v), __float_as_uint(v), false, false);
    return __uint_as_float((lane_id() & 32) ? rr[0] : rr[1]);
}
__device__ __forceinline__ bf16x8 pack8(const f32x16& x, int base) {
    u32x4 w; w.x = cvtpk(x[base], x[base + 1]); w.y = cvtpk(x[base + 2], x[base + 3]); w.z = cvtpk(x[base + 4], x[base + 5]); w.w = cvtpk(x[base + 6], x[base + 7]);
    return __builtin_bit_cast(bf16x8, w);
}
typedef short v4i16_t __attribute__((ext_vector_type(4)));
__device__ __forceinline__ u32x2 vtr4(const LAS unsigned char* p) { return __builtin_bit_cast(u32x2, __builtin_amdgcn_ds_read_tr16_b64_v4i16((LAS v4i16_t*)p)); }
__device__ __forceinline__ bf16x8 cat44(u32x2 a, u32x2 b) { u32x4 w = {a.x, a.y, b.x, b.y}; return __builtin_bit_cast(bf16x8, w); }

constexpr int AT_KSTR = 144;
constexpr int AT_BUF = 2 * 64 * AT_KSTR;
__device__ __forceinline__ void attn_unit(const Ctx& C, int j, bool samp, int b, int hq, int qb, size_t obuf) {
    const int lane = C.lane, c = lane & 31, h = lane >> 5, w = C.wave, kvh = hq >> 2;
    const int rowbase = samp ? MP + b * 1024 : b * 256, q0 = qb * 256, qlo = q0 + 32 * w;
    const bf16_t* Q = C.h(SCR_Q); const bf16_t* KB = C.h(SCR_KB); const bf16_t* VB = C.h(SCR_VB);
    const bf16_t* CK = C.h(WS_CTXK) + ((size_t)(b * 2 + j) * 512) * 256; const bf16_t* CV = C.h(WS_CTXV) + ((size_t)(b * 2 + j) * 512) * 256;
    int klo = 0, nlat = 4, NT = 4;
    if (samp) { klo = q0 - 128 < 0 ? 0 : q0 - 128; const int khi = q0 + 384 > 1024 ? 1024 : q0 + 384; nlat = (khi - klo) >> 6; NT = nlat + 8; }
    bf16x8 qf[4];
#pragma unroll
    for (int s = 0; s < 4; ++s) qf[s] = *(const bf16x8*)(Q + (size_t)(rowbase + qlo + c) * D + hq * 64 + 16 * s + 8 * h);
    float m = C.in(14)[j * 16 + hq] * LOG2E, lsum = h == 0 ? 1.f : 0.f;
    f32x16 o0 = {}, o1 = {};
    const int lkey = C.tid >> 3, lch = C.tid & 7;
    auto src_k = [&](int t) -> const bf16_t* { return (t < nlat ? KB + (size_t)(rowbase + klo + 64 * t + lkey) * 256 : CK + (size_t)(64 * (t - nlat) + lkey) * 256) + kvh * 64 + lch * 8; };
    auto src_v = [&](int t) -> const bf16_t* { return (t < nlat ? VB + (size_t)(rowbase + klo + 64 * t + lkey) * 256 : CV + (size_t)(64 * (t - nlat) + lkey) * 256) + kvh * 64 + lch * 8; };
    auto put = [&](int buf, u32x4 kr, u32x4 vr) {
        LAS unsigned char* kb = C.lds + buf * AT_BUF; LAS unsigned char* vb = kb + 64 * AT_KSTR;
        *(LAS u32x4*)(kb + lkey * AT_KSTR + lch * 16) = kr;
        *(LAS u32x4*)(vb + lkey * AT_KSTR + lch * 16) = vr;
    };
    const int vtr_off = (4 * h + ((lane & 15) >> 2)) * AT_KSTR + (16 * ((lane >> 4) & 1) + 4 * (lane & 3)) * 2;
    { const u32x4 kr = *(const u32x4*)src_k(0), vr = *(const u32x4*)src_v(0); put(0, kr, vr); }
    __syncthreads();
    for (int t = 0; t < NT; ++t) {
        u32x4 kr = {}, vr = {};
        if (t + 1 < NT) { kr = *(const u32x4*)src_k(t + 1); vr = *(const u32x4*)src_v(t + 1); }
        const bool lat = samp && t < nlat; const int key0 = klo + 64 * t;
        const bool skip = lat && (key0 > qlo + 31 + 128 || key0 + 63 < qlo - 128);
        if (!skip) {
            LAS unsigned char* kb = C.lds + (t & 1) * AT_BUF; LAS unsigned char* vb = kb + 64 * AT_KSTR;
            f32x16 x0 = {}, x1 = {};
#pragma unroll
            for (int s = 0; s < 4; ++s) {
                const bf16x8 a0 = *(const LAS bf16x8*)(kb + c * AT_KSTR + (16 * s + 8 * h) * 2), a1 = *(const LAS bf16x8*)(kb + (32 + c) * AT_KSTR + (16 * s + 8 * h) * 2);
                x0 = __builtin_amdgcn_mfma_f32_32x32x16_bf16(a0, qf[s], x0, 0, 0, 0); x1 = __builtin_amdgcn_mfma_f32_32x32x16_bf16(a1, qf[s], x1, 0, 0, 0);
            }
            if (lat && !(key0 >= qlo + 31 - 128 && key0 + 63 <= qlo + 128)) {
                const int tq = qlo + c;
#pragma unroll
                for (int r = 0; r < 16; ++r) { const int k0 = key0 + rowidx(r, h) - tq; if (k0 > 128 || k0 < -128) x0[r] = -INFINITY; if (k0 + 32 > 128 || k0 + 32 < -128) x1[r] = -INFINITY; }
            }
            float mx = fmaxf(x0[0], x1[0]);
#pragma unroll
            for (int r = 1; r < 16; ++r) mx = fmaxf(mx, fmaxf(x0[r], x1[r]));
            mx = fmaxf(mx, xhalf(mx));
            const float mn = fmaxf(m, mx), al = __builtin_amdgcn_exp2f(m - mn); m = mn;
            float ps = 0.f;
#pragma unroll
            for (int r = 0; r < 16; ++r) { x0[r] = __builtin_amdgcn_exp2f(x0[r] - mn); x1[r] = __builtin_amdgcn_exp2f(x1[r] - mn); ps += x0[r] + x1[r]; }
            lsum = lsum * al + ps;
#pragma unroll
            for (int r = 0; r < 16; ++r) { o0[r] *= al; o1[r] *= al; }
#pragma unroll
            for (int ks = 0; ks < 2; ++ks) {
                const bf16x8 p0 = pack8(x0, 8 * ks), p1 = pack8(x1, 8 * ks);
#pragma unroll
                for (int dt = 0; dt < 2; ++dt) {
                    const LAS unsigned char* vp = vb + vtr_off + (16 * ks) * AT_KSTR + (32 * dt) * 2;
                    const bf16x8 v0 = cat44(vtr4(vp), vtr4(vp + 8 * AT_KSTR)), v1 = cat44(vtr4(vp + 32 * AT_KSTR), vtr4(vp + 40 * AT_KSTR));
                    if (dt == 0) { o0 = __builtin_amdgcn_mfma_f32_32x32x16_bf16(v0, p0, o0, 0, 0, 0); o0 = __builtin_amdgcn_mfma_f32_32x32x16_bf16(v1, p1, o0, 0, 0, 0); }
                    else { o1 = __builtin_amdgcn_mfma_f32_32x32x16_bf16(v0, p0, o1, 0, 0, 0); o1 = __builtin_amdgcn_mfma_f32_32x32x16_bf16(v1, p1, o1, 0, 0, 0); }
                }
            }
        }
        if (t + 1 < NT) put((t + 1) & 1, kr, vr);
        __syncthreads();
    }
    lsum += xhalf(lsum);
    const float il = 1.f / lsum;
    bf16_t* O = C.h(obuf) + (size_t)(rowbase + qlo + c) * D + hq * 64 + 4 * h;
#pragma unroll
    for (int g = 0; g < 4; ++g) { st_bf16x4(O + 8 * g, (f32x4){o0[4 * g], o0[4 * g + 1], o0[4 * g + 2], o0[4 * g + 3]} * il); st_bf16x4(O + 32 + 8 * g, (f32x4){o1[4 * g], o1[4 * g + 1], o1[4 * g + 2], o1[4 * g + 3]} * il); }
}
__device__ __forceinline__ void phase_attn(const Ctx& C, int l, size_t obuf) {
    const int j = l / 3;
    for (int u = C.bid; u < 512; u += C.G) {
        if (u < 256) attn_unit(C, j, false, u >> 4, u & 15, 0, obuf);
        else { const int v = u - 256; attn_unit(C, j, true, v >> 6, (v >> 2) & 15, v & 3, obuf); }
    }
}
constexpr size_t CKS_TAB = 376 * MiB; constexpr int CKS_NW = (int)((268 * MiB) / 65536), CKS_NO = (17039360 * 4) / 65536, CKS_N = CKS_NW + CKS_NO;
__device__ __forceinline__ void phase_cks(const Ctx& C, int slot) {
    const int gw = C.bid * NWAVES + C.wave, NGW = C.G * NWAVES; unsigned* tab = (unsigned*)(C.ws + CKS_TAB) + (size_t)slot * 8192;
    for (int ck = gw; ck < CKS_N; ck += NGW) {
        const unsigned char* base = ck < CKS_NW ? C.ws + 108 * MiB + (size_t)ck * 65536 : (const unsigned char*)C.out + (size_t)(ck - CKS_NW) * 65536; unsigned s = 0;
        for (int i = 0; i < 64; ++i) { const u32x4 v = *(const u32x4*)(base + (size_t)i * 1024 + C.lane * 16); s += v[0] + v[1] * 3u + v[2] * 5u + v[3] * 7u; }
#pragma unroll
        for (int o = 1; o < 64; o <<= 1) s += (unsigned)__shfl_xor((int)s, o);
        if (C.lane == 0) tab[ck] = s;
    }
}
__device__ __forceinline__ void phase_clr(const Ctx& C) {
    const int gt = C.bid * NTHREADS + C.tid, NGT = C.G * NTHREADS; unsigned z0 = 0u; asm volatile("" : "+v"(z0)); const u32x4 z = {z0, z0, z0, z0};
    for (size_t i = gt; i < (268 * MiB) / 16; i += NGT) *(u32x4*)(C.ws + 108 * MiB + i * 16) = z;
    for (size_t i = gt; i < (size_t)17039360 / 4; i += NGT) *(u32x4*)((unsigned char*)C.out + i * 16) = z;
}
__device__ __forceinline__ void phase_clr2(const Ctx& C, size_t off, size_t bytes) {
    const int gt = C.bid * NTHREADS + C.tid, NGT = C.G * NTHREADS; unsigned z0 = 0u; asm volatile("" : "+v"(z0)); const u32x4 z = {z0, z0, z0, z0};
    for (size_t i = gt; i < bytes / 16; i += NGT) *(u32x4*)(C.ws + off + i * 16) = z;
}
__device__ __forceinline__ void phase_cmp(const Ctx& C, int nslots) {
    const int gt = C.bid * NTHREADS + C.tid, NGT = C.G * NTHREADS; const unsigned* tab = (const unsigned*)(C.ws + CKS_TAB);
    for (int i = gt; i < nslots * 8192; i += NGT) { const int sl = i >> 13, ck = i & 8191; if (ck < CKS_N && tab[(size_t)sl * 8192 + ck] != tab[(size_t)(sl + 32) * 8192 + ck]) {
#ifdef SSDET
        const int cls = ck >= CKS_NW ? 4 : (ck < 1472 + 512 ? 1 : 2); atomicOr((unsigned*)(C.ws + WS_CTL) + 4002, (unsigned)cls); atomicAdd((unsigned*)(C.ws + WS_CTL) + 4003, 1u);
#endif
        atomicMax((unsigned*)(C.ws + WS_CTL) + 4001, (unsigned)(1000 - sl)); } }
}
__device__ __forceinline__ void phase_chk(const Ctx& C, size_t a, size_t b, size_t bytes) {
    const int gt = C.bid * NTHREADS + C.tid, NGT = C.G * NTHREADS; unsigned bad = 0;
    for (size_t i = gt; i < bytes / 16; i += NGT) { const u32x4 x = *(const u32x4*)(C.ws + a + i * 16), y = *(const u32x4*)(C.ws + b + i * 16); bad += (x[0] != y[0]) | (x[1] != y[1]) | (x[2] != y[2]) | (x[3] != y[3]); }
    if (bad) atomicAdd((unsigned*)(C.ws + WS_CTL) + 4000, bad);
}

constexpr int HS_QSTR = 272, HS_TSTR = 80;
constexpr int HS_QT = 0, HS_KT = 32 * HS_QSTR, HS_KTT = 2 * 32 * HS_QSTR, HS_VT = HS_KTT + 128 * HS_TSTR, HS_E1 = HS_VT + 128 * HS_TSTR, HS_E2 = HS_E1 + 512, HS_T1 = HS_E2 + 512, HS_GRP = HS_T1 + 512;
__device__ __forceinline__ void hscan_item(const Ctx& C, int item) {
    const bool samp = item < 64; const int it = samp ? item : item - 64;
    const int dir = it & 1, hd = (it >> 1) & 7, sq = it >> 4;
    const int S = samp ? 1024 : 256, rowbase = samp ? MP + sq * 1024 : sq * 256, nchunk = S >> 5;
    const int tg = C.tid & 255, lane = C.lane, c = lane & 31, h = lane >> 5, w4 = C.wave & 3; const bool producer = C.wave >= 4;
    LAS unsigned char* L = C.lds;
    const bf16_t* HQ = C.h(SCR_HQ); const bf16_t* HV = C.h(SCR_HV); const float* LF = C.f(dir == 0 ? SCR_LFF : SCR_LFB); float* OD = C.f(dir == 0 ? SCR_OF : SCR_OB);
    const int pd = tg & 127, ph = tg >> 7;
    unsigned qw[8], kw[8], vtw[8]; float e1v = 0.f, e2v = 0.f;
    float rlf[16], rpre[16]; unsigned rq[16], rv[16];
    auto issue = [&](int ch) {
#pragma unroll
        for (int i = 0; i < 16; ++i) { const int pos = 32 * ch + 16 * ph + i, t = dir == 0 ? pos : S - 1 - pos; const size_t off = (size_t)(rowbase + t) * D + hd * 128 + pd;
            rlf[i] = LF[off]; rq[i] = HQ[off]; rv[i] = HV[off];
            const int pos2 = 32 * ch + i, t2 = dir == 0 ? pos2 : S - 1 - pos2; rpre[i] = ph == 1 ? LF[(size_t)(rowbase + t2) * D + hd * 128 + pd] : 0.f; }
    };
    auto compute = [&]() {
        float cl[16]; float pre = 0.f, run = 0.f;
#pragma unroll
        for (int i = 0; i < 16; ++i) { pre += rpre[i]; run += rlf[i]; cl[i] = run; }
        const float t1v = ph == 0 ? cl[15] : pre;
#pragma unroll
        for (int i = 0; i < 16; i += 2) {
            const float e0 = ph == 0 ? cl[i] - t1v : cl[i], e1 = ph == 0 ? cl[i + 1] - t1v : cl[i + 1];
            const float k0 = 1.f - __expf(rlf[i]), k1 = 1.f - __expf(rlf[i + 1]);
            qw[i >> 1] = cvtpk(__uint_as_float(rq[i] << 16) * __expf(e0), __uint_as_float(rq[i + 1] << 16) * __expf(e1)); kw[i >> 1] = cvtpk(k0 * __expf(-e0), k1 * __expf(-e1));
            vtw[i >> 1] = rv[i] | (rv[i + 1] << 16); }
        e1v = __expf(t1v); e2v = __expf(cl[15]);
    };
    auto put = [&]() {
#pragma unroll
        for (int i = 0; i < 8; ++i) {
            *(LAS unsigned short*)(L + HS_QT + (16 * ph + 2 * i) * HS_QSTR + pd * 2) = (unsigned short)(qw[i] & 0xffffu); *(LAS unsigned short*)(L + HS_QT + (16 * ph + 2 * i + 1) * HS_QSTR + pd * 2) = (unsigned short)(qw[i] >> 16);
            *(LAS unsigned short*)(L + HS_KT + (16 * ph + 2 * i) * HS_QSTR + pd * 2) = (unsigned short)(kw[i] & 0xffffu); *(LAS unsigned short*)(L + HS_KT + (16 * ph + 2 * i + 1) * HS_QSTR + pd * 2) = (unsigned short)(kw[i] >> 16); }
        *(LAS u32x4*)(L + HS_KTT + pd * HS_TSTR + ph * 32) = (u32x4){kw[0], kw[1], kw[2], kw[3]}; *(LAS u32x4*)(L + HS_KTT + pd * HS_TSTR + ph * 32 + 16) = (u32x4){kw[4], kw[5], kw[6], kw[7]};
        *(LAS u32x4*)(L + HS_VT + pd * HS_TSTR + ph * 32) = (u32x4){vtw[0], vtw[1], vtw[2], vtw[3]}; *(LAS u32x4*)(L + HS_VT + pd * HS_TSTR + ph * 32 + 16) = (u32x4){vtw[4], vtw[5], vtw[6], vtw[7]};
        if (ph == 0) *(LAS float*)(L + HS_E1 + pd * 4) = e1v; else *(LAS float*)(L + HS_E2 + pd * 4) = e2v;
    };
    if (producer) {
        issue(0); compute(); if (nchunk > 1) issue(1);
        for (int ch = 0; ch < nchunk; ++ch) {
            put();
            __syncthreads();
            if (ch + 1 < nchunk) { compute(); if (ch + 2 < nchunk) issue(ch + 2); }
            __syncthreads();
        }
        return;
    }
    f32x16 St[4];
#pragma unroll
    for (int dt = 0; dt < 4; ++dt) {
        if (samp) { const float* s0 = C.in(4) + ((((size_t)sq * 2 + dir) * 8 + hd) * 128) * 128;
#pragma unroll
            for (int r = 0; r < 16; ++r) St[dt][r] = s0[(size_t)(32 * dt + rowidx(r, h)) * 128 + 32 * w4 + c]; }
        else St[dt] = (f32x16){};
    }
    for (int ch = 0; ch < nchunk; ++ch) {
        __syncthreads();
#pragma unroll
        for (int dt = 0; dt < 4; ++dt)
#pragma unroll
            for (int g = 0; g < 4; ++g) { const f32x4 e = *(const LAS f32x4*)(L + HS_E1 + (32 * dt + 8 * g + 4 * h) * 4);
#pragma unroll
                for (int q = 0; q < 4; ++q) St[dt][4 * g + q] *= e[q]; }
        f32x16 X = {};
#pragma unroll
        for (int s = 0; s < 8; ++s) {
            const bf16x8 a = *(const LAS bf16x8*)(L + HS_KT + c * HS_QSTR + (16 * s + 8 * h) * 2), bq = *(const LAS bf16x8*)(L + HS_QT + c * HS_QSTR + (16 * s + 8 * h) * 2);
            X = __builtin_amdgcn_mfma_f32_32x32x16_bf16(a, bq, X, 0, 0, 0);
        }
#pragma unroll
        for (int r = 0; r < 16; ++r) if (rowidx(r, h) > c) X[r] = 0.f;
        f32x16 OT = {};
#pragma unroll
        for (int ks = 0; ks < 2; ++ks) {
            const LAS unsigned char* vrow = L + HS_VT + (32 * w4 + c) * HS_TSTR + (16 * ks + 4 * h) * 2;
            const bf16x8 va = cat44(*(const LAS u32x2*)(vrow), *(const LAS u32x2*)(vrow + 16));
            OT = __builtin_amdgcn_mfma_f32_32x32x16_bf16(va, pack8(X, 8 * ks), OT, 0, 0, 0);
        }
#pragma unroll
        for (int dt = 0; dt < 4; ++dt)
#pragma unroll
            for (int ks = 0; ks < 2; ++ks) {
                const LAS unsigned char* qrow = L + HS_QT + c * HS_QSTR + (32 * dt + 16 * ks + 4 * h) * 2;
                const bf16x8 bq = cat44(*(const LAS u32x2*)(qrow), *(const LAS u32x2*)(qrow + 16));
                OT = __builtin_amdgcn_mfma_f32_32x32x16_bf16(pack8(St[dt], 8 * ks), bq, OT, 0, 0, 0);
            }
#pragma unroll
        for (int dt = 0; dt < 4; ++dt)
#pragma unroll
            for (int ks = 0; ks < 2; ++ks) {
                const bf16x8 a = *(const LAS bf16x8*)(L + HS_KTT + (32 * dt + c) * HS_TSTR + (16 * ks + 8 * h) * 2), bv = *(const LAS bf16x8*)(L + HS_VT + (32 * w4 + c) * HS_TSTR + (16 * ks + 8 * h) * 2);
                St[dt] = __builtin_amdgcn_mfma_f32_32x32x16_bf16(a, bv, St[dt], 0, 0, 0);
            }
#pragma unroll
        for (int dt = 0; dt < 4; ++dt)
#pragma unroll
            for (int g = 0; g < 4; ++g) { const f32x4 e = *(const LAS f32x4*)(L + HS_E2 + (32 * dt + 8 * g + 4 * h) * 4);
#pragma unroll
                for (int q = 0; q < 4; ++q) St[dt][4 * g + q] *= e[q]; }
        { const int pos = 32 * ch + c, t = dir == 0 ? pos : S - 1 - pos; float* op = OD + (size_t)(rowbase + t) * D + hd * 128 + 32 * w4 + 4 * h;
#pragma unroll
            for (int g = 0; g < 4; ++g) *(f32x4*)(op + 8 * g) = (f32x4){OT[4 * g], OT[4 * g + 1], OT[4 * g + 2], OT[4 * g + 3]}; }
        __syncthreads();
    }
    if (!samp) { float* so = C.out + 8388608 + 2 * 2097152 + ((((size_t)sq * 2 + dir) * 8 + hd) * 128) * 128;
        int c2 = c, h2 = h; asm volatile("" : "+v"(c2), "+v"(h2));
        unsigned base = (unsigned)((4 * h2) * 128 + 32 * w4 + c2);
#pragma unroll
        for (int dt = 0; dt < 4; ++dt)
#pragma unroll
            for (int r = 0; r < 16; ++r) so[base + (unsigned)((32 * dt + (r & 3) + 8 * (r >> 2)) * 128)] = St[dt][r]; }
}
__device__ __forceinline__ void phase_hscan(const Ctx& C) {
    if (C.G == 256) {
        hscan_item(C, C.bid);
        if (C.bid >= 64 && C.bid < 128) hscan_item(C, 256 + (C.bid - 64));
    } else for (int it = C.bid; it < 320; it += C.G) hscan_item(C, it);
}
__device__ __forceinline__ void phase_hpost(const Ctx& C) {
    const int gw = C.bid * NWAVES + C.wave, NGW = C.G * NWAVES;
    for (int r = gw; r < M; r += NGW) {
        const size_t off = (size_t)r * D + 16 * C.lane; float o[16]; float sq = 0.f;
#pragma unroll
        for (int q = 0; q < 4; ++q) { const f32x4 a = *(const f32x4*)(C.f(SCR_OF) + off + 4 * q), b = *(const f32x4*)(C.f(SCR_OB) + off + 4 * q);
#pragma unroll
            for (int e = 0; e < 4; ++e) { o[4 * q + e] = a[e] + b[e]; sq += o[4 * q + e] * o[4 * q + e]; } }
        sq += __shfl_xor(sq, 1); sq += __shfl_xor(sq, 2); sq += __shfl_xor(sq, 4);
        const float rs = rsqrtf(sq * (1.f / 128.f) + EPS);
        const u32x4 g0 = *(const u32x4*)(C.h(SCR_HG) + off), g1 = *(const u32x4*)(C.h(SCR_HG) + off + 8);
        const float* gn = C.in(17) + (16 * C.lane & 127);
        float sg[16];
#pragma unroll
        for (int e = 0; e < 4; ++e) { sg[2 * e] = bflo(g0[e]); sg[2 * e + 1] = bfhi(g0[e]); sg[8 + 2 * e] = bflo(g1[e]); sg[8 + 2 * e + 1] = bfhi(g1[e]); }
        u32x4 w0, w1;
#pragma unroll
        for (int e = 0; e < 4; ++e) { w0[e] = cvtpk(o[2 * e] * rs * gn[2 * e] * sg[2 * e], o[2 * e + 1] * rs * gn[2 * e + 1] * sg[2 * e + 1]);
            w1[e] = cvtpk(o[8 + 2 * e] * rs * gn[8 + 2 * e] * sg[8 + 2 * e], o[8 + 2 * e + 1] * rs * gn[8 + 2 * e + 1] * sg[8 + 2 * e + 1]); }
        *(u32x4*)(C.h(SCR_AWO) + off) = w0; *(u32x4*)(C.h(SCR_AWO) + off + 8) = w1;
    }
}

constexpr int SS_RSTR = 512;
constexpr int SS_WAVE = 16 * SS_RSTR;
__device__ __forceinline__ void sscan_seq(const Ctx& C, int l, bool samp, int sq, int dir, int g, size_t ydbg) {
    const int lane = C.lane, c = lane & 31, h = lane >> 5, dg = dir * 64 + g;
    const int S = samp ? 1024 : 256, rowbase = samp ? MP + sq * 1024 : sq * 256, nchunk = S >> 5, cond = samp ? 1 + sq : 0;
    LAS unsigned char* LB = C.lds + C.wave * SS_WAVE; LAS unsigned char* LH = LB + 4096;
    const float* X = C.f(WS_X); const u64_t* ss = (const u64_t*)(C.ws + WS_SS) + (size_t)(l * 2) * M; float* Y = C.f(ydbg ? ydbg : (dir == 0 ? SCR_YF : SCR_YB)); const bool ywr = !ydbg || dir == 0;
    bf16x8 bfr[4], cfr[4];
#pragma unroll
    for (int ct = 0; ct < 4; ++ct) bfr[ct] = *(const bf16x8*)(C.h(WS_SBB) + ((size_t)dg * 128 + 32 * ct + c) * 16 + 8 * h);
#pragma unroll
    for (int s = 0; s < 4; ++s) cfr[s] = *(const bf16x8*)(C.h(WS_SCB) + ((size_t)dg * 16 + (lane & 15)) * 128 + 32 * s + 8 * (lane >> 4));
    const float lr = C.f(WS_SLAM)[2 * (dg * 64 + lane)], li = C.f(WS_SLAM)[2 * (dg * 64 + lane) + 1];
    f32x4 gm0, gm1, sh0, sh1;
    { const float* gm = C.f(WS_GMOD) + ((size_t)(l * 2) * 5 + cond) * 1024 + g * 16 + 8 * h; gm0 = *(const f32x4*)gm; gm1 = *(const f32x4*)(gm + 4);
      const float* sh = C.f(WS_MOD) + ((size_t)l * 5 + cond) * 6144 + g * 16 + 8 * h; sh0 = *(const f32x4*)sh; sh1 = *(const f32x4*)(sh + 4); }
    float hr = 0.f, hi = 0.f;
    if (samp) { const float* s0 = C.in(5) + ((((size_t)sq * 2 + dir) * 64 + g) * 64 + lane) * 2; hr = s0[0]; hi = s0[1]; }
    for (int ch = 0; ch < nchunk; ++ch) {
        const int pos = 32 * ch + c, t = dir == 0 ? pos : S - 1 - pos, r = rowbase + t;
        const float rs = rstd_of(ss, r);
        const f32x4 x0 = *(const f32x4*)(X + (size_t)r * D + g * 16 + 8 * h), x1 = *(const f32x4*)(X + (size_t)r * D + g * 16 + 8 * h + 4);
        const f32x4 u0 = x0 * rs * gm0 + sh0, u1 = x1 * rs * gm1 + sh1;
        u32x4 uw = {cvtpk(u0[0], u0[1]), cvtpk(u0[2], u0[3]), cvtpk(u1[0], u1[1]), cvtpk(u1[2], u1[3])};
        const bf16x8 uf = __builtin_bit_cast(bf16x8, uw);
        f32x16 bu[4];
#pragma unroll
        for (int ct = 0; ct < 4; ++ct) { bu[ct] = (f32x16){}; bu[ct] = __builtin_amdgcn_mfma_f32_32x32x16_bf16(uf, bfr[ct], bu[ct], 0, 0, 0); }
#pragma unroll
        for (int hf = 0; hf < 2; ++hf) {
#pragma unroll
            for (int t8 = 0; t8 < 2; ++t8) {
#pragma unroll
                for (int ct = 0; ct < 4; ++ct)
#pragma unroll
                    for (int r4 = 0; r4 < 4; ++r4) *(LAS float*)(LB + (4 * h + r4) * 512 + (32 * ct + c) * 4) = bu[ct][8 * hf + 4 * t8 + r4];
                float br[8], bi[8]; unsigned wv[8];
#pragma unroll
                for (int k = 0; k < 8; ++k) { br[k] = *(LAS float*)(LB + k * 512 + lane * 4); bi[k] = *(LAS float*)(LB + k * 512 + 256 + lane * 4); }
#pragma unroll
                for (int k = 0; k < 8; ++k) { const float nr = lr * hr - li * hi + br[k], ni = lr * hi + li * hr + bi[k]; hr = nr; hi = ni; wv[k] = cvtpk(hr, hi); }
#pragma unroll
                for (int k = 0; k < 8; ++k) { const int row = 8 * t8 + k;
                    *(LAS unsigned short*)(LH + row * 256 + ((((lane >> 3)) ^ row) << 4) + (lane & 7) * 2) = (unsigned short)(wv[k] & 0xffffu);
                    *(LAS unsigned short*)(LH + row * 256 + (((8 + (lane >> 3)) ^ row) << 4) + (lane & 7) * 2) = (unsigned short)(wv[k] >> 16); }
                LDS_WAIT();
            }
            f32x4 y0 = {};
#pragma unroll
            for (int s = 0; s < 4; ++s) {
                const bf16x8 a0 = *(const LAS bf16x8*)(LH + (lane & 15) * 256 + (((4 * s + (lane >> 4)) ^ (lane & 15)) << 4));
                y0 = __builtin_amdgcn_mfma_f32_16x16x32_bf16(a0, cfr[s], y0, 0, 0, 0);
            }
            if (ywr) {
#pragma unroll
                for (int q = 0; q < 4; ++q) { const int p0 = 32 * ch + 16 * hf + 4 * (lane >> 4) + q, t0 = dir == 0 ? p0 : S - 1 - p0; Y[(size_t)(rowbase + t0) * D + g * 16 + (lane & 15)] = y0[q]; }
            }
            LDS_WAIT();
        }
    }
    if (!samp && !ydbg) { float* so = C.out + 8388608 + 2 * 2097152 + 4194304 + ((((size_t)sq * 2 + dir) * 64 + g) * 64 + lane) * 2; so[0] = hr; so[1] = hi; }
}
__device__ __forceinline__ void phase_sscan(const Ctx& C, int l, size_t ydbg) {
    for (int bb = C.bid; bb < 256; bb += C.G) {
        const int w = C.wave;
#ifdef SS_ONLYWAVE
        if (ydbg && !((SS_ONLYWAVE >> w) & 1)) continue;
#endif
        if (w < 2) { const int id = 2 * bb + w; sscan_seq(C, l, true, id >> 7, (id >> 6) & 1, id & 63, ydbg); }
        else { int id = 8 * bb + (w - 2); sscan_seq(C, l, false, id >> 7, (id >> 6) & 1, id & 63, ydbg);
            if (w < 4) { id = 8 * bb + 6 + (w - 2); sscan_seq(C, l, false, id >> 7, (id >> 6) & 1, id & 63, ydbg); } }
    }
}
__device__ __forceinline__ void phase_spost(const Ctx& C, int l) {
    const int gw = C.bid * NWAVES + C.wave, NGW = C.G * NWAVES; const u64_t* ss = (const u64_t*)(C.ws + WS_SS) + (size_t)(l * 2) * M;
    for (int r = gw; r < M; r += NGW) {
        const int cond = cond_of_row(r); const float rs = rstd_of(ss, r);
#pragma unroll
        for (int jq = 0; jq < 4; ++jq) {
            const int n = 4 * C.lane + 256 * jq; const size_t off = (size_t)r * D + n;
            const f32x4 x = *(const f32x4*)(C.f(WS_X) + off), gm = *(const f32x4*)(C.f(WS_GMOD) + ((size_t)(l * 2) * 5 + cond) * 1024 + n), sh = *(const f32x4*)(C.f(WS_MOD) + ((size_t)l * 5 + cond) * 6144 + n);
            const f32x4 u = x * rs * gm + sh, y = *(const f32x4*)(C.in(26) + n) * u + *(const f32x4*)(C.f(SCR_YF) + off) + *(const f32x4*)(C.f(SCR_YB) + off);
            f32x4 o;
#pragma unroll
            for (int e = 0; e < 4; ++e) { const float v = y[e], uu = 0.7978845608028654f * (v + 0.044715f * v * v * v); const float th = 1.f - 2.f * __builtin_amdgcn_rcpf(1.f + __expf(2.f * uu)); o[e] = 0.5f * v * (1.f + th); }
            st_bf16x4(C.h(SCR_AGLU) + off, o);
        }
    }
}
#define XB_TMO      128
#define XB_XCNT(j)  (256  + 64 * (j))
#define XB_XSUB(j)  (1280 + 64 * (j))
#define XB_XGEN(j)  (2304 + 64 * (j))
#define XB_TOP      3328
#define XB_TOPGEN   3392
#define XCD_BAR_WORDS 3456
#define XB_SPIN_CAP (1u << 18)
#ifndef XB_SCOPE
#define XB_SCOPE "agent"
#endif
__device__ __forceinline__ unsigned xb_ld(unsigned* p)              { return __hip_atomic_load(p, __ATOMIC_RELAXED, __HIP_MEMORY_SCOPE_AGENT); }
__device__ __forceinline__ unsigned xb_add(unsigned* p, unsigned v) { return __hip_atomic_fetch_add(p, v, __ATOMIC_RELAXED, __HIP_MEMORY_SCOPE_AGENT); }
__device__ __forceinline__ unsigned xb_xcc_id() { return (unsigned)__builtin_amdgcn_s_getreg((3 << 11) | 20) & 0xFu; }
#define XB_SPIN(cond, bar) do { unsigned _sp = 0; while (cond) { __builtin_amdgcn_s_sleep(1); \
    if ((++_sp & 255u) == 0u) { if (xb_ld(&(bar)[XB_TMO])) break; if (_sp > XB_SPIN_CAP) { atomicAdd(&(bar)[XB_TMO], 1u); break; } } } } while (0)
struct XcdBarrier { unsigned* bar; unsigned x; volatile LAS unsigned* st; };
__device__ __forceinline__ XcdBarrier xcd_barrier_post(unsigned* bar, volatile LAS unsigned* st) {
    XcdBarrier b; b.bar = bar; b.x = xb_xcc_id(); b.st = st;
    if (threadIdx.x == 0) (void)xb_add(&bar[XB_XCNT(b.x)], 1u);
    return b;
}
__device__ __forceinline__ void xcd_barrier_complete(unsigned* bar, unsigned x, unsigned& nloc, unsigned& nx) {
    const unsigned G = gridDim.x * gridDim.y * gridDim.z;
    unsigned sum, cnt, mine, sp = 0u;
    for (;;) {
        sum = 0u; cnt = 0u; mine = 0u;
#pragma unroll
        for (unsigned j = 0; j < 16; ++j) { const unsigned c = xb_ld(&bar[XB_XCNT(j)]); sum += c; cnt += (c > 0u) ? 1u : 0u; mine = (j == x) ? c : mine; }
        if (sum == G) break;
        __builtin_amdgcn_s_sleep(1);
        if ((++sp & 255u) == 0u) { if (xb_ld(&bar[XB_TMO])) break; if (sp > XB_SPIN_CAP) { atomicAdd(&bar[XB_TMO], 1u); break; } }
    }
    nloc = mine > 0u ? mine : 1u; nx = cnt > 0u ? cnt : 1u;
}
__device__ __forceinline__ void xcd_barrier(const XcdBarrier& b, bool thread0) {
    asm volatile("s_waitcnt vmcnt(0)" ::: "memory");
    __syncthreads();
    if (thread0) {
        unsigned* bar = b.bar;
        __builtin_amdgcn_s_waitcnt(0);
        unsigned nloc = b.st[0], nx = b.st[1];
        if (nloc == 0u) { xcd_barrier_complete(bar, b.x, nloc, nx); b.st[0] = nloc; b.st[1] = nx; }
#ifdef XB_EARLY_WB
        asm volatile("buffer_wbl2 sc1" ::: "memory");
#endif
        const unsigned old = xb_add(&bar[XB_XSUB(b.x)], 1u);
        const unsigned gen = old / nloc;
        if (old + 1u == (gen + 1u) * nloc) {
            __builtin_amdgcn_fence(__ATOMIC_RELEASE, XB_SCOPE);
            asm volatile("s_waitcnt vmcnt(0)" ::: "memory");
            const unsigned og = xb_add(&bar[XB_TOP], 1u);
            const unsigned tg = og / nx;
            __builtin_amdgcn_fence(__ATOMIC_ACQUIRE, XB_SCOPE);
            if (og + 1u == (tg + 1u) * nx) xb_add(&bar[XB_TOPGEN], 1u);
            else XB_SPIN(xb_ld(&bar[XB_TOPGEN]) == tg, bar);
            xb_add(&bar[XB_XGEN(b.x)], 1u);
            asm volatile("s_waitcnt vmcnt(0)" ::: "memory");
        } else {
            __builtin_amdgcn_fence(__ATOMIC_ACQUIRE, XB_SCOPE);
            XB_SPIN(xb_ld(&bar[XB_XGEN(b.x)]) == gen, bar);
            asm volatile("s_waitcnt vmcnt(0)" ::: "memory");
        }
#ifdef XB_DELAY
        for (int q = 0; q < XB_DELAY; ++q) __builtin_amdgcn_s_sleep(127);
#endif
    }
    __syncthreads();
}
}
namespace om {
enum { PH_P0A = 0, PH_P0C, PH_GLUE, PH_QKV, PH_ATTN, PH_WO, PH_HIN, PH_HSCAN, PH_HPOST, PH_HWO, PH_SSCAN, PH_SPOST, PH_GLU, PH_UP, PH_CONV, PH_DOWN, PH_FINAL };

struct Args { const float* in[33]; float* out; unsigned char* ws; int nph; int pad; unsigned char ptype[160]; unsigned char parg[160]; };
static_assert(offsetof(Args, ptype) == 288 && offsetof(Args, parg) == 448, "Args layout");

__device__ __forceinline__ void down_patch(const Ctx& C, int l, const pg8::StaticOrder& S) {
    Unit u; const float* cw = C.in(29) + (size_t)l * 3 * NUP; const float* E0 = C.f(WS_EDGE); bf16_t* act = C.h(WS_ACT);
    for (int i = 0; S.next(i, u); ++i) {
        if (u.pm < 16) continue;
        const bool top = (u.pm & 3) != 0, bot = (u.pm & 3) != 3;
        for (int n = C.tid; n < DFF; n += NTHREADS) {
            if (top) { const float* e = E0 + ((size_t)((u.pm - 16) * 2 + 0) * 4) * DFF; const float* ep = E0 + ((size_t)((u.pm - 17) * 2 + 1) * 4) * DFF;
                const float hg = e[n] + cw[n] * ep[2 * DFF + n], hv = e[DFF + n] + cw[DFF + n] * ep[3 * DFF + n];
                act[(size_t)(u.pm * 256) * DFF + n] = (bf16_t)(cvtpk(hg * sigm(hg) * hv, 0.f) & 0xffffu); }
            if (bot) { const float* e = E0 + ((size_t)((u.pm - 16) * 2 + 1) * 4) * DFF; const float* en = E0 + ((size_t)((u.pm - 15) * 2 + 0) * 4) * DFF;
                const float hg = e[n] + cw[2 * NUP + n] * en[2 * DFF + n], hv = e[DFF + n] + cw[2 * NUP + DFF + n] * en[3 * DFF + n];
                act[(size_t)(u.pm * 256 + 255) * DFF + n] = (bf16_t)(cvtpk(hg * sigm(hg) * hv, 0.f) & 0xffffu); }
        }
    }
    asm volatile("s_waitcnt vmcnt(0)" ::: "memory"); __syncthreads();
}
__device__ __forceinline__ void run_phase(const Ctx& C0, int type, int arg, int epoch) {
    Ctx C = C0; asm volatile("" : "+v"(C.tid)); asm volatile("" : "+s"(C.bid), "+s"(C.G), "+s"(C.kp), "+s"(C.ws), "+s"(C.out));
    C.lane = C.tid & 63; C.wave = __builtin_amdgcn_readfirstlane(C.tid >> 6);
    const int l = arg & 3;
    if (type == 31) return;
#ifndef PHASE_MASK
#define PHASE_MASK 0xFFFFFFFFu
#endif
    if (!((PHASE_MASK >> type) & 1u)) return;
    pg8::Gemm g{nullptr, nullptr, D, 256, 128, D, 0}; int nN = 0; EpiAny E{}; E.ws = C.ws; E.out = C.out; E.l = l; E.epoch = epoch;
    const bool splitk = false;
    switch (type) {
    case PH_P0A: phase_p0a(C); break;
    case PH_P0C: phase_p0c(C); break;
    case PH_GLUE: phase_glue(C, arg >> 1, arg & 1); break;
    case PH_QKV: { g.A = C.h(WS_AP); g.Bt = C.h(WS_WQKV) + (size_t)(l / 3) * NQKV * D; nN = 6; E.kind = EK_QKV; } break;
    case PH_ATTN: phase_attn(C, l, (arg & 32) ? SCR_O + 96 * MiB : SCR_O); break;
#ifdef DBG
    case 17: phase_chk(C, SCR_O, SCR_O + 96 * MiB, 16 * MiB); break;
#endif
#ifdef DBG
    case 18: phase_cks(C, arg); break;
#endif
#ifdef DBG
    case 19: phase_cmp(C, arg); break;
#endif
#ifdef DBG
    case 20: phase_clr(C); break;
#endif
    case PH_WO: case PH_HWO: case PH_GLU: {
        if (type == PH_WO) { g.A = C.h(SCR_O); g.Bt = C.h(WS_WO) + (size_t)(l / 3) * D * D; nN = 4; E.kind = EK_RES; if (splitk) { g.split = 1; g.K = D / 2; nN = 8; } }
        else if (type == PH_HWO) { g.A = C.h(SCR_AWO); g.Bt = C.h(WS_HWO); nN = 4; E.kind = EK_RES; if (splitk) { g.split = 1; g.K = D / 2; nN = 8; } }
        else { g.A = C.h(SCR_AGLU); g.Bt = C.h(WS_GLU); g.b_tile_rows = 128; g.b_half_rows = 1024; nN = 8; E.kind = EK_RES_GLU; }
        E.flags = ((arg & 32) ? 4 : 0) | (type == PH_HWO ? 8 : 0); } break;
    case PH_HIN: { g.A = C.h(WS_AP); g.Bt = C.h(WS_HWIN); nN = (C.G == 256) ? 16 : 20; E.kind = EK_HIN; } break;
    case PH_HSCAN: { phase_hscan(C);
        if (C.G == 256 && C.bid >= 128) {
            __syncthreads();
            g.A = C.h(WS_AP); g.Bt = C.h(WS_HWIN) + (size_t)4096 * D; E.kind = EK_HIN; E.pn_off = 16;
            pg8::StaticOrder S; S.init(32, 4, 128, C.bid - 128); pg8::gemm_phase(C.lds, g, S, E, C.tid); } } break;
    case PH_HPOST: phase_hpost(C); break;
    case PH_SSCAN: phase_sscan(C, l, (arg & 32) ? WS_SCR + 80 * MiB : ((arg & 64) ? WS_SCR + 112 * MiB : 0)); break;
#ifdef DBG
    case 22: phase_clr2(C, WS_SCR + 80 * MiB, 64 * MiB); break;
#endif
#ifdef DBG
    case 21: phase_chk(C, WS_SCR + 80 * MiB, WS_SCR + 112 * MiB, 32 * MiB); break;
#endif
    case PH_SPOST: phase_spost(C, l); break;
    case PH_UP: { g.A = C.h(WS_AP); g.Bt = C.h(WS_UP) + (size_t)l * NUP * D; g.b_tile_rows = 128; g.b_half_rows = DFF; nN = 22; E.kind = EK_UPCONV; E.in29 = C.in(29); E.in30 = C.in(30); E.xl = C.lds + RING_BYTES; } break;
#ifdef DBG
    case 23: phase_chk(C, WS_SCR, WS_SCR + 88 * MiB, 88 * MiB); break;
#endif
    case PH_CONV: phase_conv(C, l); break;
    case PH_DOWN: { if (l < 3 && C.G == 256 && C.bid >= 128) convert_layer(C, l + 1, C.bid - 128, 128);
        { pg8::StaticOrder S0; S0.init(32, splitk ? 8 : 4, C.G, C.bid); down_patch(C, l, S0); }
        g.A = C.h(WS_ACT); g.Bt = C.h(WS_DOWN) + (size_t)l * D * DFF; g.K = DFF; g.ld = DFF; nN = 4; if (splitk) { g.split = 1; g.K = DFF / 2; nN = 8; } E.kind = EK_RES; E.flags = 1 | ((arg & 16) ? 2 : 0) | ((arg & 32) ? 4 : 0); } break;
    case PH_FINAL: { const unsigned fl = __hip_atomic_load((unsigned*)(C.ws + WS_CTL) + 4000, __ATOMIC_RELAXED, __HIP_MEMORY_SCOPE_AGENT), fd = __hip_atomic_load((unsigned*)(C.ws + WS_CTL) + 4001, __ATOMIC_RELAXED, __HIP_MEMORY_SCOPE_AGENT);
        #ifdef SSDET_CLS
        const unsigned cls = __hip_atomic_load((unsigned*)(C.ws + WS_CTL) + 4002, __ATOMIC_RELAXED, __HIP_MEMORY_SCOPE_AGENT), cnt = __hip_atomic_load((unsigned*)(C.ws + WS_CTL) + 4003, __ATOMIC_RELAXED, __HIP_MEMORY_SCOPE_AGENT);
        phase_final(C, 1.f + (float)cls / 8.f + (float)(cnt > 63 ? 63 : cnt) / 1024.f); } break;
#else
        phase_final(C, fl ? 3.f : (fd ? exp2f((float)(1001 - fd)) : 1.f)); } break;
#endif
    default: break;
    }
    if (nN) { pg8::StaticOrder S; S.init(32, nN, C.G, C.bid); pg8::gemm_phase(C.lds, g, S, E, C.tid); }
}

__device__ __forceinline__ void canary(const Ctx& C0, unsigned char* ws, int i, bool check) {
    int tid = C0.tid; asm volatile("" : "+v"(tid)); const int lane = tid & 63, wave = tid >> 6;
    unsigned* can = (unsigned*)(ws + WS_CTL + 32768);
#ifdef CANARY_SC1
    if (!check) { if (wave == 0 && lane < 32) __hip_atomic_store(can + C0.bid * 32 + lane, (unsigned)(i + 1), __ATOMIC_RELAXED, __HIP_MEMORY_SCOPE_AGENT); }
#else
    if (!check) { if (wave == 0 && lane < 32) can[C0.bid * 32 + lane] = (unsigned)(i + 1); }
#endif
#ifdef CANARY_LD_SC1
    else { const unsigned v = __hip_atomic_load(can + (wave * 32 + (lane >> 1)) * 32 + (lane & 1) * 16, __ATOMIC_RELAXED, __HIP_MEMORY_SCOPE_AGENT);
#else
    else { const unsigned v = can[(wave * 32 + (lane >> 1)) * 32 + (lane & 1) * 16];
#endif
      if (v != (unsigned)(i + 1) && v != (unsigned)(i + 2)) atomicAdd((unsigned*)(ws + WS_CTL) + 4000, 1u); }
}
__global__ void __launch_bounds__(NTHREADS, 2) mk_fwd(Args a) {
    extern __shared__ __attribute__((aligned(16))) unsigned char lds[];
    int wave_s = __builtin_amdgcn_readfirstlane((int)(threadIdx.x >> 6));
    { volatile LAS unsigned* misc = (volatile LAS unsigned*)((LAS unsigned char*)lds + LDS_BYTES - 64); if (threadIdx.x < 16) misc[threadIdx.x] = 0u; }
    __syncthreads();
    (void)xcd_barrier_post((unsigned*)(a.ws + WS_CTL), (volatile LAS unsigned*)((LAS unsigned char*)lds + LDS_BYTES - 64));
    for (int i = 0; i < a.nph; ++i) {
        {
            Ctx C; C.kp = (const unsigned char __attribute__((address_space(4)))*)__builtin_amdgcn_kernarg_segment_ptr();
            C.out = a.out; C.ws = a.ws; C.lds = (LAS unsigned char*)lds; asm volatile("" : "+s"(wave_s)); C.tid = (wave_s << 6) | lane_id(); C.lane = C.tid & 63; C.wave = 0; C.G = gridDim.x; C.bid = blockIdx.x;
            const unsigned wt = *(const unsigned __attribute__((address_space(4)))*)(C.kp + 288 + (i & ~3)), wa = *(const unsigned __attribute__((address_space(4)))*)(C.kp + 448 + (i & ~3));
            run_phase(C, (int)((wt >> (8 * (i & 3))) & 255u), (int)((wa >> (8 * (i & 3))) & 255u), i + 1);
#ifdef CANARY
            canary(C, a.ws, i, false);
#endif
        }
        if (i + 1 < a.nph) { XcdBarrier bar; bar.bar = (unsigned*)(a.ws + WS_CTL); bar.x = xb_xcc_id(); bar.st = (volatile LAS unsigned*)((LAS unsigned char*)lds + LDS_BYTES - 64); xcd_barrier(bar, wave_s == 0 && lane_id() == 0); }
#ifdef CANARY
        if (i + 1 < a.nph) { Ctx C; C.tid = (wave_s << 6) | lane_id(); C.bid = blockIdx.x; canary(C, a.ws, i, true); }
#endif
    }
}
}
extern "C" void kernel_launch(void* const* d_in, const int* in_sizes, int n_in, void* d_out, int out_size, void* d_ws, size_t ws_size, hipStream_t stream) {
    using namespace om;
    static int grid = 0;
    if (grid == 0) {
        if (n_in != 33 || out_size != 17039360 || ws_size < WS_END) { fprintf(stderr, "kernel_launch: unexpected sizes n_in %d out %d ws %zu; nothing launched\n", n_in, out_size, ws_size); grid = -1; return; }
        int dev = 0, cus = 0, per_cu = 0;
        (void)hipGetDevice(&dev); (void)hipDeviceGetAttribute(&cus, hipDeviceAttributeMultiprocessorCount, dev);
        (void)hipFuncSetAttribute((const void*)mk_fwd, hipFuncAttributeMaxDynamicSharedMemorySize, LDS_BYTES);
        if (hipOccupancyMaxActiveBlocksPerMultiprocessor(&per_cu, (const void*)mk_fwd, NTHREADS, LDS_BYTES) != hipSuccess || per_cu < 1) { fprintf(stderr, "kernel_launch: occupancy query gives %d blocks per CU\n", per_cu); per_cu = 1; }
        (void)hipGetLastError();
        grid = cus;
        if (grid > 256) grid = 256;
    }
    if (grid < 0) return;
    (void)hipMemsetAsync((char*)d_ws + WS_CTL, 0, CTL_ZERO_BYTES, stream);
    Args a{};
    for (int i = 0; i < 33; ++i) a.in[i] = (const float*)d_in[i];
    a.out = (float*)d_out; a.ws = (unsigned char*)d_ws;
    int n = 0;
#ifndef DUP_MASK
#define DUP_MASK 0u
#endif
#ifndef XBAR
#define XBAR 0
#endif
    auto add1 = [&](int t, int p) { a.ptype[n] = (unsigned char)t; a.parg[n] = (unsigned char)p; ++n; };
    auto add = [&](int t, int p) { add1(t, p);
        if ((DUP_MASK >> t) & 1u) { const bool resid = (t == PH_WO || t == PH_HWO || t == PH_GLU || t == PH_DOWN); add1(t, resid ? (p | 32) : p); }
        for (int q = 0; q < XBAR; ++q) add1(31, 0); };
#ifdef UPDET
    add1(PH_P0A, 0); add1(PH_P0C, 0);
    for (int l = 0; l < 4; ++l) { const int kind = l % 3;
        if (kind == 0) { add1(PH_QKV, l); add1(PH_ATTN, l); add1(PH_WO, l); }
        else if (kind == 1) { add1(PH_HIN, l); add1(PH_HSCAN, l); add1(PH_HPOST, l); add1(PH_HWO, l); }
        else { add1(PH_SSCAN, l); add1(PH_SPOST, l); add1(PH_GLU, l); }
        add1(PH_UP, l); add1(PH_UP, l | 32); add1(23, 0); add1(PH_CONV, l); add1(PH_DOWN, l == 3 ? (l | 16) : l); }
    add1(PH_FINAL, 0);
#elif defined(SSDET)
    add1(PH_P0A, 0); add1(PH_P0C, 0);
    for (int l = 0; l < 4; ++l) { const int kind = l % 3;
        if (kind == 0) { add1(PH_QKV, l); add1(PH_ATTN, l); add1(PH_WO, l); }
        else if (kind == 1) { add1(PH_HIN, l); add1(PH_HSCAN, l); add1(PH_HPOST, l); add1(PH_HWO, l); }
        else { add1(22, 0); add1(PH_SSCAN, l | 32); add1(PH_SSCAN, l | 64); add1(21, 0); add1(PH_SSCAN, l); add1(PH_SPOST, l); add1(PH_GLU, l); }
        add1(PH_UP, l); add1(PH_DOWN, l == 3 ? (l | 16) : l); }
    add1(PH_FINAL, 0);
#elif defined(LOCALIZE)
    for (int fwd = 0; fwd < 2; ++fwd) { int idx = 0;
        auto addc = [&](int t, int p) { add1(t, p); add1(18, fwd * 32 + idx); ++idx; };
        add1(20, 0); addc(PH_P0A, 0); addc(PH_P0C, 0);
        for (int l = 0; l < 4; ++l) { const int kind = l % 3;
            if (kind == 0) { addc(PH_QKV, l); addc(PH_ATTN, l); addc(PH_WO, l); }
            else if (kind == 1) { addc(PH_HIN, l); addc(PH_HSCAN, l); addc(PH_HPOST, l); addc(PH_HWO, l); }
            else { addc(PH_SSCAN, l); addc(PH_SPOST, l); addc(PH_GLU, l); }
            addc(PH_UP, l); addc(PH_DOWN, l == 3 ? (l | 16) : l); }
        if (fwd == 1) { add1(19, idx); add1(PH_FINAL, 0); } }
#else
    add(PH_P0A, 0); add(PH_P0C, 0);
    for (int l = 0; l < 4; ++l) {
        const int kind = l % 3;
        if (kind == 0) { add(PH_QKV, l); add(PH_ATTN, l); add(PH_WO, l); }
        else if (kind == 1) { add(PH_HIN, l); add(PH_HSCAN, l); add(PH_HPOST, l); add(PH_HWO, l); }
        else { add(PH_SSCAN, l); add(PH_SPOST, l); add(PH_GLU, l); }
        add(PH_UP, l); add(PH_DOWN, l == 3 ? (l | 16) : l);
    }
    add(PH_FINAL, 0);
#endif
    a.nph = n;
    void* args[] = {&a};
    const hipError_t e = hipLaunchCooperativeKernel((const void*)mk_fwd, dim3(grid), dim3(NTHREADS), args, LDS_BYTES, stream);
    if (e != hipSuccess) fprintf(stderr, "kernel_launch: cooperative launch failed: %s (grid %d)\n", hipGetErrorString(e), grid);
}
```

```cpp
#include <hip/hip_runtime.h>
#include <hip/hip_cooperative_groups.h>
#include <cstdio>
#include <cstdint>
#include <cmath>
#include <cstddef>
#define LAS __attribute__((address_space(3)))
#define GAS __attribute__((address_space(1)))
typedef unsigned short bf16_t;
typedef short bf16x8 __attribute__((ext_vector_type(8)));
typedef short s16x4 __attribute__((ext_vector_type(4)));
typedef float f32x2 __attribute__((ext_vector_type(2)));
typedef float f32x4 __attribute__((ext_vector_type(4)));
typedef float f32x16 __attribute__((ext_vector_type(16)));
typedef unsigned u32x2 __attribute__((ext_vector_type(2)));
typedef unsigned u32x4 __attribute__((ext_vector_type(4)));
typedef __bf16 bf16x2_t __attribute__((ext_vector_type(2)));

namespace om {
constexpr int D = 1024, MP = 4096, M = 8192, DFF = 2816, NUP = 5632, NQKV = 1536, NHIN = 5120;
constexpr float EPS = 1e-6f, LOG2E = 1.4426950408889634f, QSCALE = 0.125f * 1.4426950408889634f;
constexpr int NTHREADS = 512, NWAVES = 8, LDS_BYTES = 159744, RING_BYTES = 131072;
constexpr int SW_STRIDE = 5632;
constexpr float SS_FIX = 16777216.f, SS_INV = 1.f / (16777216.f * 1024.f);
typedef unsigned long long u64_t;
__device__ __forceinline__ float rstd_of(const u64_t* ss, int r) { return rsqrtf((float)ss[r] * SS_INV + 1e-6f); }
constexpr size_t MiB = 1u << 20;
constexpr size_t WS_CTL = 0, CTL_ZERO_BYTES = 64 * 1024;
constexpr size_t WS_MODP = 1 * MiB, WS_MOD = 3 * MiB, WS_SW = 4 * MiB, WS_GMOD = 5 * MiB, WS_SS = 6 * MiB, WS_ROPE = 7 * MiB;
constexpr size_t WS_LB1 = 8 * MiB, WS_SLAM = 8 * MiB + 64 * 1024, WS_SBB = 8 * MiB + 512 * 1024, WS_SCB = 9 * MiB;
constexpr size_t WS_CTXK = 10 * MiB, WS_CTXV = 12 * MiB;
constexpr size_t WS_NAIVE_MOD = 14 * MiB;
constexpr size_t WS_WQKV = 16 * MiB, WS_WO = 22 * MiB, WS_HWIN = 26 * MiB, WS_HWO = 36 * MiB, WS_GLU = 38 * MiB, WS_UP = 42 * MiB, WS_DOWN = 86 * MiB;
constexpr size_t WS_X = 108 * MiB, WS_R = 140 * MiB;
constexpr size_t WS_AP = WS_R, WS_ACT = WS_R + 16 * MiB, WS_SCR = WS_R + 60 * MiB, WS_END = WS_SCR + 176 * MiB;

constexpr size_t SCR_Q = WS_SCR, SCR_KB = WS_SCR + 16 * MiB, SCR_VB = WS_SCR + 20 * MiB, SCR_O = WS_SCR + 24 * MiB;
constexpr size_t SCR_HQ = WS_SCR, SCR_HV = WS_SCR + 16 * MiB, SCR_HG = WS_SCR + 32 * MiB, SCR_LFF = WS_SCR + 48 * MiB, SCR_LFB = WS_SCR + 80 * MiB, SCR_OF = WS_SCR + 112 * MiB, SCR_OB = WS_SCR + 144 * MiB, SCR_AWO = WS_SCR;
constexpr size_t SCR_YF = WS_SCR, SCR_YB = WS_SCR + 32 * MiB, SCR_AGLU = WS_SCR + 64 * MiB;

__device__ __forceinline__ int cond_of_tile(int pm) { return pm < 16 ? 0 : 1 + ((pm - 16) >> 2); }
__device__ __forceinline__ int cond_of_row(int r) { return r < MP ? 0 : 1 + ((r - MP) >> 10); }
__device__ __forceinline__ unsigned cvtpk(float lo, float hi) { f32x2 v = {lo, hi}; bf16x2_t b = __builtin_convertvector(v, bf16x2_t); return __builtin_bit_cast(unsigned, b); }
__device__ __forceinline__ float bf2f(unsigned short h) { return __uint_as_float(((unsigned)h) << 16); }
__device__ __forceinline__ float bflo(unsigned w) { return __uint_as_float(w << 16); }
__device__ __forceinline__ float bfhi(unsigned w) { return __uint_as_float(w & 0xffff0000u); }
__device__ __forceinline__ float sigm(float x) { return __builtin_amdgcn_rcpf(1.f + __expf(-x)); }
__device__ __forceinline__ int lane_id() { unsigned m = ~0u; asm volatile("" : "+s"(m)); return (int)__builtin_amdgcn_mbcnt_hi(m, __builtin_amdgcn_mbcnt_lo(m, 0u)); }
__device__ __forceinline__ float wave_sum(float v) {
#pragma unroll
    for (int o = 1; o < 64; o <<= 1) v += __shfl_xor(v, o);
    return v;
}

struct Ctx {
    const unsigned char __attribute__((address_space(4)))* kp;
    float* out; unsigned char* ws;
    LAS unsigned char* lds; int tid, lane, wave, G, bid;
    __device__ __forceinline__ const float* in(int i) const { return *(const float* const __attribute__((address_space(4)))*)(kp + 8 * i); }
    __device__ __forceinline__ float* f(size_t off) const { return (float*)(ws + off); }
    __device__ __forceinline__ bf16_t* h(size_t off) const { return (bf16_t*)(ws + off); }
};

namespace pg8 {
constexpr int BM = 256, BK = 64, HALF = 128, HTB = HALF * BK * 2, STAGE_BYTES = 8 * HTB, NXCD = 8, WGM = 8;
__host__ __device__ __forceinline__ int lds_byte(int r, int c) { const int st = (r >> 4) * 2 + (c >> 5), rr = r & 15, cc = c & 31, ob = rr * 64 + cc * 2; return st * 1024 + (ob ^ (((ob >> 9) & 1) << 5)); }
__host__ __device__ __forceinline__ void stage_rc(int b, int& R, int& C) { const int st = b / 1024, sb = b % 1024, swz = sb ^ (((sb >> 9) & 1) << 5); R = (st >> 1) * 16 + swz / 64; C = (st & 1) * 32 + (swz % 64) / 2; }
struct Unit { int pm, pn; };
struct Gemm { const bf16_t* A; const bf16_t* Bt; int K; int b_tile_rows, b_half_rows; int ld; int split; };
struct StaticOrder {
    int nM, nN, nwg, G, c;
    __device__ void init(int nM_, int nN_, int G_, int c_) { nM = nM_; nN = nN_; nwg = nM * nN; G = G_; c = c_; }
    __device__ bool next(int i, Unit& u) const {
        const long L = (long)i * G + c; if (L >= nwg) return false;
        int wgid = (int)L; { const int q = nwg / NXCD, r = nwg % NXCD, xcd = wgid % NXCD, off = wgid / NXCD; wgid = (xcd < r ? xcd * (q + 1) : r * (q + 1) + (xcd - r) * q) + off; }
        const int nig = WGM * nN, gid = wgid / nig, fm = gid * WGM, gsz = (nM - fm) < WGM ? (nM - fm) : WGM;
        u.pm = fm + ((wgid % nig) % gsz); u.pn = (wgid % nig) / gsz; return true;
    }
};
template <class Epi>
__device__ __forceinline__ void gemm_phase(LAS unsigned char* lds, const Gemm g, const StaticOrder& S, const Epi& E, int tid_in) {
    int tid_ = tid_in; asm volatile("" : "+v"(tid_));
    const int tid = tid_, wid = __builtin_amdgcn_readfirstlane(tid >> 6), lane = tid & 63, wr = wid >> 2, wc = wid & 3, fr = lane & 15, fq = lane >> 4;
    const int K = g.K, nt = K / BK, ld = g.ld;
    unsigned voffA[2];
#pragma unroll
    for (int i = 0; i < 2; ++i) { int R, C; stage_rc(tid * 16 + i * 8192, R, C); voffA[i] = (unsigned)(R * ld + C) * 2u; }
    const size_t kstep = (size_t)(BK * 2);
    const size_t hstepA = (size_t)HALF * ld * 2, tstepA = 2 * hstepA;
    const size_t hstepB = (size_t)g.b_half_rows * ld * 2, tstepB = (size_t)g.b_tile_rows * ld * 2, khb = (size_t)K * 2;
#define PG8_UA(u) ((const char*)g.A + (size_t)(u).pm * tstepA + (g.split ? (size_t)((u).pn & 1) * khb : 0))
#define PG8_UB(u) ((const char*)g.Bt + (size_t)(g.split ? (u).pn >> 1 : (u).pn) * tstepB + (g.split ? (size_t)((u).pn & 1) * khb : 0))
    const unsigned ldsw = (unsigned)wid * 1024u;
    const int aoff = lds_byte(wr * 64 + fr, fq * 8), boff = lds_byte(wc * 32 + fr, fq * 8);
#define PG8_SA(b, h) (((b) * 2 + (h)) * HTB)
#define PG8_SB(b, h) ((4 + (b) * 2 + (h)) * HTB)
#define PG8_STAGE(bufoff, gbase) do { _Pragma("unroll") for (int _i = 0; _i < 2; ++_i) \
        __builtin_amdgcn_global_load_lds((const unsigned*)((const char*)(gbase) + voffA[_i]), (LAS unsigned*)(lds + (bufoff) + ldsw + _i * 8192), 16, 0, 0); } while (0)
#define PG8_LDA(dst, b, h) do { _Pragma("unroll") for (int m = 0; m < 4; ++m) _Pragma("unroll") for (int k = 0; k < 2; ++k) dst[m][k] = *(const LAS bf16x8*)(lds + PG8_SA(b, h) + aoff + m * 2048 + k * 1024); } while (0)
#define PG8_LDB(dst, b, h) do { _Pragma("unroll") for (int n = 0; n < 2; ++n) _Pragma("unroll") for (int k = 0; k < 2; ++k) dst[n][k] = *(const LAS bf16x8*)(lds + PG8_SB(b, h) + boff + n * 2048 + k * 1024); } while (0)
#define PG8_MMA(ai, bj, At, Bt) do { __builtin_amdgcn_s_setprio(1); _Pragma("unroll") for (int m = 0; m < 4; ++m) _Pragma("unroll") for (int n = 0; n < 2; ++n) _Pragma("unroll") for (int k = 0; k < 2; ++k) \
        acc[ai][bj][m][n] = __builtin_amdgcn_mfma_f32_16x16x32_bf16(Bt[n][k], At[m][k], acc[ai][bj][m][n], 0, 0, 0); __builtin_amdgcn_s_setprio(0); } while (0)
#define PG8_WAIT_V(n) asm volatile("s_waitcnt vmcnt(" #n ")" ::: "memory")
#define PG8_WAIT_L(n) asm volatile("s_waitcnt lgkmcnt(" #n ")" ::: "memory")
#define PG8_BAR __builtin_amdgcn_s_barrier()
#define PG8_SCHED __builtin_amdgcn_sched_barrier(0)
    Unit cur, nxt; int ui = 0;
    if (!S.next(0, cur)) return;
    f32x4 acc[2][2][4][2];
#pragma unroll
    for (int a = 0; a < 2; ++a)
#pragma unroll
        for (int b = 0; b < 2; ++b)
#pragma unroll
            for (int m = 0; m < 4; ++m)
#pragma unroll
                for (int n = 0; n < 2; ++n) acc[a][b][m][n] = (f32x4){0.f, 0.f, 0.f, 0.f};
    bf16x8 At[4][2], B0[2][2], B1[2][2];
    const char* cA = PG8_UA(cur); const char* cB = PG8_UB(cur);
    PG8_STAGE(PG8_SB(0, 0), cB); PG8_STAGE(PG8_SB(0, 1), cB + hstepB); PG8_STAGE(PG8_SA(0, 0), cA); PG8_STAGE(PG8_SA(0, 1), cA + hstepA);
    if (wr == 1) PG8_BAR;
    PG8_WAIT_V(2); PG8_BAR;
    PG8_STAGE(PG8_SB(1, 0), cB + kstep); PG8_STAGE(PG8_SA(1, 0), cA + kstep); PG8_STAGE(PG8_SB(1, 1), cB + hstepB + kstep);
    PG8_WAIT_V(6); PG8_BAR;
    for (;;) {
        const bool has_next = S.next(ui + 1, nxt);
        const char* nA = has_next ? PG8_UA(nxt) : cA; const char* nB = has_next ? PG8_UB(nxt) : cB;
        for (int t = 0; t < nt; t += 2) {
            const bool last = (t == nt - 2);
            const char* a1 = cA + (size_t)(t + 1) * kstep;
            const char* a2 = last ? nA : cA + (size_t)(t + 2) * kstep; const char* b2 = last ? nB : cB + (size_t)(t + 2) * kstep;
            const char* a3 = a2 + kstep; const char* b3 = b2 + kstep;
            PG8_LDB(B0, 0, 0); PG8_LDB(B1, 0, 1); PG8_SCHED; PG8_LDA(At, 0, 0); PG8_STAGE(PG8_SA(1, 1), a1 + hstepA);
            PG8_WAIT_V(8); PG8_WAIT_L(0); PG8_BAR; PG8_MMA(0, 0, At, B0); PG8_MMA(0, 1, At, B1); PG8_BAR; PG8_SCHED;
            PG8_LDA(At, 0, 1); PG8_STAGE(PG8_SB(0, 0), b2); PG8_STAGE(PG8_SB(0, 1), b2 + hstepB); PG8_STAGE(PG8_SA(0, 0), a2);
            PG8_WAIT_V(8); PG8_WAIT_L(0); PG8_BAR; PG8_MMA(1, 0, At, B0); PG8_MMA(1, 1, At, B1); PG8_BAR; PG8_SCHED;
            PG8_LDB(B0, 1, 0); PG8_LDB(B1, 1, 1); PG8_SCHED; PG8_LDA(At, 1, 0); PG8_STAGE(PG8_SA(0, 1), a2 + hstepA);
            PG8_WAIT_V(8); PG8_WAIT_L(0); PG8_BAR; PG8_MMA(0, 0, At, B0); PG8_MMA(0, 1, At, B1); PG8_BAR; PG8_SCHED;
            PG8_LDA(At, 1, 1); PG8_STAGE(PG8_SB(1, 0), b3); PG8_STAGE(PG8_SB(1, 1), b3 + hstepB); PG8_STAGE(PG8_SA(1, 0), a3);
            PG8_WAIT_V(8); PG8_WAIT_L(0); PG8_BAR; PG8_MMA(1, 0, At, B0); PG8_MMA(1, 1, At, B1); PG8_BAR; PG8_SCHED;
        }
        if (wr == 0) PG8_BAR;
        { int l_e = lane_id(); asm volatile("" : "+v"(l_e));
          int fr_e = l_e & 15, fq_e = l_e >> 4, wr_e = wr, wc_e = wc; asm volatile("" : "+s"(wr_e), "+s"(wc_e));
          int tid_e = (wid << 6) | l_e;
          const Unit ue{cur.pm, g.split ? cur.pn >> 1 : cur.pn};
          E(acc, ue, wr_e, wc_e, fr_e, fq_e, g.split ? (cur.pn & 1) : -1, tid_e);
          E.post(ue, tid_e);
#ifdef DUP_POST
          E.post(ue, tid_e);
#endif
          }
        if (!has_next) break;
#pragma unroll
        for (int a = 0; a < 2; ++a)
#pragma unroll
            for (int b = 0; b < 2; ++b)
#pragma unroll
                for (int m = 0; m < 4; ++m)
#pragma unroll
                    for (int n = 0; n < 2; ++n) acc[a][b][m][n] = (f32x4){0.f, 0.f, 0.f, 0.f};
        cur = nxt; cA = nA; cB = nB; ++ui;
        if (wr == 1) PG8_BAR;
    }
    PG8_WAIT_V(0);
    PG8_BAR;
#undef PG8_SA
#undef PG8_UA
#undef PG8_UB
#undef PG8_SB
#undef PG8_STAGE
#undef PG8_LDA
#undef PG8_LDB
#undef PG8_MMA
#undef PG8_WAIT_V
#undef PG8_WAIT_L
#undef PG8_BAR
#undef PG8_SCHED
}
}
using pg8::Unit;
typedef f32x4 Acc[2][2][4][2];

__device__ __forceinline__ void st_bf16x4(bf16_t* p, f32x4 v) { u32x2 w; w.x = cvtpk(v[0], v[1]); w.y = cvtpk(v[2], v[3]); *(u32x2*)p = w; }

template <bool PAIRED> struct EpiRes {
    const float* xin; float* xout; bf16_t* ap; u64_t* ssn; const float* gate;   const float* gmodn;
    __device__ __forceinline__ void operator()(const Acc& acc, const Unit& u, int wr, int wc, int fr, int fq) const {
        const int c = cond_of_tile(u.pm);
        const int colb = (PAIRED ? u.pn * 128 : u.pn * 256) + wc * 32 + 4 * fq;
        constexpr int NBJ = PAIRED ? 1 : 2;
        f32x4 gv[NBJ][2], gm[NBJ][2];
#pragma unroll
        for (int bj = 0; bj < NBJ; ++bj)
#pragma unroll
            for (int n = 0; n < 2; ++n) { gv[bj][n] = *(const f32x4*)(gate + (size_t)c * 6144 + colb + bj * 128 + n * 16);
                gm[bj][n] = gmodn ? *(const f32x4*)(gmodn + (size_t)c * 1024 + colb + bj * 128 + n * 16) : (f32x4){0.f, 0.f, 0.f, 0.f}; }
#pragma unroll
        for (int ai = 0; ai < 2; ++ai)
#pragma unroll
            for (int m = 0; m < 4; ++m) {
                const int r = u.pm * 256 + ai * 128 + wr * 64 + m * 16 + fr; float sq = 0.f;
#pragma unroll
                for (int bj = 0; bj < NBJ; ++bj)
#pragma unroll
                    for (int n = 0; n < 2; ++n) {
                        f32x4 o = acc[ai][bj][m][n];
                        if (PAIRED) { const f32x4 gt = acc[ai][1][m][n];
#pragma unroll
                            for (int e = 0; e < 4; ++e) o[e] = o[e] * sigm(gt[e]); }
                        const size_t off = (size_t)r * D + colb + bj * 128 + n * 16;
                        const f32x4 xo = *(const f32x4*)(xin + off) + gv[bj][n] * o;
                        *(f32x4*)(xout + off) = xo;
                        sq += (xo[0] * xo[0] + xo[1] * xo[1]) + (xo[2] * xo[2] + xo[3] * xo[3]);
                        if (gmodn) st_bf16x4(ap + off, xo * gm[bj][n]);
                    }
                sq += __shfl_xor(sq, 16); sq += __shfl_xor(sq, 32);
                if (fq == 0) atomicAdd(ssn + r, (u64_t)(sq * SS_FIX));
            }
    }
};
struct EpiUpRaw {
    const u64_t* ss; const float* sw;   bf16_t* hraw;
    __device__ __forceinline__ void operator()(const Acc& acc, const Unit& u, int wr, int wc, int fr, int fq) const {
        const int c = cond_of_tile(u.pm); const int colb = u.pn * 256 + wc * 32 + 4 * fq;
        f32x4 sv[2][2];
#pragma unroll
        for (int bj = 0; bj < 2; ++bj)
#pragma unroll
            for (int n = 0; n < 2; ++n) sv[bj][n] = *(const f32x4*)(sw + (size_t)c * SW_STRIDE + colb + bj * 128 + n * 16);
#pragma unroll
        for (int ai = 0; ai < 2; ++ai)
#pragma unroll
            for (int m = 0; m < 4; ++m) {
                const int r = u.pm * 256 + ai * 128 + wr * 64 + m * 16 + fr; const float rs = rstd_of(ss, r);
#pragma unroll
                for (int bj = 0; bj < 2; ++bj)
#pragma unroll
                    for (int n = 0; n < 2; ++n) st_bf16x4(hraw + (size_t)r * NUP + colb + bj * 128 + n * 16, acc[ai][bj][m][n] * rs + sv[bj][n]);
            }
    }
};
constexpr size_t WS_EDGE = 14 * MiB;
template <int CTRL> __device__ __forceinline__ float dpp_f(float old, float src) { return __int_as_float(__builtin_amdgcn_update_dpp(__float_as_int(old), __float_as_int(src), CTRL, 0xf, 0xf, false)); }
#define DPP_ROW_SHL1 0x101
#define DPP_ROW_SHR1 0x111
#define DPP_ROW_ROR1 0x121
#define DPP_ROW_ROR15 0x12f
struct EpiUpConv {
    const u64_t* ss; const float* sw; const float* cw; const float* cb; bf16_t* act; float* edge; bf16_t* tile;
    __device__ __forceinline__ void operator()(const Acc& acc, const Unit& u, int wr, int wc, int fr, int fq) const {
        const int c = cond_of_tile(u.pm); const int cc0 = wc * 32 + 4 * fq, colg0 = u.pn * 128 + cc0;
        f32x4 sv[2][2];
#pragma unroll
        for (int bj = 0; bj < 2; ++bj)
#pragma unroll
            for (int n = 0; n < 2; ++n) sv[bj][n] = *(const f32x4*)(sw + (size_t)c * SW_STRIDE + bj * DFF + colg0 + n * 16);
#pragma unroll
        for (int ai = 0; ai < 2; ++ai)
#pragma unroll
            for (int m = 0; m < 4; ++m) { const int rl = ai * 128 + wr * 64 + m * 16 + fr; const float rs = rstd_of(ss, u.pm * 256 + rl);
#pragma unroll
                for (int bj = 0; bj < 2; ++bj)
#pragma unroll
                    for (int n = 0; n < 2; ++n) st_bf16x4(tile + rl * 256 + bj * 128 + cc0 + n * 16, acc[ai][bj][m][n] * rs + sv[bj][n]); }
    }
    __device__ __forceinline__ void fused(const Acc& acc, const Unit& u, int wr, int wc, int fr, int fq, int tid, LAS unsigned char* xl) const {
        const int c = cond_of_tile(u.pm);
        const bool samp = u.pm >= 16; const bool nb_top = samp && (u.pm & 3) != 0, nb_bot = samp && (u.pm & 3) != 3;
        float rs[8];
#pragma unroll
        for (int ai = 0; ai < 2; ++ai)
#pragma unroll
            for (int m = 0; m < 4; ++m) rs[ai * 4 + m] = rstd_of(ss, u.pm * 256 + ai * 128 + wr * 64 + m * 16 + fr);
        const int r = tid >> 1, q = tid & 1;
        LAS float* cf = (LAS float*)(xl + 20480);
        { const int bj = tid >> 8, jj = (tid >> 6) & 3, cl2 = 2 * (tid & 63); const float* src = (jj < 3 ? cw + jj * NUP : cb) + bj * DFF + u.pn * 128 + cl2;
          *(LAS f32x2*)(cf + (bj * 4 + jj) * 128 + cl2) = *(const f32x2*)src; }
#pragma unroll
        for (int sl = 0; sl < 8; ++sl) {
            const int swc = sl >> 1, sn = sl & 1, colg = u.pn * 128 + 32 * swc + 16 * sn, cs = 32 * swc + 16 * sn + 8 * q;
            if (wc == swc) {
                const f32x4 svg = *(const f32x4*)(sw + (size_t)c * SW_STRIDE + colg + 4 * fq), svv = *(const f32x4*)(sw + (size_t)c * SW_STRIDE + DFF + colg + 4 * fq);
#pragma unroll
                for (int ai = 0; ai < 2; ++ai)
#pragma unroll
                    for (int m = 0; m < 4; ++m) { const int row = ai * 128 + wr * 64 + m * 16 + fr;
                        const f32x4 hg = acc[ai][0][m][sn] * rs[ai * 4 + m] + svg, hv = acc[ai][1][m][sn] * rs[ai * 4 + m] + svv;
                        *(LAS u32x2*)(xl + row * 80 + 8 * fq) = (u32x2){cvtpk(hg[0], hg[1]), cvtpk(hg[2], hg[3])}; *(LAS u32x2*)(xl + row * 80 + 32 + 8 * fq) = (u32x2){cvtpk(hv[0], hv[1]), cvtpk(hv[2], hv[3])}; }
            }
            asm volatile("s_waitcnt lgkmcnt(0)" ::: "memory"); __builtin_amdgcn_s_barrier(); asm volatile("" ::: "memory");
            {
                const u32x4 z = {0u, 0u, 0u, 0u};
                const u32x4 pg = r > 0 ? *(const LAS u32x4*)(xl + (r - 1) * 80 + 16 * q) : z, pv = r > 0 ? *(const LAS u32x4*)(xl + (r - 1) * 80 + 32 + 16 * q) : z;
                const u32x4 cg = *(const LAS u32x4*)(xl + r * 80 + 16 * q), cv = *(const LAS u32x4*)(xl + r * 80 + 32 + 16 * q);
                const u32x4 ng = r < 255 ? *(const LAS u32x4*)(xl + (r + 1) * 80 + 16 * q) : z, nv = r < 255 ? *(const LAS u32x4*)(xl + (r + 1) * 80 + 32 + 16 * q) : z;
                float hg[8], hv[8];
                f32x4 wA[2][3], bA[2];
#pragma unroll
                for (int bj = 0; bj < 2; ++bj) {
#pragma unroll
                    for (int jj = 0; jj < 3; ++jj) wA[bj][jj] = *(const LAS f32x4*)(cf + (bj * 4 + jj) * 128 + cs);
                    bA[bj] = *(const LAS f32x4*)(cf + (bj * 4 + 3) * 128 + cs); }
#pragma unroll
                for (int e = 0; e < 2; ++e) { const int k0 = 2 * e;
                    hg[2 * e] = wA[0][0][k0] * bflo(pg[e]) + wA[0][1][k0] * bflo(cg[e]) + wA[0][2][k0] * bflo(ng[e]) + bA[0][k0];
                    hg[2 * e + 1] = wA[0][0][k0 + 1] * bfhi(pg[e]) + wA[0][1][k0 + 1] * bfhi(cg[e]) + wA[0][2][k0 + 1] * bfhi(ng[e]) + bA[0][k0 + 1];
                    hv[2 * e] = wA[1][0][k0] * bflo(pv[e]) + wA[1][1][k0] * bflo(cv[e]) + wA[1][2][k0] * bflo(nv[e]) + bA[1][k0];
                    hv[2 * e + 1] = wA[1][0][k0 + 1] * bfhi(pv[e]) + wA[1][1][k0 + 1] * bfhi(cv[e]) + wA[1][2][k0 + 1] * bfhi(nv[e]) + bA[1][k0 + 1]; }
                f32x4 wB[2][3], bB[2];
#pragma unroll
                for (int bj = 0; bj < 2; ++bj) {
#pragma unroll
                    for (int jj = 0; jj < 3; ++jj) wB[bj][jj] = *(const LAS f32x4*)(cf + (bj * 4 + jj) * 128 + cs + 4);
                    bB[bj] = *(const LAS f32x4*)(cf + (bj * 4 + 3) * 128 + cs + 4); }
#pragma unroll
                for (int e = 2; e < 4; ++e) { const int k0 = 2 * (e - 2);
                    hg[2 * e] = wB[0][0][k0] * bflo(pg[e]) + wB[0][1][k0] * bflo(cg[e]) + wB[0][2][k0] * bflo(ng[e]) + bB[0][k0];
                    hg[2 * e + 1] = wB[0][0][k0 + 1] * bfhi(pg[e]) + wB[0][1][k0 + 1] * bfhi(cg[e]) + wB[0][2][k0 + 1] * bfhi(ng[e]) + bB[0][k0 + 1];
                    hv[2 * e] = wB[1][0][k0] * bflo(pv[e]) + wB[1][1][k0] * bflo(cv[e]) + wB[1][2][k0] * bflo(nv[e]) + bB[1][k0];
                    hv[2 * e + 1] = wB[1][0][k0 + 1] * bfhi(pv[e]) + wB[1][1][k0 + 1] * bfhi(cv[e]) + wB[1][2][k0 + 1] * bfhi(nv[e]) + bB[1][k0 + 1]; }
                u32x4 o;
#pragma unroll
                for (int e = 0; e < 4; ++e) o[e] = cvtpk(hg[2 * e] * sigm(hg[2 * e]) * hv[2 * e], hg[2 * e + 1] * sigm(hg[2 * e + 1]) * hv[2 * e + 1]);
                *(u32x4*)(act + (size_t)(u.pm * 256 + r) * DFF + colg + 8 * q) = o;
                if ((r == 0 && nb_top) || (r == 255 && nb_bot)) {
                    float* e0 = edge + ((size_t)((u.pm - 16) * 2 + (r == 0 ? 0 : 1)) * 4) * DFF + colg + 8 * q;
#pragma unroll
                    for (int e = 0; e < 4; ++e) { e0[2 * e] = hg[2 * e]; e0[2 * e + 1] = hg[2 * e + 1]; e0[DFF + 2 * e] = hv[2 * e]; e0[DFF + 2 * e + 1] = hv[2 * e + 1];
                        e0[2 * DFF + 2 * e] = bflo(cg[e]); e0[2 * DFF + 2 * e + 1] = bfhi(cg[e]); e0[3 * DFF + 2 * e] = bflo(cv[e]); e0[3 * DFF + 2 * e + 1] = bfhi(cv[e]); } }
            }
            asm volatile("s_waitcnt lgkmcnt(0)" ::: "memory"); __builtin_amdgcn_s_barrier(); asm volatile("" ::: "memory"); __builtin_amdgcn_sched_barrier(0);
        }
    }
};
struct EpiQKV {
    const u64_t* ss; const float* sw; bf16_t *Q, *KB, *VB; float *outK, *outV; const float *ropec, *ropes; int j;
    __device__ __forceinline__ void operator()(const Acc& acc, const Unit& u, int wr, int wc, int fr, int fq) const {
        const int c = cond_of_tile(u.pm); const bool samp = u.pm >= 16; const int colt = u.pn * 256, cl0 = wc * 32 + 4 * fq;
        f32x4 sv[2][2];
#pragma unroll
        for (int bj = 0; bj < 2; ++bj)
#pragma unroll
            for (int n = 0; n < 2; ++n) sv[bj][n] = *(const f32x4*)(sw + (size_t)c * SW_STRIDE + colt + cl0 + bj * 128 + n * 16);
#pragma unroll
        for (int ai = 0; ai < 2; ++ai)
#pragma unroll
            for (int m = 0; m < 4; ++m) {
                const int r = u.pm * 256 + ai * 128 + wr * 64 + m * 16 + fr; const float rs = rstd_of(ss, r);
                f32x4 cs = {1.f, 1.f, 1.f, 1.f}, sn = {0.f, 0.f, 0.f, 0.f};
                if (samp && u.pn < 5) { const int t = (r - MP) & 1023, idx = t * 32 + (wc & 1) * 16 + 4 * fq; cs = *(const f32x4*)(ropec + idx); sn = *(const f32x4*)(ropes + idx); }
#pragma unroll
                for (int bj = 0; bj < 2; ++bj) {
                    f32x4 v0 = acc[ai][bj][m][0] * rs + sv[bj][0], v1 = acc[ai][bj][m][1] * rs + sv[bj][1];
                    if (u.pn < 5) { const f32x4 o0 = v0 * cs - v1 * sn, o1 = v1 * cs + v0 * sn; v0 = o0; v1 = o1; }
                    const int cl = bj * 128 + cl0;
                    if (u.pn < 4) { st_bf16x4(Q + (size_t)r * D + colt + cl, v0 * QSCALE); st_bf16x4(Q + (size_t)r * D + colt + cl + 16, v1 * QSCALE); }
                    else {
                        bf16_t* dst = (u.pn == 4 ? KB : VB) + (size_t)r * 256 + cl; st_bf16x4(dst, v0); st_bf16x4(dst + 16, v1);
                        if (!samp) { float* o = (u.pn == 4 ? outK : outV) + (((size_t)(r >> 8) * 2 + j) * 256 + (r & 255)) * 256 + cl; *(f32x4*)o = v0; *(f32x4*)(o + 16) = v1; }
                    }
                }
            }
    }
};
struct EpiHin {
    const u64_t* ss; const float* sw; const float* lb1; bf16_t *HQ, *HV, *HG; float *LFF, *LFB;
    __device__ __forceinline__ void operator()(const Acc& acc, const Unit& u, int wr, int wc, int fr, int fq) const {
        const int c = cond_of_tile(u.pm); const int seg = u.pn >> 2, colt = u.pn * 256, cl0 = wc * 32 + 4 * fq, cs0 = (u.pn & 3) * 256 + cl0;
        f32x4 sv[2][2], lbv[2][2];
#pragma unroll
        for (int bj = 0; bj < 2; ++bj)
#pragma unroll
            for (int n = 0; n < 2; ++n) { sv[bj][n] = *(const f32x4*)(sw + (size_t)c * SW_STRIDE + colt + cl0 + bj * 128 + n * 16);
                lbv[bj][n] = (seg == 2 || seg == 3) ? *(const f32x4*)(lb1 + (seg - 2) * 1024 + cs0 + bj * 128 + n * 16) : (f32x4){0.f, 0.f, 0.f, 0.f}; }
#pragma unroll
        for (int ai = 0; ai < 2; ++ai)
#pragma unroll
            for (int m = 0; m < 4; ++m) {
                const int r = u.pm * 256 + ai * 128 + wr * 64 + m * 16 + fr; const float rs = rstd_of(ss, r);
#pragma unroll
                for (int bj = 0; bj < 2; ++bj)
#pragma unroll
                    for (int n = 0; n < 2; ++n) {
                        f32x4 v = acc[ai][bj][m][n] * rs + sv[bj][n]; const size_t off = (size_t)r * D + cs0 + bj * 128 + n * 16;
                        if (seg == 0) st_bf16x4(HQ + off, v);
                        else if (seg == 1) st_bf16x4(HV + off, v);
                        else if (seg == 4) {
#pragma unroll
                            for (int e = 0; e < 4; ++e) v[e] = v[e] * sigm(v[e]);
                            st_bf16x4(HG + off, v); }
                        else { const f32x4 lb = lbv[bj][n];
#pragma unroll
                            for (int e = 0; e < 4; ++e) v[e] = __logf(lb[e] + (1.f - lb[e]) * sigm(v[e]));
                            *(f32x4*)((seg == 2 ? LFF : LFB) + off) = v; }
                    }
            }
    }
};
enum { EK_RES = 0, EK_RES_GLU, EK_UPRAW, EK_QKV, EK_HIN, EK_UPCONV };
struct EpiAny {
    int kind, l, flags, epoch, pn_off; unsigned char* ws; float* out; const float *in29, *in30; LAS unsigned char* xl;
    __device__ __forceinline__ float* F(size_t o) const { return (float*)(ws + o); }
    __device__ __forceinline__ bf16_t* H(size_t o) const { return (bf16_t*)(ws + o); }
    __device__ __forceinline__ void post(const Unit&, int) const {}
    __device__ __forceinline__ void operator()(Acc& acc, const Unit& u, int wr, int wc, int fr, int fq, int kh, int tid) const {
#ifndef EK_MASK
#define EK_MASK 63
#endif
        if (!((EK_MASK >> this->kind) & 1)) return;
        unsigned char* ws = this->ws; float* out = this->out; int kind = this->kind, l = this->l, flags = this->flags;
        asm volatile("" : "+s"(ws), "+s"(out), "+s"(kind), "+s"(l), "+s"(flags));
        if (kh >= 0) {
            const int tile = u.pm * 4 + u.pn; unsigned* flag = (unsigned*)(ws + WS_CTL + 40960) + tile * 16;
            unsigned char* slab = ws + WS_SCR + 64 * MiB + (size_t)tile * 262144 + (size_t)tid * 16;
            if (kh == 1) {
                __amdgpu_buffer_rsrc_t rs = __builtin_amdgcn_make_buffer_rsrc(ws + WS_SCR + 64 * MiB + (size_t)tile * 262144, 0, 262144, 0x00020000);
#pragma unroll
                for (int j = 0; j < 32; ++j) __builtin_amdgcn_raw_buffer_store_b128(__builtin_bit_cast(u32x4, acc[j >> 4][(j >> 3) & 1][(j >> 1) & 3][j & 1]), rs, tid * 16 + j * 8192, 0, 16);
                asm volatile("s_waitcnt vmcnt(0)" ::: "memory"); __builtin_amdgcn_s_barrier(); asm volatile("" ::: "memory");
                if (tid == 0) __hip_atomic_store(flag, (unsigned)epoch, __ATOMIC_RELAXED, __HIP_MEMORY_SCOPE_AGENT);
                return;
            }
            if (tid < 64) {
                unsigned sp = 0;
                while ((unsigned)__builtin_amdgcn_readfirstlane((int)__hip_atomic_load(flag, __ATOMIC_RELAXED, __HIP_MEMORY_SCOPE_AGENT)) != (unsigned)epoch) { __builtin_amdgcn_s_sleep(2); if (++sp > (1u << 22)) break; }
                __builtin_amdgcn_fence(__ATOMIC_ACQUIRE, "agent"); asm volatile("s_waitcnt vmcnt(0)" ::: "memory");
            }
            asm volatile("" ::: "memory"); __builtin_amdgcn_s_barrier(); asm volatile("" ::: "memory");
#pragma unroll
            for (int j = 0; j < 32; ++j) acc[j >> 4][(j >> 3) & 1][(j >> 1) & 3][j & 1] += *(const f32x4*)(slab + (size_t)j * 8192);
        }
        auto F = [&](size_t o) { return (float*)(ws + o); }; auto H = [&](size_t o) { return (bf16_t*)(ws + o); };
        const size_t ss1 = WS_SS + (size_t)(l * 2) * M * 8, sw1 = WS_SW + (size_t)(l * 2) * 5 * SW_STRIDE * 4;
        switch (kind) {
        case EK_RES: case EK_RES_GLU: {
            const bool down = flags & 1;
            const size_t ssn = down ? WS_SS + (size_t)((l + 1) * 2) * M * 8 : ss1 + (size_t)M * 8;
            const size_t gate = WS_MOD + ((size_t)l * 5 * 6144 + (down ? 5 : 2) * 1024) * 4;
            const size_t gmn = down ? WS_GMOD + (size_t)((l + 1) * 2) * 5 * 1024 * 4 : WS_GMOD + (size_t)(l * 2 + 1) * 5 * 1024 * 4;
            const bool has_next = !(down && l == 3);
            float* xo = (flags & 2) ? out : F(WS_X); bf16_t* ap = H(WS_AP); u64_t* sp = (u64_t*)(ws + ssn);
            if (flags & 4) { const size_t dm = WS_SCR + ((flags & 8) ? 48 : 96) * MiB; xo = F(dm); ap = H(dm + 32 * MiB); sp = (u64_t*)(ws + dm + 48 * MiB); }
            if (kind == EK_RES) { EpiRes<false> E{F(WS_X), xo, ap, sp, F(gate), has_next ? F(gmn) : nullptr}; E(acc, u, wr, wc, fr, fq); }
            else { EpiRes<true> E{F(WS_X), xo, ap, sp, F(gate), F(gmn)}; E(acc, u, wr, wc, fr, fq); } } break;
        case EK_UPRAW: { EpiUpRaw E{(const u64_t*)(ws + ss1 + (size_t)M * 8), F(sw1 + (size_t)5 * SW_STRIDE * 4), H(WS_SCR + (size_t)((flags >> 2) & 1) * (88 * MiB))}; E(acc, u, wr, wc, fr, fq); } break;
        case EK_UPCONV: { EpiUpConv E{(const u64_t*)(ws + ss1 + (size_t)M * 8), F(sw1 + (size_t)5 * SW_STRIDE * 4), in29 + (size_t)l * 3 * NUP, in30 + (size_t)l * NUP, H(WS_ACT), F(WS_EDGE), nullptr}; E.fused(acc, u, wr, wc, fr, fq, tid, xl);
#ifdef DUP_FUSED
            E.fused(acc, u, wr, wc, fr, fq, tid, xl);
#endif
            } break;
        case EK_QKV: { EpiQKV E{(const u64_t*)(ws + ss1), F(sw1), H(SCR_Q), H(SCR_KB), H(SCR_VB), out + 8388608, out + 8388608 + 2097152, F(WS_ROPE), F(WS_ROPE) + 32768, l / 3}; E(acc, u, wr, wc, fr, fq); } break;
        default: { Unit u2{u.pm, u.pn + pn_off}; const Unit& u = u2; EpiHin E{(const u64_t*)(ws + ss1), F(sw1), F(WS_LB1), H(SCR_HQ), H(SCR_HV), H(SCR_HG), F(SCR_LFF), F(SCR_LFB)}; E(acc, u, wr, wc, fr, fq); } break;
        }
    }
};
}
namespace om {
#define LDS_WAIT() asm volatile("s_waitcnt lgkmcnt(0)" ::: "memory")
__device__ __forceinline__ void transpose_item(const float* W, int K, int N, bf16_t* WT, LAS unsigned short* scr, int item, int lane) {
    const int nblk = N / 32, kb = item / nblk, nb = item % nblk, k0 = 64 * kb, n0 = 32 * nb;
    float v[32];
#pragma unroll
    for (int i = 0; i < 32; ++i) v[i] = W[(size_t)(k0 + 2 * i + (lane >> 5)) * N + n0 + (lane & 31)];
#pragma unroll
    for (int i = 0; i < 32; ++i) scr[(2 * i + (lane >> 5)) * 33 + (lane & 31)] = (unsigned short)(cvtpk(v[i], 0.f) & 0xffffu);
    LDS_WAIT(); asm volatile("" ::: "memory");
    const int c = lane & 7;
#pragma unroll
    for (int j = 0; j < 4; ++j) { const int n = (lane >> 3) + 8 * j; const LAS unsigned short* s = scr + (8 * c) * 33 + n;
        u32x4 o; o.x = (unsigned)s[0 * 33] | ((unsigned)s[1 * 33] << 16); o.y = (unsigned)s[2 * 33] | ((unsigned)s[3 * 33] << 16); o.z = (unsigned)s[4 * 33] | ((unsigned)s[5 * 33] << 16); o.w = (unsigned)s[6 * 33] | ((unsigned)s[7 * 33] << 16);
        *(u32x4*)(WT + (size_t)(n0 + n) * K + k0 + 8 * c) = o; }
    LDS_WAIT(); asm volatile("" ::: "memory");
}
__device__ __forceinline__ float modsum(const Ctx& C, int l, int c, int idx) {
    const float* mp = C.f(WS_MODP) + ((size_t)l * 5 + c) * 6144 + idx; float s = C.in(9)[l * 6144 + idx];
#pragma unroll
    for (int kp = 0; kp < 4; ++kp) s += mp[(size_t)kp * 4 * 5 * 6144];
    return s;
}
__device__ __forceinline__ void convert_layer(const Ctx& C, int layer, int vb, int nvb) {
    const int gw = vb * NWAVES + C.wave, NGW = nvb * NWAVES;
    LAS unsigned short* scr = (LAS unsigned short*)(C.lds + C.wave * 4352);
#define DO_MAT(src, dst, K, N) for (int it = gw; it < ((K) / 64) * ((N) / 32); it += NGW) transpose_item((src), (K), (N), (dst), scr, it, C.lane)
    if (layer == 0 || layer == 3) { const int j = layer / 3; DO_MAT(C.in(12) + (size_t)j * D * NQKV, C.h(WS_WQKV) + (size_t)j * NQKV * D, D, NQKV); DO_MAT(C.in(13) + (size_t)j * D * D, C.h(WS_WO) + (size_t)j * D * D, D, D); }
    else if (layer == 1) { DO_MAT(C.in(15), C.h(WS_HWIN), D, NHIN); DO_MAT(C.in(18), C.h(WS_HWO), D, D); }
    else { DO_MAT(C.in(27), C.h(WS_GLU), D, 2048); }
    DO_MAT(C.in(28) + (size_t)layer * D * NUP, C.h(WS_UP) + (size_t)layer * NUP * D, D, NUP); DO_MAT(C.in(31) + (size_t)layer * DFF * D, C.h(WS_DOWN) + (size_t)layer * D * DFF, DFF, D);
#undef DO_MAT
}
__device__ __forceinline__ void phase_p0a(const Ctx& C) {
    const int gt = C.bid * NTHREADS + C.tid, NGT = C.G * NTHREADS;
    for (int layer = 0; layer < 4; ++layer) if (layer == 0 || C.G != 256) convert_layer(C, layer, C.bid, C.G);
    __syncthreads();
    LAS float* sS = (LAS float*)(C.lds + 40960);
    LAS float* red = (LAS float*)(C.lds);
    for (int it = C.bid; it < 384; it += C.G) {
        const int l = it / 96, cb = (it % 96) >> 2, kp = it & 3;
        for (int i = C.tid; i < 5 * 256; i += NTHREADS) { const int c = i >> 8, k = kp * 256 + (i & 255); const float v = c == 0 ? C.in(7)[k] : C.in(6)[(c - 1) * 1024 + k]; sS[i] = v / (1.f + __expf(-v)); }
        __syncthreads();
        f32x4 a[5];
#pragma unroll
        for (int c = 0; c < 5; ++c) a[c] = (f32x4){0.f, 0.f, 0.f, 0.f};
        const float* wp = C.in(8) + ((size_t)l * 1024 + kp * 256 + C.wave * 32) * 6144 + cb * 256 + 4 * C.lane;
#pragma unroll 4
        for (int k = 0; k < 32; ++k) { const f32x4 w = *(const f32x4*)(wp + (size_t)k * 6144);
#pragma unroll
            for (int c = 0; c < 5; ++c) a[c] += w * sS[c * 256 + C.wave * 32 + k]; }
#pragma unroll
        for (int c = 0; c < 5; ++c) *(LAS f32x4*)(red + (C.wave * 5 + c) * 256 + 4 * C.lane) = a[c];
        __syncthreads();
        for (int i = C.tid; i < 5 * 256; i += NTHREADS) { float s = 0.f;
#pragma unroll
            for (int w = 0; w < 8; ++w) s += red[w * 1280 + i];
            C.f(WS_MODP)[(((size_t)kp * 4 + l) * 5 + (i >> 8)) * 6144 + cb * 256 + (i & 255)] = s; }
        __syncthreads();
    }
    { unsigned zero = 0u; asm volatile("" : "+v"(zero));
      for (int i = gt; i < 9 * M; i += NGT) ((u32x2*)(C.ws + WS_SS))[i] = (u32x2){zero, zero}; }
    for (int i = gt; i < 1024 * 32; i += NGT) { const int t = i >> 5, e = i & 31, fi = e & 15; const float pos = (e >> 4) == 0 ? (float)(t >> 6) : (float)(t & 63);
        const float ang = pos * __builtin_amdgcn_exp2f(-(float)fi * (13.287712379549449f / 16.0f))  ; C.f(WS_ROPE)[i] = cosf(ang); C.f(WS_ROPE)[32768 + i] = sinf(ang); }
    for (int i = gt; i < 2 * 131072; i += NGT) { const int which = i >> 17, e = (i & 131071) * 8; const float* s = (which ? C.in(3) : C.in(2)) + e; const f32x4 a = *(const f32x4*)s, b = *(const f32x4*)(s + 4);
        u32x4 o; o.x = cvtpk(a[0], a[1]); o.y = cvtpk(a[2], a[3]); o.z = cvtpk(b[0], b[1]); o.w = cvtpk(b[2], b[3]); *(u32x4*)(C.h(which ? WS_CTXV : WS_CTXK) + e) = o; }
    for (int i = gt; i < 2048; i += NGT) { float v[4], mx = -1e30f;
#pragma unroll
        for (int l = 0; l < 4; ++l) { v[l] = C.in(16)[l * 2048 + i]; mx = fmaxf(mx, v[l]); }
        float s = 0.f;
#pragma unroll
        for (int l = 0; l < 4; ++l) { v[l] = expf(v[l] - mx); s += v[l]; }
        C.f(WS_LB1)[i] = v[1] / s; }
    for (int i = gt; i < 8192; i += NGT) {
        const int dg = i >> 6, p = i & 63;
        const float ar = fminf(C.in(19)[i], -1e-4f), ai = C.in(20)[i], dt = expf(C.in(21)[dg]);
        const float e = expf(ar * dt), lr = e * cosf(ai * dt), li = e * sinf(ai * dt);
        const float den = ar * ar + ai * ai, fr = ((lr - 1.f) * ar + li * ai) / den, fi = (li * ar - (lr - 1.f) * ai) / den;
        C.f(WS_SLAM)[2 * i] = lr; C.f(WS_SLAM)[2 * i + 1] = li;
        unsigned wr_[8], wi_[8];
#pragma unroll
        for (int q = 0; q < 8; ++q) { const float x0 = C.in(22)[(size_t)i * 16 + 2 * q], y0 = C.in(23)[(size_t)i * 16 + 2 * q], x1 = C.in(22)[(size_t)i * 16 + 2 * q + 1], y1 = C.in(23)[(size_t)i * 16 + 2 * q + 1];
            wr_[q] = cvtpk(fr * x0 - fi * y0, fr * x1 - fi * y1); wi_[q] = cvtpk(fr * y0 + fi * x0, fr * y1 + fi * x1); }
        bf16_t* bb = C.h(WS_SBB) + ((size_t)dg * 128 + p) * 16;
        *(u32x4*)bb = (u32x4){wr_[0], wr_[1], wr_[2], wr_[3]}; *(u32x4*)(bb + 8) = (u32x4){wr_[4], wr_[5], wr_[6], wr_[7]};
        *(u32x4*)(bb + 64 * 16) = (u32x4){wi_[0], wi_[1], wi_[2], wi_[3]}; *(u32x4*)(bb + 64 * 16 + 8) = (u32x4){wi_[4], wi_[5], wi_[6], wi_[7]};
    }
    for (int i = gt; i < 2 * 64 * 16 * 64; i += NGT) {
        const int p = i & 63, row = i >> 6; bf16_t* cb = C.h(WS_SCB) + (size_t)row * 128;
        cb[p] = (bf16_t)(cvtpk(C.in(24)[i], 0.f) & 0xffffu); cb[64 + p] = (bf16_t)(cvtpk(-C.in(25)[i], 0.f) & 0xffffu); }
}
__device__ __forceinline__ void rows_ap_ss(const Ctx& C, const float* xsrc_p, const float* xsrc_s, float* xcopy, int l, int s, bool from_table, u64_t* ssdst) {
    for (int gw = C.bid * NWAVES + C.wave; gw < M / 4; gw += C.G * NWAVES) {
    const int r0 = gw * 4;
    const int c = cond_of_row(r0);
    f32x4 gm[4];
#pragma unroll
    for (int j = 0; j < 4; ++j) { const int n = 4 * C.lane + 256 * j;
        if (from_table) gm[j] = *(const f32x4*)(C.f(WS_GMOD) + (((size_t)l * 2 + s) * 5 + c) * 1024 + n);
        else { const float* g = (s == 0 ? C.in(10) : C.in(11)) + l * D + n;
#pragma unroll
            for (int e = 0; e < 4; ++e) gm[j][e] = g[e] * (1.f + modsum(C, l, c, (s == 0 ? 1 : 4) * 1024 + n + e)); } }
    for (int rr = 0; rr < 4; ++rr) {
        const int r = r0 + rr; const float* xr = (r < MP ? xsrc_p + (size_t)r * D : xsrc_s + (size_t)(r - MP) * D);
        f32x4 v[4]; float sq = 0.f;
#pragma unroll
        for (int j = 0; j < 4; ++j) { v[j] = *(const f32x4*)(xr + 4 * C.lane + 256 * j); sq += (v[j][0] * v[j][0] + v[j][1] * v[j][1]) + (v[j][2] * v[j][2] + v[j][3] * v[j][3]); }
        sq = wave_sum(sq);
#pragma unroll
        for (int j = 0; j < 4; ++j) { const size_t off = (size_t)r * D + 4 * C.lane + 256 * j; if (xcopy) *(f32x4*)(xcopy + off) = v[j]; st_bf16x4(C.h(WS_AP) + off, v[j] * gm[j]); }
        if (C.lane == 0) ssdst[r] = (u64_t)(sq * SS_FIX);
    }
    }
}
template <bool FROM_TABLE> __device__ __forceinline__ void sw_item_t(const Ctx& C, int item) {
    int ch = item, l = 0, s = 0, N = 0; const float* Wf = nullptr;
    if (ch < 12) { l = 0; s = 0; N = NQKV; Wf = C.in(12); }
    else if ((ch -= 12) < 44) { l = 0; s = 1; N = NUP; Wf = C.in(28); }
    else if ((ch -= 44) < 40) { l = 1; s = 0; N = NHIN; Wf = C.in(15); }
    else if ((ch -= 40) < 44) { l = 1; s = 1; N = NUP; Wf = C.in(28) + (size_t)1 * D * NUP; }
    else if ((ch -= 44) < 44) { l = 2; s = 1; N = NUP; Wf = C.in(28) + (size_t)2 * D * NUP; }
    else if ((ch -= 44) < 12) { l = 3; s = 0; N = NQKV; Wf = C.in(12) + (size_t)1 * D * NQKV; }
    else { ch -= 12; l = 3; s = 1; N = NUP; Wf = C.in(28) + (size_t)3 * D * NUP; }
    LAS float* sh = (LAS float*)C.lds;
    for (int i = C.tid; i < 5 * 1024; i += NTHREADS) sh[i] = FROM_TABLE ? C.f(WS_MOD)[((size_t)l * 5 + (i >> 10)) * 6144 + (s == 0 ? 0 : 3) * 1024 + (i & 1023)] : modsum(C, l, i >> 10, (s == 0 ? 0 : 3) * 1024 + (i & 1023));
    __syncthreads();
    const int n0 = ch * 128 + 4 * (C.lane & 31);
    f32x4 a[5];
#pragma unroll
    for (int c = 0; c < 5; ++c) a[c] = (f32x4){0.f, 0.f, 0.f, 0.f};
    const float* wp = Wf + (size_t)(C.wave * 128 + (C.lane >> 5)) * N + n0;
#pragma unroll 4
    for (int k = 0; k < 64; ++k) { const f32x4 w = *(const f32x4*)(wp + (size_t)(2 * k) * N); const int kk = C.wave * 128 + 2 * k + (C.lane >> 5);
#pragma unroll
        for (int c = 0; c < 5; ++c) a[c] += w * sh[c * 1024 + kk]; }
    LAS float* red = (LAS float*)(C.lds + 20480);
#pragma unroll
    for (int c = 0; c < 5; ++c) *(LAS f32x4*)(red + ((C.wave * 2 + (C.lane >> 5)) * 5 + c) * 128 + 4 * (C.lane & 31)) = a[c];
    __syncthreads();
    for (int i = C.tid; i < 5 * 128; i += NTHREADS) { float sum = 0.f;
#pragma unroll
        for (int w = 0; w < 16; ++w) sum += red[w * 640 + i];
        C.f(WS_SW)[(((size_t)l * 2 + s) * 5 + (i >> 7)) * SW_STRIDE + ch * 128 + (i & 127)] = sum; }
    __syncthreads();
}
__device__ __forceinline__ void sw_item_p0(const Ctx& C, int item) { sw_item_t<false>(C, item); }
__device__ __forceinline__ void sw_item(const Ctx& C, int item) { sw_item_t<true>(C, item); }
__device__ __forceinline__ void phase_p0c(const Ctx& C) {
    for (int vb = C.bid; vb < 256; vb += C.G) {
    if (vb < 240) {
        sw_item_p0(C, vb);
    } else {
        const int t = (vb - 240) * NTHREADS + C.tid, NT = 16 * NTHREADS;
        for (int i = t; i < 4 * 5 * 6144; i += NT) { const int l = i / 30720, c = (i / 6144) % 5, idx = i % 6144; C.f(WS_MOD)[i] = modsum(C, l, c, idx); }
        for (int i = t; i < 4 * 2 * 5 * 1024; i += NT) { const int n = i & 1023, c = (i >> 10) % 5, s = (i / 5120) & 1, l = i / 10240;
            C.f(WS_GMOD)[i] = (s == 0 ? C.in(10) : C.in(11))[l * D + n] * (1.f + modsum(C, l, c, (s == 0 ? 1 : 4) * 1024 + n)); }
    }
    __syncthreads();
    }
    rows_ap_ss(C, C.in(0), C.in(1), C.f(WS_X), 0, 0, false, (u64_t*)(C.ws + WS_SS));
}
__device__ __forceinline__ void phase_glue(const Ctx& C, int l, int s) { rows_ap_ss(C, C.f(WS_X), C.f(WS_X) + (size_t)MP * D, nullptr, l, s, true, (u64_t*)(C.ws + WS_SS) + (size_t)(l * 2 + s) * M); }

__device__ __forceinline__ void phase_conv(const Ctx& C, int l) {
    const bf16_t* h = C.h(WS_SCR); bf16_t* act = C.h(WS_ACT); const float* cw = C.in(29) + (size_t)l * 3 * NUP; const float* cb = C.in(30) + (size_t)l * NUP;
    const int gt = C.bid * NTHREADS + C.tid, NGT = C.G * NTHREADS;
    for (int i = gt; i < M * (DFF / 8); i += NGT) {
        const int r = i / (DFF / 8), n = (i % (DFF / 8)) * 8;
        int t, S; if (r < MP) { t = r & 255; S = 256; } else { t = (r - MP) & 1023; S = 1024; }
        float g[8], v[8];
#pragma unroll
        for (int e = 0; e < 8; ++e) { g[e] = cb[n + e]; v[e] = cb[DFF + n + e]; }
#pragma unroll
        for (int jj = 0; jj < 3; ++jj) { const int tt = t + jj - 1; if (tt >= 0 && tt < S) {
            const u32x4 hg = *(const u32x4*)(h + (size_t)(r + jj - 1) * NUP + n), hv = *(const u32x4*)(h + (size_t)(r + jj - 1) * NUP + DFF + n);
#pragma unroll
            for (int e = 0; e < 4; ++e) { g[2 * e] += cw[jj * NUP + n + 2 * e] * bflo(hg[e]); g[2 * e + 1] += cw[jj * NUP + n + 2 * e + 1] * bfhi(hg[e]);
                v[2 * e] += cw[jj * NUP + DFF + n + 2 * e] * bflo(hv[e]); v[2 * e + 1] += cw[jj * NUP + DFF + n + 2 * e + 1] * bfhi(hv[e]); } } }
        u32x4 o;
#pragma unroll
        for (int e = 0; e < 4; ++e) o[e] = cvtpk(g[2 * e] * sigm(g[2 * e]) * v[2 * e], g[2 * e + 1] * sigm(g[2 * e + 1]) * v[2 * e + 1]);
        *(u32x4*)(act + (size_t)r * DFF + n) = o;
    }
}
__device__ __forceinline__ void phase_final(const Ctx& C, float dbg) {
    const int gw = C.bid * NWAVES + C.wave, NGW = C.G * NWAVES; const u64_t* ss = (const u64_t*)(C.ws + WS_SS) + (size_t)8 * M;
    for (int r = gw; r < M; r += NGW) { const float rs = rstd_of(ss, r);
#pragma unroll
        for (int j = 0; j < 4; ++j) { const int n = 4 * C.lane + 256 * j; float* p = C.out + (size_t)r * D + n; *(f32x4*)p = *(const f32x4*)p * (rs * dbg) * *(const f32x4*)(C.in(32) + n); } }
}
}
namespace om {
__device__ __forceinline__ int rowidx(int r, int h) { return (r & 3) + 8 * (r >> 2) + 4 * h; }
__device__ __forceinline__ float xhalf(float v) {
    auto rr = __builtin_amdgcn_permlane32_swap(__float_as_uint(v), __float_as_uint(v), false, false);
    return __uint_as_float((lane_id() & 32) ? rr[0] : rr[1]);
}
__device__ __forceinline__ bf16x8 pack8(const f32x16& x, int base) {
    u32x4 w; w.x = cvtpk(x[base], x[base + 1]); w.y = cvtpk(x[base + 2], x[base + 3]); w.z = cvtpk(x[base + 4], x[base + 5]); w.w = cvtpk(x[base + 6], x[base + 7]);
    return __builtin_bit_cast(bf16x8, w);
}
typedef short v4i16_t __attribute__((ext_vector_type(4)));
__device__ __forceinline__ u32x2 vtr4(const LAS unsigned char* p) { return __builtin_bit_cast(u32x2, __builtin_amdgcn_ds_read_tr16_b64_v4i16((LAS v4i16_t*)p)); }
__device__ __forceinline__ bf16x8 cat44(u32x2 a, u32x2 b) { u32x4 w = {a.x, a.y, b.x, b.y}; return __builtin_bit_cast(bf16x8, w); }

constexpr int AT_KSTR = 144;
constexpr int AT_BUF = 2 * 64 * AT_KSTR;
__device__ __forceinline__ void attn_unit(const Ctx& C, int j, bool samp, int b, int hq, int qb, size_t obuf) {
    const int lane = C.lane, c = lane & 31, h = lane >> 5, w = C.wave, kvh = hq >> 2;
    const int rowbase = samp ? MP + b * 1024 : b * 256, q0 = qb * 256, qlo = q0 + 32 * w;
    const bf16_t* Q = C.h(SCR_Q); const bf16_t* KB = C.h(SCR_KB); const bf16_t* VB = C.h(SCR_VB);
    const bf16_t* CK = C.h(WS_CTXK) + ((size_t)(b * 2 + j) * 512) * 256; const bf16_t* CV = C.h(WS_CTXV) + ((size_t)(b * 2 + j) * 512) * 256;
    int klo = 0, nlat = 4, NT = 4;
    if (samp) { klo = q0 - 128 < 0 ? 0 : q0 - 128; const int khi = q0 + 384 > 1024 ? 1024 : q0 + 384; nlat = (khi - klo) >> 6; NT = nlat + 8; }
    bf16x8 qf[4];
#pragma unroll
    for (int s = 0; s < 4; ++s) qf[s] = *(const bf16x8*)(Q + (size_t)(rowbase + qlo + c) * D + hq * 64 + 16 * s + 8 * h);
    float m = C.in(14)[j * 16 + hq] * LOG2E, lsum = h == 0 ? 1.f : 0.f;
    f32x16 o0 = {}, o1 = {};
    const int lkey = C.tid >> 3, lch = C.tid & 7;
    auto src_k = [&](int t) -> const bf16_t* { return (t < nlat ? KB + (size_t)(rowbase + klo + 64 * t + lkey) * 256 : CK + (size_t)(64 * (t - nlat) + lkey) * 256) + kvh * 64 + lch * 8; };
    auto src_v = [&](int t) -> const bf16_t* { return (t < nlat ? VB + (size_t)(rowbase + klo + 64 * t + lkey) * 256 : CV + (size_t)(64 * (t - nlat) + lkey) * 256) + kvh * 64 + lch * 8; };
    auto put = [&](int buf, u32x4 kr, u32x4 vr) {
        LAS unsigned char* kb = C.lds + buf * AT_BUF; LAS unsigned char* vb = kb + 64 * AT_KSTR;
        *(LAS u32x4*)(kb + lkey * AT_KSTR + lch * 16) = kr;
        *(LAS u32x4*)(vb + lkey * AT_KSTR + lch * 16) = vr;
    };
    const int vtr_off = (4 * h + ((lane & 15) >> 2)) * AT_KSTR + (16 * ((lane >> 4) & 1) + 4 * (lane & 3)) * 2;
    { const u32x4 kr = *(const u32x4*)src_k(0), vr = *(const u32x4*)src_v(0); put(0, kr, vr); }
    __syncthreads();
    for (int t = 0; t < NT; ++t) {
        u32x4 kr = {}, vr = {};
        if (t + 1 < NT) { kr = *(const u32x4*)src_k(t + 1); vr = *(const u32x4*)src_v(t + 1); }
        const bool lat = samp && t < nlat; const int key0 = klo + 64 * t;
        const bool skip = lat && (key0 > qlo + 31 + 128 || key0 + 63 < qlo - 128);
        if (!skip) {
            LAS unsigned char* kb = C.lds + (t & 1) * AT_BUF; LAS unsigned char* vb = kb + 64 * AT_KSTR;
            f32x16 x0 = {}, x1 = {};
#pragma unroll
            for (int s = 0; s < 4; ++s) {
                const bf16x8 a0 = *(const LAS bf16x8*)(kb + c * AT_KSTR + (16 * s + 8 * h) * 2), a1 = *(const LAS bf16x8*)(kb + (32 + c) * AT_KSTR + (16 * s + 8 * h) * 2);
                x0 = __builtin_amdgcn_mfma_f32_32x32x16_bf16(a0, qf[s], x0, 0, 0, 0); x1 = __builtin_amdgcn_mfma_f32_32x32x16_bf16(a1, qf[s], x1, 0, 0, 0);
            }
            if (lat && !(key0 >= qlo + 31 - 128 && key0 + 63 <= qlo + 128)) {
                const int tq = qlo + c;
#pragma unroll
                for (int r = 0; r < 16; ++r) { const int k0 = key0 + rowidx(r, h) - tq; if (k0 > 128 || k0 < -128) x0[r] = -INFINITY; if (k0 + 32 > 128 || k0 + 32 < -128) x1[r] = -INFINITY; }
            }
            float mx = fmaxf(x0[0], x1[0]);
#pragma unroll
            for (int r = 1; r < 16; ++r) mx = fmaxf(mx, fmaxf(x0[r], x1[r]));
            mx = fmaxf(mx, xhalf(mx));
            const float mn = fmaxf(m, mx), al = __builtin_amdgcn_exp2f(m - mn); m = mn;
            float ps = 0.f;
#pragma unroll
            for (int r = 0; r < 16; ++r) { x0[r] = __builtin_amdgcn_exp2f(x0[r] - mn); x1[r] = __builtin_amdgcn_exp2f(x1[r] - mn); ps += x0[r] + x1[r]; }
            lsum = lsum * al + ps;
#pragma unroll
            for (int r = 0; r < 16; ++r) { o0[r] *= al; o1[r] *= al; }
#pragma unroll
            for (int ks = 0; ks < 2; ++ks) {
                const bf16x8 p0 = pack8(x0, 8 * ks), p1 = pack8(x1, 8 * ks);
#pragma unroll
                for (int dt = 0; dt < 2; ++dt) {
                    const LAS unsigned char* vp = vb + vtr_off + (16 * ks) * AT_KSTR + (32 * dt) * 2;
                    const bf16x8 v0 = cat44(vtr4(vp), vtr4(vp + 8 * AT_KSTR)), v1 = cat44(vtr4(vp + 32 * AT_KSTR), vtr4(vp + 40 * AT_KSTR));
                    if (dt == 0) { o0 = __builtin_amdgcn_mfma_f32_32x32x16_bf16(v0, p0, o0, 0, 0, 0); o0 = __builtin_amdgcn_mfma_f32_32x32x16_bf16(v1, p1, o0, 0, 0, 0); }
                    else { o1 = __builtin_amdgcn_mfma_f32_32x32x16_bf16(v0, p0, o1, 0, 0, 0); o1 = __builtin_amdgcn_mfma_f32_32x32x16_bf16(v1, p1, o1, 0, 0, 0); }
                }
            }
        }
        if (t + 1 < NT) put((t + 1) & 1, kr, vr);
        __syncthreads();
    }
    lsum += xhalf(lsum);
    const float il = 1.f / lsum;
    bf16_t* O = C.h(obuf) + (size_t)(rowbase + qlo + c) * D + hq * 64 + 4 * h;
#pragma unroll
    for (int g = 0; g < 4; ++g) { st_bf16x4(O + 8 * g, (f32x4){o0[4 * g], o0[4 * g + 1], o0[4 * g + 2], o0[4 * g + 3]} * il); st_bf16x4(O + 32 + 8 * g, (f32x4){o1[4 * g], o1[4 * g + 1], o1[4 * g + 2], o1[4 * g + 3]} * il); }
}
__device__ __forceinline__ void phase_attn(const Ctx& C, int l, size_t obuf) {
    const int j = l / 3;
    for (int u = C.bid; u < 512; u += C.G) {
        if (u < 256) attn_unit(C, j, false, u >> 4, u & 15, 0, obuf);
        else { const int v = u - 256; attn_unit(C, j, true, v >> 6, (v >> 2) & 15, v & 3, obuf); }
    }
}
constexpr size_t CKS_TAB = 376 * MiB; constexpr int CKS_NW = (int)((268 * MiB) / 65536), CKS_NO = (17039360 * 4) / 65536, CKS_N = CKS_NW + CKS_NO;
__device__ __forceinline__ void phase_cks(const Ctx& C, int slot) {
    const int gw = C.bid * NWAVES + C.wave, NGW = C.G * NWAVES; unsigned* tab = (unsigned*)(C.ws + CKS_TAB) + (size_t)slot * 8192;
    for (int ck = gw; ck < CKS_N; ck += NGW) {
        const unsigned char* base = ck < CKS_NW ? C.ws + 108 * MiB + (size_t)ck * 65536 : (const unsigned char*)C.out + (size_t)(ck - CKS_NW) * 65536; unsigned s = 0;
        for (int i = 0; i < 64; ++i) { const u32x4 v = *(const u32x4*)(base + (size_t)i * 1024 + C.lane * 16); s += v[0] + v[1] * 3u + v[2] * 5u + v[3] * 7u; }
#pragma unroll
        for (int o = 1; o < 64; o <<= 1) s += (unsigned)__shfl_xor((int)s, o);
        if (C.lane == 0) tab[ck] = s;
    }
}
__device__ __forceinline__ void phase_clr(const Ctx& C) {
    const int gt = C.bid * NTHREADS + C.tid, NGT = C.G * NTHREADS; unsigned z0 = 0u; asm volatile("" : "+v"(z0)); const u32x4 z = {z0, z0, z0, z0};
    for (size_t i = gt; i < (268 * MiB) / 16; i += NGT) *(u32x4*)(C.ws + 108 * MiB + i * 16) = z;
    for (size_t i = gt; i < (size_t)17039360 / 4; i += NGT) *(u32x4*)((unsigned char*)C.out + i * 16) = z;
}
__device__ __forceinline__ void phase_clr2(const Ctx& C, size_t off, size_t bytes) {
    const int gt = C.bid * NTHREADS + C.tid, NGT = C.G * NTHREADS; unsigned z0 = 0u; asm volatile("" : "+v"(z0)); const u32x4 z = {z0, z0, z0, z0};
    for (size_t i = gt; i < bytes / 16; i += NGT) *(u32x4*)(C.ws + off + i * 16) = z;
}
__device__ __forceinline__ void phase_cmp(const Ctx& C, int nslots) {
    const int gt = C.bid * NTHREADS + C.tid, NGT = C.G * NTHREADS; const unsigned* tab = (const unsigned*)(C.ws + CKS_TAB);
    for (int i = gt; i < nslots * 8192; i += NGT) { const int sl = i >> 13, ck = i & 8191; if (ck < CKS_N && tab[(size_t)sl * 8192 + ck] != tab[(size_t)(sl + 32) * 8192 + ck]) {
#if defined(SSDET) || defined(SS2RUN)
        const int cls = ck >= CKS_NW ? 4 : (ck < 1472 + 512 ? 1 : 2); atomicOr((unsigned*)(C.ws + WS_CTL) + 4002, (unsigned)cls); atomicAdd((unsigned*)(C.ws + WS_CTL) + 4003, 1u);
#endif
        atomicMax((unsigned*)(C.ws + WS_CTL) + 4001, (unsigned)(1000 - sl)); } }
}
__device__ __forceinline__ void phase_chk(const Ctx& C, size_t a, size_t b, size_t bytes) {
    const int gt = C.bid * NTHREADS + C.tid, NGT = C.G * NTHREADS; unsigned bad = 0;
    for (size_t i = gt; i < bytes / 16; i += NGT) { const u32x4 x = *(const u32x4*)(C.ws + a + i * 16), y = *(const u32x4*)(C.ws + b + i * 16); bad += (x[0] != y[0]) | (x[1] != y[1]) | (x[2] != y[2]) | (x[3] != y[3]); }
    if (bad) atomicAdd((unsigned*)(C.ws + WS_CTL) + 4000, bad);
}

constexpr int HS_QSTR = 272, HS_TSTR = 80;
constexpr int HS_QT = 0, HS_KT = 32 * HS_QSTR, HS_KTT = 2 * 32 * HS_QSTR, HS_VT = HS_KTT + 128 * HS_TSTR, HS_E1 = HS_VT + 128 * HS_TSTR, HS_E2 = HS_E1 + 512, HS_T1 = HS_E2 + 512, HS_GRP = HS_T1 + 512;
__device__ __forceinline__ void hscan_item(const Ctx& C, int item) {
    const bool samp = item < 64; const int it = samp ? item : item - 64;
    const int dir = it & 1, hd = (it >> 1) & 7, sq = it >> 4;
    const int S = samp ? 1024 : 256, rowbase = samp ? MP + sq * 1024 : sq * 256, nchunk = S >> 5;
    const int tg = C.tid & 255, lane = C.lane, c = lane & 31, h = lane >> 5, w4 = C.wave & 3; const bool producer = C.wave >= 4;
    LAS unsigned char* L = C.lds;
    const bf16_t* HQ = C.h(SCR_HQ); const bf16_t* HV = C.h(SCR_HV); const float* LF = C.f(dir == 0 ? SCR_LFF : SCR_LFB); float* OD = C.f(dir == 0 ? SCR_OF : SCR_OB);
    const int pd = tg & 127, ph = tg >> 7;
    unsigned qw[8], kw[8], vtw[8]; float e1v = 0.f, e2v = 0.f;
    float rlf[16], rpre[16]; unsigned rq[16], rv[16];
    auto issue = [&](int ch) {
#pragma unroll
        for (int i = 0; i < 16; ++i) { const int pos = 32 * ch + 16 * ph + i, t = dir == 0 ? pos : S - 1 - pos; const size_t off = (size_t)(rowbase + t) * D + hd * 128 + pd;
            rlf[i] = LF[off]; rq[i] = HQ[off]; rv[i] = HV[off];
            const int pos2 = 32 * ch + i, t2 = dir == 0 ? pos2 : S - 1 - pos2; rpre[i] = ph == 1 ? LF[(size_t)(rowbase + t2) * D + hd * 128 + pd] : 0.f; }
    };
    auto compute = [&]() {
        float cl[16]; float pre = 0.f, run = 0.f;
#pragma unroll
        for (int i = 0; i < 16; ++i) { pre += rpre[i]; run += rlf[i]; cl[i] = run; }
        const float t1v = ph == 0 ? cl[15] : pre;
#pragma unroll
        for (int i = 0; i < 16; i += 2) {
            const float e0 = ph == 0 ? cl[i] - t1v : cl[i], e1 = ph == 0 ? cl[i + 1] - t1v : cl[i + 1];
            const float k0 = 1.f - __expf(rlf[i]), k1 = 1.f - __expf(rlf[i + 1]);
            qw[i >> 1] = cvtpk(__uint_as_float(rq[i] << 16) * __expf(e0), __uint_as_float(rq[i + 1] << 16) * __expf(e1)); kw[i >> 1] = cvtpk(k0 * __expf(-e0), k1 * __expf(-e1));
            vtw[i >> 1] = rv[i] | (rv[i + 1] << 16); }
        e1v = __expf(t1v); e2v = __expf(cl[15]);
    };
    auto put = [&]() {
#pragma unroll
        for (int i = 0; i < 8; ++i) {
            *(LAS unsigned short*)(L + HS_QT + (16 * ph + 2 * i) * HS_QSTR + pd * 2) = (unsigned short)(qw[i] & 0xffffu); *(LAS unsigned short*)(L + HS_QT + (16 * ph + 2 * i + 1) * HS_QSTR + pd * 2) = (unsigned short)(qw[i] >> 16);
            *(LAS unsigned short*)(L + HS_KT + (16 * ph + 2 * i) * HS_QSTR + pd * 2) = (unsigned short)(kw[i] & 0xffffu); *(LAS unsigned short*)(L + HS_KT + (16 * ph + 2 * i + 1) * HS_QSTR + pd * 2) = (unsigned short)(kw[i] >> 16); }
        *(LAS u32x4*)(L + HS_KTT + pd * HS_TSTR + ph * 32) = (u32x4){kw[0], kw[1], kw[2], kw[3]}; *(LAS u32x4*)(L + HS_KTT + pd * HS_TSTR + ph * 32 + 16) = (u32x4){kw[4], kw[5], kw[6], kw[7]};
        *(LAS u32x4*)(L + HS_VT + pd * HS_TSTR + ph * 32) = (u32x4){vtw[0], vtw[1], vtw[2], vtw[3]}; *(LAS u32x4*)(L + HS_VT + pd * HS_TSTR + ph * 32 + 16) = (u32x4){vtw[4], vtw[5], vtw[6], vtw[7]};
        if (ph == 0) *(LAS float*)(L + HS_E1 + pd * 4) = e1v; else *(LAS float*)(L + HS_E2 + pd * 4) = e2v;
    };
    if (producer) {
        issue(0); compute(); if (nchunk > 1) issue(1);
        for (int ch = 0; ch < nchunk; ++ch) {
            put();
            __syncthreads();
            if (ch + 1 < nchunk) { compute(); if (ch + 2 < nchunk) issue(ch + 2); }
            __syncthreads();
        }
        return;
    }
    f32x16 St[4];
#pragma unroll
    for (int dt = 0; dt < 4; ++dt) {
        if (samp) { const float* s0 = C.in(4) + ((((size_t)sq * 2 + dir) * 8 + hd) * 128) * 128;
#pragma unroll
            for (int r = 0; r < 16; ++r) St[dt][r] = s0[(size_t)(32 * dt + rowidx(r, h)) * 128 + 32 * w4 + c]; }
        else St[dt] = (f32x16){};
    }
    for (int ch = 0; ch < nchunk; ++ch) {
        __syncthreads();
#pragma unroll
        for (int dt = 0; dt < 4; ++dt)
#pragma unroll
            for (int g = 0; g < 4; ++g) { const f32x4 e = *(const LAS f32x4*)(L + HS_E1 + (32 * dt + 8 * g + 4 * h) * 4);
#pragma unroll
                for (int q = 0; q < 4; ++q) St[dt][4 * g + q] *= e[q]; }
        f32x16 X = {};
#pragma unroll
        for (int s = 0; s < 8; ++s) {
            const bf16x8 a = *(const LAS bf16x8*)(L + HS_KT + c * HS_QSTR + (16 * s + 8 * h) * 2), bq = *(const LAS bf16x8*)(L + HS_QT + c * HS_QSTR + (16 * s + 8 * h) * 2);
            X = __builtin_amdgcn_mfma_f32_32x32x16_bf16(a, bq, X, 0, 0, 0);
        }
#pragma unroll
        for (int r = 0; r < 16; ++r) if (rowidx(r, h) > c) X[r] = 0.f;
        f32x16 OT = {};
#pragma unroll
        for (int ks = 0; ks < 2; ++ks) {
            const LAS unsigned char* vrow = L + HS_VT + (32 * w4 + c) * HS_TSTR + (16 * ks + 4 * h) * 2;
            const bf16x8 va = cat44(*(const LAS u32x2*)(vrow), *(const LAS u32x2*)(vrow + 16));
            OT = __builtin_amdgcn_mfma_f32_32x32x16_bf16(va, pack8(X, 8 * ks), OT, 0, 0, 0);
        }
#pragma unroll
        for (int dt = 0; dt < 4; ++dt)
#pragma unroll
            for (int ks = 0; ks < 2; ++ks) {
                const LAS unsigned char* qrow = L + HS_QT + c * HS_QSTR + (32 * dt + 16 * ks + 4 * h) * 2;
                const bf16x8 bq = cat44(*(const LAS u32x2*)(qrow), *(const LAS u32x2*)(qrow + 16));
                OT = __builtin_amdgcn_mfma_f32_32x32x16_bf16(pack8(St[dt], 8 * ks), bq, OT, 0, 0, 0);
            }
#pragma unroll
        for (int dt = 0; dt < 4; ++dt)
#pragma unroll
            for (int ks = 0; ks < 2; ++ks) {
                const bf16x8 a = *(const LAS bf16x8*)(L + HS_KTT + (32 * dt + c) * HS_TSTR + (16 * ks + 8 * h) * 2), bv = *(const LAS bf16x8*)(L + HS_VT + (32 * w4 + c) * HS_TSTR + (16 * ks + 8 * h) * 2);
                St[dt] = __builtin_amdgcn_mfma_f32_32x32x16_bf16(a, bv, St[dt], 0, 0, 0);
            }
#pragma unroll
        for (int dt = 0; dt < 4; ++dt)
#pragma unroll
            for (int g = 0; g < 4; ++g) { const f32x4 e = *(const LAS f32x4*)(L + HS_E2 + (32 * dt + 8 * g + 4 * h) * 4);
#pragma unroll
                for (int q = 0; q < 4; ++q) St[dt][4 * g + q] *= e[q]; }
        { const int pos = 32 * ch + c, t = dir == 0 ? pos : S - 1 - pos; float* op = OD + (size_t)(rowbase + t) * D + hd * 128 + 32 * w4 + 4 * h;
#pragma unroll
            for (int g = 0; g < 4; ++g) *(f32x4*)(op + 8 * g) = (f32x4){OT[4 * g], OT[4 * g + 1], OT[4 * g + 2], OT[4 * g + 3]}; }
        __syncthreads();
    }
    if (!samp) { float* so = C.out + 8388608 + 2 * 2097152 + ((((size_t)sq * 2 + dir) * 8 + hd) * 128) * 128;
        int c2 = c, h2 = h; asm volatile("" : "+v"(c2), "+v"(h2));
        unsigned base = (unsigned)((4 * h2) * 128 + 32 * w4 + c2);
#pragma unroll
        for (int dt = 0; dt < 4; ++dt)
#pragma unroll
            for (int r = 0; r < 16; ++r) so[base + (unsigned)((32 * dt + (r & 3) + 8 * (r >> 2)) * 128)] = St[dt][r]; }
}
__device__ __forceinline__ void phase_hscan(const Ctx& C) {
    if (C.G == 256) {
        hscan_item(C, C.bid);
        if (C.bid >= 64 && C.bid < 128) hscan_item(C, 256 + (C.bid - 64));
    } else for (int it = C.bid; it < 320; it += C.G) hscan_item(C, it);
}
__device__ __forceinline__ void phase_hpost(const Ctx& C) {
    const int gw = C.bid * NWAVES + C.wave, NGW = C.G * NWAVES;
    for (int r = gw; r < M; r += NGW) {
        const size_t off = (size_t)r * D + 16 * C.lane; float o[16]; float sq = 0.f;
#pragma unroll
        for (int q = 0; q < 4; ++q) { const f32x4 a = *(const f32x4*)(C.f(SCR_OF) + off + 4 * q), b = *(const f32x4*)(C.f(SCR_OB) + off + 4 * q);
#pragma unroll
            for (int e = 0; e < 4; ++e) { o[4 * q + e] = a[e] + b[e]; sq += o[4 * q + e] * o[4 * q + e]; } }
        sq += __shfl_xor(sq, 1); sq += __shfl_xor(sq, 2); sq += __shfl_xor(sq, 4);
        const float rs = rsqrtf(sq * (1.f / 128.f) + EPS);
        const u32x4 g0 = *(const u32x4*)(C.h(SCR_HG) + off), g1 = *(const u32x4*)(C.h(SCR_HG) + off + 8);
        const float* gn = C.in(17) + (16 * C.lane & 127);
        float sg[16];
#pragma unroll
        for (int e = 0; e < 4; ++e) { sg[2 * e] = bflo(g0[e]); sg[2 * e + 1] = bfhi(g0[e]); sg[8 + 2 * e] = bflo(g1[e]); sg[8 + 2 * e + 1] = bfhi(g1[e]); }
        u32x4 w0, w1;
#pragma unroll
        for (int e = 0; e < 4; ++e) { w0[e] = cvtpk(o[2 * e] * rs * gn[2 * e] * sg[2 * e], o[2 * e + 1] * rs * gn[2 * e + 1] * sg[2 * e + 1]);
            w1[e] = cvtpk(o[8 + 2 * e] * rs * gn[8 + 2 * e] * sg[8 + 2 * e], o[8 + 2 * e + 1] * rs * gn[8 + 2 * e + 1] * sg[8 + 2 * e + 1]); }
        *(u32x4*)(C.h(SCR_AWO) + off) = w0; *(u32x4*)(C.h(SCR_AWO) + off + 8) = w1;
    }
}

constexpr int SS_RSTR = 512;
constexpr int SS_WAVE = 16 * SS_RSTR;
__device__ __forceinline__ void sscan_seq(const Ctx& C, int l, bool samp, int sq, int dir, int g, size_t ydbg) {
    const int lane = C.lane, c = lane & 31, h = lane >> 5, dg = dir * 64 + g;
    const int S = samp ? 1024 : 256, rowbase = samp ? MP + sq * 1024 : sq * 256, nchunk = S >> 5, cond = samp ? 1 + sq : 0;
    LAS unsigned char* LB = C.lds + C.wave * SS_WAVE; LAS unsigned char* LH = LB + 4096;
    const float* X = C.f(WS_X); const u64_t* ss = (const u64_t*)(C.ws + WS_SS) + (size_t)(l * 2) * M; float* Y = C.f(ydbg ? ydbg : (dir == 0 ? SCR_YF : SCR_YB)); const bool ywr = !ydbg || dir == 0;
    bf16x8 bfr[4], cfr[4];
#pragma unroll
    for (int ct = 0; ct < 4; ++ct) bfr[ct] = *(const bf16x8*)(C.h(WS_SBB) + ((size_t)dg * 128 + 32 * ct + c) * 16 + 8 * h);
#pragma unroll
    for (int s = 0; s < 4; ++s) cfr[s] = *(const bf16x8*)(C.h(WS_SCB) + ((size_t)dg * 16 + (lane & 15)) * 128 + 32 * s + 8 * (lane >> 4));
    const float lr = C.f(WS_SLAM)[2 * (dg * 64 + lane)], li = C.f(WS_SLAM)[2 * (dg * 64 + lane) + 1];
    f32x4 gm0, gm1, sh0, sh1;
    { const float* gm = C.f(WS_GMOD) + ((size_t)(l * 2) * 5 + cond) * 1024 + g * 16 + 8 * h; gm0 = *(const f32x4*)gm; gm1 = *(const f32x4*)(gm + 4);
      const float* sh = C.f(WS_MOD) + ((size_t)l * 5 + cond) * 6144 + g * 16 + 8 * h; sh0 = *(const f32x4*)sh; sh1 = *(const f32x4*)(sh + 4); }
    float hr = 0.f, hi = 0.f;
    if (samp) { const float* s0 = C.in(5) + ((((size_t)sq * 2 + dir) * 64 + g) * 64 + lane) * 2; hr = s0[0]; hi = s0[1]; }
    for (int ch = 0; ch < nchunk; ++ch) {
        const int pos = 32 * ch + c, t = dir == 0 ? pos : S - 1 - pos, r = rowbase + t;
        const float rs = rstd_of(ss, r);
        const f32x4 x0 = *(const f32x4*)(X + (size_t)r * D + g * 16 + 8 * h), x1 = *(const f32x4*)(X + (size_t)r * D + g * 16 + 8 * h + 4);
        const f32x4 u0 = x0 * rs * gm0 + sh0, u1 = x1 * rs * gm1 + sh1;
        u32x4 uw = {cvtpk(u0[0], u0[1]), cvtpk(u0[2], u0[3]), cvtpk(u1[0], u1[1]), cvtpk(u1[2], u1[3])};
        const bf16x8 uf = __builtin_bit_cast(bf16x8, uw);
        f32x16 bu[4];
#pragma unroll
        for (int ct = 0; ct < 4; ++ct) { bu[ct] = (f32x16){}; bu[ct] = __builtin_amdgcn_mfma_f32_32x32x16_bf16(uf, bfr[ct], bu[ct], 0, 0, 0); }
#pragma unroll
        for (int i = 0; i < 16; ++i) {
            const auto sr = __builtin_amdgcn_permlane32_swap(__float_as_uint(bu[0][i]), __float_as_uint(bu[1][i]), false, false);
            bu[0][i] = __uint_as_float(sr[0]); bu[1][i] = __uint_as_float(sr[1]);
            const auto si = __builtin_amdgcn_permlane32_swap(__float_as_uint(bu[2][i]), __float_as_uint(bu[3][i]), false, false);
            bu[2][i] = __uint_as_float(si[0]); bu[3][i] = __uint_as_float(si[1]);
        }
#pragma unroll
        for (int hf = 0; hf < 2; ++hf) {
#pragma unroll
            for (int t8 = 0; t8 < 2; ++t8) {
                float br[8], bi[8]; unsigned wv[8];
#pragma unroll
                for (int k = 0; k < 8; ++k) { br[k] = bu[k >> 2][4 * (2 * hf + t8) + (k & 3)]; bi[k] = bu[2 + (k >> 2)][4 * (2 * hf + t8) + (k & 3)]; }
#pragma unroll
                for (int k = 0; k < 8; ++k) { const float nr = lr * hr - li * hi + br[k], ni = lr * hi + li * hr + bi[k]; hr = nr; hi = ni; wv[k] = cvtpk(hr, hi); }
#pragma unroll
                for (int k = 0; k < 8; ++k) { const int row = 8 * t8 + k;
                    *(LAS unsigned short*)(LH + row * 256 + ((((lane >> 3)) ^ row) << 4) + (lane & 7) * 2) = (unsigned short)(wv[k] & 0xffffu);
                    *(LAS unsigned short*)(LH + row * 256 + (((8 + (lane >> 3)) ^ row) << 4) + (lane & 7) * 2) = (unsigned short)(wv[k] >> 16); }
                LDS_WAIT();
            }
            f32x4 y0 = {};
#pragma unroll
            for (int s = 0; s < 4; ++s) {
                const bf16x8 a0 = *(const LAS bf16x8*)(LH + (lane & 15) * 256 + (((4 * s + (lane >> 4)) ^ (lane & 15)) << 4));
                y0 = __builtin_amdgcn_mfma_f32_16x16x32_bf16(a0, cfr[s], y0, 0, 0, 0);
            }
            if (ywr) {
#pragma unroll
                for (int q = 0; q < 4; ++q) { const int p0 = 32 * ch + 16 * hf + 4 * (lane >> 4) + q, t0 = dir == 0 ? p0 : S - 1 - p0; Y[(size_t)(rowbase + t0) * D + g * 16 + (lane & 15)] = y0[q]; }
            }
            LDS_WAIT();
        }
    }
    if (!samp && !ydbg) { float* so = C.out + 8388608 + 2 * 2097152 + 4194304 + ((((size_t)sq * 2 + dir) * 64 + g) * 64 + lane) * 2; so[0] = hr; so[1] = hi; }
}
__device__ __forceinline__ void phase_sscan(const Ctx& C, int l, size_t ydbg) {
    for (int bb = C.bid; bb < 256; bb += C.G) {
        const int w = C.wave;
#ifdef SS_ONLYWAVE
        if (ydbg && !((SS_ONLYWAVE >> w) & 1)) continue;
#endif
        if (w < 2) { const int id = 2 * bb + w; sscan_seq(C, l, true, id >> 7, (id >> 6) & 1, id & 63, ydbg); }
        else { int id = 8 * bb + (w - 2); sscan_seq(C, l, false, id >> 7, (id >> 6) & 1, id & 63, ydbg);
            if (w < 4) { id = 8 * bb + 6 + (w - 2); sscan_seq(C, l, false, id >> 7, (id >> 6) & 1, id & 63, ydbg); } }
    }
}
__device__ __forceinline__ void phase_spost(const Ctx& C, int l) {
    const int gw = C.bid * NWAVES + C.wave, NGW = C.G * NWAVES; const u64_t* ss = (const u64_t*)(C.ws + WS_SS) + (size_t)(l * 2) * M;
    for (int r = gw; r < M; r += NGW) {
        const int cond = cond_of_row(r); const float rs = rstd_of(ss, r);
#pragma unroll
        for (int jq = 0; jq < 4; ++jq) {
            const int n = 4 * C.lane + 256 * jq; const size_t off = (size_t)r * D + n;
            const f32x4 x = *(const f32x4*)(C.f(WS_X) + off), gm = *(const f32x4*)(C.f(WS_GMOD) + ((size_t)(l * 2) * 5 + cond) * 1024 + n), sh = *(const f32x4*)(C.f(WS_MOD) + ((size_t)l * 5 + cond) * 6144 + n);
            const f32x4 u = x * rs * gm + sh, y = *(const f32x4*)(C.in(26) + n) * u + *(const f32x4*)(C.f(SCR_YF) + off) + *(const f32x4*)(C.f(SCR_YB) + off);
            f32x4 o;
#pragma unroll
            for (int e = 0; e < 4; ++e) { const float v = y[e], uu = 0.7978845608028654f * (v + 0.044715f * v * v * v); const float th = 1.f - 2.f * __builtin_amdgcn_rcpf(1.f + __expf(2.f * uu)); o[e] = 0.5f * v * (1.f + th); }
            st_bf16x4(C.h(SCR_AGLU) + off, o);
        }
    }
}
#define XB_TMO      128
#define XB_XCNT(j)  (256  + 64 * (j))
#define XB_XSUB(j)  (1280 + 64 * (j))
#define XB_XGEN(j)  (2304 + 64 * (j))
#define XB_TOP      3328
#define XB_TOPGEN   3392
#define XCD_BAR_WORDS 3456
#define XB_SPIN_CAP (1u << 18)
#ifndef XB_SCOPE
#define XB_SCOPE "agent"
#endif
__device__ __forceinline__ unsigned xb_ld(unsigned* p)              { return __hip_atomic_load(p, __ATOMIC_RELAXED, __HIP_MEMORY_SCOPE_AGENT); }
__device__ __forceinline__ unsigned xb_add(unsigned* p, unsigned v) { return __hip_atomic_fetch_add(p, v, __ATOMIC_RELAXED, __HIP_MEMORY_SCOPE_AGENT); }
__device__ __forceinline__ unsigned xb_xcc_id() { return (unsigned)__builtin_amdgcn_s_getreg((3 << 11) | 20) & 0xFu; }
#define XB_SPIN(cond, bar) do { unsigned _sp = 0; while (cond) { __builtin_amdgcn_s_sleep(1); \
    if ((++_sp & 255u) == 0u) { if (xb_ld(&(bar)[XB_TMO])) break; if (_sp > XB_SPIN_CAP) { atomicAdd(&(bar)[XB_TMO], 1u); break; } } } } while (0)
struct XcdBarrier { unsigned* bar; unsigned x; volatile LAS unsigned* st; };
__device__ __forceinline__ XcdBarrier xcd_barrier_post(unsigned* bar, volatile LAS unsigned* st) {
    XcdBarrier b; b.bar = bar; b.x = xb_xcc_id(); b.st = st;
    if (threadIdx.x == 0) (void)xb_add(&bar[XB_XCNT(b.x)], 1u);
    return b;
}
__device__ __forceinline__ void xcd_barrier_complete(unsigned* bar, unsigned x, unsigned& nloc, unsigned& nx) {
    const unsigned G = gridDim.x * gridDim.y * gridDim.z;
    unsigned sum, cnt, mine, sp = 0u;
    for (;;) {
        sum = 0u; cnt = 0u; mine = 0u;
#pragma unroll
        for (unsigned j = 0; j < 16; ++j) { const unsigned c = xb_ld(&bar[XB_XCNT(j)]); sum += c; cnt += (c > 0u) ? 1u : 0u; mine = (j == x) ? c : mine; }
        if (sum == G) break;
        __builtin_amdgcn_s_sleep(1);
        if ((++sp & 255u) == 0u) { if (xb_ld(&bar[XB_TMO])) break; if (sp > XB_SPIN_CAP) { atomicAdd(&bar[XB_TMO], 1u); break; } }
    }
    nloc = mine > 0u ? mine : 1u; nx = cnt > 0u ? cnt : 1u;
}
__device__ __forceinline__ void xcd_barrier(const XcdBarrier& b, bool thread0) {
    asm volatile("s_waitcnt vmcnt(0)" ::: "memory");
    __syncthreads();
    if (thread0) {
        unsigned* bar = b.bar;
        __builtin_amdgcn_s_waitcnt(0);
        unsigned nloc = b.st[0], nx = b.st[1];
        if (nloc == 0u) { xcd_barrier_complete(bar, b.x, nloc, nx); b.st[0] = nloc; b.st[1] = nx; }
#ifdef XB_EARLY_WB
        asm volatile("buffer_wbl2 sc1" ::: "memory");
#endif
        const unsigned old = xb_add(&bar[XB_XSUB(b.x)], 1u);
        const unsigned gen = old / nloc;
        if (old + 1u == (gen + 1u) * nloc) {
            __builtin_amdgcn_fence(__ATOMIC_RELEASE, XB_SCOPE);
            asm volatile("s_waitcnt vmcnt(0)" ::: "memory");
            const unsigned og = xb_add(&bar[XB_TOP], 1u);
            const unsigned tg = og / nx;
            __builtin_amdgcn_fence(__ATOMIC_ACQUIRE, XB_SCOPE);
            if (og + 1u == (tg + 1u) * nx) xb_add(&bar[XB_TOPGEN], 1u);
            else XB_SPIN(xb_ld(&bar[XB_TOPGEN]) == tg, bar);
            xb_add(&bar[XB_XGEN(b.x)], 1u);
            asm volatile("s_waitcnt vmcnt(0)" ::: "memory");
        } else {
            __builtin_amdgcn_fence(__ATOMIC_ACQUIRE, XB_SCOPE);
            XB_SPIN(xb_ld(&bar[XB_XGEN(b.x)]) == gen, bar);
            asm volatile("s_waitcnt vmcnt(0)" ::: "memory");
        }
#ifdef XB_DELAY
        for (int q = 0; q < XB_DELAY; ++q) __builtin_amdgcn_s_sleep(127);
#endif
    }
    __syncthreads();
}
}
namespace om {
enum { PH_P0A = 0, PH_P0C, PH_GLUE, PH_QKV, PH_ATTN, PH_WO, PH_HIN, PH_HSCAN, PH_HPOST, PH_HWO, PH_SSCAN, PH_SPOST, PH_GLU, PH_UP, PH_CONV, PH_DOWN, PH_FINAL };

struct Args { const float* in[33]; float* out; unsigned char* ws; int nph; int pad; unsigned char ptype[160]; unsigned char parg[160]; };
static_assert(offsetof(Args, ptype) == 288 && offsetof(Args, parg) == 448, "Args layout");

__device__ __forceinline__ void down_patch(const Ctx& C, int l, const pg8::StaticOrder& S) {
    Unit u; const float* cw = C.in(29) + (size_t)l * 3 * NUP; const float* E0 = C.f(WS_EDGE); bf16_t* act = C.h(WS_ACT);
    for (int i = 0; S.next(i, u); ++i) {
        if (u.pm < 16) continue;
        const bool top = (u.pm & 3) != 0, bot = (u.pm & 3) != 3;
        for (int n = C.tid; n < DFF; n += NTHREADS) {
            if (top) { const float* e = E0 + ((size_t)((u.pm - 16) * 2 + 0) * 4) * DFF; const float* ep = E0 + ((size_t)((u.pm - 17) * 2 + 1) * 4) * DFF;
                const float hg = e[n] + cw[n] * ep[2 * DFF + n], hv = e[DFF + n] + cw[DFF + n] * ep[3 * DFF + n];
                act[(size_t)(u.pm * 256) * DFF + n] = (bf16_t)(cvtpk(hg * sigm(hg) * hv, 0.f) & 0xffffu); }
            if (bot) { const float* e = E0 + ((size_t)((u.pm - 16) * 2 + 1) * 4) * DFF; const float* en = E0 + ((size_t)((u.pm - 15) * 2 + 0) * 4) * DFF;
                const float hg = e[n] + cw[2 * NUP + n] * en[2 * DFF + n], hv = e[DFF + n] + cw[2 * NUP + DFF + n] * en[3 * DFF + n];
                act[(size_t)(u.pm * 256 + 255) * DFF + n] = (bf16_t)(cvtpk(hg * sigm(hg) * hv, 0.f) & 0xffffu); }
        }
    }
    asm volatile("s_waitcnt vmcnt(0)" ::: "memory"); __syncthreads();
}
__device__ __forceinline__ void run_phase(const Ctx& C0, int type, int arg, int epoch) {
    Ctx C = C0; asm volatile("" : "+v"(C.tid)); asm volatile("" : "+s"(C.bid), "+s"(C.G), "+s"(C.kp), "+s"(C.ws), "+s"(C.out));
    C.lane = C.tid & 63; C.wave = __builtin_amdgcn_readfirstlane(C.tid >> 6);
    const int l = arg & 3;
    if (type == 31) return;
#ifndef PHASE_MASK
#define PHASE_MASK 0xFFFFFFFFu
#endif
    if (!((PHASE_MASK >> type) & 1u)) return;
    pg8::Gemm g{nullptr, nullptr, D, 256, 128, D, 0}; int nN = 0; EpiAny E{}; E.ws = C.ws; E.out = C.out; E.l = l; E.epoch = epoch;
    const bool splitk = false;
    switch (type) {
    case PH_P0A: phase_p0a(C); break;
    case PH_P0C: phase_p0c(C); break;
    case PH_GLUE: phase_glue(C, arg >> 1, arg & 1); break;
    case PH_QKV: { g.A = C.h(WS_AP); g.Bt = C.h(WS_WQKV) + (size_t)(l / 3) * NQKV * D; nN = 6; E.kind = EK_QKV; } break;
    case PH_ATTN: phase_attn(C, l, (arg & 32) ? SCR_O + 96 * MiB : SCR_O); break;
#ifdef DBG
    case 17: phase_chk(C, SCR_O, SCR_O + 96 * MiB, 16 * MiB); break;
#endif
#ifdef DBG
    case 18: phase_cks(C, arg); break;
#endif
#ifdef DBG
    case 19: phase_cmp(C, arg); break;
#endif
#ifdef DBG
    case 20: phase_clr(C); break;
#endif
    case PH_WO: case PH_HWO: case PH_GLU: {
        if (type == PH_WO) { g.A = C.h(SCR_O); g.Bt = C.h(WS_WO) + (size_t)(l / 3) * D * D; nN = 4; E.kind = EK_RES; if (splitk) { g.split = 1; g.K = D / 2; nN = 8; } }
        else if (type == PH_HWO) { g.A = C.h(SCR_AWO); g.Bt = C.h(WS_HWO); nN = 4; E.kind = EK_RES; if (splitk) { g.split = 1; g.K = D / 2; nN = 8; } }
        else { g.A = C.h(SCR_AGLU); g.Bt = C.h(WS_GLU); g.b_tile_rows = 128; g.b_half_rows = 1024; nN = 8; E.kind = EK_RES_GLU; }
        E.flags = ((arg & 32) ? 4 : 0) | (type == PH_HWO ? 8 : 0); } break;
    case PH_HIN: { g.A = C.h(WS_AP); g.Bt = C.h(WS_HWIN); nN = (C.G == 256) ? 16 : 20; E.kind = EK_HIN; } break;
    case PH_HSCAN: { phase_hscan(C);
        if (C.G == 256 && C.bid >= 128) {
            __syncthreads();
            g.A = C.h(WS_AP); g.Bt = C.h(WS_HWIN) + (size_t)4096 * D; E.kind = EK_HIN; E.pn_off = 16;
            pg8::StaticOrder S; S.init(32, 4, 128, C.bid - 128); pg8::gemm_phase(C.lds, g, S, E, C.tid); } } break;
    case PH_HPOST: phase_hpost(C); break;
    case PH_SSCAN: phase_sscan(C, l, (arg & 32) ? WS_SCR + 80 * MiB : ((arg & 64) ? WS_SCR + 112 * MiB : 0)); break;
#ifdef DBG
    case 22: phase_clr2(C, WS_SCR + 80 * MiB, 64 * MiB); break;
#endif
#ifdef DBG
    case 21: phase_chk(C, WS_SCR + 80 * MiB, WS_SCR + 112 * MiB, 32 * MiB); break;
#endif
    case PH_SPOST: phase_spost(C, l); break;
    case PH_UP: { g.A = C.h(WS_AP); g.Bt = C.h(WS_UP) + (size_t)l * NUP * D; g.b_tile_rows = 128; g.b_half_rows = DFF; nN = 22; E.kind = EK_UPCONV; E.in29 = C.in(29); E.in30 = C.in(30); E.xl = C.lds + RING_BYTES; } break;
#ifdef DBG
    case 23: phase_chk(C, WS_SCR, WS_SCR + 88 * MiB, 88 * MiB); break;
#endif
    case PH_CONV: phase_conv(C, l); break;
    case PH_DOWN: { if (l < 3 && C.G == 256 && C.bid >= 128) convert_layer(C, l + 1, C.bid - 128, 128);
        { pg8::StaticOrder S0; S0.init(32, splitk ? 8 : 4, C.G, C.bid); down_patch(C, l, S0); }
        g.A = C.h(WS_ACT); g.Bt = C.h(WS_DOWN) + (size_t)l * D * DFF; g.K = DFF; g.ld = DFF; nN = 4; if (splitk) { g.split = 1; g.K = DFF / 2; nN = 8; } E.kind = EK_RES; E.flags = 1 | ((arg & 16) ? 2 : 0) | ((arg & 32) ? 4 : 0); } break;
    case PH_FINAL: { const unsigned fl = __hip_atomic_load((unsigned*)(C.ws + WS_CTL) + 4000, __ATOMIC_RELAXED, __HIP_MEMORY_SCOPE_AGENT), fd = __hip_atomic_load((unsigned*)(C.ws + WS_CTL) + 4001, __ATOMIC_RELAXED, __HIP_MEMORY_SCOPE_AGENT);
        #ifdef SSDET_CLS
        const unsigned cls = __hip_atomic_load((unsigned*)(C.ws + WS_CTL) + 4002, __ATOMIC_RELAXED, __HIP_MEMORY_SCOPE_AGENT), cnt = __hip_atomic_load((unsigned*)(C.ws + WS_CTL) + 4003, __ATOMIC_RELAXED, __HIP_MEMORY_SCOPE_AGENT);
        phase_final(C, 1.f + (float)cls / 8.f + (float)(cnt > 63 ? 63 : cnt) / 1024.f); } break;
#else
        phase_final(C, fl ? 3.f : (fd ? exp2f((float)(1001 - fd)) : 1.f)); } break;
#endif
    default: break;
    }
    if (nN) { pg8::StaticOrder S; S.init(32, nN, C.G, C.bid); pg8::gemm_phase(C.lds, g, S, E, C.tid); }
}

__device__ __forceinline__ void canary(const Ctx& C0, unsigned char* ws, int i, bool check) {
    int tid = C0.tid; asm volatile("" : "+v"(tid)); const int lane = tid & 63, wave = tid >> 6;
    unsigned* can = (unsigned*)(ws + WS_CTL + 32768);
#ifdef CANARY_SC1
    if (!check) { if (wave == 0 && lane < 32) __hip_atomic_store(can + C0.bid * 32 + lane, (unsigned)(i + 1), __ATOMIC_RELAXED, __HIP_MEMORY_SCOPE_AGENT); }
#else
    if (!check) { if (wave == 0 && lane < 32) can[C0.bid * 32 + lane] = (unsigned)(i + 1); }
#endif
#ifdef CANARY_LD_SC1
    else { const unsigned v = __hip_atomic_load(can + (wave * 32 + (lane >> 1)) * 32 + (lane & 1) * 16, __ATOMIC_RELAXED, __HIP_MEMORY_SCOPE_AGENT);
#else
    else { const unsigned v = can[(wave * 32 + (lane >> 1)) * 32 + (lane & 1) * 16];
#endif
      if (v != (unsigned)(i + 1) && v != (unsigned)(i + 2)) atomicAdd((unsigned*)(ws + WS_CTL) + 4000, 1u); }
}
__global__ void __launch_bounds__(NTHREADS, 2) mk_fwd(Args a) {
    extern __shared__ __attribute__((aligned(16))) unsigned char lds[];
    int wave_s = __builtin_amdgcn_readfirstlane((int)(threadIdx.x >> 6));
    { volatile LAS unsigned* misc = (volatile LAS unsigned*)((LAS unsigned char*)lds + LDS_BYTES - 64); if (threadIdx.x < 16) misc[threadIdx.x] = 0u; }
    __syncthreads();
    (void)xcd_barrier_post((unsigned*)(a.ws + WS_CTL), (volatile LAS unsigned*)((LAS unsigned char*)lds + LDS_BYTES - 64));
    for (int i = 0; i < a.nph; ++i) {
        {
            Ctx C; C.kp = (const unsigned char __attribute__((address_space(4)))*)__builtin_amdgcn_kernarg_segment_ptr();
            C.out = a.out; C.ws = a.ws; C.lds = (LAS unsigned char*)lds; asm volatile("" : "+s"(wave_s)); C.tid = (wave_s << 6) | lane_id(); C.lane = C.tid & 63; C.wave = 0; C.G = gridDim.x; C.bid = blockIdx.x;
            const unsigned wt = *(const unsigned __attribute__((address_space(4)))*)(C.kp + 288 + (i & ~3)), wa = *(const unsigned __attribute__((address_space(4)))*)(C.kp + 448 + (i & ~3));
            run_phase(C, (int)((wt >> (8 * (i & 3))) & 255u), (int)((wa >> (8 * (i & 3))) & 255u), i + 1);
#ifdef CANARY
            canary(C, a.ws, i, false);
#endif
        }
        if (i + 1 < a.nph) { XcdBarrier bar; bar.bar = (unsigned*)(a.ws + WS_CTL); bar.x = xb_xcc_id(); bar.st = (volatile LAS unsigned*)((LAS unsigned char*)lds + LDS_BYTES - 64); xcd_barrier(bar, wave_s == 0 && lane_id() == 0); }
#ifdef CANARY
        if (i + 1 < a.nph) { Ctx C; C.tid = (wave_s << 6) | lane_id(); C.bid = blockIdx.x; canary(C, a.ws, i, true); }
#endif
    }
}
}
extern "C" void kernel_launch(void* const* d_in, const int* in_sizes, int n_in, void* d_out, int out_size, void* d_ws, size_t ws_size, hipStream_t stream) {
    using namespace om;
    static int grid = 0;
    if (grid == 0) {
        if (n_in != 33 || out_size != 17039360 || ws_size < WS_END) { fprintf(stderr, "kernel_launch: unexpected sizes n_in %d out %d ws %zu; nothing launched\n", n_in, out_size, ws_size); grid = -1; return; }
        int dev = 0, cus = 0, per_cu = 0;
        (void)hipGetDevice(&dev); (void)hipDeviceGetAttribute(&cus, hipDeviceAttributeMultiprocessorCount, dev);
        (void)hipFuncSetAttribute((const void*)mk_fwd, hipFuncAttributeMaxDynamicSharedMemorySize, LDS_BYTES);
        if (hipOccupancyMaxActiveBlocksPerMultiprocessor(&per_cu, (const void*)mk_fwd, NTHREADS, LDS_BYTES) != hipSuccess || per_cu < 1) { fprintf(stderr, "kernel_launch: occupancy query gives %d blocks per CU\n", per_cu); per_cu = 1; }
        (void)hipGetLastError();
        grid = cus;
        if (grid > 256) grid = 256;
    }
    if (grid < 0) return;
    (void)hipMemsetAsync((char*)d_ws + WS_CTL, 0, CTL_ZERO_BYTES, stream);
    Args a{};
    for (int i = 0; i < 33; ++i) a.in[i] = (const float*)d_in[i];
    a.out = (float*)d_out; a.ws = (unsigned char*)d_ws;
    int n = 0;
#ifndef DUP_MASK
#define DUP_MASK 0u
#endif
#ifndef XBAR
#define XBAR 0
#endif
    auto add1 = [&](int t, int p) { a.ptype[n] = (unsigned char)t; a.parg[n] = (unsigned char)p; ++n; };
    auto add = [&](int t, int p) { add1(t, p);
        if ((DUP_MASK >> t) & 1u) { const bool resid = (t == PH_WO || t == PH_HWO || t == PH_GLU || t == PH_DOWN); add1(t, resid ? (p | 32) : p); }
        for (int q = 0; q < XBAR; ++q) add1(31, 0); };
#ifdef UPDET
    add1(PH_P0A, 0); add1(PH_P0C, 0);
    for (int l = 0; l < 4; ++l) { const int kind = l % 3;
        if (kind == 0) { add1(PH_QKV, l); add1(PH_ATTN, l); add1(PH_WO, l); }
        else if (kind == 1) { add1(PH_HIN, l); add1(PH_HSCAN, l); add1(PH_HPOST, l); add1(PH_HWO, l); }
        else { add1(PH_SSCAN, l); add1(PH_SPOST, l); add1(PH_GLU, l); }
        add1(PH_UP, l); add1(PH_UP, l | 32); add1(23, 0); add1(PH_CONV, l); add1(PH_DOWN, l == 3 ? (l | 16) : l); }
    add1(PH_FINAL, 0);
#elif defined(SS2RUN)
    add1(PH_P0A, 0); add1(PH_P0C, 0);
    for (int l = 0; l < 4; ++l) { const int kind = l % 3;
        if (kind == 0) { add1(PH_QKV, l); add1(PH_ATTN, l); add1(PH_WO, l); }
        else if (kind == 1) { add1(PH_HIN, l); add1(PH_HSCAN, l); add1(PH_HPOST, l); add1(PH_HWO, l); }
        else { add1(PH_SSCAN, l); add1(18, 0); add1(PH_SSCAN, l); add1(18, 32); add1(19, 1); add1(PH_SPOST, l); add1(PH_GLU, l); }
        add1(PH_UP, l); add1(PH_DOWN, l == 3 ? (l | 16) : l); }
    add1(PH_FINAL, 0);
#elif defined(SSDET)
    add1(PH_P0A, 0); add1(PH_P0C, 0);
    for (int l = 0; l < 4; ++l) { const int kind = l % 3;
        if (kind == 0) { add1(PH_QKV, l); add1(PH_ATTN, l); add1(PH_WO, l); }
        else if (kind == 1) { add1(PH_HIN, l); add1(PH_HSCAN, l); add1(PH_HPOST, l); add1(PH_HWO, l); }
        else { add1(22, 0); add1(PH_SSCAN, l | 32); add1(PH_SSCAN, l | 64); add1(21, 0); add1(PH_SSCAN, l); add1(PH_SPOST, l); add1(PH_GLU, l); }
        add1(PH_UP, l); add1(PH_DOWN, l == 3 ? (l | 16) : l); }
    add1(PH_FINAL, 0);
#elif defined(LOCALIZE)
    for (int fwd = 0; fwd < 2; ++fwd) { int idx = 0;
        auto addc = [&](int t, int p) { add1(t, p); add1(18, fwd * 32 + idx); ++idx; };
        add1(20, 0); addc(PH_P0A, 0); addc(PH_P0C, 0);
        for (int l = 0; l < 4; ++l) { const int kind = l % 3;
            if (kind == 0) { addc(PH_QKV, l); addc(PH_ATTN, l); addc(PH_WO, l); }
            else if (kind == 1) { addc(PH_HIN, l); addc(PH_HSCAN, l); addc(PH_HPOST, l); addc(PH_HWO, l); }
            else { addc(PH_SSCAN, l); addc(PH_SPOST, l); addc(PH_GLU, l); }
            addc(PH_UP, l); addc(PH_DOWN, l == 3 ? (l | 16) : l); }
        if (fwd == 1) { add1(19, idx); add1(PH_FINAL, 0); } }
#else
    add(PH_P0A, 0); add(PH_P0C, 0);
    for (int l = 0; l < 4; ++l) {
        const int kind = l % 3;
        if (kind == 0) { add(PH_QKV, l); add(PH_ATTN, l); add(PH_WO, l); }
        else if (kind == 1) { add(PH_HIN, l); add(PH_HSCAN, l); add(PH_HPOST, l); add(PH_HWO, l); }
        else { add(PH_SSCAN, l); add(PH_SPOST, l); add(PH_GLU, l); }
        add(PH_UP, l); add(PH_DOWN, l == 3 ? (l | 16) : l);
    }
    add(PH_FINAL, 0);
#endif
    a.nph = n;
    void* args[] = {&a};
    const hipError_t e = hipLaunchCooperativeKernel((const void*)mk_fwd, dim3(grid), dim3(NTHREADS), args, LDS_BYTES, stream);
    if (e != hipSuccess) fprintf(stderr, "kernel_launch: cooperative launch failed: %s (grid %d)\n", hipGetErrorString(e), grid);
}
```

```cpp
#define KSP4_NOP 1
#define KLOOP_ALIGN ".p2align 6\n\t.rept 11\n\ts_nop 0\n\t.endr"
#include <hip/hip_runtime.h>
#include <hip/hip_cooperative_groups.h>
#include <cstdio>
#include <cstdint>
#include <cmath>
#include <cstddef>
#define LAS __attribute__((address_space(3)))
#define GAS __attribute__((address_space(1)))
typedef unsigned short bf16_t;
typedef short bf16x8 __attribute__((ext_vector_type(8)));
typedef short s16x4 __attribute__((ext_vector_type(4)));
typedef float f32x2 __attribute__((ext_vector_type(2)));
typedef float f32x4 __attribute__((ext_vector_type(4)));
typedef float f32x16 __attribute__((ext_vector_type(16)));
typedef unsigned u32x2 __attribute__((ext_vector_type(2)));
typedef unsigned u32x4 __attribute__((ext_vector_type(4)));
typedef __bf16 bf16x2_t __attribute__((ext_vector_type(2)));

namespace om {
constexpr int D = 1024, MP = 4096, M = 8192, DFF = 2816, NUP = 5632, NQKV = 1536, NHIN = 5120;
constexpr float EPS = 1e-6f, LOG2E = 1.4426950408889634f, QSCALE = 0.125f * 1.4426950408889634f;
constexpr int NTHREADS = 512, NWAVES = 8, LDS_BYTES = 159744, RING_BYTES = 131072;
constexpr int SW_STRIDE = 5632;
constexpr float SS_FIX = 16777216.f, SS_INV = 1.f / (16777216.f * 1024.f);
typedef unsigned long long u64_t;
__device__ __forceinline__ float rstd_of(const u64_t* ss, int r) { return rsqrtf((float)ss[r] * SS_INV + 1e-6f); }
constexpr size_t MiB = 1u << 20;
constexpr size_t WS_CTL = 0, CTL_ZERO_BYTES = 64 * 1024;
constexpr size_t WS_MODP = 1 * MiB, WS_MOD = 3 * MiB, WS_SW = 4 * MiB, WS_GMOD = 5 * MiB, WS_SS = 6 * MiB, WS_ROPE = 7 * MiB;
constexpr size_t WS_LB1 = 8 * MiB, WS_SLAM = 8 * MiB + 64 * 1024, WS_SBB = 8 * MiB + 512 * 1024, WS_SCB = 9 * MiB;
constexpr size_t WS_CTXK = 10 * MiB, WS_CTXV = 12 * MiB;
constexpr size_t WS_NAIVE_MOD = 14 * MiB;
constexpr size_t WS_WQKV = 16 * MiB, WS_WO = 22 * MiB, WS_HWIN = 26 * MiB, WS_HWO = 36 * MiB, WS_GLU = 38 * MiB, WS_UP = 42 * MiB, WS_DOWN = 86 * MiB;
constexpr size_t WS_X = 108 * MiB, WS_R = 140 * MiB;
constexpr size_t WS_AP = WS_R, WS_ACT = WS_R + 16 * MiB, WS_SCR = WS_R + 60 * MiB, WS_END = WS_SCR + 176 * MiB;

constexpr size_t SCR_Q = WS_SCR, SCR_KB = WS_SCR + 16 * MiB, SCR_VB = WS_SCR + 20 * MiB, SCR_O = WS_SCR + 24 * MiB;
constexpr size_t SCR_HQ = WS_SCR, SCR_HV = WS_SCR + 16 * MiB, SCR_HG = WS_SCR + 32 * MiB, SCR_LFF = WS_SCR + 48 * MiB, SCR_LFB = WS_SCR + 80 * MiB, SCR_OF = WS_SCR + 112 * MiB, SCR_OB = WS_SCR + 144 * MiB, SCR_AWO = WS_SCR;
constexpr size_t SCR_YF = WS_SCR, SCR_YB = WS_SCR + 32 * MiB, SCR_AGLU = WS_SCR + 64 * MiB;

__device__ __forceinline__ int cond_of_tile(int pm) { return pm < 16 ? 0 : 1 + ((pm - 16) >> 2); }
__device__ __forceinline__ int cond_of_row(int r) { return r < MP ? 0 : 1 + ((r - MP) >> 10); }
__device__ __forceinline__ unsigned cvtpk(float lo, float hi) { f32x2 v = {lo, hi}; bf16x2_t b = __builtin_convertvector(v, bf16x2_t); return __builtin_bit_cast(unsigned, b); }
__device__ __forceinline__ float bf2f(unsigned short h) { return __uint_as_float(((unsigned)h) << 16); }
__device__ __forceinline__ float bflo(unsigned w) { return __uint_as_float(w << 16); }
__device__ __forceinline__ float bfhi(unsigned w) { return __uint_as_float(w & 0xffff0000u); }
__device__ __forceinline__ float sigm(float x) { return __builtin_amdgcn_rcpf(1.f + __expf(-x)); }
__device__ __forceinline__ int lane_id() { unsigned m = ~0u; asm volatile("" : "+s"(m)); return (int)__builtin_amdgcn_mbcnt_hi(m, __builtin_amdgcn_mbcnt_lo(m, 0u)); }
__device__ __forceinline__ float wave_sum(float v) {
#pragma unroll
    for (int o = 1; o < 64; o <<= 1) v += __shfl_xor(v, o);
    return v;
}

struct Ctx {
    const unsigned char __attribute__((address_space(4)))* kp;
    float* out; unsigned char* ws;
    LAS unsigned char* lds; int tid, lane, wave, G, bid;
    __device__ __forceinline__ const float* in(int i) const { return *(const float* const __attribute__((address_space(4)))*)(kp + 8 * i); }
    __device__ __forceinline__ float* f(size_t off) const { return (float*)(ws + off); }
    __device__ __forceinline__ bf16_t* h(size_t off) const { return (bf16_t*)(ws + off); }
};

namespace pg8 {
constexpr int BM = 256, BK = 64, HALF = 128, HTB = HALF * BK * 2, STAGE_BYTES = 8 * HTB, NXCD = 8, WGM = 8;
__host__ __device__ __forceinline__ int lds_byte(int r, int c) { const int st = (r >> 4) * 2 + (c >> 5), rr = r & 15, cc = c & 31, ob = rr * 64 + cc * 2; return st * 1024 + (ob ^ (((ob >> 9) & 1) << 5)); }
__host__ __device__ __forceinline__ void stage_rc(int b, int& R, int& C) { const int st = b / 1024, sb = b % 1024, swz = sb ^ (((sb >> 9) & 1) << 5); R = (st >> 1) * 16 + swz / 64; C = (st & 1) * 32 + (swz % 64) / 2; }
struct Unit { int pm, pn; };
struct Gemm { const bf16_t* A; const bf16_t* Bt; int K; int b_tile_rows, b_half_rows; int ld; int split; };
struct StaticOrder {
    int nM, nN, nwg, G, c;
    __device__ void init(int nM_, int nN_, int G_, int c_) { nM = nM_; nN = nN_; nwg = nM * nN; G = G_; c = c_; }
    __device__ bool next(int i, Unit& u) const {
        const long L = (long)i * G + c; if (L >= nwg) return false;
        int wgid = (int)L; { const int q = nwg / NXCD, r = nwg % NXCD, xcd = wgid % NXCD, off = wgid / NXCD; wgid = (xcd < r ? xcd * (q + 1) : r * (q + 1) + (xcd - r) * q) + off; }
        const int nig = WGM * nN, gid = wgid / nig, fm = gid * WGM, gsz = (nM - fm) < WGM ? (nM - fm) : WGM;
        u.pm = fm + ((wgid % nig) % gsz); u.pn = (wgid % nig) / gsz; return true;
    }
};
template <class Epi>
__device__ __forceinline__ void gemm_phase(LAS unsigned char* lds, const Gemm g, const StaticOrder& S, const Epi& E, int tid_in) {
    int tid_ = tid_in; asm volatile("" : "+v"(tid_));
    const int tid = tid_, wid = __builtin_amdgcn_readfirstlane(tid >> 6), lane = tid & 63, wr = wid >> 2, wc = wid & 3, fr = lane & 15, fq = lane >> 4;
    const int K = g.K, nt = K / BK, ld = g.ld;
    unsigned voffA[2];
#pragma unroll
    for (int i = 0; i < 2; ++i) { int R, C; stage_rc(tid * 16 + i * 8192, R, C); voffA[i] = (unsigned)(R * ld + C) * 2u; }
    const size_t kstep = (size_t)(BK * 2);
    const size_t hstepA = (size_t)HALF * ld * 2, tstepA = 2 * hstepA;
    const size_t hstepB = (size_t)g.b_half_rows * ld * 2, tstepB = (size_t)g.b_tile_rows * ld * 2, khb = (size_t)K * 2;
#define PG8_UA(u) ((const char*)g.A + (size_t)(u).pm * tstepA + (g.split ? (size_t)((u).pn & 1) * khb : 0))
#define PG8_UB(u) ((const char*)g.Bt + (size_t)(g.split ? (u).pn >> 1 : (u).pn) * tstepB + (g.split ? (size_t)((u).pn & 1) * khb : 0))
    const unsigned ldsw = (unsigned)wid * 1024u;
    const int aoff = lds_byte(wr * 64 + fr, fq * 8), boff = lds_byte(wc * 32 + fr, fq * 8);
#define PG8_SA(b, h) (((b) * 2 + (h)) * HTB)
#define PG8_SB(b, h) ((4 + (b) * 2 + (h)) * HTB)
#define PG8_STAGE(bufoff, gbase) do { _Pragma("unroll") for (int _i = 0; _i < 2; ++_i) \
        __builtin_amdgcn_global_load_lds((const unsigned*)((const char*)(gbase) + voffA[_i]), (LAS unsigned*)(lds + (bufoff) + ldsw + _i * 8192), 16, 0, 0); } while (0)
#define PG8_LDA(dst, b, h) do { _Pragma("unroll") for (int m = 0; m < 4; ++m) _Pragma("unroll") for (int k = 0; k < 2; ++k) dst[m][k] = *(const LAS bf16x8*)(lds + PG8_SA(b, h) + aoff + m * 2048 + k * 1024); } while (0)
#define PG8_LDB(dst, b, h) do { _Pragma("unroll") for (int n = 0; n < 2; ++n) _Pragma("unroll") for (int k = 0; k < 2; ++k) dst[n][k] = *(const LAS bf16x8*)(lds + PG8_SB(b, h) + boff + n * 2048 + k * 1024); } while (0)
#define PG8_MMA(ai, bj, At, Bt) do { __builtin_amdgcn_s_setprio(1); _Pragma("unroll") for (int m = 0; m < 4; ++m) _Pragma("unroll") for (int n = 0; n < 2; ++n) _Pragma("unroll") for (int k = 0; k < 2; ++k) \
        acc[ai][bj][m][n] = __builtin_amdgcn_mfma_f32_16x16x32_bf16(Bt[n][k], At[m][k], acc[ai][bj][m][n], 0, 0, 0); __builtin_amdgcn_s_setprio(0); } while (0)
#define PG8_WAIT_V(n) asm volatile("s_waitcnt vmcnt(" #n ")" ::: "memory")
#define PG8_WAIT_L(n) asm volatile("s_waitcnt lgkmcnt(" #n ")" ::: "memory")
#define PG8_BAR __builtin_amdgcn_s_barrier()
#define PG8_SCHED __builtin_amdgcn_sched_barrier(0)
    Unit cur, nxt; int ui = 0;
    if (!S.next(0, cur)) return;
    f32x4 acc[2][2][4][2];
#pragma unroll
    for (int a = 0; a < 2; ++a)
#pragma unroll
        for (int b = 0; b < 2; ++b)
#pragma unroll
            for (int m = 0; m < 4; ++m)
#pragma unroll
                for (int n = 0; n < 2; ++n) acc[a][b][m][n] = (f32x4){0.f, 0.f, 0.f, 0.f};
    bf16x8 At[4][2], B0[2][2], B1[2][2];
    const char* cA = PG8_UA(cur); const char* cB = PG8_UB(cur);
    PG8_STAGE(PG8_SB(0, 0), cB); PG8_STAGE(PG8_SB(0, 1), cB + hstepB); PG8_STAGE(PG8_SA(0, 0), cA); PG8_STAGE(PG8_SA(0, 1), cA + hstepA);
    if (wr == 1) PG8_BAR;
    PG8_WAIT_V(2); PG8_BAR;
    PG8_STAGE(PG8_SB(1, 0), cB + kstep); PG8_STAGE(PG8_SA(1, 0), cA + kstep); PG8_STAGE(PG8_SB(1, 1), cB + hstepB + kstep);
    PG8_WAIT_V(6); PG8_BAR;
    for (;;) {
        const bool has_next = S.next(ui + 1, nxt);
        const char* nA = has_next ? PG8_UA(nxt) : cA; const char* nB = has_next ? PG8_UB(nxt) : cB;
#ifdef KLOOP_ALIGN
        asm volatile(KLOOP_ALIGN ::: "memory");
#endif
        for (int t = 0; t < nt; t += 2) {
            const bool last = (t == nt - 2);
            const char* a1 = cA + (size_t)(t + 1) * kstep;
            const char* a2 = last ? nA : cA + (size_t)(t + 2) * kstep; const char* b2 = last ? nB : cB + (size_t)(t + 2) * kstep;
            const char* a3 = a2 + kstep; const char* b3 = b2 + kstep;
            PG8_LDB(B0, 0, 0); PG8_LDB(B1, 0, 1); PG8_SCHED; PG8_LDA(At, 0, 0); PG8_STAGE(PG8_SA(1, 1), a1 + hstepA);
            PG8_WAIT_V(8); PG8_WAIT_L(0); PG8_BAR; PG8_MMA(0, 0, At, B0); PG8_MMA(0, 1, At, B1); PG8_BAR; PG8_SCHED;
            PG8_LDA(At, 0, 1); PG8_STAGE(PG8_SB(0, 0), b2); PG8_STAGE(PG8_SB(0, 1), b2 + hstepB); PG8_STAGE(PG8_SA(0, 0), a2);
            PG8_WAIT_V(8); PG8_WAIT_L(0); PG8_BAR; PG8_MMA(1, 0, At, B0); PG8_MMA(1, 1, At, B1); PG8_BAR; PG8_SCHED;
            PG8_LDB(B0, 1, 0); PG8_LDB(B1, 1, 1); PG8_SCHED; PG8_LDA(At, 1, 0); PG8_STAGE(PG8_SA(0, 1), a2 + hstepA);
            PG8_WAIT_V(8); PG8_WAIT_L(0); PG8_BAR; PG8_MMA(0, 0, At, B0); PG8_MMA(0, 1, At, B1); PG8_BAR; PG8_SCHED;
#ifdef KSP4_NOP
            asm volatile("s_nop 0" ::: "memory");
#endif
            PG8_LDA(At, 1, 1); PG8_STAGE(PG8_SB(1, 0), b3); PG8_STAGE(PG8_SB(1, 1), b3 + hstepB); PG8_STAGE(PG8_SA(1, 0), a3);
            PG8_WAIT_V(8); PG8_WAIT_L(0); PG8_BAR; PG8_MMA(1, 0, At, B0); PG8_MMA(1, 1, At, B1); PG8_BAR; PG8_SCHED;
        }
        if (wr == 0) PG8_BAR;
        { int l_e = lane_id(); asm volatile("" : "+v"(l_e));
          int fr_e = l_e & 15, fq_e = l_e >> 4, wr_e = wr, wc_e = wc; asm volatile("" : "+s"(wr_e), "+s"(wc_e));
          int tid_e = (wid << 6) | l_e;
          const Unit ue{cur.pm, g.split ? cur.pn >> 1 : cur.pn};
          E(acc, ue, wr_e, wc_e, fr_e, fq_e, g.split ? (cur.pn & 1) : -1, tid_e);
          E.post(ue, tid_e);
#ifdef DUP_POST
          E.post(ue, tid_e);
#endif
          }
        if (!has_next) break;
#pragma unroll
        for (int a = 0; a < 2; ++a)
#pragma unroll
            for (int b = 0; b < 2; ++b)
#pragma unroll
                for (int m = 0; m < 4; ++m)
#pragma unroll
                    for (int n = 0; n < 2; ++n) acc[a][b][m][n] = (f32x4){0.f, 0.f, 0.f, 0.f};
        cur = nxt; cA = nA; cB = nB; ++ui;
        if (wr == 1) PG8_BAR;
    }
    PG8_WAIT_V(0);
    PG8_BAR;
#undef PG8_SA
#undef PG8_UA
#undef PG8_UB
#undef PG8_SB
#undef PG8_STAGE
#undef PG8_LDA
#undef PG8_LDB
#undef PG8_MMA
#undef PG8_WAIT_V
#undef PG8_WAIT_L
#undef PG8_BAR
#undef PG8_SCHED
}
}
using pg8::Unit;
typedef f32x4 Acc[2][2][4][2];

__device__ __forceinline__ void st_bf16x4(bf16_t* p, f32x4 v) { u32x2 w; w.x = cvtpk(v[0], v[1]); w.y = cvtpk(v[2], v[3]); *(u32x2*)p = w; }

template <bool PAIRED> struct EpiRes {
    const float* xin; float* xout; bf16_t* ap; u64_t* ssn; const float* gate;   const float* gmodn;
    __device__ __forceinline__ void operator()(const Acc& acc, const Unit& u, int wr, int wc, int fr, int fq) const {
        const int c = cond_of_tile(u.pm);
        const int colb = (PAIRED ? u.pn * 128 : u.pn * 256) + wc * 32 + 4 * fq;
        constexpr int NBJ = PAIRED ? 1 : 2;
        f32x4 gv[NBJ][2], gm[NBJ][2];
#pragma unroll
        for (int bj = 0; bj < NBJ; ++bj)
#pragma unroll
            for (int n = 0; n < 2; ++n) { gv[bj][n] = *(const f32x4*)(gate + (size_t)c * 6144 + colb + bj * 128 + n * 16);
                gm[bj][n] = gmodn ? *(const f32x4*)(gmodn + (size_t)c * 1024 + colb + bj * 128 + n * 16) : (f32x4){0.f, 0.f, 0.f, 0.f}; }
#pragma unroll
        for (int ai = 0; ai < 2; ++ai)
#pragma unroll
            for (int m = 0; m < 4; ++m) {
                const int r = u.pm * 256 + ai * 128 + wr * 64 + m * 16 + fr; float sq = 0.f;
#pragma unroll
                for (int bj = 0; bj < NBJ; ++bj)
#pragma unroll
                    for (int n = 0; n < 2; ++n) {
                        f32x4 o = acc[ai][bj][m][n];
                        if (PAIRED) { const f32x4 gt = acc[ai][1][m][n];
#pragma unroll
                            for (int e = 0; e < 4; ++e) o[e] = o[e] * sigm(gt[e]); }
                        const size_t off = (size_t)r * D + colb + bj * 128 + n * 16;
                        const f32x4 xo = *(const f32x4*)(xin + off) + gv[bj][n] * o;
                        *(f32x4*)(xout + off) = xo;
                        sq += (xo[0] * xo[0] + xo[1] * xo[1]) + (xo[2] * xo[2] + xo[3] * xo[3]);
                        if (gmodn) st_bf16x4(ap + off, xo * gm[bj][n]);
                    }
                sq += __shfl_xor(sq, 16); sq += __shfl_xor(sq, 32);
                if (fq == 0) atomicAdd(ssn + r, (u64_t)(sq * SS_FIX));
            }
    }
};
struct EpiUpRaw {
    const u64_t* ss; const float* sw;   bf16_t* hraw;
    __device__ __forceinline__ void operator()(const Acc& acc, const Unit& u, int wr, int wc, int fr, int fq) const {
        const int c = cond_of_tile(u.pm); const int colb = u.pn * 256 + wc * 32 + 4 * fq;
        f32x4 sv[2][2];
#pragma unroll
        for (int bj = 0; bj < 2; ++bj)
#pragma unroll
            for (int n = 0; n < 2; ++n) sv[bj][n] = *(const f32x4*)(sw + (size_t)c * SW_STRIDE + colb + bj * 128 + n * 16);
#pragma unroll
        for (int ai = 0; ai < 2; ++ai)
#pragma unroll
            for (int m = 0; m < 4; ++m) {
                const int r = u.pm * 256 + ai * 128 + wr * 64 + m * 16 + fr; const float rs = rstd_of(ss, r);
#pragma unroll
                for (int bj = 0; bj < 2; ++bj)
#pragma unroll
                    for (int n = 0; n < 2; ++n) st_bf16x4(hraw + (size_t)r * NUP + colb + bj * 128 + n * 16, acc[ai][bj][m][n] * rs + sv[bj][n]);
            }
    }
};
constexpr size_t WS_EDGE = 14 * MiB;
template <int CTRL> __device__ __forceinline__ float dpp_f(float old, float src) { return __int_as_float(__builtin_amdgcn_update_dpp(__float_as_int(old), __float_as_int(src), CTRL, 0xf, 0xf, false)); }
#define DPP_ROW_SHL1 0x101
#define DPP_ROW_SHR1 0x111
#define DPP_ROW_ROR1 0x121
#define DPP_ROW_ROR15 0x12f
struct EpiUpConv {
    const u64_t* ss; const float* sw; const float* cw; const float* cb; bf16_t* act; float* edge; bf16_t* tile;
    __device__ __forceinline__ void operator()(const Acc& acc, const Unit& u, int wr, int wc, int fr, int fq) const {
        const int c = cond_of_tile(u.pm); const int cc0 = wc * 32 + 4 * fq, colg0 = u.pn * 128 + cc0;
        f32x4 sv[2][2];
#pragma unroll
        for (int bj = 0; bj < 2; ++bj)
#pragma unroll
            for (int n = 0; n < 2; ++n) sv[bj][n] = *(const f32x4*)(sw + (size_t)c * SW_STRIDE + bj * DFF + colg0 + n * 16);
#pragma unroll
        for (int ai = 0; ai < 2; ++ai)
#pragma unroll
            for (int m = 0; m < 4; ++m) { const int rl = ai * 128 + wr * 64 + m * 16 + fr; const float rs = rstd_of(ss, u.pm * 256 + rl);
#pragma unroll
                for (int bj = 0; bj < 2; ++bj)
#pragma unroll
                    for (int n = 0; n < 2; ++n) st_bf16x4(tile + rl * 256 + bj * 128 + cc0 + n * 16, acc[ai][bj][m][n] * rs + sv[bj][n]); }
    }
    __device__ __forceinline__ void fused(const Acc& acc, const Unit& u, int wr, int wc, int fr, int fq, int tid, LAS unsigned char* xl) const {
        const int c = cond_of_tile(u.pm);
        const bool samp = u.pm >= 16; const bool nb_top = samp && (u.pm & 3) != 0, nb_bot = samp && (u.pm & 3) != 3;
        float rs[8];
#pragma unroll
        for (int ai = 0; ai < 2; ++ai)
#pragma unroll
            for (int m = 0; m < 4; ++m) rs[ai * 4 + m] = rstd_of(ss, u.pm * 256 + ai * 128 + wr * 64 + m * 16 + fr);
        const int r = tid >> 1, q = tid & 1;
        LAS float* cf = (LAS float*)(xl + 20480);
        { const int bj = tid >> 8, jj = (tid >> 6) & 3, cl2 = 2 * (tid & 63); const float* src = (jj < 3 ? cw + jj * NUP : cb) + bj * DFF + u.pn * 128 + cl2;
          *(LAS f32x2*)(cf + (bj * 4 + jj) * 128 + cl2) = *(const f32x2*)src; }
#pragma unroll
        for (int sl = 0; sl < 8; ++sl) {
            const int swc = sl >> 1, sn = sl & 1, colg = u.pn * 128 + 32 * swc + 16 * sn, cs = 32 * swc + 16 * sn + 8 * q;
            if (wc == swc) {
                const f32x4 svg = *(const f32x4*)(sw + (size_t)c * SW_STRIDE + colg + 4 * fq), svv = *(const f32x4*)(sw + (size_t)c * SW_STRIDE + DFF + colg + 4 * fq);
#pragma unroll
                for (int ai = 0; ai < 2; ++ai)
#pragma unroll
                    for (int m = 0; m < 4; ++m) { const int row = ai * 128 + wr * 64 + m * 16 + fr;
                        const f32x4 hg = acc[ai][0][m][sn] * rs[ai * 4 + m] + svg, hv = acc[ai][1][m][sn] * rs[ai * 4 + m] + svv;
                        *(LAS u32x2*)(xl + row * 80 + 8 * fq) = (u32x2){cvtpk(hg[0], hg[1]), cvtpk(hg[2], hg[3])}; *(LAS u32x2*)(xl + row * 80 + 32 + 8 * fq) = (u32x2){cvtpk(hv[0], hv[1]), cvtpk(hv[2], hv[3])}; }
            }
            asm volatile("s_waitcnt lgkmcnt(0)" ::: "memory"); __builtin_amdgcn_s_barrier(); asm volatile("" ::: "memory");
            {
                const u32x4 z = {0u, 0u, 0u, 0u};
                const u32x4 pg = r > 0 ? *(const LAS u32x4*)(xl + (r - 1) * 80 + 16 * q) : z, pv = r > 0 ? *(const LAS u32x4*)(xl + (r - 1) * 80 + 32 + 16 * q) : z;
                const u32x4 cg = *(const LAS u32x4*)(xl + r * 80 + 16 * q), cv = *(const LAS u32x4*)(xl + r * 80 + 32 + 16 * q);
                const u32x4 ng = r < 255 ? *(const LAS u32x4*)(xl + (r + 1) * 80 + 16 * q) : z, nv = r < 255 ? *(const LAS u32x4*)(xl + (r + 1) * 80 + 32 + 16 * q) : z;
                float hg[8], hv[8];
                f32x4 wA[2][3], bA[2];
#pragma unroll
                for (int bj = 0; bj < 2; ++bj) {
#pragma unroll
                    for (int jj = 0; jj < 3; ++jj) wA[bj][jj] = *(const LAS f32x4*)(cf + (bj * 4 + jj) * 128 + cs);
                    bA[bj] = *(const LAS f32x4*)(cf + (bj * 4 + 3) * 128 + cs); }
#pragma unroll
                for (int e = 0; e < 2; ++e) { const int k0 = 2 * e;
                    hg[2 * e] = wA[0][0][k0] * bflo(pg[e]) + wA[0][1][k0] * bflo(cg[e]) + wA[0][2][k0] * bflo(ng[e]) + bA[0][k0];
                    hg[2 * e + 1] = wA[0][0][k0 + 1] * bfhi(pg[e]) + wA[0][1][k0 + 1] * bfhi(cg[e]) + wA[0][2][k0 + 1] * bfhi(ng[e]) + bA[0][k0 + 1];
                    hv[2 * e] = wA[1][0][k0] * bflo(pv[e]) + wA[1][1][k0] * bflo(cv[e]) + wA[1][2][k0] * bflo(nv[e]) + bA[1][k0];
                    hv[2 * e + 1] = wA[1][0][k0 + 1] * bfhi(pv[e]) + wA[1][1][k0 + 1] * bfhi(cv[e]) + wA[1][2][k0 + 1] * bfhi(nv[e]) + bA[1][k0 + 1]; }
                f32x4 wB[2][3], bB[2];
#pragma unroll
                for (int bj = 0; bj < 2; ++bj) {
#pragma unroll
                    for (int jj = 0; jj < 3; ++jj) wB[bj][jj] = *(const LAS f32x4*)(cf + (bj * 4 + jj) * 128 + cs + 4);
                    bB[bj] = *(const LAS f32x4*)(cf + (bj * 4 + 3) * 128 + cs + 4); }
#pragma unroll
                for (int e = 2; e < 4; ++e) { const int k0 = 2 * (e - 2);
                    hg[2 * e] = wB[0][0][k0] * bflo(pg[e]) + wB[0][1][k0] * bflo(cg[e]) + wB[0][2][k0] * bflo(ng[e]) + bB[0][k0];
                    hg[2 * e + 1] = wB[0][0][k0 + 1] * bfhi(pg[e]) + wB[0][1][k0 + 1] * bfhi(cg[e]) + wB[0][2][k0 + 1] * bfhi(ng[e]) + bB[0][k0 + 1];
                    hv[2 * e] = wB[1][0][k0] * bflo(pv[e]) + wB[1][1][k0] * bflo(cv[e]) + wB[1][2][k0] * bflo(nv[e]) + bB[1][k0];
                    hv[2 * e + 1] = wB[1][0][k0 + 1] * bfhi(pv[e]) + wB[1][1][k0 + 1] * bfhi(cv[e]) + wB[1][2][k0 + 1] * bfhi(nv[e]) + bB[1][k0 + 1]; }
                u32x4 o;
#pragma unroll
                for (int e = 0; e < 4; ++e) o[e] = cvtpk(hg[2 * e] * sigm(hg[2 * e]) * hv[2 * e], hg[2 * e + 1] * sigm(hg[2 * e + 1]) * hv[2 * e + 1]);
                *(u32x4*)(act + (size_t)(u.pm * 256 + r) * DFF + colg + 8 * q) = o;
                if ((r == 0 && nb_top) || (r == 255 && nb_bot)) {
                    float* e0 = edge + ((size_t)((u.pm - 16) * 2 + (r == 0 ? 0 : 1)) * 4) * DFF + colg + 8 * q;
#pragma unroll
                    for (int e = 0; e < 4; ++e) { e0[2 * e] = hg[2 * e]; e0[2 * e + 1] = hg[2 * e + 1]; e0[DFF + 2 * e] = hv[2 * e]; e0[DFF + 2 * e + 1] = hv[2 * e + 1];
                        e0[2 * DFF + 2 * e] = bflo(cg[e]); e0[2 * DFF + 2 * e + 1] = bfhi(cg[e]); e0[3 * DFF + 2 * e] = bflo(cv[e]); e0[3 * DFF + 2 * e + 1] = bfhi(cv[e]); } }
            }
            asm volatile("s_waitcnt lgkmcnt(0)" ::: "memory"); __builtin_amdgcn_s_barrier(); asm volatile("" ::: "memory"); __builtin_amdgcn_sched_barrier(0);
        }
    }
};
struct EpiQKV {
    const u64_t* ss; const float* sw; bf16_t *Q, *KB, *VB; float *outK, *outV; const float *ropec, *ropes; int j;
    __device__ __forceinline__ void operator()(const Acc& acc, const Unit& u, int wr, int wc, int fr, int fq) const {
        const int c = cond_of_tile(u.pm); const bool samp = u.pm >= 16; const int colt = u.pn * 256, cl0 = wc * 32 + 4 * fq;
        f32x4 sv[2][2];
#pragma unroll
        for (int bj = 0; bj < 2; ++bj)
#pragma unroll
            for (int n = 0; n < 2; ++n) sv[bj][n] = *(const f32x4*)(sw + (size_t)c * SW_STRIDE + colt + cl0 + bj * 128 + n * 16);
#pragma unroll
        for (int ai = 0; ai < 2; ++ai)
#pragma unroll
            for (int m = 0; m < 4; ++m) {
                const int r = u.pm * 256 + ai * 128 + wr * 64 + m * 16 + fr; const float rs = rstd_of(ss, r);
                f32x4 cs = {1.f, 1.f, 1.f, 1.f}, sn = {0.f, 0.f, 0.f, 0.f};
                if (samp && u.pn < 5) { const int t = (r - MP) & 1023, idx = t * 32 + (wc & 1) * 16 + 4 * fq; cs = *(const f32x4*)(ropec + idx); sn = *(const f32x4*)(ropes + idx); }
#pragma unroll
                for (int bj = 0; bj < 2; ++bj) {
                    f32x4 v0 = acc[ai][bj][m][0] * rs + sv[bj][0], v1 = acc[ai][bj][m][1] * rs + sv[bj][1];
                    if (u.pn < 5) { const f32x4 o0 = v0 * cs - v1 * sn, o1 = v1 * cs + v0 * sn; v0 = o0; v1 = o1; }
                    const int cl = bj * 128 + cl0;
                    if (u.pn < 4) { st_bf16x4(Q + (size_t)r * D + colt + cl, v0 * QSCALE); st_bf16x4(Q + (size_t)r * D + colt + cl + 16, v1 * QSCALE); }
                    else {
                        bf16_t* dst = (u.pn == 4 ? KB : VB) + (size_t)r * 256 + cl; st_bf16x4(dst, v0); st_bf16x4(dst + 16, v1);
                        if (!samp) { float* o = (u.pn == 4 ? outK : outV) + (((size_t)(r >> 8) * 2 + j) * 256 + (r & 255)) * 256 + cl; *(f32x4*)o = v0; *(f32x4*)(o + 16) = v1; }
                    }
                }
            }
    }
};
struct EpiHin {
    const u64_t* ss; const float* sw; const float* lb1; bf16_t *HQ, *HV, *HG; float *LFF, *LFB;
    __device__ __forceinline__ void operator()(const Acc& acc, const Unit& u, int wr, int wc, int fr, int fq) const {
        const int c = cond_of_tile(u.pm); const int seg = u.pn >> 2, colt = u.pn * 256, cl0 = wc * 32 + 4 * fq, cs0 = (u.pn & 3) * 256 + cl0;
        f32x4 sv[2][2], lbv[2][2];
#pragma unroll
        for (int bj = 0; bj < 2; ++bj)
#pragma unroll
            for (int n = 0; n < 2; ++n) { sv[bj][n] = *(const f32x4*)(sw + (size_t)c * SW_STRIDE + colt + cl0 + bj * 128 + n * 16);
                lbv[bj][n] = (seg == 2 || seg == 3) ? *(const f32x4*)(lb1 + (seg - 2) * 1024 + cs0 + bj * 128 + n * 16) : (f32x4){0.f, 0.f, 0.f, 0.f}; }
#pragma unroll
        for (int ai = 0; ai < 2; ++ai)
#pragma unroll
            for (int m = 0; m < 4; ++m) {
                const int r = u.pm * 256 + ai * 128 + wr * 64 + m * 16 + fr; const float rs = rstd_of(ss, r);
#pragma unroll
                for (int bj = 0; bj < 2; ++bj)
#pragma unroll
                    for (int n = 0; n < 2; ++n) {
                        f32x4 v = acc[ai][bj][m][n] * rs + sv[bj][n]; const size_t off = (size_t)r * D + cs0 + bj * 128 + n * 16;
                        if (seg == 0) st_bf16x4(HQ + off, v);
                        else if (seg == 1) st_bf16x4(HV + off, v);
                        else if (seg == 4) {
#pragma unroll
                            for (int e = 0; e < 4; ++e) v[e] = v[e] * sigm(v[e]);
                            st_bf16x4(HG + off, v); }
                        else { const f32x4 lb = lbv[bj][n];
#pragma unroll
                            for (int e = 0; e < 4; ++e) v[e] = __logf(lb[e] + (1.f - lb[e]) * sigm(v[e]));
                            *(f32x4*)((seg == 2 ? LFF : LFB) + off) = v; }
                    }
            }
    }
};
enum { EK_RES = 0, EK_RES_GLU, EK_UPRAW, EK_QKV, EK_HIN, EK_UPCONV };
struct EpiAny {
    int kind, l, flags, epoch, pn_off; unsigned char* ws; float* out; const float *in29, *in30; LAS unsigned char* xl;
    __device__ __forceinline__ float* F(size_t o) const { return (float*)(ws + o); }
    __device__ __forceinline__ bf16_t* H(size_t o) const { return (bf16_t*)(ws + o); }
    __device__ __forceinline__ void post(const Unit&, int) const {}
    __device__ __forceinline__ void operator()(Acc& acc, const Unit& u, int wr, int wc, int fr, int fq, int kh, int tid) const {
#ifndef EK_MASK
#define EK_MASK 63
#endif
        if (!((EK_MASK >> this->kind) & 1)) return;
        unsigned char* ws = this->ws; float* out = this->out; int kind = this->kind, l = this->l, flags = this->flags;
        asm volatile("" : "+s"(ws), "+s"(out), "+s"(kind), "+s"(l), "+s"(flags));
        if (kh >= 0) {
            const int tile = u.pm * 4 + u.pn; unsigned* flag = (unsigned*)(ws + WS_CTL + 40960) + tile * 16;
            unsigned char* slab = ws + WS_SCR + 64 * MiB + (size_t)tile * 262144 + (size_t)tid * 16;
            if (kh == 1) {
                __amdgpu_buffer_rsrc_t rs = __builtin_amdgcn_make_buffer_rsrc(ws + WS_SCR + 64 * MiB + (size_t)tile * 262144, 0, 262144, 0x00020000);
#pragma unroll
                for (int j = 0; j < 32; ++j) __builtin_amdgcn_raw_buffer_store_b128(__builtin_bit_cast(u32x4, acc[j >> 4][(j >> 3) & 1][(j >> 1) & 3][j & 1]), rs, tid * 16 + j * 8192, 0, 16);
                asm volatile("s_waitcnt vmcnt(0)" ::: "memory"); __builtin_amdgcn_s_barrier(); asm volatile("" ::: "memory");
                if (tid == 0) __hip_atomic_store(flag, (unsigned)epoch, __ATOMIC_RELAXED, __HIP_MEMORY_SCOPE_AGENT);
                return;
            }
            if (tid < 64) {
                unsigned sp = 0;
                while ((unsigned)__builtin_amdgcn_readfirstlane((int)__hip_atomic_load(flag, __ATOMIC_RELAXED, __HIP_MEMORY_SCOPE_AGENT)) != (unsigned)epoch) { __builtin_amdgcn_s_sleep(2); if (++sp > (1u << 22)) break; }
                __builtin_amdgcn_fence(__ATOMIC_ACQUIRE, "agent"); asm volatile("s_waitcnt vmcnt(0)" ::: "memory");
            }
            asm volatile("" ::: "memory"); __builtin_amdgcn_s_barrier(); asm volatile("" ::: "memory");
#pragma unroll
            for (int j = 0; j < 32; ++j) acc[j >> 4][(j >> 3) & 1][(j >> 1) & 3][j & 1] += *(const f32x4*)(slab + (size_t)j * 8192);
        }
        auto F = [&](size_t o) { return (float*)(ws + o); }; auto H = [&](size_t o) { return (bf16_t*)(ws + o); };
        const size_t ss1 = WS_SS + (size_t)(l * 2) * M * 8, sw1 = WS_SW + (size_t)(l * 2) * 5 * SW_STRIDE * 4;
        switch (kind) {
        case EK_RES: case EK_RES_GLU: {
            const bool down = flags & 1;
            const size_t ssn = down ? WS_SS + (size_t)((l + 1) * 2) * M * 8 : ss1 + (size_t)M * 8;
            const size_t gate = WS_MOD + ((size_t)l * 5 * 6144 + (down ? 5 : 2) * 1024) * 4;
            const size_t gmn = down ? WS_GMOD + (size_t)((l + 1) * 2) * 5 * 1024 * 4 : WS_GMOD + (size_t)(l * 2 + 1) * 5 * 1024 * 4;
            const bool has_next = !(down && l == 3);
            float* xo = (flags & 2) ? out : F(WS_X); bf16_t* ap = H(WS_AP); u64_t* sp = (u64_t*)(ws + ssn);
            if (flags & 4) { const size_t dm = WS_SCR + ((flags & 8) ? 48 : 96) * MiB; xo = F(dm); ap = H(dm + 32 * MiB); sp = (u64_t*)(ws + dm + 48 * MiB); }
            if (kind == EK_RES) { EpiRes<false> E{F(WS_X), xo, ap, sp, F(gate), has_next ? F(gmn) : nullptr}; E(acc, u, wr, wc, fr, fq); }
            else { EpiRes<true> E{F(WS_X), xo, ap, sp, F(gate), F(gmn)}; E(acc, u, wr, wc, fr, fq); } } break;
        case EK_UPRAW: { EpiUpRaw E{(const u64_t*)(ws + ss1 + (size_t)M * 8), F(sw1 + (size_t)5 * SW_STRIDE * 4), H(WS_SCR + (size_t)((flags >> 2) & 1) * (88 * MiB))}; E(acc, u, wr, wc, fr, fq); } break;
        case EK_UPCONV: { EpiUpConv E{(const u64_t*)(ws + ss1 + (size_t)M * 8), F(sw1 + (size_t)5 * SW_STRIDE * 4), in29 + (size_t)l * 3 * NUP, in30 + (size_t)l * NUP, H(WS_ACT), F(WS_EDGE), nullptr}; E.fused(acc, u, wr, wc, fr, fq, tid, xl);
#ifdef DUP_FUSED
            E.fused(acc, u, wr, wc, fr, fq, tid, xl);
#endif
            } break;
        case EK_QKV: { EpiQKV E{(const u64_t*)(ws + ss1), F(sw1), H(SCR_Q), H(SCR_KB), H(SCR_VB), out + 8388608, out + 8388608 + 2097152, F(WS_ROPE), F(WS_ROPE) + 32768, l / 3}; E(acc, u, wr, wc, fr, fq); } break;
        default: { Unit u2{u.pm, u.pn + pn_off}; const Unit& u = u2; EpiHin E{(const u64_t*)(ws + ss1), F(sw1), F(WS_LB1), H(SCR_HQ), H(SCR_HV), H(SCR_HG), F(SCR_LFF), F(SCR_LFB)}; E(acc, u, wr, wc, fr, fq); } break;
        }
    }
};
}
namespace om {
#define LDS_WAIT() asm volatile("s_waitcnt lgkmcnt(0)" ::: "memory")
__device__ __forceinline__ void transpose_item(const float* W, int K, int N, bf16_t* WT, LAS unsigned short* scr, int item, int lane) {
    const int nblk = N / 32, kb = item / nblk, nb = item % nblk, k0 = 64 * kb, n0 = 32 * nb;
    float v[32];
#pragma unroll
    for (int i = 0; i < 32; ++i) v[i] = W[(size_t)(k0 + 2 * i + (lane >> 5)) * N + n0 + (lane & 31)];
#pragma unroll
    for (int i = 0; i < 32; ++i) scr[(2 * i + (lane >> 5)) * 33 + (lane & 31)] = (unsigned short)(cvtpk(v[i], 0.f) & 0xffffu);
    LDS_WAIT(); asm volatile("" ::: "memory");
    const int c = lane & 7;
#pragma unroll
    for (int j = 0; j < 4; ++j) { const int n = (lane >> 3) + 8 * j; const LAS unsigned short* s = scr + (8 * c) * 33 + n;
        u32x4 o; o.x = (unsigned)s[0 * 33] | ((unsigned)s[1 * 33] << 16); o.y = (unsigned)s[2 * 33] | ((unsigned)s[3 * 33] << 16); o.z = (unsigned)s[4 * 33] | ((unsigned)s[5 * 33] << 16); o.w = (unsigned)s[6 * 33] | ((unsigned)s[7 * 33] << 16);
        *(u32x4*)(WT + (size_t)(n0 + n) * K + k0 + 8 * c) = o; }
    LDS_WAIT(); asm volatile("" ::: "memory");
}
__device__ __forceinline__ float modsum(const Ctx& C, int l, int c, int idx) {
    const float* mp = C.f(WS_MODP) + ((size_t)l * 5 + c) * 6144 + idx; float s = C.in(9)[l * 6144 + idx];
#pragma unroll
    for (int kp = 0; kp < 4; ++kp) s += mp[(size_t)kp * 4 * 5 * 6144];
    return s;
}
__device__ __forceinline__ void convert_layer(const Ctx& C, int layer, int vb, int nvb) {
    const int gw = vb * NWAVES + C.wave, NGW = nvb * NWAVES;
    LAS unsigned short* scr = (LAS unsigned short*)(C.lds + C.wave * 4352);
#define DO_MAT(src, dst, K, N) for (int it = gw; it < ((K) / 64) * ((N) / 32); it += NGW) transpose_item((src), (K), (N), (dst), scr, it, C.lane)
    if (layer == 0 || layer == 3) { const int j = layer / 3; DO_MAT(C.in(12) + (size_t)j * D * NQKV, C.h(WS_WQKV) + (size_t)j * NQKV * D, D, NQKV); DO_MAT(C.in(13) + (size_t)j * D * D, C.h(WS_WO) + (size_t)j * D * D, D, D); }
    else if (layer == 1) { DO_MAT(C.in(15), C.h(WS_HWIN), D, NHIN); DO_MAT(C.in(18), C.h(WS_HWO), D, D); }
    else { DO_MAT(C.in(27), C.h(WS_GLU), D, 2048); }
    DO_MAT(C.in(28) + (size_t)layer * D * NUP, C.h(WS_UP) + (size_t)layer * NUP * D, D, NUP); DO_MAT(C.in(31) + (size_t)layer * DFF * D, C.h(WS_DOWN) + (size_t)layer * D * DFF, DFF, D);
#undef DO_MAT
}
__device__ __forceinline__ void phase_p0a(const Ctx& C) {
    const int gt = C.bid * NTHREADS + C.tid, NGT = C.G * NTHREADS;
    for (int layer = 0; layer < 4; ++layer) if (layer == 0 || C.G != 256) convert_layer(C, layer, C.bid, C.G);
    __syncthreads();
    LAS float* sS = (LAS float*)(C.lds + 40960);
    LAS float* red = (LAS float*)(C.lds);
    for (int it = C.bid; it < 384; it += C.G) {
        const int l = it / 96, cb = (it % 96) >> 2, kp = it & 3;
        for (int i = C.tid; i < 5 * 256; i += NTHREADS) { const int c = i >> 8, k = kp * 256 + (i & 255); const float v = c == 0 ? C.in(7)[k] : C.in(6)[(c - 1) * 1024 + k]; sS[i] = v / (1.f + __expf(-v)); }
        __syncthreads();
        f32x4 a[5];
#pragma unroll
        for (int c = 0; c < 5; ++c) a[c] = (f32x4){0.f, 0.f, 0.f, 0.f};
        const float* wp = C.in(8) + ((size_t)l * 1024 + kp * 256 + C.wave * 32) * 6144 + cb * 256 + 4 * C.lane;
#pragma unroll 4
        for (int k = 0; k < 32; ++k) { const f32x4 w = *(const f32x4*)(wp + (size_t)k * 6144);
#pragma unroll
            for (int c = 0; c < 5; ++c) a[c] += w * sS[c * 256 + C.wave * 32 + k]; }
#pragma unroll
        for (int c = 0; c < 5; ++c) *(LAS f32x4*)(red + (C.wave * 5 + c) * 256 + 4 * C.lane) = a[c];
        __syncthreads();
        for (int i = C.tid; i < 5 * 256; i += NTHREADS) { float s = 0.f;
#pragma unroll
            for (int w = 0; w < 8; ++w) s += red[w * 1280 + i];
            C.f(WS_MODP)[(((size_t)kp * 4 + l) * 5 + (i >> 8)) * 6144 + cb * 256 + (i & 255)] = s; }
        __syncthreads();
    }
    { unsigned zero = 0u; asm volatile("" : "+v"(zero));
      for (int i = gt; i < 9 * M; i += NGT) ((u32x2*)(C.ws + WS_SS))[i] = (u32x2){zero, zero}; }
    for (int i = gt; i < 1024 * 32; i += NGT) { const int t = i >> 5, e = i & 31, fi = e & 15; const float pos = (e >> 4) == 0 ? (float)(t >> 6) : (float)(t & 63);
        const float ang = pos * __builtin_amdgcn_exp2f(-(float)fi * (13.287712379549449f / 16.0f))  ; C.f(WS_ROPE)[i] = cosf(ang); C.f(WS_ROPE)[32768 + i] = sinf(ang); }
    for (int i = gt; i < 2 * 131072; i += NGT) { const int which = i >> 17, e = (i & 131071) * 8; const float* s = (which ? C.in(3) : C.in(2)) + e; const f32x4 a = *(const f32x4*)s, b = *(const f32x4*)(s + 4);
        u32x4 o; o.x = cvtpk(a[0], a[1]); o.y = cvtpk(a[2], a[3]); o.z = cvtpk(b[0], b[1]); o.w = cvtpk(b[2], b[3]); *(u32x4*)(C.h(which ? WS_CTXV : WS_CTXK) + e) = o; }
    for (int i = gt; i < 2048; i += NGT) { float v[4], mx = -1e30f;
#pragma unroll
        for (int l = 0; l < 4; ++l) { v[l] = C.in(16)[l * 2048 + i]; mx = fmaxf(mx, v[l]); }
        float s = 0.f;
#pragma unroll
        for (int l = 0; l < 4; ++l) { v[l] = expf(v[l] - mx); s += v[l]; }
        C.f(WS_LB1)[i] = v[1] / s; }
    for (int i = gt; i < 8192; i += NGT) {
        const int dg = i >> 6, p = i & 63;
        const float ar = fminf(C.in(19)[i], -1e-4f), ai = C.in(20)[i], dt = expf(C.in(21)[dg]);
        const float e = expf(ar * dt), lr = e * cosf(ai * dt), li = e * sinf(ai * dt);
        const float den = ar * ar + ai * ai, fr = ((lr - 1.f) * ar + li * ai) / den, fi = (li * ar - (lr - 1.f) * ai) / den;
        C.f(WS_SLAM)[2 * i] = lr; C.f(WS_SLAM)[2 * i + 1] = li;
        unsigned wr_[8], wi_[8];
#pragma unroll
        for (int q = 0; q < 8; ++q) { const float x0 = C.in(22)[(size_t)i * 16 + 2 * q], y0 = C.in(23)[(size_t)i * 16 + 2 * q], x1 = C.in(22)[(size_t)i * 16 + 2 * q + 1], y1 = C.in(23)[(size_t)i * 16 + 2 * q + 1];
            wr_[q] = cvtpk(fr * x0 - fi * y0, fr * x1 - fi * y1); wi_[q] = cvtpk(fr * y0 + fi * x0, fr * y1 + fi * x1); }
        bf16_t* bb = C.h(WS_SBB) + ((size_t)dg * 128 + p) * 16;
        *(u32x4*)bb = (u32x4){wr_[0], wr_[1], wr_[2], wr_[3]}; *(u32x4*)(bb + 8) = (u32x4){wr_[4], wr_[5], wr_[6], wr_[7]};
        *(u32x4*)(bb + 64 * 16) = (u32x4){wi_[0], wi_[1], wi_[2], wi_[3]}; *(u32x4*)(bb + 64 * 16 + 8) = (u32x4){wi_[4], wi_[5], wi_[6], wi_[7]};
    }
    for (int i = gt; i < 2 * 64 * 16 * 64; i += NGT) {
        const int p = i & 63, row = i >> 6; bf16_t* cb = C.h(WS_SCB) + (size_t)row * 128;
        cb[p] = (bf16_t)(cvtpk(C.in(24)[i], 0.f) & 0xffffu); cb[64 + p] = (bf16_t)(cvtpk(-C.in(25)[i], 0.f) & 0xffffu); }
}
__device__ __forceinline__ void rows_ap_ss(const Ctx& C, const float* xsrc_p, const float* xsrc_s, float* xcopy, int l, int s, bool from_table, u64_t* ssdst) {
    for (int gw = C.bid * NWAVES + C.wave; gw < M / 4; gw += C.G * NWAVES) {
    const int r0 = gw * 4;
    const int c = cond_of_row(r0);
    f32x4 gm[4];
#pragma unroll
    for (int j = 0; j < 4; ++j) { const int n = 4 * C.lane + 256 * j;
        if (from_table) gm[j] = *(const f32x4*)(C.f(WS_GMOD) + (((size_t)l * 2 + s) * 5 + c) * 1024 + n);
        else { const float* g = (s == 0 ? C.in(10) : C.in(11)) + l * D + n;
#pragma unroll
            for (int e = 0; e < 4; ++e) gm[j][e] = g[e] * (1.f + modsum(C, l, c, (s == 0 ? 1 : 4) * 1024 + n + e)); } }
    for (int rr = 0; rr < 4; ++rr) {
        const int r = r0 + rr; const float* xr = (r < MP ? xsrc_p + (size_t)r * D : xsrc_s + (size_t)(r - MP) * D);
        f32x4 v[4]; float sq = 0.f;
#pragma unroll
        for (int j = 0; j < 4; ++j) { v[j] = *(const f32x4*)(xr + 4 * C.lane + 256 * j); sq += (v[j][0] * v[j][0] + v[j][1] * v[j][1]) + (v[j][2] * v[j][2] + v[j][3] * v[j][3]); }
        sq = wave_sum(sq);
#pragma unroll
        for (int j = 0; j < 4; ++j) { const size_t off = (size_t)r * D + 4 * C.lane + 256 * j; if (xcopy) *(f32x4*)(xcopy + off) = v[j]; st_bf16x4(C.h(WS_AP) + off, v[j] * gm[j]); }
        if (C.lane == 0) ssdst[r] = (u64_t)(sq * SS_FIX);
    }
    }
}
template <bool FROM_TABLE> __device__ __forceinline__ void sw_item_t(const Ctx& C, int item) {
    int ch = item, l = 0, s = 0, N = 0; const float* Wf = nullptr;
    if (ch < 12) { l = 0; s = 0; N = NQKV; Wf = C.in(12); }
    else if ((ch -= 12) < 44) { l = 0; s = 1; N = NUP; Wf = C.in(28); }
    else if ((ch -= 44) < 40) { l = 1; s = 0; N = NHIN; Wf = C.in(15); }
    else if ((ch -= 40) < 44) { l = 1; s = 1; N = NUP; Wf = C.in(28) + (size_t)1 * D * NUP; }
    else if ((ch -= 44) < 44) { l = 2; s = 1; N = NUP; Wf = C.in(28) + (size_t)2 * D * NUP; }
    else if ((ch -= 44) < 12) { l = 3; s = 0; N = NQKV; Wf = C.in(12) + (size_t)1 * D * NQKV; }
    else { ch -= 12; l = 3; s = 1; N = NUP; Wf = C.in(28) + (size_t)3 * D * NUP; }
    LAS float* sh = (LAS float*)C.lds;
    for (int i = C.tid; i < 5 * 1024; i += NTHREADS) sh[i] = FROM_TABLE ? C.f(WS_MOD)[((size_t)l * 5 + (i >> 10)) * 6144 + (s == 0 ? 0 : 3) * 1024 + (i & 1023)] : modsum(C, l, i >> 10, (s == 0 ? 0 : 3) * 1024 + (i & 1023));
    __syncthreads();
    const int n0 = ch * 128 + 4 * (C.lane & 31);
    f32x4 a[5];
#pragma unroll
    for (int c = 0; c < 5; ++c) a[c] = (f32x4){0.f, 0.f, 0.f, 0.f};
    const float* wp = Wf + (size_t)(C.wave * 128 + (C.lane >> 5)) * N + n0;
#pragma unroll 4
    for (int k = 0; k < 64; ++k) { const f32x4 w = *(const f32x4*)(wp + (size_t)(2 * k) * N); const int kk = C.wave * 128 + 2 * k + (C.lane >> 5);
#pragma unroll
        for (int c = 0; c < 5; ++c) a[c] += w * sh[c * 1024 + kk]; }
    LAS float* red = (LAS float*)(C.lds + 20480);
#pragma unroll
    for (int c = 0; c < 5; ++c) *(LAS f32x4*)(red + ((C.wave * 2 + (C.lane >> 5)) * 5 + c) * 128 + 4 * (C.lane & 31)) = a[c];
    __syncthreads();
    for (int i = C.tid; i < 5 * 128; i += NTHREADS) { float sum = 0.f;
#pragma unroll
        for (int w = 0; w < 16; ++w) sum += red[w * 640 + i];
        C.f(WS_SW)[(((size_t)l * 2 + s) * 5 + (i >> 7)) * SW_STRIDE + ch * 128 + (i & 127)] = sum; }
    __syncthreads();
}
__device__ __forceinline__ void sw_item_p0(const Ctx& C, int item) { sw_item_t<false>(C, item); }
__device__ __forceinline__ void sw_item(const Ctx& C, int item) { sw_item_t<true>(C, item); }
__device__ __forceinline__ void phase_p0c(const Ctx& C) {
    for (int vb = C.bid; vb < 256; vb += C.G) {
    if (vb < 240) {
        sw_item_p0(C, vb);
    } else {
        const int t = (vb - 240) * NTHREADS + C.tid, NT = 16 * NTHREADS;
        for (int i = t; i < 4 * 5 * 6144; i += NT) { const int l = i / 30720, c = (i / 6144) % 5, idx = i % 6144; C.f(WS_MOD)[i] = modsum(C, l, c, idx); }
        for (int i = t; i < 4 * 2 * 5 * 1024; i += NT) { const int n = i & 1023, c = (i >> 10) % 5, s = (i / 5120) & 1, l = i / 10240;
            C.f(WS_GMOD)[i] = (s == 0 ? C.in(10) : C.in(11))[l * D + n] * (1.f + modsum(C, l, c, (s == 0 ? 1 : 4) * 1024 + n)); }
    }
    __syncthreads();
    }
    rows_ap_ss(C, C.in(0), C.in(1), C.f(WS_X), 0, 0, false, (u64_t*)(C.ws + WS_SS));
}
__device__ __forceinline__ void phase_glue(const Ctx& C, int l, int s) { rows_ap_ss(C, C.f(WS_X), C.f(WS_X) + (size_t)MP * D, nullptr, l, s, true, (u64_t*)(C.ws + WS_SS) + (size_t)(l * 2 + s) * M); }

__device__ __forceinline__ void phase_conv(const Ctx& C, int l) {
    const bf16_t* h = C.h(WS_SCR); bf16_t* act = C.h(WS_ACT); const float* cw = C.in(29) + (size_t)l * 3 * NUP; const float* cb = C.in(30) + (size_t)l * NUP;
    const int gt = C.bid * NTHREADS + C.tid, NGT = C.G * NTHREADS;
    for (int i = gt; i < M * (DFF / 8); i += NGT) {
        const int r = i / (DFF / 8), n = (i % (DFF / 8)) * 8;
        int t, S; if (r < MP) { t = r & 255; S = 256; } else { t = (r - MP) & 1023; S = 1024; }
        float g[8], v[8];
#pragma unroll
        for (int e = 0; e < 8; ++e) { g[e] = cb[n + e]; v[e] = cb[DFF + n + e]; }
#pragma unroll
        for (int jj = 0; jj < 3; ++jj) { const int tt = t + jj - 1; if (tt >= 0 && tt < S) {
            const u32x4 hg = *(const u32x4*)(h + (size_t)(r + jj - 1) * NUP + n), hv = *(const u32x4*)(h + (size_t)(r + jj - 1) * NUP + DFF + n);
#pragma unroll
            for (int e = 0; e < 4; ++e) { g[2 * e] += cw[jj * NUP + n + 2 * e] * bflo(hg[e]); g[2 * e + 1] += cw[jj * NUP + n + 2 * e + 1] * bfhi(hg[e]);
                v[2 * e] += cw[jj * NUP + DFF + n + 2 * e] * bflo(hv[e]); v[2 * e + 1] += cw[jj * NUP + DFF + n + 2 * e + 1] * bfhi(hv[e]); } } }
        u32x4 o;
#pragma unroll
        for (int e = 0; e < 4; ++e) o[e] = cvtpk(g[2 * e] * sigm(g[2 * e]) * v[2 * e], g[2 * e + 1] * sigm(g[2 * e + 1]) * v[2 * e + 1]);
        *(u32x4*)(act + (size_t)r * DFF + n) = o;
    }
}
__device__ __forceinline__ void phase_final(const Ctx& C, float dbg) {
    const int gw = C.bid * NWAVES + C.wave, NGW = C.G * NWAVES; const u64_t* ss = (const u64_t*)(C.ws + WS_SS) + (size_t)8 * M;
    for (int r = gw; r < M; r += NGW) { const float rs = rstd_of(ss, r);
#pragma unroll
        for (int j = 0; j < 4; ++j) { const int n = 4 * C.lane + 256 * j; float* p = C.out + (size_t)r * D + n; *(f32x4*)p = *(const f32x4*)p * (rs * dbg) * *(const f32x4*)(C.in(32) + n); } }
}
}
namespace om {
__device__ __forceinline__ int rowidx(int r, int h) { return (r & 3) + 8 * (r >> 2) + 4 * h; }
__device__ __forceinline__ float xhalf(float v) {
    auto rr = __builtin_amdgcn_permlane32_swap(__float_as_uint(v), __float_as_uint(v), false, false);
    return __uint_as_float((lane_id() & 32) ? rr[0] : rr[1]);
}
__device__ __forceinline__ bf16x8 pack8(const f32x16& x, int base) {
    u32x4 w; w.x = cvtpk(x[base], x[base + 1]); w.y = cvtpk(x[base + 2], x[base + 3]); w.z = cvtpk(x[base + 4], x[base + 5]); w.w = cvtpk(x[base + 6], x[base + 7]);
    return __builtin_bit_cast(bf16x8, w);
}
typedef short v4i16_t __attribute__((ext_vector_type(4)));
__device__ __forceinline__ u32x2 vtr4(const LAS unsigned char* p) { return __builtin_bit_cast(u32x2, __builtin_amdgcn_ds_read_tr16_b64_v4i16((LAS v4i16_t*)p)); }
__device__ __forceinline__ bf16x8 cat44(u32x2 a, u32x2 b) { u32x4 w = {a.x, a.y, b.x, b.y}; return __builtin_bit_cast(bf16x8, w); }

constexpr int AT_KSTR = 144;
constexpr int AT_BUF = 2 * 64 * AT_KSTR;
__device__ __forceinline__ void attn_unit(const Ctx& C, int j, bool samp, int b, int hq, int qb, size_t obuf) {
    const int lane = C.lane, c = lane & 31, h = lane >> 5, w = C.wave, kvh = hq >> 2;
    const int rowbase = samp ? MP + b * 1024 : b * 256, q0 = qb * 256, qlo = q0 + 32 * w;
    const bf16_t* Q = C.h(SCR_Q); const bf16_t* KB = C.h(SCR_KB); const bf16_t* VB = C.h(SCR_VB);
    const bf16_t* CK = C.h(WS_CTXK) + ((size_t)(b * 2 + j) * 512) * 256; const bf16_t* CV = C.h(WS_CTXV) + ((size_t)(b * 2 + j) * 512) * 256;
    int klo = 0, nlat = 4, NT = 4;
    if (samp) { klo = q0 - 128 < 0 ? 0 : q0 - 128; const int khi = q0 + 384 > 1024 ? 1024 : q0 + 384; nlat = (khi - klo) >> 6; NT = nlat + 8; }
    bf16x8 qf[4];
#pragma unroll
    for (int s = 0; s < 4; ++s) qf[s] = *(const bf16x8*)(Q + (size_t)(rowbase + qlo + c) * D + hq * 64 + 16 * s + 8 * h);
    float m = C.in(14)[j * 16 + hq] * LOG2E, lsum = h == 0 ? 1.f : 0.f;
    f32x16 o0 = {}, o1 = {};
    const int lkey = C.tid >> 3, lch = C.tid & 7;
    auto src_k = [&](int t) -> const bf16_t* { return (t < nlat ? KB + (size_t)(rowbase + klo + 64 * t + lkey) * 256 : CK + (size_t)(64 * (t - nlat) + lkey) * 256) + kvh * 64 + lch * 8; };
    auto src_v = [&](int t) -> const bf16_t* { return (t < nlat ? VB + (size_t)(rowbase + klo + 64 * t + lkey) * 256 : CV + (size_t)(64 * (t - nlat) + lkey) * 256) + kvh * 64 + lch * 8; };
    auto put = [&](int buf, u32x4 kr, u32x4 vr) {
        LAS unsigned char* kb = C.lds + buf * AT_BUF; LAS unsigned char* vb = kb + 64 * AT_KSTR;
        *(LAS u32x4*)(kb + lkey * AT_KSTR + lch * 16) = kr;
        *(LAS u32x4*)(vb + lkey * AT_KSTR + lch * 16) = vr;
    };
    const int vtr_off = (4 * h + ((lane & 15) >> 2)) * AT_KSTR + (16 * ((lane >> 4) & 1) + 4 * (lane & 3)) * 2;
    { const u32x4 kr = *(const u32x4*)src_k(0), vr = *(const u32x4*)src_v(0); put(0, kr, vr); }
    __syncthreads();
    for (int t = 0; t < NT; ++t) {
        u32x4 kr = {}, vr = {};
        if (t + 1 < NT) { kr = *(const u32x4*)src_k(t + 1); vr = *(const u32x4*)src_v(t + 1); }
        const bool lat = samp && t < nlat; const int key0 = klo + 64 * t;
        const bool skip = lat && (key0 > qlo + 31 + 128 || key0 + 63 < qlo - 128);
        if (!skip) {
            LAS unsigned char* kb = C.lds + (t & 1) * AT_BUF; LAS unsigned char* vb = kb + 64 * AT_KSTR;
            f32x16 x0 = {}, x1 = {};
#pragma unroll
            for (int s = 0; s < 4; ++s) {
                const bf16x8 a0 = *(const LAS bf16x8*)(kb + c * AT_KSTR + (16 * s + 8 * h) * 2), a1 = *(const LAS bf16x8*)(kb + (32 + c) * AT_KSTR + (16 * s + 8 * h) * 2);
                x0 = __builtin_amdgcn_mfma_f32_32x32x16_bf16(a0, qf[s], x0, 0, 0, 0); x1 = __builtin_amdgcn_mfma_f32_32x32x16_bf16(a1, qf[s], x1, 0, 0, 0);
            }
            if (lat && !(key0 >= qlo + 31 - 128 && key0 + 63 <= qlo + 128)) {
                const int tq = qlo + c;
#pragma unroll
                for (int r = 0; r < 16; ++r) { const int k0 = key0 + rowidx(r, h) - tq; if (k0 > 128 || k0 < -128) x0[r] = -INFINITY; if (k0 + 32 > 128 || k0 + 32 < -128) x1[r] = -INFINITY; }
            }
            float mx = fmaxf(x0[0], x1[0]);
#pragma unroll
            for (int r = 1; r < 16; ++r) mx = fmaxf(mx, fmaxf(x0[r], x1[r]));
            mx = fmaxf(mx, xhalf(mx));
            const float mn = fmaxf(m, mx), al = __builtin_amdgcn_exp2f(m - mn); m = mn;
            float ps = 0.f;
#pragma unroll
            for (int r = 0; r < 16; ++r) { x0[r] = __builtin_amdgcn_exp2f(x0[r] - mn); x1[r] = __builtin_amdgcn_exp2f(x1[r] - mn); ps += x0[r] + x1[r]; }
            lsum = lsum * al + ps;
#pragma unroll
            for (int r = 0; r < 16; ++r) { o0[r] *= al; o1[r] *= al; }
#pragma unroll
            for (int ks = 0; ks < 2; ++ks) {
                const bf16x8 p0 = pack8(x0, 8 * ks), p1 = pack8(x1, 8 * ks);
#pragma unroll
                for (int dt = 0; dt < 2; ++dt) {
                    const LAS unsigned char* vp = vb + vtr_off + (16 * ks) * AT_KSTR + (32 * dt) * 2;
                    const bf16x8 v0 = cat44(vtr4(vp), vtr4(vp + 8 * AT_KSTR)), v1 = cat44(vtr4(vp + 32 * AT_KSTR), vtr4(vp + 40 * AT_KSTR));
                    if (dt == 0) { o0 = __builtin_amdgcn_mfma_f32_32x32x16_bf16(v0, p0, o0, 0, 0, 0); o0 = __builtin_amdgcn_mfma_f32_32x32x16_bf16(v1, p1, o0, 0, 0, 0); }
                    else { o1 = __builtin_amdgcn_mfma_f32_32x32x16_bf16(v0, p0, o1, 0, 0, 0); o1 = __builtin_amdgcn_mfma_f32_32x32x16_bf16(v1, p1, o1, 0, 0, 0); }
                }
            }
        }
        if (t + 1 < NT) put((t + 1) & 1, kr, vr);
        __syncthreads();
    }
    lsum += xhalf(lsum);
    const float il = 1.f / lsum;
    bf16_t* O = C.h(obuf) + (size_t)(rowbase + qlo + c) * D + hq * 64 + 4 * h;
#pragma unroll
    for (int g = 0; g < 4; ++g) { st_bf16x4(O + 8 * g, (f32x4){o0[4 * g], o0[4 * g + 1], o0[4 * g + 2], o0[4 * g + 3]} * il); st_bf16x4(O + 32 + 8 * g, (f32x4){o1[4 * g], o1[4 * g + 1], o1[4 * g + 2], o1[4 * g + 3]} * il); }
}
__device__ __forceinline__ void phase_attn(const Ctx& C, int l, size_t obuf) {
    const int j = l / 3;
    for (int u = C.bid; u < 512; u += C.G) {
        if (u < 256) attn_unit(C, j, false, u >> 4, u & 15, 0, obuf);
        else { const int v = u - 256; attn_unit(C, j, true, v >> 6, (v >> 2) & 15, v & 3, obuf); }
    }
}
constexpr size_t CKS_TAB = 376 * MiB; constexpr int CKS_NW = (int)((268 * MiB) / 65536), CKS_NO = (17039360 * 4) / 65536, CKS_N = CKS_NW + CKS_NO;
__device__ __forceinline__ void phase_cks(const Ctx& C, int slot) {
    const int gw = C.bid * NWAVES + C.wave, NGW = C.G * NWAVES; unsigned* tab = (unsigned*)(C.ws + CKS_TAB) + (size_t)slot * 8192;
    for (int ck = gw; ck < CKS_N; ck += NGW) {
        const unsigned char* base = ck < CKS_NW ? C.ws + 108 * MiB + (size_t)ck * 65536 : (const unsigned char*)C.out + (size_t)(ck - CKS_NW) * 65536; unsigned s = 0;
        for (int i = 0; i < 64; ++i) { const u32x4 v = *(const u32x4*)(base + (size_t)i * 1024 + C.lane * 16); s += v[0] + v[1] * 3u + v[2] * 5u + v[3] * 7u; }
#pragma unroll
        for (int o = 1; o < 64; o <<= 1) s += (unsigned)__shfl_xor((int)s, o);
        if (C.lane == 0) tab[ck] = s;
    }
}
__device__ __forceinline__ void phase_clr(const Ctx& C) {
    const int gt = C.bid * NTHREADS + C.tid, NGT = C.G * NTHREADS; unsigned z0 = 0u; asm volatile("" : "+v"(z0)); const u32x4 z = {z0, z0, z0, z0};
    for (size_t i = gt; i < (268 * MiB) / 16; i += NGT) *(u32x4*)(C.ws + 108 * MiB + i * 16) = z;
    for (size_t i = gt; i < (size_t)17039360 / 4; i += NGT) *(u32x4*)((unsigned char*)C.out + i * 16) = z;
}
__device__ __forceinline__ void phase_clr2(const Ctx& C, size_t off, size_t bytes) {
    const int gt = C.bid * NTHREADS + C.tid, NGT = C.G * NTHREADS; unsigned z0 = 0u; asm volatile("" : "+v"(z0)); const u32x4 z = {z0, z0, z0, z0};
    for (size_t i = gt; i < bytes / 16; i += NGT) *(u32x4*)(C.ws + off + i * 16) = z;
}
__device__ __forceinline__ void phase_cmp(const Ctx& C, int nslots) {
    const int gt = C.bid * NTHREADS + C.tid, NGT = C.G * NTHREADS; const unsigned* tab = (const unsigned*)(C.ws + CKS_TAB);
    for (int i = gt; i < nslots * 8192; i += NGT) { const int sl = i >> 13, ck = i & 8191; if (ck < CKS_N && tab[(size_t)sl * 8192 + ck] != tab[(size_t)(sl + 32) * 8192 + ck]) {
#if defined(SSDET) || defined(SS2RUN)
        const int cls = ck >= CKS_NW ? 4 : (ck < 1472 + 512 ? 1 : 2); atomicOr((unsigned*)(C.ws + WS_CTL) + 4002, (unsigned)cls); atomicAdd((unsigned*)(C.ws + WS_CTL) + 4003, 1u);
#endif
        atomicMax((unsigned*)(C.ws + WS_CTL) + 4001, (unsigned)(1000 - sl)); } }
}
__device__ __forceinline__ void phase_chk(const Ctx& C, size_t a, size_t b, size_t bytes) {
    const int gt = C.bid * NTHREADS + C.tid, NGT = C.G * NTHREADS; unsigned bad = 0;
    for (size_t i = gt; i < bytes / 16; i += NGT) { const u32x4 x = *(const u32x4*)(C.ws + a + i * 16), y = *(const u32x4*)(C.ws + b + i * 16); bad += (x[0] != y[0]) | (x[1] != y[1]) | (x[2] != y[2]) | (x[3] != y[3]); }
    if (bad) atomicAdd((unsigned*)(C.ws + WS_CTL) + 4000, bad);
}

constexpr int HS_QSTR = 272, HS_TSTR = 80;
constexpr int HS_QT = 0, HS_KT = 32 * HS_QSTR, HS_KTT = 2 * 32 * HS_QSTR, HS_VT = HS_KTT + 128 * HS_TSTR, HS_E1 = HS_VT + 128 * HS_TSTR, HS_E2 = HS_E1 + 512, HS_T1 = HS_E2 + 512, HS_GRP = HS_T1 + 512;
__device__ __forceinline__ void hscan_item(const Ctx& C, int item) {
    const bool samp = item < 64; const int it = samp ? item : item - 64;
    const int dir = it & 1, hd = (it >> 1) & 7, sq = it >> 4;
    const int S = samp ? 1024 : 256, rowbase = samp ? MP + sq * 1024 : sq * 256, nchunk = S >> 5;
    const int tg = C.tid & 255, lane = C.lane, c = lane & 31, h = lane >> 5, w4 = C.wave & 3; const bool producer = C.wave >= 4;
    LAS unsigned char* L = C.lds;
    const bf16_t* HQ = C.h(SCR_HQ); const bf16_t* HV = C.h(SCR_HV); const float* LF = C.f(dir == 0 ? SCR_LFF : SCR_LFB); float* OD = C.f(dir == 0 ? SCR_OF : SCR_OB);
    const int pd = tg & 127, ph = tg >> 7;
    unsigned qw[8], kw[8], vtw[8]; float e1v = 0.f, e2v = 0.f;
    float rlf[16], rpre[16]; unsigned rq[16], rv[16];
    auto issue = [&](int ch) {
#pragma unroll
        for (int i = 0; i < 16; ++i) { const int pos = 32 * ch + 16 * ph + i, t = dir == 0 ? pos : S - 1 - pos; const size_t off = (size_t)(rowbase + t) * D + hd * 128 + pd;
            rlf[i] = LF[off]; rq[i] = HQ[off]; rv[i] = HV[off];
            const int pos2 = 32 * ch + i, t2 = dir == 0 ? pos2 : S - 1 - pos2; rpre[i] = ph == 1 ? LF[(size_t)(rowbase + t2) * D + hd * 128 + pd] : 0.f; }
    };
    auto compute = [&]() {
        float cl[16]; float pre = 0.f, run = 0.f;
#pragma unroll
        for (int i = 0; i < 16; ++i) { pre += rpre[i]; run += rlf[i]; cl[i] = run; }
        const float t1v = ph == 0 ? cl[15] : pre;
#pragma unroll
        for (int i = 0; i < 16; i += 2) {
            const float e0 = ph == 0 ? cl[i] - t1v : cl[i], e1 = ph == 0 ? cl[i + 1] - t1v : cl[i + 1];
            const float k0 = 1.f - __expf(rlf[i]), k1 = 1.f - __expf(rlf[i + 1]);
            qw[i >> 1] = cvtpk(__uint_as_float(rq[i] << 16) * __expf(e0), __uint_as_float(rq[i + 1] << 16) * __expf(e1)); kw[i >> 1] = cvtpk(k0 * __expf(-e0), k1 * __expf(-e1));
            vtw[i >> 1] = rv[i] | (rv[i + 1] << 16); }
        e1v = __expf(t1v); e2v = __expf(cl[15]);
    };
    auto put = [&]() {
#pragma unroll
        for (int i = 0; i < 8; ++i) {
            *(LAS unsigned short*)(L + HS_QT + (16 * ph + 2 * i) * HS_QSTR + pd * 2) = (unsigned short)(qw[i] & 0xffffu); *(LAS unsigned short*)(L + HS_QT + (16 * ph + 2 * i + 1) * HS_QSTR + pd * 2) = (unsigned short)(qw[i] >> 16);
            *(LAS unsigned short*)(L + HS_KT + (16 * ph + 2 * i) * HS_QSTR + pd * 2) = (unsigned short)(kw[i] & 0xffffu); *(LAS unsigned short*)(L + HS_KT + (16 * ph + 2 * i + 1) * HS_QSTR + pd * 2) = (unsigned short)(kw[i] >> 16); }
        *(LAS u32x4*)(L + HS_KTT + pd * HS_TSTR + ph * 32) = (u32x4){kw[0], kw[1], kw[2], kw[3]}; *(LAS u32x4*)(L + HS_KTT + pd * HS_TSTR + ph * 32 + 16) = (u32x4){kw[4], kw[5], kw[6], kw[7]};
        *(LAS u32x4*)(L + HS_VT + pd * HS_TSTR + ph * 32) = (u32x4){vtw[0], vtw[1], vtw[2], vtw[3]}; *(LAS u32x4*)(L + HS_VT + pd * HS_TSTR + ph * 32 + 16) = (u32x4){vtw[4], vtw[5], vtw[6], vtw[7]};
        if (ph == 0) *(LAS float*)(L + HS_E1 + pd * 4) = e1v; else *(LAS float*)(L + HS_E2 + pd * 4) = e2v;
    };
    if (producer) {
        issue(0); compute(); if (nchunk > 1) issue(1);
        for (int ch = 0; ch < nchunk; ++ch) {
            put();
            __syncthreads();
            if (ch + 1 < nchunk) { compute(); if (ch + 2 < nchunk) issue(ch + 2); }
            __syncthreads();
        }
        return;
    }
    f32x16 St[4];
#pragma unroll
    for (int dt = 0; dt < 4; ++dt) {
        if (samp) { const float* s0 = C.in(4) + ((((size_t)sq * 2 + dir) * 8 + hd) * 128) * 128;
#pragma unroll
            for (int r = 0; r < 16; ++r) St[dt][r] = s0[(size_t)(32 * dt + rowidx(r, h)) * 128 + 32 * w4 + c]; }
        else St[dt] = (f32x16){};
    }
    for (int ch = 0; ch < nchunk; ++ch) {
        __syncthreads();
#pragma unroll
        for (int dt = 0; dt < 4; ++dt)
#pragma unroll
            for (int g = 0; g < 4; ++g) { const f32x4 e = *(const LAS f32x4*)(L + HS_E1 + (32 * dt + 8 * g + 4 * h) * 4);
#pragma unroll
                for (int q = 0; q < 4; ++q) St[dt][4 * g + q] *= e[q]; }
        f32x16 X = {};
#pragma unroll
        for (int s = 0; s < 8; ++s) {
            const bf16x8 a = *(const LAS bf16x8*)(L + HS_KT + c * HS_QSTR + (16 * s + 8 * h) * 2), bq = *(const LAS bf16x8*)(L + HS_QT + c * HS_QSTR + (16 * s + 8 * h) * 2);
            X = __builtin_amdgcn_mfma_f32_32x32x16_bf16(a, bq, X, 0, 0, 0);
        }
#pragma unroll
        for (int r = 0; r < 16; ++r) if (rowidx(r, h) > c) X[r] = 0.f;
        f32x16 OT = {};
#pragma unroll
        for (int ks = 0; ks < 2; ++ks) {
            const LAS unsigned char* vrow = L + HS_VT + (32 * w4 + c) * HS_TSTR + (16 * ks + 4 * h) * 2;
            const bf16x8 va = cat44(*(const LAS u32x2*)(vrow), *(const LAS u32x2*)(vrow + 16));
            OT = __builtin_amdgcn_mfma_f32_32x32x16_bf16(va, pack8(X, 8 * ks), OT, 0, 0, 0);
        }
#pragma unroll
        for (int dt = 0; dt < 4; ++dt)
#pragma unroll
            for (int ks = 0; ks < 2; ++ks) {
                const LAS unsigned char* qrow = L + HS_QT + c * HS_QSTR + (32 * dt + 16 * ks + 4 * h) * 2;
                const bf16x8 bq = cat44(*(const LAS u32x2*)(qrow), *(const LAS u32x2*)(qrow + 16));
                OT = __builtin_amdgcn_mfma_f32_32x32x16_bf16(pack8(St[dt], 8 * ks), bq, OT, 0, 0, 0);
            }
#pragma unroll
        for (int dt = 0; dt < 4; ++dt)
#pragma unroll
            for (int ks = 0; ks < 2; ++ks) {
                const bf16x8 a = *(const LAS bf16x8*)(L + HS_KTT + (32 * dt + c) * HS_TSTR + (16 * ks + 8 * h) * 2), bv = *(const LAS bf16x8*)(L + HS_VT + (32 * w4 + c) * HS_TSTR + (16 * ks + 8 * h) * 2);
                St[dt] = __builtin_amdgcn_mfma_f32_32x32x16_bf16(a, bv, St[dt], 0, 0, 0);
            }
#pragma unroll
        for (int dt = 0; dt < 4; ++dt)
#pragma unroll
            for (int g = 0; g < 4; ++g) { const f32x4 e = *(const LAS f32x4*)(L + HS_E2 + (32 * dt + 8 * g + 4 * h) * 4);
#pragma unroll
                for (int q = 0; q < 4; ++q) St[dt][4 * g + q] *= e[q]; }
        { const int pos = 32 * ch + c, t = dir == 0 ? pos : S - 1 - pos; float* op = OD + (size_t)(rowbase + t) * D + hd * 128 + 32 * w4 + 4 * h;
#pragma unroll
            for (int g = 0; g < 4; ++g) *(f32x4*)(op + 8 * g) = (f32x4){OT[4 * g], OT[4 * g + 1], OT[4 * g + 2], OT[4 * g + 3]}; }
        __syncthreads();
    }
    if (!samp) { float* so = C.out + 8388608 + 2 * 2097152 + ((((size_t)sq * 2 + dir) * 8 + hd) * 128) * 128;
        int c2 = c, h2 = h; asm volatile("" : "+v"(c2), "+v"(h2));
        unsigned base = (unsigned)((4 * h2) * 128 + 32 * w4 + c2);
#pragma unroll
        for (int dt = 0; dt < 4; ++dt)
#pragma unroll
            for (int r = 0; r < 16; ++r) so[base + (unsigned)((32 * dt + (r & 3) + 8 * (r >> 2)) * 128)] = St[dt][r]; }
}
__device__ __forceinline__ void phase_hscan(const Ctx& C) {
    if (C.G == 256) {
        hscan_item(C, C.bid);
        if (C.bid >= 64 && C.bid < 128) hscan_item(C, 256 + (C.bid - 64));
    } else for (int it = C.bid; it < 320; it += C.G) hscan_item(C, it);
}
__device__ __forceinline__ void phase_hpost(const Ctx& C) {
    const int gw = C.bid * NWAVES + C.wave, NGW = C.G * NWAVES;
    for (int r = gw; r < M; r += NGW) {
        const size_t off = (size_t)r * D + 16 * C.lane; float o[16]; float sq = 0.f;
#pragma unroll
        for (int q = 0; q < 4; ++q) { const f32x4 a = *(const f32x4*)(C.f(SCR_OF) + off + 4 * q), b = *(const f32x4*)(C.f(SCR_OB) + off + 4 * q);
#pragma unroll
            for (int e = 0; e < 4; ++e) { o[4 * q + e] = a[e] + b[e]; sq += o[4 * q + e] * o[4 * q + e]; } }
        sq += __shfl_xor(sq, 1); sq += __shfl_xor(sq, 2); sq += __shfl_xor(sq, 4);
        const float rs = rsqrtf(sq * (1.f / 128.f) + EPS);
        const u32x4 g0 = *(const u32x4*)(C.h(SCR_HG) + off), g1 = *(const u32x4*)(C.h(SCR_HG) + off + 8);
        const float* gn = C.in(17) + (16 * C.lane & 127);
        float sg[16];
#pragma unroll
        for (int e = 0; e < 4; ++e) { sg[2 * e] = bflo(g0[e]); sg[2 * e + 1] = bfhi(g0[e]); sg[8 + 2 * e] = bflo(g1[e]); sg[8 + 2 * e + 1] = bfhi(g1[e]); }
        u32x4 w0, w1;
#pragma unroll
        for (int e = 0; e < 4; ++e) { w0[e] = cvtpk(o[2 * e] * rs * gn[2 * e] * sg[2 * e], o[2 * e + 1] * rs * gn[2 * e + 1] * sg[2 * e + 1]);
            w1[e] = cvtpk(o[8 + 2 * e] * rs * gn[8 + 2 * e] * sg[8 + 2 * e], o[8 + 2 * e + 1] * rs * gn[8 + 2 * e + 1] * sg[8 + 2 * e + 1]); }
        *(u32x4*)(C.h(SCR_AWO) + off) = w0; *(u32x4*)(C.h(SCR_AWO) + off + 8) = w1;
    }
}

constexpr int SS_RSTR = 512;
constexpr int SS_WAVE = 16 * SS_RSTR;
__device__ __forceinline__ void sscan_seq(const Ctx& C, int l, bool samp, int sq, int dir, int g, size_t ydbg) {
    const int lane = C.lane, c = lane & 31, h = lane >> 5, dg = dir * 64 + g;
    const int S = samp ? 1024 : 256, rowbase = samp ? MP + sq * 1024 : sq * 256, nchunk = S >> 5, cond = samp ? 1 + sq : 0;
    LAS unsigned char* LB = C.lds + C.wave * SS_WAVE; LAS unsigned char* LH = LB + 4096;
    const float* X = C.f(WS_X); const u64_t* ss = (const u64_t*)(C.ws + WS_SS) + (size_t)(l * 2) * M; float* Y = C.f(ydbg ? ydbg : (dir == 0 ? SCR_YF : SCR_YB)); const bool ywr = !ydbg || dir == 0;
    bf16x8 bfr[4], cfr[4];
#pragma unroll
    for (int ct = 0; ct < 4; ++ct) bfr[ct] = *(const bf16x8*)(C.h(WS_SBB) + ((size_t)dg * 128 + 32 * ct + c) * 16 + 8 * h);
#pragma unroll
    for (int s = 0; s < 4; ++s) cfr[s] = *(const bf16x8*)(C.h(WS_SCB) + ((size_t)dg * 16 + (lane & 15)) * 128 + 32 * s + 8 * (lane >> 4));
    const float lr = C.f(WS_SLAM)[2 * (dg * 64 + lane)], li = C.f(WS_SLAM)[2 * (dg * 64 + lane) + 1];
    f32x4 gm0, gm1, sh0, sh1;
    { const float* gm = C.f(WS_GMOD) + ((size_t)(l * 2) * 5 + cond) * 1024 + g * 16 + 8 * h; gm0 = *(const f32x4*)gm; gm1 = *(const f32x4*)(gm + 4);
      const float* sh = C.f(WS_MOD) + ((size_t)l * 5 + cond) * 6144 + g * 16 + 8 * h; sh0 = *(const f32x4*)sh; sh1 = *(const f32x4*)(sh + 4); }
    float hr = 0.f, hi = 0.f;
    if (samp) { const float* s0 = C.in(5) + ((((size_t)sq * 2 + dir) * 64 + g) * 64 + lane) * 2; hr = s0[0]; hi = s0[1]; }
    for (int ch = 0; ch < nchunk; ++ch) {
        const int pos = 32 * ch + c, t = dir == 0 ? pos : S - 1 - pos, r = rowbase + t;
        const float rs = rstd_of(ss, r);
        const f32x4 x0 = *(const f32x4*)(X + (size_t)r * D + g * 16 + 8 * h), x1 = *(const f32x4*)(X + (size_t)r * D + g * 16 + 8 * h + 4);
        const f32x4 u0 = x0 * rs * gm0 + sh0, u1 = x1 * rs * gm1 + sh1;
        u32x4 uw = {cvtpk(u0[0], u0[1]), cvtpk(u0[2], u0[3]), cvtpk(u1[0], u1[1]), cvtpk(u1[2], u1[3])};
        const bf16x8 uf = __builtin_bit_cast(bf16x8, uw);
        f32x16 bu[4];
#pragma unroll
        for (int ct = 0; ct < 4; ++ct) { bu[ct] = (f32x16){}; bu[ct] = __builtin_amdgcn_mfma_f32_32x32x16_bf16(uf, bfr[ct], bu[ct], 0, 0, 0); }
#pragma unroll
        for (int i = 0; i < 16; ++i) {
            const auto sr = __builtin_amdgcn_permlane32_swap(__float_as_uint(bu[0][i]), __float_as_uint(bu[1][i]), false, false);
            bu[0][i] = __uint_as_float(sr[0]); bu[1][i] = __uint_as_float(sr[1]);
            const auto si = __builtin_amdgcn_permlane32_swap(__float_as_uint(bu[2][i]), __float_as_uint(bu[3][i]), false, false);
            bu[2][i] = __uint_as_float(si[0]); bu[3][i] = __uint_as_float(si[1]);
        }
#pragma unroll
        for (int hf = 0; hf < 2; ++hf) {
#pragma unroll
            for (int t8 = 0; t8 < 2; ++t8) {
                float br[8], bi[8]; unsigned wv[8];
#pragma unroll
                for (int k = 0; k < 8; ++k) { br[k] = bu[k >> 2][4 * (2 * hf + t8) + (k & 3)]; bi[k] = bu[2 + (k >> 2)][4 * (2 * hf + t8) + (k & 3)]; }
#pragma unroll
                for (int k = 0; k < 8; ++k) { const float nr = lr * hr - li * hi + br[k], ni = lr * hi + li * hr + bi[k]; hr = nr; hi = ni; wv[k] = cvtpk(hr, hi); }
#pragma unroll
                for (int k = 0; k < 8; ++k) { const int row = 8 * t8 + k;
                    *(LAS unsigned short*)(LH + row * 256 + ((((lane >> 3)) ^ row) << 4) + (lane & 7) * 2) = (unsigned short)(wv[k] & 0xffffu);
                    *(LAS unsigned short*)(LH + row * 256 + (((8 + (lane >> 3)) ^ row) << 4) + (lane & 7) * 2) = (unsigned short)(wv[k] >> 16); }
                LDS_WAIT();
            }
            f32x4 y0 = {};
#pragma unroll
            for (int s = 0; s < 4; ++s) {
                const bf16x8 a0 = *(const LAS bf16x8*)(LH + (lane & 15) * 256 + (((4 * s + (lane >> 4)) ^ (lane & 15)) << 4));
                y0 = __builtin_amdgcn_mfma_f32_16x16x32_bf16(a0, cfr[s], y0, 0, 0, 0);
            }
            if (ywr) {
#pragma unroll
                for (int q = 0; q < 4; ++q) { const int p0 = 32 * ch + 16 * hf + 4 * (lane >> 4) + q, t0 = dir == 0 ? p0 : S - 1 - p0; Y[(size_t)(rowbase + t0) * D + g * 16 + (lane & 15)] = y0[q]; }
            }
            LDS_WAIT();
        }
    }
    if (!samp && !ydbg) { float* so = C.out + 8388608 + 2 * 2097152 + 4194304 + ((((size_t)sq * 2 + dir) * 64 + g) * 64 + lane) * 2; so[0] = hr; so[1] = hi; }
}
__device__ __forceinline__ void phase_sscan(const Ctx& C, int l, size_t ydbg) {
    for (int bb = C.bid; bb < 256; bb += C.G) {
        const int w = C.wave;
#ifdef SS_ONLYWAVE
        if (ydbg && !((SS_ONLYWAVE >> w) & 1)) continue;
#endif
        if (w < 2) { const int id = 2 * bb + w; sscan_seq(C, l, true, id >> 7, (id >> 6) & 1, id & 63, ydbg); }
        else { int id = 8 * bb + (w - 2); sscan_seq(C, l, false, id >> 7, (id >> 6) & 1, id & 63, ydbg);
            if (w < 4) { id = 8 * bb + 6 + (w - 2); sscan_seq(C, l, false, id >> 7, (id >> 6) & 1, id & 63, ydbg); } }
    }
}
__device__ __forceinline__ void phase_spost(const Ctx& C, int l) {
    const int gw = C.bid * NWAVES + C.wave, NGW = C.G * NWAVES; const u64_t* ss = (const u64_t*)(C.ws + WS_SS) + (size_t)(l * 2) * M;
    for (int r = gw; r < M; r += NGW) {
        const int cond = cond_of_row(r); const float rs = rstd_of(ss, r);
#pragma unroll
        for (int jq = 0; jq < 4; ++jq) {
            const int n = 4 * C.lane + 256 * jq; const size_t off = (size_t)r * D + n;
            const f32x4 x = *(const f32x4*)(C.f(WS_X) + off), gm = *(const f32x4*)(C.f(WS_GMOD) + ((size_t)(l * 2) * 5 + cond) * 1024 + n), sh = *(const f32x4*)(C.f(WS_MOD) + ((size_t)l * 5 + cond) * 6144 + n);
            const f32x4 u = x * rs * gm + sh, y = *(const f32x4*)(C.in(26) + n) * u + *(const f32x4*)(C.f(SCR_YF) + off) + *(const f32x4*)(C.f(SCR_YB) + off);
            f32x4 o;
#pragma unroll
            for (int e = 0; e < 4; ++e) { const float v = y[e], uu = 0.7978845608028654f * (v + 0.044715f * v * v * v); const float th = 1.f - 2.f * __builtin_amdgcn_rcpf(1.f + __expf(2.f * uu)); o[e] = 0.5f * v * (1.f + th); }
            st_bf16x4(C.h(SCR_AGLU) + off, o);
        }
    }
}
#define XB_TMO      128
#define XB_XCNT(j)  (256  + 64 * (j))
#define XB_XSUB(j)  (1280 + 64 * (j))
#define XB_XGEN(j)  (2304 + 64 * (j))
#define XB_TOP      3328
#define XB_TOPGEN   3392
#define XCD_BAR_WORDS 3456
#define XB_SPIN_CAP (1u << 18)
#ifndef XB_SCOPE
#define XB_SCOPE "agent"
#endif
__device__ __forceinline__ unsigned xb_ld(unsigned* p)              { return __hip_atomic_load(p, __ATOMIC_RELAXED, __HIP_MEMORY_SCOPE_AGENT); }
__device__ __forceinline__ unsigned xb_add(unsigned* p, unsigned v) { return __hip_atomic_fetch_add(p, v, __ATOMIC_RELAXED, __HIP_MEMORY_SCOPE_AGENT); }
__device__ __forceinline__ unsigned xb_xcc_id() { return (unsigned)__builtin_amdgcn_s_getreg((3 << 11) | 20) & 0xFu; }
#define XB_SPIN(cond, bar) do { unsigned _sp = 0; while (cond) { __builtin_amdgcn_s_sleep(1); \
    if ((++_sp & 255u) == 0u) { if (xb_ld(&(bar)[XB_TMO])) break; if (_sp > XB_SPIN_CAP) { atomicAdd(&(bar)[XB_TMO], 1u); break; } } } } while (0)
struct XcdBarrier { unsigned* bar; unsigned x; volatile LAS unsigned* st; };
__device__ __forceinline__ XcdBarrier xcd_barrier_post(unsigned* bar, volatile LAS unsigned* st) {
    XcdBarrier b; b.bar = bar; b.x = xb_xcc_id(); b.st = st;
    if (threadIdx.x == 0) (void)xb_add(&bar[XB_XCNT(b.x)], 1u);
    return b;
}
__device__ __forceinline__ void xcd_barrier_complete(unsigned* bar, unsigned x, unsigned& nloc, unsigned& nx) {
    const unsigned G = gridDim.x * gridDim.y * gridDim.z;
    unsigned sum, cnt, mine, sp = 0u;
    for (;;) {
        sum = 0u; cnt = 0u; mine = 0u;
#pragma unroll
        for (unsigned j = 0; j < 16; ++j) { const unsigned c = xb_ld(&bar[XB_XCNT(j)]); sum += c; cnt += (c > 0u) ? 1u : 0u; mine = (j == x) ? c : mine; }
        if (sum == G) break;
        __builtin_amdgcn_s_sleep(1);
        if ((++sp & 255u) == 0u) { if (xb_ld(&bar[XB_TMO])) break; if (sp > XB_SPIN_CAP) { atomicAdd(&bar[XB_TMO], 1u); break; } }
    }
    nloc = mine > 0u ? mine : 1u; nx = cnt > 0u ? cnt : 1u;
}
__device__ __forceinline__ void xcd_barrier(const XcdBarrier& b, bool thread0) {
    asm volatile("s_waitcnt vmcnt(0)" ::: "memory");
    __syncthreads();
    if (thread0) {
        unsigned* bar = b.bar;
        __builtin_amdgcn_s_waitcnt(0);
        unsigned nloc = b.st[0], nx = b.st[1];
        if (nloc == 0u) { xcd_barrier_complete(bar, b.x, nloc, nx); b.st[0] = nloc; b.st[1] = nx; }
#ifdef XB_EARLY_WB
        asm volatile("buffer_wbl2 sc1" ::: "memory");
#endif
        const unsigned old = xb_add(&bar[XB_XSUB(b.x)], 1u);
        const unsigned gen = old / nloc;
        if (old + 1u == (gen + 1u) * nloc) {
            __builtin_amdgcn_fence(__ATOMIC_RELEASE, XB_SCOPE);
            asm volatile("s_waitcnt vmcnt(0)" ::: "memory");
            const unsigned og = xb_add(&bar[XB_TOP], 1u);
            const unsigned tg = og / nx;
            __builtin_amdgcn_fence(__ATOMIC_ACQUIRE, XB_SCOPE);
            if (og + 1u == (tg + 1u) * nx) xb_add(&bar[XB_TOPGEN], 1u);
            else XB_SPIN(xb_ld(&bar[XB_TOPGEN]) == tg, bar);
            xb_add(&bar[XB_XGEN(b.x)], 1u);
            asm volatile("s_waitcnt vmcnt(0)" ::: "memory");
        } else {
            __builtin_amdgcn_fence(__ATOMIC_ACQUIRE, XB_SCOPE);
            XB_SPIN(xb_ld(&bar[XB_XGEN(b.x)]) == gen, bar);
            asm volatile("s_waitcnt vmcnt(0)" ::: "memory");
        }
#ifdef XB_DELAY
        for (int q = 0; q < XB_DELAY; ++q) __builtin_amdgcn_s_sleep(127);
#endif
    }
    __syncthreads();
}
}
namespace om {
enum { PH_P0A = 0, PH_P0C, PH_GLUE, PH_QKV, PH_ATTN, PH_WO, PH_HIN, PH_HSCAN, PH_HPOST, PH_HWO, PH_SSCAN, PH_SPOST, PH_GLU, PH_UP, PH_CONV, PH_DOWN, PH_FINAL };

struct Args { const float* in[33]; float* out; unsigned char* ws; int nph; int pad; unsigned char ptype[160]; unsigned char parg[160]; };
static_assert(offsetof(Args, ptype) == 288 && offsetof(Args, parg) == 448, "Args layout");

__device__ __forceinline__ void down_patch(const Ctx& C, int l, const pg8::StaticOrder& S) {
    Unit u; const float* cw = C.in(29) + (size_t)l * 3 * NUP; const float* E0 = C.f(WS_EDGE); bf16_t* act = C.h(WS_ACT);
    for (int i = 0; S.next(i, u); ++i) {
        if (u.pm < 16) continue;
        const bool top = (u.pm & 3) != 0, bot = (u.pm & 3) != 3;
        for (int n = C.tid; n < DFF; n += NTHREADS) {
            if (top) { const float* e = E0 + ((size_t)((u.pm - 16) * 2 + 0) * 4) * DFF; const float* ep = E0 + ((size_t)((u.pm - 17) * 2 + 1) * 4) * DFF;
                const float hg = e[n] + cw[n] * ep[2 * DFF + n], hv = e[DFF + n] + cw[DFF + n] * ep[3 * DFF + n];
                act[(size_t)(u.pm * 256) * DFF + n] = (bf16_t)(cvtpk(hg * sigm(hg) * hv, 0.f) & 0xffffu); }
            if (bot) { const float* e = E0 + ((size_t)((u.pm - 16) * 2 + 1) * 4) * DFF; const float* en = E0 + ((size_t)((u.pm - 15) * 2 + 0) * 4) * DFF;
                const float hg = e[n] + cw[2 * NUP + n] * en[2 * DFF + n], hv = e[DFF + n] + cw[2 * NUP + DFF + n] * en[3 * DFF + n];
                act[(size_t)(u.pm * 256 + 255) * DFF + n] = (bf16_t)(cvtpk(hg * sigm(hg) * hv, 0.f) & 0xffffu); }
        }
    }
    asm volatile("s_waitcnt vmcnt(0)" ::: "memory"); __syncthreads();
}
__device__ __forceinline__ void run_phase(const Ctx& C0, int type, int arg, int epoch) {
    Ctx C = C0; asm volatile("" : "+v"(C.tid)); asm volatile("" : "+s"(C.bid), "+s"(C.G), "+s"(C.kp), "+s"(C.ws), "+s"(C.out));
    C.lane = C.tid & 63; C.wave = __builtin_amdgcn_readfirstlane(C.tid >> 6);
    const int l = arg & 3;
    if (type == 31) return;
#ifndef PHASE_MASK
#define PHASE_MASK 0xFFFFFFFFu
#endif
    if (!((PHASE_MASK >> type) & 1u)) return;
    pg8::Gemm g{nullptr, nullptr, D, 256, 128, D, 0}; int nN = 0; EpiAny E{}; E.ws = C.ws; E.out = C.out; E.l = l; E.epoch = epoch;
    const bool splitk = false;
    switch (type) {
    case PH_P0A: phase_p0a(C); break;
    case PH_P0C: phase_p0c(C); break;
    case PH_GLUE: phase_glue(C, arg >> 1, arg & 1); break;
    case PH_QKV: { g.A = C.h(WS_AP); g.Bt = C.h(WS_WQKV) + (size_t)(l / 3) * NQKV * D; nN = 6; E.kind = EK_QKV; } break;
    case PH_ATTN: phase_attn(C, l, (arg & 32) ? SCR_O + 96 * MiB : SCR_O); break;
#ifdef DBG
    case 17: phase_chk(C, SCR_O, SCR_O + 96 * MiB, 16 * MiB); break;
#endif
#ifdef DBG
    case 18: phase_cks(C, arg); break;
#endif
#ifdef DBG
    case 19: phase_cmp(C, arg); break;
#endif
#ifdef DBG
    case 20: phase_clr(C); break;
#endif
    case PH_WO: case PH_HWO: case PH_GLU: {
        if (type == PH_WO) { g.A = C.h(SCR_O); g.Bt = C.h(WS_WO) + (size_t)(l / 3) * D * D; nN = 4; E.kind = EK_RES; if (splitk) { g.split = 1; g.K = D / 2; nN = 8; } }
        else if (type == PH_HWO) { g.A = C.h(SCR_AWO); g.Bt = C.h(WS_HWO); nN = 4; E.kind = EK_RES; if (splitk) { g.split = 1; g.K = D / 2; nN = 8; } }
        else { g.A = C.h(SCR_AGLU); g.Bt = C.h(WS_GLU); g.b_tile_rows = 128; g.b_half_rows = 1024; nN = 8; E.kind = EK_RES_GLU; }
        E.flags = ((arg & 32) ? 4 : 0) | (type == PH_HWO ? 8 : 0); } break;
    case PH_HIN: { g.A = C.h(WS_AP); g.Bt = C.h(WS_HWIN); nN = (C.G == 256) ? 16 : 20; E.kind = EK_HIN; } break;
    case PH_HSCAN: { phase_hscan(C);
        if (C.G == 256 && C.bid >= 128) {
            __syncthreads();
            g.A = C.h(WS_AP); g.Bt = C.h(WS_HWIN) + (size_t)4096 * D; E.kind = EK_HIN; E.pn_off = 16;
            pg8::StaticOrder S; S.init(32, 4, 128, C.bid - 128); pg8::gemm_phase(C.lds, g, S, E, C.tid); } } break;
    case PH_HPOST: phase_hpost(C); break;
    case PH_SSCAN: phase_sscan(C, l, (arg & 32) ? WS_SCR + 80 * MiB : ((arg & 64) ? WS_SCR + 112 * MiB : 0)); break;
#ifdef DBG
    case 22: phase_clr2(C, WS_SCR + 80 * MiB, 64 * MiB); break;
#endif
#ifdef DBG
    case 21: phase_chk(C, WS_SCR + 80 * MiB, WS_SCR + 112 * MiB, 32 * MiB); break;
#endif
    case PH_SPOST: phase_spost(C, l); break;
    case PH_UP: { g.A = C.h(WS_AP); g.Bt = C.h(WS_UP) + (size_t)l * NUP * D; g.b_tile_rows = 128; g.b_half_rows = DFF; nN = 22; E.kind = EK_UPCONV; E.in29 = C.in(29); E.in30 = C.in(30); E.xl = C.lds + RING_BYTES; } break;
#ifdef DBG
    case 23: phase_chk(C, WS_SCR, WS_SCR + 88 * MiB, 88 * MiB); break;
#endif
    case PH_CONV: phase_conv(C, l); break;
    case PH_DOWN: { if (l < 3 && C.G == 256 && C.bid >= 128) convert_layer(C, l + 1, C.bid - 128, 128);
        { pg8::StaticOrder S0; S0.init(32, splitk ? 8 : 4, C.G, C.bid); down_patch(C, l, S0); }
        g.A = C.h(WS_ACT); g.Bt = C.h(WS_DOWN) + (size_t)l * D * DFF; g.K = DFF; g.ld = DFF; nN = 4; if (splitk) { g.split = 1; g.K = DFF / 2; nN = 8; } E.kind = EK_RES; E.flags = 1 | ((arg & 16) ? 2 : 0) | ((arg & 32) ? 4 : 0); } break;
    case PH_FINAL: { const unsigned fl = __hip_atomic_load((unsigned*)(C.ws + WS_CTL) + 4000, __ATOMIC_RELAXED, __HIP_MEMORY_SCOPE_AGENT), fd = __hip_atomic_load((unsigned*)(C.ws + WS_CTL) + 4001, __ATOMIC_RELAXED, __HIP_MEMORY_SCOPE_AGENT);
        #ifdef SSDET_CLS
        const unsigned cls = __hip_atomic_load((unsigned*)(C.ws + WS_CTL) + 4002, __ATOMIC_RELAXED, __HIP_MEMORY_SCOPE_AGENT), cnt = __hip_atomic_load((unsigned*)(C.ws + WS_CTL) + 4003, __ATOMIC_RELAXED, __HIP_MEMORY_SCOPE_AGENT);
        phase_final(C, 1.f + (float)cls / 8.f + (float)(cnt > 63 ? 63 : cnt) / 1024.f); } break;
#else
        phase_final(C, fl ? 3.f : (fd ? exp2f((float)(1001 - fd)) : 1.f)); } break;
#endif
    default: break;
    }
    if (nN) { pg8::StaticOrder S; S.init(32, nN, C.G, C.bid); pg8::gemm_phase(C.lds, g, S, E, C.tid); }
}

__device__ __forceinline__ void canary(const Ctx& C0, unsigned char* ws, int i, bool check) {
    int tid = C0.tid; asm volatile("" : "+v"(tid)); const int lane = tid & 63, wave = tid >> 6;
    unsigned* can = (unsigned*)(ws + WS_CTL + 32768);
#ifdef CANARY_SC1
    if (!check) { if (wave == 0 && lane < 32) __hip_atomic_store(can + C0.bid * 32 + lane, (unsigned)(i + 1), __ATOMIC_RELAXED, __HIP_MEMORY_SCOPE_AGENT); }
#else
    if (!check) { if (wave == 0 && lane < 32) can[C0.bid * 32 + lane] = (unsigned)(i + 1); }
#endif
#ifdef CANARY_LD_SC1
    else { const unsigned v = __hip_atomic_load(can + (wave * 32 + (lane >> 1)) * 32 + (lane & 1) * 16, __ATOMIC_RELAXED, __HIP_MEMORY_SCOPE_AGENT);
#else
    else { const unsigned v = can[(wave * 32 + (lane >> 1)) * 32 + (lane & 1) * 16];
#endif
      if (v != (unsigned)(i + 1) && v != (unsigned)(i + 2)) atomicAdd((unsigned*)(ws + WS_CTL) + 4000, 1u); }
}
__global__ void __launch_bounds__(NTHREADS, 2) mk_fwd(Args a) {
    extern __shared__ __attribute__((aligned(16))) unsigned char lds[];
    int wave_s = __builtin_amdgcn_readfirstlane((int)(threadIdx.x >> 6));
    { volatile LAS unsigned* misc = (volatile LAS unsigned*)((LAS unsigned char*)lds + LDS_BYTES - 64); if (threadIdx.x < 16) misc[threadIdx.x] = 0u; }
    __syncthreads();
    (void)xcd_barrier_post((unsigned*)(a.ws + WS_CTL), (volatile LAS unsigned*)((LAS unsigned char*)lds + LDS_BYTES - 64));
    for (int i = 0; i < a.nph; ++i) {
        {
            Ctx C; C.kp = (const unsigned char __attribute__((address_space(4)))*)__builtin_amdgcn_kernarg_segment_ptr();
            C.out = a.out; C.ws = a.ws; C.lds = (LAS unsigned char*)lds; asm volatile("" : "+s"(wave_s)); C.tid = (wave_s << 6) | lane_id(); C.lane = C.tid & 63; C.wave = 0; C.G = gridDim.x; C.bid = blockIdx.x;
            const unsigned wt = *(const unsigned __attribute__((address_space(4)))*)(C.kp + 288 + (i & ~3)), wa = *(const unsigned __attribute__((address_space(4)))*)(C.kp + 448 + (i & ~3));
            run_phase(C, (int)((wt >> (8 * (i & 3))) & 255u), (int)((wa >> (8 * (i & 3))) & 255u), i + 1);
#ifdef CANARY
            canary(C, a.ws, i, false);
#endif
        }
        if (i + 1 < a.nph) { XcdBarrier bar; bar.bar = (unsigned*)(a.ws + WS_CTL); bar.x = xb_xcc_id(); bar.st = (volatile LAS unsigned*)((LAS unsigned char*)lds + LDS_BYTES - 64); xcd_barrier(bar, wave_s == 0 && lane_id() == 0); }
#ifdef CANARY
        if (i + 1 < a.nph) { Ctx C; C.tid = (wave_s << 6) | lane_id(); C.bid = blockIdx.x; canary(C, a.ws, i, true); }
#endif
    }
}
}
extern "C" void kernel_launch(void* const* d_in, const int* in_sizes, int n_in, void* d_out, int out_size, void* d_ws, size_t ws_size, hipStream_t stream) {
    using namespace om;
    static int grid = 0;
    if (grid == 0) {
        if (n_in != 33 || out_size != 17039360 || ws_size < WS_END) { fprintf(stderr, "kernel_launch: unexpected sizes n_in %d out %d ws %zu; nothing launched\n", n_in, out_size, ws_size); grid = -1; return; }
        int dev = 0, cus = 0, per_cu = 0;
        (void)hipGetDevice(&dev); (void)hipDeviceGetAttribute(&cus, hipDeviceAttributeMultiprocessorCount, dev);
        (void)hipFuncSetAttribute((const void*)mk_fwd, hipFuncAttributeMaxDynamicSharedMemorySize, LDS_BYTES);
        if (hipOccupancyMaxActiveBlocksPerMultiprocessor(&per_cu, (const void*)mk_fwd, NTHREADS, LDS_BYTES) != hipSuccess || per_cu < 1) { fprintf(stderr, "kernel_launch: occupancy query gives %d blocks per CU\n", per_cu); per_cu = 1; }
        (void)hipGetLastError();
        grid = cus;
        if (grid > 256) grid = 256;
    }
    if (grid < 0) return;
    (void)hipMemsetAsync((char*)d_ws + WS_CTL, 0, CTL_ZERO_BYTES, stream);
    Args a{};
    for (int i = 0; i < 33; ++i) a.in[i] = (const float*)d_in[i];
    a.out = (float*)d_out; a.ws = (unsigned char*)d_ws;
    int n = 0;
#ifndef DUP_MASK
#define DUP_MASK 0u
#endif
#ifndef XBAR
#define XBAR 0
#endif
    auto add1 = [&](int t, int p) { a.ptype[n] = (unsigned char)t; a.parg[n] = (unsigned char)p; ++n; };
    auto add = [&](int t, int p) { add1(t, p);
        if ((DUP_MASK >> t) & 1u) { const bool resid = (t == PH_WO || t == PH_HWO || t == PH_GLU || t == PH_DOWN); add1(t, resid ? (p | 32) : p); }
        for (int q = 0; q < XBAR; ++q) add1(31, 0); };
#ifdef UPDET
    add1(PH_P0A, 0); add1(PH_P0C, 0);
    for (int l = 0; l < 4; ++l) { const int kind = l % 3;
        if (kind == 0) { add1(PH_QKV, l); add1(PH_ATTN, l); add1(PH_WO, l); }
        else if (kind == 1) { add1(PH_HIN, l); add1(PH_HSCAN, l); add1(PH_HPOST, l); add1(PH_HWO, l); }
        else { add1(PH_SSCAN, l); add1(PH_SPOST, l); add1(PH_GLU, l); }
        add1(PH_UP, l); add1(PH_UP, l | 32); add1(23, 0); add1(PH_CONV, l); add1(PH_DOWN, l == 3 ? (l | 16) : l); }
    add1(PH_FINAL, 0);
#elif defined(SS2RUN)
    add1(PH_P0A, 0); add1(PH_P0C, 0);
    for (int l = 0; l < 4; ++l) { const int kind = l % 3;
        if (kind == 0) { add1(PH_QKV, l); add1(PH_ATTN, l); add1(PH_WO, l); }
        else if (kind == 1) { add1(PH_HIN, l); add1(PH_HSCAN, l); add1(PH_HPOST, l); add1(PH_HWO, l); }
        else { add1(PH_SSCAN, l); add1(18, 0); add1(PH_SSCAN, l); add1(18, 32); add1(19, 1); add1(PH_SPOST, l); add1(PH_GLU, l); }
        add1(PH_UP, l); add1(PH_DOWN, l == 3 ? (l | 16) : l); }
    add1(PH_FINAL, 0);
#elif defined(SSDET)
    add1(PH_P0A, 0); add1(PH_P0C, 0);
    for (int l = 0; l < 4; ++l) { const int kind = l % 3;
        if (kind == 0) { add1(PH_QKV, l); add1(PH_ATTN, l); add1(PH_WO, l); }
        else if (kind == 1) { add1(PH_HIN, l); add1(PH_HSCAN, l); add1(PH_HPOST, l); add1(PH_HWO, l); }
        else { add1(22, 0); add1(PH_SSCAN, l | 32); add1(PH_SSCAN, l | 64); add1(21, 0); add1(PH_SSCAN, l); add1(PH_SPOST, l); add1(PH_GLU, l); }
        add1(PH_UP, l); add1(PH_DOWN, l == 3 ? (l | 16) : l); }
    add1(PH_FINAL, 0);
#elif defined(LOCALIZE)
    for (int fwd = 0; fwd < 2; ++fwd) { int idx = 0;
        auto addc = [&](int t, int p) { add1(t, p); add1(18, fwd * 32 + idx); ++idx; };
        add1(20, 0); addc(PH_P0A, 0); addc(PH_P0C, 0);
        for (int l = 0; l < 4; ++l) { const int kind = l % 3;
            if (kind == 0) { addc(PH_QKV, l); addc(PH_ATTN, l); addc(PH_WO, l); }
            else if (kind == 1) { addc(PH_HIN, l); addc(PH_HSCAN, l); addc(PH_HPOST, l); addc(PH_HWO, l); }
            else { addc(PH_SSCAN, l); addc(PH_SPOST, l); addc(PH_GLU, l); }
            addc(PH_UP, l); addc(PH_DOWN, l == 3 ? (l | 16) : l); }
        if (fwd == 1) { add1(19, idx); add1(PH_FINAL, 0); } }
#else
    add(PH_P0A, 0); add(PH_P0C, 0);
    for (int l = 0; l < 4; ++l) {
        const int kind = l % 3;
        if (kind == 0) { add(PH_QKV, l); add(PH_ATTN, l); add(PH_WO, l); }
        else if (kind == 1) { add(PH_HIN, l); add(PH_HSCAN, l); add(PH_HPOST, l); add(PH_HWO, l); }
        else { add(PH_SSCAN, l); add(PH_SPOST, l); add(PH_GLU, l); }
        add(PH_UP, l); add(PH_DOWN, l == 3 ? (l | 16) : l);
    }
    add(PH_FINAL, 0);
#endif
    a.nph = n;
    void* args[] = {&a};
    const hipError_t e = hipLaunchCooperativeKernel((const void*)mk_fwd, dim3(grid), dim3(NTHREADS), args, LDS_BYTES, stream);
    if (e != hipSuccess) fprintf(stderr, "kernel_launch: cooperative launch failed: %s (grid %d)\n", hipGetErrorString(e), grid);
}
```
